# Optimizing an MI355X kernel written in HIP

```python
import jax, jax.numpy as jnp
from jax import lax
import numpy as np

D_MODEL = 1024
BATCH = 4
SEQ = 4096
DEPTH = 2
DEC_BATCH = 128
DEC_SEQ = 8
PAST_LEN = 8192
PAGE_SIZE = 128

A_WIDTH = D_MODEL // 2
A_GROUPS = 4
A_GROUP_DIM = A_WIDTH // A_GROUPS
A_CHUNK = 128
B_HEADS = 8
B_KV_HEADS = 2
B_HEAD_DIM = 64
B_GROUP = B_HEADS // B_KV_HEADS
B_WIDTH = B_HEADS * B_HEAD_DIM
B_KV_WIDTH = B_KV_HEADS * B_HEAD_DIM
WINDOW = 128
C_HEADS = 4
C_HEAD_DIM = 128
C_WIDTH = C_HEADS * C_HEAD_DIM
C_CONV = 4
C_CHUNK = 64
N_BRANCH = 3
EPS = 1e-6

IN_SPLITS = (A_WIDTH, A_WIDTH, A_WIDTH,
             B_WIDTH, B_KV_WIDTH, B_KV_WIDTH, B_WIDTH,
             2 * C_WIDTH, C_WIDTH, C_HEADS, C_HEADS, C_WIDTH, C_WIDTH,
             N_BRANCH * D_MODEL)
IN_WIDTH = sum(IN_SPLITS)
IN_OFFSETS = tuple(int(s) for s in np.cumsum(IN_SPLITS)[:-1])

kernel_name = 'gated_parallel_gmlp_swa_mlstm_decoder_step'


def rmsnorm(x, g):
    xf = x.astype(jnp.float32)
    y = xf * lax.rsqrt(jnp.mean(xf * xf, axis=-1, keepdims=True) + EPS)
    return (y * g.astype(jnp.float32)).astype(x.dtype)


def causal_conv(x, buf, w, b):
    t = x.shape[1]
    xp = jnp.concatenate([buf.astype(x.dtype), x], axis=1)
    y = b
    for j in range(C_CONV):
        y = y + w[j] * xp[:, j:j + t]
    return y, xp[:, -(C_CONV - 1):]


def chunk_gmlp(u, v, vnorm_g, ws, bs):
    bsz, t = u.shape[0], u.shape[1]
    L = min(A_CHUNK, t)
    nc = t // L
    vn = rmsnorm(v, vnorm_g)
    vb = vn.reshape(bsz, nc, L, A_GROUPS, A_GROUP_DIM)
    w = ws[:, :L, :L] * jnp.tril(jnp.ones((L, L), ws.dtype))
    s = jnp.einsum('gts,bnsgc->bntgc', w, vb) + bs[:, :L].T[None, None, :, :, None]
    return u * s.reshape(bsz, t, A_WIDTH), vn


def sink_attention(qb, kb, vb, mask, sinks):
    logits = jnp.einsum('bnqkgd,bnskd->bnkgqs', qb, kb).astype(jnp.float32) * (B_HEAD_DIM ** -0.5)
    logits = jnp.where(mask[None, :, None, None], logits, -jnp.inf)
    snk = sinks.astype(jnp.float32).reshape(B_KV_HEADS, B_GROUP)[None, None, :, :, None]
    mx = jnp.maximum(logits.max(axis=-1), snk)
    p = jnp.exp(logits - mx[..., None])
    den = p.sum(axis=-1) + jnp.exp(snk - mx)
    out = jnp.einsum('bnkgqs,bnskd->bnkgqd', p, vb.astype(jnp.float32)) / den[..., None]
    return out.transpose(0, 1, 4, 2, 3, 5).astype(qb.dtype)


def swa_branch(q, k, v, qn_g, kn_g, sinks, buf_k, buf_v):
    bsz, t = q.shape[0], q.shape[1]
    q = rmsnorm(q.reshape(bsz, t, B_HEADS, B_HEAD_DIM), qn_g).reshape(bsz, t, B_KV_HEADS, B_GROUP, B_HEAD_DIM)
    k = rmsnorm(k.reshape(bsz, t, B_KV_HEADS, B_HEAD_DIM), kn_g)
    v = v.reshape(bsz, t, B_KV_HEADS, B_HEAD_DIM)
    if buf_k is None:
        nb = t // WINDOW
        kp = jnp.concatenate([jnp.zeros_like(k[:, :WINDOW]), k], axis=1)
        vp = jnp.concatenate([jnp.zeros_like(v[:, :WINDOW]), v], axis=1)
        kb = jnp.concatenate([kp[:, :t].reshape(bsz, nb, WINDOW, B_KV_HEADS, B_HEAD_DIM),
                              k.reshape(bsz, nb, WINDOW, B_KV_HEADS, B_HEAD_DIM)], axis=2)
        vb = jnp.concatenate([vp[:, :t].reshape(bsz, nb, WINDOW, B_KV_HEADS, B_HEAD_DIM),
                              v.reshape(bsz, nb, WINDOW, B_KV_HEADS, B_HEAD_DIM)], axis=2)
        qb = q.reshape(bsz, nb, WINDOW, B_KV_HEADS, B_GROUP, B_HEAD_DIM)
        qpos = jnp.arange(t).reshape(nb, WINDOW)
        kpos = (jnp.arange(nb) * WINDOW - WINDOW)[:, None] + jnp.arange(2 * WINDOW)[None]
        valid = (kpos >= 0)[:, None, :]
        new_k, new_v = k[:, t - WINDOW:], v[:, t - WINDOW:]
    else:
        wb = buf_k.shape[1]
        kall = jnp.concatenate([buf_k.astype(k.dtype), k], axis=1)
        vall = jnp.concatenate([buf_v.astype(v.dtype), v], axis=1)
        kb, vb, qb = kall[:, None], vall[:, None], q[:, None]
        qpos = jnp.arange(t)[None]
        kpos = (jnp.arange(wb + t) - wb)[None]
        valid = True
        new_k, new_v = kall[:, -wb:], vall[:, -wb:]
    diff = qpos[:, :, None] - kpos[:, None, :]
    mask = (diff >= 0) & (diff < WINDOW) & valid
    out = sink_attention(qb, kb, vb, mask, sinks).reshape(bsz, t, B_WIDTH)
    return out, new_k, new_v


def mlstm_scan(q, k, v, i_pre, logf, C0, n0, m0, chunk):
    bsz, t, nh, d = q.shape
    nc = t // chunk
    f32 = jnp.float32

    def to_chunks(a):
        a = a.astype(f32).reshape((bsz, nc, chunk) + a.shape[2:])
        return jnp.moveaxis(a, 1, 0)

    causal = jnp.tril(jnp.ones((chunk, chunk), bool))

    def step(carry, xs):
        C, n, m = carry
        qc, kc, vc, ic, fc = xs
        cum = jnp.cumsum(fc, axis=1)
        dmat = cum[:, :, None, :] - cum[:, None, :, :] + ic[:, None, :, :]
        dmat = jnp.where(causal[None, :, :, None], dmat, -jnp.inf)
        m_inter = cum + m[:, None, :]
        m_t = jnp.maximum(m_inter, dmat.max(axis=2))
        a = jnp.exp(dmat - m_t[:, :, None, :]) * jnp.einsum('bthd,bshd->btsh', qc, kc)
        w_inter = jnp.exp(m_inter - m_t)
        num = jnp.einsum('btsh,bshd->bthd', a, vc) + w_inter[..., None] * jnp.einsum('bthd,bhde->bthe', qc, C)
        den = a.sum(axis=2) + w_inter * jnp.einsum('bthd,bhd->bth', qc, n)
        h = num / jnp.maximum(jnp.abs(den), jnp.exp(-m_t))[..., None]
        total = cum[:, -1]
        g = total[:, None] - cum + ic
        m_new = jnp.maximum(total + m, g.max(axis=1))
        wsel = jnp.exp(g - m_new[:, None])
        decay = jnp.exp(total + m - m_new)
        C_new = decay[..., None, None] * C + jnp.einsum('bsh,bshd,bshe->bhde', wsel, kc, vc)
        n_new = decay[..., None] * n + jnp.einsum('bsh,bshd->bhd', wsel, kc)
        return (C_new, n_new, m_new), h

    xs = (to_chunks(q), to_chunks(k), to_chunks(v), to_chunks(i_pre), to_chunks(logf))
    (C1, n1, m1), h = lax.scan(step, (C0.astype(f32), n0.astype(f32), m0.astype(f32)), xs)
    h = jnp.moveaxis(h, 0, 1).reshape(bsz, t, nh, d)
    return h, C1, n1, m1


def mlstm_branch(qk, v, i_pre, f_pre, o_pre, conv_w, conv_b, f_bias, hnorm_g, conv_buf, C0, n0, m0):
    bsz, t = qk.shape[0], qk.shape[1]
    qk, new_buf = causal_conv(qk, conv_buf, conv_w, conv_b)
    qk = jax.nn.silu(qk)
    q, k = jnp.split(qk, 2, axis=-1)
    q = q.reshape(bsz, t, C_HEADS, C_HEAD_DIM)
    k = k.reshape(bsz, t, C_HEADS, C_HEAD_DIM) * (C_HEAD_DIM ** -0.5)
    v = v.reshape(bsz, t, C_HEADS, C_HEAD_DIM)
    logf = jax.nn.log_sigmoid((f_pre + f_bias).astype(jnp.float32))
    h, C1, n1, m1 = mlstm_scan(q, k, v, i_pre, logf, C0, n0, m0, min(C_CHUNK, t))
    h = rmsnorm(h.astype(qk.dtype), hnorm_g.reshape(C_HEADS, C_HEAD_DIM)).reshape(bsz, t, C_WIDTH)
    return h * jax.nn.sigmoid(o_pre), new_buf, C1, n1, m1


def trunk_layer(x, c, lp, past):
    bsz, t = x.shape[0], x.shape[1]
    mod = jax.nn.silu(c) @ lp['ada_w'] + lp['ada_b']
    shift, scale, gate = jnp.split(mod, 3, axis=-1)
    h = rmsnorm(x, lp['norm_g']) * (1.0 + scale[:, None]) + shift[:, None]
    z = h @ lp['w_in'] + lp['b_in']
    a_u, a_v, a_g, b_q, b_k, b_v, b_g, c_qk, c_v, c_i, c_f, c_o, c_g, m_g = jnp.split(z, IN_OFFSETS, axis=-1)
    ya, v_rows = chunk_gmlp(a_u, a_v, lp['gmlp_vnorm_g'], lp['gmlp_ws'], lp['gmlp_bs'])
    ya = ya * jax.nn.silu(a_g)
    if past is None:
        buf_k = None
        buf_v = None
        conv_buf = jnp.zeros((bsz, C_CONV - 1, 2 * C_WIDTH), x.dtype)
        C0 = jnp.zeros((bsz, C_HEADS, C_HEAD_DIM, C_HEAD_DIM), jnp.float32)
        n0 = jnp.zeros((bsz, C_HEADS, C_HEAD_DIM), jnp.float32)
        m0 = jnp.zeros((bsz, C_HEADS), jnp.float32)
    else:
        buf_k, buf_v, conv_buf, C0, n0, m0 = past
    yb, new_k, new_v = swa_branch(b_q, b_k, b_v, lp['swa_qnorm_g'], lp['swa_knorm_g'], lp['swa_sinks'], buf_k, buf_v)
    yb = yb * jax.nn.silu(b_g)
    yc, new_conv, C1, n1, m1 = mlstm_branch(c_qk, c_v, c_i, c_f, c_o, lp['mlstm_conv_w'], lp['mlstm_conv_b'],
                                            lp['mlstm_f_bias'], lp['mlstm_hnorm_g'], conv_buf, C0, n0, m0)
    yc = yc * jax.nn.silu(c_g)
    gates = jax.nn.sigmoid(m_g).reshape(bsz, t, N_BRANCH, D_MODEL)
    merged = (gates[:, :, 0] * (ya @ lp['w_branch_a'])
              + gates[:, :, 1] * (yb @ lp['w_branch_b'])
              + gates[:, :, 2] * (yc @ lp['w_branch_c']))
    x_out = x + gate[:, None] * (merged @ lp['w_out'])
    new_state = (new_k, new_v, new_conv, C1.astype(x.dtype), n1.astype(x.dtype), m1.astype(x.dtype))
    return x_out, new_state, v_rows


def setup_inputs(seed: int = 0) -> dict:
    key = jax.random.key(seed)
    ks = iter(jax.random.split(key, 40))

    def nrm(shape, s):
        return jax.random.normal(next(ks), shape, jnp.float32) * s

    wb = min(WINDOW, PAST_LEN)
    return {
        'x_prompt': nrm((BATCH, SEQ, D_MODEL), 1.0),
        'x_sample': nrm((DEC_BATCH, DEC_SEQ, D_MODEL), 1.0),
        'cache_swa_k': nrm((DEPTH, DEC_BATCH, wb, B_KV_HEADS, B_HEAD_DIM), 1.0),
        'cache_swa_v': nrm((DEPTH, DEC_BATCH, wb, B_KV_HEADS, B_HEAD_DIM), 1.0),
        'state_mlstm_conv': nrm((DEPTH, DEC_BATCH, C_CONV - 1, 2 * C_WIDTH), 1.0),
        'state_mlstm_C': nrm((DEPTH, DEC_BATCH, C_HEADS, C_HEAD_DIM, C_HEAD_DIM), 0.1),
        'state_mlstm_n': nrm((DEPTH, DEC_BATCH, C_HEADS, C_HEAD_DIM), 0.1),
        'state_mlstm_m': nrm((DEPTH, DEC_BATCH, C_HEADS), 1.0),
        'c_prompt': nrm((BATCH, D_MODEL), 1.0),
        'c_sample': nrm((DEC_BATCH, D_MODEL), 1.0),
        'ada_w': nrm((DEPTH, D_MODEL, 3 * D_MODEL), 0.3 * D_MODEL ** -0.5),
        'ada_b': nrm((DEPTH, 3 * D_MODEL), 0.02),
        'norm_g': 1.0 + nrm((DEPTH, D_MODEL), 0.05),
        'w_in': nrm((DEPTH, D_MODEL, IN_WIDTH), D_MODEL ** -0.5),
        'b_in': nrm((DEPTH, IN_WIDTH), 0.02),
        'gmlp_vnorm_g': 1.0 + nrm((DEPTH, A_WIDTH), 0.05),
        'gmlp_ws': nrm((DEPTH, A_GROUPS, A_CHUNK, A_CHUNK), A_CHUNK ** -0.5),
        'gmlp_bs': 1.0 + nrm((DEPTH, A_GROUPS, A_CHUNK), 0.1),
        'swa_qnorm_g': 1.0 + nrm((DEPTH, B_HEAD_DIM), 0.05),
        'swa_knorm_g': 1.0 + nrm((DEPTH, B_HEAD_DIM), 0.05),
        'swa_sinks': nrm((DEPTH, B_HEADS), 0.5),
        'mlstm_conv_w': nrm((DEPTH, C_CONV, 2 * C_WIDTH), C_CONV ** -0.5),
        'mlstm_conv_b': nrm((DEPTH, 2 * C_WIDTH), 0.02),
        'mlstm_f_bias': jnp.linspace(3.0, 6.0, C_HEADS, dtype=jnp.float32)[None] + nrm((DEPTH, C_HEADS), 0.1),
        'mlstm_hnorm_g': 1.0 + nrm((DEPTH, C_WIDTH), 0.05),
        'w_branch_a': nrm((DEPTH, A_WIDTH, D_MODEL), A_WIDTH ** -0.5),
        'w_branch_b': nrm((DEPTH, B_WIDTH, D_MODEL), B_WIDTH ** -0.5),
        'w_branch_c': nrm((DEPTH, C_WIDTH, D_MODEL), C_WIDTH ** -0.5),
        'w_out': nrm((DEPTH, D_MODEL, D_MODEL), D_MODEL ** -0.5),
    }


def reference(x_prompt, x_sample, cache_swa_k, cache_swa_v, state_mlstm_conv, state_mlstm_C, state_mlstm_n,
              state_mlstm_m, c_prompt, c_sample, ada_w, ada_b, norm_g, w_in, b_in, gmlp_vnorm_g, gmlp_ws, gmlp_bs,
              swa_qnorm_g, swa_knorm_g, swa_sinks, mlstm_conv_w, mlstm_conv_b, mlstm_f_bias, mlstm_hnorm_g,
              w_branch_a, w_branch_b, w_branch_c, w_out):
    x_p, x_s = x_prompt, x_sample
    states_p, states_s, vrows_s = [], [], []
    for l in range(DEPTH):
        lp = {
            'ada_w': ada_w[l], 'ada_b': ada_b[l], 'norm_g': norm_g[l], 'w_in': w_in[l], 'b_in': b_in[l],
            'gmlp_vnorm_g': gmlp_vnorm_g[l], 'gmlp_ws': gmlp_ws[l], 'gmlp_bs': gmlp_bs[l],
            'swa_qnorm_g': swa_qnorm_g[l], 'swa_knorm_g': swa_knorm_g[l], 'swa_sinks': swa_sinks[l],
            'mlstm_conv_w': mlstm_conv_w[l], 'mlstm_conv_b': mlstm_conv_b[l], 'mlstm_f_bias': mlstm_f_bias[l],
            'mlstm_hnorm_g': mlstm_hnorm_g[l], 'w_branch_a': w_branch_a[l], 'w_branch_b': w_branch_b[l],
            'w_branch_c': w_branch_c[l], 'w_out': w_out[l],
        }
        x_p, st_p, _ = trunk_layer(x_p, c_prompt, lp, None)
        past = (cache_swa_k[l], cache_swa_v[l], state_mlstm_conv[l], state_mlstm_C[l], state_mlstm_n[l],
                state_mlstm_m[l])
        x_s, st_s, vr = trunk_layer(x_s, c_sample, lp, past)
        states_p.append(st_p)
        states_s.append(st_s)
        vrows_s.append(vr)
    sp = [jnp.stack([st[j] for st in states_p]) for j in range(6)]
    ss = [jnp.stack([st[j] for st in states_s]) for j in range(6)]
    gmlp_v_sample = jnp.stack(vrows_s)
    return (x_p, x_s, sp[0], sp[1], sp[2], sp[3], sp[4], sp[5],
            ss[0], ss[1], ss[2], ss[3], ss[4], ss[5], gmlp_v_sample)
```

```cpp
#include <hip/hip_runtime.h>
#include <hip/hip_cooperative_groups.h>
#include <cstdio>
namespace cg = cooperative_groups;

typedef unsigned short bf16;
typedef short bf16x8 __attribute__((ext_vector_type(8)));
typedef float f32x4 __attribute__((ext_vector_type(4)));
typedef unsigned u32x4 __attribute__((ext_vector_type(4)));

#ifndef SINGLE_LAUNCH
#define SINGLE_LAUNCH 0
#endif

constexpr int D = 1024, TP = 16384, TS = 1024, TT = TP + TS, SEQ = 4096;
constexpr int ZIN = 8456, NWIN = 8576;
constexpr int OFF_AV = 512, OFF_AG = 1024, OFF_BQ = 1536, OFF_BK = 2048, OFF_BV = 2176, OFF_BG = 2304, OFF_MG = 5384;
constexpr int ZAB = 2816;
constexpr int ZC = 2688;
constexpr int C_QK = 0, C_V = 1024, C_I = 1536, C_F = 1540, C_O = 1544, C_G = 2056;
constexpr float EPS = 1e-6f;
constexpr int NMOD = 132;
constexpr int SMEM_BYTES = 73728;

constexpr size_t O_Y = 0;
constexpr size_t O_SKP = (size_t)TT * D;
constexpr size_t O_SVP = O_SKP + 2 * 4 * 128 * 128;
constexpr size_t O_CVP = O_SVP + 2 * 4 * 128 * 128;
constexpr size_t O_CP = O_CVP + 2 * 4 * 3 * 1024;
constexpr size_t O_NP = O_CP + (size_t)2 * 4 * 4 * 128 * 128;
constexpr size_t O_MP = O_NP + 2 * 4 * 4 * 128;
constexpr size_t O_SKS = O_MP + 2 * 4 * 4;
constexpr size_t O_SVS = O_SKS + (size_t)2 * 128 * 128 * 128;
constexpr size_t O_CVS = O_SVS + (size_t)2 * 128 * 128 * 128;
constexpr size_t O_CS = O_CVS + (size_t)2 * 128 * 3 * 1024;
constexpr size_t O_NS = O_CS + (size_t)2 * 128 * 4 * 128 * 128;
constexpr size_t O_MS = O_NS + (size_t)2 * 128 * 4 * 128;
constexpr size_t O_GV = O_MS + 2 * 128 * 4;
constexpr size_t O_END = O_GV + (size_t)2 * 128 * 8 * 512;

constexpr size_t WS_WIN = 0;
constexpr size_t WS_WBR = WS_WIN + (size_t)2 * NWIN * 1024 * 2;
constexpr size_t WS_WOUT = WS_WBR + (size_t)2 * 1024 * 1536 * 2;
constexpr size_t WS_MOD = WS_WOUT + (size_t)2 * 1024 * 1024 * 2;
constexpr size_t WS_H = WS_MOD + (size_t)2 * NMOD * 3072 * 4;
constexpr size_t WS_YAB = WS_H + (size_t)TT * 1024 * 2;
constexpr size_t WS_U = WS_YAB + (size_t)TT * 1024 * 2;
constexpr size_t WS_UN = WS_U + (size_t)TT * 1024 * 2;
constexpr size_t WS_G = WS_UN + (size_t)1024 * 128 * 4;
constexpr size_t WS_TOT = WS_G + 4096;
constexpr size_t WS_M = WS_TOT + 4096;
constexpr size_t WS_Z = WS_M + 4096;
constexpr size_t WS_END = WS_Z + (size_t)TT * ZAB * 2;

struct Params {
  const float *x_prompt, *x_sample, *cache_k, *cache_v, *st_conv, *st_C, *st_n, *st_m, *c_prompt, *c_sample;
  const float *ada_w, *ada_b, *norm_g, *w_in, *b_in, *vnorm_g, *gmlp_ws, *gmlp_bs, *qn_g, *kn_g, *sinks;
  const float *conv_w, *conv_b, *f_bias, *hnorm_g, *w_a, *w_b, *w_c, *w_out;
  float* out;
  unsigned char* ws;
};

__device__ __forceinline__ bf16 f2bf(float f) {
  unsigned u = __float_as_uint(f);
  u += 0x7fffu + ((u >> 16) & 1u);
  return (bf16)(u >> 16);
}
__device__ __forceinline__ float bf2f(bf16 h) { return __uint_as_float(((unsigned)h) << 16); }
__device__ __forceinline__ unsigned pack2(float a, float b) { return (unsigned)f2bf(a) | ((unsigned)f2bf(b) << 16); }
__device__ __forceinline__ float lo2f(unsigned u) { return __uint_as_float(u << 16); }
__device__ __forceinline__ float hi2f(unsigned u) { return __uint_as_float(u & 0xffff0000u); }
__device__ __forceinline__ void unpack8(const uint4& v, float* f) {
  f[0] = lo2f(v.x); f[1] = hi2f(v.x); f[2] = lo2f(v.y); f[3] = hi2f(v.y);
  f[4] = lo2f(v.z); f[5] = hi2f(v.z); f[6] = lo2f(v.w); f[7] = hi2f(v.w);
}
__device__ __forceinline__ void unpack4(const uint2& v, float* f) {
  f[0] = lo2f(v.x); f[1] = hi2f(v.x); f[2] = lo2f(v.y); f[3] = hi2f(v.y);
}
__device__ __forceinline__ float sigmoidf_(float x) { return 1.0f / (1.0f + __expf(-x)); }
__device__ __forceinline__ float siluf_(float x) { return x / (1.0f + __expf(-x)); }
__device__ __forceinline__ float logsigmoidf_(float x) { return fminf(x, 0.0f) - log1pf(__expf(-fabsf(x))); }
__device__ __forceinline__ float wave_sum(float v) {
#pragma unroll
  for (int o = 32; o >= 1; o >>= 1) v += __shfl_xor(v, o);
  return v;
}
__device__ __forceinline__ float wave_max(float v) {
#pragma unroll
  for (int o = 32; o >= 1; o >>= 1) v = fmaxf(v, __shfl_xor(v, o));
  return v;
}
__device__ __forceinline__ f32x4 mfma16(bf16x8 a, bf16x8 b, f32x4 c) {
  return __builtin_amdgcn_mfma_f32_16x16x32_bf16(a, b, c, 0, 0, 0);
}
template <int MI, int NI>
__device__ __forceinline__ void mma_lds(f32x4 (&acc)[MI][NI], const bf16* sA, int lda, const bf16* sB, int ldb, int K, int lane) {
  const int r = lane & 15, q = (lane >> 4) * 8;
  for (int k0 = 0; k0 < K; k0 += 32) {
    bf16x8 a[MI], b[NI];
#pragma unroll
    for (int i = 0; i < MI; ++i) a[i] = *(const bf16x8*)(sA + (i * 16 + r) * lda + k0 + q);
#pragma unroll
    for (int j = 0; j < NI; ++j) b[j] = *(const bf16x8*)(sB + (j * 16 + r) * ldb + k0 + q);
#pragma unroll
    for (int i = 0; i < MI; ++i)
#pragma unroll
      for (int j = 0; j < NI; ++j) acc[i][j] = mfma16(b[j], a[i], acc[i][j]);
  }
}

constexpr int GLD = 72;
constexpr int GTILE = 128 * GLD;
template <int NI>
__device__ __forceinline__ void gemm_accum(f32x4 (&acc)[4][NI], const bf16* __restrict__ A, int lda,
                                           const bf16* __restrict__ B, int ldb, int K, bf16* sm) {
  const int tid = threadIdx.x, lane = tid & 63, wave = tid >> 6, wr = wave >> 1, wc = wave & 1;
  u32x4 ra[4], rb[NI];
  const int nk = K >> 6;
#pragma unroll
  for (int i = 0; i < 4; ++i) {
    const int id = tid + 256 * i, r = id >> 3, ch = id & 7;
    ra[i] = *(const u32x4*)(A + (size_t)r * lda + ch * 8);
  }
#pragma unroll
  for (int i = 0; i < NI; ++i) {
    const int id = tid + 256 * i, r = id >> 3, ch = id & 7;
    rb[i] = *(const u32x4*)(B + (size_t)r * ldb + ch * 8);
  }
#pragma unroll
  for (int i = 0; i < 4; ++i) {
    const int id = tid + 256 * i, r = id >> 3, ch = id & 7;
    *(u32x4*)(sm + r * GLD + ch * 8) = ra[i];
  }
#pragma unroll
  for (int i = 0; i < NI; ++i) {
    const int id = tid + 256 * i, r = id >> 3, ch = id & 7;
    *(u32x4*)(sm + GTILE + r * GLD + ch * 8) = rb[i];
  }
  __syncthreads();
#pragma unroll 1
  for (int kt = 0; kt < nk; ++kt) {
    const bf16* cur = sm + (kt & 1) * 2 * GTILE;
    if (kt + 1 < nk) {
      const int ko = (kt + 1) * 64;
#pragma unroll
      for (int i = 0; i < 4; ++i) {
        const int id = tid + 256 * i, r = id >> 3, ch = id & 7;
        ra[i] = *(const u32x4*)(A + (size_t)r * lda + ko + ch * 8);
      }
#pragma unroll
      for (int i = 0; i < NI; ++i) {
        const int id = tid + 256 * i, r = id >> 3, ch = id & 7;
        rb[i] = *(const u32x4*)(B + (size_t)r * ldb + ko + ch * 8);
      }
    }
#pragma unroll
    for (int ks = 0; ks < 2; ++ks) {
      bf16x8 a[4], b[NI];
#pragma unroll
      for (int i = 0; i < 4; ++i) a[i] = *(const bf16x8*)(cur + (wr * 64 + i * 16 + (lane & 15)) * GLD + ks * 32 + (lane >> 4) * 8);
#pragma unroll
      for (int j = 0; j < NI; ++j) b[j] = *(const bf16x8*)(cur + GTILE + (wc * 16 * NI + j * 16 + (lane & 15)) * GLD + ks * 32 + (lane >> 4) * 8);
#pragma unroll
      for (int i = 0; i < 4; ++i)
#pragma unroll
        for (int j = 0; j < NI; ++j) acc[i][j] = mfma16(b[j], a[i], acc[i][j]);
    }
    if (kt + 1 < nk) {
      bf16* nxt = sm + ((kt + 1) & 1) * 2 * GTILE;
#pragma unroll
      for (int i = 0; i < 4; ++i) {
        const int id = tid + 256 * i, r = id >> 3, ch = id & 7;
        *(u32x4*)(nxt + r * GLD + ch * 8) = ra[i];
      }
#pragma unroll
      for (int i = 0; i < NI; ++i) {
        const int id = tid + 256 * i, r = id >> 3, ch = id & 7;
        *(u32x4*)(nxt + GTILE + r * GLD + ch * 8) = rb[i];
      }
    }
    __syncthreads();
  }
}
template <int NI>
__device__ __forceinline__ void zero_acc(f32x4 (&acc)[4][NI]) {
#pragma unroll
  for (int i = 0; i < 4; ++i)
#pragma unroll
    for (int j = 0; j < NI; ++j) acc[i][j] = (f32x4){0.f, 0.f, 0.f, 0.f};
}
__device__ __forceinline__ void tile_map(int t, int ntn, int& pm, int& pn) {
  const int grp = t / (8 * ntn), w = t % (8 * ntn);
  pm = grp * 8 + (w & 7);
  pn = w >> 3;
}

__device__ __forceinline__ void transpose_tile(const float* __restrict__ src, int ld_src, int n_valid, bf16* __restrict__ dst, int ld_dst,
                               int k0, int n0, int kdst0, float* sm) {
  const int tid = threadIdx.x;
  for (int i = tid; i < 64 * 16; i += 256) {
    const int kk = i >> 4, n4 = (i & 15) * 4, n = n0 + n4;
    float4 v = make_float4(0.f, 0.f, 0.f, 0.f);
    if (n + 3 < n_valid) v = *(const float4*)(src + (size_t)(k0 + kk) * ld_src + n);
    sm[kk * 65 + n4 + 0] = v.x; sm[kk * 65 + n4 + 1] = v.y; sm[kk * 65 + n4 + 2] = v.z; sm[kk * 65 + n4 + 3] = v.w;
  }
  __syncthreads();
  for (int i = tid; i < 64 * 8; i += 256) {
    const int nn = i >> 3, kc = (i & 7) * 8;
    uint4 o;
    o.x = pack2(sm[(kc + 0) * 65 + nn], sm[(kc + 1) * 65 + nn]);
    o.y = pack2(sm[(kc + 2) * 65 + nn], sm[(kc + 3) * 65 + nn]);
    o.z = pack2(sm[(kc + 4) * 65 + nn], sm[(kc + 5) * 65 + nn]);
    o.w = pack2(sm[(kc + 6) * 65 + nn], sm[(kc + 7) * 65 + nn]);
    *(uint4*)(dst + (size_t)(n0 + nn) * ld_dst + kdst0 + kc) = o;
  }
  __syncthreads();
}

__device__ __forceinline__ void ada_item(const Params& p, int item, float* sm) {
  const int l = item / 96, n0 = (item % 96) * 32;
  const int tid = threadIdx.x, col = tid & 31, rg = tid >> 5;
  float acc[17];
#pragma unroll
  for (int j = 0; j < 17; ++j) acc[j] = 0.f;
  const float* W = p.ada_w + (size_t)l * 1024 * 3072;
  for (int k0 = 0; k0 < 1024; k0 += 64) {
    for (int i = tid; i < 136 * 64; i += 256) {
      const int r = i >> 6, kk = i & 63;
      float v = 0.f;
      if (r < NMOD) {
        const float c = (r < 4) ? p.c_prompt[r * 1024 + k0 + kk] : p.c_sample[(r - 4) * 1024 + k0 + kk];
        v = siluf_(c);
      }
      sm[r * 65 + kk] = v;
    }
    __syncthreads();
#pragma unroll 4
    for (int kk = 0; kk < 64; ++kk) {
      const float w = W[(size_t)(k0 + kk) * 3072 + n0 + col];
#pragma unroll
      for (int j = 0; j < 17; ++j) acc[j] += sm[(rg * 17 + j) * 65 + kk] * w;
    }
    __syncthreads();
  }
  float* mod = (float*)(p.ws + WS_MOD);
  const float b = p.ada_b[l * 3072 + n0 + col];
#pragma unroll
  for (int j = 0; j < 17; ++j) {
    const int r = rg * 17 + j;
    if (r < NMOD) mod[((size_t)l * NMOD + r) * 3072 + n0 + col] = acc[j] + b;
  }
}

__device__ __forceinline__ void phase_prep(const Params& p, unsigned char* smem) {
  float* sm = (float*)smem;
  constexpr int N_WIN = 2 * 16 * (NWIN / 64);
  constexpr int N_WBR = 2 * 3 * 8 * 16;
  constexpr int N_WOUT = 2 * 16 * 16;
  constexpr int N_ADA = 192;
  constexpr int N_ALL = N_ADA + N_WIN + N_WBR + N_WOUT;
  bf16* WinT = (bf16*)(p.ws + WS_WIN);
  bf16* WbrT = (bf16*)(p.ws + WS_WBR);
  bf16* WoutT = (bf16*)(p.ws + WS_WOUT);
  for (int it = blockIdx.x; it < N_ALL; it += gridDim.x) {
    int i = it;
    if (i < N_ADA) { ada_item(p, i, sm); continue; }
    i -= N_ADA;
    if (i < N_WIN) {
      const int l = i / (16 * 134), r = i % (16 * 134), kt = r / 134, nt = r % 134;
      transpose_tile(p.w_in + (size_t)l * 1024 * ZIN, ZIN, ZIN, WinT + (size_t)l * NWIN * 1024, 1024, kt * 64, nt * 64, kt * 64, sm);
      continue;
    }
    i -= N_WIN;
    if (i < N_WBR) {
      const int l = i / 384, r = i % 384, seg = r / 128, r2 = r % 128, kt = r2 / 16, nt = r2 % 16;
      const float* src = (seg == 0 ? p.w_a : seg == 1 ? p.w_b : p.w_c) + (size_t)l * 512 * 1024;
      transpose_tile(src, 1024, 1024, WbrT + (size_t)l * 1024 * 1536, 1536, kt * 64, nt * 64, seg * 512 + kt * 64, sm);
      continue;
    }
    i -= N_WBR;
    {
      const int l = i / 256, r = i % 256, kt = r / 16, nt = r % 16;
      transpose_tile(p.w_out + (size_t)l * 1024 * 1024, 1024, 1024, WoutT + (size_t)l * 1024 * 1024, 1024, kt * 64, nt * 64, kt * 64, sm);
    }
  }
}

__device__ __forceinline__ const float* xrow_ptr(const Params& p, int l, int row) {
  if (l == 0) return row < TP ? p.x_prompt + (size_t)row * D : p.x_sample + (size_t)(row - TP) * D;
  return p.out + (size_t)row * D;
}
__device__ __forceinline__ int mod_row(int row) { return row < TP ? (row >> 12) : 4 + ((row - TP) >> 3); }

__device__ __forceinline__ void phase_norm(const Params& p, int l) {
  const int lane = threadIdx.x & 63, wave = threadIdx.x >> 6;
  bf16* hbuf = (bf16*)(p.ws + WS_H);
  const float* mod = (const float*)(p.ws + WS_MOD);
  const float* g = p.norm_g + l * D;
  for (int row = blockIdx.x * 4 + wave; row < TT; row += gridDim.x * 4) {
    const float4* x = (const float4*)xrow_ptr(p, l, row);
    float4 v[4];
    float ss = 0.f;
#pragma unroll
    for (int i = 0; i < 4; ++i) {
      v[i] = x[lane + 64 * i];
      ss += v[i].x * v[i].x + v[i].y * v[i].y + v[i].z * v[i].z + v[i].w * v[i].w;
    }
    ss = wave_sum(ss);
    const float rstd = rsqrtf(ss * (1.0f / D) + EPS);
    const float* mp = mod + ((size_t)l * NMOD + mod_row(row)) * 3072;
#pragma unroll
    for (int i = 0; i < 4; ++i) {
      const int c = (lane + 64 * i) * 4;
      const float4 gg = *(const float4*)(g + c), sh = *(const float4*)(mp + c), sc = *(const float4*)(mp + 1024 + c);
      uint2 o;
      o.x = pack2(v[i].x * rstd * gg.x * (1.f + sc.x) + sh.x, v[i].y * rstd * gg.y * (1.f + sc.y) + sh.y);
      o.y = pack2(v[i].z * rstd * gg.z * (1.f + sc.z) + sh.z, v[i].w * rstd * gg.w * (1.f + sc.w) + sh.w);
      *(uint2*)(hbuf + (size_t)row * D + c) = o;
    }
  }
}

__device__ __forceinline__ void phase_gemm_in(const Params& p, int l, int col0, int ntn, int ldz, unsigned char* smem) {
  bf16* sm = (bf16*)smem;
  const bf16* hbuf = (const bf16*)(p.ws + WS_H);
  const bf16* W = (const bf16*)(p.ws + WS_WIN) + (size_t)l * NWIN * 1024;
  bf16* z = (bf16*)(p.ws + WS_Z);
  const float* bias = p.b_in + (size_t)l * ZIN;
  const int lane = threadIdx.x & 63, wave = threadIdx.x >> 6, wr = wave >> 1, wc = wave & 1;
  const int ntiles = (TT / 128) * ntn;
  for (int t = blockIdx.x; t < ntiles; t += gridDim.x) {
    int pm, pn;
    tile_map(t, ntn, pm, pn);
    const int m0 = pm * 128, n0 = pn * 128;
    f32x4 acc[4][4];
    zero_acc<4>(acc);
    gemm_accum<4>(acc, hbuf + (size_t)m0 * 1024, 1024, W + (size_t)(col0 + n0) * 1024, 1024, 1024, sm);
#pragma unroll
    for (int j = 0; j < 4; ++j) {
      const int col = n0 + wc * 64 + j * 16 + (lane >> 4) * 4;
      const float4 b = *(const float4*)(bias + col0 + col);
#pragma unroll
      for (int i = 0; i < 4; ++i) {
        const int row = m0 + wr * 64 + i * 16 + (lane & 15);
        uint2 o;
        o.x = pack2(acc[i][j][0] + b.x, acc[i][j][1] + b.y);
        o.y = pack2(acc[i][j][2] + b.z, acc[i][j][3] + b.w);
        *(uint2*)(z + (size_t)row * ldz + col) = o;
      }
    }
  }
}

__device__ __forceinline__ void gmlp_prompt_item(const Params& p, int l, int item, unsigned char* smem) {
  const int b = item >> 7, n = (item >> 2) & 31, g = item & 3;
  const int r0 = b * SEQ + n * 128;
  const bf16* z = (const bf16*)(p.ws + WS_Z);
  bf16* yab = (bf16*)(p.ws + WS_YAB);
  bf16* sW = (bf16*)smem;
  bf16* sV = (bf16*)(smem + 34816);
  float* srstd = (float*)(smem + 69632);
  const int tid = threadIdx.x, lane = tid & 63, wave = tid >> 6, wr = wave >> 1, wc = wave & 1;
  {
    const int tok = tid >> 1, half = tid & 1;
    const uint4* ptr = (const uint4*)(z + (size_t)(r0 + tok) * ZAB + OFF_AV + half * 256);
    float ss = 0.f;
    for (int i = 0; i < 32; ++i) {
      float f[8];
      unpack8(ptr[i], f);
#pragma unroll
      for (int j = 0; j < 8; ++j) ss += f[j] * f[j];
    }
    ss += __shfl_xor(ss, 1);
    if (half == 0) srstd[tok] = rsqrtf(ss * (1.0f / 512.f) + EPS);
  }
  __syncthreads();
  const float* vg = p.vnorm_g + l * 512 + g * 128;
  for (int i = tid; i < 2048; i += 256) {
    const int s = i >> 4, c8 = (i & 15) * 8;
    float f[8];
    unpack8(*(const uint4*)(z + (size_t)(r0 + s) * ZAB + OFF_AV + g * 128 + c8), f);
    const float rs = srstd[s];
#pragma unroll
    for (int j = 0; j < 8; ++j) sV[(c8 + j) * 136 + s] = f2bf(f[j] * rs * vg[c8 + j]);
  }
  const float* Wg = p.gmlp_ws + ((size_t)(l * 4 + g)) * 128 * 128;
  for (int i = tid; i < 4096; i += 256) {
    const int t = i >> 5, s4 = (i & 31) * 4;
    const float4 w = *(const float4*)(Wg + t * 128 + s4);
    uint2 o;
    o.x = pack2(s4 + 0 <= t ? w.x : 0.f, s4 + 1 <= t ? w.y : 0.f);
    o.y = pack2(s4 + 2 <= t ? w.z : 0.f, s4 + 3 <= t ? w.w : 0.f);
    *(uint2*)(sW + t * 136 + s4) = o;
  }
  __syncthreads();
  f32x4 acc[4][4];
  zero_acc<4>(acc);
  mma_lds<4, 4>(acc, sW + wr * 64 * 136, 136, sV + wc * 64 * 136, 136, wr * 64 + 64, lane);
  const float* bs = p.gmlp_bs + (l * 4 + g) * 128;
#pragma unroll
  for (int i = 0; i < 4; ++i) {
    const int t = wr * 64 + i * 16 + (lane & 15);
    const float bst = bs[t];
    const size_t rowoff = (size_t)(r0 + t) * ZAB;
#pragma unroll
    for (int j = 0; j < 4; ++j) {
      const int c = g * 128 + wc * 64 + j * 16 + (lane >> 4) * 4;
      float u[4], ag[4];
      unpack4(*(const uint2*)(z + rowoff + c), u);
      unpack4(*(const uint2*)(z + rowoff + OFF_AG + c), ag);
      uint2 o;
      o.x = pack2(u[0] * (acc[i][j][0] + bst) * siluf_(ag[0]), u[1] * (acc[i][j][1] + bst) * siluf_(ag[1]));
      o.y = pack2(u[2] * (acc[i][j][2] + bst) * siluf_(ag[2]), u[3] * (acc[i][j][3] + bst) * siluf_(ag[3]));
      *(uint2*)(yab + (size_t)(r0 + t) * 1024 + c) = o;
    }
  }
  __syncthreads();
}

__device__ __forceinline__ void gmlp_sample_item(const Params& p, int l, int b, unsigned char* smem) {
  const int r0 = TP + b * 8;
  const bf16* z = (const bf16*)(p.ws + WS_Z);
  bf16* yab = (bf16*)(p.ws + WS_YAB);
  float* svn = (float*)smem;
  const int tid = threadIdx.x, lane = tid & 63, wave = tid >> 6;
  const float* vg = p.vnorm_g + l * 512;
  for (int tt = 0; tt < 2; ++tt) {
    const int t = wave * 2 + tt;
    float f[8];
    unpack8(*(const uint4*)(z + (size_t)(r0 + t) * ZAB + OFF_AV + lane * 8), f);
    float ss = 0.f;
#pragma unroll
    for (int j = 0; j < 8; ++j) ss += f[j] * f[j];
    ss = wave_sum(ss);
    const float rstd = rsqrtf(ss * (1.0f / 512.f) + EPS);
    float* gv = p.out + O_GV + (((size_t)l * 128 + b) * 8 + t) * 512 + lane * 8;
#pragma unroll
    for (int j = 0; j < 8; ++j) {
      const float vn = f[j] * rstd * vg[lane * 8 + j];
      svn[t * 512 + lane * 8 + j] = vn;
      gv[j] = vn;
    }
  }
  __syncthreads();
  {
    const int c = tid * 2, g = c >> 7;
    const float* Wg = p.gmlp_ws + ((size_t)(l * 4 + g)) * 128 * 128;
    const float* bs = p.gmlp_bs + (l * 4 + g) * 128;
    for (int t = 0; t < 8; ++t) {
      float s0 = bs[t], s1 = bs[t];
      for (int s = 0; s <= t; ++s) {
        const float w = Wg[t * 128 + s];
        s0 += w * svn[s * 512 + c];
        s1 += w * svn[s * 512 + c + 1];
      }
      const unsigned uu = *(const unsigned*)(z + (size_t)(r0 + t) * ZAB + c);
      const unsigned gg = *(const unsigned*)(z + (size_t)(r0 + t) * ZAB + OFF_AG + c);
      *(unsigned*)(yab + (size_t)(r0 + t) * 1024 + c) = pack2(lo2f(uu) * s0 * siluf_(lo2f(gg)), hi2f(uu) * s1 * siluf_(hi2f(gg)));
    }
  }
  __syncthreads();
}

__device__ __forceinline__ void swa_prompt_item(const Params& p, int l, int item, unsigned char* smem) {
  const int b = item >> 7, qt = (item >> 1) & 63, kv = item & 1;
  const int q0 = qt * 64, rb = b * SEQ;
  const bf16* z = (const bf16*)(p.ws + WS_Z);
  bf16* yab = (bf16*)(p.ws + WS_YAB);
  bf16* sK = (bf16*)smem;
  bf16* sVT = (bf16*)(smem + 27648);
  const int tid = threadIdx.x, lane = tid & 63, wave = tid >> 6;
  const float* kg = p.kn_g + l * 64;
  const float* qg = p.qn_g + l * 64;
#pragma unroll 1
  for (int it = 0; it < 6; ++it) {
    const int id = tid + 256 * it, kk = id >> 3, ch = id & 7, kp = q0 - 128 + kk;
    float f[8];
    uint4 vraw = make_uint4(0, 0, 0, 0);
    if (kp >= 0) {
      unpack8(*(const uint4*)(z + (size_t)(rb + kp) * ZAB + OFF_BK + kv * 64 + ch * 8), f);
      vraw = *(const uint4*)(z + (size_t)(rb + kp) * ZAB + OFF_BV + kv * 64 + ch * 8);
    } else {
#pragma unroll
      for (int j = 0; j < 8; ++j) f[j] = 0.f;
    }
    float ss = 0.f;
#pragma unroll
    for (int j = 0; j < 8; ++j) ss += f[j] * f[j];
    ss += __shfl_xor(ss, 1); ss += __shfl_xor(ss, 2); ss += __shfl_xor(ss, 4);
    const float rstd = rsqrtf(ss * (1.0f / 64.f) + EPS);
#pragma unroll
    for (int j = 0; j < 8; ++j) f[j] = f[j] * rstd * kg[ch * 8 + j];
    uint4 ko;
    ko.x = pack2(f[0], f[1]); ko.y = pack2(f[2], f[3]); ko.z = pack2(f[4], f[5]); ko.w = pack2(f[6], f[7]);
    *(uint4*)(sK + kk * 72 + ch * 8) = ko;
    float vf[8];
    unpack8(vraw, vf);
#pragma unroll
    for (int j = 0; j < 8; ++j) sVT[(ch * 8 + j) * 200 + kk] = f2bf(vf[j]);
    if (kk >= 128 && kp >= SEQ - 128) {
      const size_t o = ((((size_t)l * 4 + b) * 128 + (kp - (SEQ - 128))) * 2 + kv) * 64 + ch * 8;
#pragma unroll
      for (int j = 0; j < 8; ++j) { p.out[O_SKP + o + j] = f[j]; p.out[O_SVP + o + j] = vf[j]; }
    }
  }
  __syncthreads();
  const int h = kv * 4 + wave;
  const float sink = p.sinks[l * 8 + h];
  const int g4 = lane >> 4, r16 = lane & 15;
#pragma unroll 1
  for (int i = 0; i < 4; ++i) {
    const int qrow = q0 + i * 16 + r16;
    const size_t grow = (size_t)(rb + qrow);
    bf16x8 qf[2];
    {
      float f0[8], f1[8];
      unpack8(*(const uint4*)(z + grow * ZAB + OFF_BQ + h * 64 + g4 * 8), f0);
      unpack8(*(const uint4*)(z + grow * ZAB + OFF_BQ + h * 64 + 32 + g4 * 8), f1);
      float ss = 0.f;
#pragma unroll
      for (int j = 0; j < 8; ++j) ss += f0[j] * f0[j] + f1[j] * f1[j];
      ss += __shfl_xor(ss, 16); ss += __shfl_xor(ss, 32);
      const float rstd = rsqrtf(ss * (1.0f / 64.f) + EPS) * 0.125f;
#pragma unroll
      for (int j = 0; j < 8; ++j) {
        qf[0][j] = (short)f2bf(f0[j] * rstd * qg[g4 * 8 + j]);
        qf[1][j] = (short)f2bf(f1[j] * rstd * qg[32 + g4 * 8 + j]);
      }
    }
    f32x4 st[12];
#pragma unroll
    for (int kt = 0; kt < 12; ++kt) {
      st[kt] = (f32x4){0.f, 0.f, 0.f, 0.f};
#pragma unroll
      for (int ks = 0; ks < 2; ++ks) {
        const bf16x8 kf = *(const bf16x8*)(sK + (kt * 16 + r16) * 72 + ks * 32 + g4 * 8);
        st[kt] = mfma16(kf, qf[ks], st[kt]);
      }
      if ((kt & 1) == 1) __builtin_amdgcn_sched_barrier(0);
    }
    float mx = -INFINITY;
#pragma unroll
    for (int kt = 0; kt < 12; ++kt)
#pragma unroll
      for (int x = 0; x < 4; ++x) {
        const int kp = q0 - 128 + kt * 16 + g4 * 4 + x, diff = qrow - kp;
        const bool valid = (kp >= 0) && (diff >= 0) && (diff < 128);
        st[kt][x] = valid ? st[kt][x] : -INFINITY;
        mx = fmaxf(mx, st[kt][x]);
      }
    mx = fmaxf(mx, __shfl_xor(mx, 16)); mx = fmaxf(mx, __shfl_xor(mx, 32));
    mx = fmaxf(mx, sink);
    float sum = 0.f;
#pragma unroll
    for (int kt = 0; kt < 12; ++kt)
#pragma unroll
      for (int x = 0; x < 4; ++x) {
        const float pv = __expf(st[kt][x] - mx);
        st[kt][x] = pv;
        sum += pv;
      }
    sum += __shfl_xor(sum, 16); sum += __shfl_xor(sum, 32);
    const float inv = 1.0f / (sum + __expf(sink - mx));
    f32x4 o[4];
#pragma unroll
    for (int dt = 0; dt < 4; ++dt) o[dt] = (f32x4){0.f, 0.f, 0.f, 0.f};
#pragma unroll
    for (int t2 = 0; t2 < 6; ++t2) {
      bf16x8 pf;
#pragma unroll
      for (int x = 0; x < 4; ++x) { pf[x] = (short)f2bf(st[2 * t2][x]); pf[4 + x] = (short)f2bf(st[2 * t2 + 1][x]); }
#pragma unroll
      for (int dt = 0; dt < 4; ++dt) {
        const uint2 v0 = *(const uint2*)(sVT + (dt * 16 + r16) * 200 + t2 * 32 + g4 * 4);
        const uint2 v1 = *(const uint2*)(sVT + (dt * 16 + r16) * 200 + t2 * 32 + 16 + g4 * 4);
        union { uint4 u; bf16x8 v; } cv;
        cv.u = make_uint4(v0.x, v0.y, v1.x, v1.y);
        o[dt] = mfma16(cv.v, pf, o[dt]);
      }
      __builtin_amdgcn_sched_barrier(0);
    }
#pragma unroll
    for (int dt = 0; dt < 4; ++dt) {
      const int d0 = dt * 16 + g4 * 4;
      float bg[4];
      unpack4(*(const uint2*)(z + grow * ZAB + OFF_BG + h * 64 + d0), bg);
      uint2 oo;
      oo.x = pack2(o[dt][0] * inv * siluf_(bg[0]), o[dt][1] * inv * siluf_(bg[1]));
      oo.y = pack2(o[dt][2] * inv * siluf_(bg[2]), o[dt][3] * inv * siluf_(bg[3]));
      *(uint2*)(yab + grow * 1024 + 512 + h * 64 + d0) = oo;
    }
  }
  __syncthreads();
}

__device__ __forceinline__ void swa_sample_item(const Params& p, int l, int item, unsigned char* smem) {
  const int b = item >> 1, kv = item & 1;
  const int r0 = TP + b * 8;
  const bf16* z = (const bf16*)(p.ws + WS_Z);
  bf16* yab = (bf16*)(p.ws + WS_YAB);
  bf16* sK = (bf16*)smem;
  bf16* sV = (bf16*)(smem + 19584);
  float* sq = (float*)(smem + 39168);
  float* sP = (float*)(smem + 47488);
  const int tid = threadIdx.x;
  const float* kg = p.kn_g + l * 64;
  const float* qg = p.qn_g + l * 64;
  const float* ck = p.cache_k + ((size_t)l * 128 + b) * 128 * 128;
  const float* cvp = p.cache_v + ((size_t)l * 128 + b) * 128 * 128;
#pragma unroll 1
  for (int it = 0; it < 5; ++it) {
    const int id = tid + 256 * it, j = id >> 3, ch = id & 7;
    const bool act = id < 1088;
    float kf[8], vf[8];
#pragma unroll
    for (int x = 0; x < 8; ++x) { kf[x] = 0.f; vf[x] = 0.f; }
    if (act) {
      if (j < 128) {
        const float4 a0 = *(const float4*)(ck + (j * 2 + kv) * 64 + ch * 8), a1 = *(const float4*)(ck + (j * 2 + kv) * 64 + ch * 8 + 4);
        const float4 b0 = *(const float4*)(cvp + (j * 2 + kv) * 64 + ch * 8), b1 = *(const float4*)(cvp + (j * 2 + kv) * 64 + ch * 8 + 4);
        kf[0] = a0.x; kf[1] = a0.y; kf[2] = a0.z; kf[3] = a0.w; kf[4] = a1.x; kf[5] = a1.y; kf[6] = a1.z; kf[7] = a1.w;
        vf[0] = b0.x; vf[1] = b0.y; vf[2] = b0.z; vf[3] = b0.w; vf[4] = b1.x; vf[5] = b1.y; vf[6] = b1.z; vf[7] = b1.w;
      } else {
        unpack8(*(const uint4*)(z + (size_t)(r0 + j - 128) * ZAB + OFF_BK + kv * 64 + ch * 8), kf);
        unpack8(*(const uint4*)(z + (size_t)(r0 + j - 128) * ZAB + OFF_BV + kv * 64 + ch * 8), vf);
      }
    }
    float ss = 0.f;
#pragma unroll
    for (int x = 0; x < 8; ++x) ss += kf[x] * kf[x];
    ss += __shfl_xor(ss, 1); ss += __shfl_xor(ss, 2); ss += __shfl_xor(ss, 4);
    if (act) {
      if (j >= 128) {
        const float rstd = rsqrtf(ss * (1.0f / 64.f) + EPS);
#pragma unroll
        for (int x = 0; x < 8; ++x) kf[x] = kf[x] * rstd * kg[ch * 8 + x];
      }
      uint4 ko, vo;
      ko.x = pack2(kf[0], kf[1]); ko.y = pack2(kf[2], kf[3]); ko.z = pack2(kf[4], kf[5]); ko.w = pack2(kf[6], kf[7]);
      vo.x = pack2(vf[0], vf[1]); vo.y = pack2(vf[2], vf[3]); vo.z = pack2(vf[4], vf[5]); vo.w = pack2(vf[6], vf[7]);
      *(uint4*)(sK + j * 72 + ch * 8) = ko;
      *(uint4*)(sV + j * 72 + ch * 8) = vo;
      if (j >= 8) {
        const size_t o = ((((size_t)l * 128 + b) * 128 + (j - 8)) * 2 + kv) * 64 + ch * 8;
        *(float4*)(p.out + O_SKS + o) = make_float4(kf[0], kf[1], kf[2], kf[3]);
        *(float4*)(p.out + O_SKS + o + 4) = make_float4(kf[4], kf[5], kf[6], kf[7]);
        *(float4*)(p.out + O_SVS + o) = make_float4(vf[0], vf[1], vf[2], vf[3]);
        *(float4*)(p.out + O_SVS + o + 4) = make_float4(vf[4], vf[5], vf[6], vf[7]);
      }
    }
  }
  const int qi = tid >> 3, sub = tid & 7, t = qi >> 2, h = kv * 4 + (qi & 3);
  {
    float f[8];
    unpack8(*(const uint4*)(z + (size_t)(r0 + t) * ZAB + OFF_BQ + h * 64 + sub * 8), f);
    float ss = 0.f;
#pragma unroll
    for (int x = 0; x < 8; ++x) ss += f[x] * f[x];
    ss += __shfl_xor(ss, 1); ss += __shfl_xor(ss, 2); ss += __shfl_xor(ss, 4);
    const float rstd = rsqrtf(ss * (1.0f / 64.f) + EPS) * 0.125f;
#pragma unroll
    for (int x = 0; x < 8; ++x) sq[qi * 65 + sub * 8 + x] = f[x] * rstd * qg[sub * 8 + x];
  }
  __syncthreads();
  const float sink = p.sinks[l * 8 + h];
  float mx = -INFINITY;
#pragma unroll 1
  for (int jj = 0; jj < 17; ++jj) {
    const int key = sub + 8 * jj;
    float s = 0.f;
#pragma unroll 8
    for (int d = 0; d < 64; ++d) s += sq[qi * 65 + d] * bf2f(sK[key * 72 + d]);
    const bool valid = (key >= t + 1) && (key <= t + 128);
    s = valid ? s : -INFINITY;
    sP[qi * 140 + key] = s;
    mx = fmaxf(mx, s);
  }
  mx = fmaxf(mx, __shfl_xor(mx, 1)); mx = fmaxf(mx, __shfl_xor(mx, 2)); mx = fmaxf(mx, __shfl_xor(mx, 4));
  mx = fmaxf(mx, sink);
  float sum = 0.f;
  for (int jj = 0; jj < 17; ++jj) {
    const int key = sub + 8 * jj;
    const float pv = __expf(sP[qi * 140 + key] - mx);
    sP[qi * 140 + key] = pv;
    sum += pv;
  }
  sum += __shfl_xor(sum, 1); sum += __shfl_xor(sum, 2); sum += __shfl_xor(sum, 4);
  const float inv = 1.0f / (sum + __expf(sink - mx));
  __syncthreads();
  {
    float o[8];
#pragma unroll
    for (int x = 0; x < 8; ++x) o[x] = 0.f;
#pragma unroll 2
    for (int key = 0; key < 136; ++key) {
      const float pv = sP[qi * 140 + key];
      float vf[8];
      unpack8(*(const uint4*)(sV + key * 72 + sub * 8), vf);
#pragma unroll
      for (int x = 0; x < 8; ++x) o[x] += pv * vf[x];
    }
    float bg[8];
    unpack8(*(const uint4*)(z + (size_t)(r0 + t) * ZAB + OFF_BG + h * 64 + sub * 8), bg);
    uint4 oo;
    oo.x = pack2(o[0] * inv * siluf_(bg[0]), o[1] * inv * siluf_(bg[1]));
    oo.y = pack2(o[2] * inv * siluf_(bg[2]), o[3] * inv * siluf_(bg[3]));
    oo.z = pack2(o[4] * inv * siluf_(bg[4]), o[5] * inv * siluf_(bg[5]));
    oo.w = pack2(o[6] * inv * siluf_(bg[6]), o[7] * inv * siluf_(bg[7]));
    *(uint4*)(yab + (size_t)(r0 + t) * 1024 + 512 + h * 64 + sub * 8) = oo;
  }
  __syncthreads();
}

__device__ __forceinline__ void phase_mix_ab(const Params& p, int l, unsigned char* smem) {
  constexpr int N_SWA = 512, N_GM = 512, N_SWS = 256, N_GMS = 128;
  constexpr int N_ALL = N_SWA + N_GM + N_SWS + N_GMS;
  for (int it = blockIdx.x; it < N_ALL; it += gridDim.x) {
    int i = it;
    if (i < N_SWA) { swa_prompt_item(p, l, i, smem); continue; }
    i -= N_SWA;
    if (i < N_GM) { gmlp_prompt_item(p, l, i, smem); continue; }
    i -= N_GM;
    if (i < N_SWS) { swa_sample_item(p, l, i, smem); continue; }
    i -= N_SWS;
    gmlp_sample_item(p, l, i, smem);
  }
}

__device__ __forceinline__ void conv8_prompt(const Params& p, int l, const bf16* z, int r0, int pos0, int s, int zc, float* y) {
  const float* cw = p.conv_w + (size_t)l * 4 * 1024 + zc;
  const float* cb = p.conv_b + l * 1024 + zc;
#pragma unroll
  for (int j = 0; j < 8; ++j) y[j] = cb[j];
#pragma unroll
  for (int tap = 0; tap < 4; ++tap) {
    const int back = 3 - tap;
    if (pos0 + s - back >= 0) {
      float f[8];
      unpack8(*(const uint4*)(z + (size_t)(r0 + s - back) * ZC + C_QK + zc), f);
#pragma unroll
      for (int j = 0; j < 8; ++j) y[j] += cw[tap * 1024 + j] * f[j];
    }
  }
#pragma unroll
  for (int j = 0; j < 8; ++j) y[j] = siluf_(y[j]);
}

__device__ __forceinline__ void chunk_gates(const Params& p, int l, const bf16* z, int r0, int hh, int lane, float& cum, float& iv) {
  const float f = bf2f(z[(size_t)(r0 + lane) * ZC + C_F + hh]) + p.f_bias[l * 4 + hh];
  iv = bf2f(z[(size_t)(r0 + lane) * ZC + C_I + hh]);
  float c = logsigmoidf_(f);
#pragma unroll
  for (int o = 1; o < 64; o <<= 1) {
    const float n = __shfl_up(c, o);
    if (lane >= o) c += n;
  }
  cum = c;
}

__device__ __forceinline__ void mlstm_local_item(const Params& p, int l, int item, unsigned char* smem) {
  const int bh = item >> 6, c = item & 63, b = bh >> 2, hh = bh & 3;
  const int r0 = b * SEQ + c * 64;
  const bf16* z = (const bf16*)(p.ws + WS_Z);
  bf16* skT = (bf16*)smem;
  bf16* svT = (bf16*)(smem + 18432);
  float* swsel = (float*)(smem + 36864);
  const int tid = threadIdx.x, lane = tid & 63, wave = tid >> 6, wr = wave >> 1, wc = wave & 1;
  if (wave == 0) {
    float cum, iv;
    chunk_gates(p, l, z, r0, hh, lane, cum, iv);
    const float total = __shfl(cum, 63);
    const float g = total - cum + iv;
    const float G = wave_max(g);
    swsel[lane] = __expf(g - G);
    if (lane == 0) {
      ((float*)(p.ws + WS_G))[item] = G;
      ((float*)(p.ws + WS_TOT))[item] = total;
    }
  }
  __syncthreads();
  for (int i = tid; i < 1024; i += 256) {
    const int s = i >> 4, d8 = (i & 15) * 8;
    float y[8];
    conv8_prompt(p, l, z, r0, c * 64, s, 512 + hh * 128 + d8, y);
    const float sc = 0.08838834764831845f * swsel[s];
#pragma unroll
    for (int j = 0; j < 8; ++j) skT[(d8 + j) * 72 + s] = f2bf(y[j] * sc);
    float v[8];
    unpack8(*(const uint4*)(z + (size_t)(r0 + s) * ZC + C_V + hh * 128 + d8), v);
#pragma unroll
    for (int j = 0; j < 8; ++j) svT[(d8 + j) * 72 + s] = f2bf(v[j]);
  }
  __syncthreads();
  f32x4 acc[4][4];
  zero_acc<4>(acc);
  mma_lds<4, 4>(acc, svT + wr * 64 * 72, 72, skT + wc * 64 * 72, 72, 64, lane);
  bf16* U = (bf16*)(p.ws + WS_U) + (size_t)item * 16384;
#pragma unroll
  for (int i = 0; i < 4; ++i)
#pragma unroll
    for (int j = 0; j < 4; ++j) {
      const int e = wr * 64 + i * 16 + (lane & 15), d = wc * 64 + j * 16 + (lane >> 4) * 4;
      uint2 o;
      o.x = pack2(acc[i][j][0], acc[i][j][1]);
      o.y = pack2(acc[i][j][2], acc[i][j][3]);
      *(uint2*)(U + e * 128 + d) = o;
    }
  if (tid < 128) {
    float s = 0.f;
    for (int k = 0; k < 64; ++k) s += bf2f(skT[tid * 72 + k]);
    ((float*)(p.ws + WS_UN))[(size_t)item * 128 + tid] = s;
  }
  __syncthreads();
}

__device__ __forceinline__ void mlstm_convout_item(const Params& p, int l, int b) {
  const bf16* z = (const bf16*)(p.ws + WS_Z);
  for (int i = threadIdx.x; i < 3 * 1024; i += 256) {
    const int j = i >> 10, ch = i & 1023;
    p.out[O_CVP + (((size_t)l * 4 + b) * 3 + j) * 1024 + ch] = bf2f(z[(size_t)(b * SEQ + SEQ - 3 + j) * ZC + C_QK + ch]);
  }
}

__device__ __forceinline__ void mlstm_sample_item(const Params& p, int l, int item, unsigned char* smem) {
  const int b = item >> 2, hh = item & 3;
  const int r0 = TP + b * 8;
  bf16* z = (bf16*)(p.ws + WS_Z);
  float* sq = (float*)smem;
  float* sk = sq + 1024;
  float* sv = sk + 1024;
  float* sh = sv + 1024;
  float* sint = sh + 1024;
  float* sa = sint + 2048;
  float* sqn = sa + 64;
  float* smt = sqn + 8;
  float* swi = smt + 8;
  float* swsel = swi + 8;
  float* sdm = swsel + 8;
  float* sdecay = sdm + 64;
  const int tid = threadIdx.x, lane = tid & 63, wave = tid >> 6;
  {
    const int isk = tid >> 7, d = tid & 127, zc = isk * 512 + hh * 128 + d;
    const float* cw = p.conv_w + (size_t)l * 4 * 1024 + zc;
    const float cb = p.conv_b[l * 1024 + zc];
    float xp[11];
    const float* cs = p.st_conv + ((size_t)l * 128 + b) * 3 * 1024 + zc;
    xp[0] = cs[0]; xp[1] = cs[1024]; xp[2] = cs[2048];
#pragma unroll
    for (int t = 0; t < 8; ++t) xp[3 + t] = bf2f(z[(size_t)(r0 + t) * ZC + C_QK + zc]);
    const float w0 = cw[0], w1 = cw[1024], w2 = cw[2048], w3 = cw[3072];
    float* dst = isk ? sk : sq;
    const float sc = isk ? 0.08838834764831845f : 1.0f;
#pragma unroll
    for (int t = 0; t < 8; ++t) {
      const float y = cb + w0 * xp[t] + w1 * xp[t + 1] + w2 * xp[t + 2] + w3 * xp[t + 3];
      dst[t * 128 + d] = siluf_(y) * sc;
    }
    float* co = p.out + O_CVS + ((size_t)l * 128 + b) * 3 * 1024 + zc;
    co[0] = xp[8]; co[1024] = xp[9]; co[2048] = xp[10];
  }
  for (int i = tid; i < 1024; i += 256) {
    const int t = i >> 7, e = i & 127;
    sv[i] = bf2f(z[(size_t)(r0 + t) * ZC + C_V + hh * 128 + e]);
  }
  if (tid == 0) {
    float cum[8], iv[8];
    float c = 0.f;
    for (int t = 0; t < 8; ++t) {
      const float f = bf2f(z[(size_t)(r0 + t) * ZC + C_F + hh]) + p.f_bias[l * 4 + hh];
      c += logsigmoidf_(f);
      cum[t] = c;
      iv[t] = bf2f(z[(size_t)(r0 + t) * ZC + C_I + hh]);
    }
    const float m0 = p.st_m[(l * 128 + b) * 4 + hh];
    for (int t = 0; t < 8; ++t) {
      float dmax = -INFINITY;
      for (int s = 0; s <= t; ++s) dmax = fmaxf(dmax, cum[t] - cum[s] + iv[s]);
      const float mi = cum[t] + m0, mt = fmaxf(mi, dmax);
      smt[t] = mt;
      swi[t] = __expf(mi - mt);
      for (int s = 0; s < 8; ++s) sdm[t * 8 + s] = (s <= t) ? __expf(cum[t] - cum[s] + iv[s] - mt) : 0.f;
    }
    const float total = cum[7];
    float gm = -INFINITY;
    for (int s = 0; s < 8; ++s) gm = fmaxf(gm, total - cum[s] + iv[s]);
    const float mn = fmaxf(total + m0, gm);
    for (int s = 0; s < 8; ++s) swsel[s] = __expf(total - cum[s] + iv[s] - mn);
    sdecay[0] = __expf(total + m0 - mn);
    p.out[O_MS + (l * 128 + b) * 4 + hh] = mn;
  }
  __syncthreads();
  const float* n0 = p.st_n + (((size_t)l * 128 + b) * 4 + hh) * 128;
  if (tid < 64) {
    const int t = tid >> 3, s = tid & 7;
    float dsum = 0.f;
    for (int d = 0; d < 128; ++d) dsum += sq[t * 128 + d] * sk[s * 128 + d];
    sa[t * 8 + s] = sdm[t * 8 + s] * dsum;
  } else if (tid < 128) {
    const int t = (tid - 64) >> 3, part = (tid - 64) & 7;
    float dsum = 0.f;
    for (int d = part * 16; d < part * 16 + 16; ++d) dsum += sq[t * 128 + d] * n0[d];
    dsum += __shfl_xor(dsum, 1); dsum += __shfl_xor(dsum, 2); dsum += __shfl_xor(dsum, 4);
    if (part == 0) sqn[t] = dsum;
  }
  __syncthreads();
  {
    const int e = tid & 127, dh = tid >> 7;
    const float decay = sdecay[0];
    const float* C0 = p.st_C + (((size_t)l * 128 + b) * 4 + hh) * 16384;
    float* C1 = p.out + O_CS + (((size_t)l * 128 + b) * 4 + hh) * 16384;
    float vw[8], inter[8];
#pragma unroll
    for (int s = 0; s < 8; ++s) { vw[s] = sv[s * 128 + e] * swsel[s]; inter[s] = 0.f; }
    for (int d = dh * 64; d < dh * 64 + 64; ++d) {
      const float c0 = C0[d * 128 + e];
      float upd = decay * c0;
#pragma unroll
      for (int s = 0; s < 8; ++s) {
        upd += sk[s * 128 + d] * vw[s];
        inter[s] += sq[s * 128 + d] * c0;
      }
      C1[d * 128 + e] = upd;
    }
#pragma unroll
    for (int t = 0; t < 8; ++t) sint[(dh * 8 + t) * 128 + e] = inter[t];
  }
  __syncthreads();
  if (tid < 128) {
    const int e = tid;
    for (int t = 0; t < 8; ++t) {
      float num = swi[t] * (sint[t * 128 + e] + sint[(8 + t) * 128 + e]);
      float den = swi[t] * sqn[t];
      for (int s = 0; s <= t; ++s) { num += sa[t * 8 + s] * sv[s * 128 + e]; den += sa[t * 8 + s]; }
      sh[t * 128 + e] = num / fmaxf(fabsf(den), __expf(-smt[t]));
    }
    float nn = sdecay[0] * n0[e];
    for (int s = 0; s < 8; ++s) nn += swsel[s] * sk[s * 128 + e];
    p.out[O_NS + (((size_t)l * 128 + b) * 4 + hh) * 128 + e] = nn;
  }
  __syncthreads();
  const float* hg = p.hnorm_g + l * 512 + hh * 128;
  for (int tt = 0; tt < 2; ++tt) {
    const int t = wave * 2 + tt;
    const float h0 = sh[t * 128 + lane], h1 = sh[t * 128 + 64 + lane];
    const float ss = wave_sum(h0 * h0 + h1 * h1);
    const float rstd = rsqrtf(ss * (1.0f / 128.f) + EPS);
    bf16* zr = z + (size_t)(r0 + t) * ZC;
#pragma unroll
    for (int k = 0; k < 2; ++k) {
      const int e = lane + 64 * k;
      const float hv = k ? h1 : h0;
      const float o = bf2f(zr[C_O + hh * 128 + e]), cg_ = bf2f(zr[C_G + hh * 128 + e]);
      zr[C_O + hh * 128 + e] = f2bf(hv * rstd * hg[e] * sigmoidf_(o) * siluf_(cg_));
    }
  }
  __syncthreads();
}

__device__ __forceinline__ void phase_mix1(const Params& p, int l, unsigned char* smem) {
  constexpr int N_LOC = 1024, N_SMP = 512, N_CV = 4;
  constexpr int N_ALL = N_LOC + N_SMP + N_CV;
  for (int it = blockIdx.x; it < N_ALL; it += gridDim.x) {
    int i = it;
    if (i < N_LOC) { mlstm_local_item(p, l, i, smem); continue; }
    i -= N_LOC;
    if (i < N_SMP) { mlstm_sample_item(p, l, i, smem); continue; }
    i -= N_SMP;
    mlstm_convout_item(p, l, i);
  }
}

__device__ __forceinline__ void phase_scan(const Params& p, int l, unsigned char* smem) {
  float* sdec = (float*)smem;
  float* ssc = sdec + 64;
  const int tid = threadIdx.x;
  float* Gb = (float*)(p.ws + WS_G);
  float* Tb = (float*)(p.ws + WS_TOT);
  float* Mb = (float*)(p.ws + WS_M);
  for (int it = blockIdx.x; it < 256; it += gridDim.x) {
    const int bh = it >> 4, slice = it & 15;
    if (tid == 0) {
      float m = 0.f;
      for (int c = 0; c < 64; ++c) {
        const float G = Gb[bh * 64 + c], tot = Tb[bh * 64 + c];
        const float mn = fmaxf(tot + m, G);
        sdec[c] = __expf(tot + m - mn);
        ssc[c] = __expf(G - mn);
        if (slice == 0) Mb[bh * 64 + c] = m;
        m = mn;
      }
      if (slice == 0) p.out[O_MP + l * 16 + bh] = m;
    }
    __syncthreads();
    {
      const int idx = slice * 1024 + tid * 4;
      bf16* U = (bf16*)(p.ws + WS_U) + (size_t)bh * 64 * 16384 + idx;
      float st[4] = {0.f, 0.f, 0.f, 0.f};
#pragma unroll 8
      for (int c = 0; c < 64; ++c) {
        float u[4];
        unpack4(*(const uint2*)(U + (size_t)c * 16384), u);
        uint2 o;
        o.x = pack2(st[0], st[1]); o.y = pack2(st[2], st[3]);
        *(uint2*)(U + (size_t)c * 16384) = o;
        const float dc = sdec[c], sc = ssc[c];
#pragma unroll
        for (int x = 0; x < 4; ++x) st[x] = dc * st[x] + sc * u[x];
      }
      const int e = idx >> 7, d0 = idx & 127;
      float* Co = p.out + O_CP + ((size_t)l * 16 + bh) * 16384;
#pragma unroll
      for (int x = 0; x < 4; ++x) Co[(d0 + x) * 128 + e] = st[x];
    }
    if (slice == 0 && tid < 128) {
      float* un = (float*)(p.ws + WS_UN) + (size_t)bh * 64 * 128 + tid;
      float n = 0.f;
#pragma unroll 8
      for (int c = 0; c < 64; ++c) {
        const float u = un[c * 128];
        un[c * 128] = n;
        n = sdec[c] * n + ssc[c] * u;
      }
      p.out[O_NP + ((size_t)l * 16 + bh) * 128 + tid] = n;
    }
    __syncthreads();
  }
}

__device__ __forceinline__ void mlstm_out_item(const Params& p, int l, int item, unsigned char* smem) {
  const int bh = item >> 6, c = item & 63, b = bh >> 2, hh = bh & 3;
  const int r0 = b * SEQ + c * 64;
  bf16* z = (bf16*)(p.ws + WS_Z);
  bf16* sq = (bf16*)smem;
  bf16* sk = (bf16*)(smem + 17408);
  bf16* svT = (bf16*)(smem + 34816);
  bf16* sa = (bf16*)(smem + 53248);
  float* scum = (float*)(smem + 62464);
  float* siv = scum + 64;
  float* smt = siv + 64;
  float* swi = smt + 64;
  float* sden = swi + 64;
  float* sqn = sden + 64;
  float* spart = sqn + 64;
  const int tid = threadIdx.x, lane = tid & 63, wave = tid >> 6;
  const int r16 = lane & 15, g4 = lane >> 4;
  if (wave == 0) {
    float cum, iv;
    chunk_gates(p, l, z, r0, hh, lane, cum, iv);
    scum[lane] = cum;
    siv[lane] = iv;
  }
  for (int i = tid; i < 2048; i += 256) {
    const int isk = i >> 10, r = i & 1023, s = r >> 4, d8 = (r & 15) * 8;
    float y[8];
    conv8_prompt(p, l, z, r0, c * 64, s, isk * 512 + hh * 128 + d8, y);
    const float sc = isk ? 0.08838834764831845f : 1.0f;
    uint4 o;
    o.x = pack2(y[0] * sc, y[1] * sc); o.y = pack2(y[2] * sc, y[3] * sc);
    o.z = pack2(y[4] * sc, y[5] * sc); o.w = pack2(y[6] * sc, y[7] * sc);
    *(uint4*)((isk ? sk : sq) + s * 136 + d8) = o;
  }
  for (int i = tid; i < 1024; i += 256) {
    const int s = i >> 4, d8 = (i & 15) * 8;
    float v[8];
    unpack8(*(const uint4*)(z + (size_t)(r0 + s) * ZC + C_V + hh * 128 + d8), v);
#pragma unroll
    for (int j = 0; j < 8; ++j) svT[(d8 + j) * 72 + s] = f2bf(v[j]);
  }
  __syncthreads();
  const float m_prev = ((const float*)(p.ws + WS_M))[item];
  {
    const int t = wave * 16 + r16;
    bf16x8 qf[4];
#pragma unroll
    for (int ks = 0; ks < 4; ++ks) qf[ks] = *(const bf16x8*)(sq + t * 136 + ks * 32 + g4 * 8);
    f32x4 st[4];
#pragma unroll
    for (int kt = 0; kt < 4; ++kt) {
      st[kt] = (f32x4){0.f, 0.f, 0.f, 0.f};
#pragma unroll
      for (int ks = 0; ks < 4; ++ks) {
        const bf16x8 kf = *(const bf16x8*)(sk + (kt * 16 + r16) * 136 + ks * 32 + g4 * 8);
        st[kt] = mfma16(kf, qf[ks], st[kt]);
      }
    }
    const float cumt = scum[t];
    float dm[4][4];
    float rmax = -INFINITY;
#pragma unroll
    for (int kt = 0; kt < 4; ++kt)
#pragma unroll
      for (int x = 0; x < 4; ++x) {
        const int s = kt * 16 + g4 * 4 + x;
        dm[kt][x] = (s <= t) ? (cumt - scum[s] + siv[s]) : -INFINITY;
        rmax = fmaxf(rmax, dm[kt][x]);
      }
    rmax = fmaxf(rmax, __shfl_xor(rmax, 16)); rmax = fmaxf(rmax, __shfl_xor(rmax, 32));
    const float mi = cumt + m_prev, mt = fmaxf(mi, rmax);
    float rsum = 0.f;
#pragma unroll
    for (int kt = 0; kt < 4; ++kt) {
      float a[4];
#pragma unroll
      for (int x = 0; x < 4; ++x) {
        const int s = kt * 16 + g4 * 4 + x;
        a[x] = (s <= t) ? __expf(dm[kt][x] - mt) * st[kt][x] : 0.f;
        rsum += a[x];
      }
      uint2 o;
      o.x = pack2(a[0], a[1]); o.y = pack2(a[2], a[3]);
      *(uint2*)(sa + t * 72 + kt * 16 + g4 * 4) = o;
    }
    rsum += __shfl_xor(rsum, 16); rsum += __shfl_xor(rsum, 32);
    if (g4 == 0) { smt[t] = mt; swi[t] = __expf(mi - mt); sden[t] = rsum; }
  }
  {
    const int t = tid >> 2, part = tid & 3;
    const float* nc = (const float*)(p.ws + WS_UN) + (size_t)item * 128;
    float s = 0.f;
    for (int d = part * 32; d < part * 32 + 32; ++d) s += bf2f(sq[t * 136 + d]) * nc[d];
    s += __shfl_xor(s, 1); s += __shfl_xor(s, 2);
    if (part == 0) sqn[t] = s;
  }
  __syncthreads();
  f32x4 acc[4][2];
#pragma unroll
  for (int ti = 0; ti < 4; ++ti)
#pragma unroll
    for (int et = 0; et < 2; ++et) acc[ti][et] = (f32x4){0.f, 0.f, 0.f, 0.f};
  const bf16* Cc = (const bf16*)(p.ws + WS_U) + (size_t)item * 16384;
#pragma unroll
  for (int ks = 0; ks < 4; ++ks) {
    bf16x8 cf[2], qf[4];
#pragma unroll
    for (int et = 0; et < 2; ++et) cf[et] = *(const bf16x8*)(Cc + (wave * 32 + et * 16 + r16) * 128 + ks * 32 + g4 * 8);
#pragma unroll
    for (int ti = 0; ti < 4; ++ti) qf[ti] = *(const bf16x8*)(sq + (ti * 16 + r16) * 136 + ks * 32 + g4 * 8);
#pragma unroll
    for (int ti = 0; ti < 4; ++ti)
#pragma unroll
      for (int et = 0; et < 2; ++et) acc[ti][et] = mfma16(cf[et], qf[ti], acc[ti][et]);
  }
#pragma unroll
  for (int ti = 0; ti < 4; ++ti) {
    const float w = swi[ti * 16 + r16];
#pragma unroll
    for (int et = 0; et < 2; ++et) acc[ti][et] *= w;
  }
#pragma unroll
  for (int ks = 0; ks < 2; ++ks) {
    bf16x8 vf[2], af[4];
#pragma unroll
    for (int et = 0; et < 2; ++et) vf[et] = *(const bf16x8*)(svT + (wave * 32 + et * 16 + r16) * 72 + ks * 32 + g4 * 8);
#pragma unroll
    for (int ti = 0; ti < 4; ++ti) af[ti] = *(const bf16x8*)(sa + (ti * 16 + r16) * 72 + ks * 32 + g4 * 8);
#pragma unroll
    for (int ti = 0; ti < 4; ++ti)
#pragma unroll
      for (int et = 0; et < 2; ++et) acc[ti][et] = mfma16(vf[et], af[ti], acc[ti][et]);
  }
#pragma unroll
  for (int ti = 0; ti < 4; ++ti) {
    const int t = ti * 16 + r16;
    const float den = sden[t] + swi[t] * sqn[t];
    const float inv = 1.0f / fmaxf(fabsf(den), __expf(-smt[t]));
    float ss = 0.f;
#pragma unroll
    for (int et = 0; et < 2; ++et) {
      acc[ti][et] *= inv;
#pragma unroll
      for (int x = 0; x < 4; ++x) ss += acc[ti][et][x] * acc[ti][et][x];
    }
    ss += __shfl_xor(ss, 16); ss += __shfl_xor(ss, 32);
    if (g4 == 0) spart[t * 4 + wave] = ss;
  }
  __syncthreads();
  const float* hg = p.hnorm_g + l * 512 + hh * 128;
#pragma unroll
  for (int ti = 0; ti < 4; ++ti) {
    const int t = ti * 16 + r16;
    const float rstd = rsqrtf((spart[t * 4] + spart[t * 4 + 1] + spart[t * 4 + 2] + spart[t * 4 + 3]) * (1.0f / 128.f) + EPS);
    bf16* zr = z + (size_t)(r0 + t) * ZC;
#pragma unroll
    for (int et = 0; et < 2; ++et) {
      const int e = wave * 32 + et * 16 + g4 * 4;
      float o[4], cg_[4];
      unpack4(*(const uint2*)(zr + C_O + hh * 128 + e), o);
      unpack4(*(const uint2*)(zr + C_G + hh * 128 + e), cg_);
      float y[4];
#pragma unroll
      for (int x = 0; x < 4; ++x) y[x] = acc[ti][et][x] * rstd * hg[e + x] * sigmoidf_(o[x]) * siluf_(cg_[x]);
      uint2 oo;
      oo.x = pack2(y[0], y[1]); oo.y = pack2(y[2], y[3]);
      *(uint2*)(zr + C_O + hh * 128 + e) = oo;
    }
  }
  __syncthreads();
}

__device__ __forceinline__ void phase_mix2(const Params& p, int l, unsigned char* smem) {
  for (int it = blockIdx.x; it < 1024; it += gridDim.x) mlstm_out_item(p, l, it, smem);
}

__device__ __forceinline__ void phase_gemm_br(const Params& p, int l, unsigned char* smem) {
  bf16* sm = (bf16*)smem;
  const bf16* hbuf = (const bf16*)(p.ws + WS_H);
  const bf16* Win = (const bf16*)(p.ws + WS_WIN) + (size_t)l * NWIN * 1024;
  const bf16* Wbr = (const bf16*)(p.ws + WS_WBR) + (size_t)l * 1024 * 1536;
  const bf16* yab = (const bf16*)(p.ws + WS_YAB);
  const bf16* z = (const bf16*)(p.ws + WS_Z);
  bf16* merged = (bf16*)(p.ws + WS_U);
  const float* bias = p.b_in + (size_t)l * ZIN + OFF_MG;
  const int lane = threadIdx.x & 63, wave = threadIdx.x >> 6, wr = wave >> 1, wc = wave & 1;
  const int ntiles = (TT / 128) * 16;
  for (int t = blockIdx.x; t < ntiles; t += gridDim.x) {
    int pm, pn;
    tile_map(t, 16, pm, pn);
    const int m0 = pm * 128, n0 = pn * 64;
    f32x4 tot[4][2];
    zero_acc<2>(tot);
#pragma unroll 1
    for (int seg = 0; seg < 3; ++seg) {
      f32x4 acc[4][2];
      zero_acc<2>(acc);
      gemm_accum<2>(acc, hbuf + (size_t)m0 * 1024, 1024, Win + (size_t)(OFF_MG + seg * 1024 + n0) * 1024, 1024, 1024, sm);
      f32x4 gt[4][2];
#pragma unroll
      for (int j = 0; j < 2; ++j) {
        const int col = n0 + wc * 32 + j * 16 + (lane >> 4) * 4;
        const float4 bb = *(const float4*)(bias + seg * 1024 + col);
#pragma unroll
        for (int i = 0; i < 4; ++i) {
          gt[i][j][0] = sigmoidf_(acc[i][j][0] + bb.x); gt[i][j][1] = sigmoidf_(acc[i][j][1] + bb.y);
          gt[i][j][2] = sigmoidf_(acc[i][j][2] + bb.z); gt[i][j][3] = sigmoidf_(acc[i][j][3] + bb.w);
        }
      }
      zero_acc<2>(acc);
      const bf16* A = (seg == 0) ? yab + (size_t)m0 * 1024 : (seg == 1) ? yab + (size_t)m0 * 1024 + 512 : z + (size_t)m0 * ZC + C_O;
      const int lda = (seg == 2) ? ZC : 1024;
      gemm_accum<2>(acc, A, lda, Wbr + (size_t)n0 * 1536 + seg * 512, 1536, 512, sm);
#pragma unroll
      for (int i = 0; i < 4; ++i)
#pragma unroll
        for (int j = 0; j < 2; ++j) tot[i][j] += gt[i][j] * acc[i][j];
    }
#pragma unroll
    for (int i = 0; i < 4; ++i)
#pragma unroll
      for (int j = 0; j < 2; ++j) {
        const int row = m0 + wr * 64 + i * 16 + (lane & 15), col = n0 + wc * 32 + j * 16 + (lane >> 4) * 4;
        uint2 o;
        o.x = pack2(tot[i][j][0], tot[i][j][1]);
        o.y = pack2(tot[i][j][2], tot[i][j][3]);
        *(uint2*)(merged + (size_t)row * 1024 + col) = o;
      }
  }
}

__device__ __forceinline__ void phase_gemm_out(const Params& p, int l, unsigned char* smem) {
  bf16* sm = (bf16*)smem;
  const bf16* merged = (const bf16*)(p.ws + WS_U);
  const bf16* Wout = (const bf16*)(p.ws + WS_WOUT) + (size_t)l * 1024 * 1024;
  const float* mod = (const float*)(p.ws + WS_MOD);
  const int lane = threadIdx.x & 63, wave = threadIdx.x >> 6, wr = wave >> 1, wc = wave & 1;
  const int ntiles = (TT / 128) * 8;
  for (int t = blockIdx.x; t < ntiles; t += gridDim.x) {
    int pm, pn;
    tile_map(t, 8, pm, pn);
    const int m0 = pm * 128, n0 = pn * 128;
    f32x4 acc[4][4];
    zero_acc<4>(acc);
    gemm_accum<4>(acc, merged + (size_t)m0 * 1024, 1024, Wout + (size_t)n0 * 1024, 1024, 1024, sm);
#pragma unroll
    for (int i = 0; i < 4; ++i) {
      const int row = m0 + wr * 64 + i * 16 + (lane & 15);
      const float* xr = xrow_ptr(p, l, row);
      const float* gate = mod + ((size_t)l * NMOD + mod_row(row)) * 3072 + 2048;
#pragma unroll
      for (int j = 0; j < 4; ++j) {
        const int col = n0 + wc * 64 + j * 16 + (lane >> 4) * 4;
        const float4 xv = *(const float4*)(xr + col), gv = *(const float4*)(gate + col);
        float4 o;
        o.x = xv.x + gv.x * acc[i][j][0]; o.y = xv.y + gv.y * acc[i][j][1];
        o.z = xv.z + gv.z * acc[i][j][2]; o.w = xv.w + gv.w * acc[i][j][3];
        *(float4*)(p.out + (size_t)row * D + col) = o;
      }
    }
  }
}

constexpr int N_PHASES = 19;
template <int S>
__device__ __forceinline__ void run_stage(const Params& p, int l, unsigned char* smem) {
  if (S == -1) phase_prep(p, smem);
  if (S == 0) phase_norm(p, l);
  if (S == 1) phase_gemm_in(p, l, 0, ZAB / 128, ZAB, smem);
  if (S == 2) phase_mix_ab(p, l, smem);
  if (S == 3) phase_gemm_in(p, l, ZAB, ZC / 128, ZC, smem);
  if (S == 4) phase_mix1(p, l, smem);
  if (S == 5) phase_scan(p, l, smem);
  if (S == 6) phase_mix2(p, l, smem);
  if (S == 7) phase_gemm_br(p, l, smem);
  if (S == 8) phase_gemm_out(p, l, smem);
}

#define GSYNC() cg::this_grid().sync()
__global__ void __launch_bounds__(256, 2) mega_kernel(Params p_in) {
  __shared__ __attribute__((aligned(16))) unsigned char smem[SMEM_BYTES];
  const Params& p = *(const Params*)__builtin_amdgcn_kernarg_segment_ptr();
  run_stage<-1>(p, 0, smem);
  GSYNC();
#define LAYER(L, LAST)                 \
  run_stage<0>(p, L, smem); GSYNC();   \
  run_stage<1>(p, L, smem); GSYNC();   \
  run_stage<2>(p, L, smem); GSYNC();   \
  run_stage<3>(p, L, smem); GSYNC();   \
  run_stage<4>(p, L, smem); GSYNC();   \
  run_stage<5>(p, L, smem); GSYNC();   \
  run_stage<6>(p, L, smem); GSYNC();   \
  run_stage<7>(p, L, smem); GSYNC();   \
  run_stage<8>(p, L, smem);            \
  if (!LAST) GSYNC();
  LAYER(0, 0)
  LAYER(1, 1)
}

extern "C" void kernel_launch(void* const* d_in, const int* in_sizes, int n_in, void* d_out, int out_size, void* d_ws,
                              size_t ws_size, hipStream_t stream) {
  if (ws_size < WS_END || n_in < 29) { fprintf(stderr, "workspace too small / bad inputs\n"); return; }
  Params p{};
  const float** f = (const float**)&p;
  for (int i = 0; i < 29; ++i) f[i] = (const float*)d_in[i];
  p.out = (float*)d_out;
  p.ws = (unsigned char*)d_ws;
  static int grid_blocks = 0;
  if (!grid_blocks) {
    int dev = 0, cus = 0, per_cu = 0;
    (void)hipGetDevice(&dev);
    (void)hipDeviceGetAttribute(&cus, hipDeviceAttributeMultiprocessorCount, dev);
    (void)hipOccupancyMaxActiveBlocksPerMultiprocessor(&per_cu, mega_kernel, 256, 0);
    if (per_cu < 1) per_cu = 1;
    if (per_cu > 2) per_cu = 2;
    grid_blocks = cus * per_cu;
  }
  void* args[] = {&p};
  hipError_t e = hipLaunchCooperativeKernel((void*)mega_kernel, dim3(grid_blocks), dim3(256), args, 0, stream);
  if (e != hipSuccess) fprintf(stderr, "cooperative launch failed: %s (grid %d)\n", hipGetErrorString(e), grid_blocks);
}
```

```cpp
#include <hip/hip_runtime.h>
#include <hip/hip_cooperative_groups.h>
#include <cstdio>
namespace cg = cooperative_groups;

typedef unsigned short bf16;
typedef short bf16x8 __attribute__((ext_vector_type(8)));
typedef float f32x4 __attribute__((ext_vector_type(4)));
typedef unsigned u32x4 __attribute__((ext_vector_type(4)));

#ifndef SINGLE_LAUNCH
#define SINGLE_LAUNCH 0
#endif

constexpr int D = 1024, TP = 16384, TS = 1024, TT = TP + TS, SEQ = 4096;
constexpr int ZIN = 8456, NWIN = 8576;
constexpr int OFF_AV = 512, OFF_AG = 1024, OFF_BQ = 1536, OFF_BK = 2048, OFF_BV = 2176, OFF_BG = 2304, OFF_MG = 5384;
constexpr int ZAB = 2816;
constexpr int ZC = 2688;
constexpr int C_QK = 0, C_V = 1024, C_I = 1536, C_F = 1540, C_O = 1544, C_G = 2056;
constexpr float EPS = 1e-6f;
constexpr int NMOD = 132;
constexpr int SMEM_BYTES = 73728;

constexpr size_t O_Y = 0;
constexpr size_t O_SKP = (size_t)TT * D;
constexpr size_t O_SVP = O_SKP + 2 * 4 * 128 * 128;
constexpr size_t O_CVP = O_SVP + 2 * 4 * 128 * 128;
constexpr size_t O_CP = O_CVP + 2 * 4 * 3 * 1024;
constexpr size_t O_NP = O_CP + (size_t)2 * 4 * 4 * 128 * 128;
constexpr size_t O_MP = O_NP + 2 * 4 * 4 * 128;
constexpr size_t O_SKS = O_MP + 2 * 4 * 4;
constexpr size_t O_SVS = O_SKS + (size_t)2 * 128 * 128 * 128;
constexpr size_t O_CVS = O_SVS + (size_t)2 * 128 * 128 * 128;
constexpr size_t O_CS = O_CVS + (size_t)2 * 128 * 3 * 1024;
constexpr size_t O_NS = O_CS + (size_t)2 * 128 * 4 * 128 * 128;
constexpr size_t O_MS = O_NS + (size_t)2 * 128 * 4 * 128;
constexpr size_t O_GV = O_MS + 2 * 128 * 4;
constexpr size_t O_END = O_GV + (size_t)2 * 128 * 8 * 512;

constexpr size_t WS_WIN = 0;
constexpr size_t WS_WBR = WS_WIN + (size_t)2 * NWIN * 1024 * 2;
constexpr size_t WS_WOUT = WS_WBR + (size_t)2 * 1024 * 1536 * 2;
constexpr size_t WS_MOD = WS_WOUT + (size_t)2 * 1024 * 1024 * 2;
constexpr size_t WS_H = WS_MOD + (size_t)2 * NMOD * 3072 * 4;
constexpr size_t WS_YAB = WS_H + (size_t)TT * 1024 * 2;
constexpr size_t WS_U = WS_YAB + (size_t)TT * 1024 * 2;
constexpr size_t WS_UN = WS_U + (size_t)TT * 1024 * 2;
constexpr size_t WS_G = WS_UN + (size_t)1024 * 128 * 4;
constexpr size_t WS_TOT = WS_G + 4096;
constexpr size_t WS_M = WS_TOT + 4096;
constexpr size_t WS_Z = WS_M + 4096;
constexpr size_t WS_BAR = WS_Z + (size_t)TT * ZAB * 2;
constexpr size_t WS_END = WS_BAR + 16384;

struct Params {
  const float *x_prompt, *x_sample, *cache_k, *cache_v, *st_conv, *st_C, *st_n, *st_m, *c_prompt, *c_sample;
  const float *ada_w, *ada_b, *norm_g, *w_in, *b_in, *vnorm_g, *gmlp_ws, *gmlp_bs, *qn_g, *kn_g, *sinks;
  const float *conv_w, *conv_b, *f_bias, *hnorm_g, *w_a, *w_b, *w_c, *w_out;
  float* out;
  unsigned char* ws;
};

__device__ __forceinline__ int tidx() { int t = threadIdx.x; asm volatile("" : "+v"(t)); return t; }
__device__ __forceinline__ bf16 f2bf(float f) {
  unsigned u = __float_as_uint(f);
  u += 0x7fffu + ((u >> 16) & 1u);
  return (bf16)(u >> 16);
}
__device__ __forceinline__ float bf2f(bf16 h) { return __uint_as_float(((unsigned)h) << 16); }
__device__ __forceinline__ unsigned pack2(float a, float b) { return (unsigned)f2bf(a) | ((unsigned)f2bf(b) << 16); }
__device__ __forceinline__ float lo2f(unsigned u) { return __uint_as_float(u << 16); }
__device__ __forceinline__ float hi2f(unsigned u) { return __uint_as_float(u & 0xffff0000u); }
__device__ __forceinline__ void unpack8(const uint4& v, float* f) {
  f[0] = lo2f(v.x); f[1] = hi2f(v.x); f[2] = lo2f(v.y); f[3] = hi2f(v.y);
  f[4] = lo2f(v.z); f[5] = hi2f(v.z); f[6] = lo2f(v.w); f[7] = hi2f(v.w);
}
__device__ __forceinline__ void unpack4(const uint2& v, float* f) {
  f[0] = lo2f(v.x); f[1] = hi2f(v.x); f[2] = lo2f(v.y); f[3] = hi2f(v.y);
}
__device__ __forceinline__ float sigmoidf_(float x) { return 1.0f / (1.0f + __expf(-x)); }
__device__ __forceinline__ float siluf_(float x) { return x / (1.0f + __expf(-x)); }
__device__ __forceinline__ float logsigmoidf_(float x) { return fminf(x, 0.0f) - log1pf(__expf(-fabsf(x))); }
__device__ __forceinline__ float wave_sum(float v) {
#pragma unroll
  for (int o = 32; o >= 1; o >>= 1) v += __shfl_xor(v, o);
  return v;
}
__device__ __forceinline__ float wave_max(float v) {
#pragma unroll
  for (int o = 32; o >= 1; o >>= 1) v = fmaxf(v, __shfl_xor(v, o));
  return v;
}
__device__ __forceinline__ f32x4 mfma16(bf16x8 a, bf16x8 b, f32x4 c) {
  return __builtin_amdgcn_mfma_f32_16x16x32_bf16(a, b, c, 0, 0, 0);
}
template <int MI, int NI>
__device__ __forceinline__ void mma_lds(f32x4 (&acc)[MI][NI], const bf16* sA, int lda, const bf16* sB, int ldb, int K, int lane) {
  const int r = lane & 15, q = (lane >> 4) * 8;
  for (int k0 = 0; k0 < K; k0 += 32) {
    bf16x8 a[MI], b[NI];
#pragma unroll
    for (int i = 0; i < MI; ++i) a[i] = *(const bf16x8*)(sA + (i * 16 + r) * lda + k0 + q);
#pragma unroll
    for (int j = 0; j < NI; ++j) b[j] = *(const bf16x8*)(sB + (j * 16 + r) * ldb + k0 + q);
#pragma unroll
    for (int i = 0; i < MI; ++i)
#pragma unroll
      for (int j = 0; j < NI; ++j) acc[i][j] = mfma16(b[j], a[i], acc[i][j]);
  }
}

constexpr int GLD = 72;
constexpr int GTILE = 128 * GLD;
template <int NI>
__device__ __forceinline__ void g_load(u32x4 (&ra)[4], u32x4 (&rb)[NI], const bf16* __restrict__ A, int lda, const bf16* __restrict__ B, int ldb, int ko, int tid) {
  const unsigned offA = (unsigned)((tid >> 3) * lda + (tid & 7) * 8), offB = (unsigned)((tid >> 3) * ldb + (tid & 7) * 8);
#pragma unroll
  for (int i = 0; i < 4; ++i) {
    const bf16* Ai = A + (size_t)(i * 32) * lda + ko;
    ra[i] = *(const u32x4*)(Ai + offA);
  }
#pragma unroll
  for (int i = 0; i < NI; ++i) {
    const bf16* Bi = B + (size_t)(i * 32) * ldb + ko;
    rb[i] = *(const u32x4*)(Bi + offB);
  }
}
template <int NI>
__device__ __forceinline__ void g_store(const u32x4 (&ra)[4], const u32x4 (&rb)[NI], bf16* buf, int tid) {
#pragma unroll
  for (int i = 0; i < 4; ++i) {
    const int id = tid + 256 * i, r = id >> 3, ch = id & 7;
    *(u32x4*)(buf + r * GLD + ch * 8) = ra[i];
  }
#pragma unroll
  for (int i = 0; i < NI; ++i) {
    const int id = tid + 256 * i, r = id >> 3, ch = id & 7;
    *(u32x4*)(buf + GTILE + r * GLD + ch * 8) = rb[i];
  }
}
template <int NI>
__device__ __forceinline__ void g_compute(f32x4 (&acc)[4][NI], const bf16* cur, int wr, int wc, int lane) {
#pragma unroll
  for (int ks = 0; ks < 2; ++ks) {
    bf16x8 a[4], b[NI];
#pragma unroll
    for (int i = 0; i < 4; ++i) a[i] = *(const bf16x8*)(cur + (wr * 64 + i * 16 + (lane & 15)) * GLD + ks * 32 + (lane >> 4) * 8);
#pragma unroll
    for (int j = 0; j < NI; ++j) b[j] = *(const bf16x8*)(cur + GTILE + (wc * 16 * NI + j * 16 + (lane & 15)) * GLD + ks * 32 + (lane >> 4) * 8);
#pragma unroll
    for (int i = 0; i < 4; ++i)
#pragma unroll
      for (int j = 0; j < NI; ++j) acc[i][j] = mfma16(b[j], a[i], acc[i][j]);
  }
}
template <int NI, bool DEEP = true>
__device__ __forceinline__ void gemm_accum(f32x4 (&acc)[4][NI], const bf16* __restrict__ A, int lda,
                                           const bf16* __restrict__ B, int ldb, int K, bf16* sm) {
  const int tid = tidx(), lane = tid & 63, wave = tid >> 6, wr = wave >> 1, wc = wave & 1;
  const int nk = K >> 6;
  bf16* buf0 = sm;
  bf16* buf1 = sm + 2 * GTILE;
  if (!DEEP) {
    u32x4 ra[4], rb[NI];
    g_load<NI>(ra, rb, A, lda, B, ldb, 0, tid);
    g_store<NI>(ra, rb, buf0, tid);
    __syncthreads();
#pragma unroll 1
    for (int kt = 0; kt < nk; kt += 2) {
      g_load<NI>(ra, rb, A, lda, B, ldb, (kt + 1) * 64, tid);
      g_compute<NI>(acc, buf0, wr, wc, lane);
      g_store<NI>(ra, rb, buf1, tid);
      __syncthreads();
      if (kt + 2 < nk) g_load<NI>(ra, rb, A, lda, B, ldb, (kt + 2) * 64, tid);
      g_compute<NI>(acc, buf1, wr, wc, lane);
      if (kt + 2 < nk) g_store<NI>(ra, rb, buf0, tid);
      __syncthreads();
    }
    return;
  }
  u32x4 ra0[4], rb0[NI], ra1[4], rb1[NI];
  g_load<NI>(ra0, rb0, A, lda, B, ldb, 0, tid);
  g_load<NI>(ra1, rb1, A, lda, B, ldb, 64, tid);
  g_store<NI>(ra0, rb0, buf0, tid);
  __syncthreads();
#pragma unroll 1
  for (int kt = 0; kt < nk; kt += 2) {
    if (kt + 2 < nk) g_load<NI>(ra0, rb0, A, lda, B, ldb, (kt + 2) * 64, tid);
    g_compute<NI>(acc, buf0, wr, wc, lane);
    g_store<NI>(ra1, rb1, buf1, tid);
    __syncthreads();
    if (kt + 3 < nk) g_load<NI>(ra1, rb1, A, lda, B, ldb, (kt + 3) * 64, tid);
    g_compute<NI>(acc, buf1, wr, wc, lane);
    if (kt + 2 < nk) g_store<NI>(ra0, rb0, buf0, tid);
    __syncthreads();
  }
}
template <int NI>
__device__ __forceinline__ void zero_acc(f32x4 (&acc)[4][NI]) {
#pragma unroll
  for (int i = 0; i < 4; ++i)
#pragma unroll
    for (int j = 0; j < NI; ++j) acc[i][j] = (f32x4){0.f, 0.f, 0.f, 0.f};
}
__device__ __forceinline__ void tile_map(int t, int ntn, int& pm, int& pn) {
  const int grp = t / (8 * ntn), w = t % (8 * ntn);
  pm = grp * 8 + (w & 7);
  pn = w >> 3;
}

__device__ __forceinline__ void transpose_tile(const float* __restrict__ src, int ld_src, int n_valid, bf16* __restrict__ dst, int ld_dst,
                               int k0, int n0, int kdst0, float* sm) {
  const int tid = tidx();
  for (int i = tid; i < 64 * 16; i += 256) {
    const int kk = i >> 4, n4 = (i & 15) * 4, n = n0 + n4;
    float4 v = make_float4(0.f, 0.f, 0.f, 0.f);
    if (n + 3 < n_valid) v = *(const float4*)(src + (size_t)(k0 + kk) * ld_src + n);
    sm[kk * 65 + n4 + 0] = v.x; sm[kk * 65 + n4 + 1] = v.y; sm[kk * 65 + n4 + 2] = v.z; sm[kk * 65 + n4 + 3] = v.w;
  }
  __syncthreads();
  for (int i = tid; i < 64 * 8; i += 256) {
    const int nn = i >> 3, kc = (i & 7) * 8;
    uint4 o;
    o.x = pack2(sm[(kc + 0) * 65 + nn], sm[(kc + 1) * 65 + nn]);
    o.y = pack2(sm[(kc + 2) * 65 + nn], sm[(kc + 3) * 65 + nn]);
    o.z = pack2(sm[(kc + 4) * 65 + nn], sm[(kc + 5) * 65 + nn]);
    o.w = pack2(sm[(kc + 6) * 65 + nn], sm[(kc + 7) * 65 + nn]);
    *(uint4*)(dst + (size_t)(n0 + nn) * ld_dst + kdst0 + kc) = o;
  }
  __syncthreads();
}

__device__ __forceinline__ void ada_item(const Params& p, int item, float* sm) {
  const int l = item / 96, n0 = (item % 96) * 32;
  const int tid = tidx(), col = tid & 31, rg = tid >> 5;
  float acc[17];
#pragma unroll
  for (int j = 0; j < 17; ++j) acc[j] = 0.f;
  const float* W = p.ada_w + (size_t)l * 1024 * 3072;
  for (int k0 = 0; k0 < 1024; k0 += 64) {
    for (int i = tid; i < 136 * 64; i += 256) {
      const int r = i >> 6, kk = i & 63;
      float v = 0.f;
      if (r < NMOD) {
        const float c = (r < 4) ? p.c_prompt[r * 1024 + k0 + kk] : p.c_sample[(r - 4) * 1024 + k0 + kk];
        v = siluf_(c);
      }
      sm[r * 65 + kk] = v;
    }
    __syncthreads();
#pragma unroll 4
    for (int kk = 0; kk < 64; ++kk) {
      const float w = W[(size_t)(k0 + kk) * 3072 + n0 + col];
#pragma unroll
      for (int j = 0; j < 17; ++j) acc[j] += sm[(rg * 17 + j) * 65 + kk] * w;
    }
    __syncthreads();
  }
  float* mod = (float*)(p.ws + WS_MOD);
  const float b = p.ada_b[l * 3072 + n0 + col];
#pragma unroll
  for (int j = 0; j < 17; ++j) {
    const int r = rg * 17 + j;
    if (r < NMOD) mod[((size_t)l * NMOD + r) * 3072 + n0 + col] = acc[j] + b;
  }
}

__device__ __forceinline__ void phase_prep(const Params& p, unsigned char* smem) {
  float* sm = (float*)smem;
  constexpr int N_WIN = 2 * 16 * (NWIN / 64);
  constexpr int N_WBR = 2 * 3 * 8 * 16;
  constexpr int N_WOUT = 2 * 16 * 16;
  constexpr int N_ADA = 192;
  constexpr int N_ALL = N_ADA + N_WIN + N_WBR + N_WOUT;
  bf16* WinT = (bf16*)(p.ws + WS_WIN);
  bf16* WbrT = (bf16*)(p.ws + WS_WBR);
  bf16* WoutT = (bf16*)(p.ws + WS_WOUT);
  for (int it = blockIdx.x; it < N_ALL; it += gridDim.x) {
    int i = it;
    if (i < N_ADA) { ada_item(p, i, sm); continue; }
    i -= N_ADA;
    if (i < N_WIN) {
      const int l = i / (16 * 134), r = i % (16 * 134), kt = r / 134, nt = r % 134;
      transpose_tile(p.w_in + (size_t)l * 1024 * ZIN, ZIN, ZIN, WinT + (size_t)l * NWIN * 1024, 1024, kt * 64, nt * 64, kt * 64, sm);
      continue;
    }
    i -= N_WIN;
    if (i < N_WBR) {
      const int l = i / 384, r = i % 384, seg = r / 128, r2 = r % 128, kt = r2 / 16, nt = r2 % 16;
      const float* src = (seg == 0 ? p.w_a : seg == 1 ? p.w_b : p.w_c) + (size_t)l * 512 * 1024;
      transpose_tile(src, 1024, 1024, WbrT + (size_t)l * 1024 * 1536, 1536, kt * 64, nt * 64, seg * 512 + kt * 64, sm);
      continue;
    }
    i -= N_WBR;
    {
      const int l = i / 256, r = i % 256, kt = r / 16, nt = r % 16;
      transpose_tile(p.w_out + (size_t)l * 1024 * 1024, 1024, 1024, WoutT + (size_t)l * 1024 * 1024, 1024, kt * 64, nt * 64, kt * 64, sm);
    }
  }
}

__device__ __forceinline__ const float* xrow_ptr(const Params& p, int l, int row) {
  if (l == 0) return row < TP ? p.x_prompt + (size_t)row * D : p.x_sample + (size_t)(row - TP) * D;
  return p.out + (size_t)row * D;
}
__device__ __forceinline__ int mod_row(int row) { return row < TP ? (row >> 12) : 4 + ((row - TP) >> 3); }

__device__ __forceinline__ void phase_norm(const Params& p, int l) {
  const int lane = tidx() & 63, wave = tidx() >> 6;
  bf16* hbuf = (bf16*)(p.ws + WS_H);
  const float* mod = (const float*)(p.ws + WS_MOD);
  const float* g = p.norm_g + l * D;
  for (int row = blockIdx.x * 4 + wave; row < TT; row += gridDim.x * 4) {
    const float4* x = (const float4*)xrow_ptr(p, l, row);
    float4 v[4];
    float ss = 0.f;
#pragma unroll
    for (int i = 0; i < 4; ++i) {
      v[i] = x[lane + 64 * i];
      ss += v[i].x * v[i].x + v[i].y * v[i].y + v[i].z * v[i].z + v[i].w * v[i].w;
    }
    ss = wave_sum(ss);
    const float rstd = rsqrtf(ss * (1.0f / D) + EPS);
    const float* mp = mod + ((size_t)l * NMOD + mod_row(row)) * 3072;
#pragma unroll
    for (int i = 0; i < 4; ++i) {
      const int c = (lane + 64 * i) * 4;
      const float4 gg = *(const float4*)(g + c), sh = *(const float4*)(mp + c), sc = *(const float4*)(mp + 1024 + c);
      uint2 o;
      o.x = pack2(v[i].x * rstd * gg.x * (1.f + sc.x) + sh.x, v[i].y * rstd * gg.y * (1.f + sc.y) + sh.y);
      o.y = pack2(v[i].z * rstd * gg.z * (1.f + sc.z) + sh.z, v[i].w * rstd * gg.w * (1.f + sc.w) + sh.w);
      *(uint2*)(hbuf + (size_t)row * D + c) = o;
    }
  }
}

__device__ __forceinline__ void phase_gemm_in(const Params& p, int l, int col0, int ntn, int ldz, unsigned char* smem) {
  bf16* sm = (bf16*)smem;
  const bf16* hbuf = (const bf16*)(p.ws + WS_H);
  const bf16* W = (const bf16*)(p.ws + WS_WIN) + (size_t)l * NWIN * 1024;
  bf16* z = (bf16*)(p.ws + WS_Z);
  const float* bias = p.b_in + (size_t)l * ZIN;
  const int lane = tidx() & 63, wave = tidx() >> 6, wr = wave >> 1, wc = wave & 1;
  const int ntiles = (TT / 128) * ntn;
  for (int t = blockIdx.x; t < ntiles; t += gridDim.x) {
    int pm, pn;
    tile_map(t, ntn, pm, pn);
    const int m0 = pm * 128, n0 = pn * 128;
    f32x4 acc[4][4];
    zero_acc<4>(acc);
    gemm_accum<4>(acc, hbuf + (size_t)m0 * 1024, 1024, W + (size_t)(col0 + n0) * 1024, 1024, 1024, sm);
#pragma unroll
    for (int j = 0; j < 4; ++j) {
      const int col = n0 + wc * 64 + j * 16 + (lane >> 4) * 4;
      const float4 b = *(const float4*)(bias + col0 + col);
#pragma unroll
      for (int i = 0; i < 4; ++i) {
        const int row = m0 + wr * 64 + i * 16 + (lane & 15);
        uint2 o;
        o.x = pack2(acc[i][j][0] + b.x, acc[i][j][1] + b.y);
        o.y = pack2(acc[i][j][2] + b.z, acc[i][j][3] + b.w);
        *(uint2*)(z + (size_t)row * ldz + col) = o;
      }
    }
  }
}

__device__ __forceinline__ void gmlp_prompt_item(const Params& p, int l, int item, unsigned char* smem) {
  const int b = item >> 7, n = (item >> 2) & 31, g = item & 3;
  const int r0 = b * SEQ + n * 128;
  const bf16* z = (const bf16*)(p.ws + WS_Z);
  bf16* yab = (bf16*)(p.ws + WS_YAB);
  bf16* sW = (bf16*)smem;
  bf16* sV = (bf16*)(smem + 34816);
  float* srstd = (float*)(smem + 69632);
  const int tid = tidx(), lane = tid & 63, wave = tid >> 6, wr = wave >> 1, wc = wave & 1;
  {
    const int tok = tid >> 1, half = tid & 1;
    const uint4* ptr = (const uint4*)(z + (size_t)(r0 + tok) * ZAB + OFF_AV + half * 256);
    float ss = 0.f;
    for (int i = 0; i < 32; ++i) {
      float f[8];
      unpack8(ptr[i], f);
#pragma unroll
      for (int j = 0; j < 8; ++j) ss += f[j] * f[j];
    }
    ss += __shfl_xor(ss, 1);
    if (half == 0) srstd[tok] = rsqrtf(ss * (1.0f / 512.f) + EPS);
  }
  __syncthreads();
  const float* vg = p.vnorm_g + l * 512 + g * 128;
  for (int i = tid; i < 2048; i += 256) {
    const int s = i >> 4, c8 = (i & 15) * 8;
    float f[8];
    unpack8(*(const uint4*)(z + (size_t)(r0 + s) * ZAB + OFF_AV + g * 128 + c8), f);
    const float rs = srstd[s];
#pragma unroll
    for (int j = 0; j < 8; ++j) sV[(c8 + j) * 136 + s] = f2bf(f[j] * rs * vg[c8 + j]);
  }
  const float* Wg = p.gmlp_ws + ((size_t)(l * 4 + g)) * 128 * 128;
  for (int i = tid; i < 4096; i += 256) {
    const int t = i >> 5, s4 = (i & 31) * 4;
    const float4 w = *(const float4*)(Wg + t * 128 + s4);
    uint2 o;
    o.x = pack2(s4 + 0 <= t ? w.x : 0.f, s4 + 1 <= t ? w.y : 0.f);
    o.y = pack2(s4 + 2 <= t ? w.z : 0.f, s4 + 3 <= t ? w.w : 0.f);
    *(uint2*)(sW + t * 136 + s4) = o;
  }
  __syncthreads();
  f32x4 acc[4][4];
  zero_acc<4>(acc);
  mma_lds<4, 4>(acc, sW + wr * 64 * 136, 136, sV + wc * 64 * 136, 136, wr * 64 + 64, lane);
  const float* bs = p.gmlp_bs + (l * 4 + g) * 128;
#pragma unroll
  for (int i = 0; i < 4; ++i) {
    const int t = wr * 64 + i * 16 + (lane & 15);
    const float bst = bs[t];
    const size_t rowoff = (size_t)(r0 + t) * ZAB;
#pragma unroll
    for (int j = 0; j < 4; ++j) {
      const int c = g * 128 + wc * 64 + j * 16 + (lane >> 4) * 4;
      float u[4], ag[4];
      unpack4(*(const uint2*)(z + rowoff + c), u);
      unpack4(*(const uint2*)(z + rowoff + OFF_AG + c), ag);
      uint2 o;
      o.x = pack2(u[0] * (acc[i][j][0] + bst) * siluf_(ag[0]), u[1] * (acc[i][j][1] + bst) * siluf_(ag[1]));
      o.y = pack2(u[2] * (acc[i][j][2] + bst) * siluf_(ag[2]), u[3] * (acc[i][j][3] + bst) * siluf_(ag[3]));
      *(uint2*)(yab + (size_t)(r0 + t) * 1024 + c) = o;
    }
  }
  __syncthreads();
}

__device__ __forceinline__ void gmlp_sample_item(const Params& p, int l, int b, unsigned char* smem) {
  const int r0 = TP + b * 8;
  const bf16* z = (const bf16*)(p.ws + WS_Z);
  bf16* yab = (bf16*)(p.ws + WS_YAB);
  float* svn = (float*)smem;
  const int tid = tidx(), lane = tid & 63, wave = tid >> 6;
  const float* vg = p.vnorm_g + l * 512;
  for (int tt = 0; tt < 2; ++tt) {
    const int t = wave * 2 + tt;
    float f[8];
    unpack8(*(const uint4*)(z + (size_t)(r0 + t) * ZAB + OFF_AV + lane * 8), f);
    float ss = 0.f;
#pragma unroll
    for (int j = 0; j < 8; ++j) ss += f[j] * f[j];
    ss = wave_sum(ss);
    const float rstd = rsqrtf(ss * (1.0f / 512.f) + EPS);
    float* gv = p.out + O_GV + (((size_t)l * 128 + b) * 8 + t) * 512 + lane * 8;
#pragma unroll
    for (int j = 0; j < 8; ++j) {
      const float vn = f[j] * rstd * vg[lane * 8 + j];
      svn[t * 512 + lane * 8 + j] = vn;
      gv[j] = vn;
    }
  }
  __syncthreads();
  {
    const int c = tid * 2, g = c >> 7;
    const float* Wg = p.gmlp_ws + ((size_t)(l * 4 + g)) * 128 * 128;
    const float* bs = p.gmlp_bs + (l * 4 + g) * 128;
    for (int t = 0; t < 8; ++t) {
      float s0 = bs[t], s1 = bs[t];
      for (int s = 0; s <= t; ++s) {
        const float w = Wg[t * 128 + s];
        s0 += w * svn[s * 512 + c];
        s1 += w * svn[s * 512 + c + 1];
      }
      const unsigned uu = *(const unsigned*)(z + (size_t)(r0 + t) * ZAB + c);
      const unsigned gg = *(const unsigned*)(z + (size_t)(r0 + t) * ZAB + OFF_AG + c);
      *(unsigned*)(yab + (size_t)(r0 + t) * 1024 + c) = pack2(lo2f(uu) * s0 * siluf_(lo2f(gg)), hi2f(uu) * s1 * siluf_(hi2f(gg)));
    }
  }
  __syncthreads();
}

__device__ __forceinline__ void swa_prompt_item(const Params& p, int l, int item, unsigned char* smem) {
  const int b = item >> 7, qt = (item >> 1) & 63, kv = item & 1;
  const int q0 = qt * 64, rb = b * SEQ;
  const bf16* z = (const bf16*)(p.ws + WS_Z);
  bf16* yab = (bf16*)(p.ws + WS_YAB);
  bf16* sK = (bf16*)smem;
  bf16* sVT = (bf16*)(smem + 27648);
  const int tid = tidx(), lane = tid & 63, wave = tid >> 6;
  const float* kg = p.kn_g + l * 64;
  const float* qg = p.qn_g + l * 64;
#pragma unroll 1
  for (int it = 0; it < 6; ++it) {
    const int id = tid + 256 * it, kk = id >> 3, ch = id & 7, kp = q0 - 128 + kk;
    float f[8];
    uint4 vraw = make_uint4(0, 0, 0, 0);
    if (kp >= 0) {
      unpack8(*(const uint4*)(z + (size_t)(rb + kp) * ZAB + OFF_BK + kv * 64 + ch * 8), f);
      vraw = *(const uint4*)(z + (size_t)(rb + kp) * ZAB + OFF_BV + kv * 64 + ch * 8);
    } else {
#pragma unroll
      for (int j = 0; j < 8; ++j) f[j] = 0.f;
    }
    float ss = 0.f;
#pragma unroll
    for (int j = 0; j < 8; ++j) ss += f[j] * f[j];
    ss += __shfl_xor(ss, 1); ss += __shfl_xor(ss, 2); ss += __shfl_xor(ss, 4);
    const float rstd = rsqrtf(ss * (1.0f / 64.f) + EPS);
#pragma unroll
    for (int j = 0; j < 8; ++j) f[j] = f[j] * rstd * kg[ch * 8 + j];
    uint4 ko;
    ko.x = pack2(f[0], f[1]); ko.y = pack2(f[2], f[3]); ko.z = pack2(f[4], f[5]); ko.w = pack2(f[6], f[7]);
    *(uint4*)(sK + kk * 72 + ch * 8) = ko;
    float vf[8];
    unpack8(vraw, vf);
#pragma unroll
    for (int j = 0; j < 8; ++j) sVT[(ch * 8 + j) * 200 + kk] = f2bf(vf[j]);
    if (kk >= 128 && kp >= SEQ - 128) {
      const size_t o = ((((size_t)l * 4 + b) * 128 + (kp - (SEQ - 128))) * 2 + kv) * 64 + ch * 8;
#pragma unroll
      for (int j = 0; j < 8; ++j) { p.out[O_SKP + o + j] = f[j]; p.out[O_SVP + o + j] = vf[j]; }
    }
  }
  __syncthreads();
  const int h = kv * 4 + wave;
  const float sink = p.sinks[l * 8 + h];
  const int g4 = lane >> 4, r16 = lane & 15;
#pragma unroll 1
  for (int i = 0; i < 4; ++i) {
    const int qrow = q0 + i * 16 + r16;
    const size_t grow = (size_t)(rb + qrow);
    bf16x8 qf[2];
    {
      float f0[8], f1[8];
      unpack8(*(const uint4*)(z + grow * ZAB + OFF_BQ + h * 64 + g4 * 8), f0);
      unpack8(*(const uint4*)(z + grow * ZAB + OFF_BQ + h * 64 + 32 + g4 * 8), f1);
      float ss = 0.f;
#pragma unroll
      for (int j = 0; j < 8; ++j) ss += f0[j] * f0[j] + f1[j] * f1[j];
      ss += __shfl_xor(ss, 16); ss += __shfl_xor(ss, 32);
      const float rstd = rsqrtf(ss * (1.0f / 64.f) + EPS) * 0.125f;
#pragma unroll
      for (int j = 0; j < 8; ++j) {
        qf[0][j] = (short)f2bf(f0[j] * rstd * qg[g4 * 8 + j]);
        qf[1][j] = (short)f2bf(f1[j] * rstd * qg[32 + g4 * 8 + j]);
      }
    }
    f32x4 st[12];
#pragma unroll
    for (int kt = 0; kt < 12; ++kt) {
      st[kt] = (f32x4){0.f, 0.f, 0.f, 0.f};
#pragma unroll
      for (int ks = 0; ks < 2; ++ks) {
        const bf16x8 kf = *(const bf16x8*)(sK + (kt * 16 + r16) * 72 + ks * 32 + g4 * 8);
        st[kt] = mfma16(kf, qf[ks], st[kt]);
      }
      if ((kt & 1) == 1) __builtin_amdgcn_sched_barrier(0);
    }
    float mx = -INFINITY;
#pragma unroll
    for (int kt = 0; kt < 12; ++kt)
#pragma unroll
      for (int x = 0; x < 4; ++x) {
        const int kp = q0 - 128 + kt * 16 + g4 * 4 + x, diff = qrow - kp;
        const bool valid = (kp >= 0) && (diff >= 0) && (diff < 128);
        st[kt][x] = valid ? st[kt][x] : -INFINITY;
        mx = fmaxf(mx, st[kt][x]);
      }
    mx = fmaxf(mx, __shfl_xor(mx, 16)); mx = fmaxf(mx, __shfl_xor(mx, 32));
    mx = fmaxf(mx, sink);
    float sum = 0.f;
#pragma unroll
    for (int kt = 0; kt < 12; ++kt)
#pragma unroll
      for (int x = 0; x < 4; ++x) {
        const float pv = __expf(st[kt][x] - mx);
        st[kt][x] = pv;
        sum += pv;
      }
    sum += __shfl_xor(sum, 16); sum += __shfl_xor(sum, 32);
    const float inv = 1.0f / (sum + __expf(sink - mx));
    f32x4 o[4];
#pragma unroll
    for (int dt = 0; dt < 4; ++dt) o[dt] = (f32x4){0.f, 0.f, 0.f, 0.f};
#pragma unroll
    for (int t2 = 0; t2 < 6; ++t2) {
      bf16x8 pf;
#pragma unroll
      for (int x = 0; x < 4; ++x) { pf[x] = (short)f2bf(st[2 * t2][x]); pf[4 + x] = (short)f2bf(st[2 * t2 + 1][x]); }
#pragma unroll
      for (int dt = 0; dt < 4; ++dt) {
        const uint2 v0 = *(const uint2*)(sVT + (dt * 16 + r16) * 200 + t2 * 32 + g4 * 4);
        const uint2 v1 = *(const uint2*)(sVT + (dt * 16 + r16) * 200 + t2 * 32 + 16 + g4 * 4);
        union { uint4 u; bf16x8 v; } cv;
        cv.u = make_uint4(v0.x, v0.y, v1.x, v1.y);
        o[dt] = mfma16(cv.v, pf, o[dt]);
      }
      __builtin_amdgcn_sched_barrier(0);
    }
#pragma unroll
    for (int dt = 0; dt < 4; ++dt) {
      const int d0 = dt * 16 + g4 * 4;
      float bg[4];
      unpack4(*(const uint2*)(z + grow * ZAB + OFF_BG + h * 64 + d0), bg);
      uint2 oo;
      oo.x = pack2(o[dt][0] * inv * siluf_(bg[0]), o[dt][1] * inv * siluf_(bg[1]));
      oo.y = pack2(o[dt][2] * inv * siluf_(bg[2]), o[dt][3] * inv * siluf_(bg[3]));
      *(uint2*)(yab + grow * 1024 + 512 + h * 64 + d0) = oo;
    }
  }
  __syncthreads();
}

__device__ __forceinline__ void swa_sample_item(const Params& p, int l, int item, unsigned char* smem) {
  const int b = item >> 1, kv = item & 1;
  const int r0 = TP + b * 8;
  const bf16* z = (const bf16*)(p.ws + WS_Z);
  bf16* yab = (bf16*)(p.ws + WS_YAB);
  bf16* sK = (bf16*)smem;
  bf16* sV = (bf16*)(smem + 19584);
  float* sq = (float*)(smem + 39168);
  float* sP = (float*)(smem + 47488);
  const int tid = tidx();
  const float* kg = p.kn_g + l * 64;
  const float* qg = p.qn_g + l * 64;
  const float* ck = p.cache_k + ((size_t)l * 128 + b) * 128 * 128;
  const float* cvp = p.cache_v + ((size_t)l * 128 + b) * 128 * 128;
#pragma unroll 1
  for (int it = 0; it < 5; ++it) {
    const int id = tid + 256 * it, j = id >> 3, ch = id & 7;
    const bool act = id < 1088;
    float kf[8], vf[8];
#pragma unroll
    for (int x = 0; x < 8; ++x) { kf[x] = 0.f; vf[x] = 0.f; }
    if (act) {
      if (j < 128) {
        const float4 a0 = *(const float4*)(ck + (j * 2 + kv) * 64 + ch * 8), a1 = *(const float4*)(ck + (j * 2 + kv) * 64 + ch * 8 + 4);
        const float4 b0 = *(const float4*)(cvp + (j * 2 + kv) * 64 + ch * 8), b1 = *(const float4*)(cvp + (j * 2 + kv) * 64 + ch * 8 + 4);
        kf[0] = a0.x; kf[1] = a0.y; kf[2] = a0.z; kf[3] = a0.w; kf[4] = a1.x; kf[5] = a1.y; kf[6] = a1.z; kf[7] = a1.w;
        vf[0] = b0.x; vf[1] = b0.y; vf[2] = b0.z; vf[3] = b0.w; vf[4] = b1.x; vf[5] = b1.y; vf[6] = b1.z; vf[7] = b1.w;
      } else {
        unpack8(*(const uint4*)(z + (size_t)(r0 + j - 128) * ZAB + OFF_BK + kv * 64 + ch * 8), kf);
        unpack8(*(const uint4*)(z + (size_t)(r0 + j - 128) * ZAB + OFF_BV + kv * 64 + ch * 8), vf);
      }
    }
    float ss = 0.f;
#pragma unroll
    for (int x = 0; x < 8; ++x) ss += kf[x] * kf[x];
    ss += __shfl_xor(ss, 1); ss += __shfl_xor(ss, 2); ss += __shfl_xor(ss, 4);
    if (act) {
      if (j >= 128) {
        const float rstd = rsqrtf(ss * (1.0f / 64.f) + EPS);
#pragma unroll
        for (int x = 0; x < 8; ++x) kf[x] = kf[x] * rstd * kg[ch * 8 + x];
      }
      uint4 ko, vo;
      ko.x = pack2(kf[0], kf[1]); ko.y = pack2(kf[2], kf[3]); ko.z = pack2(kf[4], kf[5]); ko.w = pack2(kf[6], kf[7]);
      vo.x = pack2(vf[0], vf[1]); vo.y = pack2(vf[2], vf[3]); vo.z = pack2(vf[4], vf[5]); vo.w = pack2(vf[6], vf[7]);
      *(uint4*)(sK + j * 72 + ch * 8) = ko;
      *(uint4*)(sV + j * 72 + ch * 8) = vo;
      if (j >= 8) {
        const size_t o = ((((size_t)l * 128 + b) * 128 + (j - 8)) * 2 + kv) * 64 + ch * 8;
        *(float4*)(p.out + O_SKS + o) = make_float4(kf[0], kf[1], kf[2], kf[3]);
        *(float4*)(p.out + O_SKS + o + 4) = make_float4(kf[4], kf[5], kf[6], kf[7]);
        *(float4*)(p.out + O_SVS + o) = make_float4(vf[0], vf[1], vf[2], vf[3]);
        *(float4*)(p.out + O_SVS + o + 4) = make_float4(vf[4], vf[5], vf[6], vf[7]);
      }
    }
  }
  const int qi = tid >> 3, sub = tid & 7, t = qi >> 2, h = kv * 4 + (qi & 3);
  {
    float f[8];
    unpack8(*(const uint4*)(z + (size_t)(r0 + t) * ZAB + OFF_BQ + h * 64 + sub * 8), f);
    float ss = 0.f;
#pragma unroll
    for (int x = 0; x < 8; ++x) ss += f[x] * f[x];
    ss += __shfl_xor(ss, 1); ss += __shfl_xor(ss, 2); ss += __shfl_xor(ss, 4);
    const float rstd = rsqrtf(ss * (1.0f / 64.f) + EPS) * 0.125f;
#pragma unroll
    for (int x = 0; x < 8; ++x) sq[qi * 65 + sub * 8 + x] = f[x] * rstd * qg[sub * 8 + x];
  }
  __syncthreads();
  const float sink = p.sinks[l * 8 + h];
  float mx = -INFINITY;
#pragma unroll 1
  for (int jj = 0; jj < 17; ++jj) {
    const int key = sub + 8 * jj;
    float s = 0.f;
#pragma unroll 8
    for (int d = 0; d < 64; ++d) s += sq[qi * 65 + d] * bf2f(sK[key * 72 + d]);
    const bool valid = (key >= t + 1) && (key <= t + 128);
    s = valid ? s : -INFINITY;
    sP[qi * 140 + key] = s;
    mx = fmaxf(mx, s);
  }
  mx = fmaxf(mx, __shfl_xor(mx, 1)); mx = fmaxf(mx, __shfl_xor(mx, 2)); mx = fmaxf(mx, __shfl_xor(mx, 4));
  mx = fmaxf(mx, sink);
  float sum = 0.f;
  for (int jj = 0; jj < 17; ++jj) {
    const int key = sub + 8 * jj;
    const float pv = __expf(sP[qi * 140 + key] - mx);
    sP[qi * 140 + key] = pv;
    sum += pv;
  }
  sum += __shfl_xor(sum, 1); sum += __shfl_xor(sum, 2); sum += __shfl_xor(sum, 4);
  const float inv = 1.0f / (sum + __expf(sink - mx));
  __syncthreads();
  {
    float o[8];
#pragma unroll
    for (int x = 0; x < 8; ++x) o[x] = 0.f;
#pragma unroll 2
    for (int key = 0; key < 136; ++key) {
      const float pv = sP[qi * 140 + key];
      float vf[8];
      unpack8(*(const uint4*)(sV + key * 72 + sub * 8), vf);
#pragma unroll
      for (int x = 0; x < 8; ++x) o[x] += pv * vf[x];
    }
    float bg[8];
    unpack8(*(const uint4*)(z + (size_t)(r0 + t) * ZAB + OFF_BG + h * 64 + sub * 8), bg);
    uint4 oo;
    oo.x = pack2(o[0] * inv * siluf_(bg[0]), o[1] * inv * siluf_(bg[1]));
    oo.y = pack2(o[2] * inv * siluf_(bg[2]), o[3] * inv * siluf_(bg[3]));
    oo.z = pack2(o[4] * inv * siluf_(bg[4]), o[5] * inv * siluf_(bg[5]));
    oo.w = pack2(o[6] * inv * siluf_(bg[6]), o[7] * inv * siluf_(bg[7]));
    *(uint4*)(yab + (size_t)(r0 + t) * 1024 + 512 + h * 64 + sub * 8) = oo;
  }
  __syncthreads();
}

__device__ __forceinline__ void phase_mix_ab(const Params& p, int l, unsigned char* smem) {
  constexpr int N_SWA = 512, N_GM = 512, N_SWS = 256, N_GMS = 128;
  constexpr int N_ALL = N_SWA + N_GM + N_SWS + N_GMS;
  for (int it = blockIdx.x; it < N_ALL; it += gridDim.x) {
    int i = it;
    if (i < N_SWA) { swa_prompt_item(p, l, i, smem); continue; }
    i -= N_SWA;
    if (i < N_GM) { gmlp_prompt_item(p, l, i, smem); continue; }
    i -= N_GM;
    if (i < N_SWS) { swa_sample_item(p, l, i, smem); continue; }
    i -= N_SWS;
    gmlp_sample_item(p, l, i, smem);
  }
}

__device__ __forceinline__ void conv8_prompt(const Params& p, int l, const bf16* z, int r0, int pos0, int s, int zc, float* y) {
  const float* cw = p.conv_w + (size_t)l * 4 * 1024 + zc;
  const float* cb = p.conv_b + l * 1024 + zc;
#pragma unroll
  for (int j = 0; j < 8; ++j) y[j] = cb[j];
#pragma unroll
  for (int tap = 0; tap < 4; ++tap) {
    const int back = 3 - tap;
    if (pos0 + s - back >= 0) {
      float f[8];
      unpack8(*(const uint4*)(z + (size_t)(r0 + s - back) * ZC + C_QK + zc), f);
#pragma unroll
      for (int j = 0; j < 8; ++j) y[j] += cw[tap * 1024 + j] * f[j];
    }
  }
#pragma unroll
  for (int j = 0; j < 8; ++j) y[j] = siluf_(y[j]);
}

__device__ __forceinline__ void chunk_gates(const Params& p, int l, const bf16* z, int r0, int hh, int lane, float& cum, float& iv) {
  const float f = bf2f(z[(size_t)(r0 + lane) * ZC + C_F + hh]) + p.f_bias[l * 4 + hh];
  iv = bf2f(z[(size_t)(r0 + lane) * ZC + C_I + hh]);
  float c = logsigmoidf_(f);
#pragma unroll
  for (int o = 1; o < 64; o <<= 1) {
    const float n = __shfl_up(c, o);
    if (lane >= o) c += n;
  }
  cum = c;
}

__device__ __forceinline__ void mlstm_local_item(const Params& p, int l, int item, unsigned char* smem) {
  const int bh = item >> 6, c = item & 63, b = bh >> 2, hh = bh & 3;
  const int r0 = b * SEQ + c * 64;
  const bf16* z = (const bf16*)(p.ws + WS_Z);
  bf16* skT = (bf16*)smem;
  bf16* svT = (bf16*)(smem + 18432);
  float* swsel = (float*)(smem + 36864);
  const int tid = tidx(), lane = tid & 63, wave = tid >> 6, wr = wave >> 1, wc = wave & 1;
  if (wave == 0) {
    float cum, iv;
    chunk_gates(p, l, z, r0, hh, lane, cum, iv);
    const float total = __shfl(cum, 63);
    const float g = total - cum + iv;
    const float G = wave_max(g);
    swsel[lane] = __expf(g - G);
    if (lane == 0) {
      ((float*)(p.ws + WS_G))[item] = G;
      ((float*)(p.ws + WS_TOT))[item] = total;
    }
  }
  __syncthreads();
  for (int i = tid; i < 1024; i += 256) {
    const int s = i >> 4, d8 = (i & 15) * 8;
    float y[8];
    conv8_prompt(p, l, z, r0, c * 64, s, 512 + hh * 128 + d8, y);
    const float sc = 0.08838834764831845f * swsel[s];
#pragma unroll
    for (int j = 0; j < 8; ++j) skT[(d8 + j) * 72 + s] = f2bf(y[j] * sc);
    float v[8];
    unpack8(*(const uint4*)(z + (size_t)(r0 + s) * ZC + C_V + hh * 128 + d8), v);
#pragma unroll
    for (int j = 0; j < 8; ++j) svT[(d8 + j) * 72 + s] = f2bf(v[j]);
  }
  __syncthreads();
  f32x4 acc[4][4];
  zero_acc<4>(acc);
  mma_lds<4, 4>(acc, svT + wr * 64 * 72, 72, skT + wc * 64 * 72, 72, 64, lane);
  bf16* U = (bf16*)(p.ws + WS_U) + (size_t)item * 16384;
#pragma unroll
  for (int i = 0; i < 4; ++i)
#pragma unroll
    for (int j = 0; j < 4; ++j) {
      const int e = wr * 64 + i * 16 + (lane & 15), d = wc * 64 + j * 16 + (lane >> 4) * 4;
      uint2 o;
      o.x = pack2(acc[i][j][0], acc[i][j][1]);
      o.y = pack2(acc[i][j][2], acc[i][j][3]);
      *(uint2*)(U + e * 128 + d) = o;
    }
  if (tid < 128) {
    float s = 0.f;
    for (int k = 0; k < 64; ++k) s += bf2f(skT[tid * 72 + k]);
    ((float*)(p.ws + WS_UN))[(size_t)item * 128 + tid] = s;
  }
  __syncthreads();
}

__device__ __forceinline__ void mlstm_convout_item(const Params& p, int l, int b) {
  const bf16* z = (const bf16*)(p.ws + WS_Z);
  for (int i = tidx(); i < 3 * 1024; i += 256) {
    const int j = i >> 10, ch = i & 1023;
    p.out[O_CVP + (((size_t)l * 4 + b) * 3 + j) * 1024 + ch] = bf2f(z[(size_t)(b * SEQ + SEQ - 3 + j) * ZC + C_QK + ch]);
  }
}

__device__ __forceinline__ void mlstm_sample_item(const Params& p, int l, int item, unsigned char* smem) {
  const int b = item >> 2, hh = item & 3;
  const int r0 = TP + b * 8;
  bf16* z = (bf16*)(p.ws + WS_Z);
  float* sq = (float*)smem;
  float* sk = sq + 1024;
  float* sv = sk + 1024;
  float* sh = sv + 1024;
  float* sint = sh + 1024;
  float* sa = sint + 2048;
  float* sqn = sa + 64;
  float* smt = sqn + 8;
  float* swi = smt + 8;
  float* swsel = swi + 8;
  float* sdm = swsel + 8;
  float* sdecay = sdm + 64;
  const int tid = tidx(), lane = tid & 63, wave = tid >> 6;
  {
    const int isk = tid >> 7, d = tid & 127, zc = isk * 512 + hh * 128 + d;
    const float* cw = p.conv_w + (size_t)l * 4 * 1024 + zc;
    const float cb = p.conv_b[l * 1024 + zc];
    float xp[11];
    const float* cs = p.st_conv + ((size_t)l * 128 + b) * 3 * 1024 + zc;
    xp[0] = cs[0]; xp[1] = cs[1024]; xp[2] = cs[2048];
#pragma unroll
    for (int t = 0; t < 8; ++t) xp[3 + t] = bf2f(z[(size_t)(r0 + t) * ZC + C_QK + zc]);
    const float w0 = cw[0], w1 = cw[1024], w2 = cw[2048], w3 = cw[3072];
    float* dst = isk ? sk : sq;
    const float sc = isk ? 0.08838834764831845f : 1.0f;
#pragma unroll
    for (int t = 0; t < 8; ++t) {
      const float y = cb + w0 * xp[t] + w1 * xp[t + 1] + w2 * xp[t + 2] + w3 * xp[t + 3];
      dst[t * 128 + d] = siluf_(y) * sc;
    }
    float* co = p.out + O_CVS + ((size_t)l * 128 + b) * 3 * 1024 + zc;
    co[0] = xp[8]; co[1024] = xp[9]; co[2048] = xp[10];
  }
  for (int i = tid; i < 1024; i += 256) {
    const int t = i >> 7, e = i & 127;
    sv[i] = bf2f(z[(size_t)(r0 + t) * ZC + C_V + hh * 128 + e]);
  }
  if (tid == 0) {
    float cum[8], iv[8];
    float c = 0.f;
    for (int t = 0; t < 8; ++t) {
      const float f = bf2f(z[(size_t)(r0 + t) * ZC + C_F + hh]) + p.f_bias[l * 4 + hh];
      c += logsigmoidf_(f);
      cum[t] = c;
      iv[t] = bf2f(z[(size_t)(r0 + t) * ZC + C_I + hh]);
    }
    const float m0 = p.st_m[(l * 128 + b) * 4 + hh];
    for (int t = 0; t < 8; ++t) {
      float dmax = -INFINITY;
      for (int s = 0; s <= t; ++s) dmax = fmaxf(dmax, cum[t] - cum[s] + iv[s]);
      const float mi = cum[t] + m0, mt = fmaxf(mi, dmax);
      smt[t] = mt;
      swi[t] = __expf(mi - mt);
      for (int s = 0; s < 8; ++s) sdm[t * 8 + s] = (s <= t) ? __expf(cum[t] - cum[s] + iv[s] - mt) : 0.f;
    }
    const float total = cum[7];
    float gm = -INFINITY;
    for (int s = 0; s < 8; ++s) gm = fmaxf(gm, total - cum[s] + iv[s]);
    const float mn = fmaxf(total + m0, gm);
    for (int s = 0; s < 8; ++s) swsel[s] = __expf(total - cum[s] + iv[s] - mn);
    sdecay[0] = __expf(total + m0 - mn);
    p.out[O_MS + (l * 128 + b) * 4 + hh] = mn;
  }
  __syncthreads();
  const float* n0 = p.st_n + (((size_t)l * 128 + b) * 4 + hh) * 128;
  if (tid < 64) {
    const int t = tid >> 3, s = tid & 7;
    float dsum = 0.f;
    for (int d = 0; d < 128; ++d) dsum += sq[t * 128 + d] * sk[s * 128 + d];
    sa[t * 8 + s] = sdm[t * 8 + s] * dsum;
  } else if (tid < 128) {
    const int t = (tid - 64) >> 3, part = (tid - 64) & 7;
    float dsum = 0.f;
    for (int d = part * 16; d < part * 16 + 16; ++d) dsum += sq[t * 128 + d] * n0[d];
    dsum += __shfl_xor(dsum, 1); dsum += __shfl_xor(dsum, 2); dsum += __shfl_xor(dsum, 4);
    if (part == 0) sqn[t] = dsum;
  }
  __syncthreads();
  {
    const int e = tid & 127, dh = tid >> 7;
    const float decay = sdecay[0];
    const float* C0 = p.st_C + (((size_t)l * 128 + b) * 4 + hh) * 16384;
    float* C1 = p.out + O_CS + (((size_t)l * 128 + b) * 4 + hh) * 16384;
    float vw[8], inter[8];
#pragma unroll
    for (int s = 0; s < 8; ++s) { vw[s] = sv[s * 128 + e] * swsel[s]; inter[s] = 0.f; }
    for (int d = dh * 64; d < dh * 64 + 64; ++d) {
      const float c0 = C0[d * 128 + e];
      float upd = decay * c0;
#pragma unroll
      for (int s = 0; s < 8; ++s) {
        upd += sk[s * 128 + d] * vw[s];
        inter[s] += sq[s * 128 + d] * c0;
      }
      C1[d * 128 + e] = upd;
    }
#pragma unroll
    for (int t = 0; t < 8; ++t) sint[(dh * 8 + t) * 128 + e] = inter[t];
  }
  __syncthreads();
  if (tid < 128) {
    const int e = tid;
    for (int t = 0; t < 8; ++t) {
      float num = swi[t] * (sint[t * 128 + e] + sint[(8 + t) * 128 + e]);
      float den = swi[t] * sqn[t];
      for (int s = 0; s <= t; ++s) { num += sa[t * 8 + s] * sv[s * 128 + e]; den += sa[t * 8 + s]; }
      sh[t * 128 + e] = num / fmaxf(fabsf(den), __expf(-smt[t]));
    }
    float nn = sdecay[0] * n0[e];
    for (int s = 0; s < 8; ++s) nn += swsel[s] * sk[s * 128 + e];
    p.out[O_NS + (((size_t)l * 128 + b) * 4 + hh) * 128 + e] = nn;
  }
  __syncthreads();
  const float* hg = p.hnorm_g + l * 512 + hh * 128;
  for (int tt = 0; tt < 2; ++tt) {
    const int t = wave * 2 + tt;
    const float h0 = sh[t * 128 + lane], h1 = sh[t * 128 + 64 + lane];
    const float ss = wave_sum(h0 * h0 + h1 * h1);
    const float rstd = rsqrtf(ss * (1.0f / 128.f) + EPS);
    bf16* zr = z + (size_t)(r0 + t) * ZC;
#pragma unroll
    for (int k = 0; k < 2; ++k) {
      const int e = lane + 64 * k;
      const float hv = k ? h1 : h0;
      const float o = bf2f(zr[C_O + hh * 128 + e]), cg_ = bf2f(zr[C_G + hh * 128 + e]);
      zr[C_O + hh * 128 + e] = f2bf(hv * rstd * hg[e] * sigmoidf_(o) * siluf_(cg_));
    }
  }
  __syncthreads();
}

__device__ __forceinline__ void phase_mix1(const Params& p, int l, unsigned char* smem) {
  constexpr int N_LOC = 1024, N_SMP = 512, N_CV = 4;
  constexpr int N_ALL = N_LOC + N_SMP + N_CV;
  for (int it = blockIdx.x; it < N_ALL; it += gridDim.x) {
    int i = it;
    if (i < N_LOC) { mlstm_local_item(p, l, i, smem); continue; }
    i -= N_LOC;
    if (i < N_SMP) { mlstm_sample_item(p, l, i, smem); continue; }
    i -= N_SMP;
    mlstm_convout_item(p, l, i);
  }
}

__device__ __forceinline__ void phase_scan(const Params& p, int l, unsigned char* smem) {
  float* sdec = (float*)smem;
  float* ssc = sdec + 64;
  const int tid = tidx();
  float* Gb = (float*)(p.ws + WS_G);
  float* Tb = (float*)(p.ws + WS_TOT);
  float* Mb = (float*)(p.ws + WS_M);
  for (int it = blockIdx.x; it < 256; it += gridDim.x) {
    const int bh = it >> 4, slice = it & 15;
    if (tid == 0) {
      float m = 0.f;
      for (int c = 0; c < 64; ++c) {
        const float G = Gb[bh * 64 + c], tot = Tb[bh * 64 + c];
        const float mn = fmaxf(tot + m, G);
        sdec[c] = __expf(tot + m - mn);
        ssc[c] = __expf(G - mn);
        if (slice == 0) Mb[bh * 64 + c] = m;
        m = mn;
      }
      if (slice == 0) p.out[O_MP + l * 16 + bh] = m;
    }
    __syncthreads();
    {
      const int idx = slice * 1024 + tid * 4;
      bf16* U = (bf16*)(p.ws + WS_U) + (size_t)bh * 64 * 16384 + idx;
      float st[4] = {0.f, 0.f, 0.f, 0.f};
#pragma unroll 8
      for (int c = 0; c < 64; ++c) {
        float u[4];
        unpack4(*(const uint2*)(U + (size_t)c * 16384), u);
        uint2 o;
        o.x = pack2(st[0], st[1]); o.y = pack2(st[2], st[3]);
        *(uint2*)(U + (size_t)c * 16384) = o;
        const float dc = sdec[c], sc = ssc[c];
#pragma unroll
        for (int x = 0; x < 4; ++x) st[x] = dc * st[x] + sc * u[x];
      }
      const int e = idx >> 7, d0 = idx & 127;
      float* Co = p.out + O_CP + ((size_t)l * 16 + bh) * 16384;
#pragma unroll
      for (int x = 0; x < 4; ++x) Co[(d0 + x) * 128 + e] = st[x];
    }
    if (slice == 0 && tid < 128) {
      float* un = (float*)(p.ws + WS_UN) + (size_t)bh * 64 * 128 + tid;
      float n = 0.f;
#pragma unroll 8
      for (int c = 0; c < 64; ++c) {
        const float u = un[c * 128];
        un[c * 128] = n;
        n = sdec[c] * n + ssc[c] * u;
      }
      p.out[O_NP + ((size_t)l * 16 + bh) * 128 + tid] = n;
    }
    __syncthreads();
  }
}

__device__ __forceinline__ void mlstm_out_item(const Params& p, int l, int item, unsigned char* smem) {
  const int bh = item >> 6, c = item & 63, b = bh >> 2, hh = bh & 3;
  const int r0 = b * SEQ + c * 64;
  bf16* z = (bf16*)(p.ws + WS_Z);
  bf16* sq = (bf16*)smem;
  bf16* sk = (bf16*)(smem + 17408);
  bf16* svT = (bf16*)(smem + 34816);
  bf16* sa = (bf16*)(smem + 53248);
  float* scum = (float*)(smem + 62464);
  float* siv = scum + 64;
  float* smt = siv + 64;
  float* swi = smt + 64;
  float* sden = swi + 64;
  float* sqn = sden + 64;
  float* spart = sqn + 64;
  const int tid = tidx(), lane = tid & 63, wave = tid >> 6;
  const int r16 = lane & 15, g4 = lane >> 4;
  if (wave == 0) {
    float cum, iv;
    chunk_gates(p, l, z, r0, hh, lane, cum, iv);
    scum[lane] = cum;
    siv[lane] = iv;
  }
  for (int i = tid; i < 2048; i += 256) {
    const int isk = i >> 10, r = i & 1023, s = r >> 4, d8 = (r & 15) * 8;
    float y[8];
    conv8_prompt(p, l, z, r0, c * 64, s, isk * 512 + hh * 128 + d8, y);
    const float sc = isk ? 0.08838834764831845f : 1.0f;
    uint4 o;
    o.x = pack2(y[0] * sc, y[1] * sc); o.y = pack2(y[2] * sc, y[3] * sc);
    o.z = pack2(y[4] * sc, y[5] * sc); o.w = pack2(y[6] * sc, y[7] * sc);
    *(uint4*)((isk ? sk : sq) + s * 136 + d8) = o;
  }
  for (int i = tid; i < 1024; i += 256) {
    const int s = i >> 4, d8 = (i & 15) * 8;
    float v[8];
    unpack8(*(const uint4*)(z + (size_t)(r0 + s) * ZC + C_V + hh * 128 + d8), v);
#pragma unroll
    for (int j = 0; j < 8; ++j) svT[(d8 + j) * 72 + s] = f2bf(v[j]);
  }
  __syncthreads();
  const float m_prev = ((const float*)(p.ws + WS_M))[item];
  {
    const int t = wave * 16 + r16;
    bf16x8 qf[4];
#pragma unroll
    for (int ks = 0; ks < 4; ++ks) qf[ks] = *(const bf16x8*)(sq + t * 136 + ks * 32 + g4 * 8);
    f32x4 st[4];
#pragma unroll
    for (int kt = 0; kt < 4; ++kt) {
      st[kt] = (f32x4){0.f, 0.f, 0.f, 0.f};
#pragma unroll
      for (int ks = 0; ks < 4; ++ks) {
        const bf16x8 kf = *(const bf16x8*)(sk + (kt * 16 + r16) * 136 + ks * 32 + g4 * 8);
        st[kt] = mfma16(kf, qf[ks], st[kt]);
      }
    }
    const float cumt = scum[t];
    float dm[4][4];
    float rmax = -INFINITY;
#pragma unroll
    for (int kt = 0; kt < 4; ++kt)
#pragma unroll
      for (int x = 0; x < 4; ++x) {
        const int s = kt * 16 + g4 * 4 + x;
        dm[kt][x] = (s <= t) ? (cumt - scum[s] + siv[s]) : -INFINITY;
        rmax = fmaxf(rmax, dm[kt][x]);
      }
    rmax = fmaxf(rmax, __shfl_xor(rmax, 16)); rmax = fmaxf(rmax, __shfl_xor(rmax, 32));
    const float mi = cumt + m_prev, mt = fmaxf(mi, rmax);
    float rsum = 0.f;
#pragma unroll
    for (int kt = 0; kt < 4; ++kt) {
      float a[4];
#pragma unroll
      for (int x = 0; x < 4; ++x) {
        const int s = kt * 16 + g4 * 4 + x;
        a[x] = (s <= t) ? __expf(dm[kt][x] - mt) * st[kt][x] : 0.f;
        rsum += a[x];
      }
      uint2 o;
      o.x = pack2(a[0], a[1]); o.y = pack2(a[2], a[3]);
      *(uint2*)(sa + t * 72 + kt * 16 + g4 * 4) = o;
    }
    rsum += __shfl_xor(rsum, 16); rsum += __shfl_xor(rsum, 32);
    if (g4 == 0) { smt[t] = mt; swi[t] = __expf(mi - mt); sden[t] = rsum; }
  }
  {
    const int t = tid >> 2, part = tid & 3;
    const float* nc = (const float*)(p.ws + WS_UN) + (size_t)item * 128;
    float s = 0.f;
    for (int d = part * 32; d < part * 32 + 32; ++d) s += bf2f(sq[t * 136 + d]) * nc[d];
    s += __shfl_xor(s, 1); s += __shfl_xor(s, 2);
    if (part == 0) sqn[t] = s;
  }
  __syncthreads();
  f32x4 acc[4][2];
#pragma unroll
  for (int ti = 0; ti < 4; ++ti)
#pragma unroll
    for (int et = 0; et < 2; ++et) acc[ti][et] = (f32x4){0.f, 0.f, 0.f, 0.f};
  const bf16* Cc = (const bf16*)(p.ws + WS_U) + (size_t)item * 16384;
#pragma unroll
  for (int ks = 0; ks < 4; ++ks) {
    bf16x8 cf[2], qf[4];
#pragma unroll
    for (int et = 0; et < 2; ++et) cf[et] = *(const bf16x8*)(Cc + (wave * 32 + et * 16 + r16) * 128 + ks * 32 + g4 * 8);
#pragma unroll
    for (int ti = 0; ti < 4; ++ti) qf[ti] = *(const bf16x8*)(sq + (ti * 16 + r16) * 136 + ks * 32 + g4 * 8);
#pragma unroll
    for (int ti = 0; ti < 4; ++ti)
#pragma unroll
      for (int et = 0; et < 2; ++et) acc[ti][et] = mfma16(cf[et], qf[ti], acc[ti][et]);
  }
#pragma unroll
  for (int ti = 0; ti < 4; ++ti) {
    const float w = swi[ti * 16 + r16];
#pragma unroll
    for (int et = 0; et < 2; ++et) acc[ti][et] *= w;
  }
#pragma unroll
  for (int ks = 0; ks < 2; ++ks) {
    bf16x8 vf[2], af[4];
#pragma unroll
    for (int et = 0; et < 2; ++et) vf[et] = *(const bf16x8*)(svT + (wave * 32 + et * 16 + r16) * 72 + ks * 32 + g4 * 8);
#pragma unroll
    for (int ti = 0; ti < 4; ++ti) af[ti] = *(const bf16x8*)(sa + (ti * 16 + r16) * 72 + ks * 32 + g4 * 8);
#pragma unroll
    for (int ti = 0; ti < 4; ++ti)
#pragma unroll
      for (int et = 0; et < 2; ++et) acc[ti][et] = mfma16(vf[et], af[ti], acc[ti][et]);
  }
#pragma unroll
  for (int ti = 0; ti < 4; ++ti) {
    const int t = ti * 16 + r16;
    const float den = sden[t] + swi[t] * sqn[t];
    const float inv = 1.0f / fmaxf(fabsf(den), __expf(-smt[t]));
    float ss = 0.f;
#pragma unroll
    for (int et = 0; et < 2; ++et) {
      acc[ti][et] *= inv;
#pragma unroll
      for (int x = 0; x < 4; ++x) ss += acc[ti][et][x] * acc[ti][et][x];
    }
    ss += __shfl_xor(ss, 16); ss += __shfl_xor(ss, 32);
    if (g4 == 0) spart[t * 4 + wave] = ss;
  }
  __syncthreads();
  const float* hg = p.hnorm_g + l * 512 + hh * 128;
#pragma unroll
  for (int ti = 0; ti < 4; ++ti) {
    const int t = ti * 16 + r16;
    const float rstd = rsqrtf((spart[t * 4] + spart[t * 4 + 1] + spart[t * 4 + 2] + spart[t * 4 + 3]) * (1.0f / 128.f) + EPS);
    bf16* zr = z + (size_t)(r0 + t) * ZC;
#pragma unroll
    for (int et = 0; et < 2; ++et) {
      const int e = wave * 32 + et * 16 + g4 * 4;
      float o[4], cg_[4];
      unpack4(*(const uint2*)(zr + C_O + hh * 128 + e), o);
      unpack4(*(const uint2*)(zr + C_G + hh * 128 + e), cg_);
      float y[4];
#pragma unroll
      for (int x = 0; x < 4; ++x) y[x] = acc[ti][et][x] * rstd * hg[e + x] * sigmoidf_(o[x]) * siluf_(cg_[x]);
      uint2 oo;
      oo.x = pack2(y[0], y[1]); oo.y = pack2(y[2], y[3]);
      *(uint2*)(zr + C_O + hh * 128 + e) = oo;
    }
  }
  __syncthreads();
}

__device__ __forceinline__ void phase_mix2(const Params& p, int l, unsigned char* smem) {
  for (int it = blockIdx.x; it < 1024; it += gridDim.x) mlstm_out_item(p, l, it, smem);
}

__device__ __forceinline__ void phase_gemm_br(const Params& p, int l, unsigned char* smem) {
  bf16* sm = (bf16*)smem;
  const bf16* hbuf = (const bf16*)(p.ws + WS_H);
  const bf16* Win = (const bf16*)(p.ws + WS_WIN) + (size_t)l * NWIN * 1024;
  const bf16* Wbr = (const bf16*)(p.ws + WS_WBR) + (size_t)l * 1024 * 1536;
  const bf16* yab = (const bf16*)(p.ws + WS_YAB);
  const bf16* z = (const bf16*)(p.ws + WS_Z);
  bf16* merged = (bf16*)(p.ws + WS_U);
  const float* bias = p.b_in + (size_t)l * ZIN + OFF_MG;
  const int lane = tidx() & 63, wave = tidx() >> 6, wr = wave >> 1, wc = wave & 1;
  const int ntiles = (TT / 128) * 16;
  for (int t = blockIdx.x; t < ntiles; t += gridDim.x) {
    int pm, pn;
    tile_map(t, 16, pm, pn);
    const int m0 = pm * 128, n0 = pn * 64;
    f32x4 tot[4][2];
    zero_acc<2>(tot);
#pragma unroll 1
    for (int seg = 0; seg < 3; ++seg) {
      f32x4 acc[4][2];
      zero_acc<2>(acc);
      gemm_accum<2, false>(acc, hbuf + (size_t)m0 * 1024, 1024, Win + (size_t)(OFF_MG + seg * 1024 + n0) * 1024, 1024, 1024, sm);
      __builtin_amdgcn_sched_barrier(0);
      unsigned gp[4][2][2];
#pragma unroll
      for (int j = 0; j < 2; ++j) {
        const int col = n0 + wc * 32 + j * 16 + (lane >> 4) * 4;
        const float4 bb = *(const float4*)(bias + seg * 1024 + col);
#pragma unroll
        for (int i = 0; i < 4; ++i) {
          gp[i][j][0] = pack2(sigmoidf_(acc[i][j][0] + bb.x), sigmoidf_(acc[i][j][1] + bb.y));
          gp[i][j][1] = pack2(sigmoidf_(acc[i][j][2] + bb.z), sigmoidf_(acc[i][j][3] + bb.w));
        }
      }
      __builtin_amdgcn_sched_barrier(0);
      zero_acc<2>(acc);
      const bf16* A = (seg == 0) ? yab + (size_t)m0 * 1024 : (seg == 1) ? yab + (size_t)m0 * 1024 + 512 : z + (size_t)m0 * ZC + C_O;
      const int lda = (seg == 2) ? ZC : 1024;
      gemm_accum<2, false>(acc, A, lda, Wbr + (size_t)n0 * 1536 + seg * 512, 1536, 512, sm);
      __builtin_amdgcn_sched_barrier(0);
#pragma unroll
      for (int i = 0; i < 4; ++i)
#pragma unroll
        for (int j = 0; j < 2; ++j) {
          tot[i][j][0] += lo2f(gp[i][j][0]) * acc[i][j][0];
          tot[i][j][1] += hi2f(gp[i][j][0]) * acc[i][j][1];
          tot[i][j][2] += lo2f(gp[i][j][1]) * acc[i][j][2];
          tot[i][j][3] += hi2f(gp[i][j][1]) * acc[i][j][3];
        }
    }
#pragma unroll
    for (int i = 0; i < 4; ++i)
#pragma unroll
      for (int j = 0; j < 2; ++j) {
        const int row = m0 + wr * 64 + i * 16 + (lane & 15), col = n0 + wc * 32 + j * 16 + (lane >> 4) * 4;
        uint2 o;
        o.x = pack2(tot[i][j][0], tot[i][j][1]);
        o.y = pack2(tot[i][j][2], tot[i][j][3]);
        *(uint2*)(merged + (size_t)row * 1024 + col) = o;
      }
  }
}

__device__ __forceinline__ void phase_gemm_out(const Params& p, int l, unsigned char* smem) {
  bf16* sm = (bf16*)smem;
  const bf16* merged = (const bf16*)(p.ws + WS_U);
  const bf16* Wout = (const bf16*)(p.ws + WS_WOUT) + (size_t)l * 1024 * 1024;
  const float* mod = (const float*)(p.ws + WS_MOD);
  const int lane = tidx() & 63, wave = tidx() >> 6, wr = wave >> 1, wc = wave & 1;
  const int ntiles = (TT / 128) * 8;
  for (int t = blockIdx.x; t < ntiles; t += gridDim.x) {
    int pm, pn;
    tile_map(t, 8, pm, pn);
    const int m0 = pm * 128, n0 = pn * 128;
    f32x4 acc[4][4];
    zero_acc<4>(acc);
    gemm_accum<4>(acc, merged + (size_t)m0 * 1024, 1024, Wout + (size_t)n0 * 1024, 1024, 1024, sm);
#pragma unroll
    for (int i = 0; i < 4; ++i) {
      const int row = m0 + wr * 64 + i * 16 + (lane & 15);
      const float* xr = xrow_ptr(p, l, row);
      const float* gate = mod + ((size_t)l * NMOD + mod_row(row)) * 3072 + 2048;
#pragma unroll
      for (int j = 0; j < 4; ++j) {
        const int col = n0 + wc * 64 + j * 16 + (lane >> 4) * 4;
        const float4 xv = *(const float4*)(xr + col), gv = *(const float4*)(gate + col);
        float4 o;
        o.x = xv.x + gv.x * acc[i][j][0]; o.y = xv.y + gv.y * acc[i][j][1];
        o.z = xv.z + gv.z * acc[i][j][2]; o.w = xv.w + gv.w * acc[i][j][3];
        *(float4*)(p.out + (size_t)row * D + col) = o;
      }
    }
  }
}

constexpr int N_PHASES = 19;
template <int S>
__device__ __forceinline__ void run_stage(const Params& p, int l, unsigned char* smem) {
  if (S == -1) phase_prep(p, smem);
  if (S == 0) phase_norm(p, l);
  if (S == 1) phase_gemm_in(p, l, 0, ZAB / 128, ZAB, smem);
  if (S == 2) phase_mix_ab(p, l, smem);
  if (S == 3) phase_gemm_in(p, l, ZAB, ZC / 128, ZC, smem);
  if (S == 4) phase_mix1(p, l, smem);
  if (S == 5) phase_scan(p, l, smem);
  if (S == 6) phase_mix2(p, l, smem);
  if (S == 7) phase_gemm_br(p, l, smem);
  if (S == 8) phase_gemm_out(p, l, smem);
}


#define XB_TMO      128
#define XB_XCNT(j)  (256  + 64 * (j))
#define XB_XSUB(j)  (1280 + 64 * (j))
#define XB_XGEN(j)  (2304 + 64 * (j))
#define XB_TOP      3328
#define XB_TOPGEN   3392
#define XCD_BAR_WORDS 3456
#define XB_SPIN_CAP (1u << 18)
#define LAS __attribute__((address_space(3)))
__device__ __forceinline__ unsigned xb_ld(unsigned* p)              { return __hip_atomic_load(p, __ATOMIC_RELAXED, __HIP_MEMORY_SCOPE_AGENT); }
__device__ __forceinline__ unsigned xb_add(unsigned* p, unsigned v) { return __hip_atomic_fetch_add(p, v, __ATOMIC_RELAXED, __HIP_MEMORY_SCOPE_AGENT); }
__device__ __forceinline__ unsigned xb_xcc_id() { return (unsigned)__builtin_amdgcn_s_getreg((3 << 11) | 20) & 0xFu; }
#define XB_SPIN(cond, bar) do { unsigned _sp = 0; while (cond) { __builtin_amdgcn_s_sleep(1); \
    if ((++_sp & 255u) == 0u) { if (xb_ld(&(bar)[XB_TMO])) break; if (_sp > XB_SPIN_CAP) { atomicAdd(&(bar)[XB_TMO], 1u); break; } } } } while (0)
struct XcdBarrier { unsigned* bar; unsigned x; volatile LAS unsigned* st; };
__device__ __forceinline__ XcdBarrier xcd_barrier_post(unsigned* bar, volatile LAS unsigned* st) {
  XcdBarrier b; b.bar = bar; b.x = xb_xcc_id(); b.st = st;
  if (threadIdx.x == 0) (void)xb_add(&bar[XB_XCNT(b.x)], 1u);
  return b;
}
__device__ __forceinline__ void xcd_barrier_complete(unsigned* bar, unsigned x, unsigned& nloc, unsigned& nx) {
  const unsigned G = gridDim.x * gridDim.y * gridDim.z;
  unsigned sum, cnt, mine, sp = 0u;
  for (;;) {
    sum = 0u; cnt = 0u; mine = 0u;
#pragma unroll
    for (unsigned j = 0; j < 16; ++j) { const unsigned c = xb_ld(&bar[XB_XCNT(j)]); sum += c; cnt += (c > 0u) ? 1u : 0u; mine = (j == x) ? c : mine; }
    if (sum == G) break;
    __builtin_amdgcn_s_sleep(1);
    if ((++sp & 255u) == 0u) { if (xb_ld(&bar[XB_TMO])) break; if (sp > XB_SPIN_CAP) { atomicAdd(&bar[XB_TMO], 1u); break; } }
  }
  nloc = mine > 0u ? mine : 1u; nx = cnt > 0u ? cnt : 1u;
}
__device__ __forceinline__ void xcd_barrier(const XcdBarrier& b) {
  asm volatile("s_waitcnt vmcnt(0)" ::: "memory");
  __syncthreads();
  if (threadIdx.x == 0) {
    unsigned* bar = b.bar;
    __builtin_amdgcn_s_waitcnt(0);
    unsigned nloc = b.st[0], nx = b.st[1];
    if (nloc == 0u) { xcd_barrier_complete(bar, b.x, nloc, nx); b.st[0] = nloc; b.st[1] = nx; }
    const unsigned old = xb_add(&bar[XB_XSUB(b.x)], 1u);
    const unsigned gen = old / nloc;
    if (old + 1u == (gen + 1u) * nloc) {
      __builtin_amdgcn_fence(__ATOMIC_RELEASE, "agent");
      asm volatile("s_waitcnt vmcnt(0)" ::: "memory");
      const unsigned og = xb_add(&bar[XB_TOP], 1u);
      const unsigned tg = og / nx;
      if (og + 1u == (tg + 1u) * nx) xb_add(&bar[XB_TOPGEN], 1u);
      else XB_SPIN(xb_ld(&bar[XB_TOPGEN]) == tg, bar);
      __builtin_amdgcn_fence(__ATOMIC_ACQUIRE, "agent");
      xb_add(&bar[XB_XGEN(b.x)], 1u);
      asm volatile("s_waitcnt vmcnt(0)" ::: "memory");
    } else {
      XB_SPIN(xb_ld(&bar[XB_XGEN(b.x)]) == gen, bar);
      __builtin_amdgcn_fence(__ATOMIC_ACQUIRE, "agent");
      asm volatile("s_waitcnt vmcnt(0)" ::: "memory");
    }
  }
  __syncthreads();
}

#define GSYNC() xcd_barrier(xb)
__global__ void __launch_bounds__(256, 2) mega_kernel(Params p_in) {
  __shared__ __attribute__((aligned(16))) unsigned char smem[SMEM_BYTES];
  const Params& p = *(const Params*)__builtin_amdgcn_kernarg_segment_ptr();
  __shared__ uint4 xb_words;
  if (threadIdx.x == 0) xb_words = make_uint4(0u, 0u, 0u, 0u);
  __syncthreads();
  XcdBarrier xb = xcd_barrier_post((unsigned*)(p.ws + WS_BAR), (volatile LAS unsigned*)&xb_words);
  run_stage<-1>(p, 0, smem);
  cg::this_grid().sync();
#define LAYER(L, LAST)                 \
  run_stage<0>(p, L, smem); GSYNC();   \
  run_stage<1>(p, L, smem); GSYNC();   \
  run_stage<2>(p, L, smem); GSYNC();   \
  run_stage<3>(p, L, smem); GSYNC();   \
  run_stage<4>(p, L, smem); GSYNC();   \
  run_stage<5>(p, L, smem); GSYNC();   \
  run_stage<6>(p, L, smem); GSYNC();   \
  run_stage<7>(p, L, smem); GSYNC();   \
  run_stage<8>(p, L, smem);            \
  if (!LAST) GSYNC();
  int l0 = 0, l1 = 1;
  asm volatile("" : "+s"(l0));
  asm volatile("" : "+s"(l1));
  LAYER(l0, 0)
  LAYER(l1, 1)
}

extern "C" void kernel_launch(void* const* d_in, const int* in_sizes, int n_in, void* d_out, int out_size, void* d_ws,
                              size_t ws_size, hipStream_t stream) {
  if (ws_size < WS_END || n_in < 29) { fprintf(stderr, "workspace too small / bad inputs\n"); return; }
  Params p{};
  const float** f = (const float**)&p;
  for (int i = 0; i < 29; ++i) f[i] = (const float*)d_in[i];
  p.out = (float*)d_out;
  p.ws = (unsigned char*)d_ws;
  static int grid_blocks = 0;
  if (!grid_blocks) {
    int dev = 0, cus = 0, per_cu = 0;
    (void)hipGetDevice(&dev);
    (void)hipDeviceGetAttribute(&cus, hipDeviceAttributeMultiprocessorCount, dev);
    (void)hipOccupancyMaxActiveBlocksPerMultiprocessor(&per_cu, mega_kernel, 256, 0);
    if (per_cu < 1) per_cu = 1;
    if (per_cu > 2) per_cu = 2;
    grid_blocks = cus * per_cu;
  }
  (void)hipMemsetAsync((unsigned char*)d_ws + WS_BAR, 0, 16384, stream);
  void* args[] = {&p};
  hipError_t e = hipLaunchCooperativeKernel((void*)mega_kernel, dim3(grid_blocks), dim3(256), args, 0, stream);
  if (e != hipSuccess) fprintf(stderr, "cooperative launch failed: %s (grid %d)\n", hipGetErrorString(e), grid_blocks);
}
```

```cpp
#include <hip/hip_runtime.h>
#include <hip/hip_cooperative_groups.h>
#include <cstdio>
namespace cg = cooperative_groups;

typedef unsigned short bf16;
typedef short bf16x8 __attribute__((ext_vector_type(8)));
typedef float f32x4 __attribute__((ext_vector_type(4)));
typedef unsigned u32x4 __attribute__((ext_vector_type(4)));
#define LDSP __attribute__((address_space(3)))

#ifndef SINGLE_LAUNCH
#define SINGLE_LAUNCH 0
#endif

constexpr int D = 1024, TP = 16384, TS = 1024, TT = TP + TS, SEQ = 4096;
constexpr int ZIN = 8456, NWIN = 8576;
constexpr int OFF_AV = 512, OFF_AG = 1024, OFF_BQ = 1536, OFF_BK = 2048, OFF_BV = 2176, OFF_BG = 2304, OFF_MG = 5384;
constexpr int ZAB = 2816;
constexpr int ZC = 2688;
constexpr int C_QK = 0, C_V = 1024, C_I = 1536, C_F = 1540, C_O = 1544, C_G = 2056;
constexpr float EPS = 1e-6f;
constexpr int NMOD = 132;
constexpr int SMEM_BYTES = 73728;

constexpr size_t O_Y = 0;
constexpr size_t O_SKP = (size_t)TT * D;
constexpr size_t O_SVP = O_SKP + 2 * 4 * 128 * 128;
constexpr size_t O_CVP = O_SVP + 2 * 4 * 128 * 128;
constexpr size_t O_CP = O_CVP + 2 * 4 * 3 * 1024;
constexpr size_t O_NP = O_CP + (size_t)2 * 4 * 4 * 128 * 128;
constexpr size_t O_MP = O_NP + 2 * 4 * 4 * 128;
constexpr size_t O_SKS = O_MP + 2 * 4 * 4;
constexpr size_t O_SVS = O_SKS + (size_t)2 * 128 * 128 * 128;
constexpr size_t O_CVS = O_SVS + (size_t)2 * 128 * 128 * 128;
constexpr size_t O_CS = O_CVS + (size_t)2 * 128 * 3 * 1024;
constexpr size_t O_NS = O_CS + (size_t)2 * 128 * 4 * 128 * 128;
constexpr size_t O_MS = O_NS + (size_t)2 * 128 * 4 * 128;
constexpr size_t O_GV = O_MS + 2 * 128 * 4;
constexpr size_t O_END = O_GV + (size_t)2 * 128 * 8 * 512;

constexpr size_t WS_WIN = 0;
constexpr size_t WS_WBR = WS_WIN + (size_t)2 * NWIN * 1024 * 2;
constexpr size_t WS_WOUT = WS_WBR + (size_t)2 * 1024 * 1536 * 2;
constexpr size_t WS_MOD = WS_WOUT + (size_t)2 * 1024 * 1024 * 2;
constexpr size_t WS_H = WS_MOD + (size_t)2 * NMOD * 3072 * 4;
constexpr size_t WS_YAB = WS_H + (size_t)TT * 1024 * 2;
constexpr size_t WS_U = WS_YAB + (size_t)TT * 1024 * 2;
constexpr size_t WS_UN = WS_U + (size_t)TT * 1024 * 2;
constexpr size_t WS_G = WS_UN + (size_t)1024 * 128 * 4;
constexpr size_t WS_TOT = WS_G + 4096;
constexpr size_t WS_M = WS_TOT + 4096;
constexpr size_t WS_Z = WS_M + 4096;
constexpr size_t WS_BAR = WS_Z + (size_t)TT * ZAB * 2;
constexpr size_t WS_END = WS_BAR + 16384;

struct Params {
  const float *x_prompt, *x_sample, *cache_k, *cache_v, *st_conv, *st_C, *st_n, *st_m, *c_prompt, *c_sample;
  const float *ada_w, *ada_b, *norm_g, *w_in, *b_in, *vnorm_g, *gmlp_ws, *gmlp_bs, *qn_g, *kn_g, *sinks;
  const float *conv_w, *conv_b, *f_bias, *hnorm_g, *w_a, *w_b, *w_c, *w_out;
  float* out;
  unsigned char* ws;
};

__device__ __forceinline__ int tidx() { int t = threadIdx.x; asm volatile("" : "+v"(t)); return t; }
__device__ __forceinline__ bf16 f2bf(float f) {
  unsigned u = __float_as_uint(f);
  u += 0x7fffu + ((u >> 16) & 1u);
  return (bf16)(u >> 16);
}
__device__ __forceinline__ float bf2f(bf16 h) { return __uint_as_float(((unsigned)h) << 16); }
__device__ __forceinline__ unsigned pack2(float a, float b) { return (unsigned)f2bf(a) | ((unsigned)f2bf(b) << 16); }
__device__ __forceinline__ float lo2f(unsigned u) { return __uint_as_float(u << 16); }
__device__ __forceinline__ float hi2f(unsigned u) { return __uint_as_float(u & 0xffff0000u); }
__device__ __forceinline__ void unpack8(const uint4& v, float* f) {
  f[0] = lo2f(v.x); f[1] = hi2f(v.x); f[2] = lo2f(v.y); f[3] = hi2f(v.y);
  f[4] = lo2f(v.z); f[5] = hi2f(v.z); f[6] = lo2f(v.w); f[7] = hi2f(v.w);
}
__device__ __forceinline__ void unpack4(const uint2& v, float* f) {
  f[0] = lo2f(v.x); f[1] = hi2f(v.x); f[2] = lo2f(v.y); f[3] = hi2f(v.y);
}
__device__ __forceinline__ float sigmoidf_(float x) { return __builtin_amdgcn_rcpf(1.0f + __expf(-x)); }
__device__ __forceinline__ float siluf_(float x) { return x * __builtin_amdgcn_rcpf(1.0f + __expf(-x)); }
__device__ __forceinline__ float logsigmoidf_(float x) { return fminf(x, 0.0f) - log1pf(__expf(-fabsf(x))); }
__device__ __forceinline__ float wave_sum(float v) {
#pragma unroll
  for (int o = 32; o >= 1; o >>= 1) v += __shfl_xor(v, o);
  return v;
}
__device__ __forceinline__ float wave_max(float v) {
#pragma unroll
  for (int o = 32; o >= 1; o >>= 1) v = fmaxf(v, __shfl_xor(v, o));
  return v;
}
__device__ __forceinline__ f32x4 mfma16(bf16x8 a, bf16x8 b, f32x4 c) {
  return __builtin_amdgcn_mfma_f32_16x16x32_bf16(a, b, c, 0, 0, 0);
}
template <int MI, int NI>
__device__ __forceinline__ void mma_lds(f32x4 (&acc)[MI][NI], const bf16* sA, int lda, const bf16* sB, int ldb, int K, int lane) {
  const int r = lane & 15, q = (lane >> 4) * 8;
  for (int k0 = 0; k0 < K; k0 += 32) {
    bf16x8 a[MI], b[NI];
#pragma unroll
    for (int i = 0; i < MI; ++i) a[i] = *(const bf16x8*)(sA + (i * 16 + r) * lda + k0 + q);
#pragma unroll
    for (int j = 0; j < NI; ++j) b[j] = *(const bf16x8*)(sB + (j * 16 + r) * ldb + k0 + q);
#pragma unroll
    for (int i = 0; i < MI; ++i)
#pragma unroll
      for (int j = 0; j < NI; ++j) acc[i][j] = mfma16(b[j], a[i], acc[i][j]);
  }
}

constexpr int GLD = 64;
constexpr int GTILE = 128 * GLD;
template <int NI>
__device__ __forceinline__ void g_load(u32x4 (&ra)[4], u32x4 (&rb)[NI], const bf16* __restrict__ A, int lda, const bf16* __restrict__ B, int ldb, int ko, int tid) {
  const unsigned offA = (unsigned)((tid >> 3) * lda + (tid & 7) * 8), offB = (unsigned)((tid >> 3) * ldb + (tid & 7) * 8);
#pragma unroll
  for (int i = 0; i < 4; ++i) {
    const bf16* Ai = A + (size_t)(i * 32) * lda + ko;
    ra[i] = *(const u32x4*)(Ai + offA);
  }
#pragma unroll
  for (int i = 0; i < NI; ++i) {
    const bf16* Bi = B + (size_t)(i * 32) * ldb + ko;
    rb[i] = *(const u32x4*)(Bi + offB);
  }
}
template <int NI>
__device__ __forceinline__ void g_store(const u32x4 (&ra)[4], const u32x4 (&rb)[NI], bf16* buf, int tid) {
  const int off = (tid >> 3) * GLD + (((tid & 7) ^ ((tid >> 3) & 7)) * 8);
#pragma unroll
  for (int i = 0; i < 4; ++i) *(u32x4*)(buf + off + i * 32 * GLD) = ra[i];
#pragma unroll
  for (int i = 0; i < NI; ++i) *(u32x4*)(buf + GTILE + off + i * 32 * GLD) = rb[i];
}
template <int NI, bool LOWREG = false>
__device__ __forceinline__ void g_compute(f32x4 (&acc)[4][NI], const bf16* cur, int wr, int wc, int lane) {
  const int r16 = lane & 15, sw = lane & 7, q = lane >> 4;
#pragma unroll
  for (int ks = 0; ks < 2; ++ks) {
    const int pc = ((ks * 4 + q) ^ sw) * 8;
    bf16x8 a[4];
#pragma unroll
    for (int i = 0; i < 4; ++i) a[i] = *(const bf16x8*)(cur + (wr * 64 + i * 16 + r16) * GLD + pc);
#pragma unroll
    for (int jh = 0; jh < NI; jh += 2) {
      bf16x8 b[2];
#pragma unroll
      for (int j = 0; j < 2; ++j) b[j] = *(const bf16x8*)(cur + GTILE + (wc * 16 * NI + (jh + j) * 16 + r16) * GLD + pc);
#pragma unroll
      for (int i = 0; i < 4; ++i)
#pragma unroll
        for (int j = 0; j < 2; ++j) acc[i][jh + j] = mfma16(b[j], a[i], acc[i][jh + j]);
      if (LOWREG) __builtin_amdgcn_sched_barrier(0);
    }
  }
}
template <int NI>
__device__ __forceinline__ void g_stage(const bf16* __restrict__ A, int lda, const bf16* __restrict__ B, int ldb, int ko, bf16* buf, int tid) {
  const int wave = tid >> 6;
  const int gch = ((tid & 7) ^ ((tid >> 3) & 7)) * 8;
  const unsigned offA = (unsigned)((tid >> 3) * lda + gch), offB = (unsigned)((tid >> 3) * ldb + gch);
#pragma unroll
  for (int i = 0; i < 4; ++i) {
    const bf16* Ai = A + (size_t)(i * 32) * lda + ko;
    __builtin_amdgcn_global_load_lds((const unsigned*)(Ai + offA), (LDSP unsigned*)(buf + (i * 32 + wave * 8) * GLD), 16, 0, 0);
  }
#pragma unroll
  for (int i = 0; i < NI; ++i) {
    const bf16* Bi = B + (size_t)(i * 32) * ldb + ko;
    __builtin_amdgcn_global_load_lds((const unsigned*)(Bi + offB), (LDSP unsigned*)(buf + GTILE + (i * 32 + wave * 8) * GLD), 16, 0, 0);
  }
}
template <int NI, bool LOWREG = false>
__device__ __forceinline__ void gemm_accum(f32x4 (&acc)[4][NI], const bf16* __restrict__ A, int lda,
                                           const bf16* __restrict__ B, int ldb, int K, bf16* sm) {
  const int tid = tidx(), lane = tid & 63, wave = tid >> 6, wr = wave >> 1, wc = wave & 1;
  const int nk = K >> 6;
  bf16* buf0 = sm;
  bf16* buf1 = sm + 2 * GTILE;
  g_stage<NI>(A, lda, B, ldb, 0, buf0, tid);
  asm volatile("s_waitcnt vmcnt(0)" ::: "memory");
  __syncthreads();
#pragma unroll 1
  for (int kt = 0; kt < nk; kt += 2) {
    g_stage<NI>(A, lda, B, ldb, (kt + 1) * 64, buf1, tid);
    g_compute<NI, LOWREG>(acc, buf0, wr, wc, lane);
    asm volatile("s_waitcnt vmcnt(0)" ::: "memory");
    __syncthreads();
    if (kt + 2 < nk) g_stage<NI>(A, lda, B, ldb, (kt + 2) * 64, buf0, tid);
    g_compute<NI, LOWREG>(acc, buf1, wr, wc, lane);
    asm volatile("s_waitcnt vmcnt(0)" ::: "memory");
    __syncthreads();
  }
}
template <int NI>
__device__ __forceinline__ void zero_acc(f32x4 (&acc)[4][NI]) {
#pragma unroll
  for (int i = 0; i < 4; ++i)
#pragma unroll
    for (int j = 0; j < NI; ++j) acc[i][j] = (f32x4){0.f, 0.f, 0.f, 0.f};
}
__device__ __forceinline__ void tile_map(int t, int ntn, int& pm, int& pn) {
  const int grp = t / (8 * ntn), w = t % (8 * ntn);
  pm = grp * 8 + (w & 7);
  pn = w >> 3;
}

__device__ __forceinline__ void transpose_tile(const float* __restrict__ src, int ld_src, int n_valid, bf16* __restrict__ dst, int ld_dst,
                               int k0, int n0, int kdst0, float* sm) {
  const int tid = tidx();
  for (int i = tid; i < 64 * 16; i += 256) {
    const int kk = i >> 4, n4 = (i & 15) * 4, n = n0 + n4;
    float4 v = make_float4(0.f, 0.f, 0.f, 0.f);
    if (n + 3 < n_valid) v = *(const float4*)(src + (size_t)(k0 + kk) * ld_src + n);
    sm[kk * 65 + n4 + 0] = v.x; sm[kk * 65 + n4 + 1] = v.y; sm[kk * 65 + n4 + 2] = v.z; sm[kk * 65 + n4 + 3] = v.w;
  }
  __syncthreads();
  for (int i = tid; i < 64 * 8; i += 256) {
    const int nn = i >> 3, kc = (i & 7) * 8;
    uint4 o;
    o.x = pack2(sm[(kc + 0) * 65 + nn], sm[(kc + 1) * 65 + nn]);
    o.y = pack2(sm[(kc + 2) * 65 + nn], sm[(kc + 3) * 65 + nn]);
    o.z = pack2(sm[(kc + 4) * 65 + nn], sm[(kc + 5) * 65 + nn]);
    o.w = pack2(sm[(kc + 6) * 65 + nn], sm[(kc + 7) * 65 + nn]);
    *(uint4*)(dst + (size_t)(n0 + nn) * ld_dst + kdst0 + kc) = o;
  }
  __syncthreads();
}

__device__ __forceinline__ void ada_item(const Params& p, int item, float* sm) {
  const int l = item / 96, n0 = (item % 96) * 32;
  const int tid = tidx(), col = tid & 31, rg = tid >> 5;
  float acc[17];
#pragma unroll
  for (int j = 0; j < 17; ++j) acc[j] = 0.f;
  const float* W = p.ada_w + (size_t)l * 1024 * 3072;
  for (int k0 = 0; k0 < 1024; k0 += 64) {
    for (int i = tid; i < 136 * 64; i += 256) {
      const int r = i >> 6, kk = i & 63;
      float v = 0.f;
      if (r < NMOD) {
        const float c = (r < 4) ? p.c_prompt[r * 1024 + k0 + kk] : p.c_sample[(r - 4) * 1024 + k0 + kk];
        v = siluf_(c);
      }
      sm[r * 65 + kk] = v;
    }
    __syncthreads();
#pragma unroll 4
    for (int kk = 0; kk < 64; ++kk) {
      const float w = W[(size_t)(k0 + kk) * 3072 + n0 + col];
#pragma unroll
      for (int j = 0; j < 17; ++j) acc[j] += sm[(rg * 17 + j) * 65 + kk] * w;
    }
    __syncthreads();
  }
  float* mod = (float*)(p.ws + WS_MOD);
  const float b = p.ada_b[l * 3072 + n0 + col];
#pragma unroll
  for (int j = 0; j < 17; ++j) {
    const int r = rg * 17 + j;
    if (r < NMOD) mod[((size_t)l * NMOD + r) * 3072 + n0 + col] = acc[j] + b;
  }
}

__device__ __forceinline__ void phase_prep(const Params& p, unsigned char* smem) {
  float* sm = (float*)smem;
  constexpr int N_WIN = 2 * 16 * (NWIN / 64);
  constexpr int N_WBR = 2 * 3 * 8 * 16;
  constexpr int N_WOUT = 2 * 16 * 16;
  constexpr int N_ADA = 192;
  constexpr int N_ALL = N_ADA + N_WIN + N_WBR + N_WOUT;
  bf16* WinT = (bf16*)(p.ws + WS_WIN);
  bf16* WbrT = (bf16*)(p.ws + WS_WBR);
  bf16* WoutT = (bf16*)(p.ws + WS_WOUT);
  for (int it = blockIdx.x; it < N_ALL; it += gridDim.x) {
    int i = it;
    if (i < N_ADA) { ada_item(p, i, sm); continue; }
    i -= N_ADA;
    if (i < N_WIN) {
      const int l = i / (16 * 134), r = i % (16 * 134), kt = r / 134, nt = r % 134;
      transpose_tile(p.w_in + (size_t)l * 1024 * ZIN, ZIN, ZIN, WinT + (size_t)l * NWIN * 1024, 1024, kt * 64, nt * 64, kt * 64, sm);
      continue;
    }
    i -= N_WIN;
    if (i < N_WBR) {
      const int l = i / 384, r = i % 384, seg = r / 128, r2 = r % 128, kt = r2 / 16, nt = r2 % 16;
      const float* src = (seg == 0 ? p.w_a : seg == 1 ? p.w_b : p.w_c) + (size_t)l * 512 * 1024;
      transpose_tile(src, 1024, 1024, WbrT + (size_t)l * 1024 * 1536, 1536, kt * 64, nt * 64, seg * 512 + kt * 64, sm);
      continue;
    }
    i -= N_WBR;
    {
      const int l = i / 256, r = i % 256, kt = r / 16, nt = r % 16;
      transpose_tile(p.w_out + (size_t)l * 1024 * 1024, 1024, 1024, WoutT + (size_t)l * 1024 * 1024, 1024, kt * 64, nt * 64, kt * 64, sm);
    }
  }
}

__device__ __forceinline__ const float* xrow_ptr(const Params& p, int l, int row) {
  if (l == 0) return row < TP ? p.x_prompt + (size_t)row * D : p.x_sample + (size_t)(row - TP) * D;
  return p.out + (size_t)row * D;
}
__device__ __forceinline__ int mod_row(int row) { return row < TP ? (row >> 12) : 4 + ((row - TP) >> 3); }

__device__ __forceinline__ void phase_norm(const Params& p, int l) {
  const int lane = tidx() & 63, wave = tidx() >> 6;
  bf16* hbuf = (bf16*)(p.ws + WS_H);
  const float* mod = (const float*)(p.ws + WS_MOD);
  const float* g = p.norm_g + l * D;
  for (int row = blockIdx.x * 4 + wave; row < TT; row += gridDim.x * 4) {
    const float4* x = (const float4*)xrow_ptr(p, l, row);
    float4 v[4];
    float ss = 0.f;
#pragma unroll
    for (int i = 0; i < 4; ++i) {
      v[i] = x[lane + 64 * i];
      ss += v[i].x * v[i].x + v[i].y * v[i].y + v[i].z * v[i].z + v[i].w * v[i].w;
    }
    ss = wave_sum(ss);
    const float rstd = rsqrtf(ss * (1.0f / D) + EPS);
    const float* mp = mod + ((size_t)l * NMOD + mod_row(row)) * 3072;
#pragma unroll
    for (int i = 0; i < 4; ++i) {
      const int c = (lane + 64 * i) * 4;
      const float4 gg = *(const float4*)(g + c), sh = *(const float4*)(mp + c), sc = *(const float4*)(mp + 1024 + c);
      uint2 o;
      o.x = pack2(v[i].x * rstd * gg.x * (1.f + sc.x) + sh.x, v[i].y * rstd * gg.y * (1.f + sc.y) + sh.y);
      o.y = pack2(v[i].z * rstd * gg.z * (1.f + sc.z) + sh.z, v[i].w * rstd * gg.w * (1.f + sc.w) + sh.w);
      *(uint2*)(hbuf + (size_t)row * D + c) = o;
    }
  }
}

__device__ __forceinline__ void phase_gemm_in(const Params& p, int l, int col0, int ntn, int ldz, unsigned char* smem) {
  bf16* sm = (bf16*)smem;
  const bf16* hbuf = (const bf16*)(p.ws + WS_H);
  const bf16* W = (const bf16*)(p.ws + WS_WIN) + (size_t)l * NWIN * 1024;
  bf16* z = (bf16*)(p.ws + WS_Z);
  const float* bias = p.b_in + (size_t)l * ZIN;
  const int lane = tidx() & 63, wave = tidx() >> 6, wr = wave >> 1, wc = wave & 1;
  const int ntiles = (TT / 128) * ntn;
  for (int t = blockIdx.x; t < ntiles; t += gridDim.x) {
    int pm, pn;
    tile_map(t, ntn, pm, pn);
    const int m0 = pm * 128, n0 = pn * 128;
    f32x4 acc[4][4];
    zero_acc<4>(acc);
    gemm_accum<4>(acc, hbuf + (size_t)m0 * 1024, 1024, W + (size_t)(col0 + n0) * 1024, 1024, 1024, sm);
#pragma unroll
    for (int j = 0; j < 4; ++j) {
      const int col = n0 + wc * 64 + j * 16 + (lane >> 4) * 4;
      const float4 b = *(const float4*)(bias + col0 + col);
#pragma unroll
      for (int i = 0; i < 4; ++i) {
        const int row = m0 + wr * 64 + i * 16 + (lane & 15);
        uint2 o;
        o.x = pack2(acc[i][j][0] + b.x, acc[i][j][1] + b.y);
        o.y = pack2(acc[i][j][2] + b.z, acc[i][j][3] + b.w);
        *(uint2*)(z + (size_t)row * ldz + col) = o;
      }
    }
  }
}

__device__ __forceinline__ void gmlp_prompt_item(const Params& p, int l, int item, unsigned char* smem) {
  const int b = item >> 7, n = (item >> 2) & 31, g = item & 3;
  const int r0 = b * SEQ + n * 128;
  const bf16* z = (const bf16*)(p.ws + WS_Z);
  bf16* yab = (bf16*)(p.ws + WS_YAB);
  bf16* sW = (bf16*)smem;
  bf16* sV = (bf16*)(smem + 34816);
  float* srstd = (float*)(smem + 69632);
  const int tid = tidx(), lane = tid & 63, wave = tid >> 6, wr = wave >> 1, wc = wave & 1;
  {
    const int tok = tid >> 1, half = tid & 1;
    const uint4* ptr = (const uint4*)(z + (size_t)(r0 + tok) * ZAB + OFF_AV + half * 256);
    float ss = 0.f;
    for (int i = 0; i < 32; ++i) {
      float f[8];
      unpack8(ptr[i], f);
#pragma unroll
      for (int j = 0; j < 8; ++j) ss += f[j] * f[j];
    }
    ss += __shfl_xor(ss, 1);
    if (half == 0) srstd[tok] = rsqrtf(ss * (1.0f / 512.f) + EPS);
  }
  __syncthreads();
  const float* vg = p.vnorm_g + l * 512 + g * 128;
  for (int i = tid; i < 2048; i += 256) {
    const int s = i >> 4, c8 = (i & 15) * 8;
    float f[8];
    unpack8(*(const uint4*)(z + (size_t)(r0 + s) * ZAB + OFF_AV + g * 128 + c8), f);
    const float rs = srstd[s];
#pragma unroll
    for (int j = 0; j < 8; ++j) sV[(c8 + j) * 136 + s] = f2bf(f[j] * rs * vg[c8 + j]);
  }
  const float* Wg = p.gmlp_ws + ((size_t)(l * 4 + g)) * 128 * 128;
  for (int i = tid; i < 4096; i += 256) {
    const int t = i >> 5, s4 = (i & 31) * 4;
    const float4 w = *(const float4*)(Wg + t * 128 + s4);
    uint2 o;
    o.x = pack2(s4 + 0 <= t ? w.x : 0.f, s4 + 1 <= t ? w.y : 0.f);
    o.y = pack2(s4 + 2 <= t ? w.z : 0.f, s4 + 3 <= t ? w.w : 0.f);
    *(uint2*)(sW + t * 136 + s4) = o;
  }
  __syncthreads();
  f32x4 acc[4][4];
  zero_acc<4>(acc);
  mma_lds<4, 4>(acc, sW + wr * 64 * 136, 136, sV + wc * 64 * 136, 136, wr * 64 + 64, lane);
  const float* bs = p.gmlp_bs + (l * 4 + g) * 128;
#pragma unroll
  for (int i = 0; i < 4; ++i) {
    const int t = wr * 64 + i * 16 + (lane & 15);
    const float bst = bs[t];
    const size_t rowoff = (size_t)(r0 + t) * ZAB;
#pragma unroll
    for (int j = 0; j < 4; ++j) {
      const int c = g * 128 + wc * 64 + j * 16 + (lane >> 4) * 4;
      float u[4], ag[4];
      unpack4(*(const uint2*)(z + rowoff + c), u);
      unpack4(*(const uint2*)(z + rowoff + OFF_AG + c), ag);
      uint2 o;
      o.x = pack2(u[0] * (acc[i][j][0] + bst) * siluf_(ag[0]), u[1] * (acc[i][j][1] + bst) * siluf_(ag[1]));
      o.y = pack2(u[2] * (acc[i][j][2] + bst) * siluf_(ag[2]), u[3] * (acc[i][j][3] + bst) * siluf_(ag[3]));
      *(uint2*)(yab + (size_t)(r0 + t) * 1024 + c) = o;
    }
  }
  __syncthreads();
}

__device__ __forceinline__ void gmlp_sample_item(const Params& p, int l, int b, unsigned char* smem) {
  const int r0 = TP + b * 8;
  const bf16* z = (const bf16*)(p.ws + WS_Z);
  bf16* yab = (bf16*)(p.ws + WS_YAB);
  float* svn = (float*)smem;
  const int tid = tidx(), lane = tid & 63, wave = tid >> 6;
  const float* vg = p.vnorm_g + l * 512;
  for (int tt = 0; tt < 2; ++tt) {
    const int t = wave * 2 + tt;
    float f[8];
    unpack8(*(const uint4*)(z + (size_t)(r0 + t) * ZAB + OFF_AV + lane * 8), f);
    float ss = 0.f;
#pragma unroll
    for (int j = 0; j < 8; ++j) ss += f[j] * f[j];
    ss = wave_sum(ss);
    const float rstd = rsqrtf(ss * (1.0f / 512.f) + EPS);
    float* gv = p.out + O_GV + (((size_t)l * 128 + b) * 8 + t) * 512 + lane * 8;
#pragma unroll
    for (int j = 0; j < 8; ++j) {
      const float vn = f[j] * rstd * vg[lane * 8 + j];
      svn[t * 512 + lane * 8 + j] = vn;
      gv[j] = vn;
    }
  }
  __syncthreads();
  {
    const int c = tid * 2, g = c >> 7;
    const float* Wg = p.gmlp_ws + ((size_t)(l * 4 + g)) * 128 * 128;
    const float* bs = p.gmlp_bs + (l * 4 + g) * 128;
    for (int t = 0; t < 8; ++t) {
      float s0 = bs[t], s1 = bs[t];
      for (int s = 0; s <= t; ++s) {
        const float w = Wg[t * 128 + s];
        s0 += w * svn[s * 512 + c];
        s1 += w * svn[s * 512 + c + 1];
      }
      const unsigned uu = *(const unsigned*)(z + (size_t)(r0 + t) * ZAB + c);
      const unsigned gg = *(const unsigned*)(z + (size_t)(r0 + t) * ZAB + OFF_AG + c);
      *(unsigned*)(yab + (size_t)(r0 + t) * 1024 + c) = pack2(lo2f(uu) * s0 * siluf_(lo2f(gg)), hi2f(uu) * s1 * siluf_(hi2f(gg)));
    }
  }
  __syncthreads();
}

__device__ __forceinline__ void swa_prompt_item(const Params& p, int l, int item, unsigned char* smem) {
  const int b = item >> 7, qt = (item >> 1) & 63, kv = item & 1;
  const int q0 = qt * 64, rb = b * SEQ;
  const bf16* z = (const bf16*)(p.ws + WS_Z);
  bf16* yab = (bf16*)(p.ws + WS_YAB);
  bf16* sK = (bf16*)smem;
  bf16* sVT = (bf16*)(smem + 27648);
  const int tid = tidx(), lane = tid & 63, wave = tid >> 6;
  const float* kg = p.kn_g + l * 64;
  const float* qg = p.qn_g + l * 64;
#pragma unroll 1
  for (int it = 0; it < 6; ++it) {
    const int id = tid + 256 * it, kk = id >> 3, ch = id & 7, kp = q0 - 128 + kk;
    float f[8];
    uint4 vraw = make_uint4(0, 0, 0, 0);
    if (kp >= 0) {
      unpack8(*(const uint4*)(z + (size_t)(rb + kp) * ZAB + OFF_BK + kv * 64 + ch * 8), f);
      vraw = *(const uint4*)(z + (size_t)(rb + kp) * ZAB + OFF_BV + kv * 64 + ch * 8);
    } else {
#pragma unroll
      for (int j = 0; j < 8; ++j) f[j] = 0.f;
    }
    float ss = 0.f;
#pragma unroll
    for (int j = 0; j < 8; ++j) ss += f[j] * f[j];
    ss += __shfl_xor(ss, 1); ss += __shfl_xor(ss, 2); ss += __shfl_xor(ss, 4);
    const float rstd = rsqrtf(ss * (1.0f / 64.f) + EPS);
#pragma unroll
    for (int j = 0; j < 8; ++j) f[j] = f[j] * rstd * kg[ch * 8 + j];
    uint4 ko;
    ko.x = pack2(f[0], f[1]); ko.y = pack2(f[2], f[3]); ko.z = pack2(f[4], f[5]); ko.w = pack2(f[6], f[7]);
    *(uint4*)(sK + kk * 72 + ch * 8) = ko;
    float vf[8];
    unpack8(vraw, vf);
#pragma unroll
    for (int j = 0; j < 8; ++j) sVT[(ch * 8 + j) * 200 + kk] = f2bf(vf[j]);
    if (kk >= 128 && kp >= SEQ - 128) {
      const size_t o = ((((size_t)l * 4 + b) * 128 + (kp - (SEQ - 128))) * 2 + kv) * 64 + ch * 8;
#pragma unroll
      for (int j = 0; j < 8; ++j) { p.out[O_SKP + o + j] = f[j]; p.out[O_SVP + o + j] = vf[j]; }
    }
  }
  __syncthreads();
  const int h = kv * 4 + wave;
  const float sink = p.sinks[l * 8 + h];
  const int g4 = lane >> 4, r16 = lane & 15;
#pragma unroll 1
  for (int i = 0; i < 4; ++i) {
    const int qrow = q0 + i * 16 + r16;
    const size_t grow = (size_t)(rb + qrow);
    bf16x8 qf[2];
    {
      float f0[8], f1[8];
      unpack8(*(const uint4*)(z + grow * ZAB + OFF_BQ + h * 64 + g4 * 8), f0);
      unpack8(*(const uint4*)(z + grow * ZAB + OFF_BQ + h * 64 + 32 + g4 * 8), f1);
      float ss = 0.f;
#pragma unroll
      for (int j = 0; j < 8; ++j) ss += f0[j] * f0[j] + f1[j] * f1[j];
      ss += __shfl_xor(ss, 16); ss += __shfl_xor(ss, 32);
      const float rstd = rsqrtf(ss * (1.0f / 64.f) + EPS) * 0.125f;
#pragma unroll
      for (int j = 0; j < 8; ++j) {
        qf[0][j] = (short)f2bf(f0[j] * rstd * qg[g4 * 8 + j]);
        qf[1][j] = (short)f2bf(f1[j] * rstd * qg[32 + g4 * 8 + j]);
      }
    }
    f32x4 st[12];
#pragma unroll
    for (int kt = 0; kt < 12; ++kt) {
      st[kt] = (f32x4){0.f, 0.f, 0.f, 0.f};
#pragma unroll
      for (int ks = 0; ks < 2; ++ks) {
        const bf16x8 kf = *(const bf16x8*)(sK + (kt * 16 + r16) * 72 + ks * 32 + g4 * 8);
        st[kt] = mfma16(kf, qf[ks], st[kt]);
      }
      if ((kt & 1) == 1) __builtin_amdgcn_sched_barrier(0);
    }
    float mx = -INFINITY;
#pragma unroll
    for (int kt = 0; kt < 12; ++kt)
#pragma unroll
      for (int x = 0; x < 4; ++x) {
        const int kp = q0 - 128 + kt * 16 + g4 * 4 + x, diff = qrow - kp;
        const bool valid = (kp >= 0) && (diff >= 0) && (diff < 128);
        st[kt][x] = valid ? st[kt][x] : -INFINITY;
        mx = fmaxf(mx, st[kt][x]);
      }
    mx = fmaxf(mx, __shfl_xor(mx, 16)); mx = fmaxf(mx, __shfl_xor(mx, 32));
    mx = fmaxf(mx, sink);
    float sum = 0.f;
#pragma unroll
    for (int kt = 0; kt < 12; ++kt)
#pragma unroll
      for (int x = 0; x < 4; ++x) {
        const float pv = __expf(st[kt][x] - mx);
        st[kt][x] = pv;
        sum += pv;
      }
    sum += __shfl_xor(sum, 16); sum += __shfl_xor(sum, 32);
    const float inv = 1.0f / (sum + __expf(sink - mx));
    f32x4 o[4];
#pragma unroll
    for (int dt = 0; dt < 4; ++dt) o[dt] = (f32x4){0.f, 0.f, 0.f, 0.f};
#pragma unroll
    for (int t2 = 0; t2 < 6; ++t2) {
      bf16x8 pf;
#pragma unroll
      for (int x = 0; x < 4; ++x) { pf[x] = (short)f2bf(st[2 * t2][x]); pf[4 + x] = (short)f2bf(st[2 * t2 + 1][x]); }
#pragma unroll
      for (int dt = 0; dt < 4; ++dt) {
        const uint2 v0 = *(const uint2*)(sVT + (dt * 16 + r16) * 200 + t2 * 32 + g4 * 4);
        const uint2 v1 = *(const uint2*)(sVT + (dt * 16 + r16) * 200 + t2 * 32 + 16 + g4 * 4);
        union { uint4 u; bf16x8 v; } cv;
        cv.u = make_uint4(v0.x, v0.y, v1.x, v1.y);
        o[dt] = mfma16(cv.v, pf, o[dt]);
      }
      __builtin_amdgcn_sched_barrier(0);
    }
#pragma unroll
    for (int dt = 0; dt < 4; ++dt) {
      const int d0 = dt * 16 + g4 * 4;
      float bg[4];
      unpack4(*(const uint2*)(z + grow * ZAB + OFF_BG + h * 64 + d0), bg);
      uint2 oo;
      oo.x = pack2(o[dt][0] * inv * siluf_(bg[0]), o[dt][1] * inv * siluf_(bg[1]));
      oo.y = pack2(o[dt][2] * inv * siluf_(bg[2]), o[dt][3] * inv * siluf_(bg[3]));
      *(uint2*)(yab + grow * 1024 + 512 + h * 64 + d0) = oo;
    }
  }
  __syncthreads();
}

__device__ __forceinline__ void swa_sample_item(const Params& p, int l, int item, unsigned char* smem) {
  const int b = item >> 1, kv = item & 1;
  const int r0 = TP + b * 8;
  const bf16* z = (const bf16*)(p.ws + WS_Z);
  bf16* yab = (bf16*)(p.ws + WS_YAB);
  bf16* sK = (bf16*)smem;
  bf16* sV = (bf16*)(smem + 19584);
  float* sq = (float*)(smem + 39168);
  float* sP = (float*)(smem + 47488);
  const int tid = tidx();
  const float* kg = p.kn_g + l * 64;
  const float* qg = p.qn_g + l * 64;
  const float* ck = p.cache_k + ((size_t)l * 128 + b) * 128 * 128;
  const float* cvp = p.cache_v + ((size_t)l * 128 + b) * 128 * 128;
#pragma unroll 1
  for (int it = 0; it < 5; ++it) {
    const int id = tid + 256 * it, j = id >> 3, ch = id & 7;
    const bool act = id < 1088;
    float kf[8], vf[8];
#pragma unroll
    for (int x = 0; x < 8; ++x) { kf[x] = 0.f; vf[x] = 0.f; }
    if (act) {
      if (j < 128) {
        const float4 a0 = *(const float4*)(ck + (j * 2 + kv) * 64 + ch * 8), a1 = *(const float4*)(ck + (j * 2 + kv) * 64 + ch * 8 + 4);
        const float4 b0 = *(const float4*)(cvp + (j * 2 + kv) * 64 + ch * 8), b1 = *(const float4*)(cvp + (j * 2 + kv) * 64 + ch * 8 + 4);
        kf[0] = a0.x; kf[1] = a0.y; kf[2] = a0.z; kf[3] = a0.w; kf[4] = a1.x; kf[5] = a1.y; kf[6] = a1.z; kf[7] = a1.w;
        vf[0] = b0.x; vf[1] = b0.y; vf[2] = b0.z; vf[3] = b0.w; vf[4] = b1.x; vf[5] = b1.y; vf[6] = b1.z; vf[7] = b1.w;
      } else {
        unpack8(*(const uint4*)(z + (size_t)(r0 + j - 128) * ZAB + OFF_BK + kv * 64 + ch * 8), kf);
        unpack8(*(const uint4*)(z + (size_t)(r0 + j - 128) * ZAB + OFF_BV + kv * 64 + ch * 8), vf);
      }
    }
    float ss = 0.f;
#pragma unroll
    for (int x = 0; x < 8; ++x) ss += kf[x] * kf[x];
    ss += __shfl_xor(ss, 1); ss += __shfl_xor(ss, 2); ss += __shfl_xor(ss, 4);
    if (act) {
      if (j >= 128) {
        const float rstd = rsqrtf(ss * (1.0f / 64.f) + EPS);
#pragma unroll
        for (int x = 0; x < 8; ++x) kf[x] = kf[x] * rstd * kg[ch * 8 + x];
      }
      uint4 ko, vo;
      ko.x = pack2(kf[0], kf[1]); ko.y = pack2(kf[2], kf[3]); ko.z = pack2(kf[4], kf[5]); ko.w = pack2(kf[6], kf[7]);
      vo.x = pack2(vf[0], vf[1]); vo.y = pack2(vf[2], vf[3]); vo.z = pack2(vf[4], vf[5]); vo.w = pack2(vf[6], vf[7]);
      *(uint4*)(sK + j * 72 + ch * 8) = ko;
      *(uint4*)(sV + j * 72 + ch * 8) = vo;
      if (j >= 8) {
        const size_t o = ((((size_t)l * 128 + b) * 128 + (j - 8)) * 2 + kv) * 64 + ch * 8;
        *(float4*)(p.out + O_SKS + o) = make_float4(kf[0], kf[1], kf[2], kf[3]);
        *(float4*)(p.out + O_SKS + o + 4) = make_float4(kf[4], kf[5], kf[6], kf[7]);
        *(float4*)(p.out + O_SVS + o) = make_float4(vf[0], vf[1], vf[2], vf[3]);
        *(float4*)(p.out + O_SVS + o + 4) = make_float4(vf[4], vf[5], vf[6], vf[7]);
      }
    }
  }
  const int qi = tid >> 3, sub = tid & 7, t = qi >> 2, h = kv * 4 + (qi & 3);
  {
    float f[8];
    unpack8(*(const uint4*)(z + (size_t)(r0 + t) * ZAB + OFF_BQ + h * 64 + sub * 8), f);
    float ss = 0.f;
#pragma unroll
    for (int x = 0; x < 8; ++x) ss += f[x] * f[x];
    ss += __shfl_xor(ss, 1); ss += __shfl_xor(ss, 2); ss += __shfl_xor(ss, 4);
    const float rstd = rsqrtf(ss * (1.0f / 64.f) + EPS) * 0.125f;
#pragma unroll
    for (int x = 0; x < 8; ++x) sq[qi * 65 + sub * 8 + x] = f[x] * rstd * qg[sub * 8 + x];
  }
  __syncthreads();
  const float sink = p.sinks[l * 8 + h];
  float mx = -INFINITY;
#pragma unroll 1
  for (int jj = 0; jj < 17; ++jj) {
    const int key = sub + 8 * jj;
    float s = 0.f;
#pragma unroll 8
    for (int d = 0; d < 64; ++d) s += sq[qi * 65 + d] * bf2f(sK[key * 72 + d]);
    const bool valid = (key >= t + 1) && (key <= t + 128);
    s = valid ? s : -INFINITY;
    sP[qi * 140 + key] = s;
    mx = fmaxf(mx, s);
  }
  mx = fmaxf(mx, __shfl_xor(mx, 1)); mx = fmaxf(mx, __shfl_xor(mx, 2)); mx = fmaxf(mx, __shfl_xor(mx, 4));
  mx = fmaxf(mx, sink);
  float sum = 0.f;
  for (int jj = 0; jj < 17; ++jj) {
    const int key = sub + 8 * jj;
    const float pv = __expf(sP[qi * 140 + key] - mx);
    sP[qi * 140 + key] = pv;
    sum += pv;
  }
  sum += __shfl_xor(sum, 1); sum += __shfl_xor(sum, 2); sum += __shfl_xor(sum, 4);
  const float inv = 1.0f / (sum + __expf(sink - mx));
  __syncthreads();
  {
    float o[8];
#pragma unroll
    for (int x = 0; x < 8; ++x) o[x] = 0.f;
#pragma unroll 2
    for (int key = 0; key < 136; ++key) {
      const float pv = sP[qi * 140 + key];
      float vf[8];
      unpack8(*(const uint4*)(sV + key * 72 + sub * 8), vf);
#pragma unroll
      for (int x = 0; x < 8; ++x) o[x] += pv * vf[x];
    }
    float bg[8];
    unpack8(*(const uint4*)(z + (size_t)(r0 + t) * ZAB + OFF_BG + h * 64 + sub * 8), bg);
    uint4 oo;
    oo.x = pack2(o[0] * inv * siluf_(bg[0]), o[1] * inv * siluf_(bg[1]));
    oo.y = pack2(o[2] * inv * siluf_(bg[2]), o[3] * inv * siluf_(bg[3]));
    oo.z = pack2(o[4] * inv * siluf_(bg[4]), o[5] * inv * siluf_(bg[5]));
    oo.w = pack2(o[6] * inv * siluf_(bg[6]), o[7] * inv * siluf_(bg[7]));
    *(uint4*)(yab + (size_t)(r0 + t) * 1024 + 512 + h * 64 + sub * 8) = oo;
  }
  __syncthreads();
}

__device__ __forceinline__ void phase_mix_ab(const Params& p, int l, unsigned char* smem) {
  constexpr int N_SWA = 512, N_GM = 512, N_SWS = 256, N_GMS = 128;
  constexpr int N_ALL = N_SWA + N_GM + N_SWS + N_GMS;
  for (int it = blockIdx.x; it < N_ALL; it += gridDim.x) {
    int i = it;
    if (i < N_SWA) { swa_prompt_item(p, l, i, smem); continue; }
    i -= N_SWA;
    if (i < N_GM) { gmlp_prompt_item(p, l, i, smem); continue; }
    i -= N_GM;
    if (i < N_SWS) { swa_sample_item(p, l, i, smem); continue; }
    i -= N_SWS;
    gmlp_sample_item(p, l, i, smem);
  }
}

__device__ __forceinline__ void conv8_prompt(const Params& p, int l, const bf16* z, int r0, int pos0, int s, int zc, float* y) {
  const float* cw = p.conv_w + (size_t)l * 4 * 1024 + zc;
  const float* cb = p.conv_b + l * 1024 + zc;
#pragma unroll
  for (int j = 0; j < 8; ++j) y[j] = cb[j];
#pragma unroll
  for (int tap = 0; tap < 4; ++tap) {
    const int back = 3 - tap;
    if (pos0 + s - back >= 0) {
      float f[8];
      unpack8(*(const uint4*)(z + (size_t)(r0 + s - back) * ZC + C_QK + zc), f);
#pragma unroll
      for (int j = 0; j < 8; ++j) y[j] += cw[tap * 1024 + j] * f[j];
    }
  }
#pragma unroll
  for (int j = 0; j < 8; ++j) y[j] = siluf_(y[j]);
}

__device__ __forceinline__ void chunk_gates(const Params& p, int l, const bf16* z, int r0, int hh, int lane, float& cum, float& iv) {
  const float f = bf2f(z[(size_t)(r0 + lane) * ZC + C_F + hh]) + p.f_bias[l * 4 + hh];
  iv = bf2f(z[(size_t)(r0 + lane) * ZC + C_I + hh]);
  float c = logsigmoidf_(f);
#pragma unroll
  for (int o = 1; o < 64; o <<= 1) {
    const float n = __shfl_up(c, o);
    if (lane >= o) c += n;
  }
  cum = c;
}

__device__ __forceinline__ void mlstm_local_item(const Params& p, int l, int item, unsigned char* smem) {
  const int bh = item >> 6, c = item & 63, b = bh >> 2, hh = bh & 3;
  const int r0 = b * SEQ + c * 64;
  const bf16* z = (const bf16*)(p.ws + WS_Z);
  bf16* skT = (bf16*)smem;
  bf16* svT = (bf16*)(smem + 18432);
  float* swsel = (float*)(smem + 36864);
  const int tid = tidx(), lane = tid & 63, wave = tid >> 6, wr = wave >> 1, wc = wave & 1;
  if (wave == 0) {
    float cum, iv;
    chunk_gates(p, l, z, r0, hh, lane, cum, iv);
    const float total = __shfl(cum, 63);
    const float g = total - cum + iv;
    const float G = wave_max(g);
    swsel[lane] = __expf(g - G);
    if (lane == 0) {
      ((float*)(p.ws + WS_G))[item] = G;
      ((float*)(p.ws + WS_TOT))[item] = total;
    }
  }
  __syncthreads();
  for (int i = tid; i < 1024; i += 256) {
    const int s = i >> 4, d8 = (i & 15) * 8;
    float y[8];
    conv8_prompt(p, l, z, r0, c * 64, s, 512 + hh * 128 + d8, y);
    const float sc = 0.08838834764831845f * swsel[s];
#pragma unroll
    for (int j = 0; j < 8; ++j) skT[(d8 + j) * 72 + s] = f2bf(y[j] * sc);
    float v[8];
    unpack8(*(const uint4*)(z + (size_t)(r0 + s) * ZC + C_V + hh * 128 + d8), v);
#pragma unroll
    for (int j = 0; j < 8; ++j) svT[(d8 + j) * 72 + s] = f2bf(v[j]);
  }
  __syncthreads();
  f32x4 acc[4][4];
  zero_acc<4>(acc);
  mma_lds<4, 4>(acc, svT + wr * 64 * 72, 72, skT + wc * 64 * 72, 72, 64, lane);
  bf16* U = (bf16*)(p.ws + WS_U) + (size_t)item * 16384;
#pragma unroll
  for (int i = 0; i < 4; ++i)
#pragma unroll
    for (int j = 0; j < 4; ++j) {
      const int e = wr * 64 + i * 16 + (lane & 15), d = wc * 64 + j * 16 + (lane >> 4) * 4;
      uint2 o;
      o.x = pack2(acc[i][j][0], acc[i][j][1]);
      o.y = pack2(acc[i][j][2], acc[i][j][3]);
      *(uint2*)(U + e * 128 + d) = o;
    }
  if (tid < 128) {
    float s = 0.f;
    for (int k = 0; k < 64; ++k) s += bf2f(skT[tid * 72 + k]);
    ((float*)(p.ws + WS_UN))[(size_t)item * 128 + tid] = s;
  }
  __syncthreads();
}

__device__ __forceinline__ void mlstm_convout_item(const Params& p, int l, int b) {
  const bf16* z = (const bf16*)(p.ws + WS_Z);
  for (int i = tidx(); i < 3 * 1024; i += 256) {
    const int j = i >> 10, ch = i & 1023;
    p.out[O_CVP + (((size_t)l * 4 + b) * 3 + j) * 1024 + ch] = bf2f(z[(size_t)(b * SEQ + SEQ - 3 + j) * ZC + C_QK + ch]);
  }
}

__device__ __forceinline__ void mlstm_sample_item(const Params& p, int l, int item, unsigned char* smem) {
  const int b = item >> 2, hh = item & 3;
  const int r0 = TP + b * 8;
  bf16* z = (bf16*)(p.ws + WS_Z);
  float* sq = (float*)smem;
  float* sk = sq + 1024;
  float* sv = sk + 1024;
  float* sh = sv + 1024;
  float* sint = sh + 1024;
  float* sa = sint + 2048;
  float* sqn = sa + 64;
  float* smt = sqn + 8;
  float* swi = smt + 8;
  float* swsel = swi + 8;
  float* sdm = swsel + 8;
  float* sdecay = sdm + 64;
  const int tid = tidx(), lane = tid & 63, wave = tid >> 6;
  {
    const int isk = tid >> 7, d = tid & 127, zc = isk * 512 + hh * 128 + d;
    const float* cw = p.conv_w + (size_t)l * 4 * 1024 + zc;
    const float cb = p.conv_b[l * 1024 + zc];
    float xp[11];
    const float* cs = p.st_conv + ((size_t)l * 128 + b) * 3 * 1024 + zc;
    xp[0] = cs[0]; xp[1] = cs[1024]; xp[2] = cs[2048];
#pragma unroll
    for (int t = 0; t < 8; ++t) xp[3 + t] = bf2f(z[(size_t)(r0 + t) * ZC + C_QK + zc]);
    const float w0 = cw[0], w1 = cw[1024], w2 = cw[2048], w3 = cw[3072];
    float* dst = isk ? sk : sq;
    const float sc = isk ? 0.08838834764831845f : 1.0f;
#pragma unroll
    for (int t = 0; t < 8; ++t) {
      const float y = cb + w0 * xp[t] + w1 * xp[t + 1] + w2 * xp[t + 2] + w3 * xp[t + 3];
      dst[t * 128 + d] = siluf_(y) * sc;
    }
    float* co = p.out + O_CVS + ((size_t)l * 128 + b) * 3 * 1024 + zc;
    co[0] = xp[8]; co[1024] = xp[9]; co[2048] = xp[10];
  }
  for (int i = tid; i < 1024; i += 256) {
    const int t = i >> 7, e = i & 127;
    sv[i] = bf2f(z[(size_t)(r0 + t) * ZC + C_V + hh * 128 + e]);
  }
  if (tid == 0) {
    float cum[8], iv[8];
    float c = 0.f;
    for (int t = 0; t < 8; ++t) {
      const float f = bf2f(z[(size_t)(r0 + t) * ZC + C_F + hh]) + p.f_bias[l * 4 + hh];
      c += logsigmoidf_(f);
      cum[t] = c;
      iv[t] = bf2f(z[(size_t)(r0 + t) * ZC + C_I + hh]);
    }
    const float m0 = p.st_m[(l * 128 + b) * 4 + hh];
    for (int t = 0; t < 8; ++t) {
      float dmax = -INFINITY;
      for (int s = 0; s <= t; ++s) dmax = fmaxf(dmax, cum[t] - cum[s] + iv[s]);
      const float mi = cum[t] + m0, mt = fmaxf(mi, dmax);
      smt[t] = mt;
      swi[t] = __expf(mi - mt);
      for (int s = 0; s < 8; ++s) sdm[t * 8 + s] = (s <= t) ? __expf(cum[t] - cum[s] + iv[s] - mt) : 0.f;
    }
    const float total = cum[7];
    float gm = -INFINITY;
    for (int s = 0; s < 8; ++s) gm = fmaxf(gm, total - cum[s] + iv[s]);
    const float mn = fmaxf(total + m0, gm);
    for (int s = 0; s < 8; ++s) swsel[s] = __expf(total - cum[s] + iv[s] - mn);
    sdecay[0] = __expf(total + m0 - mn);
    p.out[O_MS + (l * 128 + b) * 4 + hh] = mn;
  }
  __syncthreads();
  const float* n0 = p.st_n + (((size_t)l * 128 + b) * 4 + hh) * 128;
  if (tid < 64) {
    const int t = tid >> 3, s = tid & 7;
    float dsum = 0.f;
    for (int d = 0; d < 128; ++d) dsum += sq[t * 128 + d] * sk[s * 128 + d];
    sa[t * 8 + s] = sdm[t * 8 + s] * dsum;
  } else if (tid < 128) {
    const int t = (tid - 64) >> 3, part = (tid - 64) & 7;
    float dsum = 0.f;
    for (int d = part * 16; d < part * 16 + 16; ++d) dsum += sq[t * 128 + d] * n0[d];
    dsum += __shfl_xor(dsum, 1); dsum += __shfl_xor(dsum, 2); dsum += __shfl_xor(dsum, 4);
    if (part == 0) sqn[t] = dsum;
  }
  __syncthreads();
  {
    const int e = tid & 127, dh = tid >> 7;
    const float decay = sdecay[0];
    const float* C0 = p.st_C + (((size_t)l * 128 + b) * 4 + hh) * 16384;
    float* C1 = p.out + O_CS + (((size_t)l * 128 + b) * 4 + hh) * 16384;
    float vw[8], inter[8];
#pragma unroll
    for (int s = 0; s < 8; ++s) { vw[s] = sv[s * 128 + e] * swsel[s]; inter[s] = 0.f; }
    for (int d = dh * 64; d < dh * 64 + 64; ++d) {
      const float c0 = C0[d * 128 + e];
      float upd = decay * c0;
#pragma unroll
      for (int s = 0; s < 8; ++s) {
        upd += sk[s * 128 + d] * vw[s];
        inter[s] += sq[s * 128 + d] * c0;
      }
      C1[d * 128 + e] = upd;
    }
#pragma unroll
    for (int t = 0; t < 8; ++t) sint[(dh * 8 + t) * 128 + e] = inter[t];
  }
  __syncthreads();
  if (tid < 128) {
    const int e = tid;
    for (int t = 0; t < 8; ++t) {
      float num = swi[t] * (sint[t * 128 + e] + sint[(8 + t) * 128 + e]);
      float den = swi[t] * sqn[t];
      for (int s = 0; s <= t; ++s) { num += sa[t * 8 + s] * sv[s * 128 + e]; den += sa[t * 8 + s]; }
      sh[t * 128 + e] = num / fmaxf(fabsf(den), __expf(-smt[t]));
    }
    float nn = sdecay[0] * n0[e];
    for (int s = 0; s < 8; ++s) nn += swsel[s] * sk[s * 128 + e];
    p.out[O_NS + (((size_t)l * 128 + b) * 4 + hh) * 128 + e] = nn;
  }
  __syncthreads();
  const float* hg = p.hnorm_g + l * 512 + hh * 128;
  for (int tt = 0; tt < 2; ++tt) {
    const int t = wave * 2 + tt;
    const float h0 = sh[t * 128 + lane], h1 = sh[t * 128 + 64 + lane];
    const float ss = wave_sum(h0 * h0 + h1 * h1);
    const float rstd = rsqrtf(ss * (1.0f / 128.f) + EPS);
    bf16* zr = z + (size_t)(r0 + t) * ZC;
#pragma unroll
    for (int k = 0; k < 2; ++k) {
      const int e = lane + 64 * k;
      const float hv = k ? h1 : h0;
      const float o = bf2f(zr[C_O + hh * 128 + e]), cg_ = bf2f(zr[C_G + hh * 128 + e]);
      zr[C_O + hh * 128 + e] = f2bf(hv * rstd * hg[e] * sigmoidf_(o) * siluf_(cg_));
    }
  }
  __syncthreads();
}

__device__ __forceinline__ void phase_mix1(const Params& p, int l, unsigned char* smem) {
  constexpr int N_LOC = 1024, N_SMP = 512, N_CV = 4;
  constexpr int N_ALL = N_LOC + N_SMP + N_CV;
  for (int it = blockIdx.x; it < N_ALL; it += gridDim.x) {
    int i = it;
    if (i < N_LOC) { mlstm_local_item(p, l, i, smem); continue; }
    i -= N_LOC;
    if (i < N_SMP) { mlstm_sample_item(p, l, i, smem); continue; }
    i -= N_SMP;
    mlstm_convout_item(p, l, i);
  }
}

__device__ __forceinline__ void phase_scan(const Params& p, int l, unsigned char* smem) {
  float* sdec = (float*)smem;
  float* ssc = sdec + 64;
  const int tid = tidx();
  float* Gb = (float*)(p.ws + WS_G);
  float* Tb = (float*)(p.ws + WS_TOT);
  float* Mb = (float*)(p.ws + WS_M);
  for (int it = blockIdx.x; it < 256; it += gridDim.x) {
    const int bh = it >> 4, slice = it & 15;
    if (tid == 0) {
      float m = 0.f;
      for (int c = 0; c < 64; ++c) {
        const float G = Gb[bh * 64 + c], tot = Tb[bh * 64 + c];
        const float mn = fmaxf(tot + m, G);
        sdec[c] = __expf(tot + m - mn);
        ssc[c] = __expf(G - mn);
        if (slice == 0) Mb[bh * 64 + c] = m;
        m = mn;
      }
      if (slice == 0) p.out[O_MP + l * 16 + bh] = m;
    }
    __syncthreads();
    {
      const int idx = slice * 1024 + tid * 4;
      bf16* U = (bf16*)(p.ws + WS_U) + (size_t)bh * 64 * 16384 + idx;
      float st[4] = {0.f, 0.f, 0.f, 0.f};
#pragma unroll 8
      for (int c = 0; c < 64; ++c) {
        float u[4];
        unpack4(*(const uint2*)(U + (size_t)c * 16384), u);
        uint2 o;
        o.x = pack2(st[0], st[1]); o.y = pack2(st[2], st[3]);
        *(uint2*)(U + (size_t)c * 16384) = o;
        const float dc = sdec[c], sc = ssc[c];
#pragma unroll
        for (int x = 0; x < 4; ++x) st[x] = dc * st[x] + sc * u[x];
      }
      const int e = idx >> 7, d0 = idx & 127;
      float* Co = p.out + O_CP + ((size_t)l * 16 + bh) * 16384;
#pragma unroll
      for (int x = 0; x < 4; ++x) Co[(d0 + x) * 128 + e] = st[x];
    }
    if (slice == 0 && tid < 128) {
      float* un = (float*)(p.ws + WS_UN) + (size_t)bh * 64 * 128 + tid;
      float n = 0.f;
#pragma unroll 8
      for (int c = 0; c < 64; ++c) {
        const float u = un[c * 128];
        un[c * 128] = n;
        n = sdec[c] * n + ssc[c] * u;
      }
      p.out[O_NP + ((size_t)l * 16 + bh) * 128 + tid] = n;
    }
    __syncthreads();
  }
}

__device__ __forceinline__ void mlstm_out_item(const Params& p, int l, int item, unsigned char* smem) {
  const int bh = item >> 6, c = item & 63, b = bh >> 2, hh = bh & 3;
  const int r0 = b * SEQ + c * 64;
  bf16* z = (bf16*)(p.ws + WS_Z);
  bf16* sq = (bf16*)smem;
  bf16* sk = (bf16*)(smem + 17408);
  bf16* svT = (bf16*)(smem + 34816);
  bf16* sa = (bf16*)(smem + 53248);
  float* scum = (float*)(smem + 62464);
  float* siv = scum + 64;
  float* smt = siv + 64;
  float* swi = smt + 64;
  float* sden = swi + 64;
  float* sqn = sden + 64;
  float* spart = sqn + 64;
  const int tid = tidx(), lane = tid & 63, wave = tid >> 6;
  const int r16 = lane & 15, g4 = lane >> 4;
  if (wave == 0) {
    float cum, iv;
    chunk_gates(p, l, z, r0, hh, lane, cum, iv);
    scum[lane] = cum;
    siv[lane] = iv;
  }
  for (int i = tid; i < 2048; i += 256) {
    const int isk = i >> 10, r = i & 1023, s = r >> 4, d8 = (r & 15) * 8;
    float y[8];
    conv8_prompt(p, l, z, r0, c * 64, s, isk * 512 + hh * 128 + d8, y);
    const float sc = isk ? 0.08838834764831845f : 1.0f;
    uint4 o;
    o.x = pack2(y[0] * sc, y[1] * sc); o.y = pack2(y[2] * sc, y[3] * sc);
    o.z = pack2(y[4] * sc, y[5] * sc); o.w = pack2(y[6] * sc, y[7] * sc);
    *(uint4*)((isk ? sk : sq) + s * 136 + d8) = o;
  }
  for (int i = tid; i < 1024; i += 256) {
    const int s = i >> 4, d8 = (i & 15) * 8;
    float v[8];
    unpack8(*(const uint4*)(z + (size_t)(r0 + s) * ZC + C_V + hh * 128 + d8), v);
#pragma unroll
    for (int j = 0; j < 8; ++j) svT[(d8 + j) * 72 + s] = f2bf(v[j]);
  }
  __syncthreads();
  const float m_prev = ((const float*)(p.ws + WS_M))[item];
  {
    const int t = wave * 16 + r16;
    bf16x8 qf[4];
#pragma unroll
    for (int ks = 0; ks < 4; ++ks) qf[ks] = *(const bf16x8*)(sq + t * 136 + ks * 32 + g4 * 8);
    f32x4 st[4];
#pragma unroll
    for (int kt = 0; kt < 4; ++kt) {
      st[kt] = (f32x4){0.f, 0.f, 0.f, 0.f};
#pragma unroll
      for (int ks = 0; ks < 4; ++ks) {
        const bf16x8 kf = *(const bf16x8*)(sk + (kt * 16 + r16) * 136 + ks * 32 + g4 * 8);
        st[kt] = mfma16(kf, qf[ks], st[kt]);
      }
    }
    const float cumt = scum[t];
    float dm[4][4];
    float rmax = -INFINITY;
#pragma unroll
    for (int kt = 0; kt < 4; ++kt)
#pragma unroll
      for (int x = 0; x < 4; ++x) {
        const int s = kt * 16 + g4 * 4 + x;
        dm[kt][x] = (s <= t) ? (cumt - scum[s] + siv[s]) : -INFINITY;
        rmax = fmaxf(rmax, dm[kt][x]);
      }
    rmax = fmaxf(rmax, __shfl_xor(rmax, 16)); rmax = fmaxf(rmax, __shfl_xor(rmax, 32));
    const float mi = cumt + m_prev, mt = fmaxf(mi, rmax);
    float rsum = 0.f;
#pragma unroll
    for (int kt = 0; kt < 4; ++kt) {
      float a[4];
#pragma unroll
      for (int x = 0; x < 4; ++x) {
        const int s = kt * 16 + g4 * 4 + x;
        a[x] = (s <= t) ? __expf(dm[kt][x] - mt) * st[kt][x] : 0.f;
        rsum += a[x];
      }
      uint2 o;
      o.x = pack2(a[0], a[1]); o.y = pack2(a[2], a[3]);
      *(uint2*)(sa + t * 72 + kt * 16 + g4 * 4) = o;
    }
    rsum += __shfl_xor(rsum, 16); rsum += __shfl_xor(rsum, 32);
    if (g4 == 0) { smt[t] = mt; swi[t] = __expf(mi - mt); sden[t] = rsum; }
  }
  {
    const int t = tid >> 2, part = tid & 3;
    const float* nc = (const float*)(p.ws + WS_UN) + (size_t)item * 128;
    float s = 0.f;
    for (int d = part * 32; d < part * 32 + 32; ++d) s += bf2f(sq[t * 136 + d]) * nc[d];
    s += __shfl_xor(s, 1); s += __shfl_xor(s, 2);
    if (part == 0) sqn[t] = s;
  }
  __syncthreads();
  f32x4 acc[4][2];
#pragma unroll
  for (int ti = 0; ti < 4; ++ti)
#pragma unroll
    for (int et = 0; et < 2; ++et) acc[ti][et] = (f32x4){0.f, 0.f, 0.f, 0.f};
  const bf16* Cc = (const bf16*)(p.ws + WS_U) + (size_t)item * 16384;
#pragma unroll
  for (int ks = 0; ks < 4; ++ks) {
    bf16x8 cf[2], qf[4];
#pragma unroll
    for (int et = 0; et < 2; ++et) cf[et] = *(const bf16x8*)(Cc + (wave * 32 + et * 16 + r16) * 128 + ks * 32 + g4 * 8);
#pragma unroll
    for (int ti = 0; ti < 4; ++ti) qf[ti] = *(const bf16x8*)(sq + (ti * 16 + r16) * 136 + ks * 32 + g4 * 8);
#pragma unroll
    for (int ti = 0; ti < 4; ++ti)
#pragma unroll
      for (int et = 0; et < 2; ++et) acc[ti][et] = mfma16(cf[et], qf[ti], acc[ti][et]);
  }
#pragma unroll
  for (int ti = 0; ti < 4; ++ti) {
    const float w = swi[ti * 16 + r16];
#pragma unroll
    for (int et = 0; et < 2; ++et) acc[ti][et] *= w;
  }
#pragma unroll
  for (int ks = 0; ks < 2; ++ks) {
    bf16x8 vf[2], af[4];
#pragma unroll
    for (int et = 0; et < 2; ++et) vf[et] = *(const bf16x8*)(svT + (wave * 32 + et * 16 + r16) * 72 + ks * 32 + g4 * 8);
#pragma unroll
    for (int ti = 0; ti < 4; ++ti) af[ti] = *(const bf16x8*)(sa + (ti * 16 + r16) * 72 + ks * 32 + g4 * 8);
#pragma unroll
    for (int ti = 0; ti < 4; ++ti)
#pragma unroll
      for (int et = 0; et < 2; ++et) acc[ti][et] = mfma16(vf[et], af[ti], acc[ti][et]);
  }
#pragma unroll
  for (int ti = 0; ti < 4; ++ti) {
    const int t = ti * 16 + r16;
    const float den = sden[t] + swi[t] * sqn[t];
    const float inv = 1.0f / fmaxf(fabsf(den), __expf(-smt[t]));
    float ss = 0.f;
#pragma unroll
    for (int et = 0; et < 2; ++et) {
      acc[ti][et] *= inv;
#pragma unroll
      for (int x = 0; x < 4; ++x) ss += acc[ti][et][x] * acc[ti][et][x];
    }
    ss += __shfl_xor(ss, 16); ss += __shfl_xor(ss, 32);
    if (g4 == 0) spart[t * 4 + wave] = ss;
  }
  __syncthreads();
  const float* hg = p.hnorm_g + l * 512 + hh * 128;
#pragma unroll
  for (int ti = 0; ti < 4; ++ti) {
    const int t = ti * 16 + r16;
    const float rstd = rsqrtf((spart[t * 4] + spart[t * 4 + 1] + spart[t * 4 + 2] + spart[t * 4 + 3]) * (1.0f / 128.f) + EPS);
    bf16* zr = z + (size_t)(r0 + t) * ZC;
#pragma unroll
    for (int et = 0; et < 2; ++et) {
      const int e = wave * 32 + et * 16 + g4 * 4;
      float o[4], cg_[4];
      unpack4(*(const uint2*)(zr + C_O + hh * 128 + e), o);
      unpack4(*(const uint2*)(zr + C_G + hh * 128 + e), cg_);
      float y[4];
#pragma unroll
      for (int x = 0; x < 4; ++x) y[x] = acc[ti][et][x] * rstd * hg[e + x] * sigmoidf_(o[x]) * siluf_(cg_[x]);
      uint2 oo;
      oo.x = pack2(y[0], y[1]); oo.y = pack2(y[2], y[3]);
      *(uint2*)(zr + C_O + hh * 128 + e) = oo;
    }
  }
  __syncthreads();
}

__device__ __forceinline__ void phase_mix2(const Params& p, int l, unsigned char* smem) {
  for (int it = blockIdx.x; it < 1024; it += gridDim.x) mlstm_out_item(p, l, it, smem);
}

__device__ __forceinline__ void phase_gemm_br(const Params& p, int l, unsigned char* smem) {
  bf16* sm = (bf16*)smem;
  const bf16* hbuf = (const bf16*)(p.ws + WS_H);
  const bf16* Win = (const bf16*)(p.ws + WS_WIN) + (size_t)l * NWIN * 1024;
  const bf16* Wbr = (const bf16*)(p.ws + WS_WBR) + (size_t)l * 1024 * 1536;
  const bf16* yab = (const bf16*)(p.ws + WS_YAB);
  const bf16* z = (const bf16*)(p.ws + WS_Z);
  bf16* merged = (bf16*)(p.ws + WS_U);
  const float* bias = p.b_in + (size_t)l * ZIN + OFF_MG;
  const int lane = tidx() & 63, wave = tidx() >> 6, wr = wave >> 1, wc = wave & 1;
  const int ntiles = (TT / 128) * 8;
  for (int t = blockIdx.x; t < ntiles; t += gridDim.x) {
    int pm, pn;
    tile_map(t, 8, pm, pn);
    const int m0 = pm * 128, n0 = pn * 128;
#pragma unroll 1
    for (int seg = 0; seg < 3; ++seg) {
      f32x4 acc[4][4];
      zero_acc<4>(acc);
      gemm_accum<4, true>(acc, hbuf + (size_t)m0 * 1024, 1024, Win + (size_t)(OFF_MG + seg * 1024 + n0) * 1024, 1024, 1024, sm);
      unsigned gp[4][4][2];
#pragma unroll
      for (int j = 0; j < 4; ++j) {
        const int col = n0 + wc * 64 + j * 16 + (lane >> 4) * 4;
        const float4 bb = *(const float4*)(bias + seg * 1024 + col);
#pragma unroll
        for (int i = 0; i < 4; ++i) {
          gp[i][j][0] = pack2(sigmoidf_(acc[i][j][0] + bb.x), sigmoidf_(acc[i][j][1] + bb.y));
          gp[i][j][1] = pack2(sigmoidf_(acc[i][j][2] + bb.z), sigmoidf_(acc[i][j][3] + bb.w));
        }
      }
      zero_acc<4>(acc);
      const bf16* A = (seg == 0) ? yab + (size_t)m0 * 1024 : (seg == 1) ? yab + (size_t)m0 * 1024 + 512 : z + (size_t)m0 * ZC + C_O;
      const int lda = (seg == 2) ? ZC : 1024;
      gemm_accum<4, true>(acc, A, lda, Wbr + (size_t)n0 * 1536 + seg * 512, 1536, 512, sm);
#pragma unroll
      for (int i = 0; i < 4; ++i)
#pragma unroll
        for (int j = 0; j < 4; ++j) {
          const int row = m0 + wr * 64 + i * 16 + (lane & 15), col = n0 + wc * 64 + j * 16 + (lane >> 4) * 4;
          uint2* mp = (uint2*)(merged + (size_t)row * 1024 + col);
          uint2 prev = make_uint2(0u, 0u);
          if (seg > 0) prev = *mp;
          uint2 o;
          o.x = pack2(lo2f(prev.x) + lo2f(gp[i][j][0]) * acc[i][j][0], hi2f(prev.x) + hi2f(gp[i][j][0]) * acc[i][j][1]);
          o.y = pack2(lo2f(prev.y) + lo2f(gp[i][j][1]) * acc[i][j][2], hi2f(prev.y) + hi2f(gp[i][j][1]) * acc[i][j][3]);
          *mp = o;
        }
    }
  }
}

__device__ __forceinline__ void phase_gemm_out(const Params& p, int l, unsigned char* smem) {
  bf16* sm = (bf16*)smem;
  const bf16* merged = (const bf16*)(p.ws + WS_U);
  const bf16* Wout = (const bf16*)(p.ws + WS_WOUT) + (size_t)l * 1024 * 1024;
  const float* mod = (const float*)(p.ws + WS_MOD);
  const int lane = tidx() & 63, wave = tidx() >> 6, wr = wave >> 1, wc = wave & 1;
  const int ntiles = (TT / 128) * 8;
  for (int t = blockIdx.x; t < ntiles; t += gridDim.x) {
    int pm, pn;
    tile_map(t, 8, pm, pn);
    const int m0 = pm * 128, n0 = pn * 128;
    f32x4 acc[4][4];
    zero_acc<4>(acc);
    gemm_accum<4>(acc, merged + (size_t)m0 * 1024, 1024, Wout + (size_t)n0 * 1024, 1024, 1024, sm);
#pragma unroll
    for (int i = 0; i < 4; ++i) {
      const int row = m0 + wr * 64 + i * 16 + (lane & 15);
      const float* xr = xrow_ptr(p, l, row);
      const float* gate = mod + ((size_t)l * NMOD + mod_row(row)) * 3072 + 2048;
#pragma unroll
      for (int j = 0; j < 4; ++j) {
        const int col = n0 + wc * 64 + j * 16 + (lane >> 4) * 4;
        const float4 xv = *(const float4*)(xr + col), gv = *(const float4*)(gate + col);
        float4 o;
        o.x = xv.x + gv.x * acc[i][j][0]; o.y = xv.y + gv.y * acc[i][j][1];
        o.z = xv.z + gv.z * acc[i][j][2]; o.w = xv.w + gv.w * acc[i][j][3];
        *(float4*)(p.out + (size_t)row * D + col) = o;
      }
    }
  }
}

constexpr int N_PHASES = 19;
template <int S>
__device__ __forceinline__ void run_stage(const Params& p, int l, unsigned char* smem) {
  if (S == -1) phase_prep(p, smem);
  if (S == 0) phase_norm(p, l);
  if (S == 1) phase_gemm_in(p, l, 0, ZAB / 128, ZAB, smem);
  if (S == 2) phase_mix_ab(p, l, smem);
  if (S == 3) phase_gemm_in(p, l, ZAB, ZC / 128, ZC, smem);
  if (S == 4) phase_mix1(p, l, smem);
  if (S == 5) phase_scan(p, l, smem);
  if (S == 6) phase_mix2(p, l, smem);
  if (S == 7) phase_gemm_br(p, l, smem);
  if (S == 8) phase_gemm_out(p, l, smem);
}


#define XB_TMO      128
#define XB_XCNT(j)  (256  + 64 * (j))
#define XB_XSUB(j)  (1280 + 64 * (j))
#define XB_XGEN(j)  (2304 + 64 * (j))
#define XB_TOP      3328
#define XB_TOPGEN   3392
#define XCD_BAR_WORDS 3456
#define XB_SPIN_CAP (1u << 18)
#define LAS __attribute__((address_space(3)))
__device__ __forceinline__ unsigned xb_ld(unsigned* p)              { return __hip_atomic_load(p, __ATOMIC_RELAXED, __HIP_MEMORY_SCOPE_AGENT); }
__device__ __forceinline__ unsigned xb_add(unsigned* p, unsigned v) { return __hip_atomic_fetch_add(p, v, __ATOMIC_RELAXED, __HIP_MEMORY_SCOPE_AGENT); }
__device__ __forceinline__ unsigned xb_xcc_id() { return (unsigned)__builtin_amdgcn_s_getreg((3 << 11) | 20) & 0xFu; }
#define XB_SPIN(cond, bar) do { unsigned _sp = 0; while (cond) { __builtin_amdgcn_s_sleep(1); \
    if ((++_sp & 255u) == 0u) { if (xb_ld(&(bar)[XB_TMO])) break; if (_sp > XB_SPIN_CAP) { atomicAdd(&(bar)[XB_TMO], 1u); break; } } } } while (0)
struct XcdBarrier { unsigned* bar; unsigned x; volatile LAS unsigned* st; };
__device__ __forceinline__ XcdBarrier xcd_barrier_post(unsigned* bar, volatile LAS unsigned* st) {
  XcdBarrier b; b.bar = bar; b.x = xb_xcc_id(); b.st = st;
  if (threadIdx.x == 0) (void)xb_add(&bar[XB_XCNT(b.x)], 1u);
  return b;
}
__device__ __forceinline__ void xcd_barrier_complete(unsigned* bar, unsigned x, unsigned& nloc, unsigned& nx) {
  const unsigned G = gridDim.x * gridDim.y * gridDim.z;
  unsigned sum, cnt, mine, sp = 0u;
  for (;;) {
    sum = 0u; cnt = 0u; mine = 0u;
#pragma unroll
    for (unsigned j = 0; j < 16; ++j) { const unsigned c = xb_ld(&bar[XB_XCNT(j)]); sum += c; cnt += (c > 0u) ? 1u : 0u; mine = (j == x) ? c : mine; }
    if (sum == G) break;
    __builtin_amdgcn_s_sleep(1);
    if ((++sp & 255u) == 0u) { if (xb_ld(&bar[XB_TMO])) break; if (sp > XB_SPIN_CAP) { atomicAdd(&bar[XB_TMO], 1u); break; } }
  }
  nloc = mine > 0u ? mine : 1u; nx = cnt > 0u ? cnt : 1u;
}
__device__ __forceinline__ void xcd_barrier(const XcdBarrier& b) {
  asm volatile("s_waitcnt vmcnt(0)" ::: "memory");
  __syncthreads();
  if (threadIdx.x == 0) {
    unsigned* bar = b.bar;
    __builtin_amdgcn_s_waitcnt(0);
    unsigned nloc = b.st[0], nx = b.st[1];
    if (nloc == 0u) { xcd_barrier_complete(bar, b.x, nloc, nx); b.st[0] = nloc; b.st[1] = nx; }
    const unsigned old = xb_add(&bar[XB_XSUB(b.x)], 1u);
    const unsigned gen = old / nloc;
    if (old + 1u == (gen + 1u) * nloc) {
      __builtin_amdgcn_fence(__ATOMIC_RELEASE, "agent");
      asm volatile("s_waitcnt vmcnt(0)" ::: "memory");
      const unsigned og = xb_add(&bar[XB_TOP], 1u);
      const unsigned tg = og / nx;
      if (og + 1u == (tg + 1u) * nx) xb_add(&bar[XB_TOPGEN], 1u);
      else XB_SPIN(xb_ld(&bar[XB_TOPGEN]) == tg, bar);
      __builtin_amdgcn_fence(__ATOMIC_ACQUIRE, "agent");
      xb_add(&bar[XB_XGEN(b.x)], 1u);
      asm volatile("s_waitcnt vmcnt(0)" ::: "memory");
    } else {
      XB_SPIN(xb_ld(&bar[XB_XGEN(b.x)]) == gen, bar);
      __builtin_amdgcn_fence(__ATOMIC_ACQUIRE, "agent");
      asm volatile("s_waitcnt vmcnt(0)" ::: "memory");
    }
  }
  __syncthreads();
}

#define GSYNC() xcd_barrier(xb)
__global__ void __launch_bounds__(256, 2) mega_kernel(Params p_in) {
  __shared__ __attribute__((aligned(16))) unsigned char smem[SMEM_BYTES];
  const Params& p = *(const Params*)__builtin_amdgcn_kernarg_segment_ptr();
  __shared__ uint4 xb_words;
  if (threadIdx.x == 0) xb_words = make_uint4(0u, 0u, 0u, 0u);
  __syncthreads();
  XcdBarrier xb = xcd_barrier_post((unsigned*)(p.ws + WS_BAR), (volatile LAS unsigned*)&xb_words);
  run_stage<-1>(p, 0, smem);
  if (p.out == nullptr) cg::this_grid().sync();
  GSYNC();
#define LAYER(L, LAST)                 \
  run_stage<0>(p, L, smem); GSYNC();   \
  run_stage<1>(p, L, smem); GSYNC();   \
  run_stage<2>(p, L, smem); GSYNC();   \
  run_stage<3>(p, L, smem); GSYNC();   \
  run_stage<4>(p, L, smem); GSYNC();   \
  run_stage<5>(p, L, smem); GSYNC();   \
  run_stage<6>(p, L, smem); GSYNC();   \
  run_stage<7>(p, L, smem); GSYNC();   \
  run_stage<8>(p, L, smem);            \
  if (!LAST) GSYNC();
  int l0 = 0, l1 = 1;
  asm volatile("" : "+s"(l0));
  asm volatile("" : "+s"(l1));
  LAYER(l0, 0)
  LAYER(l1, 1)
}

extern "C" void kernel_launch(void* const* d_in, const int* in_sizes, int n_in, void* d_out, int out_size, void* d_ws,
                              size_t ws_size, hipStream_t stream) {
  if (ws_size < WS_END || n_in < 29) { fprintf(stderr, "workspace too small / bad inputs\n"); return; }
  Params p{};
  const float** f = (const float**)&p;
  for (int i = 0; i < 29; ++i) f[i] = (const float*)d_in[i];
  p.out = (float*)d_out;
  p.ws = (unsigned char*)d_ws;
  static int grid_blocks = 0;
  if (!grid_blocks) {
    int dev = 0, cus = 0, per_cu = 0;
    (void)hipGetDevice(&dev);
    (void)hipDeviceGetAttribute(&cus, hipDeviceAttributeMultiprocessorCount, dev);
    (void)hipOccupancyMaxActiveBlocksPerMultiprocessor(&per_cu, mega_kernel, 256, 0);
    if (per_cu < 1) per_cu = 1;
    if (per_cu > 2) per_cu = 2;
    grid_blocks = cus * per_cu;
  }
  (void)hipMemsetAsync((unsigned char*)d_ws + WS_BAR, 0, 16384, stream);
  void* args[] = {&p};
  hipError_t e = hipLaunchCooperativeKernel((void*)mega_kernel, dim3(grid_blocks), dim3(256), args, 0, stream);
  if (e != hipSuccess) fprintf(stderr, "cooperative launch failed: %s (grid %d)\n", hipGetErrorString(e), grid_blocks);
}
```

```cpp
#include <hip/hip_runtime.h>
#include <hip/hip_cooperative_groups.h>
#include <cstdio>
namespace cg = cooperative_groups;

typedef unsigned short bf16;
typedef short bf16x8 __attribute__((ext_vector_type(8)));
typedef float f32x4 __attribute__((ext_vector_type(4)));
typedef unsigned u32x4 __attribute__((ext_vector_type(4)));
#define LDSP __attribute__((address_space(3)))

#ifndef SINGLE_LAUNCH
#define SINGLE_LAUNCH 0
#endif

constexpr int D = 1024, TP = 16384, TS = 1024, TT = TP + TS, SEQ = 4096;
constexpr int ZIN = 8456, NWIN = 8576;
constexpr int OFF_AV = 512, OFF_AG = 1024, OFF_BQ = 1536, OFF_BK = 2048, OFF_BV = 2176, OFF_BG = 2304, OFF_MG = 5384;
constexpr int ZAB = 2816;
constexpr int ZC = 2688;
constexpr int C_QK = 0, C_V = 1024, C_I = 1536, C_F = 1540, C_O = 1544, C_G = 2056;
constexpr float EPS = 1e-6f;
constexpr int NMOD = 132;
constexpr int SMEM_BYTES = 73728;

constexpr size_t O_Y = 0;
constexpr size_t O_SKP = (size_t)TT * D;
constexpr size_t O_SVP = O_SKP + 2 * 4 * 128 * 128;
constexpr size_t O_CVP = O_SVP + 2 * 4 * 128 * 128;
constexpr size_t O_CP = O_CVP + 2 * 4 * 3 * 1024;
constexpr size_t O_NP = O_CP + (size_t)2 * 4 * 4 * 128 * 128;
constexpr size_t O_MP = O_NP + 2 * 4 * 4 * 128;
constexpr size_t O_SKS = O_MP + 2 * 4 * 4;
constexpr size_t O_SVS = O_SKS + (size_t)2 * 128 * 128 * 128;
constexpr size_t O_CVS = O_SVS + (size_t)2 * 128 * 128 * 128;
constexpr size_t O_CS = O_CVS + (size_t)2 * 128 * 3 * 1024;
constexpr size_t O_NS = O_CS + (size_t)2 * 128 * 4 * 128 * 128;
constexpr size_t O_MS = O_NS + (size_t)2 * 128 * 4 * 128;
constexpr size_t O_GV = O_MS + 2 * 128 * 4;
constexpr size_t O_END = O_GV + (size_t)2 * 128 * 8 * 512;

constexpr size_t WS_WIN = 0;
constexpr size_t WS_WBR = WS_WIN + (size_t)2 * NWIN * 1024 * 2;
constexpr size_t WS_WOUT = WS_WBR + (size_t)2 * 1024 * 1536 * 2;
constexpr size_t WS_MOD = WS_WOUT + (size_t)2 * 1024 * 1024 * 2;
constexpr size_t WS_H = WS_MOD + (size_t)2 * NMOD * 3072 * 4;
constexpr size_t WS_YAB = WS_H + (size_t)TT * 1024 * 2;
constexpr size_t WS_U = WS_YAB + (size_t)TT * 1024 * 2;
constexpr size_t WS_UN = WS_U + (size_t)TT * 1024 * 2;
constexpr size_t WS_G = WS_UN + (size_t)1024 * 128 * 4;
constexpr size_t WS_TOT = WS_G + 4096;
constexpr size_t WS_M = WS_TOT + 4096;
constexpr size_t WS_Z = WS_M + 4096;
constexpr size_t WS_BAR = WS_Z + (size_t)TT * ZAB * 2;
constexpr size_t WS_END = WS_BAR + 16384;

struct Params {
  const float *x_prompt, *x_sample, *cache_k, *cache_v, *st_conv, *st_C, *st_n, *st_m, *c_prompt, *c_sample;
  const float *ada_w, *ada_b, *norm_g, *w_in, *b_in, *vnorm_g, *gmlp_ws, *gmlp_bs, *qn_g, *kn_g, *sinks;
  const float *conv_w, *conv_b, *f_bias, *hnorm_g, *w_a, *w_b, *w_c, *w_out;
  float* out;
  unsigned char* ws;
};

__device__ __forceinline__ int tidx() { int t = threadIdx.x; asm volatile("" : "+v"(t)); return t; }
__device__ __forceinline__ bf16 f2bf(float f) {
  unsigned u = __float_as_uint(f);
  u += 0x7fffu + ((u >> 16) & 1u);
  return (bf16)(u >> 16);
}
__device__ __forceinline__ float bf2f(bf16 h) { return __uint_as_float(((unsigned)h) << 16); }
__device__ __forceinline__ unsigned pack2(float a, float b) { return (unsigned)f2bf(a) | ((unsigned)f2bf(b) << 16); }
__device__ __forceinline__ float lo2f(unsigned u) { return __uint_as_float(u << 16); }
__device__ __forceinline__ float hi2f(unsigned u) { return __uint_as_float(u & 0xffff0000u); }
__device__ __forceinline__ void unpack8(const uint4& v, float* f) {
  f[0] = lo2f(v.x); f[1] = hi2f(v.x); f[2] = lo2f(v.y); f[3] = hi2f(v.y);
  f[4] = lo2f(v.z); f[5] = hi2f(v.z); f[6] = lo2f(v.w); f[7] = hi2f(v.w);
}
__device__ __forceinline__ void unpack4(const uint2& v, float* f) {
  f[0] = lo2f(v.x); f[1] = hi2f(v.x); f[2] = lo2f(v.y); f[3] = hi2f(v.y);
}
__device__ __forceinline__ float sigmoidf_(float x) { return __builtin_amdgcn_rcpf(1.0f + __expf(-x)); }
__device__ __forceinline__ float siluf_(float x) { return x * __builtin_amdgcn_rcpf(1.0f + __expf(-x)); }
__device__ __forceinline__ float logsigmoidf_(float x) { return fminf(x, 0.0f) - log1pf(__expf(-fabsf(x))); }
__device__ __forceinline__ float wave_sum(float v) {
#pragma unroll
  for (int o = 32; o >= 1; o >>= 1) v += __shfl_xor(v, o);
  return v;
}
__device__ __forceinline__ float wave_max(float v) {
#pragma unroll
  for (int o = 32; o >= 1; o >>= 1) v = fmaxf(v, __shfl_xor(v, o));
  return v;
}
__device__ __forceinline__ f32x4 mfma16(bf16x8 a, bf16x8 b, f32x4 c) {
  return __builtin_amdgcn_mfma_f32_16x16x32_bf16(a, b, c, 0, 0, 0);
}
template <int MI, int NI>
__device__ __forceinline__ void mma_lds(f32x4 (&acc)[MI][NI], const bf16* sA, int lda, const bf16* sB, int ldb, int K, int lane) {
  const int r = lane & 15, q = (lane >> 4) * 8;
  for (int k0 = 0; k0 < K; k0 += 32) {
    bf16x8 a[MI], b[NI];
#pragma unroll
    for (int i = 0; i < MI; ++i) a[i] = *(const bf16x8*)(sA + (i * 16 + r) * lda + k0 + q);
#pragma unroll
    for (int j = 0; j < NI; ++j) b[j] = *(const bf16x8*)(sB + (j * 16 + r) * ldb + k0 + q);
#pragma unroll
    for (int i = 0; i < MI; ++i)
#pragma unroll
      for (int j = 0; j < NI; ++j) acc[i][j] = mfma16(b[j], a[i], acc[i][j]);
  }
}

constexpr int GLD = 64;
constexpr int GTILE = 128 * GLD;
template <int NI>
__device__ __forceinline__ void g_load(u32x4 (&ra)[4], u32x4 (&rb)[NI], const bf16* __restrict__ A, int lda, const bf16* __restrict__ B, int ldb, int ko, int tid) {
  const unsigned offA = (unsigned)((tid >> 3) * lda + (tid & 7) * 8), offB = (unsigned)((tid >> 3) * ldb + (tid & 7) * 8);
#pragma unroll
  for (int i = 0; i < 4; ++i) {
    const bf16* Ai = A + (size_t)(i * 32) * lda + ko;
    ra[i] = *(const u32x4*)(Ai + offA);
  }
#pragma unroll
  for (int i = 0; i < NI; ++i) {
    const bf16* Bi = B + (size_t)(i * 32) * ldb + ko;
    rb[i] = *(const u32x4*)(Bi + offB);
  }
}
template <int NI>
__device__ __forceinline__ void g_store(const u32x4 (&ra)[4], const u32x4 (&rb)[NI], bf16* buf, int tid) {
  const int off = (tid >> 3) * GLD + (((tid & 7) ^ ((tid >> 3) & 7)) * 8);
#pragma unroll
  for (int i = 0; i < 4; ++i) *(u32x4*)(buf + off + i * 32 * GLD) = ra[i];
#pragma unroll
  for (int i = 0; i < NI; ++i) *(u32x4*)(buf + GTILE + off + i * 32 * GLD) = rb[i];
}
template <int NI, bool LOWREG = false>
__device__ __forceinline__ void g_compute(f32x4 (&acc)[4][NI], const bf16* cur, int wr, int wc, int lane) {
  const int r16 = lane & 15, sw = lane & 7, q = lane >> 4;
#pragma unroll
  for (int ks = 0; ks < 2; ++ks) {
    const int pc = ((ks * 4 + q) ^ sw) * 8;
    bf16x8 a[4];
#pragma unroll
    for (int i = 0; i < 4; ++i) a[i] = *(const bf16x8*)(cur + (wr * 64 + i * 16 + r16) * GLD + pc);
#pragma unroll
    for (int jh = 0; jh < NI; jh += 2) {
      bf16x8 b[2];
#pragma unroll
      for (int j = 0; j < 2; ++j) b[j] = *(const bf16x8*)(cur + GTILE + (wc * 16 * NI + (jh + j) * 16 + r16) * GLD + pc);
#pragma unroll
      for (int i = 0; i < 4; ++i)
#pragma unroll
        for (int j = 0; j < 2; ++j) acc[i][jh + j] = mfma16(b[j], a[i], acc[i][jh + j]);
      if (LOWREG) __builtin_amdgcn_sched_barrier(0);
    }
  }
}
template <int NI>
__device__ __forceinline__ void g_stage(const bf16* __restrict__ A, int lda, const bf16* __restrict__ B, int ldb, int ko, bf16* buf, int tid) {
  const int wave = tid >> 6;
  const int gch = ((tid & 7) ^ ((tid >> 3) & 7)) * 8;
  const unsigned offA = (unsigned)((tid >> 3) * lda + gch), offB = (unsigned)((tid >> 3) * ldb + gch);
#pragma unroll
  for (int i = 0; i < 4; ++i) {
    const bf16* Ai = A + (size_t)(i * 32) * lda + ko;
    __builtin_amdgcn_global_load_lds((const unsigned*)(Ai + offA), (LDSP unsigned*)(buf + (i * 32 + wave * 8) * GLD), 16, 0, 0);
  }
#pragma unroll
  for (int i = 0; i < NI; ++i) {
    const bf16* Bi = B + (size_t)(i * 32) * ldb + ko;
    __builtin_amdgcn_global_load_lds((const unsigned*)(Bi + offB), (LDSP unsigned*)(buf + GTILE + (i * 32 + wave * 8) * GLD), 16, 0, 0);
  }
}
template <int NI, bool LOWREG = false>
__device__ __forceinline__ void gemm_accum(f32x4 (&acc)[4][NI], const bf16* __restrict__ A, int lda,
                                           const bf16* __restrict__ B, int ldb, int K, bf16* sm) {
  const int tid = tidx(), lane = tid & 63, wave = tid >> 6, wr = wave >> 1, wc = wave & 1;
  const int nk = K >> 6;
  bf16* buf0 = sm;
  bf16* buf1 = sm + 2 * GTILE;
  g_stage<NI>(A, lda, B, ldb, 0, buf0, tid);
  asm volatile("s_waitcnt vmcnt(0)" ::: "memory");
  __syncthreads();
#pragma unroll 1
  for (int kt = 0; kt < nk; kt += 2) {
    g_stage<NI>(A, lda, B, ldb, (kt + 1) * 64, buf1, tid);
    g_compute<NI, LOWREG>(acc, buf0, wr, wc, lane);
    asm volatile("s_waitcnt vmcnt(0)" ::: "memory");
    __syncthreads();
    if (kt + 2 < nk) g_stage<NI>(A, lda, B, ldb, (kt + 2) * 64, buf0, tid);
    g_compute<NI, LOWREG>(acc, buf1, wr, wc, lane);
    asm volatile("s_waitcnt vmcnt(0)" ::: "memory");
    __syncthreads();
  }
}
template <int NI>
__device__ __forceinline__ void zero_acc(f32x4 (&acc)[4][NI]) {
#pragma unroll
  for (int i = 0; i < 4; ++i)
#pragma unroll
    for (int j = 0; j < NI; ++j) acc[i][j] = (f32x4){0.f, 0.f, 0.f, 0.f};
}
__device__ __forceinline__ void tile_map(int t, int ntn, int& pm, int& pn) {
  const int grp = t / (8 * ntn), w = t % (8 * ntn);
  pm = grp * 8 + (w & 7);
  pn = w >> 3;
}

__device__ __forceinline__ void transpose_tile(const float* __restrict__ src, int ld_src, int n_valid, bf16* __restrict__ dst, int ld_dst,
                               int k0, int n0, int kdst0, float* sm) {
  const int tid = tidx();
  for (int i = tid; i < 64 * 16; i += 256) {
    const int kk = i >> 4, n4 = (i & 15) * 4, n = n0 + n4;
    float4 v = make_float4(0.f, 0.f, 0.f, 0.f);
    if (n + 3 < n_valid) v = *(const float4*)(src + (size_t)(k0 + kk) * ld_src + n);
    sm[kk * 65 + n4 + 0] = v.x; sm[kk * 65 + n4 + 1] = v.y; sm[kk * 65 + n4 + 2] = v.z; sm[kk * 65 + n4 + 3] = v.w;
  }
  __syncthreads();
  for (int i = tid; i < 64 * 8; i += 256) {
    const int nn = i >> 3, kc = (i & 7) * 8;
    uint4 o;
    o.x = pack2(sm[(kc + 0) * 65 + nn], sm[(kc + 1) * 65 + nn]);
    o.y = pack2(sm[(kc + 2) * 65 + nn], sm[(kc + 3) * 65 + nn]);
    o.z = pack2(sm[(kc + 4) * 65 + nn], sm[(kc + 5) * 65 + nn]);
    o.w = pack2(sm[(kc + 6) * 65 + nn], sm[(kc + 7) * 65 + nn]);
    *(uint4*)(dst + (size_t)(n0 + nn) * ld_dst + kdst0 + kc) = o;
  }
  __syncthreads();
}

__device__ __forceinline__ void ada_item(const Params& p, int item, float* sm) {
  const int l = item / 96, n0 = (item % 96) * 32;
  const int tid = tidx(), col = tid & 31, rg = tid >> 5;
  constexpr int SLD = 68;
  float* sW = sm + 136 * SLD;
  float acc[17];
#pragma unroll
  for (int j = 0; j < 17; ++j) acc[j] = 0.f;
  const float* W = p.ada_w + (size_t)l * 1024 * 3072 + n0;
  const int wk = tid >> 2, wc8 = (tid & 3) * 8;
  float v[34];
  float4 w0, w1;
#define ADA_LOAD(K0)                                                                                      \
  {                                                                                                       \
    _Pragma("unroll") for (int u = 0; u < 34; ++u) {                                                      \
      const int i = tid + 256 * u, r = i >> 6, kk = i & 63;                                               \
      v[u] = 0.f;                                                                                         \
      if (r < NMOD) v[u] = (r < 4) ? p.c_prompt[r * 1024 + (K0) + kk] : p.c_sample[(r - 4) * 1024 + (K0) + kk]; \
    }                                                                                                     \
    w0 = *(const float4*)(W + (size_t)((K0) + wk) * 3072 + wc8);                                          \
    w1 = *(const float4*)(W + (size_t)((K0) + wk) * 3072 + wc8 + 4);                                      \
  }
#define ADA_STORE()                                                                                       \
  {                                                                                                       \
    _Pragma("unroll") for (int u = 0; u < 34; ++u) {                                                      \
      const int i = tid + 256 * u, r = i >> 6, kk = i & 63;                                               \
      sm[r * SLD + kk] = siluf_(v[u]);                                                                    \
    }                                                                                                     \
    *(float4*)(sW + wk * 32 + wc8) = w0;                                                                  \
    *(float4*)(sW + wk * 32 + wc8 + 4) = w1;                                                              \
  }
  ADA_LOAD(0)
  ADA_STORE()
  __syncthreads();
#pragma unroll 1
  for (int k0 = 0; k0 < 1024; k0 += 64) {
    if (k0 + 64 < 1024) ADA_LOAD(k0 + 64)
#pragma unroll 4
    for (int k4 = 0; k4 < 16; ++k4) {
      const float x0 = sW[(k4 * 4 + 0) * 32 + col], x1 = sW[(k4 * 4 + 1) * 32 + col];
      const float x2 = sW[(k4 * 4 + 2) * 32 + col], x3 = sW[(k4 * 4 + 3) * 32 + col];
#pragma unroll
      for (int j = 0; j < 17; ++j) {
        const float4 sv = *(const float4*)(sm + (rg * 17 + j) * SLD + k4 * 4);
        acc[j] += sv.x * x0 + sv.y * x1 + sv.z * x2 + sv.w * x3;
      }
    }
    __syncthreads();
    if (k0 + 64 < 1024) ADA_STORE()
    __syncthreads();
  }
#undef ADA_LOAD
#undef ADA_STORE
  float* mod = (float*)(p.ws + WS_MOD);
  const float b = p.ada_b[l * 3072 + n0 + col];
#pragma unroll
  for (int j = 0; j < 17; ++j) {
    const int r = rg * 17 + j;
    if (r < NMOD) mod[((size_t)l * NMOD + r) * 3072 + n0 + col] = acc[j] + b;
  }
}

__device__ __forceinline__ void phase_prep(const Params& p, unsigned char* smem) {
  float* sm = (float*)smem;
  constexpr int N_WIN = 2 * 16 * (NWIN / 64);
  constexpr int N_WBR = 2 * 3 * 8 * 16;
  constexpr int N_WOUT = 2 * 16 * 16;
  constexpr int N_ALL = N_WIN + N_WBR + N_WOUT;
  bf16* WinT = (bf16*)(p.ws + WS_WIN);
  bf16* WbrT = (bf16*)(p.ws + WS_WBR);
  bf16* WoutT = (bf16*)(p.ws + WS_WOUT);
  if (blockIdx.x < 96) { ada_item(p, blockIdx.x, sm); return; }
  for (int it = blockIdx.x - 96; it < N_ALL; it += gridDim.x - 96) {
    int i = it;
    if (i < N_WIN) {
      const int l = i / (16 * 134), r = i % (16 * 134), kt = r / 134, nt = r % 134;
      transpose_tile(p.w_in + (size_t)l * 1024 * ZIN, ZIN, ZIN, WinT + (size_t)l * NWIN * 1024, 1024, kt * 64, nt * 64, kt * 64, sm);
      continue;
    }
    i -= N_WIN;
    if (i < N_WBR) {
      const int l = i / 384, r = i % 384, seg = r / 128, r2 = r % 128, kt = r2 / 16, nt = r2 % 16;
      const float* src = (seg == 0 ? p.w_a : seg == 1 ? p.w_b : p.w_c) + (size_t)l * 512 * 1024;
      transpose_tile(src, 1024, 1024, WbrT + (size_t)l * 1024 * 1536, 1536, kt * 64, nt * 64, seg * 512 + kt * 64, sm);
      continue;
    }
    i -= N_WBR;
    {
      const int l = i / 256, r = i % 256, kt = r / 16, nt = r % 16;
      transpose_tile(p.w_out + (size_t)l * 1024 * 1024, 1024, 1024, WoutT + (size_t)l * 1024 * 1024, 1024, kt * 64, nt * 64, kt * 64, sm);
    }
  }
}

__device__ __forceinline__ const float* xrow_ptr(const Params& p, int l, int row) {
  if (l == 0) return row < TP ? p.x_prompt + (size_t)row * D : p.x_sample + (size_t)(row - TP) * D;
  return p.out + (size_t)row * D;
}
__device__ __forceinline__ int mod_row(int row) { return row < TP ? (row >> 12) : 4 + ((row - TP) >> 3); }

__device__ __forceinline__ void phase_norm(const Params& p, int l) {
  const int lane = tidx() & 63, wave = tidx() >> 6;
  bf16* hbuf = (bf16*)(p.ws + WS_H);
  const float* mod = (const float*)(p.ws + WS_MOD);
  const float* g = p.norm_g + l * D;
  for (int row = blockIdx.x * 4 + wave; row < TT; row += gridDim.x * 4) {
    const float4* x = (const float4*)xrow_ptr(p, l, row);
    float4 v[4];
    float ss = 0.f;
#pragma unroll
    for (int i = 0; i < 4; ++i) {
      v[i] = x[lane + 64 * i];
      ss += v[i].x * v[i].x + v[i].y * v[i].y + v[i].z * v[i].z + v[i].w * v[i].w;
    }
    ss = wave_sum(ss);
    const float rstd = rsqrtf(ss * (1.0f / D) + EPS);
    const float* mp = mod + ((size_t)l * NMOD + mod_row(row)) * 3072;
#pragma unroll
    for (int i = 0; i < 4; ++i) {
      const int c = (lane + 64 * i) * 4;
      const float4 gg = *(const float4*)(g + c), sh = *(const float4*)(mp + c), sc = *(const float4*)(mp + 1024 + c);
      uint2 o;
      o.x = pack2(v[i].x * rstd * gg.x * (1.f + sc.x) + sh.x, v[i].y * rstd * gg.y * (1.f + sc.y) + sh.y);
      o.y = pack2(v[i].z * rstd * gg.z * (1.f + sc.z) + sh.z, v[i].w * rstd * gg.w * (1.f + sc.w) + sh.w);
      *(uint2*)(hbuf + (size_t)row * D + c) = o;
    }
  }
}

__device__ __forceinline__ void phase_gemm_in(const Params& p, int l, int col0, int ntn, int ldz, unsigned char* smem) {
  bf16* sm = (bf16*)smem;
  const bf16* hbuf = (const bf16*)(p.ws + WS_H);
  const bf16* W = (const bf16*)(p.ws + WS_WIN) + (size_t)l * NWIN * 1024;
  bf16* z = (bf16*)(p.ws + WS_Z);
  const float* bias = p.b_in + (size_t)l * ZIN;
  const int tid = tidx(), lane = tid & 63, wave = tid >> 6, wr = wave >> 1, wc = wave & 1;
  const int ntiles = (TT / 128) * ntn;
  constexpr int OLD = 136;
  for (int t = blockIdx.x; t < ntiles; t += gridDim.x) {
    int pm, pn;
    tile_map(t, ntn, pm, pn);
    const int m0 = pm * 128, n0 = pn * 128;
    f32x4 acc[4][4];
    zero_acc<4>(acc);
    gemm_accum<4>(acc, hbuf + (size_t)m0 * 1024, 1024, W + (size_t)(col0 + n0) * 1024, 1024, 1024, sm);
#pragma unroll
    for (int j = 0; j < 4; ++j) {
      const int cl = wc * 64 + j * 16 + (lane >> 4) * 4;
      const float4 b = *(const float4*)(bias + col0 + n0 + cl);
#pragma unroll
      for (int i = 0; i < 4; ++i) {
        const int rl = wr * 64 + i * 16 + (lane & 15);
        uint2 o;
        o.x = pack2(acc[i][j][0] + b.x, acc[i][j][1] + b.y);
        o.y = pack2(acc[i][j][2] + b.z, acc[i][j][3] + b.w);
        *(uint2*)(sm + rl * OLD + cl) = o;
      }
    }
    __syncthreads();
#pragma unroll
    for (int it = 0; it < 8; ++it) {
      const int id = tid + 256 * it, row = id >> 4, ch = id & 15;
      const u32x4 v = *(const u32x4*)(sm + row * OLD + ch * 8);
      *(u32x4*)(z + (size_t)(m0 + row) * ldz + n0 + ch * 8) = v;
    }
    __syncthreads();
  }
}

__device__ __forceinline__ void gmlp_prompt_item(const Params& p, int l, int item, unsigned char* smem) {
  const int b = item >> 7, n = (item >> 2) & 31, g = item & 3;
  const int r0 = b * SEQ + n * 128;
  const bf16* z = (const bf16*)(p.ws + WS_Z);
  bf16* yab = (bf16*)(p.ws + WS_YAB);
  bf16* sW = (bf16*)smem;
  bf16* sV = (bf16*)(smem + 34816);
  float* srstd = (float*)(smem + 69632);
  const int tid = tidx(), lane = tid & 63, wave = tid >> 6, wr = wave >> 1, wc = wave & 1;
  {
    const int tok = tid >> 1, half = tid & 1;
    const uint4* ptr = (const uint4*)(z + (size_t)(r0 + tok) * ZAB + OFF_AV + half * 256);
    float ss = 0.f;
    for (int i = 0; i < 32; ++i) {
      float f[8];
      unpack8(ptr[i], f);
#pragma unroll
      for (int j = 0; j < 8; ++j) ss += f[j] * f[j];
    }
    ss += __shfl_xor(ss, 1);
    if (half == 0) srstd[tok] = rsqrtf(ss * (1.0f / 512.f) + EPS);
  }
  __syncthreads();
  const float* vg = p.vnorm_g + l * 512 + g * 128;
  for (int i = tid; i < 2048; i += 256) {
    const int s = i >> 4, c8 = (i & 15) * 8;
    float f[8];
    unpack8(*(const uint4*)(z + (size_t)(r0 + s) * ZAB + OFF_AV + g * 128 + c8), f);
    const float rs = srstd[s];
#pragma unroll
    for (int j = 0; j < 8; ++j) sV[(c8 + j) * 136 + s] = f2bf(f[j] * rs * vg[c8 + j]);
  }
  const float* Wg = p.gmlp_ws + ((size_t)(l * 4 + g)) * 128 * 128;
  for (int i = tid; i < 4096; i += 256) {
    const int t = i >> 5, s4 = (i & 31) * 4;
    const float4 w = *(const float4*)(Wg + t * 128 + s4);
    uint2 o;
    o.x = pack2(s4 + 0 <= t ? w.x : 0.f, s4 + 1 <= t ? w.y : 0.f);
    o.y = pack2(s4 + 2 <= t ? w.z : 0.f, s4 + 3 <= t ? w.w : 0.f);
    *(uint2*)(sW + t * 136 + s4) = o;
  }
  __syncthreads();
  f32x4 acc[4][4];
  zero_acc<4>(acc);
  mma_lds<4, 4>(acc, sW + wr * 64 * 136, 136, sV + wc * 64 * 136, 136, wr * 64 + 64, lane);
  const float* bs = p.gmlp_bs + (l * 4 + g) * 128;
#pragma unroll
  for (int i = 0; i < 4; ++i) {
    const int t = wr * 64 + i * 16 + (lane & 15);
    const float bst = bs[t];
    const size_t rowoff = (size_t)(r0 + t) * ZAB;
#pragma unroll
    for (int j = 0; j < 4; ++j) {
      const int c = g * 128 + wc * 64 + j * 16 + (lane >> 4) * 4;
      float u[4], ag[4];
      unpack4(*(const uint2*)(z + rowoff + c), u);
      unpack4(*(const uint2*)(z + rowoff + OFF_AG + c), ag);
      uint2 o;
      o.x = pack2(u[0] * (acc[i][j][0] + bst) * siluf_(ag[0]), u[1] * (acc[i][j][1] + bst) * siluf_(ag[1]));
      o.y = pack2(u[2] * (acc[i][j][2] + bst) * siluf_(ag[2]), u[3] * (acc[i][j][3] + bst) * siluf_(ag[3]));
      *(uint2*)(yab + (size_t)(r0 + t) * 1024 + c) = o;
    }
  }
  __syncthreads();
}

__device__ __forceinline__ void gmlp_sample_item(const Params& p, int l, int b, unsigned char* smem) {
  const int r0 = TP + b * 8;
  const bf16* z = (const bf16*)(p.ws + WS_Z);
  bf16* yab = (bf16*)(p.ws + WS_YAB);
  float* svn = (float*)smem;
  const int tid = tidx(), lane = tid & 63, wave = tid >> 6;
  const float* vg = p.vnorm_g + l * 512;
  for (int tt = 0; tt < 2; ++tt) {
    const int t = wave * 2 + tt;
    float f[8];
    unpack8(*(const uint4*)(z + (size_t)(r0 + t) * ZAB + OFF_AV + lane * 8), f);
    float ss = 0.f;
#pragma unroll
    for (int j = 0; j < 8; ++j) ss += f[j] * f[j];
    ss = wave_sum(ss);
    const float rstd = rsqrtf(ss * (1.0f / 512.f) + EPS);
    float* gv = p.out + O_GV + (((size_t)l * 128 + b) * 8 + t) * 512 + lane * 8;
#pragma unroll
    for (int j = 0; j < 8; ++j) {
      const float vn = f[j] * rstd * vg[lane * 8 + j];
      svn[t * 512 + lane * 8 + j] = vn;
      gv[j] = vn;
    }
  }
  __syncthreads();
  {
    const int c = tid * 2, g = c >> 7;
    const float* Wg = p.gmlp_ws + ((size_t)(l * 4 + g)) * 128 * 128;
    const float* bs = p.gmlp_bs + (l * 4 + g) * 128;
    for (int t = 0; t < 8; ++t) {
      float s0 = bs[t], s1 = bs[t];
      for (int s = 0; s <= t; ++s) {
        const float w = Wg[t * 128 + s];
        s0 += w * svn[s * 512 + c];
        s1 += w * svn[s * 512 + c + 1];
      }
      const unsigned uu = *(const unsigned*)(z + (size_t)(r0 + t) * ZAB + c);
      const unsigned gg = *(const unsigned*)(z + (size_t)(r0 + t) * ZAB + OFF_AG + c);
      *(unsigned*)(yab + (size_t)(r0 + t) * 1024 + c) = pack2(lo2f(uu) * s0 * siluf_(lo2f(gg)), hi2f(uu) * s1 * siluf_(hi2f(gg)));
    }
  }
  __syncthreads();
}

__device__ __forceinline__ void swa_prompt_item(const Params& p, int l, int item, unsigned char* smem) {
  const int b = item >> 7, qt = (item >> 1) & 63, kv = item & 1;
  const int q0 = qt * 64, rb = b * SEQ;
  const bf16* z = (const bf16*)(p.ws + WS_Z);
  bf16* yab = (bf16*)(p.ws + WS_YAB);
  bf16* sK = (bf16*)smem;
  bf16* sVT = (bf16*)(smem + 27648);
  const int tid = tidx(), lane = tid & 63, wave = tid >> 6;
  const float* kg = p.kn_g + l * 64;
  const float* qg = p.qn_g + l * 64;
#pragma unroll 1
  for (int it = 0; it < 6; ++it) {
    const int id = tid + 256 * it, kk = id >> 3, ch = id & 7, kp = q0 - 128 + kk;
    float f[8];
    uint4 vraw = make_uint4(0, 0, 0, 0);
    if (kp >= 0) {
      unpack8(*(const uint4*)(z + (size_t)(rb + kp) * ZAB + OFF_BK + kv * 64 + ch * 8), f);
      vraw = *(const uint4*)(z + (size_t)(rb + kp) * ZAB + OFF_BV + kv * 64 + ch * 8);
    } else {
#pragma unroll
      for (int j = 0; j < 8; ++j) f[j] = 0.f;
    }
    float ss = 0.f;
#pragma unroll
    for (int j = 0; j < 8; ++j) ss += f[j] * f[j];
    ss += __shfl_xor(ss, 1); ss += __shfl_xor(ss, 2); ss += __shfl_xor(ss, 4);
    const float rstd = rsqrtf(ss * (1.0f / 64.f) + EPS);
#pragma unroll
    for (int j = 0; j < 8; ++j) f[j] = f[j] * rstd * kg[ch * 8 + j];
    uint4 ko;
    ko.x = pack2(f[0], f[1]); ko.y = pack2(f[2], f[3]); ko.z = pack2(f[4], f[5]); ko.w = pack2(f[6], f[7]);
    *(uint4*)(sK + kk * 72 + ch * 8) = ko;
    float vf[8];
    unpack8(vraw, vf);
#pragma unroll
    for (int j = 0; j < 8; ++j) sVT[(ch * 8 + j) * 200 + kk] = f2bf(vf[j]);
    if (kk >= 128 && kp >= SEQ - 128) {
      const size_t o = ((((size_t)l * 4 + b) * 128 + (kp - (SEQ - 128))) * 2 + kv) * 64 + ch * 8;
#pragma unroll
      for (int j = 0; j < 8; ++j) { p.out[O_SKP + o + j] = f[j]; p.out[O_SVP + o + j] = vf[j]; }
    }
  }
  __syncthreads();
  const int h = kv * 4 + wave;
  const float sink = p.sinks[l * 8 + h];
  const int g4 = lane >> 4, r16 = lane & 15;
#pragma unroll 1
  for (int i = 0; i < 4; ++i) {
    const int qrow = q0 + i * 16 + r16;
    const size_t grow = (size_t)(rb + qrow);
    bf16x8 qf[2];
    {
      float f0[8], f1[8];
      unpack8(*(const uint4*)(z + grow * ZAB + OFF_BQ + h * 64 + g4 * 8), f0);
      unpack8(*(const uint4*)(z + grow * ZAB + OFF_BQ + h * 64 + 32 + g4 * 8), f1);
      float ss = 0.f;
#pragma unroll
      for (int j = 0; j < 8; ++j) ss += f0[j] * f0[j] + f1[j] * f1[j];
      ss += __shfl_xor(ss, 16); ss += __shfl_xor(ss, 32);
      const float rstd = rsqrtf(ss * (1.0f / 64.f) + EPS) * 0.125f;
#pragma unroll
      for (int j = 0; j < 8; ++j) {
        qf[0][j] = (short)f2bf(f0[j] * rstd * qg[g4 * 8 + j]);
        qf[1][j] = (short)f2bf(f1[j] * rstd * qg[32 + g4 * 8 + j]);
      }
    }
    f32x4 st[12];
#pragma unroll
    for (int kt = 0; kt < 12; ++kt) {
      st[kt] = (f32x4){0.f, 0.f, 0.f, 0.f};
#pragma unroll
      for (int ks = 0; ks < 2; ++ks) {
        const bf16x8 kf = *(const bf16x8*)(sK + (kt * 16 + r16) * 72 + ks * 32 + g4 * 8);
        st[kt] = mfma16(kf, qf[ks], st[kt]);
      }
      if ((kt & 1) == 1) __builtin_amdgcn_sched_barrier(0);
    }
    float mx = -INFINITY;
#pragma unroll
    for (int kt = 0; kt < 12; ++kt)
#pragma unroll
      for (int x = 0; x < 4; ++x) {
        const int kp = q0 - 128 + kt * 16 + g4 * 4 + x, diff = qrow - kp;
        const bool valid = (kp >= 0) && (diff >= 0) && (diff < 128);
        st[kt][x] = valid ? st[kt][x] : -INFINITY;
        mx = fmaxf(mx, st[kt][x]);
      }
    mx = fmaxf(mx, __shfl_xor(mx, 16)); mx = fmaxf(mx, __shfl_xor(mx, 32));
    mx = fmaxf(mx, sink);
    float sum = 0.f;
#pragma unroll
    for (int kt = 0; kt < 12; ++kt)
#pragma unroll
      for (int x = 0; x < 4; ++x) {
        const float pv = __expf(st[kt][x] - mx);
        st[kt][x] = pv;
        sum += pv;
      }
    sum += __shfl_xor(sum, 16); sum += __shfl_xor(sum, 32);
    const float inv = 1.0f / (sum + __expf(sink - mx));
    f32x4 o[4];
#pragma unroll
    for (int dt = 0; dt < 4; ++dt) o[dt] = (f32x4){0.f, 0.f, 0.f, 0.f};
#pragma unroll
    for (int t2 = 0; t2 < 6; ++t2) {
      bf16x8 pf;
#pragma unroll
      for (int x = 0; x < 4; ++x) { pf[x] = (short)f2bf(st[2 * t2][x]); pf[4 + x] = (short)f2bf(st[2 * t2 + 1][x]); }
#pragma unroll
      for (int dt = 0; dt < 4; ++dt) {
        const uint2 v0 = *(const uint2*)(sVT + (dt * 16 + r16) * 200 + t2 * 32 + g4 * 4);
        const uint2 v1 = *(const uint2*)(sVT + (dt * 16 + r16) * 200 + t2 * 32 + 16 + g4 * 4);
        union { uint4 u; bf16x8 v; } cv;
        cv.u = make_uint4(v0.x, v0.y, v1.x, v1.y);
        o[dt] = mfma16(cv.v, pf, o[dt]);
      }
      __builtin_amdgcn_sched_barrier(0);
    }
#pragma unroll
    for (int dt = 0; dt < 4; ++dt) {
      const int d0 = dt * 16 + g4 * 4;
      float bg[4];
      unpack4(*(const uint2*)(z + grow * ZAB + OFF_BG + h * 64 + d0), bg);
      uint2 oo;
      oo.x = pack2(o[dt][0] * inv * siluf_(bg[0]), o[dt][1] * inv * siluf_(bg[1]));
      oo.y = pack2(o[dt][2] * inv * siluf_(bg[2]), o[dt][3] * inv * siluf_(bg[3]));
      *(uint2*)(yab + grow * 1024 + 512 + h * 64 + d0) = oo;
    }
  }
  __syncthreads();
}

__device__ __forceinline__ void swa_sample_item(const Params& p, int l, int item, unsigned char* smem) {
  const int b = item >> 1, kv = item & 1;
  const int r0 = TP + b * 8;
  const bf16* z = (const bf16*)(p.ws + WS_Z);
  bf16* yab = (bf16*)(p.ws + WS_YAB);
  bf16* sK = (bf16*)smem;
  bf16* sV = (bf16*)(smem + 19584);
  float* sq = (float*)(smem + 39168);
  float* sP = (float*)(smem + 47488);
  const int tid = tidx();
  const float* kg = p.kn_g + l * 64;
  const float* qg = p.qn_g + l * 64;
  const float* ck = p.cache_k + ((size_t)l * 128 + b) * 128 * 128;
  const float* cvp = p.cache_v + ((size_t)l * 128 + b) * 128 * 128;
#pragma unroll 1
  for (int it = 0; it < 5; ++it) {
    const int id = tid + 256 * it, j = id >> 3, ch = id & 7;
    const bool act = id < 1088;
    float kf[8], vf[8];
#pragma unroll
    for (int x = 0; x < 8; ++x) { kf[x] = 0.f; vf[x] = 0.f; }
    if (act) {
      if (j < 128) {
        const float4 a0 = *(const float4*)(ck + (j * 2 + kv) * 64 + ch * 8), a1 = *(const float4*)(ck + (j * 2 + kv) * 64 + ch * 8 + 4);
        const float4 b0 = *(const float4*)(cvp + (j * 2 + kv) * 64 + ch * 8), b1 = *(const float4*)(cvp + (j * 2 + kv) * 64 + ch * 8 + 4);
        kf[0] = a0.x; kf[1] = a0.y; kf[2] = a0.z; kf[3] = a0.w; kf[4] = a1.x; kf[5] = a1.y; kf[6] = a1.z; kf[7] = a1.w;
        vf[0] = b0.x; vf[1] = b0.y; vf[2] = b0.z; vf[3] = b0.w; vf[4] = b1.x; vf[5] = b1.y; vf[6] = b1.z; vf[7] = b1.w;
      } else {
        unpack8(*(const uint4*)(z + (size_t)(r0 + j - 128) * ZAB + OFF_BK + kv * 64 + ch * 8), kf);
        unpack8(*(const uint4*)(z + (size_t)(r0 + j - 128) * ZAB + OFF_BV + kv * 64 + ch * 8), vf);
      }
    }
    float ss = 0.f;
#pragma unroll
    for (int x = 0; x < 8; ++x) ss += kf[x] * kf[x];
    ss += __shfl_xor(ss, 1); ss += __shfl_xor(ss, 2); ss += __shfl_xor(ss, 4);
    if (act) {
      if (j >= 128) {
        const float rstd = rsqrtf(ss * (1.0f / 64.f) + EPS);
#pragma unroll
        for (int x = 0; x < 8; ++x) kf[x] = kf[x] * rstd * kg[ch * 8 + x];
      }
      uint4 ko, vo;
      ko.x = pack2(kf[0], kf[1]); ko.y = pack2(kf[2], kf[3]); ko.z = pack2(kf[4], kf[5]); ko.w = pack2(kf[6], kf[7]);
      vo.x = pack2(vf[0], vf[1]); vo.y = pack2(vf[2], vf[3]); vo.z = pack2(vf[4], vf[5]); vo.w = pack2(vf[6], vf[7]);
      *(uint4*)(sK + j * 72 + ch * 8) = ko;
      *(uint4*)(sV + j * 72 + ch * 8) = vo;
      if (j >= 8) {
        const size_t o = ((((size_t)l * 128 + b) * 128 + (j - 8)) * 2 + kv) * 64 + ch * 8;
        *(float4*)(p.out + O_SKS + o) = make_float4(kf[0], kf[1], kf[2], kf[3]);
        *(float4*)(p.out + O_SKS + o + 4) = make_float4(kf[4], kf[5], kf[6], kf[7]);
        *(float4*)(p.out + O_SVS + o) = make_float4(vf[0], vf[1], vf[2], vf[3]);
        *(float4*)(p.out + O_SVS + o + 4) = make_float4(vf[4], vf[5], vf[6], vf[7]);
      }
    }
  }
  const int qi = tid >> 3, sub = tid & 7, t = qi >> 2, h = kv * 4 + (qi & 3);
  {
    float f[8];
    unpack8(*(const uint4*)(z + (size_t)(r0 + t) * ZAB + OFF_BQ + h * 64 + sub * 8), f);
    float ss = 0.f;
#pragma unroll
    for (int x = 0; x < 8; ++x) ss += f[x] * f[x];
    ss += __shfl_xor(ss, 1); ss += __shfl_xor(ss, 2); ss += __shfl_xor(ss, 4);
    const float rstd = rsqrtf(ss * (1.0f / 64.f) + EPS) * 0.125f;
#pragma unroll
    for (int x = 0; x < 8; ++x) sq[qi * 65 + sub * 8 + x] = f[x] * rstd * qg[sub * 8 + x];
  }
  __syncthreads();
  const float sink = p.sinks[l * 8 + h];
  float mx = -INFINITY;
#pragma unroll 1
  for (int jj = 0; jj < 17; ++jj) {
    const int key = sub + 8 * jj;
    float s = 0.f;
#pragma unroll 8
    for (int d = 0; d < 64; ++d) s += sq[qi * 65 + d] * bf2f(sK[key * 72 + d]);
    const bool valid = (key >= t + 1) && (key <= t + 128);
    s = valid ? s : -INFINITY;
    sP[qi * 140 + key] = s;
    mx = fmaxf(mx, s);
  }
  mx = fmaxf(mx, __shfl_xor(mx, 1)); mx = fmaxf(mx, __shfl_xor(mx, 2)); mx = fmaxf(mx, __shfl_xor(mx, 4));
  mx = fmaxf(mx, sink);
  float sum = 0.f;
  for (int jj = 0; jj < 17; ++jj) {
    const int key = sub + 8 * jj;
    const float pv = __expf(sP[qi * 140 + key] - mx);
    sP[qi * 140 + key] = pv;
    sum += pv;
  }
  sum += __shfl_xor(sum, 1); sum += __shfl_xor(sum, 2); sum += __shfl_xor(sum, 4);
  const float inv = 1.0f / (sum + __expf(sink - mx));
  __syncthreads();
  {
    float o[8];
#pragma unroll
    for (int x = 0; x < 8; ++x) o[x] = 0.f;
#pragma unroll 2
    for (int key = 0; key < 136; ++key) {
      const float pv = sP[qi * 140 + key];
      float vf[8];
      unpack8(*(const uint4*)(sV + key * 72 + sub * 8), vf);
#pragma unroll
      for (int x = 0; x < 8; ++x) o[x] += pv * vf[x];
    }
    float bg[8];
    unpack8(*(const uint4*)(z + (size_t)(r0 + t) * ZAB + OFF_BG + h * 64 + sub * 8), bg);
    uint4 oo;
    oo.x = pack2(o[0] * inv * siluf_(bg[0]), o[1] * inv * siluf_(bg[1]));
    oo.y = pack2(o[2] * inv * siluf_(bg[2]), o[3] * inv * siluf_(bg[3]));
    oo.z = pack2(o[4] * inv * siluf_(bg[4]), o[5] * inv * siluf_(bg[5]));
    oo.w = pack2(o[6] * inv * siluf_(bg[6]), o[7] * inv * siluf_(bg[7]));
    *(uint4*)(yab + (size_t)(r0 + t) * 1024 + 512 + h * 64 + sub * 8) = oo;
  }
  __syncthreads();
}

__device__ __forceinline__ void phase_mix_ab(const Params& p, int l, unsigned char* smem) {
  constexpr int N_SWA = 512, N_GM = 512, N_SWS = 256, N_GMS = 128;
  constexpr int N_ALL = N_SWA + N_GM + N_SWS + N_GMS;
  for (int it = blockIdx.x; it < N_ALL; it += gridDim.x) {
    int i = it;
    if (i < N_SWA) { swa_prompt_item(p, l, i, smem); continue; }
    i -= N_SWA;
    if (i < N_GM) { gmlp_prompt_item(p, l, i, smem); continue; }
    i -= N_GM;
    if (i < N_SWS) { swa_sample_item(p, l, i, smem); continue; }
    i -= N_SWS;
    gmlp_sample_item(p, l, i, smem);
  }
}

__device__ __forceinline__ void conv8_prompt(const Params& p, int l, const bf16* z, int r0, int pos0, int s, int zc, float* y) {
  const float* cw = p.conv_w + (size_t)l * 4 * 1024 + zc;
  const float* cb = p.conv_b + l * 1024 + zc;
#pragma unroll
  for (int j = 0; j < 8; ++j) y[j] = cb[j];
#pragma unroll
  for (int tap = 0; tap < 4; ++tap) {
    const int back = 3 - tap;
    if (pos0 + s - back >= 0) {
      float f[8];
      unpack8(*(const uint4*)(z + (size_t)(r0 + s - back) * ZC + C_QK + zc), f);
#pragma unroll
      for (int j = 0; j < 8; ++j) y[j] += cw[tap * 1024 + j] * f[j];
    }
  }
#pragma unroll
  for (int j = 0; j < 8; ++j) y[j] = siluf_(y[j]);
}

__device__ __forceinline__ void chunk_gates(const Params& p, int l, const bf16* z, int r0, int hh, int lane, float& cum, float& iv) {
  const float f = bf2f(z[(size_t)(r0 + lane) * ZC + C_F + hh]) + p.f_bias[l * 4 + hh];
  iv = bf2f(z[(size_t)(r0 + lane) * ZC + C_I + hh]);
  float c = logsigmoidf_(f);
#pragma unroll
  for (int o = 1; o < 64; o <<= 1) {
    const float n = __shfl_up(c, o);
    if (lane >= o) c += n;
  }
  cum = c;
}

__device__ __forceinline__ void mlstm_local_item(const Params& p, int l, int item, unsigned char* smem) {
  const int bh = item >> 6, c = item & 63, b = bh >> 2, hh = bh & 3;
  const int r0 = b * SEQ + c * 64;
  const bf16* z = (const bf16*)(p.ws + WS_Z);
  bf16* skT = (bf16*)smem;
  bf16* svT = (bf16*)(smem + 18432);
  float* swsel = (float*)(smem + 36864);
  const int tid = tidx(), lane = tid & 63, wave = tid >> 6, wr = wave >> 1, wc = wave & 1;
  if (wave == 0) {
    float cum, iv;
    chunk_gates(p, l, z, r0, hh, lane, cum, iv);
    const float total = __shfl(cum, 63);
    const float g = total - cum + iv;
    const float G = wave_max(g);
    swsel[lane] = __expf(g - G);
    if (lane == 0) {
      ((float*)(p.ws + WS_G))[item] = G;
      ((float*)(p.ws + WS_TOT))[item] = total;
    }
  }
  __syncthreads();
  for (int i = tid; i < 1024; i += 256) {
    const int s = i >> 4, d8 = (i & 15) * 8;
    float y[8];
    conv8_prompt(p, l, z, r0, c * 64, s, 512 + hh * 128 + d8, y);
    const float sc = 0.08838834764831845f * swsel[s];
#pragma unroll
    for (int j = 0; j < 8; ++j) skT[(d8 + j) * 72 + s] = f2bf(y[j] * sc);
    float v[8];
    unpack8(*(const uint4*)(z + (size_t)(r0 + s) * ZC + C_V + hh * 128 + d8), v);
#pragma unroll
    for (int j = 0; j < 8; ++j) svT[(d8 + j) * 72 + s] = f2bf(v[j]);
  }
  __syncthreads();
  f32x4 acc[4][4];
  zero_acc<4>(acc);
  mma_lds<4, 4>(acc, svT + wr * 64 * 72, 72, skT + wc * 64 * 72, 72, 64, lane);
  bf16* U = (bf16*)(p.ws + WS_U) + (size_t)item * 16384;
#pragma unroll
  for (int i = 0; i < 4; ++i)
#pragma unroll
    for (int j = 0; j < 4; ++j) {
      const int e = wr * 64 + i * 16 + (lane & 15), d = wc * 64 + j * 16 + (lane >> 4) * 4;
      uint2 o;
      o.x = pack2(acc[i][j][0], acc[i][j][1]);
      o.y = pack2(acc[i][j][2], acc[i][j][3]);
      *(uint2*)(U + e * 128 + d) = o;
    }
  if (tid < 128) {
    float s = 0.f;
    for (int k = 0; k < 64; ++k) s += bf2f(skT[tid * 72 + k]);
    ((float*)(p.ws + WS_UN))[(size_t)item * 128 + tid] = s;
  }
  __syncthreads();
}

__device__ __forceinline__ void mlstm_convout_item(const Params& p, int l, int b) {
  const bf16* z = (const bf16*)(p.ws + WS_Z);
  for (int i = tidx(); i < 3 * 1024; i += 256) {
    const int j = i >> 10, ch = i & 1023;
    p.out[O_CVP + (((size_t)l * 4 + b) * 3 + j) * 1024 + ch] = bf2f(z[(size_t)(b * SEQ + SEQ - 3 + j) * ZC + C_QK + ch]);
  }
}

__device__ __forceinline__ void mlstm_sample_item(const Params& p, int l, int item, unsigned char* smem) {
  const int b = item >> 2, hh = item & 3;
  const int r0 = TP + b * 8;
  bf16* z = (bf16*)(p.ws + WS_Z);
  float* sq = (float*)smem;
  float* sk = sq + 1024;
  float* sv = sk + 1024;
  float* sh = sv + 1024;
  float* sint = sh + 1024;
  float* sa = sint + 2048;
  float* sqn = sa + 64;
  float* smt = sqn + 8;
  float* swi = smt + 8;
  float* swsel = swi + 8;
  float* sdm = swsel + 8;
  float* sdecay = sdm + 64;
  const int tid = tidx(), lane = tid & 63, wave = tid >> 6;
  {
    const int isk = tid >> 7, d = tid & 127, zc = isk * 512 + hh * 128 + d;
    const float* cw = p.conv_w + (size_t)l * 4 * 1024 + zc;
    const float cb = p.conv_b[l * 1024 + zc];
    float xp[11];
    const float* cs = p.st_conv + ((size_t)l * 128 + b) * 3 * 1024 + zc;
    xp[0] = cs[0]; xp[1] = cs[1024]; xp[2] = cs[2048];
#pragma unroll
    for (int t = 0; t < 8; ++t) xp[3 + t] = bf2f(z[(size_t)(r0 + t) * ZC + C_QK + zc]);
    const float w0 = cw[0], w1 = cw[1024], w2 = cw[2048], w3 = cw[3072];
    float* dst = isk ? sk : sq;
    const float sc = isk ? 0.08838834764831845f : 1.0f;
#pragma unroll
    for (int t = 0; t < 8; ++t) {
      const float y = cb + w0 * xp[t] + w1 * xp[t + 1] + w2 * xp[t + 2] + w3 * xp[t + 3];
      dst[t * 128 + d] = siluf_(y) * sc;
    }
    float* co = p.out + O_CVS + ((size_t)l * 128 + b) * 3 * 1024 + zc;
    co[0] = xp[8]; co[1024] = xp[9]; co[2048] = xp[10];
  }
  for (int i = tid; i < 1024; i += 256) {
    const int t = i >> 7, e = i & 127;
    sv[i] = bf2f(z[(size_t)(r0 + t) * ZC + C_V + hh * 128 + e]);
  }
  if (tid == 0) {
    float cum[8], iv[8];
    float c = 0.f;
    for (int t = 0; t < 8; ++t) {
      const float f = bf2f(z[(size_t)(r0 + t) * ZC + C_F + hh]) + p.f_bias[l * 4 + hh];
      c += logsigmoidf_(f);
      cum[t] = c;
      iv[t] = bf2f(z[(size_t)(r0 + t) * ZC + C_I + hh]);
    }
    const float m0 = p.st_m[(l * 128 + b) * 4 + hh];
    for (int t = 0; t < 8; ++t) {
      float dmax = -INFINITY;
      for (int s = 0; s <= t; ++s) dmax = fmaxf(dmax, cum[t] - cum[s] + iv[s]);
      const float mi = cum[t] + m0, mt = fmaxf(mi, dmax);
      smt[t] = mt;
      swi[t] = __expf(mi - mt);
      for (int s = 0; s < 8; ++s) sdm[t * 8 + s] = (s <= t) ? __expf(cum[t] - cum[s] + iv[s] - mt) : 0.f;
    }
    const float total = cum[7];
    float gm = -INFINITY;
    for (int s = 0; s < 8; ++s) gm = fmaxf(gm, total - cum[s] + iv[s]);
    const float mn = fmaxf(total + m0, gm);
    for (int s = 0; s < 8; ++s) swsel[s] = __expf(total - cum[s] + iv[s] - mn);
    sdecay[0] = __expf(total + m0 - mn);
    p.out[O_MS + (l * 128 + b) * 4 + hh] = mn;
  }
  __syncthreads();
  const float* n0 = p.st_n + (((size_t)l * 128 + b) * 4 + hh) * 128;
  if (tid < 64) {
    const int t = tid >> 3, s = tid & 7;
    float dsum = 0.f;
    for (int d = 0; d < 128; ++d) dsum += sq[t * 128 + d] * sk[s * 128 + d];
    sa[t * 8 + s] = sdm[t * 8 + s] * dsum;
  } else if (tid < 128) {
    const int t = (tid - 64) >> 3, part = (tid - 64) & 7;
    float dsum = 0.f;
    for (int d = part * 16; d < part * 16 + 16; ++d) dsum += sq[t * 128 + d] * n0[d];
    dsum += __shfl_xor(dsum, 1); dsum += __shfl_xor(dsum, 2); dsum += __shfl_xor(dsum, 4);
    if (part == 0) sqn[t] = dsum;
  }
  __syncthreads();
  {
    const int e = tid & 127, dh = tid >> 7;
    const float decay = sdecay[0];
    const float* C0 = p.st_C + (((size_t)l * 128 + b) * 4 + hh) * 16384;
    float* C1 = p.out + O_CS + (((size_t)l * 128 + b) * 4 + hh) * 16384;
    float vw[8], inter[8];
#pragma unroll
    for (int s = 0; s < 8; ++s) { vw[s] = sv[s * 128 + e] * swsel[s]; inter[s] = 0.f; }
    for (int d = dh * 64; d < dh * 64 + 64; ++d) {
      const float c0 = C0[d * 128 + e];
      float upd = decay * c0;
#pragma unroll
      for (int s = 0; s < 8; ++s) {
        upd += sk[s * 128 + d] * vw[s];
        inter[s] += sq[s * 128 + d] * c0;
      }
      C1[d * 128 + e] = upd;
    }
#pragma unroll
    for (int t = 0; t < 8; ++t) sint[(dh * 8 + t) * 128 + e] = inter[t];
  }
  __syncthreads();
  if (tid < 128) {
    const int e = tid;
    for (int t = 0; t < 8; ++t) {
      float num = swi[t] * (sint[t * 128 + e] + sint[(8 + t) * 128 + e]);
      float den = swi[t] * sqn[t];
      for (int s = 0; s <= t; ++s) { num += sa[t * 8 + s] * sv[s * 128 + e]; den += sa[t * 8 + s]; }
      sh[t * 128 + e] = num / fmaxf(fabsf(den), __expf(-smt[t]));
    }
    float nn = sdecay[0] * n0[e];
    for (int s = 0; s < 8; ++s) nn += swsel[s] * sk[s * 128 + e];
    p.out[O_NS + (((size_t)l * 128 + b) * 4 + hh) * 128 + e] = nn;
  }
  __syncthreads();
  const float* hg = p.hnorm_g + l * 512 + hh * 128;
  for (int tt = 0; tt < 2; ++tt) {
    const int t = wave * 2 + tt;
    const float h0 = sh[t * 128 + lane], h1 = sh[t * 128 + 64 + lane];
    const float ss = wave_sum(h0 * h0 + h1 * h1);
    const float rstd = rsqrtf(ss * (1.0f / 128.f) + EPS);
    bf16* zr = z + (size_t)(r0 + t) * ZC;
#pragma unroll
    for (int k = 0; k < 2; ++k) {
      const int e = lane + 64 * k;
      const float hv = k ? h1 : h0;
      const float o = bf2f(zr[C_O + hh * 128 + e]), cg_ = bf2f(zr[C_G + hh * 128 + e]);
      zr[C_O + hh * 128 + e] = f2bf(hv * rstd * hg[e] * sigmoidf_(o) * siluf_(cg_));
    }
  }
  __syncthreads();
}

__device__ __forceinline__ void phase_mix1(const Params& p, int l, unsigned char* smem) {
  constexpr int N_LOC = 1024, N_SMP = 512, N_CV = 4;
  constexpr int N_ALL = N_LOC + N_SMP + N_CV;
  for (int it = blockIdx.x; it < N_ALL; it += gridDim.x) {
    int i = it;
    if (i < N_LOC) { mlstm_local_item(p, l, i, smem); continue; }
    i -= N_LOC;
    if (i < N_SMP) { mlstm_sample_item(p, l, i, smem); continue; }
    i -= N_SMP;
    mlstm_convout_item(p, l, i);
  }
}

__device__ __forceinline__ void phase_scan(const Params& p, int l, unsigned char* smem) {
  float* sdec = (float*)smem;
  float* ssc = sdec + 64;
  const int tid = tidx();
  float* Gb = (float*)(p.ws + WS_G);
  float* Tb = (float*)(p.ws + WS_TOT);
  float* Mb = (float*)(p.ws + WS_M);
  if (l == 0 && gridDim.x >= 352 && blockIdx.x >= 256 && blockIdx.x < 256 + 96) { ada_item(p, 96 + (blockIdx.x - 256), (float*)smem); return; }
  if (l == 0 && gridDim.x < 352) { for (int it = blockIdx.x; it < 96; it += gridDim.x) ada_item(p, 96 + it, (float*)smem); }
  for (int it = blockIdx.x; it < 256; it += gridDim.x) {
    const int bh = it >> 4, slice = it & 15;
    if (tid < 64) { sdec[128 + tid] = Gb[bh * 64 + tid]; sdec[192 + tid] = Tb[bh * 64 + tid]; }
    __syncthreads();
    if (tid == 0) {
      float m = 0.f;
      for (int c = 0; c < 64; ++c) {
        const float G = sdec[128 + c], tot = sdec[192 + c];
        const float mn = fmaxf(tot + m, G);
        sdec[c] = __expf(tot + m - mn);
        ssc[c] = __expf(G - mn);
        if (slice == 0) Mb[bh * 64 + c] = m;
        m = mn;
      }
      if (slice == 0) p.out[O_MP + l * 16 + bh] = m;
    }
    __syncthreads();
    {
      const int idx = slice * 1024 + tid * 4;
      bf16* U = (bf16*)(p.ws + WS_U) + (size_t)bh * 64 * 16384 + idx;
      float st[4] = {0.f, 0.f, 0.f, 0.f};
#pragma unroll 8
      for (int c = 0; c < 64; ++c) {
        float u[4];
        unpack4(*(const uint2*)(U + (size_t)c * 16384), u);
        uint2 o;
        o.x = pack2(st[0], st[1]); o.y = pack2(st[2], st[3]);
        *(uint2*)(U + (size_t)c * 16384) = o;
        const float dc = sdec[c], sc = ssc[c];
#pragma unroll
        for (int x = 0; x < 4; ++x) st[x] = dc * st[x] + sc * u[x];
      }
      const int e = idx >> 7, d0 = idx & 127;
      float* Co = p.out + O_CP + ((size_t)l * 16 + bh) * 16384;
#pragma unroll
      for (int x = 0; x < 4; ++x) Co[(d0 + x) * 128 + e] = st[x];
    }
    if (slice == 0 && tid < 128) {
      float* un = (float*)(p.ws + WS_UN) + (size_t)bh * 64 * 128 + tid;
      float n = 0.f;
#pragma unroll 8
      for (int c = 0; c < 64; ++c) {
        const float u = un[c * 128];
        un[c * 128] = n;
        n = sdec[c] * n + ssc[c] * u;
      }
      p.out[O_NP + ((size_t)l * 16 + bh) * 128 + tid] = n;
    }
    __syncthreads();
  }
}

__device__ __forceinline__ void mlstm_out_item(const Params& p, int l, int item, unsigned char* smem) {
  const int bh = item >> 6, c = item & 63, b = bh >> 2, hh = bh & 3;
  const int r0 = b * SEQ + c * 64;
  bf16* z = (bf16*)(p.ws + WS_Z);
  bf16* sq = (bf16*)smem;
  bf16* sk = (bf16*)(smem + 17408);
  bf16* svT = (bf16*)(smem + 34816);
  bf16* sa = (bf16*)(smem + 53248);
  float* scum = (float*)(smem + 62464);
  float* siv = scum + 64;
  float* smt = siv + 64;
  float* swi = smt + 64;
  float* sden = swi + 64;
  float* sqn = sden + 64;
  float* spart = sqn + 64;
  const int tid = tidx(), lane = tid & 63, wave = tid >> 6;
  const int r16 = lane & 15, g4 = lane >> 4;
  if (wave == 0) {
    float cum, iv;
    chunk_gates(p, l, z, r0, hh, lane, cum, iv);
    scum[lane] = cum;
    siv[lane] = iv;
  }
  for (int i = tid; i < 2048; i += 256) {
    const int isk = i >> 10, r = i & 1023, s = r >> 4, d8 = (r & 15) * 8;
    float y[8];
    conv8_prompt(p, l, z, r0, c * 64, s, isk * 512 + hh * 128 + d8, y);
    const float sc = isk ? 0.08838834764831845f : 1.0f;
    uint4 o;
    o.x = pack2(y[0] * sc, y[1] * sc); o.y = pack2(y[2] * sc, y[3] * sc);
    o.z = pack2(y[4] * sc, y[5] * sc); o.w = pack2(y[6] * sc, y[7] * sc);
    *(uint4*)((isk ? sk : sq) + s * 136 + d8) = o;
  }
  for (int i = tid; i < 1024; i += 256) {
    const int s = i >> 4, d8 = (i & 15) * 8;
    float v[8];
    unpack8(*(const uint4*)(z + (size_t)(r0 + s) * ZC + C_V + hh * 128 + d8), v);
#pragma unroll
    for (int j = 0; j < 8; ++j) svT[(d8 + j) * 72 + s] = f2bf(v[j]);
  }
  __syncthreads();
  const float m_prev = ((const float*)(p.ws + WS_M))[item];
  {
    const int t = wave * 16 + r16;
    bf16x8 qf[4];
#pragma unroll
    for (int ks = 0; ks < 4; ++ks) qf[ks] = *(const bf16x8*)(sq + t * 136 + ks * 32 + g4 * 8);
    f32x4 st[4];
#pragma unroll
    for (int kt = 0; kt < 4; ++kt) {
      st[kt] = (f32x4){0.f, 0.f, 0.f, 0.f};
#pragma unroll
      for (int ks = 0; ks < 4; ++ks) {
        const bf16x8 kf = *(const bf16x8*)(sk + (kt * 16 + r16) * 136 + ks * 32 + g4 * 8);
        st[kt] = mfma16(kf, qf[ks], st[kt]);
      }
    }
    const float cumt = scum[t];
    float dm[4][4];
    float rmax = -INFINITY;
#pragma unroll
    for (int kt = 0; kt < 4; ++kt)
#pragma unroll
      for (int x = 0; x < 4; ++x) {
        const int s = kt * 16 + g4 * 4 + x;
        dm[kt][x] = (s <= t) ? (cumt - scum[s] + siv[s]) : -INFINITY;
        rmax = fmaxf(rmax, dm[kt][x]);
      }
    rmax = fmaxf(rmax, __shfl_xor(rmax, 16)); rmax = fmaxf(rmax, __shfl_xor(rmax, 32));
    const float mi = cumt + m_prev, mt = fmaxf(mi, rmax);
    float rsum = 0.f;
#pragma unroll
    for (int kt = 0; kt < 4; ++kt) {
      float a[4];
#pragma unroll
      for (int x = 0; x < 4; ++x) {
        const int s = kt * 16 + g4 * 4 + x;
        a[x] = (s <= t) ? __expf(dm[kt][x] - mt) * st[kt][x] : 0.f;
        rsum += a[x];
      }
      uint2 o;
      o.x = pack2(a[0], a[1]); o.y = pack2(a[2], a[3]);
      *(uint2*)(sa + t * 72 + kt * 16 + g4 * 4) = o;
    }
    rsum += __shfl_xor(rsum, 16); rsum += __shfl_xor(rsum, 32);
    if (g4 == 0) { smt[t] = mt; swi[t] = __expf(mi - mt); sden[t] = rsum; }
  }
  {
    const int t = tid >> 2, part = tid & 3;
    const float* nc = (const float*)(p.ws + WS_UN) + (size_t)item * 128;
    float s = 0.f;
    for (int d = part * 32; d < part * 32 + 32; ++d) s += bf2f(sq[t * 136 + d]) * nc[d];
    s += __shfl_xor(s, 1); s += __shfl_xor(s, 2);
    if (part == 0) sqn[t] = s;
  }
  __syncthreads();
  f32x4 acc[4][2];
#pragma unroll
  for (int ti = 0; ti < 4; ++ti)
#pragma unroll
    for (int et = 0; et < 2; ++et) acc[ti][et] = (f32x4){0.f, 0.f, 0.f, 0.f};
  const bf16* Cc = (const bf16*)(p.ws + WS_U) + (size_t)item * 16384;
#pragma unroll
  for (int ks = 0; ks < 4; ++ks) {
    bf16x8 cf[2], qf[4];
#pragma unroll
    for (int et = 0; et < 2; ++et) cf[et] = *(const bf16x8*)(Cc + (wave * 32 + et * 16 + r16) * 128 + ks * 32 + g4 * 8);
#pragma unroll
    for (int ti = 0; ti < 4; ++ti) qf[ti] = *(const bf16x8*)(sq + (ti * 16 + r16) * 136 + ks * 32 + g4 * 8);
#pragma unroll
    for (int ti = 0; ti < 4; ++ti)
#pragma unroll
      for (int et = 0; et < 2; ++et) acc[ti][et] = mfma16(cf[et], qf[ti], acc[ti][et]);
  }
#pragma unroll
  for (int ti = 0; ti < 4; ++ti) {
    const float w = swi[ti * 16 + r16];
#pragma unroll
    for (int et = 0; et < 2; ++et) acc[ti][et] *= w;
  }
#pragma unroll
  for (int ks = 0; ks < 2; ++ks) {
    bf16x8 vf[2], af[4];
#pragma unroll
    for (int et = 0; et < 2; ++et) vf[et] = *(const bf16x8*)(svT + (wave * 32 + et * 16 + r16) * 72 + ks * 32 + g4 * 8);
#pragma unroll
    for (int ti = 0; ti < 4; ++ti) af[ti] = *(const bf16x8*)(sa + (ti * 16 + r16) * 72 + ks * 32 + g4 * 8);
#pragma unroll
    for (int ti = 0; ti < 4; ++ti)
#pragma unroll
      for (int et = 0; et < 2; ++et) acc[ti][et] = mfma16(vf[et], af[ti], acc[ti][et]);
  }
#pragma unroll
  for (int ti = 0; ti < 4; ++ti) {
    const int t = ti * 16 + r16;
    const float den = sden[t] + swi[t] * sqn[t];
    const float inv = 1.0f / fmaxf(fabsf(den), __expf(-smt[t]));
    float ss = 0.f;
#pragma unroll
    for (int et = 0; et < 2; ++et) {
      acc[ti][et] *= inv;
#pragma unroll
      for (int x = 0; x < 4; ++x) ss += acc[ti][et][x] * acc[ti][et][x];
    }
    ss += __shfl_xor(ss, 16); ss += __shfl_xor(ss, 32);
    if (g4 == 0) spart[t * 4 + wave] = ss;
  }
  __syncthreads();
  const float* hg = p.hnorm_g + l * 512 + hh * 128;
#pragma unroll
  for (int ti = 0; ti < 4; ++ti) {
    const int t = ti * 16 + r16;
    const float rstd = rsqrtf((spart[t * 4] + spart[t * 4 + 1] + spart[t * 4 + 2] + spart[t * 4 + 3]) * (1.0f / 128.f) + EPS);
    bf16* zr = z + (size_t)(r0 + t) * ZC;
#pragma unroll
    for (int et = 0; et < 2; ++et) {
      const int e = wave * 32 + et * 16 + g4 * 4;
      float o[4], cg_[4];
      unpack4(*(const uint2*)(zr + C_O + hh * 128 + e), o);
      unpack4(*(const uint2*)(zr + C_G + hh * 128 + e), cg_);
      float y[4];
#pragma unroll
      for (int x = 0; x < 4; ++x) y[x] = acc[ti][et][x] * rstd * hg[e + x] * sigmoidf_(o[x]) * siluf_(cg_[x]);
      uint2 oo;
      oo.x = pack2(y[0], y[1]); oo.y = pack2(y[2], y[3]);
      *(uint2*)(zr + C_O + hh * 128 + e) = oo;
    }
  }
  __syncthreads();
}

__device__ __forceinline__ void phase_mix2(const Params& p, int l, unsigned char* smem) {
  for (int it = blockIdx.x; it < 1024; it += gridDim.x) mlstm_out_item(p, l, it, smem);
}

__device__ __forceinline__ void phase_gemm_br(const Params& p, int l, unsigned char* smem) {
  bf16* sm = (bf16*)smem;
  const bf16* hbuf = (const bf16*)(p.ws + WS_H);
  const bf16* Win = (const bf16*)(p.ws + WS_WIN) + (size_t)l * NWIN * 1024;
  const bf16* Wbr = (const bf16*)(p.ws + WS_WBR) + (size_t)l * 1024 * 1536;
  const bf16* yab = (const bf16*)(p.ws + WS_YAB);
  const bf16* z = (const bf16*)(p.ws + WS_Z);
  bf16* merged = (bf16*)(p.ws + WS_U);
  const float* bias = p.b_in + (size_t)l * ZIN + OFF_MG;
  const int lane = tidx() & 63, wave = tidx() >> 6, wr = wave >> 1, wc = wave & 1;
  const int ntiles = (TT / 128) * 8;
  for (int t = blockIdx.x; t < ntiles; t += gridDim.x) {
    int pm, pn;
    tile_map(t, 8, pm, pn);
    const int m0 = pm * 128, n0 = pn * 128;
#pragma unroll 1
    for (int seg = 0; seg < 3; ++seg) {
      f32x4 acc[4][4];
      zero_acc<4>(acc);
      gemm_accum<4, true>(acc, hbuf + (size_t)m0 * 1024, 1024, Win + (size_t)(OFF_MG + seg * 1024 + n0) * 1024, 1024, 1024, sm);
      unsigned gp[4][4][2];
#pragma unroll
      for (int j = 0; j < 4; ++j) {
        const int col = n0 + wc * 64 + j * 16 + (lane >> 4) * 4;
        const float4 bb = *(const float4*)(bias + seg * 1024 + col);
#pragma unroll
        for (int i = 0; i < 4; ++i) {
          gp[i][j][0] = pack2(sigmoidf_(acc[i][j][0] + bb.x), sigmoidf_(acc[i][j][1] + bb.y));
          gp[i][j][1] = pack2(sigmoidf_(acc[i][j][2] + bb.z), sigmoidf_(acc[i][j][3] + bb.w));
        }
      }
      zero_acc<4>(acc);
      const bf16* A = (seg == 0) ? yab + (size_t)m0 * 1024 : (seg == 1) ? yab + (size_t)m0 * 1024 + 512 : z + (size_t)m0 * ZC + C_O;
      const int lda = (seg == 2) ? ZC : 1024;
      gemm_accum<4, true>(acc, A, lda, Wbr + (size_t)n0 * 1536 + seg * 512, 1536, 512, sm);
#pragma unroll
      for (int i = 0; i < 4; ++i)
#pragma unroll
        for (int j = 0; j < 4; ++j) {
          const int row = m0 + wr * 64 + i * 16 + (lane & 15), col = n0 + wc * 64 + j * 16 + (lane >> 4) * 4;
          uint2* mp = (uint2*)(merged + (size_t)row * 1024 + col);
          uint2 prev = make_uint2(0u, 0u);
          if (seg > 0) prev = *mp;
          uint2 o;
          o.x = pack2(lo2f(prev.x) + lo2f(gp[i][j][0]) * acc[i][j][0], hi2f(prev.x) + hi2f(gp[i][j][0]) * acc[i][j][1]);
          o.y = pack2(lo2f(prev.y) + lo2f(gp[i][j][1]) * acc[i][j][2], hi2f(prev.y) + hi2f(gp[i][j][1]) * acc[i][j][3]);
          *mp = o;
        }
    }
  }
}

__device__ __forceinline__ void phase_gemm_out(const Params& p, int l, unsigned char* smem) {
  bf16* sm = (bf16*)smem;
  const bf16* merged = (const bf16*)(p.ws + WS_U);
  const bf16* Wout = (const bf16*)(p.ws + WS_WOUT) + (size_t)l * 1024 * 1024;
  const float* mod = (const float*)(p.ws + WS_MOD);
  const int lane = tidx() & 63, wave = tidx() >> 6, wr = wave >> 1, wc = wave & 1;
  const int ntiles = (TT / 128) * 8;
  for (int t = blockIdx.x; t < ntiles; t += gridDim.x) {
    int pm, pn;
    tile_map(t, 8, pm, pn);
    const int m0 = pm * 128, n0 = pn * 128;
    f32x4 acc[4][4];
    zero_acc<4>(acc);
    gemm_accum<4>(acc, merged + (size_t)m0 * 1024, 1024, Wout + (size_t)n0 * 1024, 1024, 1024, sm);
#pragma unroll
    for (int i = 0; i < 4; ++i) {
      const int row = m0 + wr * 64 + i * 16 + (lane & 15);
      const float* xr = xrow_ptr(p, l, row);
      const float* gate = mod + ((size_t)l * NMOD + mod_row(row)) * 3072 + 2048;
#pragma unroll
      for (int j = 0; j < 4; ++j) {
        const int col = n0 + wc * 64 + j * 16 + (lane >> 4) * 4;
        const float4 xv = *(const float4*)(xr + col), gv = *(const float4*)(gate + col);
        float4 o;
        o.x = xv.x + gv.x * acc[i][j][0]; o.y = xv.y + gv.y * acc[i][j][1];
        o.z = xv.z + gv.z * acc[i][j][2]; o.w = xv.w + gv.w * acc[i][j][3];
        *(float4*)(p.out + (size_t)row * D + col) = o;
      }
    }
  }
}

constexpr int N_PHASES = 19;
template <int S>
__device__ __forceinline__ void run_stage(const Params& p, int l, unsigned char* smem) {
  if (S == -1) phase_prep(p, smem);
  if (S == 0) phase_norm(p, l);
  if (S == 1) phase_gemm_in(p, l, 0, ZAB / 128, ZAB, smem);
  if (S == 2) phase_mix_ab(p, l, smem);
  if (S == 3) phase_gemm_in(p, l, ZAB, ZC / 128, ZC, smem);
  if (S == 4) phase_mix1(p, l, smem);
  if (S == 5) phase_scan(p, l, smem);
  if (S == 6) phase_mix2(p, l, smem);
  if (S == 7) phase_gemm_br(p, l, smem);
  if (S == 8) phase_gemm_out(p, l, smem);
}


#define XB_TMO      128
#define XB_XCNT(j)  (256  + 64 * (j))
#define XB_XSUB(j)  (1280 + 64 * (j))
#define XB_XGEN(j)  (2304 + 64 * (j))
#define XB_TOP      3328
#define XB_TOPGEN   3392
#define XCD_BAR_WORDS 3456
#define XB_SPIN_CAP (1u << 18)
#define LAS __attribute__((address_space(3)))
__device__ __forceinline__ unsigned xb_ld(unsigned* p)              { return __hip_atomic_load(p, __ATOMIC_RELAXED, __HIP_MEMORY_SCOPE_AGENT); }
__device__ __forceinline__ unsigned xb_add(unsigned* p, unsigned v) { return __hip_atomic_fetch_add(p, v, __ATOMIC_RELAXED, __HIP_MEMORY_SCOPE_AGENT); }
__device__ __forceinline__ unsigned xb_xcc_id() { return (unsigned)__builtin_amdgcn_s_getreg((3 << 11) | 20) & 0xFu; }
#define XB_SPIN(cond, bar) do { unsigned _sp = 0; while (cond) { __builtin_amdgcn_s_sleep(1); \
    if ((++_sp & 255u) == 0u) { if (xb_ld(&(bar)[XB_TMO])) break; if (_sp > XB_SPIN_CAP) { atomicAdd(&(bar)[XB_TMO], 1u); break; } } } } while (0)
struct XcdBarrier { unsigned* bar; unsigned x; volatile LAS unsigned* st; };
__device__ __forceinline__ XcdBarrier xcd_barrier_post(unsigned* bar, volatile LAS unsigned* st) {
  XcdBarrier b; b.bar = bar; b.x = xb_xcc_id(); b.st = st;
  if (threadIdx.x == 0) (void)xb_add(&bar[XB_XCNT(b.x)], 1u);
  return b;
}
__device__ __forceinline__ void xcd_barrier_complete(unsigned* bar, unsigned x, unsigned& nloc, unsigned& nx) {
  const unsigned G = gridDim.x * gridDim.y * gridDim.z;
  unsigned sum, cnt, mine, sp = 0u;
  for (;;) {
    sum = 0u; cnt = 0u; mine = 0u;
#pragma unroll
    for (unsigned j = 0; j < 16; ++j) { const unsigned c = xb_ld(&bar[XB_XCNT(j)]); sum += c; cnt += (c > 0u) ? 1u : 0u; mine = (j == x) ? c : mine; }
    if (sum == G) break;
    __builtin_amdgcn_s_sleep(1);
    if ((++sp & 255u) == 0u) { if (xb_ld(&bar[XB_TMO])) break; if (sp > XB_SPIN_CAP) { atomicAdd(&bar[XB_TMO], 1u); break; } }
  }
  nloc = mine > 0u ? mine : 1u; nx = cnt > 0u ? cnt : 1u;
}
__device__ __forceinline__ void xcd_barrier(const XcdBarrier& b) {
  asm volatile("s_waitcnt vmcnt(0)" ::: "memory");
  __syncthreads();
  if (threadIdx.x == 0) {
    unsigned* bar = b.bar;
    __builtin_amdgcn_s_waitcnt(0);
    unsigned nloc = b.st[0], nx = b.st[1];
    if (nloc == 0u) { xcd_barrier_complete(bar, b.x, nloc, nx); b.st[0] = nloc; b.st[1] = nx; }
    const unsigned old = xb_add(&bar[XB_XSUB(b.x)], 1u);
    const unsigned gen = old / nloc;
    if (old + 1u == (gen + 1u) * nloc) {
      __builtin_amdgcn_fence(__ATOMIC_RELEASE, "agent");
      asm volatile("s_waitcnt vmcnt(0)" ::: "memory");
      const unsigned og = xb_add(&bar[XB_TOP], 1u);
      const unsigned tg = og / nx;
      if (og + 1u == (tg + 1u) * nx) xb_add(&bar[XB_TOPGEN], 1u);
      else XB_SPIN(xb_ld(&bar[XB_TOPGEN]) == tg, bar);
      __builtin_amdgcn_fence(__ATOMIC_ACQUIRE, "agent");
      xb_add(&bar[XB_XGEN(b.x)], 1u);
      asm volatile("s_waitcnt vmcnt(0)" ::: "memory");
    } else {
      XB_SPIN(xb_ld(&bar[XB_XGEN(b.x)]) == gen, bar);
      __builtin_amdgcn_fence(__ATOMIC_ACQUIRE, "agent");
      asm volatile("s_waitcnt vmcnt(0)" ::: "memory");
    }
  }
  __syncthreads();
}

#define GSYNC() xcd_barrier(xb)
__global__ void __launch_bounds__(256, 2) mega_kernel(Params p_in) {
  __shared__ __attribute__((aligned(16))) unsigned char smem[SMEM_BYTES];
  const Params& p = *(const Params*)__builtin_amdgcn_kernarg_segment_ptr();
  __shared__ uint4 xb_words;
  if (threadIdx.x == 0) xb_words = make_uint4(0u, 0u, 0u, 0u);
  __syncthreads();
  XcdBarrier xb = xcd_barrier_post((unsigned*)(p.ws + WS_BAR), (volatile LAS unsigned*)&xb_words);
  run_stage<-1>(p, 0, smem);
  if (p.out == nullptr) cg::this_grid().sync();
  GSYNC();
#define LAYER(L, LAST)                 \
  run_stage<0>(p, L, smem); GSYNC();   \
  run_stage<1>(p, L, smem); GSYNC();   \
  run_stage<2>(p, L, smem); GSYNC();   \
  run_stage<3>(p, L, smem); GSYNC();   \
  run_stage<4>(p, L, smem); GSYNC();   \
  run_stage<5>(p, L, smem); GSYNC();   \
  run_stage<6>(p, L, smem); GSYNC();   \
  run_stage<7>(p, L, smem); GSYNC();   \
  run_stage<8>(p, L, smem);            \
  if (!LAST) GSYNC();
  int l0 = 0, l1 = 1;
  asm volatile("" : "+s"(l0));
  asm volatile("" : "+s"(l1));
  LAYER(l0, 0)
  LAYER(l1, 1)
}

extern "C" void kernel_launch(void* const* d_in, const int* in_sizes, int n_in, void* d_out, int out_size, void* d_ws,
                              size_t ws_size, hipStream_t stream) {
  if (ws_size < WS_END || n_in < 29) { fprintf(stderr, "workspace too small / bad inputs\n"); return; }
  Params p{};
  const float** f = (const float**)&p;
  for (int i = 0; i < 29; ++i) f[i] = (const float*)d_in[i];
  p.out = (float*)d_out;
  p.ws = (unsigned char*)d_ws;
  static int grid_blocks = 0;
  if (!grid_blocks) {
    int dev = 0, cus = 0, per_cu = 0;
    (void)hipGetDevice(&dev);
    (void)hipDeviceGetAttribute(&cus, hipDeviceAttributeMultiprocessorCount, dev);
    (void)hipOccupancyMaxActiveBlocksPerMultiprocessor(&per_cu, mega_kernel, 256, 0);
    if (per_cu < 1) per_cu = 1;
    if (per_cu > 2) per_cu = 2;
    grid_blocks = cus * per_cu;
  }
  (void)hipMemsetAsync((unsigned char*)d_ws + WS_BAR, 0, 16384, stream);
  void* args[] = {&p};
  hipError_t e = hipLaunchCooperativeKernel((void*)mega_kernel, dim3(grid_blocks), dim3(256), args, 0, stream);
  if (e != hipSuccess) fprintf(stderr, "cooperative launch failed: %s (grid %d)\n", hipGetErrorString(e), grid_blocks);
}
```

```cpp
#include <hip/hip_runtime.h>
#include <hip/hip_cooperative_groups.h>
#include <cstdio>
namespace cg = cooperative_groups;

typedef unsigned short bf16;
typedef short bf16x8 __attribute__((ext_vector_type(8)));
typedef float f32x4 __attribute__((ext_vector_type(4)));
typedef unsigned u32x4 __attribute__((ext_vector_type(4)));
#define LDSP __attribute__((address_space(3)))

#ifndef SINGLE_LAUNCH
#define SINGLE_LAUNCH 0
#endif

constexpr int D = 1024, TP = 16384, TS = 1024, TT = TP + TS, SEQ = 4096;
constexpr int ZIN = 8456, NWIN = 8576;
constexpr int OFF_AV = 512, OFF_AG = 1024, OFF_BQ = 1536, OFF_BK = 2048, OFF_BV = 2176, OFF_BG = 2304, OFF_MG = 5384;
constexpr int ZAB = 2816;
constexpr int ZC = 2688;
constexpr int C_QK = 0, C_V = 1024, C_I = 1536, C_F = 1540, C_O = 1544, C_G = 2056;
constexpr float EPS = 1e-6f;
constexpr int NMOD = 132;
constexpr int SMEM_BYTES = 73728;

constexpr size_t O_Y = 0;
constexpr size_t O_SKP = (size_t)TT * D;
constexpr size_t O_SVP = O_SKP + 2 * 4 * 128 * 128;
constexpr size_t O_CVP = O_SVP + 2 * 4 * 128 * 128;
constexpr size_t O_CP = O_CVP + 2 * 4 * 3 * 1024;
constexpr size_t O_NP = O_CP + (size_t)2 * 4 * 4 * 128 * 128;
constexpr size_t O_MP = O_NP + 2 * 4 * 4 * 128;
constexpr size_t O_SKS = O_MP + 2 * 4 * 4;
constexpr size_t O_SVS = O_SKS + (size_t)2 * 128 * 128 * 128;
constexpr size_t O_CVS = O_SVS + (size_t)2 * 128 * 128 * 128;
constexpr size_t O_CS = O_CVS + (size_t)2 * 128 * 3 * 1024;
constexpr size_t O_NS = O_CS + (size_t)2 * 128 * 4 * 128 * 128;
constexpr size_t O_MS = O_NS + (size_t)2 * 128 * 4 * 128;
constexpr size_t O_GV = O_MS + 2 * 128 * 4;
constexpr size_t O_END = O_GV + (size_t)2 * 128 * 8 * 512;

constexpr size_t WS_WIN = 0;
constexpr size_t WS_WBR = WS_WIN + (size_t)2 * NWIN * 1024 * 2;
constexpr size_t WS_WOUT = WS_WBR + (size_t)2 * 1024 * 1536 * 2;
constexpr size_t WS_MOD = WS_WOUT + (size_t)2 * 1024 * 1024 * 2;
constexpr size_t WS_H = WS_MOD + (size_t)2 * NMOD * 3072 * 4;
constexpr size_t WS_YAB = WS_H + (size_t)TT * 1024 * 2;
constexpr size_t WS_U = WS_YAB + (size_t)TT * 1024 * 2;
constexpr size_t WS_UN = WS_U + (size_t)TT * 1024 * 2;
constexpr size_t WS_G = WS_UN + (size_t)1024 * 128 * 4;
constexpr size_t WS_TOT = WS_G + 4096;
constexpr size_t WS_M = WS_TOT + 4096;
constexpr size_t WS_Z = WS_M + 4096;
constexpr size_t WS_BAR = WS_Z + (size_t)TT * ZAB * 2;
constexpr size_t WS_END = WS_BAR + 16384;

struct Params {
  const float *x_prompt, *x_sample, *cache_k, *cache_v, *st_conv, *st_C, *st_n, *st_m, *c_prompt, *c_sample;
  const float *ada_w, *ada_b, *norm_g, *w_in, *b_in, *vnorm_g, *gmlp_ws, *gmlp_bs, *qn_g, *kn_g, *sinks;
  const float *conv_w, *conv_b, *f_bias, *hnorm_g, *w_a, *w_b, *w_c, *w_out;
  float* out;
  unsigned char* ws;
};

__device__ __forceinline__ int tidx() { int t = threadIdx.x; asm volatile("" : "+v"(t)); return t; }
__device__ __forceinline__ bf16 f2bf(float f) {
  unsigned u = __float_as_uint(f);
  u += 0x7fffu + ((u >> 16) & 1u);
  return (bf16)(u >> 16);
}
__device__ __forceinline__ float bf2f(bf16 h) { return __uint_as_float(((unsigned)h) << 16); }
__device__ __forceinline__ unsigned pack2(float a, float b) { return (unsigned)f2bf(a) | ((unsigned)f2bf(b) << 16); }
__device__ __forceinline__ float lo2f(unsigned u) { return __uint_as_float(u << 16); }
__device__ __forceinline__ float hi2f(unsigned u) { return __uint_as_float(u & 0xffff0000u); }
__device__ __forceinline__ void unpack8(const uint4& v, float* f) {
  f[0] = lo2f(v.x); f[1] = hi2f(v.x); f[2] = lo2f(v.y); f[3] = hi2f(v.y);
  f[4] = lo2f(v.z); f[5] = hi2f(v.z); f[6] = lo2f(v.w); f[7] = hi2f(v.w);
}
__device__ __forceinline__ void unpack4(const uint2& v, float* f) {
  f[0] = lo2f(v.x); f[1] = hi2f(v.x); f[2] = lo2f(v.y); f[3] = hi2f(v.y);
}
__device__ __forceinline__ float sigmoidf_(float x) { return __builtin_amdgcn_rcpf(1.0f + __expf(-x)); }
__device__ __forceinline__ float siluf_(float x) { return x * __builtin_amdgcn_rcpf(1.0f + __expf(-x)); }
__device__ __forceinline__ float logsigmoidf_(float x) { return fminf(x, 0.0f) - log1pf(__expf(-fabsf(x))); }
__device__ __forceinline__ float wave_sum(float v) {
#pragma unroll
  for (int o = 32; o >= 1; o >>= 1) v += __shfl_xor(v, o);
  return v;
}
__device__ __forceinline__ float wave_max(float v) {
#pragma unroll
  for (int o = 32; o >= 1; o >>= 1) v = fmaxf(v, __shfl_xor(v, o));
  return v;
}
__device__ __forceinline__ f32x4 mfma16(bf16x8 a, bf16x8 b, f32x4 c) {
  return __builtin_amdgcn_mfma_f32_16x16x32_bf16(a, b, c, 0, 0, 0);
}
template <int MI, int NI>
__device__ __forceinline__ void mma_lds(f32x4 (&acc)[MI][NI], const bf16* sA, int lda, const bf16* sB, int ldb, int K, int lane) {
  const int r = lane & 15, q = (lane >> 4) * 8;
  for (int k0 = 0; k0 < K; k0 += 32) {
    bf16x8 a[MI], b[NI];
#pragma unroll
    for (int i = 0; i < MI; ++i) a[i] = *(const bf16x8*)(sA + (i * 16 + r) * lda + k0 + q);
#pragma unroll
    for (int j = 0; j < NI; ++j) b[j] = *(const bf16x8*)(sB + (j * 16 + r) * ldb + k0 + q);
#pragma unroll
    for (int i = 0; i < MI; ++i)
#pragma unroll
      for (int j = 0; j < NI; ++j) acc[i][j] = mfma16(b[j], a[i], acc[i][j]);
  }
}

constexpr int GLD = 64;
constexpr int GTILE = 128 * GLD;
template <int NI>
__device__ __forceinline__ void g_load(u32x4 (&ra)[4], u32x4 (&rb)[NI], const bf16* __restrict__ A, int lda, const bf16* __restrict__ B, int ldb, int ko, int tid) {
  const unsigned offA = (unsigned)((tid >> 3) * lda + (tid & 7) * 8), offB = (unsigned)((tid >> 3) * ldb + (tid & 7) * 8);
#pragma unroll
  for (int i = 0; i < 4; ++i) {
    const bf16* Ai = A + (size_t)(i * 32) * lda + ko;
    ra[i] = *(const u32x4*)(Ai + offA);
  }
#pragma unroll
  for (int i = 0; i < NI; ++i) {
    const bf16* Bi = B + (size_t)(i * 32) * ldb + ko;
    rb[i] = *(const u32x4*)(Bi + offB);
  }
}
template <int NI>
__device__ __forceinline__ void g_store(const u32x4 (&ra)[4], const u32x4 (&rb)[NI], bf16* buf, int tid) {
  const int off = (tid >> 3) * GLD + (((tid & 7) ^ ((tid >> 3) & 7)) * 8);
#pragma unroll
  for (int i = 0; i < 4; ++i) *(u32x4*)(buf + off + i * 32 * GLD) = ra[i];
#pragma unroll
  for (int i = 0; i < NI; ++i) *(u32x4*)(buf + GTILE + off + i * 32 * GLD) = rb[i];
}
template <int NI, bool LOWREG = false>
__device__ __forceinline__ void g_compute(f32x4 (&acc)[4][NI], const bf16* cur, int wr, int wc, int lane) {
  const int r16 = lane & 15, sw = lane & 7, q = lane >> 4;
#pragma unroll
  for (int ks = 0; ks < 2; ++ks) {
    const int pc = ((ks * 4 + q) ^ sw) * 8;
    bf16x8 a[4];
#pragma unroll
    for (int i = 0; i < 4; ++i) a[i] = *(const bf16x8*)(cur + (wr * 64 + i * 16 + r16) * GLD + pc);
#pragma unroll
    for (int jh = 0; jh < NI; jh += 2) {
      bf16x8 b[2];
#pragma unroll
      for (int j = 0; j < 2; ++j) b[j] = *(const bf16x8*)(cur + GTILE + (wc * 16 * NI + (jh + j) * 16 + r16) * GLD + pc);
#pragma unroll
      for (int i = 0; i < 4; ++i)
#pragma unroll
        for (int j = 0; j < 2; ++j) acc[i][jh + j] = mfma16(b[j], a[i], acc[i][jh + j]);
      if (LOWREG) __builtin_amdgcn_sched_barrier(0);
    }
  }
}
template <int NI>
__device__ __forceinline__ void g_stage(const bf16* __restrict__ A, int lda, const bf16* __restrict__ B, int ldb, int ko, bf16* buf, int tid) {
  const int wave = tid >> 6;
  const int gch = ((tid & 7) ^ ((tid >> 3) & 7)) * 8;
  const unsigned offA = (unsigned)((tid >> 3) * lda + gch), offB = (unsigned)((tid >> 3) * ldb + gch);
#pragma unroll
  for (int i = 0; i < 4; ++i) {
    const bf16* Ai = A + (size_t)(i * 32) * lda + ko;
    __builtin_amdgcn_global_load_lds((const unsigned*)(Ai + offA), (LDSP unsigned*)(buf + (i * 32 + wave * 8) * GLD), 16, 0, 0);
  }
#pragma unroll
  for (int i = 0; i < NI; ++i) {
    const bf16* Bi = B + (size_t)(i * 32) * ldb + ko;
    __builtin_amdgcn_global_load_lds((const unsigned*)(Bi + offB), (LDSP unsigned*)(buf + GTILE + (i * 32 + wave * 8) * GLD), 16, 0, 0);
  }
}
template <int NI, bool LOWREG = false>
__device__ __forceinline__ void gemm_accum(f32x4 (&acc)[4][NI], const bf16* __restrict__ A, int lda,
                                           const bf16* __restrict__ B, int ldb, int K, bf16* sm) {
  const int tid = tidx(), lane = tid & 63, wave = tid >> 6, wr = wave >> 1, wc = wave & 1;
  const int nk = K >> 6;
  bf16* buf0 = sm;
  bf16* buf1 = sm + 2 * GTILE;
  g_stage<NI>(A, lda, B, ldb, 0, buf0, tid);
  asm volatile("s_waitcnt vmcnt(0)" ::: "memory");
  __syncthreads();
#pragma unroll 1
  for (int kt = 0; kt < nk; kt += 2) {
    g_stage<NI>(A, lda, B, ldb, (kt + 1) * 64, buf1, tid);
    g_compute<NI, LOWREG>(acc, buf0, wr, wc, lane);
    asm volatile("s_waitcnt vmcnt(0)" ::: "memory");
    __syncthreads();
    if (kt + 2 < nk) g_stage<NI>(A, lda, B, ldb, (kt + 2) * 64, buf0, tid);
    g_compute<NI, LOWREG>(acc, buf1, wr, wc, lane);
    asm volatile("s_waitcnt vmcnt(0)" ::: "memory");
    __syncthreads();
  }
}
template <int NI>
__device__ __forceinline__ void zero_acc(f32x4 (&acc)[4][NI]) {
#pragma unroll
  for (int i = 0; i < 4; ++i)
#pragma unroll
    for (int j = 0; j < NI; ++j) acc[i][j] = (f32x4){0.f, 0.f, 0.f, 0.f};
}
__device__ __forceinline__ void tile_map(int t, int ntn, int& pm, int& pn) {
  const int grp = t / (8 * ntn), w = t % (8 * ntn);
  pm = grp * 8 + (w & 7);
  pn = w >> 3;
}

__device__ __forceinline__ void transpose_tile(const float* __restrict__ src, int ld_src, int n_valid, bf16* __restrict__ dst, int ld_dst,
                               int k0, int n0, int kdst0, float* sm) {
  const int tid = tidx();
  for (int i = tid; i < 64 * 16; i += 256) {
    const int kk = i >> 4, n4 = (i & 15) * 4, n = n0 + n4;
    float4 v = make_float4(0.f, 0.f, 0.f, 0.f);
    if (n + 3 < n_valid) v = *(const float4*)(src + (size_t)(k0 + kk) * ld_src + n);
    sm[kk * 65 + n4 + 0] = v.x; sm[kk * 65 + n4 + 1] = v.y; sm[kk * 65 + n4 + 2] = v.z; sm[kk * 65 + n4 + 3] = v.w;
  }
  __syncthreads();
  for (int i = tid; i < 64 * 8; i += 256) {
    const int nn = i >> 3, kc = (i & 7) * 8;
    uint4 o;
    o.x = pack2(sm[(kc + 0) * 65 + nn], sm[(kc + 1) * 65 + nn]);
    o.y = pack2(sm[(kc + 2) * 65 + nn], sm[(kc + 3) * 65 + nn]);
    o.z = pack2(sm[(kc + 4) * 65 + nn], sm[(kc + 5) * 65 + nn]);
    o.w = pack2(sm[(kc + 6) * 65 + nn], sm[(kc + 7) * 65 + nn]);
    *(uint4*)(dst + (size_t)(n0 + nn) * ld_dst + kdst0 + kc) = o;
  }
  __syncthreads();
}

__device__ __forceinline__ void ada_item(const Params& p, int item, float* sm) {
  const int l = item / 192, n0 = (item % 192) * 16;
  const int tid = tidx(), col = tid & 15, rg = tid >> 4;
  constexpr int SLD = 68;
  float* sW = sm + 144 * SLD;
  float acc[9];
#pragma unroll
  for (int j = 0; j < 9; ++j) acc[j] = 0.f;
  const float* W = p.ada_w + (size_t)l * 1024 * 3072 + n0;
  const int wk = tid >> 2, wc4 = (tid & 3) * 4;
  float v[36];
  float4 w0;
#define ADA_LOAD(K0)                                                                                      \
  {                                                                                                       \
    _Pragma("unroll") for (int u = 0; u < 36; ++u) {                                                      \
      const int i = tid + 256 * u, r = i >> 6, kk = i & 63;                                               \
      v[u] = 0.f;                                                                                         \
      if (r < NMOD) v[u] = (r < 4) ? p.c_prompt[r * 1024 + (K0) + kk] : p.c_sample[(r - 4) * 1024 + (K0) + kk]; \
    }                                                                                                     \
    w0 = *(const float4*)(W + (size_t)((K0) + wk) * 3072 + wc4);                                          \
  }
#define ADA_STORE()                                                                                       \
  {                                                                                                       \
    _Pragma("unroll") for (int u = 0; u < 36; ++u) {                                                      \
      const int i = tid + 256 * u, r = i >> 6, kk = i & 63;                                               \
      sm[r * SLD + kk] = siluf_(v[u]);                                                                    \
    }                                                                                                     \
    *(float4*)(sW + wk * 16 + wc4) = w0;                                                                  \
  }
  ADA_LOAD(0)
  ADA_STORE()
  __syncthreads();
#pragma unroll 1
  for (int k0 = 0; k0 < 1024; k0 += 64) {
    if (k0 + 64 < 1024) ADA_LOAD(k0 + 64)
#pragma unroll 4
    for (int k4 = 0; k4 < 16; ++k4) {
      const float x0 = sW[(k4 * 4 + 0) * 16 + col], x1 = sW[(k4 * 4 + 1) * 16 + col];
      const float x2 = sW[(k4 * 4 + 2) * 16 + col], x3 = sW[(k4 * 4 + 3) * 16 + col];
#pragma unroll
      for (int j = 0; j < 9; ++j) {
        const float4 sv = *(const float4*)(sm + (rg * 9 + j) * SLD + k4 * 4);
        acc[j] += sv.x * x0 + sv.y * x1 + sv.z * x2 + sv.w * x3;
      }
    }
    __syncthreads();
    if (k0 + 64 < 1024) ADA_STORE()
    __syncthreads();
  }
#undef ADA_LOAD
#undef ADA_STORE
  float* mod = (float*)(p.ws + WS_MOD);
  const float b = p.ada_b[l * 3072 + n0 + col];
#pragma unroll
  for (int j = 0; j < 9; ++j) {
    const int r = rg * 9 + j;
    if (r < NMOD) mod[((size_t)l * NMOD + r) * 3072 + n0 + col] = acc[j] + b;
  }
}

__device__ __forceinline__ void phase_prep(const Params& p, unsigned char* smem) {
  float* sm = (float*)smem;
  constexpr int N_WIN = 2 * 16 * (NWIN / 64);
  constexpr int N_WBR = 2 * 3 * 8 * 16;
  constexpr int N_WOUT = 2 * 16 * 16;
  constexpr int N_ALL = N_WIN + N_WBR + N_WOUT;
  bf16* WinT = (bf16*)(p.ws + WS_WIN);
  bf16* WbrT = (bf16*)(p.ws + WS_WBR);
  bf16* WoutT = (bf16*)(p.ws + WS_WOUT);
  constexpr int N_ADA = 384;
  for (int it = blockIdx.x; it < N_ADA + N_ALL; it += gridDim.x) {
    if (it < N_ADA) { ada_item(p, it, sm); continue; }
    int i = it - N_ADA;
    if (i < N_WIN) {
      const int l = i / (16 * 134), r = i % (16 * 134), kt = r / 134, nt = r % 134;
      transpose_tile(p.w_in + (size_t)l * 1024 * ZIN, ZIN, ZIN, WinT + (size_t)l * NWIN * 1024, 1024, kt * 64, nt * 64, kt * 64, sm);
      continue;
    }
    i -= N_WIN;
    if (i < N_WBR) {
      const int l = i / 384, r = i % 384, seg = r / 128, r2 = r % 128, kt = r2 / 16, nt = r2 % 16;
      const float* src = (seg == 0 ? p.w_a : seg == 1 ? p.w_b : p.w_c) + (size_t)l * 512 * 1024;
      transpose_tile(src, 1024, 1024, WbrT + (size_t)l * 1024 * 1536, 1536, kt * 64, nt * 64, seg * 512 + kt * 64, sm);
      continue;
    }
    i -= N_WBR;
    {
      const int l = i / 256, r = i % 256, kt = r / 16, nt = r % 16;
      transpose_tile(p.w_out + (size_t)l * 1024 * 1024, 1024, 1024, WoutT + (size_t)l * 1024 * 1024, 1024, kt * 64, nt * 64, kt * 64, sm);
    }
  }
}

__device__ __forceinline__ const float* xrow_ptr(const Params& p, int l, int row) {
  if (l == 0) return row < TP ? p.x_prompt + (size_t)row * D : p.x_sample + (size_t)(row - TP) * D;
  return p.out + (size_t)row * D;
}
__device__ __forceinline__ int mod_row(int row) { return row < TP ? (row >> 12) : 4 + ((row - TP) >> 3); }

__device__ __forceinline__ void phase_norm(const Params& p, int l) {
  const int lane = tidx() & 63, wave = tidx() >> 6;
  bf16* hbuf = (bf16*)(p.ws + WS_H);
  const float* mod = (const float*)(p.ws + WS_MOD);
  const float* g = p.norm_g + l * D;
  for (int row = blockIdx.x * 4 + wave; row < TT; row += gridDim.x * 4) {
    const float4* x = (const float4*)xrow_ptr(p, l, row);
    float4 v[4];
    float ss = 0.f;
#pragma unroll
    for (int i = 0; i < 4; ++i) {
      v[i] = x[lane + 64 * i];
      ss += v[i].x * v[i].x + v[i].y * v[i].y + v[i].z * v[i].z + v[i].w * v[i].w;
    }
    ss = wave_sum(ss);
    const float rstd = rsqrtf(ss * (1.0f / D) + EPS);
    const float* mp = mod + ((size_t)l * NMOD + mod_row(row)) * 3072;
#pragma unroll
    for (int i = 0; i < 4; ++i) {
      const int c = (lane + 64 * i) * 4;
      const float4 gg = *(const float4*)(g + c), sh = *(const float4*)(mp + c), sc = *(const float4*)(mp + 1024 + c);
      uint2 o;
      o.x = pack2(v[i].x * rstd * gg.x * (1.f + sc.x) + sh.x, v[i].y * rstd * gg.y * (1.f + sc.y) + sh.y);
      o.y = pack2(v[i].z * rstd * gg.z * (1.f + sc.z) + sh.z, v[i].w * rstd * gg.w * (1.f + sc.w) + sh.w);
      *(uint2*)(hbuf + (size_t)row * D + c) = o;
    }
  }
}

__device__ __forceinline__ void phase_gemm_in(const Params& p, int l, int col0, int ntn, int ldz, unsigned char* smem) {
  bf16* sm = (bf16*)smem;
  const bf16* hbuf = (const bf16*)(p.ws + WS_H);
  const bf16* W = (const bf16*)(p.ws + WS_WIN) + (size_t)l * NWIN * 1024;
  bf16* z = (bf16*)(p.ws + WS_Z);
  const float* bias = p.b_in + (size_t)l * ZIN;
  const int tid = tidx(), lane = tid & 63, wave = tid >> 6, wr = wave >> 1, wc = wave & 1;
  const int ntiles = (TT / 128) * ntn;
  constexpr int OLD = 136;
  for (int t = blockIdx.x; t < ntiles; t += gridDim.x) {
    int pm, pn;
    tile_map(t, ntn, pm, pn);
    const int m0 = pm * 128, n0 = pn * 128;
    f32x4 acc[4][4];
    zero_acc<4>(acc);
    gemm_accum<4>(acc, hbuf + (size_t)m0 * 1024, 1024, W + (size_t)(col0 + n0) * 1024, 1024, 1024, sm);
#pragma unroll
    for (int j = 0; j < 4; ++j) {
      const int cl = wc * 64 + j * 16 + (lane >> 4) * 4;
      const float4 b = *(const float4*)(bias + col0 + n0 + cl);
#pragma unroll
      for (int i = 0; i < 4; ++i) {
        const int rl = wr * 64 + i * 16 + (lane & 15);
        uint2 o;
        o.x = pack2(acc[i][j][0] + b.x, acc[i][j][1] + b.y);
        o.y = pack2(acc[i][j][2] + b.z, acc[i][j][3] + b.w);
        *(uint2*)(sm + rl * OLD + cl) = o;
      }
    }
    __syncthreads();
#pragma unroll
    for (int it = 0; it < 8; ++it) {
      const int id = tid + 256 * it, row = id >> 4, ch = id & 15;
      const u32x4 v = *(const u32x4*)(sm + row * OLD + ch * 8);
      *(u32x4*)(z + (size_t)(m0 + row) * ldz + n0 + ch * 8) = v;
    }
    __syncthreads();
  }
}

__device__ __forceinline__ void gmlp_prompt_item(const Params& p, int l, int item, unsigned char* smem) {
  const int b = item >> 7, n = (item >> 2) & 31, g = item & 3;
  const int r0 = b * SEQ + n * 128;
  const bf16* z = (const bf16*)(p.ws + WS_Z);
  bf16* yab = (bf16*)(p.ws + WS_YAB);
  bf16* sW = (bf16*)smem;
  bf16* sV = (bf16*)(smem + 34816);
  float* srstd = (float*)(smem + 69632);
  const int tid = tidx(), lane = tid & 63, wave = tid >> 6, wr = wave >> 1, wc = wave & 1;
  {
    const int tok = tid >> 1, half = tid & 1;
    const uint4* ptr = (const uint4*)(z + (size_t)(r0 + tok) * ZAB + OFF_AV + half * 256);
    float ss = 0.f;
    for (int i = 0; i < 32; ++i) {
      float f[8];
      unpack8(ptr[i], f);
#pragma unroll
      for (int j = 0; j < 8; ++j) ss += f[j] * f[j];
    }
    ss += __shfl_xor(ss, 1);
    if (half == 0) srstd[tok] = rsqrtf(ss * (1.0f / 512.f) + EPS);
  }
  __syncthreads();
  const float* vg = p.vnorm_g + l * 512 + g * 128;
  for (int i = tid; i < 2048; i += 256) {
    const int s = i >> 4, c8 = (i & 15) * 8;
    float f[8];
    unpack8(*(const uint4*)(z + (size_t)(r0 + s) * ZAB + OFF_AV + g * 128 + c8), f);
    const float rs = srstd[s];
#pragma unroll
    for (int j = 0; j < 8; ++j) sV[(c8 + j) * 136 + s] = f2bf(f[j] * rs * vg[c8 + j]);
  }
  const float* Wg = p.gmlp_ws + ((size_t)(l * 4 + g)) * 128 * 128;
  for (int i = tid; i < 4096; i += 256) {
    const int t = i >> 5, s4 = (i & 31) * 4;
    const float4 w = *(const float4*)(Wg + t * 128 + s4);
    uint2 o;
    o.x = pack2(s4 + 0 <= t ? w.x : 0.f, s4 + 1 <= t ? w.y : 0.f);
    o.y = pack2(s4 + 2 <= t ? w.z : 0.f, s4 + 3 <= t ? w.w : 0.f);
    *(uint2*)(sW + t * 136 + s4) = o;
  }
  __syncthreads();
  f32x4 acc[4][4];
  zero_acc<4>(acc);
  mma_lds<4, 4>(acc, sW + wr * 64 * 136, 136, sV + wc * 64 * 136, 136, wr * 64 + 64, lane);
  const float* bs = p.gmlp_bs + (l * 4 + g) * 128;
#pragma unroll
  for (int i = 0; i < 4; ++i) {
    const int t = wr * 64 + i * 16 + (lane & 15);
    const float bst = bs[t];
    const size_t rowoff = (size_t)(r0 + t) * ZAB;
#pragma unroll
    for (int j = 0; j < 4; ++j) {
      const int c = g * 128 + wc * 64 + j * 16 + (lane >> 4) * 4;
      float u[4], ag[4];
      unpack4(*(const uint2*)(z + rowoff + c), u);
      unpack4(*(const uint2*)(z + rowoff + OFF_AG + c), ag);
      uint2 o;
      o.x = pack2(u[0] * (acc[i][j][0] + bst) * siluf_(ag[0]), u[1] * (acc[i][j][1] + bst) * siluf_(ag[1]));
      o.y = pack2(u[2] * (acc[i][j][2] + bst) * siluf_(ag[2]), u[3] * (acc[i][j][3] + bst) * siluf_(ag[3]));
      *(uint2*)(yab + (size_t)(r0 + t) * 1024 + c) = o;
    }
  }
  __syncthreads();
}

__device__ __forceinline__ void gmlp_sample_item(const Params& p, int l, int b, unsigned char* smem) {
  const int r0 = TP + b * 8;
  const bf16* z = (const bf16*)(p.ws + WS_Z);
  bf16* yab = (bf16*)(p.ws + WS_YAB);
  float* svn = (float*)smem;
  const int tid = tidx(), lane = tid & 63, wave = tid >> 6;
  const float* vg = p.vnorm_g + l * 512;
  for (int tt = 0; tt < 2; ++tt) {
    const int t = wave * 2 + tt;
    float f[8];
    unpack8(*(const uint4*)(z + (size_t)(r0 + t) * ZAB + OFF_AV + lane * 8), f);
    float ss = 0.f;
#pragma unroll
    for (int j = 0; j < 8; ++j) ss += f[j] * f[j];
    ss = wave_sum(ss);
    const float rstd = rsqrtf(ss * (1.0f / 512.f) + EPS);
    float* gv = p.out + O_GV + (((size_t)l * 128 + b) * 8 + t) * 512 + lane * 8;
#pragma unroll
    for (int j = 0; j < 8; ++j) {
      const float vn = f[j] * rstd * vg[lane * 8 + j];
      svn[t * 512 + lane * 8 + j] = vn;
      gv[j] = vn;
    }
  }
  __syncthreads();
  {
    const int c = tid * 2, g = c >> 7;
    const float* Wg = p.gmlp_ws + ((size_t)(l * 4 + g)) * 128 * 128;
    const float* bs = p.gmlp_bs + (l * 4 + g) * 128;
    for (int t = 0; t < 8; ++t) {
      float s0 = bs[t], s1 = bs[t];
      for (int s = 0; s <= t; ++s) {
        const float w = Wg[t * 128 + s];
        s0 += w * svn[s * 512 + c];
        s1 += w * svn[s * 512 + c + 1];
      }
      const unsigned uu = *(const unsigned*)(z + (size_t)(r0 + t) * ZAB + c);
      const unsigned gg = *(const unsigned*)(z + (size_t)(r0 + t) * ZAB + OFF_AG + c);
      *(unsigned*)(yab + (size_t)(r0 + t) * 1024 + c) = pack2(lo2f(uu) * s0 * siluf_(lo2f(gg)), hi2f(uu) * s1 * siluf_(hi2f(gg)));
    }
  }
  __syncthreads();
}

__device__ __forceinline__ void swa_prompt_item(const Params& p, int l, int item, unsigned char* smem) {
  const int b = item >> 7, qt = (item >> 1) & 63, kv = item & 1;
  const int q0 = qt * 64, rb = b * SEQ;
  const bf16* z = (const bf16*)(p.ws + WS_Z);
  bf16* yab = (bf16*)(p.ws + WS_YAB);
  bf16* sK = (bf16*)smem;
  bf16* sVT = (bf16*)(smem + 27648);
  const int tid = tidx(), lane = tid & 63, wave = tid >> 6;
  const float* kg = p.kn_g + l * 64;
  const float* qg = p.qn_g + l * 64;
#pragma unroll 1
  for (int it = 0; it < 6; ++it) {
    const int id = tid + 256 * it, kk = id >> 3, ch = id & 7, kp = q0 - 128 + kk;
    float f[8];
    uint4 vraw = make_uint4(0, 0, 0, 0);
    if (kp >= 0) {
      unpack8(*(const uint4*)(z + (size_t)(rb + kp) * ZAB + OFF_BK + kv * 64 + ch * 8), f);
      vraw = *(const uint4*)(z + (size_t)(rb + kp) * ZAB + OFF_BV + kv * 64 + ch * 8);
    } else {
#pragma unroll
      for (int j = 0; j < 8; ++j) f[j] = 0.f;
    }
    float ss = 0.f;
#pragma unroll
    for (int j = 0; j < 8; ++j) ss += f[j] * f[j];
    ss += __shfl_xor(ss, 1); ss += __shfl_xor(ss, 2); ss += __shfl_xor(ss, 4);
    const float rstd = rsqrtf(ss * (1.0f / 64.f) + EPS);
#pragma unroll
    for (int j = 0; j < 8; ++j) f[j] = f[j] * rstd * kg[ch * 8 + j];
    uint4 ko;
    ko.x = pack2(f[0], f[1]); ko.y = pack2(f[2], f[3]); ko.z = pack2(f[4], f[5]); ko.w = pack2(f[6], f[7]);
    *(uint4*)(sK + kk * 72 + ch * 8) = ko;
    float vf[8];
    unpack8(vraw, vf);
#pragma unroll
    for (int j = 0; j < 8; ++j) sVT[(ch * 8 + j) * 200 + kk] = f2bf(vf[j]);
    if (kk >= 128 && kp >= SEQ - 128) {
      const size_t o = ((((size_t)l * 4 + b) * 128 + (kp - (SEQ - 128))) * 2 + kv) * 64 + ch * 8;
#pragma unroll
      for (int j = 0; j < 8; ++j) { p.out[O_SKP + o + j] = f[j]; p.out[O_SVP + o + j] = vf[j]; }
    }
  }
  __syncthreads();
  const int h = kv * 4 + wave;
  const float sink = p.sinks[l * 8 + h];
  const int g4 = lane >> 4, r16 = lane & 15;
#pragma unroll 1
  for (int i = 0; i < 4; ++i) {
    const int qrow = q0 + i * 16 + r16;
    const size_t grow = (size_t)(rb + qrow);
    bf16x8 qf[2];
    {
      float f0[8], f1[8];
      unpack8(*(const uint4*)(z + grow * ZAB + OFF_BQ + h * 64 + g4 * 8), f0);
      unpack8(*(const uint4*)(z + grow * ZAB + OFF_BQ + h * 64 + 32 + g4 * 8), f1);
      float ss = 0.f;
#pragma unroll
      for (int j = 0; j < 8; ++j) ss += f0[j] * f0[j] + f1[j] * f1[j];
      ss += __shfl_xor(ss, 16); ss += __shfl_xor(ss, 32);
      const float rstd = rsqrtf(ss * (1.0f / 64.f) + EPS) * 0.125f;
#pragma unroll
      for (int j = 0; j < 8; ++j) {
        qf[0][j] = (short)f2bf(f0[j] * rstd * qg[g4 * 8 + j]);
        qf[1][j] = (short)f2bf(f1[j] * rstd * qg[32 + g4 * 8 + j]);
      }
    }
    f32x4 st[12];
#pragma unroll
    for (int kt = 0; kt < 12; ++kt) {
      st[kt] = (f32x4){0.f, 0.f, 0.f, 0.f};
#pragma unroll
      for (int ks = 0; ks < 2; ++ks) {
        const bf16x8 kf = *(const bf16x8*)(sK + (kt * 16 + r16) * 72 + ks * 32 + g4 * 8);
        st[kt] = mfma16(kf, qf[ks], st[kt]);
      }
      if ((kt & 1) == 1) __builtin_amdgcn_sched_barrier(0);
    }
    float mx = -INFINITY;
#pragma unroll
    for (int kt = 0; kt < 12; ++kt)
#pragma unroll
      for (int x = 0; x < 4; ++x) {
        const int kp = q0 - 128 + kt * 16 + g4 * 4 + x, diff = qrow - kp;
        const bool valid = (kp >= 0) && (diff >= 0) && (diff < 128);
        st[kt][x] = valid ? st[kt][x] : -INFINITY;
        mx = fmaxf(mx, st[kt][x]);
      }
    mx = fmaxf(mx, __shfl_xor(mx, 16)); mx = fmaxf(mx, __shfl_xor(mx, 32));
    mx = fmaxf(mx, sink);
    float sum = 0.f;
#pragma unroll
    for (int kt = 0; kt < 12; ++kt)
#pragma unroll
      for (int x = 0; x < 4; ++x) {
        const float pv = __expf(st[kt][x] - mx);
        st[kt][x] = pv;
        sum += pv;
      }
    sum += __shfl_xor(sum, 16); sum += __shfl_xor(sum, 32);
    const float inv = 1.0f / (sum + __expf(sink - mx));
    f32x4 o[4];
#pragma unroll
    for (int dt = 0; dt < 4; ++dt) o[dt] = (f32x4){0.f, 0.f, 0.f, 0.f};
#pragma unroll
    for (int t2 = 0; t2 < 6; ++t2) {
      bf16x8 pf;
#pragma unroll
      for (int x = 0; x < 4; ++x) { pf[x] = (short)f2bf(st[2 * t2][x]); pf[4 + x] = (short)f2bf(st[2 * t2 + 1][x]); }
#pragma unroll
      for (int dt = 0; dt < 4; ++dt) {
        const uint2 v0 = *(const uint2*)(sVT + (dt * 16 + r16) * 200 + t2 * 32 + g4 * 4);
        const uint2 v1 = *(const uint2*)(sVT + (dt * 16 + r16) * 200 + t2 * 32 + 16 + g4 * 4);
        union { uint4 u; bf16x8 v; } cv;
        cv.u = make_uint4(v0.x, v0.y, v1.x, v1.y);
        o[dt] = mfma16(cv.v, pf, o[dt]);
      }
      __builtin_amdgcn_sched_barrier(0);
    }
#pragma unroll
    for (int dt = 0; dt < 4; ++dt) {
      const int d0 = dt * 16 + g4 * 4;
      float bg[4];
      unpack4(*(const uint2*)(z + grow * ZAB + OFF_BG + h * 64 + d0), bg);
      uint2 oo;
      oo.x = pack2(o[dt][0] * inv * siluf_(bg[0]), o[dt][1] * inv * siluf_(bg[1]));
      oo.y = pack2(o[dt][2] * inv * siluf_(bg[2]), o[dt][3] * inv * siluf_(bg[3]));
      *(uint2*)(yab + grow * 1024 + 512 + h * 64 + d0) = oo;
    }
  }
  __syncthreads();
}

__device__ __forceinline__ void swa_sample_item(const Params& p, int l, int item, unsigned char* smem) {
  const int b = item >> 1, kv = item & 1;
  const int r0 = TP + b * 8;
  const bf16* z = (const bf16*)(p.ws + WS_Z);
  bf16* yab = (bf16*)(p.ws + WS_YAB);
  bf16* sK = (bf16*)smem;
  bf16* sV = (bf16*)(smem + 19584);
  float* sq = (float*)(smem + 39168);
  float* sP = (float*)(smem + 47488);
  const int tid = tidx();
  const float* kg = p.kn_g + l * 64;
  const float* qg = p.qn_g + l * 64;
  const float* ck = p.cache_k + ((size_t)l * 128 + b) * 128 * 128;
  const float* cvp = p.cache_v + ((size_t)l * 128 + b) * 128 * 128;
#pragma unroll 1
  for (int it = 0; it < 5; ++it) {
    const int id = tid + 256 * it, j = id >> 3, ch = id & 7;
    const bool act = id < 1088;
    float kf[8], vf[8];
#pragma unroll
    for (int x = 0; x < 8; ++x) { kf[x] = 0.f; vf[x] = 0.f; }
    if (act) {
      if (j < 128) {
        const float4 a0 = *(const float4*)(ck + (j * 2 + kv) * 64 + ch * 8), a1 = *(const float4*)(ck + (j * 2 + kv) * 64 + ch * 8 + 4);
        const float4 b0 = *(const float4*)(cvp + (j * 2 + kv) * 64 + ch * 8), b1 = *(const float4*)(cvp + (j * 2 + kv) * 64 + ch * 8 + 4);
        kf[0] = a0.x; kf[1] = a0.y; kf[2] = a0.z; kf[3] = a0.w; kf[4] = a1.x; kf[5] = a1.y; kf[6] = a1.z; kf[7] = a1.w;
        vf[0] = b0.x; vf[1] = b0.y; vf[2] = b0.z; vf[3] = b0.w; vf[4] = b1.x; vf[5] = b1.y; vf[6] = b1.z; vf[7] = b1.w;
      } else {
        unpack8(*(const uint4*)(z + (size_t)(r0 + j - 128) * ZAB + OFF_BK + kv * 64 + ch * 8), kf);
        unpack8(*(const uint4*)(z + (size_t)(r0 + j - 128) * ZAB + OFF_BV + kv * 64 + ch * 8), vf);
      }
    }
    float ss = 0.f;
#pragma unroll
    for (int x = 0; x < 8; ++x) ss += kf[x] * kf[x];
    ss += __shfl_xor(ss, 1); ss += __shfl_xor(ss, 2); ss += __shfl_xor(ss, 4);
    if (act) {
      if (j >= 128) {
        const float rstd = rsqrtf(ss * (1.0f / 64.f) + EPS);
#pragma unroll
        for (int x = 0; x < 8; ++x) kf[x] = kf[x] * rstd * kg[ch * 8 + x];
      }
      uint4 ko, vo;
      ko.x = pack2(kf[0], kf[1]); ko.y = pack2(kf[2], kf[3]); ko.z = pack2(kf[4], kf[5]); ko.w = pack2(kf[6], kf[7]);
      vo.x = pack2(vf[0], vf[1]); vo.y = pack2(vf[2], vf[3]); vo.z = pack2(vf[4], vf[5]); vo.w = pack2(vf[6], vf[7]);
      *(uint4*)(sK + j * 72 + ch * 8) = ko;
      *(uint4*)(sV + j * 72 + ch * 8) = vo;
      if (j >= 8) {
        const size_t o = ((((size_t)l * 128 + b) * 128 + (j - 8)) * 2 + kv) * 64 + ch * 8;
        *(float4*)(p.out + O_SKS + o) = make_float4(kf[0], kf[1], kf[2], kf[3]);
        *(float4*)(p.out + O_SKS + o + 4) = make_float4(kf[4], kf[5], kf[6], kf[7]);
        *(float4*)(p.out + O_SVS + o) = make_float4(vf[0], vf[1], vf[2], vf[3]);
        *(float4*)(p.out + O_SVS + o + 4) = make_float4(vf[4], vf[5], vf[6], vf[7]);
      }
    }
  }
  const int qi = tid >> 3, sub = tid & 7, t = qi >> 2, h = kv * 4 + (qi & 3);
  {
    float f[8];
    unpack8(*(const uint4*)(z + (size_t)(r0 + t) * ZAB + OFF_BQ + h * 64 + sub * 8), f);
    float ss = 0.f;
#pragma unroll
    for (int x = 0; x < 8; ++x) ss += f[x] * f[x];
    ss += __shfl_xor(ss, 1); ss += __shfl_xor(ss, 2); ss += __shfl_xor(ss, 4);
    const float rstd = rsqrtf(ss * (1.0f / 64.f) + EPS) * 0.125f;
#pragma unroll
    for (int x = 0; x < 8; ++x) sq[qi * 65 + sub * 8 + x] = f[x] * rstd * qg[sub * 8 + x];
  }
  __syncthreads();
  const float sink = p.sinks[l * 8 + h];
  float mx = -INFINITY;
#pragma unroll 1
  for (int jj = 0; jj < 17; ++jj) {
    const int key = sub + 8 * jj;
    float s = 0.f;
#pragma unroll 8
    for (int d = 0; d < 64; ++d) s += sq[qi * 65 + d] * bf2f(sK[key * 72 + d]);
    const bool valid = (key >= t + 1) && (key <= t + 128);
    s = valid ? s : -INFINITY;
    sP[qi * 140 + key] = s;
    mx = fmaxf(mx, s);
  }
  mx = fmaxf(mx, __shfl_xor(mx, 1)); mx = fmaxf(mx, __shfl_xor(mx, 2)); mx = fmaxf(mx, __shfl_xor(mx, 4));
  mx = fmaxf(mx, sink);
  float sum = 0.f;
  for (int jj = 0; jj < 17; ++jj) {
    const int key = sub + 8 * jj;
    const float pv = __expf(sP[qi * 140 + key] - mx);
    sP[qi * 140 + key] = pv;
    sum += pv;
  }
  sum += __shfl_xor(sum, 1); sum += __shfl_xor(sum, 2); sum += __shfl_xor(sum, 4);
  const float inv = 1.0f / (sum + __expf(sink - mx));
  __syncthreads();
  {
    float o[8];
#pragma unroll
    for (int x = 0; x < 8; ++x) o[x] = 0.f;
#pragma unroll 2
    for (int key = 0; key < 136; ++key) {
      const float pv = sP[qi * 140 + key];
      float vf[8];
      unpack8(*(const uint4*)(sV + key * 72 + sub * 8), vf);
#pragma unroll
      for (int x = 0; x < 8; ++x) o[x] += pv * vf[x];
    }
    float bg[8];
    unpack8(*(const uint4*)(z + (size_t)(r0 + t) * ZAB + OFF_BG + h * 64 + sub * 8), bg);
    uint4 oo;
    oo.x = pack2(o[0] * inv * siluf_(bg[0]), o[1] * inv * siluf_(bg[1]));
    oo.y = pack2(o[2] * inv * siluf_(bg[2]), o[3] * inv * siluf_(bg[3]));
    oo.z = pack2(o[4] * inv * siluf_(bg[4]), o[5] * inv * siluf_(bg[5]));
    oo.w = pack2(o[6] * inv * siluf_(bg[6]), o[7] * inv * siluf_(bg[7]));
    *(uint4*)(yab + (size_t)(r0 + t) * 1024 + 512 + h * 64 + sub * 8) = oo;
  }
  __syncthreads();
}

__device__ __forceinline__ void phase_mix_ab(const Params& p, int l, unsigned char* smem) {
  constexpr int N_SWA = 512, N_GM = 512, N_SWS = 256, N_GMS = 128;
  constexpr int N_ALL = N_SWA + N_GM + N_SWS + N_GMS;
  for (int it = blockIdx.x; it < N_ALL; it += gridDim.x) {
    int i = it;
    if (i < N_SWA) { swa_prompt_item(p, l, i, smem); continue; }
    i -= N_SWA;
    if (i < N_GM) { gmlp_prompt_item(p, l, i, smem); continue; }
    i -= N_GM;
    if (i < N_SWS) { swa_sample_item(p, l, i, smem); continue; }
    i -= N_SWS;
    gmlp_sample_item(p, l, i, smem);
  }
}

__device__ __forceinline__ void conv8_prompt(const Params& p, int l, const bf16* z, int r0, int pos0, int s, int zc, float* y) {
  const float* cw = p.conv_w + (size_t)l * 4 * 1024 + zc;
  const float* cb = p.conv_b + l * 1024 + zc;
#pragma unroll
  for (int j = 0; j < 8; ++j) y[j] = cb[j];
#pragma unroll
  for (int tap = 0; tap < 4; ++tap) {
    const int back = 3 - tap;
    if (pos0 + s - back >= 0) {
      float f[8];
      unpack8(*(const uint4*)(z + (size_t)(r0 + s - back) * ZC + C_QK + zc), f);
#pragma unroll
      for (int j = 0; j < 8; ++j) y[j] += cw[tap * 1024 + j] * f[j];
    }
  }
#pragma unroll
  for (int j = 0; j < 8; ++j) y[j] = siluf_(y[j]);
}

__device__ __forceinline__ void chunk_gates(const Params& p, int l, const bf16* z, int r0, int hh, int lane, float& cum, float& iv) {
  const float f = bf2f(z[(size_t)(r0 + lane) * ZC + C_F + hh]) + p.f_bias[l * 4 + hh];
  iv = bf2f(z[(size_t)(r0 + lane) * ZC + C_I + hh]);
  float c = logsigmoidf_(f);
#pragma unroll
  for (int o = 1; o < 64; o <<= 1) {
    const float n = __shfl_up(c, o);
    if (lane >= o) c += n;
  }
  cum = c;
}

__device__ __forceinline__ void mlstm_local_item(const Params& p, int l, int item, unsigned char* smem) {
  const int bh = item >> 6, c = item & 63, b = bh >> 2, hh = bh & 3;
  const int r0 = b * SEQ + c * 64;
  const bf16* z = (const bf16*)(p.ws + WS_Z);
  bf16* skT = (bf16*)smem;
  bf16* svT = (bf16*)(smem + 18432);
  float* swsel = (float*)(smem + 36864);
  const int tid = tidx(), lane = tid & 63, wave = tid >> 6, wr = wave >> 1, wc = wave & 1;
  if (wave == 0) {
    float cum, iv;
    chunk_gates(p, l, z, r0, hh, lane, cum, iv);
    const float total = __shfl(cum, 63);
    const float g = total - cum + iv;
    const float G = wave_max(g);
    swsel[lane] = __expf(g - G);
    if (lane == 0) {
      ((float*)(p.ws + WS_G))[item] = G;
      ((float*)(p.ws + WS_TOT))[item] = total;
    }
  }
  __syncthreads();
  for (int i = tid; i < 1024; i += 256) {
    const int s = i >> 4, d8 = (i & 15) * 8;
    float y[8];
    conv8_prompt(p, l, z, r0, c * 64, s, 512 + hh * 128 + d8, y);
    const float sc = 0.08838834764831845f * swsel[s];
#pragma unroll
    for (int j = 0; j < 8; ++j) skT[(d8 + j) * 72 + s] = f2bf(y[j] * sc);
    float v[8];
    unpack8(*(const uint4*)(z + (size_t)(r0 + s) * ZC + C_V + hh * 128 + d8), v);
#pragma unroll
    for (int j = 0; j < 8; ++j) svT[(d8 + j) * 72 + s] = f2bf(v[j]);
  }
  __syncthreads();
  f32x4 acc[4][4];
  zero_acc<4>(acc);
  mma_lds<4, 4>(acc, svT + wr * 64 * 72, 72, skT + wc * 64 * 72, 72, 64, lane);
  bf16* U = (bf16*)(p.ws + WS_U) + (size_t)item * 16384;
#pragma unroll
  for (int i = 0; i < 4; ++i)
#pragma unroll
    for (int j = 0; j < 4; ++j) {
      const int e = wr * 64 + i * 16 + (lane & 15), d = wc * 64 + j * 16 + (lane >> 4) * 4;
      uint2 o;
      o.x = pack2(acc[i][j][0], acc[i][j][1]);
      o.y = pack2(acc[i][j][2], acc[i][j][3]);
      *(uint2*)(U + e * 128 + d) = o;
    }
  if (tid < 128) {
    float s = 0.f;
    for (int k = 0; k < 64; ++k) s += bf2f(skT[tid * 72 + k]);
    ((float*)(p.ws + WS_UN))[(size_t)item * 128 + tid] = s;
  }
  __syncthreads();
}

__device__ __forceinline__ void mlstm_convout_item(const Params& p, int l, int b) {
  const bf16* z = (const bf16*)(p.ws + WS_Z);
  for (int i = tidx(); i < 3 * 1024; i += 256) {
    const int j = i >> 10, ch = i & 1023;
    p.out[O_CVP + (((size_t)l * 4 + b) * 3 + j) * 1024 + ch] = bf2f(z[(size_t)(b * SEQ + SEQ - 3 + j) * ZC + C_QK + ch]);
  }
}

__device__ __forceinline__ void mlstm_sample_item(const Params& p, int l, int item, unsigned char* smem) {
  const int b = item >> 2, hh = item & 3;
  const int r0 = TP + b * 8;
  bf16* z = (bf16*)(p.ws + WS_Z);
  float* sq = (float*)smem;
  float* sk = sq + 1024;
  float* sv = sk + 1024;
  float* sh = sv + 1024;
  float* sint = sh + 1024;
  float* sa = sint + 2048;
  float* sqn = sa + 64;
  float* smt = sqn + 8;
  float* swi = smt + 8;
  float* swsel = swi + 8;
  float* sdm = swsel + 8;
  float* sdecay = sdm + 64;
  const int tid = tidx(), lane = tid & 63, wave = tid >> 6;
  {
    const int isk = tid >> 7, d = tid & 127, zc = isk * 512 + hh * 128 + d;
    const float* cw = p.conv_w + (size_t)l * 4 * 1024 + zc;
    const float cb = p.conv_b[l * 1024 + zc];
    float xp[11];
    const float* cs = p.st_conv + ((size_t)l * 128 + b) * 3 * 1024 + zc;
    xp[0] = cs[0]; xp[1] = cs[1024]; xp[2] = cs[2048];
#pragma unroll
    for (int t = 0; t < 8; ++t) xp[3 + t] = bf2f(z[(size_t)(r0 + t) * ZC + C_QK + zc]);
    const float w0 = cw[0], w1 = cw[1024], w2 = cw[2048], w3 = cw[3072];
    float* dst = isk ? sk : sq;
    const float sc = isk ? 0.08838834764831845f : 1.0f;
#pragma unroll
    for (int t = 0; t < 8; ++t) {
      const float y = cb + w0 * xp[t] + w1 * xp[t + 1] + w2 * xp[t + 2] + w3 * xp[t + 3];
      dst[t * 128 + d] = siluf_(y) * sc;
    }
    float* co = p.out + O_CVS + ((size_t)l * 128 + b) * 3 * 1024 + zc;
    co[0] = xp[8]; co[1024] = xp[9]; co[2048] = xp[10];
  }
  for (int i = tid; i < 1024; i += 256) {
    const int t = i >> 7, e = i & 127;
    sv[i] = bf2f(z[(size_t)(r0 + t) * ZC + C_V + hh * 128 + e]);
  }
  if (tid == 0) {
    float cum[8], iv[8];
    float c = 0.f;
    for (int t = 0; t < 8; ++t) {
      const float f = bf2f(z[(size_t)(r0 + t) * ZC + C_F + hh]) + p.f_bias[l * 4 + hh];
      c += logsigmoidf_(f);
      cum[t] = c;
      iv[t] = bf2f(z[(size_t)(r0 + t) * ZC + C_I + hh]);
    }
    const float m0 = p.st_m[(l * 128 + b) * 4 + hh];
    for (int t = 0; t < 8; ++t) {
      float dmax = -INFINITY;
      for (int s = 0; s <= t; ++s) dmax = fmaxf(dmax, cum[t] - cum[s] + iv[s]);
      const float mi = cum[t] + m0, mt = fmaxf(mi, dmax);
      smt[t] = mt;
      swi[t] = __expf(mi - mt);
      for (int s = 0; s < 8; ++s) sdm[t * 8 + s] = (s <= t) ? __expf(cum[t] - cum[s] + iv[s] - mt) : 0.f;
    }
    const float total = cum[7];
    float gm = -INFINITY;
    for (int s = 0; s < 8; ++s) gm = fmaxf(gm, total - cum[s] + iv[s]);
    const float mn = fmaxf(total + m0, gm);
    for (int s = 0; s < 8; ++s) swsel[s] = __expf(total - cum[s] + iv[s] - mn);
    sdecay[0] = __expf(total + m0 - mn);
    p.out[O_MS + (l * 128 + b) * 4 + hh] = mn;
  }
  __syncthreads();
  const float* n0 = p.st_n + (((size_t)l * 128 + b) * 4 + hh) * 128;
  if (tid < 64) {
    const int t = tid >> 3, s = tid & 7;
    float dsum = 0.f;
    for (int d = 0; d < 128; ++d) dsum += sq[t * 128 + d] * sk[s * 128 + d];
    sa[t * 8 + s] = sdm[t * 8 + s] * dsum;
  } else if (tid < 128) {
    const int t = (tid - 64) >> 3, part = (tid - 64) & 7;
    float dsum = 0.f;
    for (int d = part * 16; d < part * 16 + 16; ++d) dsum += sq[t * 128 + d] * n0[d];
    dsum += __shfl_xor(dsum, 1); dsum += __shfl_xor(dsum, 2); dsum += __shfl_xor(dsum, 4);
    if (part == 0) sqn[t] = dsum;
  }
  __syncthreads();
  {
    const int e = tid & 127, dh = tid >> 7;
    const float decay = sdecay[0];
    const float* C0 = p.st_C + (((size_t)l * 128 + b) * 4 + hh) * 16384;
    float* C1 = p.out + O_CS + (((size_t)l * 128 + b) * 4 + hh) * 16384;
    float vw[8], inter[8];
#pragma unroll
    for (int s = 0; s < 8; ++s) { vw[s] = sv[s * 128 + e] * swsel[s]; inter[s] = 0.f; }
    for (int d = dh * 64; d < dh * 64 + 64; ++d) {
      const float c0 = C0[d * 128 + e];
      float upd = decay * c0;
#pragma unroll
      for (int s = 0; s < 8; ++s) {
        upd += sk[s * 128 + d] * vw[s];
        inter[s] += sq[s * 128 + d] * c0;
      }
      C1[d * 128 + e] = upd;
    }
#pragma unroll
    for (int t = 0; t < 8; ++t) sint[(dh * 8 + t) * 128 + e] = inter[t];
  }
  __syncthreads();
  if (tid < 128) {
    const int e = tid;
    for (int t = 0; t < 8; ++t) {
      float num = swi[t] * (sint[t * 128 + e] + sint[(8 + t) * 128 + e]);
      float den = swi[t] * sqn[t];
      for (int s = 0; s <= t; ++s) { num += sa[t * 8 + s] * sv[s * 128 + e]; den += sa[t * 8 + s]; }
      sh[t * 128 + e] = num / fmaxf(fabsf(den), __expf(-smt[t]));
    }
    float nn = sdecay[0] * n0[e];
    for (int s = 0; s < 8; ++s) nn += swsel[s] * sk[s * 128 + e];
    p.out[O_NS + (((size_t)l * 128 + b) * 4 + hh) * 128 + e] = nn;
  }
  __syncthreads();
  const float* hg = p.hnorm_g + l * 512 + hh * 128;
  for (int tt = 0; tt < 2; ++tt) {
    const int t = wave * 2 + tt;
    const float h0 = sh[t * 128 + lane], h1 = sh[t * 128 + 64 + lane];
    const float ss = wave_sum(h0 * h0 + h1 * h1);
    const float rstd = rsqrtf(ss * (1.0f / 128.f) + EPS);
    bf16* zr = z + (size_t)(r0 + t) * ZC;
#pragma unroll
    for (int k = 0; k < 2; ++k) {
      const int e = lane + 64 * k;
      const float hv = k ? h1 : h0;
      const float o = bf2f(zr[C_O + hh * 128 + e]), cg_ = bf2f(zr[C_G + hh * 128 + e]);
      zr[C_O + hh * 128 + e] = f2bf(hv * rstd * hg[e] * sigmoidf_(o) * siluf_(cg_));
    }
  }
  __syncthreads();
}

__device__ __forceinline__ void phase_mix1(const Params& p, int l, unsigned char* smem) {
  constexpr int N_LOC = 1024, N_SMP = 512, N_CV = 4;
  constexpr int N_ALL = N_LOC + N_SMP + N_CV;
  for (int it = blockIdx.x; it < N_ALL; it += gridDim.x) {
    int i = it;
    if (i < N_LOC) { mlstm_local_item(p, l, i, smem); continue; }
    i -= N_LOC;
    if (i < N_SMP) { mlstm_sample_item(p, l, i, smem); continue; }
    i -= N_SMP;
    mlstm_convout_item(p, l, i);
  }
}

__device__ __forceinline__ void phase_scan(const Params& p, int l, unsigned char* smem) {
  float* sdec = (float*)smem;
  float* ssc = sdec + 64;
  const int tid = tidx();
  float* Gb = (float*)(p.ws + WS_G);
  float* Tb = (float*)(p.ws + WS_TOT);
  float* Mb = (float*)(p.ws + WS_M);
  for (int it = blockIdx.x; it < 256; it += gridDim.x) {
    const int bh = it >> 4, slice = it & 15;
    if (tid < 64) { sdec[128 + tid] = Gb[bh * 64 + tid]; sdec[192 + tid] = Tb[bh * 64 + tid]; }
    __syncthreads();
    if (tid == 0) {
      float m = 0.f;
      for (int c = 0; c < 64; ++c) {
        const float G = sdec[128 + c], tot = sdec[192 + c];
        const float mn = fmaxf(tot + m, G);
        sdec[c] = __expf(tot + m - mn);
        ssc[c] = __expf(G - mn);
        if (slice == 0) Mb[bh * 64 + c] = m;
        m = mn;
      }
      if (slice == 0) p.out[O_MP + l * 16 + bh] = m;
    }
    __syncthreads();
    {
      const int idx = slice * 1024 + tid * 4;
      bf16* U = (bf16*)(p.ws + WS_U) + (size_t)bh * 64 * 16384 + idx;
      float st[4] = {0.f, 0.f, 0.f, 0.f};
#pragma unroll 8
      for (int c = 0; c < 64; ++c) {
        float u[4];
        unpack4(*(const uint2*)(U + (size_t)c * 16384), u);
        uint2 o;
        o.x = pack2(st[0], st[1]); o.y = pack2(st[2], st[3]);
        *(uint2*)(U + (size_t)c * 16384) = o;
        const float dc = sdec[c], sc = ssc[c];
#pragma unroll
        for (int x = 0; x < 4; ++x) st[x] = dc * st[x] + sc * u[x];
      }
      const int e = idx >> 7, d0 = idx & 127;
      float* Co = p.out + O_CP + ((size_t)l * 16 + bh) * 16384;
#pragma unroll
      for (int x = 0; x < 4; ++x) Co[(d0 + x) * 128 + e] = st[x];
    }
    if (slice == 0 && tid < 128) {
      float* un = (float*)(p.ws + WS_UN) + (size_t)bh * 64 * 128 + tid;
      float n = 0.f;
#pragma unroll 8
      for (int c = 0; c < 64; ++c) {
        const float u = un[c * 128];
        un[c * 128] = n;
        n = sdec[c] * n + ssc[c] * u;
      }
      p.out[O_NP + ((size_t)l * 16 + bh) * 128 + tid] = n;
    }
    __syncthreads();
  }
}

__device__ __forceinline__ void mlstm_out_item(const Params& p, int l, int item, unsigned char* smem) {
  const int bh = item >> 6, c = item & 63, b = bh >> 2, hh = bh & 3;
  const int r0 = b * SEQ + c * 64;
  bf16* z = (bf16*)(p.ws + WS_Z);
  bf16* sq = (bf16*)smem;
  bf16* sk = (bf16*)(smem + 17408);
  bf16* svT = (bf16*)(smem + 34816);
  bf16* sa = (bf16*)(smem + 53248);
  float* scum = (float*)(smem + 62464);
  float* siv = scum + 64;
  float* smt = siv + 64;
  float* swi = smt + 64;
  float* sden = swi + 64;
  float* sqn = sden + 64;
  float* spart = sqn + 64;
  const int tid = tidx(), lane = tid & 63, wave = tid >> 6;
  const int r16 = lane & 15, g4 = lane >> 4;
  if (wave == 0) {
    float cum, iv;
    chunk_gates(p, l, z, r0, hh, lane, cum, iv);
    scum[lane] = cum;
    siv[lane] = iv;
  }
  for (int i = tid; i < 2048; i += 256) {
    const int isk = i >> 10, r = i & 1023, s = r >> 4, d8 = (r & 15) * 8;
    float y[8];
    conv8_prompt(p, l, z, r0, c * 64, s, isk * 512 + hh * 128 + d8, y);
    const float sc = isk ? 0.08838834764831845f : 1.0f;
    uint4 o;
    o.x = pack2(y[0] * sc, y[1] * sc); o.y = pack2(y[2] * sc, y[3] * sc);
    o.z = pack2(y[4] * sc, y[5] * sc); o.w = pack2(y[6] * sc, y[7] * sc);
    *(uint4*)((isk ? sk : sq) + s * 136 + d8) = o;
  }
  for (int i = tid; i < 1024; i += 256) {
    const int s = i >> 4, d8 = (i & 15) * 8;
    float v[8];
    unpack8(*(const uint4*)(z + (size_t)(r0 + s) * ZC + C_V + hh * 128 + d8), v);
#pragma unroll
    for (int j = 0; j < 8; ++j) svT[(d8 + j) * 72 + s] = f2bf(v[j]);
  }
  __syncthreads();
  const float m_prev = ((const float*)(p.ws + WS_M))[item];
  {
    const int t = wave * 16 + r16;
    bf16x8 qf[4];
#pragma unroll
    for (int ks = 0; ks < 4; ++ks) qf[ks] = *(const bf16x8*)(sq + t * 136 + ks * 32 + g4 * 8);
    f32x4 st[4];
#pragma unroll
    for (int kt = 0; kt < 4; ++kt) {
      st[kt] = (f32x4){0.f, 0.f, 0.f, 0.f};
#pragma unroll
      for (int ks = 0; ks < 4; ++ks) {
        const bf16x8 kf = *(const bf16x8*)(sk + (kt * 16 + r16) * 136 + ks * 32 + g4 * 8);
        st[kt] = mfma16(kf, qf[ks], st[kt]);
      }
    }
    const float cumt = scum[t];
    float dm[4][4];
    float rmax = -INFINITY;
#pragma unroll
    for (int kt = 0; kt < 4; ++kt)
#pragma unroll
      for (int x = 0; x < 4; ++x) {
        const int s = kt * 16 + g4 * 4 + x;
        dm[kt][x] = (s <= t) ? (cumt - scum[s] + siv[s]) : -INFINITY;
        rmax = fmaxf(rmax, dm[kt][x]);
      }
    rmax = fmaxf(rmax, __shfl_xor(rmax, 16)); rmax = fmaxf(rmax, __shfl_xor(rmax, 32));
    const float mi = cumt + m_prev, mt = fmaxf(mi, rmax);
    float rsum = 0.f;
#pragma unroll
    for (int kt = 0; kt < 4; ++kt) {
      float a[4];
#pragma unroll
      for (int x = 0; x < 4; ++x) {
        const int s = kt * 16 + g4 * 4 + x;
        a[x] = (s <= t) ? __expf(dm[kt][x] - mt) * st[kt][x] : 0.f;
        rsum += a[x];
      }
      uint2 o;
      o.x = pack2(a[0], a[1]); o.y = pack2(a[2], a[3]);
      *(uint2*)(sa + t * 72 + kt * 16 + g4 * 4) = o;
    }
    rsum += __shfl_xor(rsum, 16); rsum += __shfl_xor(rsum, 32);
    if (g4 == 0) { smt[t] = mt; swi[t] = __expf(mi - mt); sden[t] = rsum; }
  }
  {
    const int t = tid >> 2, part = tid & 3;
    const float* nc = (const float*)(p.ws + WS_UN) + (size_t)item * 128;
    float s = 0.f;
    for (int d = part * 32; d < part * 32 + 32; ++d) s += bf2f(sq[t * 136 + d]) * nc[d];
    s += __shfl_xor(s, 1); s += __shfl_xor(s, 2);
    if (part == 0) sqn[t] = s;
  }
  __syncthreads();
  f32x4 acc[4][2];
#pragma unroll
  for (int ti = 0; ti < 4; ++ti)
#pragma unroll
    for (int et = 0; et < 2; ++et) acc[ti][et] = (f32x4){0.f, 0.f, 0.f, 0.f};
  const bf16* Cc = (const bf16*)(p.ws + WS_U) + (size_t)item * 16384;
#pragma unroll
  for (int ks = 0; ks < 4; ++ks) {
    bf16x8 cf[2], qf[4];
#pragma unroll
    for (int et = 0; et < 2; ++et) cf[et] = *(const bf16x8*)(Cc + (wave * 32 + et * 16 + r16) * 128 + ks * 32 + g4 * 8);
#pragma unroll
    for (int ti = 0; ti < 4; ++ti) qf[ti] = *(const bf16x8*)(sq + (ti * 16 + r16) * 136 + ks * 32 + g4 * 8);
#pragma unroll
    for (int ti = 0; ti < 4; ++ti)
#pragma unroll
      for (int et = 0; et < 2; ++et) acc[ti][et] = mfma16(cf[et], qf[ti], acc[ti][et]);
  }
#pragma unroll
  for (int ti = 0; ti < 4; ++ti) {
    const float w = swi[ti * 16 + r16];
#pragma unroll
    for (int et = 0; et < 2; ++et) acc[ti][et] *= w;
  }
#pragma unroll
  for (int ks = 0; ks < 2; ++ks) {
    bf16x8 vf[2], af[4];
#pragma unroll
    for (int et = 0; et < 2; ++et) vf[et] = *(const bf16x8*)(svT + (wave * 32 + et * 16 + r16) * 72 + ks * 32 + g4 * 8);
#pragma unroll
    for (int ti = 0; ti < 4; ++ti) af[ti] = *(const bf16x8*)(sa + (ti * 16 + r16) * 72 + ks * 32 + g4 * 8);
#pragma unroll
    for (int ti = 0; ti < 4; ++ti)
#pragma unroll
      for (int et = 0; et < 2; ++et) acc[ti][et] = mfma16(vf[et], af[ti], acc[ti][et]);
  }
#pragma unroll
  for (int ti = 0; ti < 4; ++ti) {
    const int t = ti * 16 + r16;
    const float den = sden[t] + swi[t] * sqn[t];
    const float inv = 1.0f / fmaxf(fabsf(den), __expf(-smt[t]));
    float ss = 0.f;
#pragma unroll
    for (int et = 0; et < 2; ++et) {
      acc[ti][et] *= inv;
#pragma unroll
      for (int x = 0; x < 4; ++x) ss += acc[ti][et][x] * acc[ti][et][x];
    }
    ss += __shfl_xor(ss, 16); ss += __shfl_xor(ss, 32);
    if (g4 == 0) spart[t * 4 + wave] = ss;
  }
  __syncthreads();
  const float* hg = p.hnorm_g + l * 512 + hh * 128;
#pragma unroll
  for (int ti = 0; ti < 4; ++ti) {
    const int t = ti * 16 + r16;
    const float rstd = rsqrtf((spart[t * 4] + spart[t * 4 + 1] + spart[t * 4 + 2] + spart[t * 4 + 3]) * (1.0f / 128.f) + EPS);
    bf16* zr = z + (size_t)(r0 + t) * ZC;
#pragma unroll
    for (int et = 0; et < 2; ++et) {
      const int e = wave * 32 + et * 16 + g4 * 4;
      float o[4], cg_[4];
      unpack4(*(const uint2*)(zr + C_O + hh * 128 + e), o);
      unpack4(*(const uint2*)(zr + C_G + hh * 128 + e), cg_);
      float y[4];
#pragma unroll
      for (int x = 0; x < 4; ++x) y[x] = acc[ti][et][x] * rstd * hg[e + x] * sigmoidf_(o[x]) * siluf_(cg_[x]);
      uint2 oo;
      oo.x = pack2(y[0], y[1]); oo.y = pack2(y[2], y[3]);
      *(uint2*)(zr + C_O + hh * 128 + e) = oo;
    }
  }
  __syncthreads();
}

__device__ __forceinline__ void phase_mix2(const Params& p, int l, unsigned char* smem) {
  for (int it = blockIdx.x; it < 1024; it += gridDim.x) mlstm_out_item(p, l, it, smem);
}

__device__ __forceinline__ void phase_gemm_br(const Params& p, int l, unsigned char* smem) {
  bf16* sm = (bf16*)smem;
  const bf16* hbuf = (const bf16*)(p.ws + WS_H);
  const bf16* Win = (const bf16*)(p.ws + WS_WIN) + (size_t)l * NWIN * 1024;
  const bf16* Wbr = (const bf16*)(p.ws + WS_WBR) + (size_t)l * 1024 * 1536;
  const bf16* yab = (const bf16*)(p.ws + WS_YAB);
  const bf16* z = (const bf16*)(p.ws + WS_Z);
  bf16* merged = (bf16*)(p.ws + WS_U);
  const float* bias = p.b_in + (size_t)l * ZIN + OFF_MG;
  const int lane = tidx() & 63, wave = tidx() >> 6, wr = wave >> 1, wc = wave & 1;
  const int ntiles = (TT / 128) * 8;
  for (int t = blockIdx.x; t < ntiles; t += gridDim.x) {
    int pm, pn;
    tile_map(t, 8, pm, pn);
    const int m0 = pm * 128, n0 = pn * 128;
#pragma unroll 1
    for (int seg = 0; seg < 3; ++seg) {
      f32x4 acc[4][4];
      zero_acc<4>(acc);
      gemm_accum<4, true>(acc, hbuf + (size_t)m0 * 1024, 1024, Win + (size_t)(OFF_MG + seg * 1024 + n0) * 1024, 1024, 1024, sm);
      unsigned gp[4][4][2];
#pragma unroll
      for (int j = 0; j < 4; ++j) {
        const int col = n0 + wc * 64 + j * 16 + (lane >> 4) * 4;
        const float4 bb = *(const float4*)(bias + seg * 1024 + col);
#pragma unroll
        for (int i = 0; i < 4; ++i) {
          gp[i][j][0] = pack2(sigmoidf_(acc[i][j][0] + bb.x), sigmoidf_(acc[i][j][1] + bb.y));
          gp[i][j][1] = pack2(sigmoidf_(acc[i][j][2] + bb.z), sigmoidf_(acc[i][j][3] + bb.w));
        }
      }
      zero_acc<4>(acc);
      const bf16* A = (seg == 0) ? yab + (size_t)m0 * 1024 : (seg == 1) ? yab + (size_t)m0 * 1024 + 512 : z + (size_t)m0 * ZC + C_O;
      const int lda = (seg == 2) ? ZC : 1024;
      gemm_accum<4, true>(acc, A, lda, Wbr + (size_t)n0 * 1536 + seg * 512, 1536, 512, sm);
#pragma unroll
      for (int i = 0; i < 4; ++i)
#pragma unroll
        for (int j = 0; j < 4; ++j) {
          const int row = m0 + wr * 64 + i * 16 + (lane & 15), col = n0 + wc * 64 + j * 16 + (lane >> 4) * 4;
          uint2* mp = (uint2*)(merged + (size_t)row * 1024 + col);
          uint2 prev = make_uint2(0u, 0u);
          if (seg > 0) prev = *mp;
          uint2 o;
          o.x = pack2(lo2f(prev.x) + lo2f(gp[i][j][0]) * acc[i][j][0], hi2f(prev.x) + hi2f(gp[i][j][0]) * acc[i][j][1]);
          o.y = pack2(lo2f(prev.y) + lo2f(gp[i][j][1]) * acc[i][j][2], hi2f(prev.y) + hi2f(gp[i][j][1]) * acc[i][j][3]);
          *mp = o;
        }
    }
  }
}

__device__ __forceinline__ void phase_gemm_out(const Params& p, int l, unsigned char* smem) {
  bf16* sm = (bf16*)smem;
  const bf16* merged = (const bf16*)(p.ws + WS_U);
  const bf16* Wout = (const bf16*)(p.ws + WS_WOUT) + (size_t)l * 1024 * 1024;
  const float* mod = (const float*)(p.ws + WS_MOD);
  const int lane = tidx() & 63, wave = tidx() >> 6, wr = wave >> 1, wc = wave & 1;
  const int ntiles = (TT / 128) * 8;
  for (int t = blockIdx.x; t < ntiles; t += gridDim.x) {
    int pm, pn;
    tile_map(t, 8, pm, pn);
    const int m0 = pm * 128, n0 = pn * 128;
    f32x4 acc[4][4];
    zero_acc<4>(acc);
    gemm_accum<4>(acc, merged + (size_t)m0 * 1024, 1024, Wout + (size_t)n0 * 1024, 1024, 1024, sm);
#pragma unroll
    for (int i = 0; i < 4; ++i) {
      const int row = m0 + wr * 64 + i * 16 + (lane & 15);
      const float* xr = xrow_ptr(p, l, row);
      const float* gate = mod + ((size_t)l * NMOD + mod_row(row)) * 3072 + 2048;
#pragma unroll
      for (int j = 0; j < 4; ++j) {
        const int col = n0 + wc * 64 + j * 16 + (lane >> 4) * 4;
        const float4 xv = *(const float4*)(xr + col), gv = *(const float4*)(gate + col);
        float4 o;
        o.x = xv.x + gv.x * acc[i][j][0]; o.y = xv.y + gv.y * acc[i][j][1];
        o.z = xv.z + gv.z * acc[i][j][2]; o.w = xv.w + gv.w * acc[i][j][3];
        *(float4*)(p.out + (size_t)row * D + col) = o;
      }
    }
  }
}

constexpr int N_PHASES = 19;
template <int S>
__device__ __forceinline__ void run_stage(const Params& p, int l, unsigned char* smem) {
  if (S == -1) phase_prep(p, smem);
  if (S == 0) phase_norm(p, l);
  if (S == 1) phase_gemm_in(p, l, 0, ZAB / 128, ZAB, smem);
  if (S == 2) phase_mix_ab(p, l, smem);
  if (S == 3) phase_gemm_in(p, l, ZAB, ZC / 128, ZC, smem);
  if (S == 4) phase_mix1(p, l, smem);
  if (S == 5) phase_scan(p, l, smem);
  if (S == 6) phase_mix2(p, l, smem);
  if (S == 7) phase_gemm_br(p, l, smem);
  if (S == 8) phase_gemm_out(p, l, smem);
}


#define XB_TMO      128
#define XB_XCNT(j)  (256  + 64 * (j))
#define XB_XSUB(j)  (1280 + 64 * (j))
#define XB_XGEN(j)  (2304 + 64 * (j))
#define XB_TOP      3328
#define XB_TOPGEN   3392
#define XCD_BAR_WORDS 3456
#define XB_SPIN_CAP (1u << 18)
#define LAS __attribute__((address_space(3)))
__device__ __forceinline__ unsigned xb_ld(unsigned* p)              { return __hip_atomic_load(p, __ATOMIC_RELAXED, __HIP_MEMORY_SCOPE_AGENT); }
__device__ __forceinline__ unsigned xb_add(unsigned* p, unsigned v) { return __hip_atomic_fetch_add(p, v, __ATOMIC_RELAXED, __HIP_MEMORY_SCOPE_AGENT); }
__device__ __forceinline__ unsigned xb_xcc_id() { return (unsigned)__builtin_amdgcn_s_getreg((3 << 11) | 20) & 0xFu; }
#define XB_SPIN(cond, bar) do { unsigned _sp = 0; while (cond) { __builtin_amdgcn_s_sleep(1); \
    if ((++_sp & 255u) == 0u) { if (xb_ld(&(bar)[XB_TMO])) break; if (_sp > XB_SPIN_CAP) { atomicAdd(&(bar)[XB_TMO], 1u); break; } } } } while (0)
struct XcdBarrier { unsigned* bar; unsigned x; volatile LAS unsigned* st; };
__device__ __forceinline__ XcdBarrier xcd_barrier_post(unsigned* bar, volatile LAS unsigned* st) {
  XcdBarrier b; b.bar = bar; b.x = xb_xcc_id(); b.st = st;
  if (threadIdx.x == 0) (void)xb_add(&bar[XB_XCNT(b.x)], 1u);
  return b;
}
__device__ __forceinline__ void xcd_barrier_complete(unsigned* bar, unsigned x, unsigned& nloc, unsigned& nx) {
  const unsigned G = gridDim.x * gridDim.y * gridDim.z;
  unsigned sum, cnt, mine, sp = 0u;
  for (;;) {
    sum = 0u; cnt = 0u; mine = 0u;
#pragma unroll
    for (unsigned j = 0; j < 16; ++j) { const unsigned c = xb_ld(&bar[XB_XCNT(j)]); sum += c; cnt += (c > 0u) ? 1u : 0u; mine = (j == x) ? c : mine; }
    if (sum == G) break;
    __builtin_amdgcn_s_sleep(1);
    if ((++sp & 255u) == 0u) { if (xb_ld(&bar[XB_TMO])) break; if (sp > XB_SPIN_CAP) { atomicAdd(&bar[XB_TMO], 1u); break; } }
  }
  nloc = mine > 0u ? mine : 1u; nx = cnt > 0u ? cnt : 1u;
}
__device__ __forceinline__ void xcd_barrier(const XcdBarrier& b) {
  asm volatile("s_waitcnt vmcnt(0)" ::: "memory");
  __syncthreads();
  if (threadIdx.x == 0) {
    unsigned* bar = b.bar;
    __builtin_amdgcn_s_waitcnt(0);
    unsigned nloc = b.st[0], nx = b.st[1];
    if (nloc == 0u) { xcd_barrier_complete(bar, b.x, nloc, nx); b.st[0] = nloc; b.st[1] = nx; }
    const unsigned old = xb_add(&bar[XB_XSUB(b.x)], 1u);
    const unsigned gen = old / nloc;
    if (old + 1u == (gen + 1u) * nloc) {
      __builtin_amdgcn_fence(__ATOMIC_RELEASE, "agent");
      asm volatile("s_waitcnt vmcnt(0)" ::: "memory");
      const unsigned og = xb_add(&bar[XB_TOP], 1u);
      const unsigned tg = og / nx;
      if (og + 1u == (tg + 1u) * nx) xb_add(&bar[XB_TOPGEN], 1u);
      else XB_SPIN(xb_ld(&bar[XB_TOPGEN]) == tg, bar);
      __builtin_amdgcn_fence(__ATOMIC_ACQUIRE, "agent");
      xb_add(&bar[XB_XGEN(b.x)], 1u);
      asm volatile("s_waitcnt vmcnt(0)" ::: "memory");
    } else {
      XB_SPIN(xb_ld(&bar[XB_XGEN(b.x)]) == gen, bar);
      __builtin_amdgcn_fence(__ATOMIC_ACQUIRE, "agent");
      asm volatile("s_waitcnt vmcnt(0)" ::: "memory");
    }
  }
  __syncthreads();
}

#define GSYNC() xcd_barrier(xb)
__global__ void __launch_bounds__(256, 2) mega_kernel(Params p_in) {
  __shared__ __attribute__((aligned(16))) unsigned char smem[SMEM_BYTES];
  const Params& p = *(const Params*)__builtin_amdgcn_kernarg_segment_ptr();
  __shared__ uint4 xb_words;
  if (threadIdx.x == 0) xb_words = make_uint4(0u, 0u, 0u, 0u);
  __syncthreads();
  XcdBarrier xb = xcd_barrier_post((unsigned*)(p.ws + WS_BAR), (volatile LAS unsigned*)&xb_words);
  run_stage<-1>(p, 0, smem);
  if (p.out == nullptr) cg::this_grid().sync();
  GSYNC();
#define LAYER(L, LAST)                 \
  run_stage<0>(p, L, smem); GSYNC();   \
  run_stage<1>(p, L, smem); GSYNC();   \
  run_stage<2>(p, L, smem); GSYNC();   \
  run_stage<3>(p, L, smem); GSYNC();   \
  run_stage<4>(p, L, smem); GSYNC();   \
  run_stage<5>(p, L, smem); GSYNC();   \
  run_stage<6>(p, L, smem); GSYNC();   \
  run_stage<7>(p, L, smem); GSYNC();   \
  run_stage<8>(p, L, smem);            \
  if (!LAST) GSYNC();
  int l0 = 0, l1 = 1;
  asm volatile("" : "+s"(l0));
  asm volatile("" : "+s"(l1));
  LAYER(l0, 0)
  LAYER(l1, 1)
}

extern "C" void kernel_launch(void* const* d_in, const int* in_sizes, int n_in, void* d_out, int out_size, void* d_ws,
                              size_t ws_size, hipStream_t stream) {
  if (ws_size < WS_END || n_in < 29) { fprintf(stderr, "workspace too small / bad inputs\n"); return; }
  Params p{};
  const float** f = (const float**)&p;
  for (int i = 0; i < 29; ++i) f[i] = (const float*)d_in[i];
  p.out = (float*)d_out;
  p.ws = (unsigned char*)d_ws;
  static int grid_blocks = 0;
  if (!grid_blocks) {
    int dev = 0, cus = 0, per_cu = 0;
    (void)hipGetDevice(&dev);
    (void)hipDeviceGetAttribute(&cus, hipDeviceAttributeMultiprocessorCount, dev);
    (void)hipOccupancyMaxActiveBlocksPerMultiprocessor(&per_cu, mega_kernel, 256, 0);
    if (per_cu < 1) per_cu = 1;
    if (per_cu > 2) per_cu = 2;
    grid_blocks = cus * per_cu;
  }
  (void)hipMemsetAsync((unsigned char*)d_ws + WS_BAR, 0, 16384, stream);
  void* args[] = {&p};
  hipError_t e = hipLaunchCooperativeKernel((void*)mega_kernel, dim3(grid_blocks), dim3(256), args, 0, stream);
  if (e != hipSuccess) fprintf(stderr, "cooperative launch failed: %s (grid %d)\n", hipGetErrorString(e), grid_blocks);
}
```

```cpp
#include <hip/hip_runtime.h>
#include <hip/hip_cooperative_groups.h>
#include <cstdio>
namespace cg = cooperative_groups;

typedef unsigned short bf16;
typedef short bf16x8 __attribute__((ext_vector_type(8)));
typedef float f32x4 __attribute__((ext_vector_type(4)));
typedef unsigned u32x4 __attribute__((ext_vector_type(4)));
#define LDSP __attribute__((address_space(3)))

#ifndef SINGLE_LAUNCH
#define SINGLE_LAUNCH 0
#endif

constexpr int D = 1024, TP = 16384, TS = 1024, TT = TP + TS, SEQ = 4096;
constexpr int ZIN = 8456, NWIN = 8576;
constexpr int OFF_AV = 512, OFF_AG = 1024, OFF_BQ = 1536, OFF_BK = 2048, OFF_BV = 2176, OFF_BG = 2304, OFF_MG = 5384;
constexpr int ZAB = 2816;
constexpr int ZC = 2688;
constexpr int C_QK = 0, C_V = 1024, C_I = 1536, C_F = 1540, C_O = 1544, C_G = 2056;
constexpr float EPS = 1e-6f;
constexpr int NMOD = 132;
constexpr int SMEM_BYTES = 73728;

constexpr size_t O_Y = 0;
constexpr size_t O_SKP = (size_t)TT * D;
constexpr size_t O_SVP = O_SKP + 2 * 4 * 128 * 128;
constexpr size_t O_CVP = O_SVP + 2 * 4 * 128 * 128;
constexpr size_t O_CP = O_CVP + 2 * 4 * 3 * 1024;
constexpr size_t O_NP = O_CP + (size_t)2 * 4 * 4 * 128 * 128;
constexpr size_t O_MP = O_NP + 2 * 4 * 4 * 128;
constexpr size_t O_SKS = O_MP + 2 * 4 * 4;
constexpr size_t O_SVS = O_SKS + (size_t)2 * 128 * 128 * 128;
constexpr size_t O_CVS = O_SVS + (size_t)2 * 128 * 128 * 128;
constexpr size_t O_CS = O_CVS + (size_t)2 * 128 * 3 * 1024;
constexpr size_t O_NS = O_CS + (size_t)2 * 128 * 4 * 128 * 128;
constexpr size_t O_MS = O_NS + (size_t)2 * 128 * 4 * 128;
constexpr size_t O_GV = O_MS + 2 * 128 * 4;
constexpr size_t O_END = O_GV + (size_t)2 * 128 * 8 * 512;

constexpr size_t WS_WIN = 0;
constexpr size_t WS_WBR = WS_WIN + (size_t)2 * NWIN * 1024 * 2;
constexpr size_t WS_WOUT = WS_WBR + (size_t)2 * 1024 * 1536 * 2;
constexpr size_t WS_MOD = WS_WOUT + (size_t)2 * 1024 * 1024 * 2;
constexpr size_t WS_H = WS_MOD + (size_t)2 * NMOD * 3072 * 4;
constexpr size_t WS_YAB = WS_H + (size_t)TT * 1024 * 2;
constexpr size_t WS_U = WS_YAB + (size_t)TT * 1024 * 2;
constexpr size_t WS_UN = WS_U + (size_t)TT * 1024 * 2;
constexpr size_t WS_G = WS_UN + (size_t)1024 * 128 * 4;
constexpr size_t WS_TOT = WS_G + 4096;
constexpr size_t WS_M = WS_TOT + 4096;
constexpr size_t WS_Z = WS_M + 4096;
constexpr size_t WS_BAR = WS_Z + (size_t)TT * ZAB * 2;
constexpr size_t WS_H8 = WS_BAR + 16384;
constexpr int W8_ROW0 = 5376, W8_ROWS = 3200;
constexpr size_t WS_W8 = WS_H8 + (size_t)TT * 1024;
constexpr size_t WS_END = WS_W8 + (size_t)2 * W8_ROWS * 1024;

struct Params {
  const float *x_prompt, *x_sample, *cache_k, *cache_v, *st_conv, *st_C, *st_n, *st_m, *c_prompt, *c_sample;
  const float *ada_w, *ada_b, *norm_g, *w_in, *b_in, *vnorm_g, *gmlp_ws, *gmlp_bs, *qn_g, *kn_g, *sinks;
  const float *conv_w, *conv_b, *f_bias, *hnorm_g, *w_a, *w_b, *w_c, *w_out;
  float* out;
  unsigned char* ws;
};

__device__ __forceinline__ int tidx() { int t = threadIdx.x; asm volatile("" : "+v"(t)); return t; }
__device__ __forceinline__ bf16 f2bf(float f) {
  unsigned u = __float_as_uint(f);
  u += 0x7fffu + ((u >> 16) & 1u);
  return (bf16)(u >> 16);
}
__device__ __forceinline__ float bf2f(bf16 h) { return __uint_as_float(((unsigned)h) << 16); }
__device__ __forceinline__ unsigned pack2(float a, float b) { return (unsigned)f2bf(a) | ((unsigned)f2bf(b) << 16); }
__device__ __forceinline__ float lo2f(unsigned u) { return __uint_as_float(u << 16); }
__device__ __forceinline__ float hi2f(unsigned u) { return __uint_as_float(u & 0xffff0000u); }
__device__ __forceinline__ void unpack8(const uint4& v, float* f) {
  f[0] = lo2f(v.x); f[1] = hi2f(v.x); f[2] = lo2f(v.y); f[3] = hi2f(v.y);
  f[4] = lo2f(v.z); f[5] = hi2f(v.z); f[6] = lo2f(v.w); f[7] = hi2f(v.w);
}
__device__ __forceinline__ void unpack4(const uint2& v, float* f) {
  f[0] = lo2f(v.x); f[1] = hi2f(v.x); f[2] = lo2f(v.y); f[3] = hi2f(v.y);
}
__device__ __forceinline__ float sigmoidf_(float x) { return __builtin_amdgcn_rcpf(1.0f + __expf(-x)); }
__device__ __forceinline__ float siluf_(float x) { return x * __builtin_amdgcn_rcpf(1.0f + __expf(-x)); }
__device__ __forceinline__ float logsigmoidf_(float x) { return fminf(x, 0.0f) - log1pf(__expf(-fabsf(x))); }
__device__ __forceinline__ float wave_sum(float v) {
#pragma unroll
  for (int o = 32; o >= 1; o >>= 1) v += __shfl_xor(v, o);
  return v;
}
__device__ __forceinline__ float wave_max(float v) {
#pragma unroll
  for (int o = 32; o >= 1; o >>= 1) v = fmaxf(v, __shfl_xor(v, o));
  return v;
}
__device__ __forceinline__ f32x4 mfma16(bf16x8 a, bf16x8 b, f32x4 c) {
  return __builtin_amdgcn_mfma_f32_16x16x32_bf16(a, b, c, 0, 0, 0);
}
template <int MI, int NI>
__device__ __forceinline__ void mma_lds(f32x4 (&acc)[MI][NI], const bf16* sA, int lda, const bf16* sB, int ldb, int K, int lane) {
  const int r = lane & 15, q = (lane >> 4) * 8;
  for (int k0 = 0; k0 < K; k0 += 32) {
    bf16x8 a[MI], b[NI];
#pragma unroll
    for (int i = 0; i < MI; ++i) a[i] = *(const bf16x8*)(sA + (i * 16 + r) * lda + k0 + q);
#pragma unroll
    for (int j = 0; j < NI; ++j) b[j] = *(const bf16x8*)(sB + (j * 16 + r) * ldb + k0 + q);
#pragma unroll
    for (int i = 0; i < MI; ++i)
#pragma unroll
      for (int j = 0; j < NI; ++j) acc[i][j] = mfma16(b[j], a[i], acc[i][j]);
  }
}

constexpr int GLD = 64;
constexpr int GTILE = 128 * GLD;
template <int NI>
__device__ __forceinline__ void g_load(u32x4 (&ra)[4], u32x4 (&rb)[NI], const bf16* __restrict__ A, int lda, const bf16* __restrict__ B, int ldb, int ko, int tid) {
  const unsigned offA = (unsigned)((tid >> 3) * lda + (tid & 7) * 8), offB = (unsigned)((tid >> 3) * ldb + (tid & 7) * 8);
#pragma unroll
  for (int i = 0; i < 4; ++i) {
    const bf16* Ai = A + (size_t)(i * 32) * lda + ko;
    ra[i] = *(const u32x4*)(Ai + offA);
  }
#pragma unroll
  for (int i = 0; i < NI; ++i) {
    const bf16* Bi = B + (size_t)(i * 32) * ldb + ko;
    rb[i] = *(const u32x4*)(Bi + offB);
  }
}
template <int NI>
__device__ __forceinline__ void g_store(const u32x4 (&ra)[4], const u32x4 (&rb)[NI], bf16* buf, int tid) {
  const int off = (tid >> 3) * GLD + (((tid & 7) ^ ((tid >> 3) & 7)) * 8);
#pragma unroll
  for (int i = 0; i < 4; ++i) *(u32x4*)(buf + off + i * 32 * GLD) = ra[i];
#pragma unroll
  for (int i = 0; i < NI; ++i) *(u32x4*)(buf + GTILE + off + i * 32 * GLD) = rb[i];
}
template <int NI, bool LOWREG = false>
__device__ __forceinline__ void g_compute(f32x4 (&acc)[4][NI], const bf16* cur, int wr, int wc, int lane) {
  const int r16 = lane & 15, sw = lane & 7, q = lane >> 4;
#pragma unroll
  for (int ks = 0; ks < 2; ++ks) {
    const int pc = ((ks * 4 + q) ^ sw) * 8;
    bf16x8 a[4];
#pragma unroll
    for (int i = 0; i < 4; ++i) a[i] = *(const bf16x8*)(cur + (wr * 64 + i * 16 + r16) * GLD + pc);
#pragma unroll
    for (int jh = 0; jh < NI; jh += 2) {
      bf16x8 b[2];
#pragma unroll
      for (int j = 0; j < 2; ++j) b[j] = *(const bf16x8*)(cur + GTILE + (wc * 16 * NI + (jh + j) * 16 + r16) * GLD + pc);
#pragma unroll
      for (int i = 0; i < 4; ++i)
#pragma unroll
        for (int j = 0; j < 2; ++j) acc[i][jh + j] = mfma16(b[j], a[i], acc[i][jh + j]);
      if (LOWREG) __builtin_amdgcn_sched_barrier(0);
    }
  }
}
template <int NI>
__device__ __forceinline__ void g_stage(const bf16* __restrict__ A, int lda, const bf16* __restrict__ B, int ldb, int ko, bf16* buf, int tid) {
  const int wave = tid >> 6;
  const int gch = ((tid & 7) ^ ((tid >> 3) & 7)) * 8;
  const unsigned offA = (unsigned)((tid >> 3) * lda + gch), offB = (unsigned)((tid >> 3) * ldb + gch);
#pragma unroll
  for (int i = 0; i < 4; ++i) {
    const bf16* Ai = A + (size_t)(i * 32) * lda + ko;
    __builtin_amdgcn_global_load_lds((const unsigned*)(Ai + offA), (LDSP unsigned*)(buf + (i * 32 + wave * 8) * GLD), 16, 0, 0);
  }
#pragma unroll
  for (int i = 0; i < NI; ++i) {
    const bf16* Bi = B + (size_t)(i * 32) * ldb + ko;
    __builtin_amdgcn_global_load_lds((const unsigned*)(Bi + offB), (LDSP unsigned*)(buf + GTILE + (i * 32 + wave * 8) * GLD), 16, 0, 0);
  }
}
template <int NI, bool LOWREG = false>
__device__ __forceinline__ void gemm_accum(f32x4 (&acc)[4][NI], const bf16* __restrict__ A, int lda,
                                           const bf16* __restrict__ B, int ldb, int K, bf16* sm) {
  const int tid = tidx(), lane = tid & 63, wave = tid >> 6, wr = wave >> 1, wc = wave & 1;
  const int nk = K >> 6;
  bf16* buf0 = sm;
  bf16* buf1 = sm + 2 * GTILE;
  g_stage<NI>(A, lda, B, ldb, 0, buf0, tid);
  asm volatile("s_waitcnt vmcnt(0)" ::: "memory");
  __syncthreads();
#pragma unroll 1
  for (int kt = 0; kt < nk; kt += 2) {
    g_stage<NI>(A, lda, B, ldb, (kt + 1) * 64, buf1, tid);
    g_compute<NI, LOWREG>(acc, buf0, wr, wc, lane);
    asm volatile("s_waitcnt vmcnt(0)" ::: "memory");
    __syncthreads();
    if (kt + 2 < nk) g_stage<NI>(A, lda, B, ldb, (kt + 2) * 64, buf0, tid);
    g_compute<NI, LOWREG>(acc, buf1, wr, wc, lane);
    asm volatile("s_waitcnt vmcnt(0)" ::: "memory");
    __syncthreads();
  }
}
typedef int i32x8 __attribute__((ext_vector_type(8)));
template <int NI>
__device__ __forceinline__ void g_compute_f8(f32x4 (&acc)[4][NI], const bf16* cur, int wr, int wc, int lane) {
  const int r16 = lane & 15, sw = lane & 7, q = lane >> 4;
  const int pc0 = ((2 * q) ^ sw) * 8, pc1 = ((2 * q + 1) ^ sw) * 8;
  i32x8 b[NI];
#pragma unroll
  for (int j = 0; j < NI; ++j) {
    const bf16* rp = cur + GTILE + (wc * 16 * NI + j * 16 + r16) * GLD;
    const u32x4 lo = *(const u32x4*)(rp + pc0), hi = *(const u32x4*)(rp + pc1);
    b[j] = (i32x8){(int)lo.x, (int)lo.y, (int)lo.z, (int)lo.w, (int)hi.x, (int)hi.y, (int)hi.z, (int)hi.w};
  }
#pragma unroll
  for (int i = 0; i < 4; ++i) {
    const bf16* rp = cur + (wr * 64 + i * 16 + r16) * GLD;
    const u32x4 lo = *(const u32x4*)(rp + pc0), hi = *(const u32x4*)(rp + pc1);
    const i32x8 a = (i32x8){(int)lo.x, (int)lo.y, (int)lo.z, (int)lo.w, (int)hi.x, (int)hi.y, (int)hi.z, (int)hi.w};
#pragma unroll
    for (int j = 0; j < NI; ++j)
      acc[i][j] = __builtin_amdgcn_mfma_scale_f32_16x16x128_f8f6f4(b[j], a, acc[i][j], 0, 0, 0, 0x7F7F7F7F, 0, 0x7F7F7F7F);
  }
}
template <int NI>
__device__ __forceinline__ void gemm_accum_f8(f32x4 (&acc)[4][NI], const unsigned char* __restrict__ A8, const unsigned char* __restrict__ B8, bf16* sm) {
  const int tid = tidx(), lane = tid & 63, wave = tid >> 6, wr = wave >> 1, wc = wave & 1;
  const bf16* A = (const bf16*)A8;
  const bf16* B = (const bf16*)B8;
  bf16* buf0 = sm;
  bf16* buf1 = sm + 2 * GTILE;
  g_stage<NI>(A, 512, B, 512, 0, buf0, tid);
  asm volatile("s_waitcnt vmcnt(0)" ::: "memory");
  __syncthreads();
#pragma unroll 1
  for (int kt = 0; kt < 8; kt += 2) {
    g_stage<NI>(A, 512, B, 512, (kt + 1) * 64, buf1, tid);
    g_compute_f8<NI>(acc, buf0, wr, wc, lane);
    asm volatile("s_waitcnt vmcnt(0)" ::: "memory");
    __syncthreads();
    if (kt + 2 < 8) g_stage<NI>(A, 512, B, 512, (kt + 2) * 64, buf0, tid);
    g_compute_f8<NI>(acc, buf1, wr, wc, lane);
    asm volatile("s_waitcnt vmcnt(0)" ::: "memory");
    __syncthreads();
  }
}
template <int NI>
__device__ __forceinline__ void zero_acc(f32x4 (&acc)[4][NI]) {
#pragma unroll
  for (int i = 0; i < 4; ++i)
#pragma unroll
    for (int j = 0; j < NI; ++j) acc[i][j] = (f32x4){0.f, 0.f, 0.f, 0.f};
}
__device__ __forceinline__ void tile_map(int t, int ntn, int& pm, int& pn) {
  const int grp = t / (8 * ntn), w = t % (8 * ntn);
  pm = grp * 8 + (w & 7);
  pn = w >> 3;
}

__device__ __forceinline__ void transpose_tile(const float* __restrict__ src, int ld_src, int n_valid, bf16* __restrict__ dst, int ld_dst,
                               int k0, int n0, int kdst0, float* sm, unsigned char* dst8 = nullptr) {
  const int tid = tidx();
  for (int i = tid; i < 64 * 16; i += 256) {
    const int kk = i >> 4, n4 = (i & 15) * 4, n = n0 + n4;
    float4 v = make_float4(0.f, 0.f, 0.f, 0.f);
    if (n + 3 < n_valid) v = *(const float4*)(src + (size_t)(k0 + kk) * ld_src + n);
    sm[kk * 65 + n4 + 0] = v.x; sm[kk * 65 + n4 + 1] = v.y; sm[kk * 65 + n4 + 2] = v.z; sm[kk * 65 + n4 + 3] = v.w;
  }
  __syncthreads();
  for (int i = tid; i < 64 * 8; i += 256) {
    const int nn = i >> 3, kc = (i & 7) * 8;
    uint4 o;
    o.x = pack2(sm[(kc + 0) * 65 + nn], sm[(kc + 1) * 65 + nn]);
    o.y = pack2(sm[(kc + 2) * 65 + nn], sm[(kc + 3) * 65 + nn]);
    o.z = pack2(sm[(kc + 4) * 65 + nn], sm[(kc + 5) * 65 + nn]);
    o.w = pack2(sm[(kc + 6) * 65 + nn], sm[(kc + 7) * 65 + nn]);
    *(uint4*)(dst + (size_t)(n0 + nn) * ld_dst + kdst0 + kc) = o;
    if (dst8 != nullptr) {
      uint2 q8;
      int t8 = __builtin_amdgcn_cvt_pk_fp8_f32(64.f * sm[(kc + 0) * 65 + nn], 64.f * sm[(kc + 1) * 65 + nn], 0, false);
      q8.x = (unsigned)__builtin_amdgcn_cvt_pk_fp8_f32(64.f * sm[(kc + 2) * 65 + nn], 64.f * sm[(kc + 3) * 65 + nn], t8, true);
      t8 = __builtin_amdgcn_cvt_pk_fp8_f32(64.f * sm[(kc + 4) * 65 + nn], 64.f * sm[(kc + 5) * 65 + nn], 0, false);
      q8.y = (unsigned)__builtin_amdgcn_cvt_pk_fp8_f32(64.f * sm[(kc + 6) * 65 + nn], 64.f * sm[(kc + 7) * 65 + nn], t8, true);
      *(uint2*)(dst8 + (size_t)(n0 + nn - W8_ROW0) * 1024 + kdst0 + kc) = q8;
    }
  }
  __syncthreads();
}

__device__ __forceinline__ void ada_item(const Params& p, int item, float* sm) {
  const int l = item / 192, n0 = (item % 192) * 16;
  const int tid = tidx(), col = tid & 15, rg = tid >> 4;
  constexpr int SLD = 68;
  float* sW = sm + 144 * SLD;
  float acc[9];
#pragma unroll
  for (int j = 0; j < 9; ++j) acc[j] = 0.f;
  const float* W = p.ada_w + (size_t)l * 1024 * 3072 + n0;
  const int wk = tid >> 2, wc4 = (tid & 3) * 4;
  float v[36];
  float4 w0;
#define ADA_LOAD(K0)                                                                                      \
  {                                                                                                       \
    _Pragma("unroll") for (int u = 0; u < 36; ++u) {                                                      \
      const int i = tid + 256 * u, r = i >> 6, kk = i & 63;                                               \
      v[u] = 0.f;                                                                                         \
      if (r < NMOD) v[u] = (r < 4) ? p.c_prompt[r * 1024 + (K0) + kk] : p.c_sample[(r - 4) * 1024 + (K0) + kk]; \
    }                                                                                                     \
    w0 = *(const float4*)(W + (size_t)((K0) + wk) * 3072 + wc4);                                          \
  }
#define ADA_STORE()                                                                                       \
  {                                                                                                       \
    _Pragma("unroll") for (int u = 0; u < 36; ++u) {                                                      \
      const int i = tid + 256 * u, r = i >> 6, kk = i & 63;                                               \
      sm[r * SLD + kk] = siluf_(v[u]);                                                                    \
    }                                                                                                     \
    *(float4*)(sW + wk * 16 + wc4) = w0;                                                                  \
  }
  ADA_LOAD(0)
  ADA_STORE()
  __syncthreads();
#pragma unroll 1
  for (int k0 = 0; k0 < 1024; k0 += 64) {
    if (k0 + 64 < 1024) ADA_LOAD(k0 + 64)
#pragma unroll 4
    for (int k4 = 0; k4 < 16; ++k4) {
      const float x0 = sW[(k4 * 4 + 0) * 16 + col], x1 = sW[(k4 * 4 + 1) * 16 + col];
      const float x2 = sW[(k4 * 4 + 2) * 16 + col], x3 = sW[(k4 * 4 + 3) * 16 + col];
#pragma unroll
      for (int j = 0; j < 9; ++j) {
        const float4 sv = *(const float4*)(sm + (rg * 9 + j) * SLD + k4 * 4);
        acc[j] += sv.x * x0 + sv.y * x1 + sv.z * x2 + sv.w * x3;
      }
    }
    __syncthreads();
    if (k0 + 64 < 1024) ADA_STORE()
    __syncthreads();
  }
#undef ADA_LOAD
#undef ADA_STORE
  float* mod = (float*)(p.ws + WS_MOD);
  const float b = p.ada_b[l * 3072 + n0 + col];
#pragma unroll
  for (int j = 0; j < 9; ++j) {
    const int r = rg * 9 + j;
    if (r < NMOD) mod[((size_t)l * NMOD + r) * 3072 + n0 + col] = acc[j] + b;
  }
}

__device__ __forceinline__ void phase_prep(const Params& p, unsigned char* smem) {
  float* sm = (float*)smem;
  constexpr int N_WIN = 2 * 16 * (NWIN / 64);
  constexpr int N_WBR = 2 * 3 * 8 * 16;
  constexpr int N_WOUT = 2 * 16 * 16;
  constexpr int N_ALL = N_WIN + N_WBR + N_WOUT;
  bf16* WinT = (bf16*)(p.ws + WS_WIN);
  bf16* WbrT = (bf16*)(p.ws + WS_WBR);
  bf16* WoutT = (bf16*)(p.ws + WS_WOUT);
  constexpr int N_ADA = 384;
  for (int it = blockIdx.x; it < N_ADA + N_ALL; it += gridDim.x) {
    if (it < N_ADA) { ada_item(p, it, sm); continue; }
    int i = it - N_ADA;
    if (i < N_WIN) {
      const int l = i / (16 * 134), r = i % (16 * 134), kt = r / 134, nt = r % 134;
      transpose_tile(p.w_in + (size_t)l * 1024 * ZIN, ZIN, ZIN, WinT + (size_t)l * NWIN * 1024, 1024, kt * 64, nt * 64, kt * 64, sm,
                     (nt * 64 >= W8_ROW0) ? p.ws + WS_W8 + (size_t)l * W8_ROWS * 1024 : nullptr);
      continue;
    }
    i -= N_WIN;
    if (i < N_WBR) {
      const int l = i / 384, r = i % 384, seg = r / 128, r2 = r % 128, kt = r2 / 16, nt = r2 % 16;
      const float* src = (seg == 0 ? p.w_a : seg == 1 ? p.w_b : p.w_c) + (size_t)l * 512 * 1024;
      transpose_tile(src, 1024, 1024, WbrT + (size_t)l * 1024 * 1536, 1536, kt * 64, nt * 64, seg * 512 + kt * 64, sm);
      continue;
    }
    i -= N_WBR;
    {
      const int l = i / 256, r = i % 256, kt = r / 16, nt = r % 16;
      transpose_tile(p.w_out + (size_t)l * 1024 * 1024, 1024, 1024, WoutT + (size_t)l * 1024 * 1024, 1024, kt * 64, nt * 64, kt * 64, sm);
    }
  }
}

__device__ __forceinline__ const float* xrow_ptr(const Params& p, int l, int row) {
  if (l == 0) return row < TP ? p.x_prompt + (size_t)row * D : p.x_sample + (size_t)(row - TP) * D;
  return p.out + (size_t)row * D;
}
__device__ __forceinline__ int mod_row(int row) { return row < TP ? (row >> 12) : 4 + ((row - TP) >> 3); }

__device__ __forceinline__ void phase_norm(const Params& p, int l) {
  const int lane = tidx() & 63, wave = tidx() >> 6;
  bf16* hbuf = (bf16*)(p.ws + WS_H);
  unsigned char* h8 = p.ws + WS_H8;
  const float* mod = (const float*)(p.ws + WS_MOD);
  const float* g = p.norm_g + l * D;
  for (int row = blockIdx.x * 4 + wave; row < TT; row += gridDim.x * 4) {
    const float4* x = (const float4*)xrow_ptr(p, l, row);
    float4 v[4];
    float ss = 0.f;
#pragma unroll
    for (int i = 0; i < 4; ++i) {
      v[i] = x[lane + 64 * i];
      ss += v[i].x * v[i].x + v[i].y * v[i].y + v[i].z * v[i].z + v[i].w * v[i].w;
    }
    ss = wave_sum(ss);
    const float rstd = rsqrtf(ss * (1.0f / D) + EPS);
    const float* mp = mod + ((size_t)l * NMOD + mod_row(row)) * 3072;
#pragma unroll
    for (int i = 0; i < 4; ++i) {
      const int c = (lane + 64 * i) * 4;
      const float4 gg = *(const float4*)(g + c), sh = *(const float4*)(mp + c), sc = *(const float4*)(mp + 1024 + c);
      uint2 o;
      o.x = pack2(v[i].x * rstd * gg.x * (1.f + sc.x) + sh.x, v[i].y * rstd * gg.y * (1.f + sc.y) + sh.y);
      o.y = pack2(v[i].z * rstd * gg.z * (1.f + sc.z) + sh.z, v[i].w * rstd * gg.w * (1.f + sc.w) + sh.w);
      *(uint2*)(hbuf + (size_t)row * D + c) = o;
      int p8 = __builtin_amdgcn_cvt_pk_fp8_f32(v[i].x * rstd * gg.x * (1.f + sc.x) + sh.x, v[i].y * rstd * gg.y * (1.f + sc.y) + sh.y, 0, false);
      p8 = __builtin_amdgcn_cvt_pk_fp8_f32(v[i].z * rstd * gg.z * (1.f + sc.z) + sh.z, v[i].w * rstd * gg.w * (1.f + sc.w) + sh.w, p8, true);
      *(int*)(h8 + (size_t)row * D + c) = p8;
    }
  }
}

__device__ __forceinline__ void phase_gemm_in(const Params& p, int l, int col0, int ntn, int ldz, unsigned char* smem) {
  bf16* sm = (bf16*)smem;
  const bf16* hbuf = (const bf16*)(p.ws + WS_H);
  const bf16* W = (const bf16*)(p.ws + WS_WIN) + (size_t)l * NWIN * 1024;
  bf16* z = (bf16*)(p.ws + WS_Z);
  const float* bias = p.b_in + (size_t)l * ZIN;
  const int tid = tidx(), lane = tid & 63, wave = tid >> 6, wr = wave >> 1, wc = wave & 1;
  const int ntiles = (TT / 128) * ntn;
  constexpr int OLD = 136;
  for (int t = blockIdx.x; t < ntiles; t += gridDim.x) {
    int pm, pn;
    tile_map(t, ntn, pm, pn);
    const int m0 = pm * 128, n0 = pn * 128;
    f32x4 acc[4][4];
    zero_acc<4>(acc);
    gemm_accum<4>(acc, hbuf + (size_t)m0 * 1024, 1024, W + (size_t)(col0 + n0) * 1024, 1024, 1024, sm);
#pragma unroll
    for (int j = 0; j < 4; ++j) {
      const int cl = wc * 64 + j * 16 + (lane >> 4) * 4;
      const float4 b = *(const float4*)(bias + col0 + n0 + cl);
#pragma unroll
      for (int i = 0; i < 4; ++i) {
        const int rl = wr * 64 + i * 16 + (lane & 15);
        uint2 o;
        o.x = pack2(acc[i][j][0] + b.x, acc[i][j][1] + b.y);
        o.y = pack2(acc[i][j][2] + b.z, acc[i][j][3] + b.w);
        *(uint2*)(sm + rl * OLD + cl) = o;
      }
    }
    __syncthreads();
#pragma unroll
    for (int it = 0; it < 8; ++it) {
      const int id = tid + 256 * it, row = id >> 4, ch = id & 15;
      const u32x4 v = *(const u32x4*)(sm + row * OLD + ch * 8);
      *(u32x4*)(z + (size_t)(m0 + row) * ldz + n0 + ch * 8) = v;
    }
    __syncthreads();
  }
}

__device__ __forceinline__ void gmlp_prompt_item(const Params& p, int l, int item, unsigned char* smem) {
  const int b = item >> 7, n = (item >> 2) & 31, g = item & 3;
  const int r0 = b * SEQ + n * 128;
  const bf16* z = (const bf16*)(p.ws + WS_Z);
  bf16* yab = (bf16*)(p.ws + WS_YAB);
  bf16* sW = (bf16*)smem;
  bf16* sV = (bf16*)(smem + 34816);
  float* srstd = (float*)(smem + 69632);
  const int tid = tidx(), lane = tid & 63, wave = tid >> 6, wr = wave >> 1, wc = wave & 1;
  {
    const int tok = tid >> 1, half = tid & 1;
    const uint4* ptr = (const uint4*)(z + (size_t)(r0 + tok) * ZAB + OFF_AV + half * 256);
    float ss = 0.f;
    for (int i = 0; i < 32; ++i) {
      float f[8];
      unpack8(ptr[i], f);
#pragma unroll
      for (int j = 0; j < 8; ++j) ss += f[j] * f[j];
    }
    ss += __shfl_xor(ss, 1);
    if (half == 0) srstd[tok] = rsqrtf(ss * (1.0f / 512.f) + EPS);
  }
  __syncthreads();
  const float* vg = p.vnorm_g + l * 512 + g * 128;
  for (int i = tid; i < 2048; i += 256) {
    const int s = i >> 4, c8 = (i & 15) * 8;
    float f[8];
    unpack8(*(const uint4*)(z + (size_t)(r0 + s) * ZAB + OFF_AV + g * 128 + c8), f);
    const float rs = srstd[s];
#pragma unroll
    for (int j = 0; j < 8; ++j) sV[(c8 + j) * 136 + s] = f2bf(f[j] * rs * vg[c8 + j]);
  }
  const float* Wg = p.gmlp_ws + ((size_t)(l * 4 + g)) * 128 * 128;
  for (int i = tid; i < 4096; i += 256) {
    const int t = i >> 5, s4 = (i & 31) * 4;
    const float4 w = *(const float4*)(Wg + t * 128 + s4);
    uint2 o;
    o.x = pack2(s4 + 0 <= t ? w.x : 0.f, s4 + 1 <= t ? w.y : 0.f);
    o.y = pack2(s4 + 2 <= t ? w.z : 0.f, s4 + 3 <= t ? w.w : 0.f);
    *(uint2*)(sW + t * 136 + s4) = o;
  }
  __syncthreads();
  f32x4 acc[4][4];
  zero_acc<4>(acc);
  mma_lds<4, 4>(acc, sW + wr * 64 * 136, 136, sV + wc * 64 * 136, 136, wr * 64 + 64, lane);
  const float* bs = p.gmlp_bs + (l * 4 + g) * 128;
#pragma unroll
  for (int i = 0; i < 4; ++i) {
    const int t = wr * 64 + i * 16 + (lane & 15);
    const float bst = bs[t];
    const size_t rowoff = (size_t)(r0 + t) * ZAB;
#pragma unroll
    for (int j = 0; j < 4; ++j) {
      const int c = g * 128 + wc * 64 + j * 16 + (lane >> 4) * 4;
      float u[4], ag[4];
      unpack4(*(const uint2*)(z + rowoff + c), u);
      unpack4(*(const uint2*)(z + rowoff + OFF_AG + c), ag);
      uint2 o;
      o.x = pack2(u[0] * (acc[i][j][0] + bst) * siluf_(ag[0]), u[1] * (acc[i][j][1] + bst) * siluf_(ag[1]));
      o.y = pack2(u[2] * (acc[i][j][2] + bst) * siluf_(ag[2]), u[3] * (acc[i][j][3] + bst) * siluf_(ag[3]));
      *(uint2*)(yab + (size_t)(r0 + t) * 1024 + c) = o;
    }
  }
  __syncthreads();
}

__device__ __forceinline__ void gmlp_sample_item(const Params& p, int l, int b, unsigned char* smem) {
  const int r0 = TP + b * 8;
  const bf16* z = (const bf16*)(p.ws + WS_Z);
  bf16* yab = (bf16*)(p.ws + WS_YAB);
  float* svn = (float*)smem;
  const int tid = tidx(), lane = tid & 63, wave = tid >> 6;
  const float* vg = p.vnorm_g + l * 512;
  for (int tt = 0; tt < 2; ++tt) {
    const int t = wave * 2 + tt;
    float f[8];
    unpack8(*(const uint4*)(z + (size_t)(r0 + t) * ZAB + OFF_AV + lane * 8), f);
    float ss = 0.f;
#pragma unroll
    for (int j = 0; j < 8; ++j) ss += f[j] * f[j];
    ss = wave_sum(ss);
    const float rstd = rsqrtf(ss * (1.0f / 512.f) + EPS);
    float* gv = p.out + O_GV + (((size_t)l * 128 + b) * 8 + t) * 512 + lane * 8;
#pragma unroll
    for (int j = 0; j < 8; ++j) {
      const float vn = f[j] * rstd * vg[lane * 8 + j];
      svn[t * 512 + lane * 8 + j] = vn;
      gv[j] = vn;
    }
  }
  __syncthreads();
  {
    const int c = tid * 2, g = c >> 7;
    const float* Wg = p.gmlp_ws + ((size_t)(l * 4 + g)) * 128 * 128;
    const float* bs = p.gmlp_bs + (l * 4 + g) * 128;
    for (int t = 0; t < 8; ++t) {
      float s0 = bs[t], s1 = bs[t];
      for (int s = 0; s <= t; ++s) {
        const float w = Wg[t * 128 + s];
        s0 += w * svn[s * 512 + c];
        s1 += w * svn[s * 512 + c + 1];
      }
      const unsigned uu = *(const unsigned*)(z + (size_t)(r0 + t) * ZAB + c);
      const unsigned gg = *(const unsigned*)(z + (size_t)(r0 + t) * ZAB + OFF_AG + c);
      *(unsigned*)(yab + (size_t)(r0 + t) * 1024 + c) = pack2(lo2f(uu) * s0 * siluf_(lo2f(gg)), hi2f(uu) * s1 * siluf_(hi2f(gg)));
    }
  }
  __syncthreads();
}

__device__ __forceinline__ void swa_prompt_item(const Params& p, int l, int item, unsigned char* smem) {
  const int b = item >> 7, qt = (item >> 1) & 63, kv = item & 1;
  const int q0 = qt * 64, rb = b * SEQ;
  const bf16* z = (const bf16*)(p.ws + WS_Z);
  bf16* yab = (bf16*)(p.ws + WS_YAB);
  bf16* sK = (bf16*)smem;
  bf16* sVT = (bf16*)(smem + 27648);
  const int tid = tidx(), lane = tid & 63, wave = tid >> 6;
  const float* kg = p.kn_g + l * 64;
  const float* qg = p.qn_g + l * 64;
#pragma unroll 1
  for (int it = 0; it < 6; ++it) {
    const int id = tid + 256 * it, kk = id >> 3, ch = id & 7, kp = q0 - 128 + kk;
    float f[8];
    uint4 vraw = make_uint4(0, 0, 0, 0);
    if (kp >= 0) {
      unpack8(*(const uint4*)(z + (size_t)(rb + kp) * ZAB + OFF_BK + kv * 64 + ch * 8), f);
      vraw = *(const uint4*)(z + (size_t)(rb + kp) * ZAB + OFF_BV + kv * 64 + ch * 8);
    } else {
#pragma unroll
      for (int j = 0; j < 8; ++j) f[j] = 0.f;
    }
    float ss = 0.f;
#pragma unroll
    for (int j = 0; j < 8; ++j) ss += f[j] * f[j];
    ss += __shfl_xor(ss, 1); ss += __shfl_xor(ss, 2); ss += __shfl_xor(ss, 4);
    const float rstd = rsqrtf(ss * (1.0f / 64.f) + EPS);
#pragma unroll
    for (int j = 0; j < 8; ++j) f[j] = f[j] * rstd * kg[ch * 8 + j];
    uint4 ko;
    ko.x = pack2(f[0], f[1]); ko.y = pack2(f[2], f[3]); ko.z = pack2(f[4], f[5]); ko.w = pack2(f[6], f[7]);
    *(uint4*)(sK + kk * 72 + ch * 8) = ko;
    float vf[8];
    unpack8(vraw, vf);
#pragma unroll
    for (int j = 0; j < 8; ++j) sVT[(ch * 8 + j) * 200 + kk] = f2bf(vf[j]);
    if (kk >= 128 && kp >= SEQ - 128) {
      const size_t o = ((((size_t)l * 4 + b) * 128 + (kp - (SEQ - 128))) * 2 + kv) * 64 + ch * 8;
#pragma unroll
      for (int j = 0; j < 8; ++j) { p.out[O_SKP + o + j] = f[j]; p.out[O_SVP + o + j] = vf[j]; }
    }
  }
  __syncthreads();
  const int h = kv * 4 + wave;
  const float sink = p.sinks[l * 8 + h];
  const int g4 = lane >> 4, r16 = lane & 15;
#pragma unroll 1
  for (int i = 0; i < 4; ++i) {
    const int qrow = q0 + i * 16 + r16;
    const size_t grow = (size_t)(rb + qrow);
    bf16x8 qf[2];
    {
      float f0[8], f1[8];
      unpack8(*(const uint4*)(z + grow * ZAB + OFF_BQ + h * 64 + g4 * 8), f0);
      unpack8(*(const uint4*)(z + grow * ZAB + OFF_BQ + h * 64 + 32 + g4 * 8), f1);
      float ss = 0.f;
#pragma unroll
      for (int j = 0; j < 8; ++j) ss += f0[j] * f0[j] + f1[j] * f1[j];
      ss += __shfl_xor(ss, 16); ss += __shfl_xor(ss, 32);
      const float rstd = rsqrtf(ss * (1.0f / 64.f) + EPS) * 0.125f;
#pragma unroll
      for (int j = 0; j < 8; ++j) {
        qf[0][j] = (short)f2bf(f0[j] * rstd * qg[g4 * 8 + j]);
        qf[1][j] = (short)f2bf(f1[j] * rstd * qg[32 + g4 * 8 + j]);
      }
    }
    f32x4 st[12];
#pragma unroll
    for (int kt = 0; kt < 12; ++kt) {
      st[kt] = (f32x4){0.f, 0.f, 0.f, 0.f};
#pragma unroll
      for (int ks = 0; ks < 2; ++ks) {
        const bf16x8 kf = *(const bf16x8*)(sK + (kt * 16 + r16) * 72 + ks * 32 + g4 * 8);
        st[kt] = mfma16(kf, qf[ks], st[kt]);
      }
      if ((kt & 1) == 1) __builtin_amdgcn_sched_barrier(0);
    }
    float mx = -INFINITY;
#pragma unroll
    for (int kt = 0; kt < 12; ++kt)
#pragma unroll
      for (int x = 0; x < 4; ++x) {
        const int kp = q0 - 128 + kt * 16 + g4 * 4 + x, diff = qrow - kp;
        const bool valid = (kp >= 0) && (diff >= 0) && (diff < 128);
        st[kt][x] = valid ? st[kt][x] : -INFINITY;
        mx = fmaxf(mx, st[kt][x]);
      }
    mx = fmaxf(mx, __shfl_xor(mx, 16)); mx = fmaxf(mx, __shfl_xor(mx, 32));
    mx = fmaxf(mx, sink);
    float sum = 0.f;
#pragma unroll
    for (int kt = 0; kt < 12; ++kt)
#pragma unroll
      for (int x = 0; x < 4; ++x) {
        const float pv = __expf(st[kt][x] - mx);
        st[kt][x] = pv;
        sum += pv;
      }
    sum += __shfl_xor(sum, 16); sum += __shfl_xor(sum, 32);
    const float inv = 1.0f / (sum + __expf(sink - mx));
    f32x4 o[4];
#pragma unroll
    for (int dt = 0; dt < 4; ++dt) o[dt] = (f32x4){0.f, 0.f, 0.f, 0.f};
#pragma unroll
    for (int t2 = 0; t2 < 6; ++t2) {
      bf16x8 pf;
#pragma unroll
      for (int x = 0; x < 4; ++x) { pf[x] = (short)f2bf(st[2 * t2][x]); pf[4 + x] = (short)f2bf(st[2 * t2 + 1][x]); }
#pragma unroll
      for (int dt = 0; dt < 4; ++dt) {
        const uint2 v0 = *(const uint2*)(sVT + (dt * 16 + r16) * 200 + t2 * 32 + g4 * 4);
        const uint2 v1 = *(const uint2*)(sVT + (dt * 16 + r16) * 200 + t2 * 32 + 16 + g4 * 4);
        union { uint4 u; bf16x8 v; } cv;
        cv.u = make_uint4(v0.x, v0.y, v1.x, v1.y);
        o[dt] = mfma16(cv.v, pf, o[dt]);
      }
      __builtin_amdgcn_sched_barrier(0);
    }
#pragma unroll
    for (int dt = 0; dt < 4; ++dt) {
      const int d0 = dt * 16 + g4 * 4;
      float bg[4];
      unpack4(*(const uint2*)(z + grow * ZAB + OFF_BG + h * 64 + d0), bg);
      uint2 oo;
      oo.x = pack2(o[dt][0] * inv * siluf_(bg[0]), o[dt][1] * inv * siluf_(bg[1]));
      oo.y = pack2(o[dt][2] * inv * siluf_(bg[2]), o[dt][3] * inv * siluf_(bg[3]));
      *(uint2*)(yab + grow * 1024 + 512 + h * 64 + d0) = oo;
    }
  }
  __syncthreads();
}

__device__ __forceinline__ void swa_sample_item(const Params& p, int l, int item, unsigned char* smem) {
  const int b = item >> 1, kv = item & 1;
  const int r0 = TP + b * 8;
  const bf16* z = (const bf16*)(p.ws + WS_Z);
  bf16* yab = (bf16*)(p.ws + WS_YAB);
  bf16* sK = (bf16*)smem;
  bf16* sV = (bf16*)(smem + 19584);
  float* sq = (float*)(smem + 39168);
  float* sP = (float*)(smem + 47488);
  const int tid = tidx();
  const float* kg = p.kn_g + l * 64;
  const float* qg = p.qn_g + l * 64;
  const float* ck = p.cache_k + ((size_t)l * 128 + b) * 128 * 128;
  const float* cvp = p.cache_v + ((size_t)l * 128 + b) * 128 * 128;
#pragma unroll 1
  for (int it = 0; it < 5; ++it) {
    const int id = tid + 256 * it, j = id >> 3, ch = id & 7;
    const bool act = id < 1088;
    float kf[8], vf[8];
#pragma unroll
    for (int x = 0; x < 8; ++x) { kf[x] = 0.f; vf[x] = 0.f; }
    if (act) {
      if (j < 128) {
        const float4 a0 = *(const float4*)(ck + (j * 2 + kv) * 64 + ch * 8), a1 = *(const float4*)(ck + (j * 2 + kv) * 64 + ch * 8 + 4);
        const float4 b0 = *(const float4*)(cvp + (j * 2 + kv) * 64 + ch * 8), b1 = *(const float4*)(cvp + (j * 2 + kv) * 64 + ch * 8 + 4);
        kf[0] = a0.x; kf[1] = a0.y; kf[2] = a0.z; kf[3] = a0.w; kf[4] = a1.x; kf[5] = a1.y; kf[6] = a1.z; kf[7] = a1.w;
        vf[0] = b0.x; vf[1] = b0.y; vf[2] = b0.z; vf[3] = b0.w; vf[4] = b1.x; vf[5] = b1.y; vf[6] = b1.z; vf[7] = b1.w;
      } else {
        unpack8(*(const uint4*)(z + (size_t)(r0 + j - 128) * ZAB + OFF_BK + kv * 64 + ch * 8), kf);
        unpack8(*(const uint4*)(z + (size_t)(r0 + j - 128) * ZAB + OFF_BV + kv * 64 + ch * 8), vf);
      }
    }
    float ss = 0.f;
#pragma unroll
    for (int x = 0; x < 8; ++x) ss += kf[x] * kf[x];
    ss += __shfl_xor(ss, 1); ss += __shfl_xor(ss, 2); ss += __shfl_xor(ss, 4);
    if (act) {
      if (j >= 128) {
        const float rstd = rsqrtf(ss * (1.0f / 64.f) + EPS);
#pragma unroll
        for (int x = 0; x < 8; ++x) kf[x] = kf[x] * rstd * kg[ch * 8 + x];
      }
      uint4 ko, vo;
      ko.x = pack2(kf[0], kf[1]); ko.y = pack2(kf[2], kf[3]); ko.z = pack2(kf[4], kf[5]); ko.w = pack2(kf[6], kf[7]);
      vo.x = pack2(vf[0], vf[1]); vo.y = pack2(vf[2], vf[3]); vo.z = pack2(vf[4], vf[5]); vo.w = pack2(vf[6], vf[7]);
      *(uint4*)(sK + j * 72 + ch * 8) = ko;
      *(uint4*)(sV + j * 72 + ch * 8) = vo;
      if (j >= 8) {
        const size_t o = ((((size_t)l * 128 + b) * 128 + (j - 8)) * 2 + kv) * 64 + ch * 8;
        *(float4*)(p.out + O_SKS + o) = make_float4(kf[0], kf[1], kf[2], kf[3]);
        *(float4*)(p.out + O_SKS + o + 4) = make_float4(kf[4], kf[5], kf[6], kf[7]);
        *(float4*)(p.out + O_SVS + o) = make_float4(vf[0], vf[1], vf[2], vf[3]);
        *(float4*)(p.out + O_SVS + o + 4) = make_float4(vf[4], vf[5], vf[6], vf[7]);
      }
    }
  }
  const int qi = tid >> 3, sub = tid & 7, t = qi >> 2, h = kv * 4 + (qi & 3);
  {
    float f[8];
    unpack8(*(const uint4*)(z + (size_t)(r0 + t) * ZAB + OFF_BQ + h * 64 + sub * 8), f);
    float ss = 0.f;
#pragma unroll
    for (int x = 0; x < 8; ++x) ss += f[x] * f[x];
    ss += __shfl_xor(ss, 1); ss += __shfl_xor(ss, 2); ss += __shfl_xor(ss, 4);
    const float rstd = rsqrtf(ss * (1.0f / 64.f) + EPS) * 0.125f;
#pragma unroll
    for (int x = 0; x < 8; ++x) sq[qi * 65 + sub * 8 + x] = f[x] * rstd * qg[sub * 8 + x];
  }
  __syncthreads();
  const float sink = p.sinks[l * 8 + h];
  float mx = -INFINITY;
#pragma unroll 1
  for (int jj = 0; jj < 17; ++jj) {
    const int key = sub + 8 * jj;
    float s = 0.f;
#pragma unroll 8
    for (int d = 0; d < 64; ++d) s += sq[qi * 65 + d] * bf2f(sK[key * 72 + d]);
    const bool valid = (key >= t + 1) && (key <= t + 128);
    s = valid ? s : -INFINITY;
    sP[qi * 140 + key] = s;
    mx = fmaxf(mx, s);
  }
  mx = fmaxf(mx, __shfl_xor(mx, 1)); mx = fmaxf(mx, __shfl_xor(mx, 2)); mx = fmaxf(mx, __shfl_xor(mx, 4));
  mx = fmaxf(mx, sink);
  float sum = 0.f;
  for (int jj = 0; jj < 17; ++jj) {
    const int key = sub + 8 * jj;
    const float pv = __expf(sP[qi * 140 + key] - mx);
    sP[qi * 140 + key] = pv;
    sum += pv;
  }
  sum += __shfl_xor(sum, 1); sum += __shfl_xor(sum, 2); sum += __shfl_xor(sum, 4);
  const float inv = 1.0f / (sum + __expf(sink - mx));
  __syncthreads();
  {
    float o[8];
#pragma unroll
    for (int x = 0; x < 8; ++x) o[x] = 0.f;
#pragma unroll 2
    for (int key = 0; key < 136; ++key) {
      const float pv = sP[qi * 140 + key];
      float vf[8];
      unpack8(*(const uint4*)(sV + key * 72 + sub * 8), vf);
#pragma unroll
      for (int x = 0; x < 8; ++x) o[x] += pv * vf[x];
    }
    float bg[8];
    unpack8(*(const uint4*)(z + (size_t)(r0 + t) * ZAB + OFF_BG + h * 64 + sub * 8), bg);
    uint4 oo;
    oo.x = pack2(o[0] * inv * siluf_(bg[0]), o[1] * inv * siluf_(bg[1]));
    oo.y = pack2(o[2] * inv * siluf_(bg[2]), o[3] * inv * siluf_(bg[3]));
    oo.z = pack2(o[4] * inv * siluf_(bg[4]), o[5] * inv * siluf_(bg[5]));
    oo.w = pack2(o[6] * inv * siluf_(bg[6]), o[7] * inv * siluf_(bg[7]));
    *(uint4*)(yab + (size_t)(r0 + t) * 1024 + 512 + h * 64 + sub * 8) = oo;
  }
  __syncthreads();
}

__device__ __forceinline__ void phase_mix_ab(const Params& p, int l, unsigned char* smem) {
  constexpr int N_SWA = 512, N_GM = 512, N_SWS = 256, N_GMS = 128;
  constexpr int N_ALL = N_SWA + N_GM + N_SWS + N_GMS;
  for (int it = blockIdx.x; it < N_ALL; it += gridDim.x) {
    int i = it;
    if (i < N_SWA) { swa_prompt_item(p, l, i, smem); continue; }
    i -= N_SWA;
    if (i < N_GM) { gmlp_prompt_item(p, l, i, smem); continue; }
    i -= N_GM;
    if (i < N_SWS) { swa_sample_item(p, l, i, smem); continue; }
    i -= N_SWS;
    gmlp_sample_item(p, l, i, smem);
  }
}

__device__ __forceinline__ void conv8_prompt(const Params& p, int l, const bf16* z, int r0, int pos0, int s, int zc, float* y) {
  const float* cw = p.conv_w + (size_t)l * 4 * 1024 + zc;
  const float* cb = p.conv_b + l * 1024 + zc;
#pragma unroll
  for (int j = 0; j < 8; ++j) y[j] = cb[j];
#pragma unroll
  for (int tap = 0; tap < 4; ++tap) {
    const int back = 3 - tap;
    if (pos0 + s - back >= 0) {
      float f[8];
      unpack8(*(const uint4*)(z + (size_t)(r0 + s - back) * ZC + C_QK + zc), f);
#pragma unroll
      for (int j = 0; j < 8; ++j) y[j] += cw[tap * 1024 + j] * f[j];
    }
  }
#pragma unroll
  for (int j = 0; j < 8; ++j) y[j] = siluf_(y[j]);
}

__device__ __forceinline__ void chunk_gates(const Params& p, int l, const bf16* z, int r0, int hh, int lane, float& cum, float& iv) {
  const float f = bf2f(z[(size_t)(r0 + lane) * ZC + C_F + hh]) + p.f_bias[l * 4 + hh];
  iv = bf2f(z[(size_t)(r0 + lane) * ZC + C_I + hh]);
  float c = logsigmoidf_(f);
#pragma unroll
  for (int o = 1; o < 64; o <<= 1) {
    const float n = __shfl_up(c, o);
    if (lane >= o) c += n;
  }
  cum = c;
}

__device__ __forceinline__ void mlstm_local_item(const Params& p, int l, int item, unsigned char* smem) {
  const int bh = item >> 6, c = item & 63, b = bh >> 2, hh = bh & 3;
  const int r0 = b * SEQ + c * 64;
  const bf16* z = (const bf16*)(p.ws + WS_Z);
  bf16* skT = (bf16*)smem;
  bf16* svT = (bf16*)(smem + 18432);
  float* swsel = (float*)(smem + 36864);
  const int tid = tidx(), lane = tid & 63, wave = tid >> 6, wr = wave >> 1, wc = wave & 1;
  if (wave == 0) {
    float cum, iv;
    chunk_gates(p, l, z, r0, hh, lane, cum, iv);
    const float total = __shfl(cum, 63);
    const float g = total - cum + iv;
    const float G = wave_max(g);
    swsel[lane] = __expf(g - G);
    if (lane == 0) {
      ((float*)(p.ws + WS_G))[item] = G;
      ((float*)(p.ws + WS_TOT))[item] = total;
    }
  }
  __syncthreads();
  for (int i = tid; i < 1024; i += 256) {
    const int s = i >> 4, d8 = (i & 15) * 8;
    float y[8];
    conv8_prompt(p, l, z, r0, c * 64, s, 512 + hh * 128 + d8, y);
    const float sc = 0.08838834764831845f * swsel[s];
#pragma unroll
    for (int j = 0; j < 8; ++j) skT[(d8 + j) * 72 + s] = f2bf(y[j] * sc);
    float v[8];
    unpack8(*(const uint4*)(z + (size_t)(r0 + s) * ZC + C_V + hh * 128 + d8), v);
#pragma unroll
    for (int j = 0; j < 8; ++j) svT[(d8 + j) * 72 + s] = f2bf(v[j]);
  }
  __syncthreads();
  f32x4 acc[4][4];
  zero_acc<4>(acc);
  mma_lds<4, 4>(acc, svT + wr * 64 * 72, 72, skT + wc * 64 * 72, 72, 64, lane);
  bf16* U = (bf16*)(p.ws + WS_U) + (size_t)item * 16384;
#pragma unroll
  for (int i = 0; i < 4; ++i)
#pragma unroll
    for (int j = 0; j < 4; ++j) {
      const int e = wr * 64 + i * 16 + (lane & 15), d = wc * 64 + j * 16 + (lane >> 4) * 4;
      uint2 o;
      o.x = pack2(acc[i][j][0], acc[i][j][1]);
      o.y = pack2(acc[i][j][2], acc[i][j][3]);
      *(uint2*)(U + e * 128 + d) = o;
    }
  if (tid < 128) {
    float s = 0.f;
    for (int k = 0; k < 64; ++k) s += bf2f(skT[tid * 72 + k]);
    ((float*)(p.ws + WS_UN))[(size_t)item * 128 + tid] = s;
  }
  __syncthreads();
}

__device__ __forceinline__ void mlstm_convout_item(const Params& p, int l, int b) {
  const bf16* z = (const bf16*)(p.ws + WS_Z);
  for (int i = tidx(); i < 3 * 1024; i += 256) {
    const int j = i >> 10, ch = i & 1023;
    p.out[O_CVP + (((size_t)l * 4 + b) * 3 + j) * 1024 + ch] = bf2f(z[(size_t)(b * SEQ + SEQ - 3 + j) * ZC + C_QK + ch]);
  }
}

__device__ __forceinline__ void mlstm_sample_item(const Params& p, int l, int item, unsigned char* smem) {
  const int b = item >> 2, hh = item & 3;
  const int r0 = TP + b * 8;
  bf16* z = (bf16*)(p.ws + WS_Z);
  float* sq = (float*)smem;
  float* sk = sq + 1024;
  float* sv = sk + 1024;
  float* sh = sv + 1024;
  float* sint = sh + 1024;
  float* sa = sint + 2048;
  float* sqn = sa + 64;
  float* smt = sqn + 8;
  float* swi = smt + 8;
  float* swsel = swi + 8;
  float* sdm = swsel + 8;
  float* sdecay = sdm + 64;
  const int tid = tidx(), lane = tid & 63, wave = tid >> 6;
  {
    const int isk = tid >> 7, d = tid & 127, zc = isk * 512 + hh * 128 + d;
    const float* cw = p.conv_w + (size_t)l * 4 * 1024 + zc;
    const float cb = p.conv_b[l * 1024 + zc];
    float xp[11];
    const float* cs = p.st_conv + ((size_t)l * 128 + b) * 3 * 1024 + zc;
    xp[0] = cs[0]; xp[1] = cs[1024]; xp[2] = cs[2048];
#pragma unroll
    for (int t = 0; t < 8; ++t) xp[3 + t] = bf2f(z[(size_t)(r0 + t) * ZC + C_QK + zc]);
    const float w0 = cw[0], w1 = cw[1024], w2 = cw[2048], w3 = cw[3072];
    float* dst = isk ? sk : sq;
    const float sc = isk ? 0.08838834764831845f : 1.0f;
#pragma unroll
    for (int t = 0; t < 8; ++t) {
      const float y = cb + w0 * xp[t] + w1 * xp[t + 1] + w2 * xp[t + 2] + w3 * xp[t + 3];
      dst[t * 128 + d] = siluf_(y) * sc;
    }
    float* co = p.out + O_CVS + ((size_t)l * 128 + b) * 3 * 1024 + zc;
    co[0] = xp[8]; co[1024] = xp[9]; co[2048] = xp[10];
  }
  for (int i = tid; i < 1024; i += 256) {
    const int t = i >> 7, e = i & 127;
    sv[i] = bf2f(z[(size_t)(r0 + t) * ZC + C_V + hh * 128 + e]);
  }
  if (tid == 0) {
    float cum[8], iv[8];
    float c = 0.f;
    for (int t = 0; t < 8; ++t) {
      const float f = bf2f(z[(size_t)(r0 + t) * ZC + C_F + hh]) + p.f_bias[l * 4 + hh];
      c += logsigmoidf_(f);
      cum[t] = c;
      iv[t] = bf2f(z[(size_t)(r0 + t) * ZC + C_I + hh]);
    }
    const float m0 = p.st_m[(l * 128 + b) * 4 + hh];
    for (int t = 0; t < 8; ++t) {
      float dmax = -INFINITY;
      for (int s = 0; s <= t; ++s) dmax = fmaxf(dmax, cum[t] - cum[s] + iv[s]);
      const float mi = cum[t] + m0, mt = fmaxf(mi, dmax);
      smt[t] = mt;
      swi[t] = __expf(mi - mt);
      for (int s = 0; s < 8; ++s) sdm[t * 8 + s] = (s <= t) ? __expf(cum[t] - cum[s] + iv[s] - mt) : 0.f;
    }
    const float total = cum[7];
    float gm = -INFINITY;
    for (int s = 0; s < 8; ++s) gm = fmaxf(gm, total - cum[s] + iv[s]);
    const float mn = fmaxf(total + m0, gm);
    for (int s = 0; s < 8; ++s) swsel[s] = __expf(total - cum[s] + iv[s] - mn);
    sdecay[0] = __expf(total + m0 - mn);
    p.out[O_MS + (l * 128 + b) * 4 + hh] = mn;
  }
  __syncthreads();
  const float* n0 = p.st_n + (((size_t)l * 128 + b) * 4 + hh) * 128;
  if (tid < 64) {
    const int t = tid >> 3, s = tid & 7;
    float dsum = 0.f;
    for (int d = 0; d < 128; ++d) dsum += sq[t * 128 + d] * sk[s * 128 + d];
    sa[t * 8 + s] = sdm[t * 8 + s] * dsum;
  } else if (tid < 128) {
    const int t = (tid - 64) >> 3, part = (tid - 64) & 7;
    float dsum = 0.f;
    for (int d = part * 16; d < part * 16 + 16; ++d) dsum += sq[t * 128 + d] * n0[d];
    dsum += __shfl_xor(dsum, 1); dsum += __shfl_xor(dsum, 2); dsum += __shfl_xor(dsum, 4);
    if (part == 0) sqn[t] = dsum;
  }
  __syncthreads();
  {
    const int e = tid & 127, dh = tid >> 7;
    const float decay = sdecay[0];
    const float* C0 = p.st_C + (((size_t)l * 128 + b) * 4 + hh) * 16384;
    float* C1 = p.out + O_CS + (((size_t)l * 128 + b) * 4 + hh) * 16384;
    float vw[8], inter[8];
#pragma unroll
    for (int s = 0; s < 8; ++s) { vw[s] = sv[s * 128 + e] * swsel[s]; inter[s] = 0.f; }
    for (int d = dh * 64; d < dh * 64 + 64; ++d) {
      const float c0 = C0[d * 128 + e];
      float upd = decay * c0;
#pragma unroll
      for (int s = 0; s < 8; ++s) {
        upd += sk[s * 128 + d] * vw[s];
        inter[s] += sq[s * 128 + d] * c0;
      }
      C1[d * 128 + e] = upd;
    }
#pragma unroll
    for (int t = 0; t < 8; ++t) sint[(dh * 8 + t) * 128 + e] = inter[t];
  }
  __syncthreads();
  if (tid < 128) {
    const int e = tid;
    for (int t = 0; t < 8; ++t) {
      float num = swi[t] * (sint[t * 128 + e] + sint[(8 + t) * 128 + e]);
      float den = swi[t] * sqn[t];
      for (int s = 0; s <= t; ++s) { num += sa[t * 8 + s] * sv[s * 128 + e]; den += sa[t * 8 + s]; }
      sh[t * 128 + e] = num / fmaxf(fabsf(den), __expf(-smt[t]));
    }
    float nn = sdecay[0] * n0[e];
    for (int s = 0; s < 8; ++s) nn += swsel[s] * sk[s * 128 + e];
    p.out[O_NS + (((size_t)l * 128 + b) * 4 + hh) * 128 + e] = nn;
  }
  __syncthreads();
  const float* hg = p.hnorm_g + l * 512 + hh * 128;
  for (int tt = 0; tt < 2; ++tt) {
    const int t = wave * 2 + tt;
    const float h0 = sh[t * 128 + lane], h1 = sh[t * 128 + 64 + lane];
    const float ss = wave_sum(h0 * h0 + h1 * h1);
    const float rstd = rsqrtf(ss * (1.0f / 128.f) + EPS);
    bf16* zr = z + (size_t)(r0 + t) * ZC;
#pragma unroll
    for (int k = 0; k < 2; ++k) {
      const int e = lane + 64 * k;
      const float hv = k ? h1 : h0;
      const float o = bf2f(zr[C_O + hh * 128 + e]), cg_ = bf2f(zr[C_G + hh * 128 + e]);
      zr[C_O + hh * 128 + e] = f2bf(hv * rstd * hg[e] * sigmoidf_(o) * siluf_(cg_));
    }
  }
  __syncthreads();
}

__device__ __forceinline__ void phase_mix1(const Params& p, int l, unsigned char* smem) {
  constexpr int N_LOC = 1024, N_SMP = 512, N_CV = 4;
  constexpr int N_ALL = N_LOC + N_SMP + N_CV;
  for (int it = blockIdx.x; it < N_ALL; it += gridDim.x) {
    int i = it;
    if (i < N_LOC) { mlstm_local_item(p, l, i, smem); continue; }
    i -= N_LOC;
    if (i < N_SMP) { mlstm_sample_item(p, l, i, smem); continue; }
    i -= N_SMP;
    mlstm_convout_item(p, l, i);
  }
}

__device__ __forceinline__ void phase_scan(const Params& p, int l, unsigned char* smem) {
  float* sdec = (float*)smem;
  float* ssc = sdec + 64;
  const int tid = tidx();
  float* Gb = (float*)(p.ws + WS_G);
  float* Tb = (float*)(p.ws + WS_TOT);
  float* Mb = (float*)(p.ws + WS_M);
  for (int it = blockIdx.x; it < 256; it += gridDim.x) {
    const int bh = it >> 4, slice = it & 15;
    if (tid < 64) { sdec[128 + tid] = Gb[bh * 64 + tid]; sdec[192 + tid] = Tb[bh * 64 + tid]; }
    __syncthreads();
    if (tid == 0) {
      float m = 0.f;
      for (int c = 0; c < 64; ++c) {
        const float G = sdec[128 + c], tot = sdec[192 + c];
        const float mn = fmaxf(tot + m, G);
        sdec[c] = __expf(tot + m - mn);
        ssc[c] = __expf(G - mn);
        if (slice == 0) Mb[bh * 64 + c] = m;
        m = mn;
      }
      if (slice == 0) p.out[O_MP + l * 16 + bh] = m;
    }
    __syncthreads();
    {
      const int idx = slice * 1024 + tid * 4;
      bf16* U = (bf16*)(p.ws + WS_U) + (size_t)bh * 64 * 16384 + idx;
      float st[4] = {0.f, 0.f, 0.f, 0.f};
#pragma unroll 8
      for (int c = 0; c < 64; ++c) {
        float u[4];
        unpack4(*(const uint2*)(U + (size_t)c * 16384), u);
        uint2 o;
        o.x = pack2(st[0], st[1]); o.y = pack2(st[2], st[3]);
        *(uint2*)(U + (size_t)c * 16384) = o;
        const float dc = sdec[c], sc = ssc[c];
#pragma unroll
        for (int x = 0; x < 4; ++x) st[x] = dc * st[x] + sc * u[x];
      }
      const int e = idx >> 7, d0 = idx & 127;
      float* Co = p.out + O_CP + ((size_t)l * 16 + bh) * 16384;
#pragma unroll
      for (int x = 0; x < 4; ++x) Co[(d0 + x) * 128 + e] = st[x];
    }
    if (slice == 0 && tid < 128) {
      float* un = (float*)(p.ws + WS_UN) + (size_t)bh * 64 * 128 + tid;
      float n = 0.f;
#pragma unroll 8
      for (int c = 0; c < 64; ++c) {
        const float u = un[c * 128];
        un[c * 128] = n;
        n = sdec[c] * n + ssc[c] * u;
      }
      p.out[O_NP + ((size_t)l * 16 + bh) * 128 + tid] = n;
    }
    __syncthreads();
  }
}

__device__ __forceinline__ void mlstm_out_item(const Params& p, int l, int item, unsigned char* smem) {
  const int bh = item >> 6, c = item & 63, b = bh >> 2, hh = bh & 3;
  const int r0 = b * SEQ + c * 64;
  bf16* z = (bf16*)(p.ws + WS_Z);
  bf16* sq = (bf16*)smem;
  bf16* sk = (bf16*)(smem + 17408);
  bf16* svT = (bf16*)(smem + 34816);
  bf16* sa = (bf16*)(smem + 53248);
  float* scum = (float*)(smem + 62464);
  float* siv = scum + 64;
  float* smt = siv + 64;
  float* swi = smt + 64;
  float* sden = swi + 64;
  float* sqn = sden + 64;
  float* spart = sqn + 64;
  const int tid = tidx(), lane = tid & 63, wave = tid >> 6;
  const int r16 = lane & 15, g4 = lane >> 4;
  if (wave == 0) {
    float cum, iv;
    chunk_gates(p, l, z, r0, hh, lane, cum, iv);
    scum[lane] = cum;
    siv[lane] = iv;
  }
  for (int i = tid; i < 2048; i += 256) {
    const int isk = i >> 10, r = i & 1023, s = r >> 4, d8 = (r & 15) * 8;
    float y[8];
    conv8_prompt(p, l, z, r0, c * 64, s, isk * 512 + hh * 128 + d8, y);
    const float sc = isk ? 0.08838834764831845f : 1.0f;
    uint4 o;
    o.x = pack2(y[0] * sc, y[1] * sc); o.y = pack2(y[2] * sc, y[3] * sc);
    o.z = pack2(y[4] * sc, y[5] * sc); o.w = pack2(y[6] * sc, y[7] * sc);
    *(uint4*)((isk ? sk : sq) + s * 136 + d8) = o;
  }
  for (int i = tid; i < 1024; i += 256) {
    const int s = i >> 4, d8 = (i & 15) * 8;
    float v[8];
    unpack8(*(const uint4*)(z + (size_t)(r0 + s) * ZC + C_V + hh * 128 + d8), v);
#pragma unroll
    for (int j = 0; j < 8; ++j) svT[(d8 + j) * 72 + s] = f2bf(v[j]);
  }
  __syncthreads();
  const float m_prev = ((const float*)(p.ws + WS_M))[item];
  {
    const int t = wave * 16 + r16;
    bf16x8 qf[4];
#pragma unroll
    for (int ks = 0; ks < 4; ++ks) qf[ks] = *(const bf16x8*)(sq + t * 136 + ks * 32 + g4 * 8);
    f32x4 st[4];
#pragma unroll
    for (int kt = 0; kt < 4; ++kt) {
      st[kt] = (f32x4){0.f, 0.f, 0.f, 0.f};
#pragma unroll
      for (int ks = 0; ks < 4; ++ks) {
        const bf16x8 kf = *(const bf16x8*)(sk + (kt * 16 + r16) * 136 + ks * 32 + g4 * 8);
        st[kt] = mfma16(kf, qf[ks], st[kt]);
      }
    }
    const float cumt = scum[t];
    float dm[4][4];
    float rmax = -INFINITY;
#pragma unroll
    for (int kt = 0; kt < 4; ++kt)
#pragma unroll
      for (int x = 0; x < 4; ++x) {
        const int s = kt * 16 + g4 * 4 + x;
        dm[kt][x] = (s <= t) ? (cumt - scum[s] + siv[s]) : -INFINITY;
        rmax = fmaxf(rmax, dm[kt][x]);
      }
    rmax = fmaxf(rmax, __shfl_xor(rmax, 16)); rmax = fmaxf(rmax, __shfl_xor(rmax, 32));
    const float mi = cumt + m_prev, mt = fmaxf(mi, rmax);
    float rsum = 0.f;
#pragma unroll
    for (int kt = 0; kt < 4; ++kt) {
      float a[4];
#pragma unroll
      for (int x = 0; x < 4; ++x) {
        const int s = kt * 16 + g4 * 4 + x;
        a[x] = (s <= t) ? __expf(dm[kt][x] - mt) * st[kt][x] : 0.f;
        rsum += a[x];
      }
      uint2 o;
      o.x = pack2(a[0], a[1]); o.y = pack2(a[2], a[3]);
      *(uint2*)(sa + t * 72 + kt * 16 + g4 * 4) = o;
    }
    rsum += __shfl_xor(rsum, 16); rsum += __shfl_xor(rsum, 32);
    if (g4 == 0) { smt[t] = mt; swi[t] = __expf(mi - mt); sden[t] = rsum; }
  }
  {
    const int t = tid >> 2, part = tid & 3;
    const float* nc = (const float*)(p.ws + WS_UN) + (size_t)item * 128;
    float s = 0.f;
    for (int d = part * 32; d < part * 32 + 32; ++d) s += bf2f(sq[t * 136 + d]) * nc[d];
    s += __shfl_xor(s, 1); s += __shfl_xor(s, 2);
    if (part == 0) sqn[t] = s;
  }
  __syncthreads();
  f32x4 acc[4][2];
#pragma unroll
  for (int ti = 0; ti < 4; ++ti)
#pragma unroll
    for (int et = 0; et < 2; ++et) acc[ti][et] = (f32x4){0.f, 0.f, 0.f, 0.f};
  const bf16* Cc = (const bf16*)(p.ws + WS_U) + (size_t)item * 16384;
#pragma unroll
  for (int ks = 0; ks < 4; ++ks) {
    bf16x8 cf[2], qf[4];
#pragma unroll
    for (int et = 0; et < 2; ++et) cf[et] = *(const bf16x8*)(Cc + (wave * 32 + et * 16 + r16) * 128 + ks * 32 + g4 * 8);
#pragma unroll
    for (int ti = 0; ti < 4; ++ti) qf[ti] = *(const bf16x8*)(sq + (ti * 16 + r16) * 136 + ks * 32 + g4 * 8);
#pragma unroll
    for (int ti = 0; ti < 4; ++ti)
#pragma unroll
      for (int et = 0; et < 2; ++et) acc[ti][et] = mfma16(cf[et], qf[ti], acc[ti][et]);
  }
#pragma unroll
  for (int ti = 0; ti < 4; ++ti) {
    const float w = swi[ti * 16 + r16];
#pragma unroll
    for (int et = 0; et < 2; ++et) acc[ti][et] *= w;
  }
#pragma unroll
  for (int ks = 0; ks < 2; ++ks) {
    bf16x8 vf[2], af[4];
#pragma unroll
    for (int et = 0; et < 2; ++et) vf[et] = *(const bf16x8*)(svT + (wave * 32 + et * 16 + r16) * 72 + ks * 32 + g4 * 8);
#pragma unroll
    for (int ti = 0; ti < 4; ++ti) af[ti] = *(const bf16x8*)(sa + (ti * 16 + r16) * 72 + ks * 32 + g4 * 8);
#pragma unroll
    for (int ti = 0; ti < 4; ++ti)
#pragma unroll
      for (int et = 0; et < 2; ++et) acc[ti][et] = mfma16(vf[et], af[ti], acc[ti][et]);
  }
#pragma unroll
  for (int ti = 0; ti < 4; ++ti) {
    const int t = ti * 16 + r16;
    const float den = sden[t] + swi[t] * sqn[t];
    const float inv = 1.0f / fmaxf(fabsf(den), __expf(-smt[t]));
    float ss = 0.f;
#pragma unroll
    for (int et = 0; et < 2; ++et) {
      acc[ti][et] *= inv;
#pragma unroll
      for (int x = 0; x < 4; ++x) ss += acc[ti][et][x] * acc[ti][et][x];
    }
    ss += __shfl_xor(ss, 16); ss += __shfl_xor(ss, 32);
    if (g4 == 0) spart[t * 4 + wave] = ss;
  }
  __syncthreads();
  const float* hg = p.hnorm_g + l * 512 + hh * 128;
#pragma unroll
  for (int ti = 0; ti < 4; ++ti) {
    const int t = ti * 16 + r16;
    const float rstd = rsqrtf((spart[t * 4] + spart[t * 4 + 1] + spart[t * 4 + 2] + spart[t * 4 + 3]) * (1.0f / 128.f) + EPS);
    bf16* zr = z + (size_t)(r0 + t) * ZC;
#pragma unroll
    for (int et = 0; et < 2; ++et) {
      const int e = wave * 32 + et * 16 + g4 * 4;
      float o[4], cg_[4];
      unpack4(*(const uint2*)(zr + C_O + hh * 128 + e), o);
      unpack4(*(const uint2*)(zr + C_G + hh * 128 + e), cg_);
      float y[4];
#pragma unroll
      for (int x = 0; x < 4; ++x) y[x] = acc[ti][et][x] * rstd * hg[e + x] * sigmoidf_(o[x]) * siluf_(cg_[x]);
      uint2 oo;
      oo.x = pack2(y[0], y[1]); oo.y = pack2(y[2], y[3]);
      *(uint2*)(zr + C_O + hh * 128 + e) = oo;
    }
  }
  __syncthreads();
}

__device__ __forceinline__ void phase_mix2(const Params& p, int l, unsigned char* smem) {
  for (int it = blockIdx.x; it < 1024; it += gridDim.x) mlstm_out_item(p, l, it, smem);
}

__device__ __forceinline__ void phase_gemm_br(const Params& p, int l, unsigned char* smem) {
  bf16* sm = (bf16*)smem;
  const bf16* hbuf = (const bf16*)(p.ws + WS_H);
  const bf16* Win = (const bf16*)(p.ws + WS_WIN) + (size_t)l * NWIN * 1024;
  const bf16* Wbr = (const bf16*)(p.ws + WS_WBR) + (size_t)l * 1024 * 1536;
  const bf16* yab = (const bf16*)(p.ws + WS_YAB);
  const bf16* z = (const bf16*)(p.ws + WS_Z);
  bf16* merged = (bf16*)(p.ws + WS_U);
  const float* bias = p.b_in + (size_t)l * ZIN + OFF_MG;
  const int lane = tidx() & 63, wave = tidx() >> 6, wr = wave >> 1, wc = wave & 1;
  const int ntiles = (TT / 128) * 8;
  for (int t = blockIdx.x; t < ntiles; t += gridDim.x) {
    int pm, pn;
    tile_map(t, 8, pm, pn);
    const int m0 = pm * 128, n0 = pn * 128;
#pragma unroll 1
    for (int seg = 0; seg < 3; ++seg) {
      f32x4 acc[4][4];
      zero_acc<4>(acc);
      gemm_accum_f8<4>(acc, p.ws + WS_H8 + (size_t)m0 * 1024, p.ws + WS_W8 + ((size_t)l * W8_ROWS + (OFF_MG - W8_ROW0) + seg * 1024 + n0) * 1024, sm);
      unsigned gp[4][4][2];
#pragma unroll
      for (int j = 0; j < 4; ++j) {
        const int col = n0 + wc * 64 + j * 16 + (lane >> 4) * 4;
        const float4 bb = *(const float4*)(bias + seg * 1024 + col);
#pragma unroll
        for (int i = 0; i < 4; ++i) {
          gp[i][j][0] = pack2(sigmoidf_(acc[i][j][0] * 0.015625f + bb.x), sigmoidf_(acc[i][j][1] * 0.015625f + bb.y));
          gp[i][j][1] = pack2(sigmoidf_(acc[i][j][2] * 0.015625f + bb.z), sigmoidf_(acc[i][j][3] * 0.015625f + bb.w));
        }
      }
      zero_acc<4>(acc);
      const bf16* A = (seg == 0) ? yab + (size_t)m0 * 1024 : (seg == 1) ? yab + (size_t)m0 * 1024 + 512 : z + (size_t)m0 * ZC + C_O;
      const int lda = (seg == 2) ? ZC : 1024;
      gemm_accum<4, true>(acc, A, lda, Wbr + (size_t)n0 * 1536 + seg * 512, 1536, 512, sm);
#pragma unroll
      for (int i = 0; i < 4; ++i)
#pragma unroll
        for (int j = 0; j < 4; ++j) {
          const int row = m0 + wr * 64 + i * 16 + (lane & 15), col = n0 + wc * 64 + j * 16 + (lane >> 4) * 4;
          uint2* mp = (uint2*)(merged + (size_t)row * 1024 + col);
          uint2 prev = make_uint2(0u, 0u);
          if (seg > 0) prev = *mp;
          uint2 o;
          o.x = pack2(lo2f(prev.x) + lo2f(gp[i][j][0]) * acc[i][j][0], hi2f(prev.x) + hi2f(gp[i][j][0]) * acc[i][j][1]);
          o.y = pack2(lo2f(prev.y) + lo2f(gp[i][j][1]) * acc[i][j][2], hi2f(prev.y) + hi2f(gp[i][j][1]) * acc[i][j][3]);
          *mp = o;
        }
    }
  }
}

__device__ __forceinline__ void phase_gemm_out(const Params& p, int l, unsigned char* smem) {
  bf16* sm = (bf16*)smem;
  const bf16* merged = (const bf16*)(p.ws + WS_U);
  const bf16* Wout = (const bf16*)(p.ws + WS_WOUT) + (size_t)l * 1024 * 1024;
  const float* mod = (const float*)(p.ws + WS_MOD);
  const int lane = tidx() & 63, wave = tidx() >> 6, wr = wave >> 1, wc = wave & 1;
  const int ntiles = (TT / 128) * 8;
  for (int t = blockIdx.x; t < ntiles; t += gridDim.x) {
    int pm, pn;
    tile_map(t, 8, pm, pn);
    const int m0 = pm * 128, n0 = pn * 128;
    f32x4 acc[4][4];
    zero_acc<4>(acc);
    gemm_accum<4>(acc, merged + (size_t)m0 * 1024, 1024, Wout + (size_t)n0 * 1024, 1024, 1024, sm);
#pragma unroll
    for (int i = 0; i < 4; ++i) {
      const int row = m0 + wr * 64 + i * 16 + (lane & 15);
      const float* xr = xrow_ptr(p, l, row);
      const float* gate = mod + ((size_t)l * NMOD + mod_row(row)) * 3072 + 2048;
#pragma unroll
      for (int j = 0; j < 4; ++j) {
        const int col = n0 + wc * 64 + j * 16 + (lane >> 4) * 4;
        const float4 xv = *(const float4*)(xr + col), gv = *(const float4*)(gate + col);
        float4 o;
        o.x = xv.x + gv.x * acc[i][j][0]; o.y = xv.y + gv.y * acc[i][j][1];
        o.z = xv.z + gv.z * acc[i][j][2]; o.w = xv.w + gv.w * acc[i][j][3];
        *(float4*)(p.out + (size_t)row * D + col) = o;
      }
    }
  }
}

constexpr int N_PHASES = 19;
template <int S>
__device__ __forceinline__ void run_stage(const Params& p, int l, unsigned char* smem) {
  if (S == -1) phase_prep(p, smem);
  if (S == 0) phase_norm(p, l);
  if (S == 1) phase_gemm_in(p, l, 0, ZAB / 128, ZAB, smem);
  if (S == 2) phase_mix_ab(p, l, smem);
  if (S == 3) phase_gemm_in(p, l, ZAB, ZC / 128, ZC, smem);
  if (S == 4) phase_mix1(p, l, smem);
  if (S == 5) phase_scan(p, l, smem);
  if (S == 6) phase_mix2(p, l, smem);
  if (S == 7) phase_gemm_br(p, l, smem);
  if (S == 8) phase_gemm_out(p, l, smem);
}


#define XB_TMO      128
#define XB_XCNT(j)  (256  + 64 * (j))
#define XB_XSUB(j)  (1280 + 64 * (j))
#define XB_XGEN(j)  (2304 + 64 * (j))
#define XB_TOP      3328
#define XB_TOPGEN   3392
#define XCD_BAR_WORDS 3456
#define XB_SPIN_CAP (1u << 18)
#define LAS __attribute__((address_space(3)))
__device__ __forceinline__ unsigned xb_ld(unsigned* p)              { return __hip_atomic_load(p, __ATOMIC_RELAXED, __HIP_MEMORY_SCOPE_AGENT); }
__device__ __forceinline__ unsigned xb_add(unsigned* p, unsigned v) { return __hip_atomic_fetch_add(p, v, __ATOMIC_RELAXED, __HIP_MEMORY_SCOPE_AGENT); }
__device__ __forceinline__ unsigned xb_xcc_id() { return (unsigned)__builtin_amdgcn_s_getreg((3 << 11) | 20) & 0xFu; }
#define XB_SPIN(cond, bar) do { unsigned _sp = 0; while (cond) { __builtin_amdgcn_s_sleep(1); \
    if ((++_sp & 255u) == 0u) { if (xb_ld(&(bar)[XB_TMO])) break; if (_sp > XB_SPIN_CAP) { atomicAdd(&(bar)[XB_TMO], 1u); break; } } } } while (0)
struct XcdBarrier { unsigned* bar; unsigned x; volatile LAS unsigned* st; };
__device__ __forceinline__ XcdBarrier xcd_barrier_post(unsigned* bar, volatile LAS unsigned* st) {
  XcdBarrier b; b.bar = bar; b.x = xb_xcc_id(); b.st = st;
  if (threadIdx.x == 0) (void)xb_add(&bar[XB_XCNT(b.x)], 1u);
  return b;
}
__device__ __forceinline__ void xcd_barrier_complete(unsigned* bar, unsigned x, unsigned& nloc, unsigned& nx) {
  const unsigned G = gridDim.x * gridDim.y * gridDim.z;
  unsigned sum, cnt, mine, sp = 0u;
  for (;;) {
    sum = 0u; cnt = 0u; mine = 0u;
#pragma unroll
    for (unsigned j = 0; j < 16; ++j) { const unsigned c = xb_ld(&bar[XB_XCNT(j)]); sum += c; cnt += (c > 0u) ? 1u : 0u; mine = (j == x) ? c : mine; }
    if (sum == G) break;
    __builtin_amdgcn_s_sleep(1);
    if ((++sp & 255u) == 0u) { if (xb_ld(&bar[XB_TMO])) break; if (sp > XB_SPIN_CAP) { atomicAdd(&bar[XB_TMO], 1u); break; } }
  }
  nloc = mine > 0u ? mine : 1u; nx = cnt > 0u ? cnt : 1u;
}
__device__ __forceinline__ void xcd_barrier(const XcdBarrier& b) {
  asm volatile("s_waitcnt vmcnt(0)" ::: "memory");
  __syncthreads();
  if (threadIdx.x == 0) {
    unsigned* bar = b.bar;
    __builtin_amdgcn_s_waitcnt(0);
    unsigned nloc = b.st[0], nx = b.st[1];
    if (nloc == 0u) { xcd_barrier_complete(bar, b.x, nloc, nx); b.st[0] = nloc; b.st[1] = nx; }
    const unsigned old = xb_add(&bar[XB_XSUB(b.x)], 1u);
    const unsigned gen = old / nloc;
    if (old + 1u == (gen + 1u) * nloc) {
      __builtin_amdgcn_fence(__ATOMIC_RELEASE, "agent");
      asm volatile("s_waitcnt vmcnt(0)" ::: "memory");
      const unsigned og = xb_add(&bar[XB_TOP], 1u);
      const unsigned tg = og / nx;
      if (og + 1u == (tg + 1u) * nx) xb_add(&bar[XB_TOPGEN], 1u);
      else XB_SPIN(xb_ld(&bar[XB_TOPGEN]) == tg, bar);
      __builtin_amdgcn_fence(__ATOMIC_ACQUIRE, "agent");
      xb_add(&bar[XB_XGEN(b.x)], 1u);
      asm volatile("s_waitcnt vmcnt(0)" ::: "memory");
    } else {
      XB_SPIN(xb_ld(&bar[XB_XGEN(b.x)]) == gen, bar);
      __builtin_amdgcn_fence(__ATOMIC_ACQUIRE, "agent");
      asm volatile("s_waitcnt vmcnt(0)" ::: "memory");
    }
  }
  __syncthreads();
}

#define GSYNC() xcd_barrier(xb)
__global__ void __launch_bounds__(256, 2) mega_kernel(Params p_in) {
  __shared__ __attribute__((aligned(16))) unsigned char smem[SMEM_BYTES];
  const Params& p = *(const Params*)__builtin_amdgcn_kernarg_segment_ptr();
  __shared__ uint4 xb_words;
  if (threadIdx.x == 0) xb_words = make_uint4(0u, 0u, 0u, 0u);
  __syncthreads();
  XcdBarrier xb = xcd_barrier_post((unsigned*)(p.ws + WS_BAR), (volatile LAS unsigned*)&xb_words);
  run_stage<-1>(p, 0, smem);
  if (p.out == nullptr) cg::this_grid().sync();
  GSYNC();
#define LAYER(L, LAST)                 \
  run_stage<0>(p, L, smem); GSYNC();   \
  run_stage<1>(p, L, smem); GSYNC();   \
  run_stage<2>(p, L, smem); GSYNC();   \
  run_stage<3>(p, L, smem); GSYNC();   \
  run_stage<4>(p, L, smem); GSYNC();   \
  run_stage<5>(p, L, smem); GSYNC();   \
  run_stage<6>(p, L, smem); GSYNC();   \
  run_stage<7>(p, L, smem); GSYNC();   \
  run_stage<8>(p, L, smem);            \
  if (!LAST) GSYNC();
  int l0 = 0, l1 = 1;
  asm volatile("" : "+s"(l0));
  asm volatile("" : "+s"(l1));
  LAYER(l0, 0)
  LAYER(l1, 1)
}

extern "C" void kernel_launch(void* const* d_in, const int* in_sizes, int n_in, void* d_out, int out_size, void* d_ws,
                              size_t ws_size, hipStream_t stream) {
  if (ws_size < WS_END || n_in < 29) { fprintf(stderr, "workspace too small / bad inputs\n"); return; }
  Params p{};
  const float** f = (const float**)&p;
  for (int i = 0; i < 29; ++i) f[i] = (const float*)d_in[i];
  p.out = (float*)d_out;
  p.ws = (unsigned char*)d_ws;
  static int grid_blocks = 0;
  if (!grid_blocks) {
    int dev = 0, cus = 0, per_cu = 0;
    (void)hipGetDevice(&dev);
    (void)hipDeviceGetAttribute(&cus, hipDeviceAttributeMultiprocessorCount, dev);
    (void)hipOccupancyMaxActiveBlocksPerMultiprocessor(&per_cu, mega_kernel, 256, 0);
    if (per_cu < 1) per_cu = 1;
    if (per_cu > 2) per_cu = 2;
    grid_blocks = cus * per_cu;
  }
  (void)hipMemsetAsync((unsigned char*)d_ws + WS_BAR, 0, 16384, stream);
  void* args[] = {&p};
  hipError_t e = hipLaunchCooperativeKernel((void*)mega_kernel, dim3(grid_blocks), dim3(256), args, 0, stream);
  if (e != hipSuccess) fprintf(stderr, "cooperative launch failed: %s (grid %d)\n", hipGetErrorString(e), grid_blocks);
}
```

```cpp
#include <hip/hip_runtime.h>
#include <hip/hip_cooperative_groups.h>
#include <cstdio>
namespace cg = cooperative_groups;

typedef unsigned short bf16;
typedef short bf16x8 __attribute__((ext_vector_type(8)));
typedef float f32x4 __attribute__((ext_vector_type(4)));
typedef unsigned u32x4 __attribute__((ext_vector_type(4)));
#define LDSP __attribute__((address_space(3)))

#ifndef SINGLE_LAUNCH
#define SINGLE_LAUNCH 0
#endif

constexpr int D = 1024, TP = 16384, TS = 1024, TT = TP + TS, SEQ = 4096;
constexpr int ZIN = 8456, NWIN = 8576;
constexpr int OFF_AV = 512, OFF_AG = 1024, OFF_BQ = 1536, OFF_BK = 2048, OFF_BV = 2176, OFF_BG = 2304, OFF_MG = 5384;
constexpr int ZAB = 2816;
constexpr int ZC = 2688;
constexpr int C_QK = 0, C_V = 1024, C_I = 1536, C_F = 1540, C_O = 1544, C_G = 2056;
constexpr float EPS = 1e-6f;
constexpr int NMOD = 132;
constexpr int SMEM_BYTES = 73728;

constexpr size_t O_Y = 0;
constexpr size_t O_SKP = (size_t)TT * D;
constexpr size_t O_SVP = O_SKP + 2 * 4 * 128 * 128;
constexpr size_t O_CVP = O_SVP + 2 * 4 * 128 * 128;
constexpr size_t O_CP = O_CVP + 2 * 4 * 3 * 1024;
constexpr size_t O_NP = O_CP + (size_t)2 * 4 * 4 * 128 * 128;
constexpr size_t O_MP = O_NP + 2 * 4 * 4 * 128;
constexpr size_t O_SKS = O_MP + 2 * 4 * 4;
constexpr size_t O_SVS = O_SKS + (size_t)2 * 128 * 128 * 128;
constexpr size_t O_CVS = O_SVS + (size_t)2 * 128 * 128 * 128;
constexpr size_t O_CS = O_CVS + (size_t)2 * 128 * 3 * 1024;
constexpr size_t O_NS = O_CS + (size_t)2 * 128 * 4 * 128 * 128;
constexpr size_t O_MS = O_NS + (size_t)2 * 128 * 4 * 128;
constexpr size_t O_GV = O_MS + 2 * 128 * 4;
constexpr size_t O_END = O_GV + (size_t)2 * 128 * 8 * 512;

constexpr size_t WS_WIN = 0;
constexpr size_t WS_WBR = WS_WIN + (size_t)2 * NWIN * 1024 * 2;
constexpr size_t WS_WOUT = WS_WBR + (size_t)2 * 1024 * 1536 * 2;
constexpr size_t WS_MOD = WS_WOUT + (size_t)2 * 1024 * 1024 * 2;
constexpr size_t WS_H = WS_MOD + (size_t)2 * NMOD * 3072 * 4;
constexpr size_t WS_YAB = WS_H + (size_t)TT * 1024 * 2;
constexpr size_t WS_U = WS_YAB + (size_t)TT * 1024 * 2;
constexpr size_t WS_UN = WS_U + (size_t)TT * 1024 * 2;
constexpr size_t WS_G = WS_UN + (size_t)1024 * 128 * 4;
constexpr size_t WS_TOT = WS_G + 4096;
constexpr size_t WS_M = WS_TOT + 4096;
constexpr size_t WS_Z = WS_M + 4096;
constexpr size_t WS_BAR = WS_Z + (size_t)TT * ZAB * 2;
constexpr size_t WS_H8 = WS_BAR + 16384;
constexpr int W8_ROW0 = 0, W8_ROWS = NWIN;
constexpr size_t WS_W8 = WS_H8 + (size_t)TT * 1024;
constexpr size_t WS_END = WS_W8 + (size_t)2 * W8_ROWS * 1024;

struct Params {
  const float *x_prompt, *x_sample, *cache_k, *cache_v, *st_conv, *st_C, *st_n, *st_m, *c_prompt, *c_sample;
  const float *ada_w, *ada_b, *norm_g, *w_in, *b_in, *vnorm_g, *gmlp_ws, *gmlp_bs, *qn_g, *kn_g, *sinks;
  const float *conv_w, *conv_b, *f_bias, *hnorm_g, *w_a, *w_b, *w_c, *w_out;
  float* out;
  unsigned char* ws;
};

__device__ __forceinline__ int tidx() { int t = threadIdx.x; asm volatile("" : "+v"(t)); return t; }
__device__ __forceinline__ bf16 f2bf(float f) {
  unsigned u = __float_as_uint(f);
  u += 0x7fffu + ((u >> 16) & 1u);
  return (bf16)(u >> 16);
}
__device__ __forceinline__ float bf2f(bf16 h) { return __uint_as_float(((unsigned)h) << 16); }
__device__ __forceinline__ unsigned pack2(float a, float b) { return (unsigned)f2bf(a) | ((unsigned)f2bf(b) << 16); }
__device__ __forceinline__ float lo2f(unsigned u) { return __uint_as_float(u << 16); }
__device__ __forceinline__ float hi2f(unsigned u) { return __uint_as_float(u & 0xffff0000u); }
__device__ __forceinline__ void unpack8(const uint4& v, float* f) {
  f[0] = lo2f(v.x); f[1] = hi2f(v.x); f[2] = lo2f(v.y); f[3] = hi2f(v.y);
  f[4] = lo2f(v.z); f[5] = hi2f(v.z); f[6] = lo2f(v.w); f[7] = hi2f(v.w);
}
__device__ __forceinline__ void unpack4(const uint2& v, float* f) {
  f[0] = lo2f(v.x); f[1] = hi2f(v.x); f[2] = lo2f(v.y); f[3] = hi2f(v.y);
}
__device__ __forceinline__ float sigmoidf_(float x) { return __builtin_amdgcn_rcpf(1.0f + __expf(-x)); }
__device__ __forceinline__ float siluf_(float x) { return x * __builtin_amdgcn_rcpf(1.0f + __expf(-x)); }
__device__ __forceinline__ float logsigmoidf_(float x) { return fminf(x, 0.0f) - log1pf(__expf(-fabsf(x))); }
__device__ __forceinline__ float wave_sum(float v) {
#pragma unroll
  for (int o = 32; o >= 1; o >>= 1) v += __shfl_xor(v, o);
  return v;
}
__device__ __forceinline__ float wave_max(float v) {
#pragma unroll
  for (int o = 32; o >= 1; o >>= 1) v = fmaxf(v, __shfl_xor(v, o));
  return v;
}
__device__ __forceinline__ f32x4 mfma16(bf16x8 a, bf16x8 b, f32x4 c) {
  return __builtin_amdgcn_mfma_f32_16x16x32_bf16(a, b, c, 0, 0, 0);
}
template <int MI, int NI>
__device__ __forceinline__ void mma_lds(f32x4 (&acc)[MI][NI], const bf16* sA, int lda, const bf16* sB, int ldb, int K, int lane) {
  const int r = lane & 15, q = (lane >> 4) * 8;
  for (int k0 = 0; k0 < K; k0 += 32) {
    bf16x8 a[MI], b[NI];
#pragma unroll
    for (int i = 0; i < MI; ++i) a[i] = *(const bf16x8*)(sA + (i * 16 + r) * lda + k0 + q);
#pragma unroll
    for (int j = 0; j < NI; ++j) b[j] = *(const bf16x8*)(sB + (j * 16 + r) * ldb + k0 + q);
#pragma unroll
    for (int i = 0; i < MI; ++i)
#pragma unroll
      for (int j = 0; j < NI; ++j) acc[i][j] = mfma16(b[j], a[i], acc[i][j]);
  }
}

constexpr int GLD = 64;
constexpr int GTILE = 128 * GLD;
template <int NI>
__device__ __forceinline__ void g_load(u32x4 (&ra)[4], u32x4 (&rb)[NI], const bf16* __restrict__ A, int lda, const bf16* __restrict__ B, int ldb, int ko, int tid) {
  const unsigned offA = (unsigned)((tid >> 3) * lda + (tid & 7) * 8), offB = (unsigned)((tid >> 3) * ldb + (tid & 7) * 8);
#pragma unroll
  for (int i = 0; i < 4; ++i) {
    const bf16* Ai = A + (size_t)(i * 32) * lda + ko;
    ra[i] = *(const u32x4*)(Ai + offA);
  }
#pragma unroll
  for (int i = 0; i < NI; ++i) {
    const bf16* Bi = B + (size_t)(i * 32) * ldb + ko;
    rb[i] = *(const u32x4*)(Bi + offB);
  }
}
template <int NI>
__device__ __forceinline__ void g_store(const u32x4 (&ra)[4], const u32x4 (&rb)[NI], bf16* buf, int tid) {
  const int off = (tid >> 3) * GLD + (((tid & 7) ^ ((tid >> 3) & 7)) * 8);
#pragma unroll
  for (int i = 0; i < 4; ++i) *(u32x4*)(buf + off + i * 32 * GLD) = ra[i];
#pragma unroll
  for (int i = 0; i < NI; ++i) *(u32x4*)(buf + GTILE + off + i * 32 * GLD) = rb[i];
}
template <int NI, bool LOWREG = false>
__device__ __forceinline__ void g_compute(f32x4 (&acc)[4][NI], const bf16* cur, int wr, int wc, int lane) {
  const int r16 = lane & 15, sw = lane & 7, q = lane >> 4;
#pragma unroll
  for (int ks = 0; ks < 2; ++ks) {
    const int pc = ((ks * 4 + q) ^ sw) * 8;
    bf16x8 a[4];
#pragma unroll
    for (int i = 0; i < 4; ++i) a[i] = *(const bf16x8*)(cur + (wr * 64 + i * 16 + r16) * GLD + pc);
#pragma unroll
    for (int jh = 0; jh < NI; jh += 2) {
      bf16x8 b[2];
#pragma unroll
      for (int j = 0; j < 2; ++j) b[j] = *(const bf16x8*)(cur + GTILE + (wc * 16 * NI + (jh + j) * 16 + r16) * GLD + pc);
#pragma unroll
      for (int i = 0; i < 4; ++i)
#pragma unroll
        for (int j = 0; j < 2; ++j) acc[i][jh + j] = mfma16(b[j], a[i], acc[i][jh + j]);
      if (LOWREG) __builtin_amdgcn_sched_barrier(0);
    }
  }
}
template <int NI>
__device__ __forceinline__ void g_stage(const bf16* __restrict__ A, int lda, const bf16* __restrict__ B, int ldb, int ko, bf16* buf, int tid) {
  const int wave = tid >> 6;
  const int gch = ((tid & 7) ^ ((tid >> 3) & 7)) * 8;
  const unsigned offA = (unsigned)((tid >> 3) * lda + gch), offB = (unsigned)((tid >> 3) * ldb + gch);
#pragma unroll
  for (int i = 0; i < 4; ++i) {
    const bf16* Ai = A + (size_t)(i * 32) * lda + ko;
    __builtin_amdgcn_global_load_lds((const unsigned*)(Ai + offA), (LDSP unsigned*)(buf + (i * 32 + wave * 8) * GLD), 16, 0, 0);
  }
#pragma unroll
  for (int i = 0; i < NI; ++i) {
    const bf16* Bi = B + (size_t)(i * 32) * ldb + ko;
    __builtin_amdgcn_global_load_lds((const unsigned*)(Bi + offB), (LDSP unsigned*)(buf + GTILE + (i * 32 + wave * 8) * GLD), 16, 0, 0);
  }
}
template <int NI, bool LOWREG = false>
__device__ __forceinline__ void gemm_accum(f32x4 (&acc)[4][NI], const bf16* __restrict__ A, int lda,
                                           const bf16* __restrict__ B, int ldb, int K, bf16* sm) {
  const int tid = tidx(), lane = tid & 63, wave = tid >> 6, wr = wave >> 1, wc = wave & 1;
  const int nk = K >> 6;
  bf16* buf0 = sm;
  bf16* buf1 = sm + 2 * GTILE;
  g_stage<NI>(A, lda, B, ldb, 0, buf0, tid);
  asm volatile("s_waitcnt vmcnt(0)" ::: "memory");
  __syncthreads();
#pragma unroll 1
  for (int kt = 0; kt < nk; kt += 2) {
    g_stage<NI>(A, lda, B, ldb, (kt + 1) * 64, buf1, tid);
    g_compute<NI, LOWREG>(acc, buf0, wr, wc, lane);
    asm volatile("s_waitcnt vmcnt(0)" ::: "memory");
    __syncthreads();
    if (kt + 2 < nk) g_stage<NI>(A, lda, B, ldb, (kt + 2) * 64, buf0, tid);
    g_compute<NI, LOWREG>(acc, buf1, wr, wc, lane);
    asm volatile("s_waitcnt vmcnt(0)" ::: "memory");
    __syncthreads();
  }
}
typedef int i32x8 __attribute__((ext_vector_type(8)));
template <int NI>
__device__ __forceinline__ void g_compute_f8(f32x4 (&acc)[4][NI], const bf16* cur, int wr, int wc, int lane) {
  const int r16 = lane & 15, sw = lane & 7, q = lane >> 4;
  const int pc0 = ((2 * q) ^ sw) * 8, pc1 = ((2 * q + 1) ^ sw) * 8;
  i32x8 b[NI];
#pragma unroll
  for (int j = 0; j < NI; ++j) {
    const bf16* rp = cur + GTILE + (wc * 16 * NI + j * 16 + r16) * GLD;
    const u32x4 lo = *(const u32x4*)(rp + pc0), hi = *(const u32x4*)(rp + pc1);
    b[j] = (i32x8){(int)lo.x, (int)lo.y, (int)lo.z, (int)lo.w, (int)hi.x, (int)hi.y, (int)hi.z, (int)hi.w};
  }
#pragma unroll
  for (int i = 0; i < 4; ++i) {
    const bf16* rp = cur + (wr * 64 + i * 16 + r16) * GLD;
    const u32x4 lo = *(const u32x4*)(rp + pc0), hi = *(const u32x4*)(rp + pc1);
    const i32x8 a = (i32x8){(int)lo.x, (int)lo.y, (int)lo.z, (int)lo.w, (int)hi.x, (int)hi.y, (int)hi.z, (int)hi.w};
#pragma unroll
    for (int j = 0; j < NI; ++j)
      acc[i][j] = __builtin_amdgcn_mfma_scale_f32_16x16x128_f8f6f4(b[j], a, acc[i][j], 0, 0, 0, 0x7F7F7F7F, 0, 0x7F7F7F7F);
  }
}
template <int NI>
__device__ __forceinline__ void gemm_accum_f8(f32x4 (&acc)[4][NI], const unsigned char* __restrict__ A8, const unsigned char* __restrict__ B8, bf16* sm) {
  const int tid = tidx(), lane = tid & 63, wave = tid >> 6, wr = wave >> 1, wc = wave & 1;
  const bf16* A = (const bf16*)A8;
  const bf16* B = (const bf16*)B8;
  bf16* buf0 = sm;
  bf16* buf1 = sm + 2 * GTILE;
  g_stage<NI>(A, 512, B, 512, 0, buf0, tid);
  asm volatile("s_waitcnt vmcnt(0)" ::: "memory");
  __syncthreads();
#pragma unroll 1
  for (int kt = 0; kt < 8; kt += 2) {
    g_stage<NI>(A, 512, B, 512, (kt + 1) * 64, buf1, tid);
    g_compute_f8<NI>(acc, buf0, wr, wc, lane);
    asm volatile("s_waitcnt vmcnt(0)" ::: "memory");
    __syncthreads();
    if (kt + 2 < 8) g_stage<NI>(A, 512, B, 512, (kt + 2) * 64, buf0, tid);
    g_compute_f8<NI>(acc, buf1, wr, wc, lane);
    asm volatile("s_waitcnt vmcnt(0)" ::: "memory");
    __syncthreads();
  }
}
template <int NI>
__device__ __forceinline__ void zero_acc(f32x4 (&acc)[4][NI]) {
#pragma unroll
  for (int i = 0; i < 4; ++i)
#pragma unroll
    for (int j = 0; j < NI; ++j) acc[i][j] = (f32x4){0.f, 0.f, 0.f, 0.f};
}
__device__ __forceinline__ void tile_map(int t, int ntn, int& pm, int& pn) {
  const int grp = t / (8 * ntn), w = t % (8 * ntn);
  pm = grp * 8 + (w & 7);
  pn = w >> 3;
}

__device__ __forceinline__ void transpose_tile(const float* __restrict__ src, int ld_src, int n_valid, bf16* __restrict__ dst, int ld_dst,
                               int k0, int n0, int kdst0, float* sm, unsigned char* dst8 = nullptr) {
  const int tid = tidx();
  for (int i = tid; i < 64 * 16; i += 256) {
    const int kk = i >> 4, n4 = (i & 15) * 4, n = n0 + n4;
    float4 v = make_float4(0.f, 0.f, 0.f, 0.f);
    if (n + 3 < n_valid) v = *(const float4*)(src + (size_t)(k0 + kk) * ld_src + n);
    sm[kk * 65 + n4 + 0] = v.x; sm[kk * 65 + n4 + 1] = v.y; sm[kk * 65 + n4 + 2] = v.z; sm[kk * 65 + n4 + 3] = v.w;
  }
  __syncthreads();
  for (int i = tid; i < 64 * 8; i += 256) {
    const int nn = i >> 3, kc = (i & 7) * 8;
    uint4 o;
    o.x = pack2(sm[(kc + 0) * 65 + nn], sm[(kc + 1) * 65 + nn]);
    o.y = pack2(sm[(kc + 2) * 65 + nn], sm[(kc + 3) * 65 + nn]);
    o.z = pack2(sm[(kc + 4) * 65 + nn], sm[(kc + 5) * 65 + nn]);
    o.w = pack2(sm[(kc + 6) * 65 + nn], sm[(kc + 7) * 65 + nn]);
    *(uint4*)(dst + (size_t)(n0 + nn) * ld_dst + kdst0 + kc) = o;
    if (dst8 != nullptr) {
      uint2 q8;
      int t8 = __builtin_amdgcn_cvt_pk_fp8_f32(64.f * sm[(kc + 0) * 65 + nn], 64.f * sm[(kc + 1) * 65 + nn], 0, false);
      q8.x = (unsigned)__builtin_amdgcn_cvt_pk_fp8_f32(64.f * sm[(kc + 2) * 65 + nn], 64.f * sm[(kc + 3) * 65 + nn], t8, true);
      t8 = __builtin_amdgcn_cvt_pk_fp8_f32(64.f * sm[(kc + 4) * 65 + nn], 64.f * sm[(kc + 5) * 65 + nn], 0, false);
      q8.y = (unsigned)__builtin_amdgcn_cvt_pk_fp8_f32(64.f * sm[(kc + 6) * 65 + nn], 64.f * sm[(kc + 7) * 65 + nn], t8, true);
      *(uint2*)(dst8 + (size_t)(n0 + nn - W8_ROW0) * 1024 + kdst0 + kc) = q8;
    }
  }
  __syncthreads();
}

__device__ __forceinline__ void ada_item(const Params& p, int item, float* sm) {
  const int l = item / 192, n0 = (item % 192) * 16;
  const int tid = tidx(), col = tid & 15, rg = tid >> 4;
  constexpr int SLD = 68;
  float* sW = sm + 144 * SLD;
  float acc[9];
#pragma unroll
  for (int j = 0; j < 9; ++j) acc[j] = 0.f;
  const float* W = p.ada_w + (size_t)l * 1024 * 3072 + n0;
  const int wk = tid >> 2, wc4 = (tid & 3) * 4;
  float v[36];
  float4 w0;
#define ADA_LOAD(K0)                                                                                      \
  {                                                                                                       \
    _Pragma("unroll") for (int u = 0; u < 36; ++u) {                                                      \
      const int i = tid + 256 * u, r = i >> 6, kk = i & 63;                                               \
      v[u] = 0.f;                                                                                         \
      if (r < NMOD) v[u] = (r < 4) ? p.c_prompt[r * 1024 + (K0) + kk] : p.c_sample[(r - 4) * 1024 + (K0) + kk]; \
    }                                                                                                     \
    w0 = *(const float4*)(W + (size_t)((K0) + wk) * 3072 + wc4);                                          \
  }
#define ADA_STORE()                                                                                       \
  {                                                                                                       \
    _Pragma("unroll") for (int u = 0; u < 36; ++u) {                                                      \
      const int i = tid + 256 * u, r = i >> 6, kk = i & 63;                                               \
      sm[r * SLD + kk] = siluf_(v[u]);                                                                    \
    }                                                                                                     \
    *(float4*)(sW + wk * 16 + wc4) = w0;                                                                  \
  }
  ADA_LOAD(0)
  ADA_STORE()
  __syncthreads();
#pragma unroll 1
  for (int k0 = 0; k0 < 1024; k0 += 64) {
    if (k0 + 64 < 1024) ADA_LOAD(k0 + 64)
#pragma unroll 4
    for (int k4 = 0; k4 < 16; ++k4) {
      const float x0 = sW[(k4 * 4 + 0) * 16 + col], x1 = sW[(k4 * 4 + 1) * 16 + col];
      const float x2 = sW[(k4 * 4 + 2) * 16 + col], x3 = sW[(k4 * 4 + 3) * 16 + col];
#pragma unroll
      for (int j = 0; j < 9; ++j) {
        const float4 sv = *(const float4*)(sm + (rg * 9 + j) * SLD + k4 * 4);
        acc[j] += sv.x * x0 + sv.y * x1 + sv.z * x2 + sv.w * x3;
      }
    }
    __syncthreads();
    if (k0 + 64 < 1024) ADA_STORE()
    __syncthreads();
  }
#undef ADA_LOAD
#undef ADA_STORE
  float* mod = (float*)(p.ws + WS_MOD);
  const float b = p.ada_b[l * 3072 + n0 + col];
#pragma unroll
  for (int j = 0; j < 9; ++j) {
    const int r = rg * 9 + j;
    if (r < NMOD) mod[((size_t)l * NMOD + r) * 3072 + n0 + col] = acc[j] + b;
  }
}

__device__ __forceinline__ void phase_prep(const Params& p, unsigned char* smem) {
  float* sm = (float*)smem;
  constexpr int N_WIN = 2 * 16 * (NWIN / 64);
  constexpr int N_WBR = 2 * 3 * 8 * 16;
  constexpr int N_WOUT = 2 * 16 * 16;
  constexpr int N_ALL = N_WIN + N_WBR + N_WOUT;
  bf16* WinT = (bf16*)(p.ws + WS_WIN);
  bf16* WbrT = (bf16*)(p.ws + WS_WBR);
  bf16* WoutT = (bf16*)(p.ws + WS_WOUT);
  constexpr int N_ADA = 384;
  for (int it = blockIdx.x; it < N_ADA + N_ALL; it += gridDim.x) {
    if (it < N_ADA) { ada_item(p, it, sm); continue; }
    int i = it - N_ADA;
    if (i < N_WIN) {
      const int l = i / (16 * 134), r = i % (16 * 134), kt = r / 134, nt = r % 134;
      transpose_tile(p.w_in + (size_t)l * 1024 * ZIN, ZIN, ZIN, WinT + (size_t)l * NWIN * 1024, 1024, kt * 64, nt * 64, kt * 64, sm,
                     (nt * 64 >= W8_ROW0) ? p.ws + WS_W8 + (size_t)l * W8_ROWS * 1024 : nullptr);
      continue;
    }
    i -= N_WIN;
    if (i < N_WBR) {
      const int l = i / 384, r = i % 384, seg = r / 128, r2 = r % 128, kt = r2 / 16, nt = r2 % 16;
      const float* src = (seg == 0 ? p.w_a : seg == 1 ? p.w_b : p.w_c) + (size_t)l * 512 * 1024;
      transpose_tile(src, 1024, 1024, WbrT + (size_t)l * 1024 * 1536, 1536, kt * 64, nt * 64, seg * 512 + kt * 64, sm);
      continue;
    }
    i -= N_WBR;
    {
      const int l = i / 256, r = i % 256, kt = r / 16, nt = r % 16;
      transpose_tile(p.w_out + (size_t)l * 1024 * 1024, 1024, 1024, WoutT + (size_t)l * 1024 * 1024, 1024, kt * 64, nt * 64, kt * 64, sm);
    }
  }
}

__device__ __forceinline__ const float* xrow_ptr(const Params& p, int l, int row) {
  if (l == 0) return row < TP ? p.x_prompt + (size_t)row * D : p.x_sample + (size_t)(row - TP) * D;
  return p.out + (size_t)row * D;
}
__device__ __forceinline__ int mod_row(int row) { return row < TP ? (row >> 12) : 4 + ((row - TP) >> 3); }

__device__ __forceinline__ void phase_norm(const Params& p, int l) {
  const int lane = tidx() & 63, wave = tidx() >> 6;
  bf16* hbuf = (bf16*)(p.ws + WS_H);
  unsigned char* h8 = p.ws + WS_H8;
  const float* mod = (const float*)(p.ws + WS_MOD);
  const float* g = p.norm_g + l * D;
  for (int row = blockIdx.x * 4 + wave; row < TT; row += gridDim.x * 4) {
    const float4* x = (const float4*)xrow_ptr(p, l, row);
    float4 v[4];
    float ss = 0.f;
#pragma unroll
    for (int i = 0; i < 4; ++i) {
      v[i] = x[lane + 64 * i];
      ss += v[i].x * v[i].x + v[i].y * v[i].y + v[i].z * v[i].z + v[i].w * v[i].w;
    }
    ss = wave_sum(ss);
    const float rstd = rsqrtf(ss * (1.0f / D) + EPS);
    const float* mp = mod + ((size_t)l * NMOD + mod_row(row)) * 3072;
#pragma unroll
    for (int i = 0; i < 4; ++i) {
      const int c = (lane + 64 * i) * 4;
      const float4 gg = *(const float4*)(g + c), sh = *(const float4*)(mp + c), sc = *(const float4*)(mp + 1024 + c);
      uint2 o;
      o.x = pack2(v[i].x * rstd * gg.x * (1.f + sc.x) + sh.x, v[i].y * rstd * gg.y * (1.f + sc.y) + sh.y);
      o.y = pack2(v[i].z * rstd * gg.z * (1.f + sc.z) + sh.z, v[i].w * rstd * gg.w * (1.f + sc.w) + sh.w);
      *(uint2*)(hbuf + (size_t)row * D + c) = o;
      int p8 = __builtin_amdgcn_cvt_pk_fp8_f32(v[i].x * rstd * gg.x * (1.f + sc.x) + sh.x, v[i].y * rstd * gg.y * (1.f + sc.y) + sh.y, 0, false);
      p8 = __builtin_amdgcn_cvt_pk_fp8_f32(v[i].z * rstd * gg.z * (1.f + sc.z) + sh.z, v[i].w * rstd * gg.w * (1.f + sc.w) + sh.w, p8, true);
      *(int*)(h8 + (size_t)row * D + c) = p8;
    }
  }
}

__device__ __forceinline__ void phase_gemm_in(const Params& p, int l, int col0, int ntn, int ldz, unsigned char* smem) {
  bf16* sm = (bf16*)smem;
  const bf16* hbuf = (const bf16*)(p.ws + WS_H);
  const bf16* W = (const bf16*)(p.ws + WS_WIN) + (size_t)l * NWIN * 1024;
  bf16* z = (bf16*)(p.ws + WS_Z);
  const float* bias = p.b_in + (size_t)l * ZIN;
  const int tid = tidx(), lane = tid & 63, wave = tid >> 6, wr = wave >> 1, wc = wave & 1;
  const int ntiles = (TT / 128) * ntn;
  constexpr int OLD = 136;
  const bool isAB = (col0 == 0);
  const int nb = isAB ? 6 : 13;
  const int NB = (TT / 128) * nb;
  for (int t = blockIdx.x; t < ntiles; t += gridDim.x) {
    const bool f8 = t >= NB;
    int pm, pk;
    tile_map(f8 ? t - NB : t, f8 ? ntn - nb : nb, pm, pk);
    int pn;
    if (isAB) pn = f8 ? (pk < 4 ? pk : pk < 12 ? pk + 4 : pk + 6) : (pk < 4 ? 4 + pk : 12 + pk);
    else pn = f8 ? 13 + pk : pk;
    const int m0 = pm * 128, n0 = pn * 128;
    f32x4 acc[4][4];
    zero_acc<4>(acc);
    float osc = 1.0f;
    if (f8) {
      gemm_accum_f8<4>(acc, p.ws + WS_H8 + (size_t)m0 * 1024, p.ws + WS_W8 + ((size_t)l * W8_ROWS + col0 + n0) * 1024, sm);
      osc = 0.015625f;
    } else {
      gemm_accum<4>(acc, hbuf + (size_t)m0 * 1024, 1024, W + (size_t)(col0 + n0) * 1024, 1024, 1024, sm);
    }
#pragma unroll
    for (int j = 0; j < 4; ++j) {
      const int cl = wc * 64 + j * 16 + (lane >> 4) * 4;
      const float4 b = *(const float4*)(bias + col0 + n0 + cl);
#pragma unroll
      for (int i = 0; i < 4; ++i) {
        const int rl = wr * 64 + i * 16 + (lane & 15);
        uint2 o;
        o.x = pack2(acc[i][j][0] * osc + b.x, acc[i][j][1] * osc + b.y);
        o.y = pack2(acc[i][j][2] * osc + b.z, acc[i][j][3] * osc + b.w);
        *(uint2*)(sm + rl * OLD + cl) = o;
      }
    }
    __syncthreads();
#pragma unroll
    for (int it = 0; it < 8; ++it) {
      const int id = tid + 256 * it, row = id >> 4, ch = id & 15;
      const u32x4 v = *(const u32x4*)(sm + row * OLD + ch * 8);
      *(u32x4*)(z + (size_t)(m0 + row) * ldz + n0 + ch * 8) = v;
    }
    __syncthreads();
  }
}

__device__ __forceinline__ void gmlp_prompt_item(const Params& p, int l, int item, unsigned char* smem) {
  const int b = item >> 7, n = (item >> 2) & 31, g = item & 3;
  const int r0 = b * SEQ + n * 128;
  const bf16* z = (const bf16*)(p.ws + WS_Z);
  bf16* yab = (bf16*)(p.ws + WS_YAB);
  bf16* sW = (bf16*)smem;
  bf16* sV = (bf16*)(smem + 34816);
  float* srstd = (float*)(smem + 69632);
  const int tid = tidx(), lane = tid & 63, wave = tid >> 6, wr = wave >> 1, wc = wave & 1;
  {
    const int tok = tid >> 1, half = tid & 1;
    const uint4* ptr = (const uint4*)(z + (size_t)(r0 + tok) * ZAB + OFF_AV + half * 256);
    float ss = 0.f;
    for (int i = 0; i < 32; ++i) {
      float f[8];
      unpack8(ptr[i], f);
#pragma unroll
      for (int j = 0; j < 8; ++j) ss += f[j] * f[j];
    }
    ss += __shfl_xor(ss, 1);
    if (half == 0) srstd[tok] = rsqrtf(ss * (1.0f / 512.f) + EPS);
  }
  __syncthreads();
  const float* vg = p.vnorm_g + l * 512 + g * 128;
  for (int i = tid; i < 2048; i += 256) {
    const int s = i >> 4, c8 = (i & 15) * 8;
    float f[8];
    unpack8(*(const uint4*)(z + (size_t)(r0 + s) * ZAB + OFF_AV + g * 128 + c8), f);
    const float rs = srstd[s];
#pragma unroll
    for (int j = 0; j < 8; ++j) sV[(c8 + j) * 136 + s] = f2bf(f[j] * rs * vg[c8 + j]);
  }
  const float* Wg = p.gmlp_ws + ((size_t)(l * 4 + g)) * 128 * 128;
  for (int i = tid; i < 4096; i += 256) {
    const int t = i >> 5, s4 = (i & 31) * 4;
    const float4 w = *(const float4*)(Wg + t * 128 + s4);
    uint2 o;
    o.x = pack2(s4 + 0 <= t ? w.x : 0.f, s4 + 1 <= t ? w.y : 0.f);
    o.y = pack2(s4 + 2 <= t ? w.z : 0.f, s4 + 3 <= t ? w.w : 0.f);
    *(uint2*)(sW + t * 136 + s4) = o;
  }
  __syncthreads();
  f32x4 acc[4][4];
  zero_acc<4>(acc);
  mma_lds<4, 4>(acc, sW + wr * 64 * 136, 136, sV + wc * 64 * 136, 136, wr * 64 + 64, lane);
  const float* bs = p.gmlp_bs + (l * 4 + g) * 128;
#pragma unroll
  for (int i = 0; i < 4; ++i) {
    const int t = wr * 64 + i * 16 + (lane & 15);
    const float bst = bs[t];
    const size_t rowoff = (size_t)(r0 + t) * ZAB;
#pragma unroll
    for (int j = 0; j < 4; ++j) {
      const int c = g * 128 + wc * 64 + j * 16 + (lane >> 4) * 4;
      float u[4], ag[4];
      unpack4(*(const uint2*)(z + rowoff + c), u);
      unpack4(*(const uint2*)(z + rowoff + OFF_AG + c), ag);
      uint2 o;
      o.x = pack2(u[0] * (acc[i][j][0] + bst) * siluf_(ag[0]), u[1] * (acc[i][j][1] + bst) * siluf_(ag[1]));
      o.y = pack2(u[2] * (acc[i][j][2] + bst) * siluf_(ag[2]), u[3] * (acc[i][j][3] + bst) * siluf_(ag[3]));
      *(uint2*)(yab + (size_t)(r0 + t) * 1024 + c) = o;
    }
  }
  __syncthreads();
}

__device__ __forceinline__ void gmlp_sample_item(const Params& p, int l, int b, unsigned char* smem) {
  const int r0 = TP + b * 8;
  const bf16* z = (const bf16*)(p.ws + WS_Z);
  bf16* yab = (bf16*)(p.ws + WS_YAB);
  float* svn = (float*)smem;
  const int tid = tidx(), lane = tid & 63, wave = tid >> 6;
  const float* vg = p.vnorm_g + l * 512;
  for (int tt = 0; tt < 2; ++tt) {
    const int t = wave * 2 + tt;
    float f[8];
    unpack8(*(const uint4*)(z + (size_t)(r0 + t) * ZAB + OFF_AV + lane * 8), f);
    float ss = 0.f;
#pragma unroll
    for (int j = 0; j < 8; ++j) ss += f[j] * f[j];
    ss = wave_sum(ss);
    const float rstd = rsqrtf(ss * (1.0f / 512.f) + EPS);
    float* gv = p.out + O_GV + (((size_t)l * 128 + b) * 8 + t) * 512 + lane * 8;
#pragma unroll
    for (int j = 0; j < 8; ++j) {
      const float vn = f[j] * rstd * vg[lane * 8 + j];
      svn[t * 512 + lane * 8 + j] = vn;
      gv[j] = vn;
    }
  }
  __syncthreads();
  {
    const int c = tid * 2, g = c >> 7;
    const float* Wg = p.gmlp_ws + ((size_t)(l * 4 + g)) * 128 * 128;
    const float* bs = p.gmlp_bs + (l * 4 + g) * 128;
    for (int t = 0; t < 8; ++t) {
      float s0 = bs[t], s1 = bs[t];
      for (int s = 0; s <= t; ++s) {
        const float w = Wg[t * 128 + s];
        s0 += w * svn[s * 512 + c];
        s1 += w * svn[s * 512 + c + 1];
      }
      const unsigned uu = *(const unsigned*)(z + (size_t)(r0 + t) * ZAB + c);
      const unsigned gg = *(const unsigned*)(z + (size_t)(r0 + t) * ZAB + OFF_AG + c);
      *(unsigned*)(yab + (size_t)(r0 + t) * 1024 + c) = pack2(lo2f(uu) * s0 * siluf_(lo2f(gg)), hi2f(uu) * s1 * siluf_(hi2f(gg)));
    }
  }
  __syncthreads();
}

__device__ __forceinline__ void swa_prompt_item(const Params& p, int l, int item, unsigned char* smem) {
  const int b = item >> 7, qt = (item >> 1) & 63, kv = item & 1;
  const int q0 = qt * 64, rb = b * SEQ;
  const bf16* z = (const bf16*)(p.ws + WS_Z);
  bf16* yab = (bf16*)(p.ws + WS_YAB);
  bf16* sK = (bf16*)smem;
  bf16* sVT = (bf16*)(smem + 27648);
  const int tid = tidx(), lane = tid & 63, wave = tid >> 6;
  const float* kg = p.kn_g + l * 64;
  const float* qg = p.qn_g + l * 64;
#pragma unroll 1
  for (int it = 0; it < 6; ++it) {
    const int id = tid + 256 * it, kk = id >> 3, ch = id & 7, kp = q0 - 128 + kk;
    float f[8];
    uint4 vraw = make_uint4(0, 0, 0, 0);
    if (kp >= 0) {
      unpack8(*(const uint4*)(z + (size_t)(rb + kp) * ZAB + OFF_BK + kv * 64 + ch * 8), f);
      vraw = *(const uint4*)(z + (size_t)(rb + kp) * ZAB + OFF_BV + kv * 64 + ch * 8);
    } else {
#pragma unroll
      for (int j = 0; j < 8; ++j) f[j] = 0.f;
    }
    float ss = 0.f;
#pragma unroll
    for (int j = 0; j < 8; ++j) ss += f[j] * f[j];
    ss += __shfl_xor(ss, 1); ss += __shfl_xor(ss, 2); ss += __shfl_xor(ss, 4);
    const float rstd = rsqrtf(ss * (1.0f / 64.f) + EPS);
#pragma unroll
    for (int j = 0; j < 8; ++j) f[j] = f[j] * rstd * kg[ch * 8 + j];
    uint4 ko;
    ko.x = pack2(f[0], f[1]); ko.y = pack2(f[2], f[3]); ko.z = pack2(f[4], f[5]); ko.w = pack2(f[6], f[7]);
    *(uint4*)(sK + kk * 72 + ch * 8) = ko;
    float vf[8];
    unpack8(vraw, vf);
#pragma unroll
    for (int j = 0; j < 8; ++j) sVT[(ch * 8 + j) * 200 + kk] = f2bf(vf[j]);
    if (kk >= 128 && kp >= SEQ - 128) {
      const size_t o = ((((size_t)l * 4 + b) * 128 + (kp - (SEQ - 128))) * 2 + kv) * 64 + ch * 8;
#pragma unroll
      for (int j = 0; j < 8; ++j) { p.out[O_SKP + o + j] = f[j]; p.out[O_SVP + o + j] = vf[j]; }
    }
  }
  __syncthreads();
  const int h = kv * 4 + wave;
  const float sink = p.sinks[l * 8 + h];
  const int g4 = lane >> 4, r16 = lane & 15;
#pragma unroll 1
  for (int i = 0; i < 4; ++i) {
    const int qrow = q0 + i * 16 + r16;
    const size_t grow = (size_t)(rb + qrow);
    bf16x8 qf[2];
    {
      float f0[8], f1[8];
      unpack8(*(const uint4*)(z + grow * ZAB + OFF_BQ + h * 64 + g4 * 8), f0);
      unpack8(*(const uint4*)(z + grow * ZAB + OFF_BQ + h * 64 + 32 + g4 * 8), f1);
      float ss = 0.f;
#pragma unroll
      for (int j = 0; j < 8; ++j) ss += f0[j] * f0[j] + f1[j] * f1[j];
      ss += __shfl_xor(ss, 16); ss += __shfl_xor(ss, 32);
      const float rstd = rsqrtf(ss * (1.0f / 64.f) + EPS) * 0.125f;
#pragma unroll
      for (int j = 0; j < 8; ++j) {
        qf[0][j] = (short)f2bf(f0[j] * rstd * qg[g4 * 8 + j]);
        qf[1][j] = (short)f2bf(f1[j] * rstd * qg[32 + g4 * 8 + j]);
      }
    }
    f32x4 st[12];
#pragma unroll
    for (int kt = 0; kt < 12; ++kt) {
      st[kt] = (f32x4){0.f, 0.f, 0.f, 0.f};
#pragma unroll
      for (int ks = 0; ks < 2; ++ks) {
        const bf16x8 kf = *(const bf16x8*)(sK + (kt * 16 + r16) * 72 + ks * 32 + g4 * 8);
        st[kt] = mfma16(kf, qf[ks], st[kt]);
      }
      if ((kt & 1) == 1) __builtin_amdgcn_sched_barrier(0);
    }
    float mx = -INFINITY;
#pragma unroll
    for (int kt = 0; kt < 12; ++kt)
#pragma unroll
      for (int x = 0; x < 4; ++x) {
        const int kp = q0 - 128 + kt * 16 + g4 * 4 + x, diff = qrow - kp;
        const bool valid = (kp >= 0) && (diff >= 0) && (diff < 128);
        st[kt][x] = valid ? st[kt][x] : -INFINITY;
        mx = fmaxf(mx, st[kt][x]);
      }
    mx = fmaxf(mx, __shfl_xor(mx, 16)); mx = fmaxf(mx, __shfl_xor(mx, 32));
    mx = fmaxf(mx, sink);
    float sum = 0.f;
#pragma unroll
    for (int kt = 0; kt < 12; ++kt)
#pragma unroll
      for (int x = 0; x < 4; ++x) {
        const float pv = __expf(st[kt][x] - mx);
        st[kt][x] = pv;
        sum += pv;
      }
    sum += __shfl_xor(sum, 16); sum += __shfl_xor(sum, 32);
    const float inv = 1.0f / (sum + __expf(sink - mx));
    f32x4 o[4];
#pragma unroll
    for (int dt = 0; dt < 4; ++dt) o[dt] = (f32x4){0.f, 0.f, 0.f, 0.f};
#pragma unroll
    for (int t2 = 0; t2 < 6; ++t2) {
      bf16x8 pf;
#pragma unroll
      for (int x = 0; x < 4; ++x) { pf[x] = (short)f2bf(st[2 * t2][x]); pf[4 + x] = (short)f2bf(st[2 * t2 + 1][x]); }
#pragma unroll
      for (int dt = 0; dt < 4; ++dt) {
        const uint2 v0 = *(const uint2*)(sVT + (dt * 16 + r16) * 200 + t2 * 32 + g4 * 4);
        const uint2 v1 = *(const uint2*)(sVT + (dt * 16 + r16) * 200 + t2 * 32 + 16 + g4 * 4);
        union { uint4 u; bf16x8 v; } cv;
        cv.u = make_uint4(v0.x, v0.y, v1.x, v1.y);
        o[dt] = mfma16(cv.v, pf, o[dt]);
      }
      __builtin_amdgcn_sched_barrier(0);
    }
#pragma unroll
    for (int dt = 0; dt < 4; ++dt) {
      const int d0 = dt * 16 + g4 * 4;
      float bg[4];
      unpack4(*(const uint2*)(z + grow * ZAB + OFF_BG + h * 64 + d0), bg);
      uint2 oo;
      oo.x = pack2(o[dt][0] * inv * siluf_(bg[0]), o[dt][1] * inv * siluf_(bg[1]));
      oo.y = pack2(o[dt][2] * inv * siluf_(bg[2]), o[dt][3] * inv * siluf_(bg[3]));
      *(uint2*)(yab + grow * 1024 + 512 + h * 64 + d0) = oo;
    }
  }
  __syncthreads();
}

__device__ __forceinline__ void swa_sample_item(const Params& p, int l, int item, unsigned char* smem) {
  const int b = item >> 1, kv = item & 1;
  const int r0 = TP + b * 8;
  const bf16* z = (const bf16*)(p.ws + WS_Z);
  bf16* yab = (bf16*)(p.ws + WS_YAB);
  bf16* sK = (bf16*)smem;
  bf16* sV = (bf16*)(smem + 19584);
  float* sq = (float*)(smem + 39168);
  float* sP = (float*)(smem + 47488);
  const int tid = tidx();
  const float* kg = p.kn_g + l * 64;
  const float* qg = p.qn_g + l * 64;
  const float* ck = p.cache_k + ((size_t)l * 128 + b) * 128 * 128;
  const float* cvp = p.cache_v + ((size_t)l * 128 + b) * 128 * 128;
#pragma unroll 1
  for (int it = 0; it < 5; ++it) {
    const int id = tid + 256 * it, j = id >> 3, ch = id & 7;
    const bool act = id < 1088;
    float kf[8], vf[8];
#pragma unroll
    for (int x = 0; x < 8; ++x) { kf[x] = 0.f; vf[x] = 0.f; }
    if (act) {
      if (j < 128) {
        const float4 a0 = *(const float4*)(ck + (j * 2 + kv) * 64 + ch * 8), a1 = *(const float4*)(ck + (j * 2 + kv) * 64 + ch * 8 + 4);
        const float4 b0 = *(const float4*)(cvp + (j * 2 + kv) * 64 + ch * 8), b1 = *(const float4*)(cvp + (j * 2 + kv) * 64 + ch * 8 + 4);
        kf[0] = a0.x; kf[1] = a0.y; kf[2] = a0.z; kf[3] = a0.w; kf[4] = a1.x; kf[5] = a1.y; kf[6] = a1.z; kf[7] = a1.w;
        vf[0] = b0.x; vf[1] = b0.y; vf[2] = b0.z; vf[3] = b0.w; vf[4] = b1.x; vf[5] = b1.y; vf[6] = b1.z; vf[7] = b1.w;
      } else {
        unpack8(*(const uint4*)(z + (size_t)(r0 + j - 128) * ZAB + OFF_BK + kv * 64 + ch * 8), kf);
        unpack8(*(const uint4*)(z + (size_t)(r0 + j - 128) * ZAB + OFF_BV + kv * 64 + ch * 8), vf);
      }
    }
    float ss = 0.f;
#pragma unroll
    for (int x = 0; x < 8; ++x) ss += kf[x] * kf[x];
    ss += __shfl_xor(ss, 1); ss += __shfl_xor(ss, 2); ss += __shfl_xor(ss, 4);
    if (act) {
      if (j >= 128) {
        const float rstd = rsqrtf(ss * (1.0f / 64.f) + EPS);
#pragma unroll
        for (int x = 0; x < 8; ++x) kf[x] = kf[x] * rstd * kg[ch * 8 + x];
      }
      uint4 ko, vo;
      ko.x = pack2(kf[0], kf[1]); ko.y = pack2(kf[2], kf[3]); ko.z = pack2(kf[4], kf[5]); ko.w = pack2(kf[6], kf[7]);
      vo.x = pack2(vf[0], vf[1]); vo.y = pack2(vf[2], vf[3]); vo.z = pack2(vf[4], vf[5]); vo.w = pack2(vf[6], vf[7]);
      *(uint4*)(sK + j * 72 + ch * 8) = ko;
      *(uint4*)(sV + j * 72 + ch * 8) = vo;
      if (j >= 8) {
        const size_t o = ((((size_t)l * 128 + b) * 128 + (j - 8)) * 2 + kv) * 64 + ch * 8;
        *(float4*)(p.out + O_SKS + o) = make_float4(kf[0], kf[1], kf[2], kf[3]);
        *(float4*)(p.out + O_SKS + o + 4) = make_float4(kf[4], kf[5], kf[6], kf[7]);
        *(float4*)(p.out + O_SVS + o) = make_float4(vf[0], vf[1], vf[2], vf[3]);
        *(float4*)(p.out + O_SVS + o + 4) = make_float4(vf[4], vf[5], vf[6], vf[7]);
      }
    }
  }
  const int qi = tid >> 3, sub = tid & 7, t = qi >> 2, h = kv * 4 + (qi & 3);
  {
    float f[8];
    unpack8(*(const uint4*)(z + (size_t)(r0 + t) * ZAB + OFF_BQ + h * 64 + sub * 8), f);
    float ss = 0.f;
#pragma unroll
    for (int x = 0; x < 8; ++x) ss += f[x] * f[x];
    ss += __shfl_xor(ss, 1); ss += __shfl_xor(ss, 2); ss += __shfl_xor(ss, 4);
    const float rstd = rsqrtf(ss * (1.0f / 64.f) + EPS) * 0.125f;
#pragma unroll
    for (int x = 0; x < 8; ++x) sq[qi * 65 + sub * 8 + x] = f[x] * rstd * qg[sub * 8 + x];
  }
  __syncthreads();
  const float sink = p.sinks[l * 8 + h];
  float mx = -INFINITY;
#pragma unroll 1
  for (int jj = 0; jj < 17; ++jj) {
    const int key = sub + 8 * jj;
    float s = 0.f;
#pragma unroll 8
    for (int d = 0; d < 64; ++d) s += sq[qi * 65 + d] * bf2f(sK[key * 72 + d]);
    const bool valid = (key >= t + 1) && (key <= t + 128);
    s = valid ? s : -INFINITY;
    sP[qi * 140 + key] = s;
    mx = fmaxf(mx, s);
  }
  mx = fmaxf(mx, __shfl_xor(mx, 1)); mx = fmaxf(mx, __shfl_xor(mx, 2)); mx = fmaxf(mx, __shfl_xor(mx, 4));
  mx = fmaxf(mx, sink);
  float sum = 0.f;
  for (int jj = 0; jj < 17; ++jj) {
    const int key = sub + 8 * jj;
    const float pv = __expf(sP[qi * 140 + key] - mx);
    sP[qi * 140 + key] = pv;
    sum += pv;
  }
  sum += __shfl_xor(sum, 1); sum += __shfl_xor(sum, 2); sum += __shfl_xor(sum, 4);
  const float inv = 1.0f / (sum + __expf(sink - mx));
  __syncthreads();
  {
    float o[8];
#pragma unroll
    for (int x = 0; x < 8; ++x) o[x] = 0.f;
#pragma unroll 2
    for (int key = 0; key < 136; ++key) {
      const float pv = sP[qi * 140 + key];
      float vf[8];
      unpack8(*(const uint4*)(sV + key * 72 + sub * 8), vf);
#pragma unroll
      for (int x = 0; x < 8; ++x) o[x] += pv * vf[x];
    }
    float bg[8];
    unpack8(*(const uint4*)(z + (size_t)(r0 + t) * ZAB + OFF_BG + h * 64 + sub * 8), bg);
    uint4 oo;
    oo.x = pack2(o[0] * inv * siluf_(bg[0]), o[1] * inv * siluf_(bg[1]));
    oo.y = pack2(o[2] * inv * siluf_(bg[2]), o[3] * inv * siluf_(bg[3]));
    oo.z = pack2(o[4] * inv * siluf_(bg[4]), o[5] * inv * siluf_(bg[5]));
    oo.w = pack2(o[6] * inv * siluf_(bg[6]), o[7] * inv * siluf_(bg[7]));
    *(uint4*)(yab + (size_t)(r0 + t) * 1024 + 512 + h * 64 + sub * 8) = oo;
  }
  __syncthreads();
}

__device__ __forceinline__ void phase_mix_ab(const Params& p, int l, unsigned char* smem) {
  constexpr int N_SWA = 512, N_GM = 512, N_SWS = 256, N_GMS = 128;
  constexpr int N_ALL = N_SWA + N_GM + N_SWS + N_GMS;
  for (int it = blockIdx.x; it < N_ALL; it += gridDim.x) {
    int i = it;
    if (i < N_SWA) { swa_prompt_item(p, l, i, smem); continue; }
    i -= N_SWA;
    if (i < N_GM) { gmlp_prompt_item(p, l, i, smem); continue; }
    i -= N_GM;
    if (i < N_SWS) { swa_sample_item(p, l, i, smem); continue; }
    i -= N_SWS;
    gmlp_sample_item(p, l, i, smem);
  }
}

__device__ __forceinline__ void conv8_prompt(const Params& p, int l, const bf16* z, int r0, int pos0, int s, int zc, float* y) {
  const float* cw = p.conv_w + (size_t)l * 4 * 1024 + zc;
  const float* cb = p.conv_b + l * 1024 + zc;
#pragma unroll
  for (int j = 0; j < 8; ++j) y[j] = cb[j];
#pragma unroll
  for (int tap = 0; tap < 4; ++tap) {
    const int back = 3 - tap;
    if (pos0 + s - back >= 0) {
      float f[8];
      unpack8(*(const uint4*)(z + (size_t)(r0 + s - back) * ZC + C_QK + zc), f);
#pragma unroll
      for (int j = 0; j < 8; ++j) y[j] += cw[tap * 1024 + j] * f[j];
    }
  }
#pragma unroll
  for (int j = 0; j < 8; ++j) y[j] = siluf_(y[j]);
}

__device__ __forceinline__ void chunk_gates(const Params& p, int l, const bf16* z, int r0, int hh, int lane, float& cum, float& iv) {
  const float f = bf2f(z[(size_t)(r0 + lane) * ZC + C_F + hh]) + p.f_bias[l * 4 + hh];
  iv = bf2f(z[(size_t)(r0 + lane) * ZC + C_I + hh]);
  float c = logsigmoidf_(f);
#pragma unroll
  for (int o = 1; o < 64; o <<= 1) {
    const float n = __shfl_up(c, o);
    if (lane >= o) c += n;
  }
  cum = c;
}

__device__ __forceinline__ void mlstm_local_item(const Params& p, int l, int item, unsigned char* smem) {
  const int bh = item >> 6, c = item & 63, b = bh >> 2, hh = bh & 3;
  const int r0 = b * SEQ + c * 64;
  const bf16* z = (const bf16*)(p.ws + WS_Z);
  bf16* skT = (bf16*)smem;
  bf16* svT = (bf16*)(smem + 18432);
  float* swsel = (float*)(smem + 36864);
  const int tid = tidx(), lane = tid & 63, wave = tid >> 6, wr = wave >> 1, wc = wave & 1;
  if (wave == 0) {
    float cum, iv;
    chunk_gates(p, l, z, r0, hh, lane, cum, iv);
    const float total = __shfl(cum, 63);
    const float g = total - cum + iv;
    const float G = wave_max(g);
    swsel[lane] = __expf(g - G);
    if (lane == 0) {
      ((float*)(p.ws + WS_G))[item] = G;
      ((float*)(p.ws + WS_TOT))[item] = total;
    }
  }
  __syncthreads();
  for (int i = tid; i < 1024; i += 256) {
    const int s = i >> 4, d8 = (i & 15) * 8;
    float y[8];
    conv8_prompt(p, l, z, r0, c * 64, s, 512 + hh * 128 + d8, y);
    const float sc = 0.08838834764831845f * swsel[s];
#pragma unroll
    for (int j = 0; j < 8; ++j) skT[(d8 + j) * 72 + s] = f2bf(y[j] * sc);
    float v[8];
    unpack8(*(const uint4*)(z + (size_t)(r0 + s) * ZC + C_V + hh * 128 + d8), v);
#pragma unroll
    for (int j = 0; j < 8; ++j) svT[(d8 + j) * 72 + s] = f2bf(v[j]);
  }
  __syncthreads();
  f32x4 acc[4][4];
  zero_acc<4>(acc);
  mma_lds<4, 4>(acc, svT + wr * 64 * 72, 72, skT + wc * 64 * 72, 72, 64, lane);
  bf16* U = (bf16*)(p.ws + WS_U) + (size_t)item * 16384;
#pragma unroll
  for (int i = 0; i < 4; ++i)
#pragma unroll
    for (int j = 0; j < 4; ++j) {
      const int e = wr * 64 + i * 16 + (lane & 15), d = wc * 64 + j * 16 + (lane >> 4) * 4;
      uint2 o;
      o.x = pack2(acc[i][j][0], acc[i][j][1]);
      o.y = pack2(acc[i][j][2], acc[i][j][3]);
      *(uint2*)(U + e * 128 + d) = o;
    }
  if (tid < 128) {
    float s = 0.f;
    for (int k = 0; k < 64; ++k) s += bf2f(skT[tid * 72 + k]);
    ((float*)(p.ws + WS_UN))[(size_t)item * 128 + tid] = s;
  }
  __syncthreads();
}

__device__ __forceinline__ void mlstm_convout_item(const Params& p, int l, int b) {
  const bf16* z = (const bf16*)(p.ws + WS_Z);
  for (int i = tidx(); i < 3 * 1024; i += 256) {
    const int j = i >> 10, ch = i & 1023;
    p.out[O_CVP + (((size_t)l * 4 + b) * 3 + j) * 1024 + ch] = bf2f(z[(size_t)(b * SEQ + SEQ - 3 + j) * ZC + C_QK + ch]);
  }
}

__device__ __forceinline__ void mlstm_sample_item(const Params& p, int l, int item, unsigned char* smem) {
  const int b = item >> 2, hh = item & 3;
  const int r0 = TP + b * 8;
  bf16* z = (bf16*)(p.ws + WS_Z);
  float* sq = (float*)smem;
  float* sk = sq + 1024;
  float* sv = sk + 1024;
  float* sh = sv + 1024;
  float* sint = sh + 1024;
  float* sa = sint + 2048;
  float* sqn = sa + 64;
  float* smt = sqn + 8;
  float* swi = smt + 8;
  float* swsel = swi + 8;
  float* sdm = swsel + 8;
  float* sdecay = sdm + 64;
  const int tid = tidx(), lane = tid & 63, wave = tid >> 6;
  {
    const int isk = tid >> 7, d = tid & 127, zc = isk * 512 + hh * 128 + d;
    const float* cw = p.conv_w + (size_t)l * 4 * 1024 + zc;
    const float cb = p.conv_b[l * 1024 + zc];
    float xp[11];
    const float* cs = p.st_conv + ((size_t)l * 128 + b) * 3 * 1024 + zc;
    xp[0] = cs[0]; xp[1] = cs[1024]; xp[2] = cs[2048];
#pragma unroll
    for (int t = 0; t < 8; ++t) xp[3 + t] = bf2f(z[(size_t)(r0 + t) * ZC + C_QK + zc]);
    const float w0 = cw[0], w1 = cw[1024], w2 = cw[2048], w3 = cw[3072];
    float* dst = isk ? sk : sq;
    const float sc = isk ? 0.08838834764831845f : 1.0f;
#pragma unroll
    for (int t = 0; t < 8; ++t) {
      const float y = cb + w0 * xp[t] + w1 * xp[t + 1] + w2 * xp[t + 2] + w3 * xp[t + 3];
      dst[t * 128 + d] = siluf_(y) * sc;
    }
    float* co = p.out + O_CVS + ((size_t)l * 128 + b) * 3 * 1024 + zc;
    co[0] = xp[8]; co[1024] = xp[9]; co[2048] = xp[10];
  }
  for (int i = tid; i < 1024; i += 256) {
    const int t = i >> 7, e = i & 127;
    sv[i] = bf2f(z[(size_t)(r0 + t) * ZC + C_V + hh * 128 + e]);
  }
  if (tid == 0) {
    float cum[8], iv[8];
    float c = 0.f;
    for (int t = 0; t < 8; ++t) {
      const float f = bf2f(z[(size_t)(r0 + t) * ZC + C_F + hh]) + p.f_bias[l * 4 + hh];
      c += logsigmoidf_(f);
      cum[t] = c;
      iv[t] = bf2f(z[(size_t)(r0 + t) * ZC + C_I + hh]);
    }
    const float m0 = p.st_m[(l * 128 + b) * 4 + hh];
    for (int t = 0; t < 8; ++t) {
      float dmax = -INFINITY;
      for (int s = 0; s <= t; ++s) dmax = fmaxf(dmax, cum[t] - cum[s] + iv[s]);
      const float mi = cum[t] + m0, mt = fmaxf(mi, dmax);
      smt[t] = mt;
      swi[t] = __expf(mi - mt);
      for (int s = 0; s < 8; ++s) sdm[t * 8 + s] = (s <= t) ? __expf(cum[t] - cum[s] + iv[s] - mt) : 0.f;
    }
    const float total = cum[7];
    float gm = -INFINITY;
    for (int s = 0; s < 8; ++s) gm = fmaxf(gm, total - cum[s] + iv[s]);
    const float mn = fmaxf(total + m0, gm);
    for (int s = 0; s < 8; ++s) swsel[s] = __expf(total - cum[s] + iv[s] - mn);
    sdecay[0] = __expf(total + m0 - mn);
    p.out[O_MS + (l * 128 + b) * 4 + hh] = mn;
  }
  __syncthreads();
  const float* n0 = p.st_n + (((size_t)l * 128 + b) * 4 + hh) * 128;
  if (tid < 64) {
    const int t = tid >> 3, s = tid & 7;
    float dsum = 0.f;
    for (int d = 0; d < 128; ++d) dsum += sq[t * 128 + d] * sk[s * 128 + d];
    sa[t * 8 + s] = sdm[t * 8 + s] * dsum;
  } else if (tid < 128) {
    const int t = (tid - 64) >> 3, part = (tid - 64) & 7;
    float dsum = 0.f;
    for (int d = part * 16; d < part * 16 + 16; ++d) dsum += sq[t * 128 + d] * n0[d];
    dsum += __shfl_xor(dsum, 1); dsum += __shfl_xor(dsum, 2); dsum += __shfl_xor(dsum, 4);
    if (part == 0) sqn[t] = dsum;
  }
  __syncthreads();
  {
    const int e = tid & 127, dh = tid >> 7;
    const float decay = sdecay[0];
    const float* C0 = p.st_C + (((size_t)l * 128 + b) * 4 + hh) * 16384;
    float* C1 = p.out + O_CS + (((size_t)l * 128 + b) * 4 + hh) * 16384;
    float vw[8], inter[8];
#pragma unroll
    for (int s = 0; s < 8; ++s) { vw[s] = sv[s * 128 + e] * swsel[s]; inter[s] = 0.f; }
    for (int d = dh * 64; d < dh * 64 + 64; ++d) {
      const float c0 = C0[d * 128 + e];
      float upd = decay * c0;
#pragma unroll
      for (int s = 0; s < 8; ++s) {
        upd += sk[s * 128 + d] * vw[s];
        inter[s] += sq[s * 128 + d] * c0;
      }
      C1[d * 128 + e] = upd;
    }
#pragma unroll
    for (int t = 0; t < 8; ++t) sint[(dh * 8 + t) * 128 + e] = inter[t];
  }
  __syncthreads();
  if (tid < 128) {
    const int e = tid;
    for (int t = 0; t < 8; ++t) {
      float num = swi[t] * (sint[t * 128 + e] + sint[(8 + t) * 128 + e]);
      float den = swi[t] * sqn[t];
      for (int s = 0; s <= t; ++s) { num += sa[t * 8 + s] * sv[s * 128 + e]; den += sa[t * 8 + s]; }
      sh[t * 128 + e] = num / fmaxf(fabsf(den), __expf(-smt[t]));
    }
    float nn = sdecay[0] * n0[e];
    for (int s = 0; s < 8; ++s) nn += swsel[s] * sk[s * 128 + e];
    p.out[O_NS + (((size_t)l * 128 + b) * 4 + hh) * 128 + e] = nn;
  }
  __syncthreads();
  const float* hg = p.hnorm_g + l * 512 + hh * 128;
  for (int tt = 0; tt < 2; ++tt) {
    const int t = wave * 2 + tt;
    const float h0 = sh[t * 128 + lane], h1 = sh[t * 128 + 64 + lane];
    const float ss = wave_sum(h0 * h0 + h1 * h1);
    const float rstd = rsqrtf(ss * (1.0f / 128.f) + EPS);
    bf16* zr = z + (size_t)(r0 + t) * ZC;
#pragma unroll
    for (int k = 0; k < 2; ++k) {
      const int e = lane + 64 * k;
      const float hv = k ? h1 : h0;
      const float o = bf2f(zr[C_O + hh * 128 + e]), cg_ = bf2f(zr[C_G + hh * 128 + e]);
      zr[C_O + hh * 128 + e] = f2bf(hv * rstd * hg[e] * sigmoidf_(o) * siluf_(cg_));
    }
  }
  __syncthreads();
}

__device__ __forceinline__ void phase_mix1(const Params& p, int l, unsigned char* smem) {
  constexpr int N_LOC = 1024, N_SMP = 512, N_CV = 4;
  constexpr int N_ALL = N_LOC + N_SMP + N_CV;
  for (int it = blockIdx.x; it < N_ALL; it += gridDim.x) {
    int i = it;
    if (i < N_LOC) { mlstm_local_item(p, l, i, smem); continue; }
    i -= N_LOC;
    if (i < N_SMP) { mlstm_sample_item(p, l, i, smem); continue; }
    i -= N_SMP;
    mlstm_convout_item(p, l, i);
  }
}

__device__ __forceinline__ void phase_scan(const Params& p, int l, unsigned char* smem) {
  float* sdec = (float*)smem;
  float* ssc = sdec + 64;
  const int tid = tidx();
  float* Gb = (float*)(p.ws + WS_G);
  float* Tb = (float*)(p.ws + WS_TOT);
  float* Mb = (float*)(p.ws + WS_M);
  for (int it = blockIdx.x; it < 256; it += gridDim.x) {
    const int bh = it >> 4, slice = it & 15;
    if (tid < 64) { sdec[128 + tid] = Gb[bh * 64 + tid]; sdec[192 + tid] = Tb[bh * 64 + tid]; }
    __syncthreads();
    if (tid == 0) {
      float m = 0.f;
      for (int c = 0; c < 64; ++c) {
        const float G = sdec[128 + c], tot = sdec[192 + c];
        const float mn = fmaxf(tot + m, G);
        sdec[c] = __expf(tot + m - mn);
        ssc[c] = __expf(G - mn);
        if (slice == 0) Mb[bh * 64 + c] = m;
        m = mn;
      }
      if (slice == 0) p.out[O_MP + l * 16 + bh] = m;
    }
    __syncthreads();
    {
      const int idx = slice * 1024 + tid * 4;
      bf16* U = (bf16*)(p.ws + WS_U) + (size_t)bh * 64 * 16384 + idx;
      float st[4] = {0.f, 0.f, 0.f, 0.f};
#pragma unroll 8
      for (int c = 0; c < 64; ++c) {
        float u[4];
        unpack4(*(const uint2*)(U + (size_t)c * 16384), u);
        uint2 o;
        o.x = pack2(st[0], st[1]); o.y = pack2(st[2], st[3]);
        *(uint2*)(U + (size_t)c * 16384) = o;
        const float dc = sdec[c], sc = ssc[c];
#pragma unroll
        for (int x = 0; x < 4; ++x) st[x] = dc * st[x] + sc * u[x];
      }
      const int e = idx >> 7, d0 = idx & 127;
      float* Co = p.out + O_CP + ((size_t)l * 16 + bh) * 16384;
#pragma unroll
      for (int x = 0; x < 4; ++x) Co[(d0 + x) * 128 + e] = st[x];
    }
    if (slice == 0 && tid < 128) {
      float* un = (float*)(p.ws + WS_UN) + (size_t)bh * 64 * 128 + tid;
      float n = 0.f;
#pragma unroll 8
      for (int c = 0; c < 64; ++c) {
        const float u = un[c * 128];
        un[c * 128] = n;
        n = sdec[c] * n + ssc[c] * u;
      }
      p.out[O_NP + ((size_t)l * 16 + bh) * 128 + tid] = n;
    }
    __syncthreads();
  }
}

__device__ __forceinline__ void mlstm_out_item(const Params& p, int l, int item, unsigned char* smem) {
  const int bh = item >> 6, c = item & 63, b = bh >> 2, hh = bh & 3;
  const int r0 = b * SEQ + c * 64;
  bf16* z = (bf16*)(p.ws + WS_Z);
  bf16* sq = (bf16*)smem;
  bf16* sk = (bf16*)(smem + 17408);
  bf16* svT = (bf16*)(smem + 34816);
  bf16* sa = (bf16*)(smem + 53248);
  float* scum = (float*)(smem + 62464);
  float* siv = scum + 64;
  float* smt = siv + 64;
  float* swi = smt + 64;
  float* sden = swi + 64;
  float* sqn = sden + 64;
  float* spart = sqn + 64;
  const int tid = tidx(), lane = tid & 63, wave = tid >> 6;
  const int r16 = lane & 15, g4 = lane >> 4;
  if (wave == 0) {
    float cum, iv;
    chunk_gates(p, l, z, r0, hh, lane, cum, iv);
    scum[lane] = cum;
    siv[lane] = iv;
  }
  for (int i = tid; i < 2048; i += 256) {
    const int isk = i >> 10, r = i & 1023, s = r >> 4, d8 = (r & 15) * 8;
    float y[8];
    conv8_prompt(p, l, z, r0, c * 64, s, isk * 512 + hh * 128 + d8, y);
    const float sc = isk ? 0.08838834764831845f : 1.0f;
    uint4 o;
    o.x = pack2(y[0] * sc, y[1] * sc); o.y = pack2(y[2] * sc, y[3] * sc);
    o.z = pack2(y[4] * sc, y[5] * sc); o.w = pack2(y[6] * sc, y[7] * sc);
    *(uint4*)((isk ? sk : sq) + s * 136 + d8) = o;
  }
  for (int i = tid; i < 1024; i += 256) {
    const int s = i >> 4, d8 = (i & 15) * 8;
    float v[8];
    unpack8(*(const uint4*)(z + (size_t)(r0 + s) * ZC + C_V + hh * 128 + d8), v);
#pragma unroll
    for (int j = 0; j < 8; ++j) svT[(d8 + j) * 72 + s] = f2bf(v[j]);
  }
  __syncthreads();
  const float m_prev = ((const float*)(p.ws + WS_M))[item];
  {
    const int t = wave * 16 + r16;
    bf16x8 qf[4];
#pragma unroll
    for (int ks = 0; ks < 4; ++ks) qf[ks] = *(const bf16x8*)(sq + t * 136 + ks * 32 + g4 * 8);
    f32x4 st[4];
#pragma unroll
    for (int kt = 0; kt < 4; ++kt) {
      st[kt] = (f32x4){0.f, 0.f, 0.f, 0.f};
#pragma unroll
      for (int ks = 0; ks < 4; ++ks) {
        const bf16x8 kf = *(const bf16x8*)(sk + (kt * 16 + r16) * 136 + ks * 32 + g4 * 8);
        st[kt] = mfma16(kf, qf[ks], st[kt]);
      }
    }
    const float cumt = scum[t];
    float dm[4][4];
    float rmax = -INFINITY;
#pragma unroll
    for (int kt = 0; kt < 4; ++kt)
#pragma unroll
      for (int x = 0; x < 4; ++x) {
        const int s = kt * 16 + g4 * 4 + x;
        dm[kt][x] = (s <= t) ? (cumt - scum[s] + siv[s]) : -INFINITY;
        rmax = fmaxf(rmax, dm[kt][x]);
      }
    rmax = fmaxf(rmax, __shfl_xor(rmax, 16)); rmax = fmaxf(rmax, __shfl_xor(rmax, 32));
    const float mi = cumt + m_prev, mt = fmaxf(mi, rmax);
    float rsum = 0.f;
#pragma unroll
    for (int kt = 0; kt < 4; ++kt) {
      float a[4];
#pragma unroll
      for (int x = 0; x < 4; ++x) {
        const int s = kt * 16 + g4 * 4 + x;
        a[x] = (s <= t) ? __expf(dm[kt][x] - mt) * st[kt][x] : 0.f;
        rsum += a[x];
      }
      uint2 o;
      o.x = pack2(a[0], a[1]); o.y = pack2(a[2], a[3]);
      *(uint2*)(sa + t * 72 + kt * 16 + g4 * 4) = o;
    }
    rsum += __shfl_xor(rsum, 16); rsum += __shfl_xor(rsum, 32);
    if (g4 == 0) { smt[t] = mt; swi[t] = __expf(mi - mt); sden[t] = rsum; }
  }
  {
    const int t = tid >> 2, part = tid & 3;
    const float* nc = (const float*)(p.ws + WS_UN) + (size_t)item * 128;
    float s = 0.f;
    for (int d = part * 32; d < part * 32 + 32; ++d) s += bf2f(sq[t * 136 + d]) * nc[d];
    s += __shfl_xor(s, 1); s += __shfl_xor(s, 2);
    if (part == 0) sqn[t] = s;
  }
  __syncthreads();
  f32x4 acc[4][2];
#pragma unroll
  for (int ti = 0; ti < 4; ++ti)
#pragma unroll
    for (int et = 0; et < 2; ++et) acc[ti][et] = (f32x4){0.f, 0.f, 0.f, 0.f};
  const bf16* Cc = (const bf16*)(p.ws + WS_U) + (size_t)item * 16384;
#pragma unroll
  for (int ks = 0; ks < 4; ++ks) {
    bf16x8 cf[2], qf[4];
#pragma unroll
    for (int et = 0; et < 2; ++et) cf[et] = *(const bf16x8*)(Cc + (wave * 32 + et * 16 + r16) * 128 + ks * 32 + g4 * 8);
#pragma unroll
    for (int ti = 0; ti < 4; ++ti) qf[ti] = *(const bf16x8*)(sq + (ti * 16 + r16) * 136 + ks * 32 + g4 * 8);
#pragma unroll
    for (int ti = 0; ti < 4; ++ti)
#pragma unroll
      for (int et = 0; et < 2; ++et) acc[ti][et] = mfma16(cf[et], qf[ti], acc[ti][et]);
  }
#pragma unroll
  for (int ti = 0; ti < 4; ++ti) {
    const float w = swi[ti * 16 + r16];
#pragma unroll
    for (int et = 0; et < 2; ++et) acc[ti][et] *= w;
  }
#pragma unroll
  for (int ks = 0; ks < 2; ++ks) {
    bf16x8 vf[2], af[4];
#pragma unroll
    for (int et = 0; et < 2; ++et) vf[et] = *(const bf16x8*)(svT + (wave * 32 + et * 16 + r16) * 72 + ks * 32 + g4 * 8);
#pragma unroll
    for (int ti = 0; ti < 4; ++ti) af[ti] = *(const bf16x8*)(sa + (ti * 16 + r16) * 72 + ks * 32 + g4 * 8);
#pragma unroll
    for (int ti = 0; ti < 4; ++ti)
#pragma unroll
      for (int et = 0; et < 2; ++et) acc[ti][et] = mfma16(vf[et], af[ti], acc[ti][et]);
  }
#pragma unroll
  for (int ti = 0; ti < 4; ++ti) {
    const int t = ti * 16 + r16;
    const float den = sden[t] + swi[t] * sqn[t];
    const float inv = 1.0f / fmaxf(fabsf(den), __expf(-smt[t]));
    float ss = 0.f;
#pragma unroll
    for (int et = 0; et < 2; ++et) {
      acc[ti][et] *= inv;
#pragma unroll
      for (int x = 0; x < 4; ++x) ss += acc[ti][et][x] * acc[ti][et][x];
    }
    ss += __shfl_xor(ss, 16); ss += __shfl_xor(ss, 32);
    if (g4 == 0) spart[t * 4 + wave] = ss;
  }
  __syncthreads();
  const float* hg = p.hnorm_g + l * 512 + hh * 128;
#pragma unroll
  for (int ti = 0; ti < 4; ++ti) {
    const int t = ti * 16 + r16;
    const float rstd = rsqrtf((spart[t * 4] + spart[t * 4 + 1] + spart[t * 4 + 2] + spart[t * 4 + 3]) * (1.0f / 128.f) + EPS);
    bf16* zr = z + (size_t)(r0 + t) * ZC;
#pragma unroll
    for (int et = 0; et < 2; ++et) {
      const int e = wave * 32 + et * 16 + g4 * 4;
      float o[4], cg_[4];
      unpack4(*(const uint2*)(zr + C_O + hh * 128 + e), o);
      unpack4(*(const uint2*)(zr + C_G + hh * 128 + e), cg_);
      float y[4];
#pragma unroll
      for (int x = 0; x < 4; ++x) y[x] = acc[ti][et][x] * rstd * hg[e + x] * sigmoidf_(o[x]) * siluf_(cg_[x]);
      uint2 oo;
      oo.x = pack2(y[0], y[1]); oo.y = pack2(y[2], y[3]);
      *(uint2*)(zr + C_O + hh * 128 + e) = oo;
    }
  }
  __syncthreads();
}

__device__ __forceinline__ void phase_mix2(const Params& p, int l, unsigned char* smem) {
  for (int it = blockIdx.x; it < 1024; it += gridDim.x) mlstm_out_item(p, l, it, smem);
}

__device__ __forceinline__ void phase_gemm_br(const Params& p, int l, unsigned char* smem) {
  bf16* sm = (bf16*)smem;
  const bf16* hbuf = (const bf16*)(p.ws + WS_H);
  const bf16* Win = (const bf16*)(p.ws + WS_WIN) + (size_t)l * NWIN * 1024;
  const bf16* Wbr = (const bf16*)(p.ws + WS_WBR) + (size_t)l * 1024 * 1536;
  const bf16* yab = (const bf16*)(p.ws + WS_YAB);
  const bf16* z = (const bf16*)(p.ws + WS_Z);
  bf16* merged = (bf16*)(p.ws + WS_U);
  const float* bias = p.b_in + (size_t)l * ZIN + OFF_MG;
  const int lane = tidx() & 63, wave = tidx() >> 6, wr = wave >> 1, wc = wave & 1;
  const int ntiles = (TT / 128) * 8;
  for (int t = blockIdx.x; t < ntiles; t += gridDim.x) {
    int pm, pn;
    tile_map(t, 8, pm, pn);
    const int m0 = pm * 128, n0 = pn * 128;
#pragma unroll 1
    for (int seg = 0; seg < 3; ++seg) {
      f32x4 acc[4][4];
      zero_acc<4>(acc);
      gemm_accum_f8<4>(acc, p.ws + WS_H8 + (size_t)m0 * 1024, p.ws + WS_W8 + ((size_t)l * W8_ROWS + (OFF_MG - W8_ROW0) + seg * 1024 + n0) * 1024, sm);
      unsigned gp[4][4][2];
#pragma unroll
      for (int j = 0; j < 4; ++j) {
        const int col = n0 + wc * 64 + j * 16 + (lane >> 4) * 4;
        const float4 bb = *(const float4*)(bias + seg * 1024 + col);
#pragma unroll
        for (int i = 0; i < 4; ++i) {
          gp[i][j][0] = pack2(sigmoidf_(acc[i][j][0] * 0.015625f + bb.x), sigmoidf_(acc[i][j][1] * 0.015625f + bb.y));
          gp[i][j][1] = pack2(sigmoidf_(acc[i][j][2] * 0.015625f + bb.z), sigmoidf_(acc[i][j][3] * 0.015625f + bb.w));
        }
      }
      zero_acc<4>(acc);
      const bf16* A = (seg == 0) ? yab + (size_t)m0 * 1024 : (seg == 1) ? yab + (size_t)m0 * 1024 + 512 : z + (size_t)m0 * ZC + C_O;
      const int lda = (seg == 2) ? ZC : 1024;
      gemm_accum<4, true>(acc, A, lda, Wbr + (size_t)n0 * 1536 + seg * 512, 1536, 512, sm);
#pragma unroll
      for (int i = 0; i < 4; ++i)
#pragma unroll
        for (int j = 0; j < 4; ++j) {
          const int row = m0 + wr * 64 + i * 16 + (lane & 15), col = n0 + wc * 64 + j * 16 + (lane >> 4) * 4;
          uint2* mp = (uint2*)(merged + (size_t)row * 1024 + col);
          uint2 prev = make_uint2(0u, 0u);
          if (seg > 0) prev = *mp;
          uint2 o;
          o.x = pack2(lo2f(prev.x) + lo2f(gp[i][j][0]) * acc[i][j][0], hi2f(prev.x) + hi2f(gp[i][j][0]) * acc[i][j][1]);
          o.y = pack2(lo2f(prev.y) + lo2f(gp[i][j][1]) * acc[i][j][2], hi2f(prev.y) + hi2f(gp[i][j][1]) * acc[i][j][3]);
          *mp = o;
        }
    }
  }
}

__device__ __forceinline__ void phase_gemm_out(const Params& p, int l, unsigned char* smem) {
  bf16* sm = (bf16*)smem;
  const bf16* merged = (const bf16*)(p.ws + WS_U);
  const bf16* Wout = (const bf16*)(p.ws + WS_WOUT) + (size_t)l * 1024 * 1024;
  const float* mod = (const float*)(p.ws + WS_MOD);
  const int lane = tidx() & 63, wave = tidx() >> 6, wr = wave >> 1, wc = wave & 1;
  const int ntiles = (TT / 128) * 8;
  for (int t = blockIdx.x; t < ntiles; t += gridDim.x) {
    int pm, pn;
    tile_map(t, 8, pm, pn);
    const int m0 = pm * 128, n0 = pn * 128;
    f32x4 acc[4][4];
    zero_acc<4>(acc);
    gemm_accum<4>(acc, merged + (size_t)m0 * 1024, 1024, Wout + (size_t)n0 * 1024, 1024, 1024, sm);
#pragma unroll
    for (int i = 0; i < 4; ++i) {
      const int row = m0 + wr * 64 + i * 16 + (lane & 15);
      const float* xr = xrow_ptr(p, l, row);
      const float* gate = mod + ((size_t)l * NMOD + mod_row(row)) * 3072 + 2048;
#pragma unroll
      for (int j = 0; j < 4; ++j) {
        const int col = n0 + wc * 64 + j * 16 + (lane >> 4) * 4;
        const float4 xv = *(const float4*)(xr + col), gv = *(const float4*)(gate + col);
        float4 o;
        o.x = xv.x + gv.x * acc[i][j][0]; o.y = xv.y + gv.y * acc[i][j][1];
        o.z = xv.z + gv.z * acc[i][j][2]; o.w = xv.w + gv.w * acc[i][j][3];
        *(float4*)(p.out + (size_t)row * D + col) = o;
      }
    }
  }
}

constexpr int N_PHASES = 19;
template <int S>
__device__ __forceinline__ void run_stage(const Params& p, int l, unsigned char* smem) {
  if (S == -1) phase_prep(p, smem);
  if (S == 0) phase_norm(p, l);
  if (S == 1) phase_gemm_in(p, l, 0, ZAB / 128, ZAB, smem);
  if (S == 2) phase_mix_ab(p, l, smem);
  if (S == 3) phase_gemm_in(p, l, ZAB, ZC / 128, ZC, smem);
  if (S == 4) phase_mix1(p, l, smem);
  if (S == 5) phase_scan(p, l, smem);
  if (S == 6) phase_mix2(p, l, smem);
  if (S == 7) phase_gemm_br(p, l, smem);
  if (S == 8) phase_gemm_out(p, l, smem);
}


#define XB_TMO      128
#define XB_XCNT(j)  (256  + 64 * (j))
#define XB_XSUB(j)  (1280 + 64 * (j))
#define XB_XGEN(j)  (2304 + 64 * (j))
#define XB_TOP      3328
#define XB_TOPGEN   3392
#define XCD_BAR_WORDS 3456
#define XB_SPIN_CAP (1u << 18)
#define LAS __attribute__((address_space(3)))
__device__ __forceinline__ unsigned xb_ld(unsigned* p)              { return __hip_atomic_load(p, __ATOMIC_RELAXED, __HIP_MEMORY_SCOPE_AGENT); }
__device__ __forceinline__ unsigned xb_add(unsigned* p, unsigned v) { return __hip_atomic_fetch_add(p, v, __ATOMIC_RELAXED, __HIP_MEMORY_SCOPE_AGENT); }
__device__ __forceinline__ unsigned xb_xcc_id() { return (unsigned)__builtin_amdgcn_s_getreg((3 << 11) | 20) & 0xFu; }
#define XB_SPIN(cond, bar) do { unsigned _sp = 0; while (cond) { __builtin_amdgcn_s_sleep(1); \
    if ((++_sp & 255u) == 0u) { if (xb_ld(&(bar)[XB_TMO])) break; if (_sp > XB_SPIN_CAP) { atomicAdd(&(bar)[XB_TMO], 1u); break; } } } } while (0)
struct XcdBarrier { unsigned* bar; unsigned x; volatile LAS unsigned* st; };
__device__ __forceinline__ XcdBarrier xcd_barrier_post(unsigned* bar, volatile LAS unsigned* st) {
  XcdBarrier b; b.bar = bar; b.x = xb_xcc_id(); b.st = st;
  if (threadIdx.x == 0) (void)xb_add(&bar[XB_XCNT(b.x)], 1u);
  return b;
}
__device__ __forceinline__ void xcd_barrier_complete(unsigned* bar, unsigned x, unsigned& nloc, unsigned& nx) {
  const unsigned G = gridDim.x * gridDim.y * gridDim.z;
  unsigned sum, cnt, mine, sp = 0u;
  for (;;) {
    sum = 0u; cnt = 0u; mine = 0u;
#pragma unroll
    for (unsigned j = 0; j < 16; ++j) { const unsigned c = xb_ld(&bar[XB_XCNT(j)]); sum += c; cnt += (c > 0u) ? 1u : 0u; mine = (j == x) ? c : mine; }
    if (sum == G) break;
    __builtin_amdgcn_s_sleep(1);
    if ((++sp & 255u) == 0u) { if (xb_ld(&bar[XB_TMO])) break; if (sp > XB_SPIN_CAP) { atomicAdd(&bar[XB_TMO], 1u); break; } }
  }
  nloc = mine > 0u ? mine : 1u; nx = cnt > 0u ? cnt : 1u;
}
__device__ __forceinline__ void xcd_barrier(const XcdBarrier& b) {
  asm volatile("s_waitcnt vmcnt(0)" ::: "memory");
  __syncthreads();
  if (threadIdx.x == 0) {
    unsigned* bar = b.bar;
    __builtin_amdgcn_s_waitcnt(0);
    unsigned nloc = b.st[0], nx = b.st[1];
    if (nloc == 0u) { xcd_barrier_complete(bar, b.x, nloc, nx); b.st[0] = nloc; b.st[1] = nx; }
    const unsigned old = xb_add(&bar[XB_XSUB(b.x)], 1u);
    const unsigned gen = old / nloc;
    if (old + 1u == (gen + 1u) * nloc) {
      __builtin_amdgcn_fence(__ATOMIC_RELEASE, "agent");
      asm volatile("s_waitcnt vmcnt(0)" ::: "memory");
      const unsigned og = xb_add(&bar[XB_TOP], 1u);
      const unsigned tg = og / nx;
      if (og + 1u == (tg + 1u) * nx) xb_add(&bar[XB_TOPGEN], 1u);
      else XB_SPIN(xb_ld(&bar[XB_TOPGEN]) == tg, bar);
      __builtin_amdgcn_fence(__ATOMIC_ACQUIRE, "agent");
      xb_add(&bar[XB_XGEN(b.x)], 1u);
      asm volatile("s_waitcnt vmcnt(0)" ::: "memory");
    } else {
      XB_SPIN(xb_ld(&bar[XB_XGEN(b.x)]) == gen, bar);
      __builtin_amdgcn_fence(__ATOMIC_ACQUIRE, "agent");
      asm volatile("s_waitcnt vmcnt(0)" ::: "memory");
    }
  }
  __syncthreads();
}

#define GSYNC() xcd_barrier(xb)
__global__ void __launch_bounds__(256, 2) mega_kernel(Params p_in) {
  __shared__ __attribute__((aligned(16))) unsigned char smem[SMEM_BYTES];
  const Params& p = *(const Params*)__builtin_amdgcn_kernarg_segment_ptr();
  __shared__ uint4 xb_words;
  if (threadIdx.x == 0) xb_words = make_uint4(0u, 0u, 0u, 0u);
  __syncthreads();
  XcdBarrier xb = xcd_barrier_post((unsigned*)(p.ws + WS_BAR), (volatile LAS unsigned*)&xb_words);
  run_stage<-1>(p, 0, smem);
  if (p.out == nullptr) cg::this_grid().sync();
  GSYNC();
#define LAYER(L, LAST)                 \
  run_stage<0>(p, L, smem); GSYNC();   \
  run_stage<1>(p, L, smem); GSYNC();   \
  run_stage<2>(p, L, smem); GSYNC();   \
  run_stage<3>(p, L, smem); GSYNC();   \
  run_stage<4>(p, L, smem); GSYNC();   \
  run_stage<5>(p, L, smem); GSYNC();   \
  run_stage<6>(p, L, smem); GSYNC();   \
  run_stage<7>(p, L, smem); GSYNC();   \
  run_stage<8>(p, L, smem);            \
  if (!LAST) GSYNC();
  int l0 = 0, l1 = 1;
  asm volatile("" : "+s"(l0));
  asm volatile("" : "+s"(l1));
  LAYER(l0, 0)
  LAYER(l1, 1)
}

extern "C" void kernel_launch(void* const* d_in, const int* in_sizes, int n_in, void* d_out, int out_size, void* d_ws,
                              size_t ws_size, hipStream_t stream) {
  if (ws_size < WS_END || n_in < 29) { fprintf(stderr, "workspace too small / bad inputs\n"); return; }
  Params p{};
  const float** f = (const float**)&p;
  for (int i = 0; i < 29; ++i) f[i] = (const float*)d_in[i];
  p.out = (float*)d_out;
  p.ws = (unsigned char*)d_ws;
  static int grid_blocks = 0;
  if (!grid_blocks) {
    int dev = 0, cus = 0, per_cu = 0;
    (void)hipGetDevice(&dev);
    (void)hipDeviceGetAttribute(&cus, hipDeviceAttributeMultiprocessorCount, dev);
    (void)hipOccupancyMaxActiveBlocksPerMultiprocessor(&per_cu, mega_kernel, 256, 0);
    if (per_cu < 1) per_cu = 1;
    if (per_cu > 2) per_cu = 2;
    grid_blocks = cus * per_cu;
  }
  (void)hipMemsetAsync((unsigned char*)d_ws + WS_BAR, 0, 16384, stream);
  void* args[] = {&p};
  hipError_t e = hipLaunchCooperativeKernel((void*)mega_kernel, dim3(grid_blocks), dim3(256), args, 0, stream);
  if (e != hipSuccess) fprintf(stderr, "cooperative launch failed: %s (grid %d)\n", hipGetErrorString(e), grid_blocks);
}
```

```cpp
#include <hip/hip_runtime.h>
#include <hip/hip_cooperative_groups.h>
#include <cstdio>
namespace cg = cooperative_groups;

typedef unsigned short bf16;
typedef short bf16x8 __attribute__((ext_vector_type(8)));
typedef float f32x4 __attribute__((ext_vector_type(4)));
typedef unsigned u32x4 __attribute__((ext_vector_type(4)));
#define LDSP __attribute__((address_space(3)))

#ifndef SINGLE_LAUNCH
#define SINGLE_LAUNCH 0
#endif

constexpr int D = 1024, TP = 16384, TS = 1024, TT = TP + TS, SEQ = 4096;
constexpr int ZIN = 8456, NWIN = 8576;
constexpr int OFF_AV = 512, OFF_AG = 1024, OFF_BQ = 1536, OFF_BK = 2048, OFF_BV = 2176, OFF_BG = 2304, OFF_MG = 5384;
constexpr int ZAB = 2816;
constexpr int ZC = 2688;
constexpr int C_QK = 0, C_V = 1024, C_I = 1536, C_F = 1540, C_O = 1544, C_G = 2056;
constexpr float EPS = 1e-6f;
constexpr int NMOD = 132;
constexpr int SMEM_BYTES = 73728;

constexpr size_t O_Y = 0;
constexpr size_t O_SKP = (size_t)TT * D;
constexpr size_t O_SVP = O_SKP + 2 * 4 * 128 * 128;
constexpr size_t O_CVP = O_SVP + 2 * 4 * 128 * 128;
constexpr size_t O_CP = O_CVP + 2 * 4 * 3 * 1024;
constexpr size_t O_NP = O_CP + (size_t)2 * 4 * 4 * 128 * 128;
constexpr size_t O_MP = O_NP + 2 * 4 * 4 * 128;
constexpr size_t O_SKS = O_MP + 2 * 4 * 4;
constexpr size_t O_SVS = O_SKS + (size_t)2 * 128 * 128 * 128;
constexpr size_t O_CVS = O_SVS + (size_t)2 * 128 * 128 * 128;
constexpr size_t O_CS = O_CVS + (size_t)2 * 128 * 3 * 1024;
constexpr size_t O_NS = O_CS + (size_t)2 * 128 * 4 * 128 * 128;
constexpr size_t O_MS = O_NS + (size_t)2 * 128 * 4 * 128;
constexpr size_t O_GV = O_MS + 2 * 128 * 4;
constexpr size_t O_END = O_GV + (size_t)2 * 128 * 8 * 512;

constexpr size_t WS_WIN = 0;
constexpr size_t WS_WBR = WS_WIN + (size_t)2 * NWIN * 1024 * 2;
constexpr size_t WS_WOUT = WS_WBR + (size_t)2 * 1024 * 1536 * 2;
constexpr size_t WS_MOD = WS_WOUT + (size_t)2 * 1024 * 1024 * 2;
constexpr size_t WS_H = WS_MOD + (size_t)2 * NMOD * 3072 * 4;
constexpr size_t WS_YAB = WS_H + (size_t)TT * 1024 * 2;
constexpr size_t WS_U = WS_YAB + (size_t)TT * 1024 * 2;
constexpr size_t WS_UN = WS_U + (size_t)TT * 1024 * 2;
constexpr size_t WS_G = WS_UN + (size_t)1024 * 128 * 4;
constexpr size_t WS_TOT = WS_G + 4096;
constexpr size_t WS_M = WS_TOT + 4096;
constexpr size_t WS_Z = WS_M + 4096;
constexpr size_t WS_BAR = WS_Z + (size_t)TT * ZAB * 2;
constexpr size_t WS_H8 = WS_BAR + 16384;
constexpr int W8_ROW0 = 0, W8_ROWS = NWIN;
constexpr size_t WS_W8 = WS_H8 + (size_t)TT * 1024;
constexpr size_t WS_END = WS_W8 + (size_t)2 * W8_ROWS * 1024;

struct Params {
  const float *x_prompt, *x_sample, *cache_k, *cache_v, *st_conv, *st_C, *st_n, *st_m, *c_prompt, *c_sample;
  const float *ada_w, *ada_b, *norm_g, *w_in, *b_in, *vnorm_g, *gmlp_ws, *gmlp_bs, *qn_g, *kn_g, *sinks;
  const float *conv_w, *conv_b, *f_bias, *hnorm_g, *w_a, *w_b, *w_c, *w_out;
  float* out;
  unsigned char* ws;
};

__device__ __forceinline__ int tidx() { int t = threadIdx.x; asm volatile("" : "+v"(t)); return t; }
__device__ __forceinline__ bf16 f2bf(float f) {
  unsigned u = __float_as_uint(f);
  u += 0x7fffu + ((u >> 16) & 1u);
  return (bf16)(u >> 16);
}
__device__ __forceinline__ float bf2f(bf16 h) { return __uint_as_float(((unsigned)h) << 16); }
__device__ __forceinline__ unsigned pack2(float a, float b) { return (unsigned)f2bf(a) | ((unsigned)f2bf(b) << 16); }
__device__ __forceinline__ float lo2f(unsigned u) { return __uint_as_float(u << 16); }
__device__ __forceinline__ float hi2f(unsigned u) { return __uint_as_float(u & 0xffff0000u); }
__device__ __forceinline__ void unpack8(const uint4& v, float* f) {
  f[0] = lo2f(v.x); f[1] = hi2f(v.x); f[2] = lo2f(v.y); f[3] = hi2f(v.y);
  f[4] = lo2f(v.z); f[5] = hi2f(v.z); f[6] = lo2f(v.w); f[7] = hi2f(v.w);
}
__device__ __forceinline__ void unpack4(const uint2& v, float* f) {
  f[0] = lo2f(v.x); f[1] = hi2f(v.x); f[2] = lo2f(v.y); f[3] = hi2f(v.y);
}
__device__ __forceinline__ float sigmoidf_(float x) { return __builtin_amdgcn_rcpf(1.0f + __expf(-x)); }
__device__ __forceinline__ float siluf_(float x) { return x * __builtin_amdgcn_rcpf(1.0f + __expf(-x)); }
__device__ __forceinline__ float logsigmoidf_(float x) { return fminf(x, 0.0f) - log1pf(__expf(-fabsf(x))); }
__device__ __forceinline__ float wave_sum(float v) {
#pragma unroll
  for (int o = 32; o >= 1; o >>= 1) v += __shfl_xor(v, o);
  return v;
}
__device__ __forceinline__ float wave_max(float v) {
#pragma unroll
  for (int o = 32; o >= 1; o >>= 1) v = fmaxf(v, __shfl_xor(v, o));
  return v;
}
__device__ __forceinline__ f32x4 mfma16(bf16x8 a, bf16x8 b, f32x4 c) {
  return __builtin_amdgcn_mfma_f32_16x16x32_bf16(a, b, c, 0, 0, 0);
}
template <int MI, int NI>
__device__ __forceinline__ void mma_lds(f32x4 (&acc)[MI][NI], const bf16* sA, int lda, const bf16* sB, int ldb, int K, int lane) {
  const int r = lane & 15, q = (lane >> 4) * 8;
  for (int k0 = 0; k0 < K; k0 += 32) {
    bf16x8 a[MI], b[NI];
#pragma unroll
    for (int i = 0; i < MI; ++i) a[i] = *(const bf16x8*)(sA + (i * 16 + r) * lda + k0 + q);
#pragma unroll
    for (int j = 0; j < NI; ++j) b[j] = *(const bf16x8*)(sB + (j * 16 + r) * ldb + k0 + q);
#pragma unroll
    for (int i = 0; i < MI; ++i)
#pragma unroll
      for (int j = 0; j < NI; ++j) acc[i][j] = mfma16(b[j], a[i], acc[i][j]);
  }
}

constexpr int GLD = 64;
constexpr int GTILE = 128 * GLD;
template <int NI>
__device__ __forceinline__ void g_load(u32x4 (&ra)[4], u32x4 (&rb)[NI], const bf16* __restrict__ A, int lda, const bf16* __restrict__ B, int ldb, int ko, int tid) {
  const unsigned offA = (unsigned)((tid >> 3) * lda + (tid & 7) * 8), offB = (unsigned)((tid >> 3) * ldb + (tid & 7) * 8);
#pragma unroll
  for (int i = 0; i < 4; ++i) {
    const bf16* Ai = A + (size_t)(i * 32) * lda + ko;
    ra[i] = *(const u32x4*)(Ai + offA);
  }
#pragma unroll
  for (int i = 0; i < NI; ++i) {
    const bf16* Bi = B + (size_t)(i * 32) * ldb + ko;
    rb[i] = *(const u32x4*)(Bi + offB);
  }
}
template <int NI>
__device__ __forceinline__ void g_store(const u32x4 (&ra)[4], const u32x4 (&rb)[NI], bf16* buf, int tid) {
  const int off = (tid >> 3) * GLD + (((tid & 7) ^ ((tid >> 3) & 7)) * 8);
#pragma unroll
  for (int i = 0; i < 4; ++i) *(u32x4*)(buf + off + i * 32 * GLD) = ra[i];
#pragma unroll
  for (int i = 0; i < NI; ++i) *(u32x4*)(buf + GTILE + off + i * 32 * GLD) = rb[i];
}
template <int NI, bool LOWREG = false>
__device__ __forceinline__ void g_compute(f32x4 (&acc)[4][NI], const bf16* cur, int wr, int wc, int lane) {
  const int r16 = lane & 15, sw = lane & 7, q = lane >> 4;
#pragma unroll
  for (int ks = 0; ks < 2; ++ks) {
    const int pc = ((ks * 4 + q) ^ sw) * 8;
    bf16x8 a[4];
#pragma unroll
    for (int i = 0; i < 4; ++i) a[i] = *(const bf16x8*)(cur + (wr * 64 + i * 16 + r16) * GLD + pc);
#pragma unroll
    for (int jh = 0; jh < NI; jh += 2) {
      bf16x8 b[2];
#pragma unroll
      for (int j = 0; j < 2; ++j) b[j] = *(const bf16x8*)(cur + GTILE + (wc * 16 * NI + (jh + j) * 16 + r16) * GLD + pc);
#pragma unroll
      for (int i = 0; i < 4; ++i)
#pragma unroll
        for (int j = 0; j < 2; ++j) acc[i][jh + j] = mfma16(b[j], a[i], acc[i][jh + j]);
      if (LOWREG) __builtin_amdgcn_sched_barrier(0);
    }
  }
}
template <int NI, bool F8SWZ = false>
__device__ __forceinline__ void g_stage(const bf16* __restrict__ A, int lda, const bf16* __restrict__ B, int ldb, int ko, bf16* buf, int tid) {
  const int wave = tid >> 6;
  const int lrow = tid >> 3;
  const int gch = ((tid & 7) ^ (F8SWZ ? ((lrow & 6) | ((lrow >> 3) & 1)) : (lrow & 7))) * 8;
  const unsigned offA = (unsigned)((tid >> 3) * lda + gch), offB = (unsigned)((tid >> 3) * ldb + gch);
#pragma unroll
  for (int i = 0; i < 4; ++i) {
    const bf16* Ai = A + (size_t)(i * 32) * lda + ko;
    __builtin_amdgcn_global_load_lds((const unsigned*)(Ai + offA), (LDSP unsigned*)(buf + (i * 32 + wave * 8) * GLD), 16, 0, 0);
  }
#pragma unroll
  for (int i = 0; i < NI; ++i) {
    const bf16* Bi = B + (size_t)(i * 32) * ldb + ko;
    __builtin_amdgcn_global_load_lds((const unsigned*)(Bi + offB), (LDSP unsigned*)(buf + GTILE + (i * 32 + wave * 8) * GLD), 16, 0, 0);
  }
}
template <int NI, bool LOWREG = false>
__device__ __forceinline__ void gemm_accum(f32x4 (&acc)[4][NI], const bf16* __restrict__ A, int lda,
                                           const bf16* __restrict__ B, int ldb, int K, bf16* sm) {
  const int tid = tidx(), lane = tid & 63, wave = tid >> 6, wr = wave >> 1, wc = wave & 1;
  const int nk = K >> 6;
  bf16* buf0 = sm;
  bf16* buf1 = sm + 2 * GTILE;
  g_stage<NI>(A, lda, B, ldb, 0, buf0, tid);
  asm volatile("s_waitcnt vmcnt(0)" ::: "memory");
  __syncthreads();
#pragma unroll 1
  for (int kt = 0; kt < nk; kt += 2) {
    g_stage<NI>(A, lda, B, ldb, (kt + 1) * 64, buf1, tid);
    g_compute<NI, LOWREG>(acc, buf0, wr, wc, lane);
    asm volatile("s_waitcnt vmcnt(0)" ::: "memory");
    __syncthreads();
    if (kt + 2 < nk) g_stage<NI>(A, lda, B, ldb, (kt + 2) * 64, buf0, tid);
    g_compute<NI, LOWREG>(acc, buf1, wr, wc, lane);
    asm volatile("s_waitcnt vmcnt(0)" ::: "memory");
    __syncthreads();
  }
}
typedef int i32x8 __attribute__((ext_vector_type(8)));
template <int NI>
__device__ __forceinline__ void g_compute_f8(f32x4 (&acc)[4][NI], const bf16* cur, int wr, int wc, int lane) {
  const int r16 = lane & 15, sw = (r16 & 6) | (r16 >> 3), q = lane >> 4;
  const int pc0 = ((2 * q) ^ sw) * 8, pc1 = ((2 * q + 1) ^ sw) * 8;
  i32x8 b[NI];
#pragma unroll
  for (int j = 0; j < NI; ++j) {
    const bf16* rp = cur + GTILE + (wc * 16 * NI + j * 16 + r16) * GLD;
    const u32x4 lo = *(const u32x4*)(rp + pc0), hi = *(const u32x4*)(rp + pc1);
    b[j] = (i32x8){(int)lo.x, (int)lo.y, (int)lo.z, (int)lo.w, (int)hi.x, (int)hi.y, (int)hi.z, (int)hi.w};
  }
#pragma unroll
  for (int i = 0; i < 4; ++i) {
    const bf16* rp = cur + (wr * 64 + i * 16 + r16) * GLD;
    const u32x4 lo = *(const u32x4*)(rp + pc0), hi = *(const u32x4*)(rp + pc1);
    const i32x8 a = (i32x8){(int)lo.x, (int)lo.y, (int)lo.z, (int)lo.w, (int)hi.x, (int)hi.y, (int)hi.z, (int)hi.w};
#pragma unroll
    for (int j = 0; j < NI; ++j)
      acc[i][j] = __builtin_amdgcn_mfma_scale_f32_16x16x128_f8f6f4(b[j], a, acc[i][j], 0, 0, 0, 0x7F7F7F7F, 0, 0x7F7F7F7F);
  }
}
template <int NI>
__device__ __forceinline__ void gemm_accum_f8(f32x4 (&acc)[4][NI], const unsigned char* __restrict__ A8, const unsigned char* __restrict__ B8, bf16* sm) {
  const int tid = tidx(), lane = tid & 63, wave = tid >> 6, wr = wave >> 1, wc = wave & 1;
  const bf16* A = (const bf16*)A8;
  const bf16* B = (const bf16*)B8;
  bf16* buf0 = sm;
  bf16* buf1 = sm + 2 * GTILE;
  g_stage<NI, true>(A, 512, B, 512, 0, buf0, tid);
  asm volatile("s_waitcnt vmcnt(0)" ::: "memory");
  __syncthreads();
#pragma unroll 1
  for (int kt = 0; kt < 8; kt += 2) {
    g_stage<NI, true>(A, 512, B, 512, (kt + 1) * 64, buf1, tid);
    g_compute_f8<NI>(acc, buf0, wr, wc, lane);
    asm volatile("s_waitcnt vmcnt(0)" ::: "memory");
    __syncthreads();
    if (kt + 2 < 8) g_stage<NI, true>(A, 512, B, 512, (kt + 2) * 64, buf0, tid);
    g_compute_f8<NI>(acc, buf1, wr, wc, lane);
    asm volatile("s_waitcnt vmcnt(0)" ::: "memory");
    __syncthreads();
  }
}
template <int NI>
__device__ __forceinline__ void zero_acc(f32x4 (&acc)[4][NI]) {
#pragma unroll
  for (int i = 0; i < 4; ++i)
#pragma unroll
    for (int j = 0; j < NI; ++j) acc[i][j] = (f32x4){0.f, 0.f, 0.f, 0.f};
}
__device__ __forceinline__ void tile_map(int t, int ntn, int& pm, int& pn) {
  const int grp = t / (8 * ntn), w = t % (8 * ntn);
  pm = grp * 8 + (w & 7);
  pn = w >> 3;
}

__device__ __forceinline__ void transpose_tile(const float* __restrict__ src, int ld_src, int n_valid, bf16* __restrict__ dst, int ld_dst,
                               int k0, int n0, int kdst0, float* sm, unsigned char* dst8 = nullptr) {
  const int tid = tidx();
  for (int i = tid; i < 64 * 16; i += 256) {
    const int kk = i >> 4, n4 = (i & 15) * 4, n = n0 + n4;
    float4 v = make_float4(0.f, 0.f, 0.f, 0.f);
    if (n + 3 < n_valid) v = *(const float4*)(src + (size_t)(k0 + kk) * ld_src + n);
    sm[kk * 65 + n4 + 0] = v.x; sm[kk * 65 + n4 + 1] = v.y; sm[kk * 65 + n4 + 2] = v.z; sm[kk * 65 + n4 + 3] = v.w;
  }
  __syncthreads();
  for (int i = tid; i < 64 * 8; i += 256) {
    const int nn = i >> 3, kc = (i & 7) * 8;
    uint4 o;
    o.x = pack2(sm[(kc + 0) * 65 + nn], sm[(kc + 1) * 65 + nn]);
    o.y = pack2(sm[(kc + 2) * 65 + nn], sm[(kc + 3) * 65 + nn]);
    o.z = pack2(sm[(kc + 4) * 65 + nn], sm[(kc + 5) * 65 + nn]);
    o.w = pack2(sm[(kc + 6) * 65 + nn], sm[(kc + 7) * 65 + nn]);
    *(uint4*)(dst + (size_t)(n0 + nn) * ld_dst + kdst0 + kc) = o;
    if (dst8 != nullptr) {
      uint2 q8;
      int t8 = __builtin_amdgcn_cvt_pk_fp8_f32(64.f * sm[(kc + 0) * 65 + nn], 64.f * sm[(kc + 1) * 65 + nn], 0, false);
      q8.x = (unsigned)__builtin_amdgcn_cvt_pk_fp8_f32(64.f * sm[(kc + 2) * 65 + nn], 64.f * sm[(kc + 3) * 65 + nn], t8, true);
      t8 = __builtin_amdgcn_cvt_pk_fp8_f32(64.f * sm[(kc + 4) * 65 + nn], 64.f * sm[(kc + 5) * 65 + nn], 0, false);
      q8.y = (unsigned)__builtin_amdgcn_cvt_pk_fp8_f32(64.f * sm[(kc + 6) * 65 + nn], 64.f * sm[(kc + 7) * 65 + nn], t8, true);
      *(uint2*)(dst8 + (size_t)(n0 + nn - W8_ROW0) * 1024 + kdst0 + kc) = q8;
    }
  }
  __syncthreads();
}

__device__ __forceinline__ void ada_item(const Params& p, int item, float* sm) {
  const int l = item / 192, n0 = (item % 192) * 16;
  const int tid = tidx(), col = tid & 15, rg = tid >> 4;
  constexpr int SLD = 68;
  float* sW = sm + 144 * SLD;
  float acc[9];
#pragma unroll
  for (int j = 0; j < 9; ++j) acc[j] = 0.f;
  const float* W = p.ada_w + (size_t)l * 1024 * 3072 + n0;
  const int wk = tid >> 2, wc4 = (tid & 3) * 4;
  float v[36];
  float4 w0;
#define ADA_LOAD(K0)                                                                                      \
  {                                                                                                       \
    _Pragma("unroll") for (int u = 0; u < 36; ++u) {                                                      \
      const int i = tid + 256 * u, r = i >> 6, kk = i & 63;                                               \
      v[u] = 0.f;                                                                                         \
      if (r < NMOD) v[u] = (r < 4) ? p.c_prompt[r * 1024 + (K0) + kk] : p.c_sample[(r - 4) * 1024 + (K0) + kk]; \
    }                                                                                                     \
    w0 = *(const float4*)(W + (size_t)((K0) + wk) * 3072 + wc4);                                          \
  }
#define ADA_STORE()                                                                                       \
  {                                                                                                       \
    _Pragma("unroll") for (int u = 0; u < 36; ++u) {                                                      \
      const int i = tid + 256 * u, r = i >> 6, kk = i & 63;                                               \
      sm[r * SLD + kk] = siluf_(v[u]);                                                                    \
    }                                                                                                     \
    *(float4*)(sW + wk * 16 + wc4) = w0;                                                                  \
  }
  ADA_LOAD(0)
  ADA_STORE()
  __syncthreads();
#pragma unroll 1
  for (int k0 = 0; k0 < 1024; k0 += 64) {
    if (k0 + 64 < 1024) ADA_LOAD(k0 + 64)
#pragma unroll 4
    for (int k4 = 0; k4 < 16; ++k4) {
      const float x0 = sW[(k4 * 4 + 0) * 16 + col], x1 = sW[(k4 * 4 + 1) * 16 + col];
      const float x2 = sW[(k4 * 4 + 2) * 16 + col], x3 = sW[(k4 * 4 + 3) * 16 + col];
#pragma unroll
      for (int j = 0; j < 9; ++j) {
        const float4 sv = *(const float4*)(sm + (rg * 9 + j) * SLD + k4 * 4);
        acc[j] += sv.x * x0 + sv.y * x1 + sv.z * x2 + sv.w * x3;
      }
    }
    __syncthreads();
    if (k0 + 64 < 1024) ADA_STORE()
    __syncthreads();
  }
#undef ADA_LOAD
#undef ADA_STORE
  float* mod = (float*)(p.ws + WS_MOD);
  const float b = p.ada_b[l * 3072 + n0 + col];
#pragma unroll
  for (int j = 0; j < 9; ++j) {
    const int r = rg * 9 + j;
    if (r < NMOD) mod[((size_t)l * NMOD + r) * 3072 + n0 + col] = acc[j] + b;
  }
}

__device__ __forceinline__ void phase_prep(const Params& p, unsigned char* smem) {
  float* sm = (float*)smem;
  constexpr int N_WIN = 2 * 16 * (NWIN / 64);
  constexpr int N_WBR = 2 * 3 * 8 * 16;
  constexpr int N_WOUT = 2 * 16 * 16;
  constexpr int N_ALL = N_WIN + N_WBR + N_WOUT;
  bf16* WinT = (bf16*)(p.ws + WS_WIN);
  bf16* WbrT = (bf16*)(p.ws + WS_WBR);
  bf16* WoutT = (bf16*)(p.ws + WS_WOUT);
  constexpr int N_ADA = 384;
  for (int it = blockIdx.x; it < N_ADA + N_ALL; it += gridDim.x) {
    if (it < N_ADA) { ada_item(p, it, sm); continue; }
    int i = it - N_ADA;
    if (i < N_WIN) {
      const int l = i / (16 * 134), r = i % (16 * 134), kt = r / 134, nt = r % 134;
      transpose_tile(p.w_in + (size_t)l * 1024 * ZIN, ZIN, ZIN, WinT + (size_t)l * NWIN * 1024, 1024, kt * 64, nt * 64, kt * 64, sm,
                     (nt * 64 >= W8_ROW0) ? p.ws + WS_W8 + (size_t)l * W8_ROWS * 1024 : nullptr);
      continue;
    }
    i -= N_WIN;
    if (i < N_WBR) {
      const int l = i / 384, r = i % 384, seg = r / 128, r2 = r % 128, kt = r2 / 16, nt = r2 % 16;
      const float* src = (seg == 0 ? p.w_a : seg == 1 ? p.w_b : p.w_c) + (size_t)l * 512 * 1024;
      transpose_tile(src, 1024, 1024, WbrT + (size_t)l * 1024 * 1536, 1536, kt * 64, nt * 64, seg * 512 + kt * 64, sm);
      continue;
    }
    i -= N_WBR;
    {
      const int l = i / 256, r = i % 256, kt = r / 16, nt = r % 16;
      transpose_tile(p.w_out + (size_t)l * 1024 * 1024, 1024, 1024, WoutT + (size_t)l * 1024 * 1024, 1024, kt * 64, nt * 64, kt * 64, sm);
    }
  }
}

__device__ __forceinline__ const float* xrow_ptr(const Params& p, int l, int row) {
  if (l == 0) return row < TP ? p.x_prompt + (size_t)row * D : p.x_sample + (size_t)(row - TP) * D;
  return p.out + (size_t)row * D;
}
__device__ __forceinline__ int mod_row(int row) { return row < TP ? (row >> 12) : 4 + ((row - TP) >> 3); }

__device__ __forceinline__ void phase_norm(const Params& p, int l) {
  const int lane = tidx() & 63, wave = tidx() >> 6;
  bf16* hbuf = (bf16*)(p.ws + WS_H);
  unsigned char* h8 = p.ws + WS_H8;
  const float* mod = (const float*)(p.ws + WS_MOD);
  const float* g = p.norm_g + l * D;
  for (int row = blockIdx.x * 4 + wave; row < TT; row += gridDim.x * 4) {
    const float4* x = (const float4*)xrow_ptr(p, l, row);
    float4 v[4];
    float ss = 0.f;
#pragma unroll
    for (int i = 0; i < 4; ++i) {
      v[i] = x[lane + 64 * i];
      ss += v[i].x * v[i].x + v[i].y * v[i].y + v[i].z * v[i].z + v[i].w * v[i].w;
    }
    ss = wave_sum(ss);
    const float rstd = rsqrtf(ss * (1.0f / D) + EPS);
    const float* mp = mod + ((size_t)l * NMOD + mod_row(row)) * 3072;
#pragma unroll
    for (int i = 0; i < 4; ++i) {
      const int c = (lane + 64 * i) * 4;
      const float4 gg = *(const float4*)(g + c), sh = *(const float4*)(mp + c), sc = *(const float4*)(mp + 1024 + c);
      uint2 o;
      o.x = pack2(v[i].x * rstd * gg.x * (1.f + sc.x) + sh.x, v[i].y * rstd * gg.y * (1.f + sc.y) + sh.y);
      o.y = pack2(v[i].z * rstd * gg.z * (1.f + sc.z) + sh.z, v[i].w * rstd * gg.w * (1.f + sc.w) + sh.w);
      *(uint2*)(hbuf + (size_t)row * D + c) = o;
      int p8 = __builtin_amdgcn_cvt_pk_fp8_f32(v[i].x * rstd * gg.x * (1.f + sc.x) + sh.x, v[i].y * rstd * gg.y * (1.f + sc.y) + sh.y, 0, false);
      p8 = __builtin_amdgcn_cvt_pk_fp8_f32(v[i].z * rstd * gg.z * (1.f + sc.z) + sh.z, v[i].w * rstd * gg.w * (1.f + sc.w) + sh.w, p8, true);
      *(int*)(h8 + (size_t)row * D + c) = p8;
    }
  }
}

__device__ __forceinline__ void phase_gemm_in(const Params& p, int l, int col0, int ntn, int ldz, unsigned char* smem) {
  bf16* sm = (bf16*)smem;
  const bf16* hbuf = (const bf16*)(p.ws + WS_H);
  const bf16* W = (const bf16*)(p.ws + WS_WIN) + (size_t)l * NWIN * 1024;
  bf16* z = (bf16*)(p.ws + WS_Z);
  const float* bias = p.b_in + (size_t)l * ZIN;
  const int tid = tidx(), lane = tid & 63, wave = tid >> 6, wr = wave >> 1, wc = wave & 1;
  const int ntiles = (TT / 128) * ntn;
  constexpr int OLD = 136;
  const bool isAB = (col0 == 0);
  const int nb = isAB ? 6 : 13;
  const int NB = (TT / 128) * nb;
  for (int t = blockIdx.x; t < ntiles; t += gridDim.x) {
    const bool f8 = t >= NB;
    int pm, pk;
    tile_map(f8 ? t - NB : t, f8 ? ntn - nb : nb, pm, pk);
    int pn;
    if (isAB) pn = f8 ? (pk < 4 ? pk : pk < 12 ? pk + 4 : pk + 6) : (pk < 4 ? 4 + pk : 12 + pk);
    else pn = f8 ? 13 + pk : pk;
    const int m0 = pm * 128, n0 = pn * 128;
    f32x4 acc[4][4];
    zero_acc<4>(acc);
    float osc = 1.0f;
    if (f8) {
      gemm_accum_f8<4>(acc, p.ws + WS_H8 + (size_t)m0 * 1024, p.ws + WS_W8 + ((size_t)l * W8_ROWS + col0 + n0) * 1024, sm);
      osc = 0.015625f;
    } else {
      gemm_accum<4>(acc, hbuf + (size_t)m0 * 1024, 1024, W + (size_t)(col0 + n0) * 1024, 1024, 1024, sm);
    }
#pragma unroll
    for (int j = 0; j < 4; ++j) {
      const int cl = wc * 64 + j * 16 + (lane >> 4) * 4;
      const float4 b = *(const float4*)(bias + col0 + n0 + cl);
#pragma unroll
      for (int i = 0; i < 4; ++i) {
        const int rl = wr * 64 + i * 16 + (lane & 15);
        uint2 o;
        o.x = pack2(acc[i][j][0] * osc + b.x, acc[i][j][1] * osc + b.y);
        o.y = pack2(acc[i][j][2] * osc + b.z, acc[i][j][3] * osc + b.w);
        *(uint2*)(sm + rl * OLD + cl) = o;
      }
    }
    __syncthreads();
#pragma unroll
    for (int it = 0; it < 8; ++it) {
      const int id = tid + 256 * it, row = id >> 4, ch = id & 15;
      const u32x4 v = *(const u32x4*)(sm + row * OLD + ch * 8);
      *(u32x4*)(z + (size_t)(m0 + row) * ldz + n0 + ch * 8) = v;
    }
    __syncthreads();
  }
}

__device__ __forceinline__ void gmlp_prompt_item(const Params& p, int l, int item, unsigned char* smem) {
  const int b = item >> 7, n = (item >> 2) & 31, g = item & 3;
  const int r0 = b * SEQ + n * 128;
  const bf16* z = (const bf16*)(p.ws + WS_Z);
  bf16* yab = (bf16*)(p.ws + WS_YAB);
  bf16* sW = (bf16*)smem;
  bf16* sV = (bf16*)(smem + 34816);
  float* srstd = (float*)(smem + 69632);
  const int tid = tidx(), lane = tid & 63, wave = tid >> 6, wr = wave >> 1, wc = wave & 1;
  {
    const int tok = tid >> 1, half = tid & 1;
    const uint4* ptr = (const uint4*)(z + (size_t)(r0 + tok) * ZAB + OFF_AV + half * 256);
    float ss = 0.f;
    for (int i = 0; i < 32; ++i) {
      float f[8];
      unpack8(ptr[i], f);
#pragma unroll
      for (int j = 0; j < 8; ++j) ss += f[j] * f[j];
    }
    ss += __shfl_xor(ss, 1);
    if (half == 0) srstd[tok] = rsqrtf(ss * (1.0f / 512.f) + EPS);
  }
  __syncthreads();
  const float* vg = p.vnorm_g + l * 512 + g * 128;
  for (int i = tid; i < 2048; i += 256) {
    const int s = i >> 4, c8 = (i & 15) * 8;
    float f[8];
    unpack8(*(const uint4*)(z + (size_t)(r0 + s) * ZAB + OFF_AV + g * 128 + c8), f);
    const float rs = srstd[s];
#pragma unroll
    for (int j = 0; j < 8; ++j) sV[(c8 + j) * 136 + s] = f2bf(f[j] * rs * vg[c8 + j]);
  }
  const float* Wg = p.gmlp_ws + ((size_t)(l * 4 + g)) * 128 * 128;
  for (int i = tid; i < 4096; i += 256) {
    const int t = i >> 5, s4 = (i & 31) * 4;
    const float4 w = *(const float4*)(Wg + t * 128 + s4);
    uint2 o;
    o.x = pack2(s4 + 0 <= t ? w.x : 0.f, s4 + 1 <= t ? w.y : 0.f);
    o.y = pack2(s4 + 2 <= t ? w.z : 0.f, s4 + 3 <= t ? w.w : 0.f);
    *(uint2*)(sW + t * 136 + s4) = o;
  }
  __syncthreads();
  f32x4 acc[4][4];
  zero_acc<4>(acc);
  mma_lds<4, 4>(acc, sW + wr * 64 * 136, 136, sV + wc * 64 * 136, 136, wr * 64 + 64, lane);
  const float* bs = p.gmlp_bs + (l * 4 + g) * 128;
#pragma unroll
  for (int i = 0; i < 4; ++i) {
    const int t = wr * 64 + i * 16 + (lane & 15);
    const float bst = bs[t];
    const size_t rowoff = (size_t)(r0 + t) * ZAB;
#pragma unroll
    for (int j = 0; j < 4; ++j) {
      const int c = g * 128 + wc * 64 + j * 16 + (lane >> 4) * 4;
      float u[4], ag[4];
      unpack4(*(const uint2*)(z + rowoff + c), u);
      unpack4(*(const uint2*)(z + rowoff + OFF_AG + c), ag);
      uint2 o;
      o.x = pack2(u[0] * (acc[i][j][0] + bst) * siluf_(ag[0]), u[1] * (acc[i][j][1] + bst) * siluf_(ag[1]));
      o.y = pack2(u[2] * (acc[i][j][2] + bst) * siluf_(ag[2]), u[3] * (acc[i][j][3] + bst) * siluf_(ag[3]));
      *(uint2*)(yab + (size_t)(r0 + t) * 1024 + c) = o;
    }
  }
  __syncthreads();
}

__device__ __forceinline__ void gmlp_sample_item(const Params& p, int l, int b, unsigned char* smem) {
  const int r0 = TP + b * 8;
  const bf16* z = (const bf16*)(p.ws + WS_Z);
  bf16* yab = (bf16*)(p.ws + WS_YAB);
  float* svn = (float*)smem;
  const int tid = tidx(), lane = tid & 63, wave = tid >> 6;
  const float* vg = p.vnorm_g + l * 512;
  for (int tt = 0; tt < 2; ++tt) {
    const int t = wave * 2 + tt;
    float f[8];
    unpack8(*(const uint4*)(z + (size_t)(r0 + t) * ZAB + OFF_AV + lane * 8), f);
    float ss = 0.f;
#pragma unroll
    for (int j = 0; j < 8; ++j) ss += f[j] * f[j];
    ss = wave_sum(ss);
    const float rstd = rsqrtf(ss * (1.0f / 512.f) + EPS);
    float* gv = p.out + O_GV + (((size_t)l * 128 + b) * 8 + t) * 512 + lane * 8;
#pragma unroll
    for (int j = 0; j < 8; ++j) {
      const float vn = f[j] * rstd * vg[lane * 8 + j];
      svn[t * 512 + lane * 8 + j] = vn;
      gv[j] = vn;
    }
  }
  __syncthreads();
  {
    const int c = tid * 2, g = c >> 7;
    const float* Wg = p.gmlp_ws + ((size_t)(l * 4 + g)) * 128 * 128;
    const float* bs = p.gmlp_bs + (l * 4 + g) * 128;
    for (int t = 0; t < 8; ++t) {
      float s0 = bs[t], s1 = bs[t];
      for (int s = 0; s <= t; ++s) {
        const float w = Wg[t * 128 + s];
        s0 += w * svn[s * 512 + c];
        s1 += w * svn[s * 512 + c + 1];
      }
      const unsigned uu = *(const unsigned*)(z + (size_t)(r0 + t) * ZAB + c);
      const unsigned gg = *(const unsigned*)(z + (size_t)(r0 + t) * ZAB + OFF_AG + c);
      *(unsigned*)(yab + (size_t)(r0 + t) * 1024 + c) = pack2(lo2f(uu) * s0 * siluf_(lo2f(gg)), hi2f(uu) * s1 * siluf_(hi2f(gg)));
    }
  }
  __syncthreads();
}

__device__ __forceinline__ void swa_prompt_item(const Params& p, int l, int item, unsigned char* smem) {
  const int b = item >> 7, qt = (item >> 1) & 63, kv = item & 1;
  const int q0 = qt * 64, rb = b * SEQ;
  const bf16* z = (const bf16*)(p.ws + WS_Z);
  bf16* yab = (bf16*)(p.ws + WS_YAB);
  bf16* sK = (bf16*)smem;
  bf16* sVT = (bf16*)(smem + 27648);
  const int tid = tidx(), lane = tid & 63, wave = tid >> 6;
  const float* kg = p.kn_g + l * 64;
  const float* qg = p.qn_g + l * 64;
#pragma unroll 1
  for (int it = 0; it < 6; ++it) {
    const int id = tid + 256 * it, kk = id >> 3, ch = id & 7, kp = q0 - 128 + kk;
    float f[8];
    uint4 vraw = make_uint4(0, 0, 0, 0);
    if (kp >= 0) {
      unpack8(*(const uint4*)(z + (size_t)(rb + kp) * ZAB + OFF_BK + kv * 64 + ch * 8), f);
      vraw = *(const uint4*)(z + (size_t)(rb + kp) * ZAB + OFF_BV + kv * 64 + ch * 8);
    } else {
#pragma unroll
      for (int j = 0; j < 8; ++j) f[j] = 0.f;
    }
    float ss = 0.f;
#pragma unroll
    for (int j = 0; j < 8; ++j) ss += f[j] * f[j];
    ss += __shfl_xor(ss, 1); ss += __shfl_xor(ss, 2); ss += __shfl_xor(ss, 4);
    const float rstd = rsqrtf(ss * (1.0f / 64.f) + EPS);
#pragma unroll
    for (int j = 0; j < 8; ++j) f[j] = f[j] * rstd * kg[ch * 8 + j];
    uint4 ko;
    ko.x = pack2(f[0], f[1]); ko.y = pack2(f[2], f[3]); ko.z = pack2(f[4], f[5]); ko.w = pack2(f[6], f[7]);
    *(uint4*)(sK + kk * 72 + ch * 8) = ko;
    float vf[8];
    unpack8(vraw, vf);
#pragma unroll
    for (int j = 0; j < 8; ++j) sVT[(ch * 8 + j) * 200 + kk] = f2bf(vf[j]);
    if (kk >= 128 && kp >= SEQ - 128) {
      const size_t o = ((((size_t)l * 4 + b) * 128 + (kp - (SEQ - 128))) * 2 + kv) * 64 + ch * 8;
#pragma unroll
      for (int j = 0; j < 8; ++j) { p.out[O_SKP + o + j] = f[j]; p.out[O_SVP + o + j] = vf[j]; }
    }
  }
  __syncthreads();
  const int h = kv * 4 + wave;
  const float sink = p.sinks[l * 8 + h];
  const int g4 = lane >> 4, r16 = lane & 15;
#pragma unroll 1
  for (int i = 0; i < 4; ++i) {
    const int qrow = q0 + i * 16 + r16;
    const size_t grow = (size_t)(rb + qrow);
    bf16x8 qf[2];
    {
      float f0[8], f1[8];
      unpack8(*(const uint4*)(z + grow * ZAB + OFF_BQ + h * 64 + g4 * 8), f0);
      unpack8(*(const uint4*)(z + grow * ZAB + OFF_BQ + h * 64 + 32 + g4 * 8), f1);
      float ss = 0.f;
#pragma unroll
      for (int j = 0; j < 8; ++j) ss += f0[j] * f0[j] + f1[j] * f1[j];
      ss += __shfl_xor(ss, 16); ss += __shfl_xor(ss, 32);
      const float rstd = rsqrtf(ss * (1.0f / 64.f) + EPS) * 0.125f;
#pragma unroll
      for (int j = 0; j < 8; ++j) {
        qf[0][j] = (short)f2bf(f0[j] * rstd * qg[g4 * 8 + j]);
        qf[1][j] = (short)f2bf(f1[j] * rstd * qg[32 + g4 * 8 + j]);
      }
    }
    f32x4 st[12];
#pragma unroll
    for (int kt = 0; kt < 12; ++kt) {
      st[kt] = (f32x4){0.f, 0.f, 0.f, 0.f};
#pragma unroll
      for (int ks = 0; ks < 2; ++ks) {
        const bf16x8 kf = *(const bf16x8*)(sK + (kt * 16 + r16) * 72 + ks * 32 + g4 * 8);
        st[kt] = mfma16(kf, qf[ks], st[kt]);
      }
      if ((kt & 1) == 1) __builtin_amdgcn_sched_barrier(0);
    }
    float mx = -INFINITY;
#pragma unroll
    for (int kt = 0; kt < 12; ++kt)
#pragma unroll
      for (int x = 0; x < 4; ++x) {
        const int kp = q0 - 128 + kt * 16 + g4 * 4 + x, diff = qrow - kp;
        const bool valid = (kp >= 0) && (diff >= 0) && (diff < 128);
        st[kt][x] = valid ? st[kt][x] : -INFINITY;
        mx = fmaxf(mx, st[kt][x]);
      }
    mx = fmaxf(mx, __shfl_xor(mx, 16)); mx = fmaxf(mx, __shfl_xor(mx, 32));
    mx = fmaxf(mx, sink);
    float sum = 0.f;
#pragma unroll
    for (int kt = 0; kt < 12; ++kt)
#pragma unroll
      for (int x = 0; x < 4; ++x) {
        const float pv = __expf(st[kt][x] - mx);
        st[kt][x] = pv;
        sum += pv;
      }
    sum += __shfl_xor(sum, 16); sum += __shfl_xor(sum, 32);
    const float inv = 1.0f / (sum + __expf(sink - mx));
    f32x4 o[4];
#pragma unroll
    for (int dt = 0; dt < 4; ++dt) o[dt] = (f32x4){0.f, 0.f, 0.f, 0.f};
#pragma unroll
    for (int t2 = 0; t2 < 6; ++t2) {
      bf16x8 pf;
#pragma unroll
      for (int x = 0; x < 4; ++x) { pf[x] = (short)f2bf(st[2 * t2][x]); pf[4 + x] = (short)f2bf(st[2 * t2 + 1][x]); }
#pragma unroll
      for (int dt = 0; dt < 4; ++dt) {
        const uint2 v0 = *(const uint2*)(sVT + (dt * 16 + r16) * 200 + t2 * 32 + g4 * 4);
        const uint2 v1 = *(const uint2*)(sVT + (dt * 16 + r16) * 200 + t2 * 32 + 16 + g4 * 4);
        union { uint4 u; bf16x8 v; } cv;
        cv.u = make_uint4(v0.x, v0.y, v1.x, v1.y);
        o[dt] = mfma16(cv.v, pf, o[dt]);
      }
      __builtin_amdgcn_sched_barrier(0);
    }
#pragma unroll
    for (int dt = 0; dt < 4; ++dt) {
      const int d0 = dt * 16 + g4 * 4;
      float bg[4];
      unpack4(*(const uint2*)(z + grow * ZAB + OFF_BG + h * 64 + d0), bg);
      uint2 oo;
      oo.x = pack2(o[dt][0] * inv * siluf_(bg[0]), o[dt][1] * inv * siluf_(bg[1]));
      oo.y = pack2(o[dt][2] * inv * siluf_(bg[2]), o[dt][3] * inv * siluf_(bg[3]));
      *(uint2*)(yab + grow * 1024 + 512 + h * 64 + d0) = oo;
    }
  }
  __syncthreads();
}

__device__ __forceinline__ void swa_sample_item(const Params& p, int l, int item, unsigned char* smem) {
  const int b = item >> 1, kv = item & 1;
  const int r0 = TP + b * 8;
  const bf16* z = (const bf16*)(p.ws + WS_Z);
  bf16* yab = (bf16*)(p.ws + WS_YAB);
  bf16* sK = (bf16*)smem;
  bf16* sV = (bf16*)(smem + 19584);
  float* sq = (float*)(smem + 39168);
  float* sP = (float*)(smem + 47488);
  const int tid = tidx();
  const float* kg = p.kn_g + l * 64;
  const float* qg = p.qn_g + l * 64;
  const float* ck = p.cache_k + ((size_t)l * 128 + b) * 128 * 128;
  const float* cvp = p.cache_v + ((size_t)l * 128 + b) * 128 * 128;
#pragma unroll 1
  for (int it = 0; it < 5; ++it) {
    const int id = tid + 256 * it, j = id >> 3, ch = id & 7;
    const bool act = id < 1088;
    float kf[8], vf[8];
#pragma unroll
    for (int x = 0; x < 8; ++x) { kf[x] = 0.f; vf[x] = 0.f; }
    if (act) {
      if (j < 128) {
        const float4 a0 = *(const float4*)(ck + (j * 2 + kv) * 64 + ch * 8), a1 = *(const float4*)(ck + (j * 2 + kv) * 64 + ch * 8 + 4);
        const float4 b0 = *(const float4*)(cvp + (j * 2 + kv) * 64 + ch * 8), b1 = *(const float4*)(cvp + (j * 2 + kv) * 64 + ch * 8 + 4);
        kf[0] = a0.x; kf[1] = a0.y; kf[2] = a0.z; kf[3] = a0.w; kf[4] = a1.x; kf[5] = a1.y; kf[6] = a1.z; kf[7] = a1.w;
        vf[0] = b0.x; vf[1] = b0.y; vf[2] = b0.z; vf[3] = b0.w; vf[4] = b1.x; vf[5] = b1.y; vf[6] = b1.z; vf[7] = b1.w;
      } else {
        unpack8(*(const uint4*)(z + (size_t)(r0 + j - 128) * ZAB + OFF_BK + kv * 64 + ch * 8), kf);
        unpack8(*(const uint4*)(z + (size_t)(r0 + j - 128) * ZAB + OFF_BV + kv * 64 + ch * 8), vf);
      }
    }
    float ss = 0.f;
#pragma unroll
    for (int x = 0; x < 8; ++x) ss += kf[x] * kf[x];
    ss += __shfl_xor(ss, 1); ss += __shfl_xor(ss, 2); ss += __shfl_xor(ss, 4);
    if (act) {
      if (j >= 128) {
        const float rstd = rsqrtf(ss * (1.0f / 64.f) + EPS);
#pragma unroll
        for (int x = 0; x < 8; ++x) kf[x] = kf[x] * rstd * kg[ch * 8 + x];
      }
      uint4 ko, vo;
      ko.x = pack2(kf[0], kf[1]); ko.y = pack2(kf[2], kf[3]); ko.z = pack2(kf[4], kf[5]); ko.w = pack2(kf[6], kf[7]);
      vo.x = pack2(vf[0], vf[1]); vo.y = pack2(vf[2], vf[3]); vo.z = pack2(vf[4], vf[5]); vo.w = pack2(vf[6], vf[7]);
      *(uint4*)(sK + j * 72 + ch * 8) = ko;
      *(uint4*)(sV + j * 72 + ch * 8) = vo;
      if (j >= 8) {
        const size_t o = ((((size_t)l * 128 + b) * 128 + (j - 8)) * 2 + kv) * 64 + ch * 8;
        *(float4*)(p.out + O_SKS + o) = make_float4(kf[0], kf[1], kf[2], kf[3]);
        *(float4*)(p.out + O_SKS + o + 4) = make_float4(kf[4], kf[5], kf[6], kf[7]);
        *(float4*)(p.out + O_SVS + o) = make_float4(vf[0], vf[1], vf[2], vf[3]);
        *(float4*)(p.out + O_SVS + o + 4) = make_float4(vf[4], vf[5], vf[6], vf[7]);
      }
    }
  }
  const int qi = tid >> 3, sub = tid & 7, t = qi >> 2, h = kv * 4 + (qi & 3);
  {
    float f[8];
    unpack8(*(const uint4*)(z + (size_t)(r0 + t) * ZAB + OFF_BQ + h * 64 + sub * 8), f);
    float ss = 0.f;
#pragma unroll
    for (int x = 0; x < 8; ++x) ss += f[x] * f[x];
    ss += __shfl_xor(ss, 1); ss += __shfl_xor(ss, 2); ss += __shfl_xor(ss, 4);
    const float rstd = rsqrtf(ss * (1.0f / 64.f) + EPS) * 0.125f;
#pragma unroll
    for (int x = 0; x < 8; ++x) sq[qi * 65 + sub * 8 + x] = f[x] * rstd * qg[sub * 8 + x];
  }
  __syncthreads();
  const float sink = p.sinks[l * 8 + h];
  float mx = -INFINITY;
#pragma unroll 1
  for (int jj = 0; jj < 17; ++jj) {
    const int key = sub + 8 * jj;
    float s = 0.f;
#pragma unroll 8
    for (int d = 0; d < 64; ++d) s += sq[qi * 65 + d] * bf2f(sK[key * 72 + d]);
    const bool valid = (key >= t + 1) && (key <= t + 128);
    s = valid ? s : -INFINITY;
    sP[qi * 140 + key] = s;
    mx = fmaxf(mx, s);
  }
  mx = fmaxf(mx, __shfl_xor(mx, 1)); mx = fmaxf(mx, __shfl_xor(mx, 2)); mx = fmaxf(mx, __shfl_xor(mx, 4));
  mx = fmaxf(mx, sink);
  float sum = 0.f;
  for (int jj = 0; jj < 17; ++jj) {
    const int key = sub + 8 * jj;
    const float pv = __expf(sP[qi * 140 + key] - mx);
    sP[qi * 140 + key] = pv;
    sum += pv;
  }
  sum += __shfl_xor(sum, 1); sum += __shfl_xor(sum, 2); sum += __shfl_xor(sum, 4);
  const float inv = 1.0f / (sum + __expf(sink - mx));
  __syncthreads();
  {
    float o[8];
#pragma unroll
    for (int x = 0; x < 8; ++x) o[x] = 0.f;
#pragma unroll 2
    for (int key = 0; key < 136; ++key) {
      const float pv = sP[qi * 140 + key];
      float vf[8];
      unpack8(*(const uint4*)(sV + key * 72 + sub * 8), vf);
#pragma unroll
      for (int x = 0; x < 8; ++x) o[x] += pv * vf[x];
    }
    float bg[8];
    unpack8(*(const uint4*)(z + (size_t)(r0 + t) * ZAB + OFF_BG + h * 64 + sub * 8), bg);
    uint4 oo;
    oo.x = pack2(o[0] * inv * siluf_(bg[0]), o[1] * inv * siluf_(bg[1]));
    oo.y = pack2(o[2] * inv * siluf_(bg[2]), o[3] * inv * siluf_(bg[3]));
    oo.z = pack2(o[4] * inv * siluf_(bg[4]), o[5] * inv * siluf_(bg[5]));
    oo.w = pack2(o[6] * inv * siluf_(bg[6]), o[7] * inv * siluf_(bg[7]));
    *(uint4*)(yab + (size_t)(r0 + t) * 1024 + 512 + h * 64 + sub * 8) = oo;
  }
  __syncthreads();
}

__device__ __forceinline__ void phase_mix_ab(const Params& p, int l, unsigned char* smem) {
  constexpr int N_SWA = 512, N_GM = 512, N_SWS = 256, N_GMS = 128;
  constexpr int N_ALL = N_SWA + N_GM + N_SWS + N_GMS;
  for (int it = blockIdx.x; it < N_ALL; it += gridDim.x) {
    int i = it;
    if (i < N_SWA) { swa_prompt_item(p, l, i, smem); continue; }
    i -= N_SWA;
    if (i < N_GM) { gmlp_prompt_item(p, l, i, smem); continue; }
    i -= N_GM;
    if (i < N_SWS) { swa_sample_item(p, l, i, smem); continue; }
    i -= N_SWS;
    gmlp_sample_item(p, l, i, smem);
  }
}

__device__ __forceinline__ void conv8_prompt(const Params& p, int l, const bf16* z, int r0, int pos0, int s, int zc, float* y) {
  const float* cw = p.conv_w + (size_t)l * 4 * 1024 + zc;
  const float* cb = p.conv_b + l * 1024 + zc;
#pragma unroll
  for (int j = 0; j < 8; ++j) y[j] = cb[j];
#pragma unroll
  for (int tap = 0; tap < 4; ++tap) {
    const int back = 3 - tap;
    if (pos0 + s - back >= 0) {
      float f[8];
      unpack8(*(const uint4*)(z + (size_t)(r0 + s - back) * ZC + C_QK + zc), f);
#pragma unroll
      for (int j = 0; j < 8; ++j) y[j] += cw[tap * 1024 + j] * f[j];
    }
  }
#pragma unroll
  for (int j = 0; j < 8; ++j) y[j] = siluf_(y[j]);
}

__device__ __forceinline__ void chunk_gates(const Params& p, int l, const bf16* z, int r0, int hh, int lane, float& cum, float& iv) {
  const float f = bf2f(z[(size_t)(r0 + lane) * ZC + C_F + hh]) + p.f_bias[l * 4 + hh];
  iv = bf2f(z[(size_t)(r0 + lane) * ZC + C_I + hh]);
  float c = logsigmoidf_(f);
#pragma unroll
  for (int o = 1; o < 64; o <<= 1) {
    const float n = __shfl_up(c, o);
    if (lane >= o) c += n;
  }
  cum = c;
}

__device__ __forceinline__ void mlstm_local_item(const Params& p, int l, int item, unsigned char* smem) {
  const int bh = item >> 6, c = item & 63, b = bh >> 2, hh = bh & 3;
  const int r0 = b * SEQ + c * 64;
  const bf16* z = (const bf16*)(p.ws + WS_Z);
  bf16* skT = (bf16*)smem;
  bf16* svT = (bf16*)(smem + 18432);
  float* swsel = (float*)(smem + 36864);
  const int tid = tidx(), lane = tid & 63, wave = tid >> 6, wr = wave >> 1, wc = wave & 1;
  if (wave == 0) {
    float cum, iv;
    chunk_gates(p, l, z, r0, hh, lane, cum, iv);
    const float total = __shfl(cum, 63);
    const float g = total - cum + iv;
    const float G = wave_max(g);
    swsel[lane] = __expf(g - G);
    if (lane == 0) {
      ((float*)(p.ws + WS_G))[item] = G;
      ((float*)(p.ws + WS_TOT))[item] = total;
    }
  }
  __syncthreads();
  for (int i = tid; i < 1024; i += 256) {
    const int s = i >> 4, d8 = (i & 15) * 8;
    float y[8];
    conv8_prompt(p, l, z, r0, c * 64, s, 512 + hh * 128 + d8, y);
    const float sc = 0.08838834764831845f * swsel[s];
#pragma unroll
    for (int j = 0; j < 8; ++j) skT[(d8 + j) * 72 + s] = f2bf(y[j] * sc);
    float v[8];
    unpack8(*(const uint4*)(z + (size_t)(r0 + s) * ZC + C_V + hh * 128 + d8), v);
#pragma unroll
    for (int j = 0; j < 8; ++j) svT[(d8 + j) * 72 + s] = f2bf(v[j]);
  }
  __syncthreads();
  f32x4 acc[4][4];
  zero_acc<4>(acc);
  mma_lds<4, 4>(acc, svT + wr * 64 * 72, 72, skT + wc * 64 * 72, 72, 64, lane);
  bf16* U = (bf16*)(p.ws + WS_U) + (size_t)item * 16384;
#pragma unroll
  for (int i = 0; i < 4; ++i)
#pragma unroll
    for (int j = 0; j < 4; ++j) {
      const int e = wr * 64 + i * 16 + (lane & 15), d = wc * 64 + j * 16 + (lane >> 4) * 4;
      uint2 o;
      o.x = pack2(acc[i][j][0], acc[i][j][1]);
      o.y = pack2(acc[i][j][2], acc[i][j][3]);
      *(uint2*)(U + e * 128 + d) = o;
    }
  if (tid < 128) {
    float s = 0.f;
    for (int k = 0; k < 64; ++k) s += bf2f(skT[tid * 72 + k]);
    ((float*)(p.ws + WS_UN))[(size_t)item * 128 + tid] = s;
  }
  __syncthreads();
}

__device__ __forceinline__ void mlstm_convout_item(const Params& p, int l, int b) {
  const bf16* z = (const bf16*)(p.ws + WS_Z);
  for (int i = tidx(); i < 3 * 1024; i += 256) {
    const int j = i >> 10, ch = i & 1023;
    p.out[O_CVP + (((size_t)l * 4 + b) * 3 + j) * 1024 + ch] = bf2f(z[(size_t)(b * SEQ + SEQ - 3 + j) * ZC + C_QK + ch]);
  }
}

__device__ __forceinline__ void mlstm_sample_item(const Params& p, int l, int item, unsigned char* smem) {
  const int b = item >> 2, hh = item & 3;
  const int r0 = TP + b * 8;
  bf16* z = (bf16*)(p.ws + WS_Z);
  float* sq = (float*)smem;
  float* sk = sq + 1024;
  float* sv = sk + 1024;
  float* sh = sv + 1024;
  float* sint = sh + 1024;
  float* sa = sint + 2048;
  float* sqn = sa + 64;
  float* smt = sqn + 8;
  float* swi = smt + 8;
  float* swsel = swi + 8;
  float* sdm = swsel + 8;
  float* sdecay = sdm + 64;
  const int tid = tidx(), lane = tid & 63, wave = tid >> 6;
  {
    const int isk = tid >> 7, d = tid & 127, zc = isk * 512 + hh * 128 + d;
    const float* cw = p.conv_w + (size_t)l * 4 * 1024 + zc;
    const float cb = p.conv_b[l * 1024 + zc];
    float xp[11];
    const float* cs = p.st_conv + ((size_t)l * 128 + b) * 3 * 1024 + zc;
    xp[0] = cs[0]; xp[1] = cs[1024]; xp[2] = cs[2048];
#pragma unroll
    for (int t = 0; t < 8; ++t) xp[3 + t] = bf2f(z[(size_t)(r0 + t) * ZC + C_QK + zc]);
    const float w0 = cw[0], w1 = cw[1024], w2 = cw[2048], w3 = cw[3072];
    float* dst = isk ? sk : sq;
    const float sc = isk ? 0.08838834764831845f : 1.0f;
#pragma unroll
    for (int t = 0; t < 8; ++t) {
      const float y = cb + w0 * xp[t] + w1 * xp[t + 1] + w2 * xp[t + 2] + w3 * xp[t + 3];
      dst[t * 128 + d] = siluf_(y) * sc;
    }
    float* co = p.out + O_CVS + ((size_t)l * 128 + b) * 3 * 1024 + zc;
    co[0] = xp[8]; co[1024] = xp[9]; co[2048] = xp[10];
  }
  for (int i = tid; i < 1024; i += 256) {
    const int t = i >> 7, e = i & 127;
    sv[i] = bf2f(z[(size_t)(r0 + t) * ZC + C_V + hh * 128 + e]);
  }
  if (tid == 0) {
    float cum[8], iv[8];
    float c = 0.f;
    for (int t = 0; t < 8; ++t) {
      const float f = bf2f(z[(size_t)(r0 + t) * ZC + C_F + hh]) + p.f_bias[l * 4 + hh];
      c += logsigmoidf_(f);
      cum[t] = c;
      iv[t] = bf2f(z[(size_t)(r0 + t) * ZC + C_I + hh]);
    }
    const float m0 = p.st_m[(l * 128 + b) * 4 + hh];
    for (int t = 0; t < 8; ++t) {
      float dmax = -INFINITY;
      for (int s = 0; s <= t; ++s) dmax = fmaxf(dmax, cum[t] - cum[s] + iv[s]);
      const float mi = cum[t] + m0, mt = fmaxf(mi, dmax);
      smt[t] = mt;
      swi[t] = __expf(mi - mt);
      for (int s = 0; s < 8; ++s) sdm[t * 8 + s] = (s <= t) ? __expf(cum[t] - cum[s] + iv[s] - mt) : 0.f;
    }
    const float total = cum[7];
    float gm = -INFINITY;
    for (int s = 0; s < 8; ++s) gm = fmaxf(gm, total - cum[s] + iv[s]);
    const float mn = fmaxf(total + m0, gm);
    for (int s = 0; s < 8; ++s) swsel[s] = __expf(total - cum[s] + iv[s] - mn);
    sdecay[0] = __expf(total + m0 - mn);
    p.out[O_MS + (l * 128 + b) * 4 + hh] = mn;
  }
  __syncthreads();
  const float* n0 = p.st_n + (((size_t)l * 128 + b) * 4 + hh) * 128;
  if (tid < 64) {
    const int t = tid >> 3, s = tid & 7;
    float dsum = 0.f;
    for (int d = 0; d < 128; ++d) dsum += sq[t * 128 + d] * sk[s * 128 + d];
    sa[t * 8 + s] = sdm[t * 8 + s] * dsum;
  } else if (tid < 128) {
    const int t = (tid - 64) >> 3, part = (tid - 64) & 7;
    float dsum = 0.f;
    for (int d = part * 16; d < part * 16 + 16; ++d) dsum += sq[t * 128 + d] * n0[d];
    dsum += __shfl_xor(dsum, 1); dsum += __shfl_xor(dsum, 2); dsum += __shfl_xor(dsum, 4);
    if (part == 0) sqn[t] = dsum;
  }
  __syncthreads();
  {
    const int e = tid & 127, dh = tid >> 7;
    const float decay = sdecay[0];
    const float* C0 = p.st_C + (((size_t)l * 128 + b) * 4 + hh) * 16384;
    float* C1 = p.out + O_CS + (((size_t)l * 128 + b) * 4 + hh) * 16384;
    float vw[8], inter[8];
#pragma unroll
    for (int s = 0; s < 8; ++s) { vw[s] = sv[s * 128 + e] * swsel[s]; inter[s] = 0.f; }
    for (int d = dh * 64; d < dh * 64 + 64; ++d) {
      const float c0 = C0[d * 128 + e];
      float upd = decay * c0;
#pragma unroll
      for (int s = 0; s < 8; ++s) {
        upd += sk[s * 128 + d] * vw[s];
        inter[s] += sq[s * 128 + d] * c0;
      }
      C1[d * 128 + e] = upd;
    }
#pragma unroll
    for (int t = 0; t < 8; ++t) sint[(dh * 8 + t) * 128 + e] = inter[t];
  }
  __syncthreads();
  if (tid < 128) {
    const int e = tid;
    for (int t = 0; t < 8; ++t) {
      float num = swi[t] * (sint[t * 128 + e] + sint[(8 + t) * 128 + e]);
      float den = swi[t] * sqn[t];
      for (int s = 0; s <= t; ++s) { num += sa[t * 8 + s] * sv[s * 128 + e]; den += sa[t * 8 + s]; }
      sh[t * 128 + e] = num / fmaxf(fabsf(den), __expf(-smt[t]));
    }
    float nn = sdecay[0] * n0[e];
    for (int s = 0; s < 8; ++s) nn += swsel[s] * sk[s * 128 + e];
    p.out[O_NS + (((size_t)l * 128 + b) * 4 + hh) * 128 + e] = nn;
  }
  __syncthreads();
  const float* hg = p.hnorm_g + l * 512 + hh * 128;
  for (int tt = 0; tt < 2; ++tt) {
    const int t = wave * 2 + tt;
    const float h0 = sh[t * 128 + lane], h1 = sh[t * 128 + 64 + lane];
    const float ss = wave_sum(h0 * h0 + h1 * h1);
    const float rstd = rsqrtf(ss * (1.0f / 128.f) + EPS);
    bf16* zr = z + (size_t)(r0 + t) * ZC;
#pragma unroll
    for (int k = 0; k < 2; ++k) {
      const int e = lane + 64 * k;
      const float hv = k ? h1 : h0;
      const float o = bf2f(zr[C_O + hh * 128 + e]), cg_ = bf2f(zr[C_G + hh * 128 + e]);
      zr[C_O + hh * 128 + e] = f2bf(hv * rstd * hg[e] * sigmoidf_(o) * siluf_(cg_));
    }
  }
  __syncthreads();
}

__device__ __forceinline__ void phase_mix1(const Params& p, int l, unsigned char* smem) {
  constexpr int N_LOC = 1024, N_SMP = 512, N_CV = 4;
  constexpr int N_ALL = N_LOC + N_SMP + N_CV;
  for (int it = blockIdx.x; it < N_ALL; it += gridDim.x) {
    int i = it;
    if (i < N_LOC) { mlstm_local_item(p, l, i, smem); continue; }
    i -= N_LOC;
    if (i < N_SMP) { mlstm_sample_item(p, l, i, smem); continue; }
    i -= N_SMP;
    mlstm_convout_item(p, l, i);
  }
}

__device__ __forceinline__ void phase_scan(const Params& p, int l, unsigned char* smem) {
  float* sdec = (float*)smem;
  float* ssc = sdec + 64;
  const int tid = tidx();
  float* Gb = (float*)(p.ws + WS_G);
  float* Tb = (float*)(p.ws + WS_TOT);
  float* Mb = (float*)(p.ws + WS_M);
  for (int it = blockIdx.x; it < 256; it += gridDim.x) {
    const int bh = it >> 4, slice = it & 15;
    if (tid < 64) { sdec[128 + tid] = Gb[bh * 64 + tid]; sdec[192 + tid] = Tb[bh * 64 + tid]; }
    __syncthreads();
    if (tid == 0) {
      float m = 0.f;
      for (int c = 0; c < 64; ++c) {
        const float G = sdec[128 + c], tot = sdec[192 + c];
        const float mn = fmaxf(tot + m, G);
        sdec[c] = __expf(tot + m - mn);
        ssc[c] = __expf(G - mn);
        if (slice == 0) Mb[bh * 64 + c] = m;
        m = mn;
      }
      if (slice == 0) p.out[O_MP + l * 16 + bh] = m;
    }
    __syncthreads();
    {
      const int idx = slice * 1024 + tid * 4;
      bf16* U = (bf16*)(p.ws + WS_U) + (size_t)bh * 64 * 16384 + idx;
      float st[4] = {0.f, 0.f, 0.f, 0.f};
#pragma unroll 8
      for (int c = 0; c < 64; ++c) {
        float u[4];
        unpack4(*(const uint2*)(U + (size_t)c * 16384), u);
        uint2 o;
        o.x = pack2(st[0], st[1]); o.y = pack2(st[2], st[3]);
        *(uint2*)(U + (size_t)c * 16384) = o;
        const float dc = sdec[c], sc = ssc[c];
#pragma unroll
        for (int x = 0; x < 4; ++x) st[x] = dc * st[x] + sc * u[x];
      }
      const int e = idx >> 7, d0 = idx & 127;
      float* Co = p.out + O_CP + ((size_t)l * 16 + bh) * 16384;
#pragma unroll
      for (int x = 0; x < 4; ++x) Co[(d0 + x) * 128 + e] = st[x];
    }
    if (slice == 0 && tid < 128) {
      float* un = (float*)(p.ws + WS_UN) + (size_t)bh * 64 * 128 + tid;
      float n = 0.f;
#pragma unroll 8
      for (int c = 0; c < 64; ++c) {
        const float u = un[c * 128];
        un[c * 128] = n;
        n = sdec[c] * n + ssc[c] * u;
      }
      p.out[O_NP + ((size_t)l * 16 + bh) * 128 + tid] = n;
    }
    __syncthreads();
  }
}

__device__ __forceinline__ void mlstm_out_item(const Params& p, int l, int item, unsigned char* smem) {
  const int bh = item >> 6, c = item & 63, b = bh >> 2, hh = bh & 3;
  const int r0 = b * SEQ + c * 64;
  bf16* z = (bf16*)(p.ws + WS_Z);
  bf16* sq = (bf16*)smem;
  bf16* sk = (bf16*)(smem + 17408);
  bf16* svT = (bf16*)(smem + 34816);
  bf16* sa = (bf16*)(smem + 53248);
  float* scum = (float*)(smem + 62464);
  float* siv = scum + 64;
  float* smt = siv + 64;
  float* swi = smt + 64;
  float* sden = swi + 64;
  float* sqn = sden + 64;
  float* spart = sqn + 64;
  const int tid = tidx(), lane = tid & 63, wave = tid >> 6;
  const int r16 = lane & 15, g4 = lane >> 4;
  if (wave == 0) {
    float cum, iv;
    chunk_gates(p, l, z, r0, hh, lane, cum, iv);
    scum[lane] = cum;
    siv[lane] = iv;
  }
  for (int i = tid; i < 2048; i += 256) {
    const int isk = i >> 10, r = i & 1023, s = r >> 4, d8 = (r & 15) * 8;
    float y[8];
    conv8_prompt(p, l, z, r0, c * 64, s, isk * 512 + hh * 128 + d8, y);
    const float sc = isk ? 0.08838834764831845f : 1.0f;
    uint4 o;
    o.x = pack2(y[0] * sc, y[1] * sc); o.y = pack2(y[2] * sc, y[3] * sc);
    o.z = pack2(y[4] * sc, y[5] * sc); o.w = pack2(y[6] * sc, y[7] * sc);
    *(uint4*)((isk ? sk : sq) + s * 136 + d8) = o;
  }
  for (int i = tid; i < 1024; i += 256) {
    const int s = i >> 4, d8 = (i & 15) * 8;
    float v[8];
    unpack8(*(const uint4*)(z + (size_t)(r0 + s) * ZC + C_V + hh * 128 + d8), v);
#pragma unroll
    for (int j = 0; j < 8; ++j) svT[(d8 + j) * 72 + s] = f2bf(v[j]);
  }
  __syncthreads();
  const float m_prev = ((const float*)(p.ws + WS_M))[item];
  {
    const int t = wave * 16 + r16;
    bf16x8 qf[4];
#pragma unroll
    for (int ks = 0; ks < 4; ++ks) qf[ks] = *(const bf16x8*)(sq + t * 136 + ks * 32 + g4 * 8);
    f32x4 st[4];
#pragma unroll
    for (int kt = 0; kt < 4; ++kt) {
      st[kt] = (f32x4){0.f, 0.f, 0.f, 0.f};
#pragma unroll
      for (int ks = 0; ks < 4; ++ks) {
        const bf16x8 kf = *(const bf16x8*)(sk + (kt * 16 + r16) * 136 + ks * 32 + g4 * 8);
        st[kt] = mfma16(kf, qf[ks], st[kt]);
      }
    }
    const float cumt = scum[t];
    float dm[4][4];
    float rmax = -INFINITY;
#pragma unroll
    for (int kt = 0; kt < 4; ++kt)
#pragma unroll
      for (int x = 0; x < 4; ++x) {
        const int s = kt * 16 + g4 * 4 + x;
        dm[kt][x] = (s <= t) ? (cumt - scum[s] + siv[s]) : -INFINITY;
        rmax = fmaxf(rmax, dm[kt][x]);
      }
    rmax = fmaxf(rmax, __shfl_xor(rmax, 16)); rmax = fmaxf(rmax, __shfl_xor(rmax, 32));
    const float mi = cumt + m_prev, mt = fmaxf(mi, rmax);
    float rsum = 0.f;
#pragma unroll
    for (int kt = 0; kt < 4; ++kt) {
      float a[4];
#pragma unroll
      for (int x = 0; x < 4; ++x) {
        const int s = kt * 16 + g4 * 4 + x;
        a[x] = (s <= t) ? __expf(dm[kt][x] - mt) * st[kt][x] : 0.f;
        rsum += a[x];
      }
      uint2 o;
      o.x = pack2(a[0], a[1]); o.y = pack2(a[2], a[3]);
      *(uint2*)(sa + t * 72 + kt * 16 + g4 * 4) = o;
    }
    rsum += __shfl_xor(rsum, 16); rsum += __shfl_xor(rsum, 32);
    if (g4 == 0) { smt[t] = mt; swi[t] = __expf(mi - mt); sden[t] = rsum; }
  }
  {
    const int t = tid >> 2, part = tid & 3;
    const float* nc = (const float*)(p.ws + WS_UN) + (size_t)item * 128;
    float s = 0.f;
    for (int d = part * 32; d < part * 32 + 32; ++d) s += bf2f(sq[t * 136 + d]) * nc[d];
    s += __shfl_xor(s, 1); s += __shfl_xor(s, 2);
    if (part == 0) sqn[t] = s;
  }
  __syncthreads();
  f32x4 acc[4][2];
#pragma unroll
  for (int ti = 0; ti < 4; ++ti)
#pragma unroll
    for (int et = 0; et < 2; ++et) acc[ti][et] = (f32x4){0.f, 0.f, 0.f, 0.f};
  const bf16* Cc = (const bf16*)(p.ws + WS_U) + (size_t)item * 16384;
#pragma unroll
  for (int ks = 0; ks < 4; ++ks) {
    bf16x8 cf[2], qf[4];
#pragma unroll
    for (int et = 0; et < 2; ++et) cf[et] = *(const bf16x8*)(Cc + (wave * 32 + et * 16 + r16) * 128 + ks * 32 + g4 * 8);
#pragma unroll
    for (int ti = 0; ti < 4; ++ti) qf[ti] = *(const bf16x8*)(sq + (ti * 16 + r16) * 136 + ks * 32 + g4 * 8);
#pragma unroll
    for (int ti = 0; ti < 4; ++ti)
#pragma unroll
      for (int et = 0; et < 2; ++et) acc[ti][et] = mfma16(cf[et], qf[ti], acc[ti][et]);
  }
#pragma unroll
  for (int ti = 0; ti < 4; ++ti) {
    const float w = swi[ti * 16 + r16];
#pragma unroll
    for (int et = 0; et < 2; ++et) acc[ti][et] *= w;
  }
#pragma unroll
  for (int ks = 0; ks < 2; ++ks) {
    bf16x8 vf[2], af[4];
#pragma unroll
    for (int et = 0; et < 2; ++et) vf[et] = *(const bf16x8*)(svT + (wave * 32 + et * 16 + r16) * 72 + ks * 32 + g4 * 8);
#pragma unroll
    for (int ti = 0; ti < 4; ++ti) af[ti] = *(const bf16x8*)(sa + (ti * 16 + r16) * 72 + ks * 32 + g4 * 8);
#pragma unroll
    for (int ti = 0; ti < 4; ++ti)
#pragma unroll
      for (int et = 0; et < 2; ++et) acc[ti][et] = mfma16(vf[et], af[ti], acc[ti][et]);
  }
#pragma unroll
  for (int ti = 0; ti < 4; ++ti) {
    const int t = ti * 16 + r16;
    const float den = sden[t] + swi[t] * sqn[t];
    const float inv = 1.0f / fmaxf(fabsf(den), __expf(-smt[t]));
    float ss = 0.f;
#pragma unroll
    for (int et = 0; et < 2; ++et) {
      acc[ti][et] *= inv;
#pragma unroll
      for (int x = 0; x < 4; ++x) ss += acc[ti][et][x] * acc[ti][et][x];
    }
    ss += __shfl_xor(ss, 16); ss += __shfl_xor(ss, 32);
    if (g4 == 0) spart[t * 4 + wave] = ss;
  }
  __syncthreads();
  const float* hg = p.hnorm_g + l * 512 + hh * 128;
#pragma unroll
  for (int ti = 0; ti < 4; ++ti) {
    const int t = ti * 16 + r16;
    const float rstd = rsqrtf((spart[t * 4] + spart[t * 4 + 1] + spart[t * 4 + 2] + spart[t * 4 + 3]) * (1.0f / 128.f) + EPS);
    bf16* zr = z + (size_t)(r0 + t) * ZC;
#pragma unroll
    for (int et = 0; et < 2; ++et) {
      const int e = wave * 32 + et * 16 + g4 * 4;
      float o[4], cg_[4];
      unpack4(*(const uint2*)(zr + C_O + hh * 128 + e), o);
      unpack4(*(const uint2*)(zr + C_G + hh * 128 + e), cg_);
      float y[4];
#pragma unroll
      for (int x = 0; x < 4; ++x) y[x] = acc[ti][et][x] * rstd * hg[e + x] * sigmoidf_(o[x]) * siluf_(cg_[x]);
      uint2 oo;
      oo.x = pack2(y[0], y[1]); oo.y = pack2(y[2], y[3]);
      *(uint2*)(zr + C_O + hh * 128 + e) = oo;
    }
  }
  __syncthreads();
}

__device__ __forceinline__ void phase_mix2(const Params& p, int l, unsigned char* smem) {
  for (int it = blockIdx.x; it < 1024; it += gridDim.x) mlstm_out_item(p, l, it, smem);
}

__device__ __forceinline__ void phase_gemm_br(const Params& p, int l, unsigned char* smem) {
  bf16* sm = (bf16*)smem;
  const bf16* hbuf = (const bf16*)(p.ws + WS_H);
  const bf16* Win = (const bf16*)(p.ws + WS_WIN) + (size_t)l * NWIN * 1024;
  const bf16* Wbr = (const bf16*)(p.ws + WS_WBR) + (size_t)l * 1024 * 1536;
  const bf16* yab = (const bf16*)(p.ws + WS_YAB);
  const bf16* z = (const bf16*)(p.ws + WS_Z);
  bf16* merged = (bf16*)(p.ws + WS_U);
  const float* bias = p.b_in + (size_t)l * ZIN + OFF_MG;
  const int lane = tidx() & 63, wave = tidx() >> 6, wr = wave >> 1, wc = wave & 1;
  const int ntiles = (TT / 128) * 8;
  for (int t = blockIdx.x; t < ntiles; t += gridDim.x) {
    int pm, pn;
    tile_map(t, 8, pm, pn);
    const int m0 = pm * 128, n0 = pn * 128;
#pragma unroll 1
    for (int seg = 0; seg < 3; ++seg) {
      f32x4 acc[4][4];
      zero_acc<4>(acc);
      gemm_accum_f8<4>(acc, p.ws + WS_H8 + (size_t)m0 * 1024, p.ws + WS_W8 + ((size_t)l * W8_ROWS + (OFF_MG - W8_ROW0) + seg * 1024 + n0) * 1024, sm);
      unsigned gp[4][4][2];
#pragma unroll
      for (int j = 0; j < 4; ++j) {
        const int col = n0 + wc * 64 + j * 16 + (lane >> 4) * 4;
        const float4 bb = *(const float4*)(bias + seg * 1024 + col);
#pragma unroll
        for (int i = 0; i < 4; ++i) {
          gp[i][j][0] = pack2(sigmoidf_(acc[i][j][0] * 0.015625f + bb.x), sigmoidf_(acc[i][j][1] * 0.015625f + bb.y));
          gp[i][j][1] = pack2(sigmoidf_(acc[i][j][2] * 0.015625f + bb.z), sigmoidf_(acc[i][j][3] * 0.015625f + bb.w));
        }
      }
      zero_acc<4>(acc);
      const bf16* A = (seg == 0) ? yab + (size_t)m0 * 1024 : (seg == 1) ? yab + (size_t)m0 * 1024 + 512 : z + (size_t)m0 * ZC + C_O;
      const int lda = (seg == 2) ? ZC : 1024;
      gemm_accum<4, true>(acc, A, lda, Wbr + (size_t)n0 * 1536 + seg * 512, 1536, 512, sm);
#pragma unroll
      for (int i = 0; i < 4; ++i)
#pragma unroll
        for (int j = 0; j < 4; ++j) {
          const int row = m0 + wr * 64 + i * 16 + (lane & 15), col = n0 + wc * 64 + j * 16 + (lane >> 4) * 4;
          uint2* mp = (uint2*)(merged + (size_t)row * 1024 + col);
          uint2 prev = make_uint2(0u, 0u);
          if (seg > 0) prev = *mp;
          uint2 o;
          o.x = pack2(lo2f(prev.x) + lo2f(gp[i][j][0]) * acc[i][j][0], hi2f(prev.x) + hi2f(gp[i][j][0]) * acc[i][j][1]);
          o.y = pack2(lo2f(prev.y) + lo2f(gp[i][j][1]) * acc[i][j][2], hi2f(prev.y) + hi2f(gp[i][j][1]) * acc[i][j][3]);
          *mp = o;
        }
    }
  }
}

__device__ __forceinline__ void phase_gemm_out(const Params& p, int l, unsigned char* smem) {
  bf16* sm = (bf16*)smem;
  const bf16* merged = (const bf16*)(p.ws + WS_U);
  const bf16* Wout = (const bf16*)(p.ws + WS_WOUT) + (size_t)l * 1024 * 1024;
  const float* mod = (const float*)(p.ws + WS_MOD);
  const int lane = tidx() & 63, wave = tidx() >> 6, wr = wave >> 1, wc = wave & 1;
  const int ntiles = (TT / 128) * 8;
  for (int t = blockIdx.x; t < ntiles; t += gridDim.x) {
    int pm, pn;
    tile_map(t, 8, pm, pn);
    const int m0 = pm * 128, n0 = pn * 128;
    f32x4 acc[4][4];
    zero_acc<4>(acc);
    gemm_accum<4>(acc, merged + (size_t)m0 * 1024, 1024, Wout + (size_t)n0 * 1024, 1024, 1024, sm);
#pragma unroll
    for (int i = 0; i < 4; ++i) {
      const int row = m0 + wr * 64 + i * 16 + (lane & 15);
      const float* xr = xrow_ptr(p, l, row);
      const float* gate = mod + ((size_t)l * NMOD + mod_row(row)) * 3072 + 2048;
#pragma unroll
      for (int j = 0; j < 4; ++j) {
        const int col = n0 + wc * 64 + j * 16 + (lane >> 4) * 4;
        const float4 xv = *(const float4*)(xr + col), gv = *(const float4*)(gate + col);
        float4 o;
        o.x = xv.x + gv.x * acc[i][j][0]; o.y = xv.y + gv.y * acc[i][j][1];
        o.z = xv.z + gv.z * acc[i][j][2]; o.w = xv.w + gv.w * acc[i][j][3];
        *(float4*)(p.out + (size_t)row * D + col) = o;
      }
    }
  }
}

constexpr int N_PHASES = 19;
template <int S>
__device__ __forceinline__ void run_stage(const Params& p, int l, unsigned char* smem) {
  if (S == -1) phase_prep(p, smem);
  if (S == 0) phase_norm(p, l);
  if (S == 1) phase_gemm_in(p, l, 0, ZAB / 128, ZAB, smem);
  if (S == 2) phase_mix_ab(p, l, smem);
  if (S == 3) phase_gemm_in(p, l, ZAB, ZC / 128, ZC, smem);
  if (S == 4) phase_mix1(p, l, smem);
  if (S == 5) phase_scan(p, l, smem);
  if (S == 6) phase_mix2(p, l, smem);
  if (S == 7) phase_gemm_br(p, l, smem);
  if (S == 8) phase_gemm_out(p, l, smem);
}


#define XB_TMO      128
#define XB_XCNT(j)  (256  + 64 * (j))
#define XB_XSUB(j)  (1280 + 64 * (j))
#define XB_XGEN(j)  (2304 + 64 * (j))
#define XB_TOP      3328
#define XB_TOPGEN   3392
#define XCD_BAR_WORDS 3456
#define XB_SPIN_CAP (1u << 18)
#define LAS __attribute__((address_space(3)))
__device__ __forceinline__ unsigned xb_ld(unsigned* p)              { return __hip_atomic_load(p, __ATOMIC_RELAXED, __HIP_MEMORY_SCOPE_AGENT); }
__device__ __forceinline__ unsigned xb_add(unsigned* p, unsigned v) { return __hip_atomic_fetch_add(p, v, __ATOMIC_RELAXED, __HIP_MEMORY_SCOPE_AGENT); }
__device__ __forceinline__ unsigned xb_xcc_id() { return (unsigned)__builtin_amdgcn_s_getreg((3 << 11) | 20) & 0xFu; }
#define XB_SPIN(cond, bar) do { unsigned _sp = 0; while (cond) { __builtin_amdgcn_s_sleep(1); \
    if ((++_sp & 255u) == 0u) { if (xb_ld(&(bar)[XB_TMO])) break; if (_sp > XB_SPIN_CAP) { atomicAdd(&(bar)[XB_TMO], 1u); break; } } } } while (0)
struct XcdBarrier { unsigned* bar; unsigned x; volatile LAS unsigned* st; };
__device__ __forceinline__ XcdBarrier xcd_barrier_post(unsigned* bar, volatile LAS unsigned* st) {
  XcdBarrier b; b.bar = bar; b.x = xb_xcc_id(); b.st = st;
  if (threadIdx.x == 0) (void)xb_add(&bar[XB_XCNT(b.x)], 1u);
  return b;
}
__device__ __forceinline__ void xcd_barrier_complete(unsigned* bar, unsigned x, unsigned& nloc, unsigned& nx) {
  const unsigned G = gridDim.x * gridDim.y * gridDim.z;
  unsigned sum, cnt, mine, sp = 0u;
  for (;;) {
    sum = 0u; cnt = 0u; mine = 0u;
#pragma unroll
    for (unsigned j = 0; j < 16; ++j) { const unsigned c = xb_ld(&bar[XB_XCNT(j)]); sum += c; cnt += (c > 0u) ? 1u : 0u; mine = (j == x) ? c : mine; }
    if (sum == G) break;
    __builtin_amdgcn_s_sleep(1);
    if ((++sp & 255u) == 0u) { if (xb_ld(&bar[XB_TMO])) break; if (sp > XB_SPIN_CAP) { atomicAdd(&bar[XB_TMO], 1u); break; } }
  }
  nloc = mine > 0u ? mine : 1u; nx = cnt > 0u ? cnt : 1u;
}
__device__ __forceinline__ void xcd_barrier(const XcdBarrier& b) {
  asm volatile("s_waitcnt vmcnt(0)" ::: "memory");
  __syncthreads();
  if (threadIdx.x == 0) {
    unsigned* bar = b.bar;
    __builtin_amdgcn_s_waitcnt(0);
    unsigned nloc = b.st[0], nx = b.st[1];
    if (nloc == 0u) { xcd_barrier_complete(bar, b.x, nloc, nx); b.st[0] = nloc; b.st[1] = nx; }
    const unsigned old = xb_add(&bar[XB_XSUB(b.x)], 1u);
    const unsigned gen = old / nloc;
    if (old + 1u == (gen + 1u) * nloc) {
      __builtin_amdgcn_fence(__ATOMIC_RELEASE, "agent");
      asm volatile("s_waitcnt vmcnt(0)" ::: "memory");
      const unsigned og = xb_add(&bar[XB_TOP], 1u);
      const unsigned tg = og / nx;
      if (og + 1u == (tg + 1u) * nx) xb_add(&bar[XB_TOPGEN], 1u);
      else XB_SPIN(xb_ld(&bar[XB_TOPGEN]) == tg, bar);
      __builtin_amdgcn_fence(__ATOMIC_ACQUIRE, "agent");
      xb_add(&bar[XB_XGEN(b.x)], 1u);
      asm volatile("s_waitcnt vmcnt(0)" ::: "memory");
    } else {
      XB_SPIN(xb_ld(&bar[XB_XGEN(b.x)]) == gen, bar);
      __builtin_amdgcn_fence(__ATOMIC_ACQUIRE, "agent");
      asm volatile("s_waitcnt vmcnt(0)" ::: "memory");
    }
  }
  __syncthreads();
}

#define GSYNC() xcd_barrier(xb)
__global__ void __launch_bounds__(256, 2) mega_kernel(Params p_in) {
  __shared__ __attribute__((aligned(16))) unsigned char smem[SMEM_BYTES];
  const Params& p = *(const Params*)__builtin_amdgcn_kernarg_segment_ptr();
  __shared__ uint4 xb_words;
  if (threadIdx.x == 0) xb_words = make_uint4(0u, 0u, 0u, 0u);
  __syncthreads();
  XcdBarrier xb = xcd_barrier_post((unsigned*)(p.ws + WS_BAR), (volatile LAS unsigned*)&xb_words);
  run_stage<-1>(p, 0, smem);
  if (p.out == nullptr) cg::this_grid().sync();
  GSYNC();
#define LAYER(L, LAST)                 \
  run_stage<0>(p, L, smem); GSYNC();   \
  run_stage<1>(p, L, smem); GSYNC();   \
  run_stage<2>(p, L, smem); GSYNC();   \
  run_stage<3>(p, L, smem); GSYNC();   \
  run_stage<4>(p, L, smem); GSYNC();   \
  run_stage<5>(p, L, smem); GSYNC();   \
  run_stage<6>(p, L, smem); GSYNC();   \
  run_stage<7>(p, L, smem); GSYNC();   \
  run_stage<8>(p, L, smem);            \
  if (!LAST) GSYNC();
  int l0 = 0, l1 = 1;
  asm volatile("" : "+s"(l0));
  asm volatile("" : "+s"(l1));
  LAYER(l0, 0)
  LAYER(l1, 1)
}

extern "C" void kernel_launch(void* const* d_in, const int* in_sizes, int n_in, void* d_out, int out_size, void* d_ws,
                              size_t ws_size, hipStream_t stream) {
  if (ws_size < WS_END || n_in < 29) { fprintf(stderr, "workspace too small / bad inputs\n"); return; }
  Params p{};
  const float** f = (const float**)&p;
  for (int i = 0; i < 29; ++i) f[i] = (const float*)d_in[i];
  p.out = (float*)d_out;
  p.ws = (unsigned char*)d_ws;
  static int grid_blocks = 0;
  if (!grid_blocks) {
    int dev = 0, cus = 0, per_cu = 0;
    (void)hipGetDevice(&dev);
    (void)hipDeviceGetAttribute(&cus, hipDeviceAttributeMultiprocessorCount, dev);
    (void)hipOccupancyMaxActiveBlocksPerMultiprocessor(&per_cu, mega_kernel, 256, 0);
    if (per_cu < 1) per_cu = 1;
    if (per_cu > 2) per_cu = 2;
    grid_blocks = cus * per_cu;
  }
  (void)hipMemsetAsync((unsigned char*)d_ws + WS_BAR, 0, 16384, stream);
  void* args[] = {&p};
  hipError_t e = hipLaunchCooperativeKernel((void*)mega_kernel, dim3(grid_blocks), dim3(256), args, 0, stream);
  if (e != hipSuccess) fprintf(stderr, "cooperative launch failed: %s (grid %d)\n", hipGetErrorString(e), grid_blocks);
}
```

```cpp
#include <hip/hip_runtime.h>
#include <hip/hip_cooperative_groups.h>
#include <cstdio>
namespace cg = cooperative_groups;

typedef unsigned short bf16;
typedef short bf16x8 __attribute__((ext_vector_type(8)));
typedef float f32x4 __attribute__((ext_vector_type(4)));
typedef unsigned u32x4 __attribute__((ext_vector_type(4)));
#define LDSP __attribute__((address_space(3)))

#ifndef SINGLE_LAUNCH
#define SINGLE_LAUNCH 0
#endif

constexpr int D = 1024, TP = 16384, TS = 1024, TT = TP + TS, SEQ = 4096;
constexpr int ZIN = 8456, NWIN = 8576;
constexpr int OFF_AV = 512, OFF_AG = 1024, OFF_BQ = 1536, OFF_BK = 2048, OFF_BV = 2176, OFF_BG = 2304, OFF_MG = 5384;
constexpr int ZAB = 2816;
constexpr int ZC = 2688;
constexpr int C_QK = 0, C_V = 1024, C_I = 1536, C_F = 1540, C_O = 1544, C_G = 2056;
constexpr float EPS = 1e-6f;
constexpr int NMOD = 132;
constexpr int SMEM_BYTES = 73728;

constexpr size_t O_Y = 0;
constexpr size_t O_SKP = (size_t)TT * D;
constexpr size_t O_SVP = O_SKP + 2 * 4 * 128 * 128;
constexpr size_t O_CVP = O_SVP + 2 * 4 * 128 * 128;
constexpr size_t O_CP = O_CVP + 2 * 4 * 3 * 1024;
constexpr size_t O_NP = O_CP + (size_t)2 * 4 * 4 * 128 * 128;
constexpr size_t O_MP = O_NP + 2 * 4 * 4 * 128;
constexpr size_t O_SKS = O_MP + 2 * 4 * 4;
constexpr size_t O_SVS = O_SKS + (size_t)2 * 128 * 128 * 128;
constexpr size_t O_CVS = O_SVS + (size_t)2 * 128 * 128 * 128;
constexpr size_t O_CS = O_CVS + (size_t)2 * 128 * 3 * 1024;
constexpr size_t O_NS = O_CS + (size_t)2 * 128 * 4 * 128 * 128;
constexpr size_t O_MS = O_NS + (size_t)2 * 128 * 4 * 128;
constexpr size_t O_GV = O_MS + 2 * 128 * 4;
constexpr size_t O_END = O_GV + (size_t)2 * 128 * 8 * 512;

constexpr size_t WS_WIN = 0;
constexpr size_t WS_WBR = WS_WIN + (size_t)2 * NWIN * 1024 * 2;
constexpr size_t WS_WOUT = WS_WBR + (size_t)2 * 1024 * 1536 * 2;
constexpr size_t WS_MOD = WS_WOUT + (size_t)2 * 1024 * 1024 * 2;
constexpr size_t WS_H = WS_MOD + (size_t)2 * NMOD * 3072 * 4;
constexpr size_t WS_YAB = WS_H + (size_t)TT * 1024 * 2;
constexpr size_t WS_U = WS_YAB + (size_t)TT * 1024 * 2;
constexpr size_t WS_UN = WS_U + (size_t)TT * 1024 * 2;
constexpr size_t WS_G = WS_UN + (size_t)1024 * 128 * 4;
constexpr size_t WS_TOT = WS_G + 4096;
constexpr size_t WS_M = WS_TOT + 4096;
constexpr size_t WS_Z = WS_M + 4096;
constexpr size_t WS_BAR = WS_Z + (size_t)TT * ZAB * 2;
constexpr size_t WS_H8 = WS_BAR + 16384;
constexpr int W8_ROW0 = 0, W8_ROWS = NWIN;
constexpr size_t WS_W8 = WS_H8 + (size_t)TT * 1024;
constexpr size_t WS_END = WS_W8 + (size_t)2 * W8_ROWS * 1024;

struct Params {
  const float *x_prompt, *x_sample, *cache_k, *cache_v, *st_conv, *st_C, *st_n, *st_m, *c_prompt, *c_sample;
  const float *ada_w, *ada_b, *norm_g, *w_in, *b_in, *vnorm_g, *gmlp_ws, *gmlp_bs, *qn_g, *kn_g, *sinks;
  const float *conv_w, *conv_b, *f_bias, *hnorm_g, *w_a, *w_b, *w_c, *w_out;
  float* out;
  unsigned char* ws;
};

__device__ __forceinline__ int tidx() { int t = threadIdx.x; asm volatile("" : "+v"(t)); return t; }
__device__ __forceinline__ bf16 f2bf(float f) {
  unsigned u = __float_as_uint(f);
  u += 0x7fffu + ((u >> 16) & 1u);
  return (bf16)(u >> 16);
}
__device__ __forceinline__ float bf2f(bf16 h) { return __uint_as_float(((unsigned)h) << 16); }
__device__ __forceinline__ unsigned pack2(float a, float b) { return (unsigned)f2bf(a) | ((unsigned)f2bf(b) << 16); }
__device__ __forceinline__ float lo2f(unsigned u) { return __uint_as_float(u << 16); }
__device__ __forceinline__ float hi2f(unsigned u) { return __uint_as_float(u & 0xffff0000u); }
__device__ __forceinline__ void unpack8(const uint4& v, float* f) {
  f[0] = lo2f(v.x); f[1] = hi2f(v.x); f[2] = lo2f(v.y); f[3] = hi2f(v.y);
  f[4] = lo2f(v.z); f[5] = hi2f(v.z); f[6] = lo2f(v.w); f[7] = hi2f(v.w);
}
__device__ __forceinline__ void unpack4(const uint2& v, float* f) {
  f[0] = lo2f(v.x); f[1] = hi2f(v.x); f[2] = lo2f(v.y); f[3] = hi2f(v.y);
}
__device__ __forceinline__ float sigmoidf_(float x) { return __builtin_amdgcn_rcpf(1.0f + __expf(-x)); }
__device__ __forceinline__ float siluf_(float x) { return x * __builtin_amdgcn_rcpf(1.0f + __expf(-x)); }
__device__ __forceinline__ float logsigmoidf_(float x) { return fminf(x, 0.0f) - log1pf(__expf(-fabsf(x))); }
__device__ __forceinline__ float wave_sum(float v) {
#pragma unroll
  for (int o = 32; o >= 1; o >>= 1) v += __shfl_xor(v, o);
  return v;
}
__device__ __forceinline__ float wave_max(float v) {
#pragma unroll
  for (int o = 32; o >= 1; o >>= 1) v = fmaxf(v, __shfl_xor(v, o));
  return v;
}
__device__ __forceinline__ f32x4 mfma16(bf16x8 a, bf16x8 b, f32x4 c) {
  return __builtin_amdgcn_mfma_f32_16x16x32_bf16(a, b, c, 0, 0, 0);
}
template <int MI, int NI>
__device__ __forceinline__ void mma_lds(f32x4 (&acc)[MI][NI], const bf16* sA, int lda, const bf16* sB, int ldb, int K, int lane) {
  const int r = lane & 15, q = (lane >> 4) * 8;
  for (int k0 = 0; k0 < K; k0 += 32) {
    bf16x8 a[MI], b[NI];
#pragma unroll
    for (int i = 0; i < MI; ++i) a[i] = *(const bf16x8*)(sA + (i * 16 + r) * lda + k0 + q);
#pragma unroll
    for (int j = 0; j < NI; ++j) b[j] = *(const bf16x8*)(sB + (j * 16 + r) * ldb + k0 + q);
#pragma unroll
    for (int i = 0; i < MI; ++i)
#pragma unroll
      for (int j = 0; j < NI; ++j) acc[i][j] = mfma16(b[j], a[i], acc[i][j]);
  }
}

constexpr int GLD = 64;
constexpr int GTILE = 128 * GLD;
template <int NI>
__device__ __forceinline__ void g_load(u32x4 (&ra)[4], u32x4 (&rb)[NI], const bf16* __restrict__ A, int lda, const bf16* __restrict__ B, int ldb, int ko, int tid) {
  const unsigned offA = (unsigned)((tid >> 3) * lda + (tid & 7) * 8), offB = (unsigned)((tid >> 3) * ldb + (tid & 7) * 8);
#pragma unroll
  for (int i = 0; i < 4; ++i) {
    const bf16* Ai = A + (size_t)(i * 32) * lda + ko;
    ra[i] = *(const u32x4*)(Ai + offA);
  }
#pragma unroll
  for (int i = 0; i < NI; ++i) {
    const bf16* Bi = B + (size_t)(i * 32) * ldb + ko;
    rb[i] = *(const u32x4*)(Bi + offB);
  }
}
template <int NI>
__device__ __forceinline__ void g_store(const u32x4 (&ra)[4], const u32x4 (&rb)[NI], bf16* buf, int tid) {
  const int off = (tid >> 3) * GLD + (((tid & 7) ^ ((tid >> 3) & 7)) * 8);
#pragma unroll
  for (int i = 0; i < 4; ++i) *(u32x4*)(buf + off + i * 32 * GLD) = ra[i];
#pragma unroll
  for (int i = 0; i < NI; ++i) *(u32x4*)(buf + GTILE + off + i * 32 * GLD) = rb[i];
}
template <int NI, bool LOWREG = false>
__device__ __forceinline__ void g_compute(f32x4 (&acc)[4][NI], const bf16* cur, int wr, int wc, int lane) {
  const int r16 = lane & 15, sw = lane & 7, q = lane >> 4;
#pragma unroll
  for (int ks = 0; ks < 2; ++ks) {
    const int pc = ((ks * 4 + q) ^ sw) * 8;
    bf16x8 a[4];
#pragma unroll
    for (int i = 0; i < 4; ++i) a[i] = *(const bf16x8*)(cur + (wr * 64 + i * 16 + r16) * GLD + pc);
#pragma unroll
    for (int jh = 0; jh < NI; jh += 2) {
      bf16x8 b[2];
#pragma unroll
      for (int j = 0; j < 2; ++j) b[j] = *(const bf16x8*)(cur + GTILE + (wc * 16 * NI + (jh + j) * 16 + r16) * GLD + pc);
#pragma unroll
      for (int i = 0; i < 4; ++i)
#pragma unroll
        for (int j = 0; j < 2; ++j) acc[i][jh + j] = mfma16(b[j], a[i], acc[i][jh + j]);
      if (LOWREG) __builtin_amdgcn_sched_barrier(0);
    }
  }
}
template <int NI, bool F8SWZ = false>
__device__ __forceinline__ void g_stage(const bf16* __restrict__ A, int lda, const bf16* __restrict__ B, int ldb, int ko, bf16* buf, int tid) {
  const int wave = tid >> 6;
  const int lrow = tid >> 3;
  const int gch = ((tid & 7) ^ (F8SWZ ? ((lrow & 6) | ((lrow >> 3) & 1)) : (lrow & 7))) * 8;
  const unsigned offA = (unsigned)((tid >> 3) * lda + gch), offB = (unsigned)((tid >> 3) * ldb + gch);
#pragma unroll
  for (int i = 0; i < 4; ++i) {
    const bf16* Ai = A + (size_t)(i * 32) * lda + ko;
    __builtin_amdgcn_global_load_lds((const unsigned*)(Ai + offA), (LDSP unsigned*)(buf + (i * 32 + wave * 8) * GLD), 16, 0, 0);
  }
#pragma unroll
  for (int i = 0; i < NI; ++i) {
    const bf16* Bi = B + (size_t)(i * 32) * ldb + ko;
    __builtin_amdgcn_global_load_lds((const unsigned*)(Bi + offB), (LDSP unsigned*)(buf + GTILE + (i * 32 + wave * 8) * GLD), 16, 0, 0);
  }
}
template <int NI, bool LOWREG = false>
__device__ __forceinline__ void gemm_accum(f32x4 (&acc)[4][NI], const bf16* __restrict__ A, int lda,
                                           const bf16* __restrict__ B, int ldb, int K, bf16* sm) {
  const int tid = tidx(), lane = tid & 63, wave = tid >> 6, wr = wave >> 1, wc = wave & 1;
  const int nk = K >> 6;
  bf16* buf0 = sm;
  bf16* buf1 = sm + 2 * GTILE;
  g_stage<NI>(A, lda, B, ldb, 0, buf0, tid);
  asm volatile("s_waitcnt vmcnt(0)" ::: "memory");
  __syncthreads();
#pragma unroll 1
  for (int kt = 0; kt < nk; kt += 2) {
    g_stage<NI>(A, lda, B, ldb, (kt + 1) * 64, buf1, tid);
    g_compute<NI, LOWREG>(acc, buf0, wr, wc, lane);
    asm volatile("s_waitcnt vmcnt(0)" ::: "memory");
    __syncthreads();
    if (kt + 2 < nk) g_stage<NI>(A, lda, B, ldb, (kt + 2) * 64, buf0, tid);
    g_compute<NI, LOWREG>(acc, buf1, wr, wc, lane);
    asm volatile("s_waitcnt vmcnt(0)" ::: "memory");
    __syncthreads();
  }
}
typedef int i32x8 __attribute__((ext_vector_type(8)));
template <int NI>
__device__ __forceinline__ void g_compute_f8(f32x4 (&acc)[4][NI], const bf16* cur, int wr, int wc, int lane) {
  const int r16 = lane & 15, sw = (r16 & 6) | (r16 >> 3), q = lane >> 4;
  const int pc0 = ((2 * q) ^ sw) * 8, pc1 = ((2 * q + 1) ^ sw) * 8;
  i32x8 b[NI];
#pragma unroll
  for (int j = 0; j < NI; ++j) {
    const bf16* rp = cur + GTILE + (wc * 16 * NI + j * 16 + r16) * GLD;
    const u32x4 lo = *(const u32x4*)(rp + pc0), hi = *(const u32x4*)(rp + pc1);
    b[j] = (i32x8){(int)lo.x, (int)lo.y, (int)lo.z, (int)lo.w, (int)hi.x, (int)hi.y, (int)hi.z, (int)hi.w};
  }
#pragma unroll
  for (int i = 0; i < 4; ++i) {
    const bf16* rp = cur + (wr * 64 + i * 16 + r16) * GLD;
    const u32x4 lo = *(const u32x4*)(rp + pc0), hi = *(const u32x4*)(rp + pc1);
    const i32x8 a = (i32x8){(int)lo.x, (int)lo.y, (int)lo.z, (int)lo.w, (int)hi.x, (int)hi.y, (int)hi.z, (int)hi.w};
#pragma unroll
    for (int j = 0; j < NI; ++j)
      acc[i][j] = __builtin_amdgcn_mfma_scale_f32_16x16x128_f8f6f4(b[j], a, acc[i][j], 0, 0, 0, 0x7F7F7F7F, 0, 0x7F7F7F7F);
  }
}
template <int NI>
__device__ __forceinline__ void gemm_accum_f8(f32x4 (&acc)[4][NI], const unsigned char* __restrict__ A8, const unsigned char* __restrict__ B8, bf16* sm) {
  const int tid = tidx(), lane = tid & 63, wave = tid >> 6, wr = wave >> 1, wc = wave & 1;
  const bf16* A = (const bf16*)A8;
  const bf16* B = (const bf16*)B8;
  bf16* buf0 = sm;
  bf16* buf1 = sm + 2 * GTILE;
  g_stage<NI, true>(A, 512, B, 512, 0, buf0, tid);
  asm volatile("s_waitcnt vmcnt(0)" ::: "memory");
  __syncthreads();
#pragma unroll 1
  for (int kt = 0; kt < 8; kt += 2) {
    g_stage<NI, true>(A, 512, B, 512, (kt + 1) * 64, buf1, tid);
    g_compute_f8<NI>(acc, buf0, wr, wc, lane);
    asm volatile("s_waitcnt vmcnt(0)" ::: "memory");
    __syncthreads();
    if (kt + 2 < 8) g_stage<NI, true>(A, 512, B, 512, (kt + 2) * 64, buf0, tid);
    g_compute_f8<NI>(acc, buf1, wr, wc, lane);
    asm volatile("s_waitcnt vmcnt(0)" ::: "memory");
    __syncthreads();
  }
}
template <int NI>
__device__ __forceinline__ void zero_acc(f32x4 (&acc)[4][NI]) {
#pragma unroll
  for (int i = 0; i < 4; ++i)
#pragma unroll
    for (int j = 0; j < NI; ++j) acc[i][j] = (f32x4){0.f, 0.f, 0.f, 0.f};
}
__device__ __forceinline__ void tile_map(int t, int ntn, int& pm, int& pn) {
  const int grp = t / (8 * ntn), w = t % (8 * ntn);
  pm = grp * 8 + (w & 7);
  pn = w >> 3;
}

__device__ __forceinline__ void transpose_tile(const float* __restrict__ src, int ld_src, int n_valid, bf16* __restrict__ dst, int ld_dst,
                               int k0, int n0, int kdst0, float* sm, unsigned char* dst8 = nullptr) {
  const int tid = tidx();
  for (int i = tid; i < 64 * 16; i += 256) {
    const int kk = i >> 4, n4 = (i & 15) * 4, n = n0 + n4;
    float4 v = make_float4(0.f, 0.f, 0.f, 0.f);
    if (n + 3 < n_valid) v = *(const float4*)(src + (size_t)(k0 + kk) * ld_src + n);
    sm[kk * 65 + n4 + 0] = v.x; sm[kk * 65 + n4 + 1] = v.y; sm[kk * 65 + n4 + 2] = v.z; sm[kk * 65 + n4 + 3] = v.w;
  }
  __syncthreads();
  for (int i = tid; i < 64 * 8; i += 256) {
    const int nn = i >> 3, kc = (i & 7) * 8;
    uint4 o;
    o.x = pack2(sm[(kc + 0) * 65 + nn], sm[(kc + 1) * 65 + nn]);
    o.y = pack2(sm[(kc + 2) * 65 + nn], sm[(kc + 3) * 65 + nn]);
    o.z = pack2(sm[(kc + 4) * 65 + nn], sm[(kc + 5) * 65 + nn]);
    o.w = pack2(sm[(kc + 6) * 65 + nn], sm[(kc + 7) * 65 + nn]);
    *(uint4*)(dst + (size_t)(n0 + nn) * ld_dst + kdst0 + kc) = o;
    if (dst8 != nullptr) {
      uint2 q8;
      int t8 = __builtin_amdgcn_cvt_pk_fp8_f32(64.f * sm[(kc + 0) * 65 + nn], 64.f * sm[(kc + 1) * 65 + nn], 0, false);
      q8.x = (unsigned)__builtin_amdgcn_cvt_pk_fp8_f32(64.f * sm[(kc + 2) * 65 + nn], 64.f * sm[(kc + 3) * 65 + nn], t8, true);
      t8 = __builtin_amdgcn_cvt_pk_fp8_f32(64.f * sm[(kc + 4) * 65 + nn], 64.f * sm[(kc + 5) * 65 + nn], 0, false);
      q8.y = (unsigned)__builtin_amdgcn_cvt_pk_fp8_f32(64.f * sm[(kc + 6) * 65 + nn], 64.f * sm[(kc + 7) * 65 + nn], t8, true);
      *(uint2*)(dst8 + (size_t)(n0 + nn - W8_ROW0) * 1024 + kdst0 + kc) = q8;
    }
  }
  __syncthreads();
}

__device__ __forceinline__ void ada_item(const Params& p, int item, float* sm) {
  const int l = item / 192, n0 = (item % 192) * 16;
  const int tid = tidx(), col = tid & 15, rg = tid >> 4;
  constexpr int SLD = 68;
  float* sW = sm + 144 * SLD;
  float acc[9];
#pragma unroll
  for (int j = 0; j < 9; ++j) acc[j] = 0.f;
  const float* W = p.ada_w + (size_t)l * 1024 * 3072 + n0;
  const int wk = tid >> 2, wc4 = (tid & 3) * 4;
  float v[36];
  float4 w0;
#define ADA_LOAD(K0)                                                                                      \
  {                                                                                                       \
    _Pragma("unroll") for (int u = 0; u < 36; ++u) {                                                      \
      const int i = tid + 256 * u, r = i >> 6, kk = i & 63;                                               \
      v[u] = 0.f;                                                                                         \
      if (r < NMOD) v[u] = (r < 4) ? p.c_prompt[r * 1024 + (K0) + kk] : p.c_sample[(r - 4) * 1024 + (K0) + kk]; \
    }                                                                                                     \
    w0 = *(const float4*)(W + (size_t)((K0) + wk) * 3072 + wc4);                                          \
  }
#define ADA_STORE()                                                                                       \
  {                                                                                                       \
    _Pragma("unroll") for (int u = 0; u < 36; ++u) {                                                      \
      const int i = tid + 256 * u, r = i >> 6, kk = i & 63;                                               \
      sm[r * SLD + kk] = siluf_(v[u]);                                                                    \
    }                                                                                                     \
    *(float4*)(sW + wk * 16 + wc4) = w0;                                                                  \
  }
  ADA_LOAD(0)
  ADA_STORE()
  __syncthreads();
#pragma unroll 1
  for (int k0 = 0; k0 < 1024; k0 += 64) {
    if (k0 + 64 < 1024) ADA_LOAD(k0 + 64)
#pragma unroll 4
    for (int k4 = 0; k4 < 16; ++k4) {
      const float x0 = sW[(k4 * 4 + 0) * 16 + col], x1 = sW[(k4 * 4 + 1) * 16 + col];
      const float x2 = sW[(k4 * 4 + 2) * 16 + col], x3 = sW[(k4 * 4 + 3) * 16 + col];
#pragma unroll
      for (int j = 0; j < 9; ++j) {
        const float4 sv = *(const float4*)(sm + (rg * 9 + j) * SLD + k4 * 4);
        acc[j] += sv.x * x0 + sv.y * x1 + sv.z * x2 + sv.w * x3;
      }
    }
    __syncthreads();
    if (k0 + 64 < 1024) ADA_STORE()
    __syncthreads();
  }
#undef ADA_LOAD
#undef ADA_STORE
  float* mod = (float*)(p.ws + WS_MOD);
  const float b = p.ada_b[l * 3072 + n0 + col];
#pragma unroll
  for (int j = 0; j < 9; ++j) {
    const int r = rg * 9 + j;
    if (r < NMOD) mod[((size_t)l * NMOD + r) * 3072 + n0 + col] = acc[j] + b;
  }
}

__device__ __forceinline__ void phase_prep(const Params& p, unsigned char* smem) {
  float* sm = (float*)smem;
  constexpr int N_WIN = 2 * 16 * (NWIN / 64);
  constexpr int N_WBR = 2 * 3 * 8 * 16;
  constexpr int N_WOUT = 2 * 16 * 16;
  constexpr int N_ALL = N_WIN + N_WBR + N_WOUT;
  bf16* WinT = (bf16*)(p.ws + WS_WIN);
  bf16* WbrT = (bf16*)(p.ws + WS_WBR);
  bf16* WoutT = (bf16*)(p.ws + WS_WOUT);
  constexpr int N_ADA = 384;
  for (int it = blockIdx.x; it < N_ADA + N_ALL; it += gridDim.x) {
    if (it < N_ADA) { ada_item(p, it, sm); continue; }
    int i = it - N_ADA;
    if (i < N_WIN) {
      const int l = i / (16 * 134), r = i % (16 * 134), kt = r / 134, nt = r % 134;
      transpose_tile(p.w_in + (size_t)l * 1024 * ZIN, ZIN, ZIN, WinT + (size_t)l * NWIN * 1024, 1024, kt * 64, nt * 64, kt * 64, sm,
                     (nt * 64 >= W8_ROW0) ? p.ws + WS_W8 + (size_t)l * W8_ROWS * 1024 : nullptr);
      continue;
    }
    i -= N_WIN;
    if (i < N_WBR) {
      const int l = i / 384, r = i % 384, seg = r / 128, r2 = r % 128, kt = r2 / 16, nt = r2 % 16;
      const float* src = (seg == 0 ? p.w_a : seg == 1 ? p.w_b : p.w_c) + (size_t)l * 512 * 1024;
      transpose_tile(src, 1024, 1024, WbrT + (size_t)l * 1024 * 1536, 1536, kt * 64, nt * 64, seg * 512 + kt * 64, sm);
      continue;
    }
    i -= N_WBR;
    {
      const int l = i / 256, r = i % 256, kt = r / 16, nt = r % 16;
      transpose_tile(p.w_out + (size_t)l * 1024 * 1024, 1024, 1024, WoutT + (size_t)l * 1024 * 1024, 1024, kt * 64, nt * 64, kt * 64, sm);
    }
  }
}

__device__ __forceinline__ const float* xrow_ptr(const Params& p, int l, int row) {
  if (l == 0) return row < TP ? p.x_prompt + (size_t)row * D : p.x_sample + (size_t)(row - TP) * D;
  return p.out + (size_t)row * D;
}
__device__ __forceinline__ int mod_row(int row) { return row < TP ? (row >> 12) : 4 + ((row - TP) >> 3); }

__device__ __forceinline__ void phase_norm(const Params& p, int l) {
  const int lane = tidx() & 63, wave = tidx() >> 6;
  bf16* hbuf = (bf16*)(p.ws + WS_H);
  unsigned char* h8 = p.ws + WS_H8;
  const float* mod = (const float*)(p.ws + WS_MOD);
  const float* g = p.norm_g + l * D;
  for (int row = blockIdx.x * 4 + wave; row < TT; row += gridDim.x * 4) {
    const float4* x = (const float4*)xrow_ptr(p, l, row);
    float4 v[4];
    float ss = 0.f;
#pragma unroll
    for (int i = 0; i < 4; ++i) {
      v[i] = x[lane + 64 * i];
      ss += v[i].x * v[i].x + v[i].y * v[i].y + v[i].z * v[i].z + v[i].w * v[i].w;
    }
    ss = wave_sum(ss);
    const float rstd = rsqrtf(ss * (1.0f / D) + EPS);
    const float* mp = mod + ((size_t)l * NMOD + mod_row(row)) * 3072;
#pragma unroll
    for (int i = 0; i < 4; ++i) {
      const int c = (lane + 64 * i) * 4;
      const float4 gg = *(const float4*)(g + c), sh = *(const float4*)(mp + c), sc = *(const float4*)(mp + 1024 + c);
      uint2 o;
      o.x = pack2(v[i].x * rstd * gg.x * (1.f + sc.x) + sh.x, v[i].y * rstd * gg.y * (1.f + sc.y) + sh.y);
      o.y = pack2(v[i].z * rstd * gg.z * (1.f + sc.z) + sh.z, v[i].w * rstd * gg.w * (1.f + sc.w) + sh.w);
      *(uint2*)(hbuf + (size_t)row * D + c) = o;
      int p8 = __builtin_amdgcn_cvt_pk_fp8_f32(v[i].x * rstd * gg.x * (1.f + sc.x) + sh.x, v[i].y * rstd * gg.y * (1.f + sc.y) + sh.y, 0, false);
      p8 = __builtin_amdgcn_cvt_pk_fp8_f32(v[i].z * rstd * gg.z * (1.f + sc.z) + sh.z, v[i].w * rstd * gg.w * (1.f + sc.w) + sh.w, p8, true);
      *(int*)(h8 + (size_t)row * D + c) = p8;
    }
  }
}

__device__ __forceinline__ void phase_gemm_in(const Params& p, int l, int col0, int ntn, int ldz, unsigned char* smem) {
  bf16* sm = (bf16*)smem;
  const bf16* hbuf = (const bf16*)(p.ws + WS_H);
  const bf16* W = (const bf16*)(p.ws + WS_WIN) + (size_t)l * NWIN * 1024;
  bf16* z = (bf16*)(p.ws + WS_Z);
  const float* bias = p.b_in + (size_t)l * ZIN;
  const int tid = tidx(), lane = tid & 63, wave = tid >> 6, wr = wave >> 1, wc = wave & 1;
  const int ntiles = (TT / 128) * ntn;
  constexpr int OLD = 136;
  const bool isAB = (col0 == 0);
  const int nb = isAB ? 6 : 13;
  const int NB = (TT / 128) * nb;
  for (int t = blockIdx.x; t < ntiles; t += gridDim.x) {
    const bool f8 = t >= NB;
    int pm, pk;
    tile_map(f8 ? t - NB : t, f8 ? ntn - nb : nb, pm, pk);
    int pn;
    if (isAB) pn = f8 ? (pk < 4 ? pk : pk < 12 ? pk + 4 : pk + 6) : (pk < 4 ? 4 + pk : 12 + pk);
    else pn = f8 ? 13 + pk : pk;
    const int m0 = pm * 128, n0 = pn * 128;
    f32x4 acc[4][4];
    zero_acc<4>(acc);
    float osc = 1.0f;
    if (f8) {
      gemm_accum_f8<4>(acc, p.ws + WS_H8 + (size_t)m0 * 1024, p.ws + WS_W8 + ((size_t)l * W8_ROWS + col0 + n0) * 1024, sm);
      osc = 0.015625f;
    } else {
      gemm_accum<4>(acc, hbuf + (size_t)m0 * 1024, 1024, W + (size_t)(col0 + n0) * 1024, 1024, 1024, sm);
    }
#pragma unroll
    for (int j = 0; j < 4; ++j) {
      const int cl = wc * 64 + j * 16 + (lane >> 4) * 4;
      const float4 b = *(const float4*)(bias + col0 + n0 + cl);
#pragma unroll
      for (int i = 0; i < 4; ++i) {
        const int rl = wr * 64 + i * 16 + (lane & 15);
        uint2 o;
        o.x = pack2(acc[i][j][0] * osc + b.x, acc[i][j][1] * osc + b.y);
        o.y = pack2(acc[i][j][2] * osc + b.z, acc[i][j][3] * osc + b.w);
        *(uint2*)(sm + rl * OLD + cl) = o;
      }
    }
    __syncthreads();
#pragma unroll
    for (int it = 0; it < 8; ++it) {
      const int id = tid + 256 * it, row = id >> 4, ch = id & 15;
      const u32x4 v = *(const u32x4*)(sm + row * OLD + ch * 8);
      *(u32x4*)(z + (size_t)(m0 + row) * ldz + n0 + ch * 8) = v;
    }
    __syncthreads();
  }
}

__device__ __forceinline__ void gmlp_prompt_item(const Params& p, int l, int item, unsigned char* smem) {
  const int b = item >> 7, n = (item >> 2) & 31, g = item & 3;
  const int r0 = b * SEQ + n * 128;
  const bf16* z = (const bf16*)(p.ws + WS_Z);
  bf16* yab = (bf16*)(p.ws + WS_YAB);
  bf16* sW = (bf16*)smem;
  bf16* sV = (bf16*)(smem + 34816);
  float* srstd = (float*)(smem + 69632);
  const int tid = tidx(), lane = tid & 63, wave = tid >> 6, wr = wave >> 1, wc = wave & 1;
  {
    const int tok = tid >> 1, half = tid & 1;
    const uint4* ptr = (const uint4*)(z + (size_t)(r0 + tok) * ZAB + OFF_AV + half * 256);
    float ss = 0.f;
    for (int i = 0; i < 32; ++i) {
      float f[8];
      unpack8(ptr[i], f);
#pragma unroll
      for (int j = 0; j < 8; ++j) ss += f[j] * f[j];
    }
    ss += __shfl_xor(ss, 1);
    if (half == 0) srstd[tok] = rsqrtf(ss * (1.0f / 512.f) + EPS);
  }
  __syncthreads();
  const float* vg = p.vnorm_g + l * 512 + g * 128;
  for (int i = tid; i < 2048; i += 256) {
    const int s = i >> 4, c8 = (i & 15) * 8;
    float f[8];
    unpack8(*(const uint4*)(z + (size_t)(r0 + s) * ZAB + OFF_AV + g * 128 + c8), f);
    const float rs = srstd[s];
#pragma unroll
    for (int j = 0; j < 8; ++j) sV[(c8 + j) * 136 + s] = f2bf(f[j] * rs * vg[c8 + j]);
  }
  const float* Wg = p.gmlp_ws + ((size_t)(l * 4 + g)) * 128 * 128;
  for (int i = tid; i < 4096; i += 256) {
    const int t = i >> 5, s4 = (i & 31) * 4;
    const float4 w = *(const float4*)(Wg + t * 128 + s4);
    uint2 o;
    o.x = pack2(s4 + 0 <= t ? w.x : 0.f, s4 + 1 <= t ? w.y : 0.f);
    o.y = pack2(s4 + 2 <= t ? w.z : 0.f, s4 + 3 <= t ? w.w : 0.f);
    *(uint2*)(sW + t * 136 + s4) = o;
  }
  __syncthreads();
  f32x4 acc[4][4];
  zero_acc<4>(acc);
  mma_lds<4, 4>(acc, sW + wr * 64 * 136, 136, sV + wc * 64 * 136, 136, wr * 64 + 64, lane);
  const float* bs = p.gmlp_bs + (l * 4 + g) * 128;
#pragma unroll
  for (int i = 0; i < 4; ++i) {
    const int t = wr * 64 + i * 16 + (lane & 15);
    const float bst = bs[t];
    const size_t rowoff = (size_t)(r0 + t) * ZAB;
#pragma unroll
    for (int j = 0; j < 4; ++j) {
      const int c = g * 128 + wc * 64 + j * 16 + (lane >> 4) * 4;
      float u[4], ag[4];
      unpack4(*(const uint2*)(z + rowoff + c), u);
      unpack4(*(const uint2*)(z + rowoff + OFF_AG + c), ag);
      uint2 o;
      o.x = pack2(u[0] * (acc[i][j][0] + bst) * siluf_(ag[0]), u[1] * (acc[i][j][1] + bst) * siluf_(ag[1]));
      o.y = pack2(u[2] * (acc[i][j][2] + bst) * siluf_(ag[2]), u[3] * (acc[i][j][3] + bst) * siluf_(ag[3]));
      *(uint2*)(yab + (size_t)(r0 + t) * 1024 + c) = o;
    }
  }
  __syncthreads();
}

__device__ __forceinline__ void gmlp_sample_item(const Params& p, int l, int b, unsigned char* smem) {
  const int r0 = TP + b * 8;
  const bf16* z = (const bf16*)(p.ws + WS_Z);
  bf16* yab = (bf16*)(p.ws + WS_YAB);
  float* svn = (float*)smem;
  const int tid = tidx(), lane = tid & 63, wave = tid >> 6;
  const float* vg = p.vnorm_g + l * 512;
  for (int tt = 0; tt < 2; ++tt) {
    const int t = wave * 2 + tt;
    float f[8];
    unpack8(*(const uint4*)(z + (size_t)(r0 + t) * ZAB + OFF_AV + lane * 8), f);
    float ss = 0.f;
#pragma unroll
    for (int j = 0; j < 8; ++j) ss += f[j] * f[j];
    ss = wave_sum(ss);
    const float rstd = rsqrtf(ss * (1.0f / 512.f) + EPS);
    float* gv = p.out + O_GV + (((size_t)l * 128 + b) * 8 + t) * 512 + lane * 8;
#pragma unroll
    for (int j = 0; j < 8; ++j) {
      const float vn = f[j] * rstd * vg[lane * 8 + j];
      svn[t * 512 + lane * 8 + j] = vn;
      gv[j] = vn;
    }
  }
  __syncthreads();
  {
    const int c = tid * 2, g = c >> 7;
    const float* Wg = p.gmlp_ws + ((size_t)(l * 4 + g)) * 128 * 128;
    const float* bs = p.gmlp_bs + (l * 4 + g) * 128;
    for (int t = 0; t < 8; ++t) {
      float s0 = bs[t], s1 = bs[t];
      for (int s = 0; s <= t; ++s) {
        const float w = Wg[t * 128 + s];
        s0 += w * svn[s * 512 + c];
        s1 += w * svn[s * 512 + c + 1];
      }
      const unsigned uu = *(const unsigned*)(z + (size_t)(r0 + t) * ZAB + c);
      const unsigned gg = *(const unsigned*)(z + (size_t)(r0 + t) * ZAB + OFF_AG + c);
      *(unsigned*)(yab + (size_t)(r0 + t) * 1024 + c) = pack2(lo2f(uu) * s0 * siluf_(lo2f(gg)), hi2f(uu) * s1 * siluf_(hi2f(gg)));
    }
  }
  __syncthreads();
}

__device__ __forceinline__ void swa_prompt_item(const Params& p, int l, int item, unsigned char* smem) {
  const int b = item >> 7, qt = (item >> 1) & 63, kv = item & 1;
  const int q0 = qt * 64, rb = b * SEQ;
  const bf16* z = (const bf16*)(p.ws + WS_Z);
  bf16* yab = (bf16*)(p.ws + WS_YAB);
  bf16* sK = (bf16*)smem;
  bf16* sVT = (bf16*)(smem + 27648);
  const int tid = tidx(), lane = tid & 63, wave = tid >> 6;
  const float* kg = p.kn_g + l * 64;
  const float* qg = p.qn_g + l * 64;
#pragma unroll 1
  for (int it = 0; it < 6; ++it) {
    const int id = tid + 256 * it, kk = id >> 3, ch = id & 7, kp = q0 - 128 + kk;
    float f[8];
    uint4 vraw = make_uint4(0, 0, 0, 0);
    if (kp >= 0) {
      unpack8(*(const uint4*)(z + (size_t)(rb + kp) * ZAB + OFF_BK + kv * 64 + ch * 8), f);
      vraw = *(const uint4*)(z + (size_t)(rb + kp) * ZAB + OFF_BV + kv * 64 + ch * 8);
    } else {
#pragma unroll
      for (int j = 0; j < 8; ++j) f[j] = 0.f;
    }
    float ss = 0.f;
#pragma unroll
    for (int j = 0; j < 8; ++j) ss += f[j] * f[j];
    ss += __shfl_xor(ss, 1); ss += __shfl_xor(ss, 2); ss += __shfl_xor(ss, 4);
    const float rstd = rsqrtf(ss * (1.0f / 64.f) + EPS);
#pragma unroll
    for (int j = 0; j < 8; ++j) f[j] = f[j] * rstd * kg[ch * 8 + j];
    uint4 ko;
    ko.x = pack2(f[0], f[1]); ko.y = pack2(f[2], f[3]); ko.z = pack2(f[4], f[5]); ko.w = pack2(f[6], f[7]);
    *(uint4*)(sK + kk * 72 + ch * 8) = ko;
    float vf[8];
    unpack8(vraw, vf);
#pragma unroll
    for (int j = 0; j < 8; ++j) sVT[(ch * 8 + j) * 200 + kk] = f2bf(vf[j]);
    if (kk >= 128 && kp >= SEQ - 128) {
      const size_t o = ((((size_t)l * 4 + b) * 128 + (kp - (SEQ - 128))) * 2 + kv) * 64 + ch * 8;
#pragma unroll
      for (int j = 0; j < 8; ++j) { p.out[O_SKP + o + j] = f[j]; p.out[O_SVP + o + j] = vf[j]; }
    }
  }
  __syncthreads();
  const int h = kv * 4 + wave;
  const float sink = p.sinks[l * 8 + h];
  const int g4 = lane >> 4, r16 = lane & 15;
#pragma unroll 1
  for (int i = 0; i < 4; ++i) {
    const int qrow = q0 + i * 16 + r16;
    const size_t grow = (size_t)(rb + qrow);
    bf16x8 qf[2];
    {
      float f0[8], f1[8];
      unpack8(*(const uint4*)(z + grow * ZAB + OFF_BQ + h * 64 + g4 * 8), f0);
      unpack8(*(const uint4*)(z + grow * ZAB + OFF_BQ + h * 64 + 32 + g4 * 8), f1);
      float ss = 0.f;
#pragma unroll
      for (int j = 0; j < 8; ++j) ss += f0[j] * f0[j] + f1[j] * f1[j];
      ss += __shfl_xor(ss, 16); ss += __shfl_xor(ss, 32);
      const float rstd = rsqrtf(ss * (1.0f / 64.f) + EPS) * 0.125f;
#pragma unroll
      for (int j = 0; j < 8; ++j) {
        qf[0][j] = (short)f2bf(f0[j] * rstd * qg[g4 * 8 + j]);
        qf[1][j] = (short)f2bf(f1[j] * rstd * qg[32 + g4 * 8 + j]);
      }
    }
    f32x4 st[12];
#pragma unroll
    for (int kt = 0; kt < 12; ++kt) {
      st[kt] = (f32x4){0.f, 0.f, 0.f, 0.f};
#pragma unroll
      for (int ks = 0; ks < 2; ++ks) {
        const bf16x8 kf = *(const bf16x8*)(sK + (kt * 16 + r16) * 72 + ks * 32 + g4 * 8);
        st[kt] = mfma16(kf, qf[ks], st[kt]);
      }
      if ((kt & 1) == 1) __builtin_amdgcn_sched_barrier(0);
    }
    float mx = -INFINITY;
#pragma unroll
    for (int kt = 0; kt < 12; ++kt)
#pragma unroll
      for (int x = 0; x < 4; ++x) {
        const int kp = q0 - 128 + kt * 16 + g4 * 4 + x, diff = qrow - kp;
        const bool valid = (kp >= 0) && (diff >= 0) && (diff < 128);
        st[kt][x] = valid ? st[kt][x] : -INFINITY;
        mx = fmaxf(mx, st[kt][x]);
      }
    mx = fmaxf(mx, __shfl_xor(mx, 16)); mx = fmaxf(mx, __shfl_xor(mx, 32));
    mx = fmaxf(mx, sink);
    float sum = 0.f;
#pragma unroll
    for (int kt = 0; kt < 12; ++kt)
#pragma unroll
      for (int x = 0; x < 4; ++x) {
        const float pv = __expf(st[kt][x] - mx);
        st[kt][x] = pv;
        sum += pv;
      }
    sum += __shfl_xor(sum, 16); sum += __shfl_xor(sum, 32);
    const float inv = 1.0f / (sum + __expf(sink - mx));
    f32x4 o[4];
#pragma unroll
    for (int dt = 0; dt < 4; ++dt) o[dt] = (f32x4){0.f, 0.f, 0.f, 0.f};
#pragma unroll
    for (int t2 = 0; t2 < 6; ++t2) {
      bf16x8 pf;
#pragma unroll
      for (int x = 0; x < 4; ++x) { pf[x] = (short)f2bf(st[2 * t2][x]); pf[4 + x] = (short)f2bf(st[2 * t2 + 1][x]); }
#pragma unroll
      for (int dt = 0; dt < 4; ++dt) {
        const uint2 v0 = *(const uint2*)(sVT + (dt * 16 + r16) * 200 + t2 * 32 + g4 * 4);
        const uint2 v1 = *(const uint2*)(sVT + (dt * 16 + r16) * 200 + t2 * 32 + 16 + g4 * 4);
        union { uint4 u; bf16x8 v; } cv;
        cv.u = make_uint4(v0.x, v0.y, v1.x, v1.y);
        o[dt] = mfma16(cv.v, pf, o[dt]);
      }
      __builtin_amdgcn_sched_barrier(0);
    }
#pragma unroll
    for (int dt = 0; dt < 4; ++dt) {
      const int d0 = dt * 16 + g4 * 4;
      float bg[4];
      unpack4(*(const uint2*)(z + grow * ZAB + OFF_BG + h * 64 + d0), bg);
      uint2 oo;
      oo.x = pack2(o[dt][0] * inv * siluf_(bg[0]), o[dt][1] * inv * siluf_(bg[1]));
      oo.y = pack2(o[dt][2] * inv * siluf_(bg[2]), o[dt][3] * inv * siluf_(bg[3]));
      *(uint2*)(yab + grow * 1024 + 512 + h * 64 + d0) = oo;
    }
  }
  __syncthreads();
}

__device__ __forceinline__ void swa_sample_item(const Params& p, int l, int item, unsigned char* smem) {
  const int b = item >> 1, kv = item & 1;
  const int r0 = TP + b * 8;
  const bf16* z = (const bf16*)(p.ws + WS_Z);
  bf16* yab = (bf16*)(p.ws + WS_YAB);
  bf16* sK = (bf16*)smem;
  bf16* sV = (bf16*)(smem + 19584);
  float* sq = (float*)(smem + 39168);
  float* sP = (float*)(smem + 47488);
  const int tid = tidx();
  const float* kg = p.kn_g + l * 64;
  const float* qg = p.qn_g + l * 64;
  const float* ck = p.cache_k + ((size_t)l * 128 + b) * 128 * 128;
  const float* cvp = p.cache_v + ((size_t)l * 128 + b) * 128 * 128;
#pragma unroll 1
  for (int it = 0; it < 5; ++it) {
    const int id = tid + 256 * it, j = id >> 3, ch = id & 7;
    const bool act = id < 1088;
    float kf[8], vf[8];
#pragma unroll
    for (int x = 0; x < 8; ++x) { kf[x] = 0.f; vf[x] = 0.f; }
    if (act) {
      if (j < 128) {
        const float4 a0 = *(const float4*)(ck + (j * 2 + kv) * 64 + ch * 8), a1 = *(const float4*)(ck + (j * 2 + kv) * 64 + ch * 8 + 4);
        const float4 b0 = *(const float4*)(cvp + (j * 2 + kv) * 64 + ch * 8), b1 = *(const float4*)(cvp + (j * 2 + kv) * 64 + ch * 8 + 4);
        kf[0] = a0.x; kf[1] = a0.y; kf[2] = a0.z; kf[3] = a0.w; kf[4] = a1.x; kf[5] = a1.y; kf[6] = a1.z; kf[7] = a1.w;
        vf[0] = b0.x; vf[1] = b0.y; vf[2] = b0.z; vf[3] = b0.w; vf[4] = b1.x; vf[5] = b1.y; vf[6] = b1.z; vf[7] = b1.w;
      } else {
        unpack8(*(const uint4*)(z + (size_t)(r0 + j - 128) * ZAB + OFF_BK + kv * 64 + ch * 8), kf);
        unpack8(*(const uint4*)(z + (size_t)(r0 + j - 128) * ZAB + OFF_BV + kv * 64 + ch * 8), vf);
      }
    }
    float ss = 0.f;
#pragma unroll
    for (int x = 0; x < 8; ++x) ss += kf[x] * kf[x];
    ss += __shfl_xor(ss, 1); ss += __shfl_xor(ss, 2); ss += __shfl_xor(ss, 4);
    if (act) {
      if (j >= 128) {
        const float rstd = rsqrtf(ss * (1.0f / 64.f) + EPS);
#pragma unroll
        for (int x = 0; x < 8; ++x) kf[x] = kf[x] * rstd * kg[ch * 8 + x];
      }
      uint4 ko, vo;
      ko.x = pack2(kf[0], kf[1]); ko.y = pack2(kf[2], kf[3]); ko.z = pack2(kf[4], kf[5]); ko.w = pack2(kf[6], kf[7]);
      vo.x = pack2(vf[0], vf[1]); vo.y = pack2(vf[2], vf[3]); vo.z = pack2(vf[4], vf[5]); vo.w = pack2(vf[6], vf[7]);
      *(uint4*)(sK + j * 72 + ch * 8) = ko;
      *(uint4*)(sV + j * 72 + ch * 8) = vo;
      if (j >= 8) {
        const size_t o = ((((size_t)l * 128 + b) * 128 + (j - 8)) * 2 + kv) * 64 + ch * 8;
        *(float4*)(p.out + O_SKS + o) = make_float4(kf[0], kf[1], kf[2], kf[3]);
        *(float4*)(p.out + O_SKS + o + 4) = make_float4(kf[4], kf[5], kf[6], kf[7]);
        *(float4*)(p.out + O_SVS + o) = make_float4(vf[0], vf[1], vf[2], vf[3]);
        *(float4*)(p.out + O_SVS + o + 4) = make_float4(vf[4], vf[5], vf[6], vf[7]);
      }
    }
  }
  const int qi = tid >> 3, sub = tid & 7, t = qi >> 2, h = kv * 4 + (qi & 3);
  {
    float f[8];
    unpack8(*(const uint4*)(z + (size_t)(r0 + t) * ZAB + OFF_BQ + h * 64 + sub * 8), f);
    float ss = 0.f;
#pragma unroll
    for (int x = 0; x < 8; ++x) ss += f[x] * f[x];
    ss += __shfl_xor(ss, 1); ss += __shfl_xor(ss, 2); ss += __shfl_xor(ss, 4);
    const float rstd = rsqrtf(ss * (1.0f / 64.f) + EPS) * 0.125f;
#pragma unroll
    for (int x = 0; x < 8; ++x) sq[qi * 65 + sub * 8 + x] = f[x] * rstd * qg[sub * 8 + x];
  }
  __syncthreads();
  const float sink = p.sinks[l * 8 + h];
  float mx = -INFINITY;
#pragma unroll 1
  for (int jj = 0; jj < 17; ++jj) {
    const int key = sub + 8 * jj;
    float s = 0.f;
#pragma unroll 8
    for (int d = 0; d < 64; ++d) s += sq[qi * 65 + d] * bf2f(sK[key * 72 + d]);
    const bool valid = (key >= t + 1) && (key <= t + 128);
    s = valid ? s : -INFINITY;
    sP[qi * 140 + key] = s;
    mx = fmaxf(mx, s);
  }
  mx = fmaxf(mx, __shfl_xor(mx, 1)); mx = fmaxf(mx, __shfl_xor(mx, 2)); mx = fmaxf(mx, __shfl_xor(mx, 4));
  mx = fmaxf(mx, sink);
  float sum = 0.f;
  for (int jj = 0; jj < 17; ++jj) {
    const int key = sub + 8 * jj;
    const float pv = __expf(sP[qi * 140 + key] - mx);
    sP[qi * 140 + key] = pv;
    sum += pv;
  }
  sum += __shfl_xor(sum, 1); sum += __shfl_xor(sum, 2); sum += __shfl_xor(sum, 4);
  const float inv = 1.0f / (sum + __expf(sink - mx));
  __syncthreads();
  {
    float o[8];
#pragma unroll
    for (int x = 0; x < 8; ++x) o[x] = 0.f;
#pragma unroll 2
    for (int key = 0; key < 136; ++key) {
      const float pv = sP[qi * 140 + key];
      float vf[8];
      unpack8(*(const uint4*)(sV + key * 72 + sub * 8), vf);
#pragma unroll
      for (int x = 0; x < 8; ++x) o[x] += pv * vf[x];
    }
    float bg[8];
    unpack8(*(const uint4*)(z + (size_t)(r0 + t) * ZAB + OFF_BG + h * 64 + sub * 8), bg);
    uint4 oo;
    oo.x = pack2(o[0] * inv * siluf_(bg[0]), o[1] * inv * siluf_(bg[1]));
    oo.y = pack2(o[2] * inv * siluf_(bg[2]), o[3] * inv * siluf_(bg[3]));
    oo.z = pack2(o[4] * inv * siluf_(bg[4]), o[5] * inv * siluf_(bg[5]));
    oo.w = pack2(o[6] * inv * siluf_(bg[6]), o[7] * inv * siluf_(bg[7]));
    *(uint4*)(yab + (size_t)(r0 + t) * 1024 + 512 + h * 64 + sub * 8) = oo;
  }
  __syncthreads();
}

__device__ __forceinline__ void phase_mix_ab(const Params& p, int l, unsigned char* smem) {
  constexpr int N_SWA = 512, N_GM = 512, N_SWS = 256, N_GMS = 128;
  constexpr int N_ALL = N_SWA + N_GM + N_SWS + N_GMS;
  for (int it = blockIdx.x; it < N_ALL; it += gridDim.x) {
    int i = it;
    if (i < N_SWA) { swa_prompt_item(p, l, i, smem); continue; }
    i -= N_SWA;
    if (i < N_GM) { gmlp_prompt_item(p, l, i, smem); continue; }
    i -= N_GM;
    if (i < N_SWS) { swa_sample_item(p, l, i, smem); continue; }
    i -= N_SWS;
    gmlp_sample_item(p, l, i, smem);
  }
}

__device__ __forceinline__ void conv8_prompt(const Params& p, int l, const bf16* z, int r0, int pos0, int s, int zc, float* y) {
  const float* cw = p.conv_w + (size_t)l * 4 * 1024 + zc;
  const float* cb = p.conv_b + l * 1024 + zc;
#pragma unroll
  for (int j = 0; j < 8; ++j) y[j] = cb[j];
#pragma unroll
  for (int tap = 0; tap < 4; ++tap) {
    const int back = 3 - tap;
    if (pos0 + s - back >= 0) {
      float f[8];
      unpack8(*(const uint4*)(z + (size_t)(r0 + s - back) * ZC + C_QK + zc), f);
#pragma unroll
      for (int j = 0; j < 8; ++j) y[j] += cw[tap * 1024 + j] * f[j];
    }
  }
#pragma unroll
  for (int j = 0; j < 8; ++j) y[j] = siluf_(y[j]);
}

__device__ __forceinline__ void chunk_gates(const Params& p, int l, const bf16* z, int r0, int hh, int lane, float& cum, float& iv) {
  const float f = bf2f(z[(size_t)(r0 + lane) * ZC + C_F + hh]) + p.f_bias[l * 4 + hh];
  iv = bf2f(z[(size_t)(r0 + lane) * ZC + C_I + hh]);
  float c = logsigmoidf_(f);
#pragma unroll
  for (int o = 1; o < 64; o <<= 1) {
    const float n = __shfl_up(c, o);
    if (lane >= o) c += n;
  }
  cum = c;
}

__device__ __forceinline__ void mlstm_local_item(const Params& p, int l, int item, unsigned char* smem) {
  const int bh = item >> 6, c = item & 63, b = bh >> 2, hh = bh & 3;
  const int r0 = b * SEQ + c * 64;
  const bf16* z = (const bf16*)(p.ws + WS_Z);
  bf16* skT = (bf16*)smem;
  bf16* svT = (bf16*)(smem + 18432);
  float* swsel = (float*)(smem + 36864);
  const int tid = tidx(), lane = tid & 63, wave = tid >> 6, wr = wave >> 1, wc = wave & 1;
  if (wave == 0) {
    float cum, iv;
    chunk_gates(p, l, z, r0, hh, lane, cum, iv);
    const float total = __shfl(cum, 63);
    const float g = total - cum + iv;
    const float G = wave_max(g);
    swsel[lane] = __expf(g - G);
    if (lane == 0) {
      ((float*)(p.ws + WS_G))[item] = G;
      ((float*)(p.ws + WS_TOT))[item] = total;
    }
  }
  __syncthreads();
  for (int i = tid; i < 1024; i += 256) {
    const int s = i >> 4, d8 = (i & 15) * 8;
    float y[8];
    conv8_prompt(p, l, z, r0, c * 64, s, 512 + hh * 128 + d8, y);
    {
      uint4 ko;
      ko.x = pack2(y[0] * 0.08838834764831845f, y[1] * 0.08838834764831845f); ko.y = pack2(y[2] * 0.08838834764831845f, y[3] * 0.08838834764831845f);
      ko.z = pack2(y[4] * 0.08838834764831845f, y[5] * 0.08838834764831845f); ko.w = pack2(y[6] * 0.08838834764831845f, y[7] * 0.08838834764831845f);
      *(uint4*)((bf16*)(p.ws + WS_H) + (size_t)(r0 + s) * 512 + hh * 128 + d8) = ko;
    }
    const float sc = 0.08838834764831845f * swsel[s];
#pragma unroll
    for (int j = 0; j < 8; ++j) skT[(d8 + j) * 72 + s] = f2bf(y[j] * sc);
    float v[8];
    unpack8(*(const uint4*)(z + (size_t)(r0 + s) * ZC + C_V + hh * 128 + d8), v);
#pragma unroll
    for (int j = 0; j < 8; ++j) svT[(d8 + j) * 72 + s] = f2bf(v[j]);
  }
  __syncthreads();
  f32x4 acc[4][4];
  zero_acc<4>(acc);
  mma_lds<4, 4>(acc, svT + wr * 64 * 72, 72, skT + wc * 64 * 72, 72, 64, lane);
  bf16* U = (bf16*)(p.ws + WS_U) + (size_t)item * 16384;
#pragma unroll
  for (int i = 0; i < 4; ++i)
#pragma unroll
    for (int j = 0; j < 4; ++j) {
      const int e = wr * 64 + i * 16 + (lane & 15), d = wc * 64 + j * 16 + (lane >> 4) * 4;
      uint2 o;
      o.x = pack2(acc[i][j][0], acc[i][j][1]);
      o.y = pack2(acc[i][j][2], acc[i][j][3]);
      *(uint2*)(U + e * 128 + d) = o;
    }
  if (tid < 128) {
    float s = 0.f;
    for (int k = 0; k < 64; ++k) s += bf2f(skT[tid * 72 + k]);
    ((float*)(p.ws + WS_UN))[(size_t)item * 128 + tid] = s;
  }
  __syncthreads();
}

__device__ __forceinline__ void mlstm_convout_item(const Params& p, int l, int b) {
  const bf16* z = (const bf16*)(p.ws + WS_Z);
  for (int i = tidx(); i < 3 * 1024; i += 256) {
    const int j = i >> 10, ch = i & 1023;
    p.out[O_CVP + (((size_t)l * 4 + b) * 3 + j) * 1024 + ch] = bf2f(z[(size_t)(b * SEQ + SEQ - 3 + j) * ZC + C_QK + ch]);
  }
}

__device__ __forceinline__ void mlstm_sample_item(const Params& p, int l, int item, unsigned char* smem) {
  const int b = item >> 2, hh = item & 3;
  const int r0 = TP + b * 8;
  bf16* z = (bf16*)(p.ws + WS_Z);
  float* sq = (float*)smem;
  float* sk = sq + 1024;
  float* sv = sk + 1024;
  float* sh = sv + 1024;
  float* sint = sh + 1024;
  float* sa = sint + 2048;
  float* sqn = sa + 64;
  float* smt = sqn + 8;
  float* swi = smt + 8;
  float* swsel = swi + 8;
  float* sdm = swsel + 8;
  float* sdecay = sdm + 64;
  const int tid = tidx(), lane = tid & 63, wave = tid >> 6;
  {
    const int isk = tid >> 7, d = tid & 127, zc = isk * 512 + hh * 128 + d;
    const float* cw = p.conv_w + (size_t)l * 4 * 1024 + zc;
    const float cb = p.conv_b[l * 1024 + zc];
    float xp[11];
    const float* cs = p.st_conv + ((size_t)l * 128 + b) * 3 * 1024 + zc;
    xp[0] = cs[0]; xp[1] = cs[1024]; xp[2] = cs[2048];
#pragma unroll
    for (int t = 0; t < 8; ++t) xp[3 + t] = bf2f(z[(size_t)(r0 + t) * ZC + C_QK + zc]);
    const float w0 = cw[0], w1 = cw[1024], w2 = cw[2048], w3 = cw[3072];
    float* dst = isk ? sk : sq;
    const float sc = isk ? 0.08838834764831845f : 1.0f;
#pragma unroll
    for (int t = 0; t < 8; ++t) {
      const float y = cb + w0 * xp[t] + w1 * xp[t + 1] + w2 * xp[t + 2] + w3 * xp[t + 3];
      dst[t * 128 + d] = siluf_(y) * sc;
    }
    float* co = p.out + O_CVS + ((size_t)l * 128 + b) * 3 * 1024 + zc;
    co[0] = xp[8]; co[1024] = xp[9]; co[2048] = xp[10];
  }
  for (int i = tid; i < 1024; i += 256) {
    const int t = i >> 7, e = i & 127;
    sv[i] = bf2f(z[(size_t)(r0 + t) * ZC + C_V + hh * 128 + e]);
  }
  if (tid == 0) {
    float cum[8], iv[8];
    float c = 0.f;
    for (int t = 0; t < 8; ++t) {
      const float f = bf2f(z[(size_t)(r0 + t) * ZC + C_F + hh]) + p.f_bias[l * 4 + hh];
      c += logsigmoidf_(f);
      cum[t] = c;
      iv[t] = bf2f(z[(size_t)(r0 + t) * ZC + C_I + hh]);
    }
    const float m0 = p.st_m[(l * 128 + b) * 4 + hh];
    for (int t = 0; t < 8; ++t) {
      float dmax = -INFINITY;
      for (int s = 0; s <= t; ++s) dmax = fmaxf(dmax, cum[t] - cum[s] + iv[s]);
      const float mi = cum[t] + m0, mt = fmaxf(mi, dmax);
      smt[t] = mt;
      swi[t] = __expf(mi - mt);
      for (int s = 0; s < 8; ++s) sdm[t * 8 + s] = (s <= t) ? __expf(cum[t] - cum[s] + iv[s] - mt) : 0.f;
    }
    const float total = cum[7];
    float gm = -INFINITY;
    for (int s = 0; s < 8; ++s) gm = fmaxf(gm, total - cum[s] + iv[s]);
    const float mn = fmaxf(total + m0, gm);
    for (int s = 0; s < 8; ++s) swsel[s] = __expf(total - cum[s] + iv[s] - mn);
    sdecay[0] = __expf(total + m0 - mn);
    p.out[O_MS + (l * 128 + b) * 4 + hh] = mn;
  }
  __syncthreads();
  const float* n0 = p.st_n + (((size_t)l * 128 + b) * 4 + hh) * 128;
  if (tid < 64) {
    const int t = tid >> 3, s = tid & 7;
    float dsum = 0.f;
    for (int d = 0; d < 128; ++d) dsum += sq[t * 128 + d] * sk[s * 128 + d];
    sa[t * 8 + s] = sdm[t * 8 + s] * dsum;
  } else if (tid < 128) {
    const int t = (tid - 64) >> 3, part = (tid - 64) & 7;
    float dsum = 0.f;
    for (int d = part * 16; d < part * 16 + 16; ++d) dsum += sq[t * 128 + d] * n0[d];
    dsum += __shfl_xor(dsum, 1); dsum += __shfl_xor(dsum, 2); dsum += __shfl_xor(dsum, 4);
    if (part == 0) sqn[t] = dsum;
  }
  __syncthreads();
  {
    const int e = tid & 127, dh = tid >> 7;
    const float decay = sdecay[0];
    const float* C0 = p.st_C + (((size_t)l * 128 + b) * 4 + hh) * 16384;
    float* C1 = p.out + O_CS + (((size_t)l * 128 + b) * 4 + hh) * 16384;
    float vw[8], inter[8];
#pragma unroll
    for (int s = 0; s < 8; ++s) { vw[s] = sv[s * 128 + e] * swsel[s]; inter[s] = 0.f; }
    for (int d = dh * 64; d < dh * 64 + 64; ++d) {
      const float c0 = C0[d * 128 + e];
      float upd = decay * c0;
#pragma unroll
      for (int s = 0; s < 8; ++s) {
        upd += sk[s * 128 + d] * vw[s];
        inter[s] += sq[s * 128 + d] * c0;
      }
      C1[d * 128 + e] = upd;
    }
#pragma unroll
    for (int t = 0; t < 8; ++t) sint[(dh * 8 + t) * 128 + e] = inter[t];
  }
  __syncthreads();
  if (tid < 128) {
    const int e = tid;
    for (int t = 0; t < 8; ++t) {
      float num = swi[t] * (sint[t * 128 + e] + sint[(8 + t) * 128 + e]);
      float den = swi[t] * sqn[t];
      for (int s = 0; s <= t; ++s) { num += sa[t * 8 + s] * sv[s * 128 + e]; den += sa[t * 8 + s]; }
      sh[t * 128 + e] = num / fmaxf(fabsf(den), __expf(-smt[t]));
    }
    float nn = sdecay[0] * n0[e];
    for (int s = 0; s < 8; ++s) nn += swsel[s] * sk[s * 128 + e];
    p.out[O_NS + (((size_t)l * 128 + b) * 4 + hh) * 128 + e] = nn;
  }
  __syncthreads();
  const float* hg = p.hnorm_g + l * 512 + hh * 128;
  for (int tt = 0; tt < 2; ++tt) {
    const int t = wave * 2 + tt;
    const float h0 = sh[t * 128 + lane], h1 = sh[t * 128 + 64 + lane];
    const float ss = wave_sum(h0 * h0 + h1 * h1);
    const float rstd = rsqrtf(ss * (1.0f / 128.f) + EPS);
    bf16* zr = z + (size_t)(r0 + t) * ZC;
#pragma unroll
    for (int k = 0; k < 2; ++k) {
      const int e = lane + 64 * k;
      const float hv = k ? h1 : h0;
      const float o = bf2f(zr[C_O + hh * 128 + e]), cg_ = bf2f(zr[C_G + hh * 128 + e]);
      zr[C_O + hh * 128 + e] = f2bf(hv * rstd * hg[e] * sigmoidf_(o) * siluf_(cg_));
    }
  }
  __syncthreads();
}

__device__ __forceinline__ void phase_mix1(const Params& p, int l, unsigned char* smem) {
  constexpr int N_LOC = 1024, N_SMP = 512, N_CV = 4;
  constexpr int N_ALL = N_LOC + N_SMP + N_CV;
  for (int it = blockIdx.x; it < N_ALL; it += gridDim.x) {
    int i = it;
    if (i < N_LOC) { mlstm_local_item(p, l, i, smem); continue; }
    i -= N_LOC;
    if (i < N_SMP) { mlstm_sample_item(p, l, i, smem); continue; }
    i -= N_SMP;
    mlstm_convout_item(p, l, i);
  }
}

__device__ __forceinline__ void phase_scan(const Params& p, int l, unsigned char* smem) {
  float* sdec = (float*)smem;
  float* ssc = sdec + 64;
  const int tid = tidx();
  float* Gb = (float*)(p.ws + WS_G);
  float* Tb = (float*)(p.ws + WS_TOT);
  float* Mb = (float*)(p.ws + WS_M);
  for (int it = blockIdx.x; it < 256; it += gridDim.x) {
    const int bh = it >> 4, slice = it & 15;
    if (tid < 64) { sdec[128 + tid] = Gb[bh * 64 + tid]; sdec[192 + tid] = Tb[bh * 64 + tid]; }
    __syncthreads();
    if (tid == 0) {
      float m = 0.f;
      for (int c = 0; c < 64; ++c) {
        const float G = sdec[128 + c], tot = sdec[192 + c];
        const float mn = fmaxf(tot + m, G);
        sdec[c] = __expf(tot + m - mn);
        ssc[c] = __expf(G - mn);
        if (slice == 0) Mb[bh * 64 + c] = m;
        m = mn;
      }
      if (slice == 0) p.out[O_MP + l * 16 + bh] = m;
    }
    __syncthreads();
    {
      const int idx = slice * 1024 + tid * 4;
      bf16* U = (bf16*)(p.ws + WS_U) + (size_t)bh * 64 * 16384 + idx;
      float st[4] = {0.f, 0.f, 0.f, 0.f};
#pragma unroll 8
      for (int c = 0; c < 64; ++c) {
        float u[4];
        unpack4(*(const uint2*)(U + (size_t)c * 16384), u);
        uint2 o;
        o.x = pack2(st[0], st[1]); o.y = pack2(st[2], st[3]);
        *(uint2*)(U + (size_t)c * 16384) = o;
        const float dc = sdec[c], sc = ssc[c];
#pragma unroll
        for (int x = 0; x < 4; ++x) st[x] = dc * st[x] + sc * u[x];
      }
      const int e = idx >> 7, d0 = idx & 127;
      float* Co = p.out + O_CP + ((size_t)l * 16 + bh) * 16384;
#pragma unroll
      for (int x = 0; x < 4; ++x) Co[(d0 + x) * 128 + e] = st[x];
    }
    if (slice == 0 && tid < 128) {
      float* un = (float*)(p.ws + WS_UN) + (size_t)bh * 64 * 128 + tid;
      float n = 0.f;
#pragma unroll 8
      for (int c = 0; c < 64; ++c) {
        const float u = un[c * 128];
        un[c * 128] = n;
        n = sdec[c] * n + ssc[c] * u;
      }
      p.out[O_NP + ((size_t)l * 16 + bh) * 128 + tid] = n;
    }
    __syncthreads();
  }
}

__device__ __forceinline__ void mlstm_out_item(const Params& p, int l, int item, unsigned char* smem) {
  const int bh = item >> 6, c = item & 63, b = bh >> 2, hh = bh & 3;
  const int r0 = b * SEQ + c * 64;
  bf16* z = (bf16*)(p.ws + WS_Z);
  bf16* sq = (bf16*)smem;
  bf16* sk = (bf16*)(smem + 17408);
  bf16* svT = (bf16*)(smem + 34816);
  bf16* sa = (bf16*)(smem + 53248);
  float* scum = (float*)(smem + 62464);
  float* siv = scum + 64;
  float* smt = siv + 64;
  float* swi = smt + 64;
  float* sden = swi + 64;
  float* sqn = sden + 64;
  float* spart = sqn + 64;
  const int tid = tidx(), lane = tid & 63, wave = tid >> 6;
  const int r16 = lane & 15, g4 = lane >> 4;
  if (wave == 0) {
    float cum, iv;
    chunk_gates(p, l, z, r0, hh, lane, cum, iv);
    scum[lane] = cum;
    siv[lane] = iv;
  }
  for (int i = tid; i < 1024; i += 256) {
    const int s = i >> 4, d8 = (i & 15) * 8;
    *(uint4*)(sk + s * 136 + d8) = *(const uint4*)((const bf16*)(p.ws + WS_H) + (size_t)(r0 + s) * 512 + hh * 128 + d8);
  }
  for (int i = tid; i < 1024; i += 256) {
    const int s = i >> 4, d8 = (i & 15) * 8;
    float y[8];
    conv8_prompt(p, l, z, r0, c * 64, s, hh * 128 + d8, y);
    uint4 o;
    o.x = pack2(y[0], y[1]); o.y = pack2(y[2], y[3]);
    o.z = pack2(y[4], y[5]); o.w = pack2(y[6], y[7]);
    *(uint4*)(sq + s * 136 + d8) = o;
  }
  for (int i = tid; i < 1024; i += 256) {
    const int s = i >> 4, d8 = (i & 15) * 8;
    float v[8];
    unpack8(*(const uint4*)(z + (size_t)(r0 + s) * ZC + C_V + hh * 128 + d8), v);
#pragma unroll
    for (int j = 0; j < 8; ++j) svT[(d8 + j) * 72 + s] = f2bf(v[j]);
  }
  __syncthreads();
  const float m_prev = ((const float*)(p.ws + WS_M))[item];
  {
    const int t = wave * 16 + r16;
    bf16x8 qf[4];
#pragma unroll
    for (int ks = 0; ks < 4; ++ks) qf[ks] = *(const bf16x8*)(sq + t * 136 + ks * 32 + g4 * 8);
    f32x4 st[4];
#pragma unroll
    for (int kt = 0; kt < 4; ++kt) {
      st[kt] = (f32x4){0.f, 0.f, 0.f, 0.f};
#pragma unroll
      for (int ks = 0; ks < 4; ++ks) {
        const bf16x8 kf = *(const bf16x8*)(sk + (kt * 16 + r16) * 136 + ks * 32 + g4 * 8);
        st[kt] = mfma16(kf, qf[ks], st[kt]);
      }
    }
    const float cumt = scum[t];
    float dm[4][4];
    float rmax = -INFINITY;
#pragma unroll
    for (int kt = 0; kt < 4; ++kt)
#pragma unroll
      for (int x = 0; x < 4; ++x) {
        const int s = kt * 16 + g4 * 4 + x;
        dm[kt][x] = (s <= t) ? (cumt - scum[s] + siv[s]) : -INFINITY;
        rmax = fmaxf(rmax, dm[kt][x]);
      }
    rmax = fmaxf(rmax, __shfl_xor(rmax, 16)); rmax = fmaxf(rmax, __shfl_xor(rmax, 32));
    const float mi = cumt + m_prev, mt = fmaxf(mi, rmax);
    float rsum = 0.f;
#pragma unroll
    for (int kt = 0; kt < 4; ++kt) {
      float a[4];
#pragma unroll
      for (int x = 0; x < 4; ++x) {
        const int s = kt * 16 + g4 * 4 + x;
        a[x] = (s <= t) ? __expf(dm[kt][x] - mt) * st[kt][x] : 0.f;
        rsum += a[x];
      }
      uint2 o;
      o.x = pack2(a[0], a[1]); o.y = pack2(a[2], a[3]);
      *(uint2*)(sa + t * 72 + kt * 16 + g4 * 4) = o;
    }
    rsum += __shfl_xor(rsum, 16); rsum += __shfl_xor(rsum, 32);
    if (g4 == 0) { smt[t] = mt; swi[t] = __expf(mi - mt); sden[t] = rsum; }
  }
  {
    const int t = tid >> 2, part = tid & 3;
    const float* nc = (const float*)(p.ws + WS_UN) + (size_t)item * 128;
    float s = 0.f;
    for (int d = part * 32; d < part * 32 + 32; ++d) s += bf2f(sq[t * 136 + d]) * nc[d];
    s += __shfl_xor(s, 1); s += __shfl_xor(s, 2);
    if (part == 0) sqn[t] = s;
  }
  __syncthreads();
  f32x4 acc[4][2];
#pragma unroll
  for (int ti = 0; ti < 4; ++ti)
#pragma unroll
    for (int et = 0; et < 2; ++et) acc[ti][et] = (f32x4){0.f, 0.f, 0.f, 0.f};
  const bf16* Cc = (const bf16*)(p.ws + WS_U) + (size_t)item * 16384;
#pragma unroll
  for (int ks = 0; ks < 4; ++ks) {
    bf16x8 cf[2], qf[4];
#pragma unroll
    for (int et = 0; et < 2; ++et) cf[et] = *(const bf16x8*)(Cc + (wave * 32 + et * 16 + r16) * 128 + ks * 32 + g4 * 8);
#pragma unroll
    for (int ti = 0; ti < 4; ++ti) qf[ti] = *(const bf16x8*)(sq + (ti * 16 + r16) * 136 + ks * 32 + g4 * 8);
#pragma unroll
    for (int ti = 0; ti < 4; ++ti)
#pragma unroll
      for (int et = 0; et < 2; ++et) acc[ti][et] = mfma16(cf[et], qf[ti], acc[ti][et]);
  }
#pragma unroll
  for (int ti = 0; ti < 4; ++ti) {
    const float w = swi[ti * 16 + r16];
#pragma unroll
    for (int et = 0; et < 2; ++et) acc[ti][et] *= w;
  }
#pragma unroll
  for (int ks = 0; ks < 2; ++ks) {
    bf16x8 vf[2], af[4];
#pragma unroll
    for (int et = 0; et < 2; ++et) vf[et] = *(const bf16x8*)(svT + (wave * 32 + et * 16 + r16) * 72 + ks * 32 + g4 * 8);
#pragma unroll
    for (int ti = 0; ti < 4; ++ti) af[ti] = *(const bf16x8*)(sa + (ti * 16 + r16) * 72 + ks * 32 + g4 * 8);
#pragma unroll
    for (int ti = 0; ti < 4; ++ti)
#pragma unroll
      for (int et = 0; et < 2; ++et) acc[ti][et] = mfma16(vf[et], af[ti], acc[ti][et]);
  }
#pragma unroll
  for (int ti = 0; ti < 4; ++ti) {
    const int t = ti * 16 + r16;
    const float den = sden[t] + swi[t] * sqn[t];
    const float inv = 1.0f / fmaxf(fabsf(den), __expf(-smt[t]));
    float ss = 0.f;
#pragma unroll
    for (int et = 0; et < 2; ++et) {
      acc[ti][et] *= inv;
#pragma unroll
      for (int x = 0; x < 4; ++x) ss += acc[ti][et][x] * acc[ti][et][x];
    }
    ss += __shfl_xor(ss, 16); ss += __shfl_xor(ss, 32);
    if (g4 == 0) spart[t * 4 + wave] = ss;
  }
  __syncthreads();
  const float* hg = p.hnorm_g + l * 512 + hh * 128;
#pragma unroll
  for (int ti = 0; ti < 4; ++ti) {
    const int t = ti * 16 + r16;
    const float rstd = rsqrtf((spart[t * 4] + spart[t * 4 + 1] + spart[t * 4 + 2] + spart[t * 4 + 3]) * (1.0f / 128.f) + EPS);
    bf16* zr = z + (size_t)(r0 + t) * ZC;
#pragma unroll
    for (int et = 0; et < 2; ++et) {
      const int e = wave * 32 + et * 16 + g4 * 4;
      float o[4], cg_[4];
      unpack4(*(const uint2*)(zr + C_O + hh * 128 + e), o);
      unpack4(*(const uint2*)(zr + C_G + hh * 128 + e), cg_);
      float y[4];
#pragma unroll
      for (int x = 0; x < 4; ++x) y[x] = acc[ti][et][x] * rstd * hg[e + x] * sigmoidf_(o[x]) * siluf_(cg_[x]);
      uint2 oo;
      oo.x = pack2(y[0], y[1]); oo.y = pack2(y[2], y[3]);
      *(uint2*)(zr + C_O + hh * 128 + e) = oo;
    }
  }
  __syncthreads();
}

__device__ __forceinline__ void phase_mix2(const Params& p, int l, unsigned char* smem) {
  for (int it = blockIdx.x; it < 1024; it += gridDim.x) mlstm_out_item(p, l, it, smem);
}

__device__ __forceinline__ void phase_gemm_br(const Params& p, int l, unsigned char* smem) {
  bf16* sm = (bf16*)smem;
  const bf16* hbuf = (const bf16*)(p.ws + WS_H);
  const bf16* Win = (const bf16*)(p.ws + WS_WIN) + (size_t)l * NWIN * 1024;
  const bf16* Wbr = (const bf16*)(p.ws + WS_WBR) + (size_t)l * 1024 * 1536;
  const bf16* yab = (const bf16*)(p.ws + WS_YAB);
  const bf16* z = (const bf16*)(p.ws + WS_Z);
  bf16* merged = (bf16*)(p.ws + WS_U);
  const float* bias = p.b_in + (size_t)l * ZIN + OFF_MG;
  const int lane = tidx() & 63, wave = tidx() >> 6, wr = wave >> 1, wc = wave & 1;
  const int ntiles = (TT / 128) * 8;
  for (int t = blockIdx.x; t < ntiles; t += gridDim.x) {
    int pm, pn;
    tile_map(t, 8, pm, pn);
    const int m0 = pm * 128, n0 = pn * 128;
#pragma unroll 1
    for (int seg = 0; seg < 3; ++seg) {
      f32x4 acc[4][4];
      zero_acc<4>(acc);
      gemm_accum_f8<4>(acc, p.ws + WS_H8 + (size_t)m0 * 1024, p.ws + WS_W8 + ((size_t)l * W8_ROWS + (OFF_MG - W8_ROW0) + seg * 1024 + n0) * 1024, sm);
      unsigned gp[4][4][2];
#pragma unroll
      for (int j = 0; j < 4; ++j) {
        const int col = n0 + wc * 64 + j * 16 + (lane >> 4) * 4;
        const float4 bb = *(const float4*)(bias + seg * 1024 + col);
#pragma unroll
        for (int i = 0; i < 4; ++i) {
          gp[i][j][0] = pack2(sigmoidf_(acc[i][j][0] * 0.015625f + bb.x), sigmoidf_(acc[i][j][1] * 0.015625f + bb.y));
          gp[i][j][1] = pack2(sigmoidf_(acc[i][j][2] * 0.015625f + bb.z), sigmoidf_(acc[i][j][3] * 0.015625f + bb.w));
        }
      }
      zero_acc<4>(acc);
      const bf16* A = (seg == 0) ? yab + (size_t)m0 * 1024 : (seg == 1) ? yab + (size_t)m0 * 1024 + 512 : z + (size_t)m0 * ZC + C_O;
      const int lda = (seg == 2) ? ZC : 1024;
      gemm_accum<4, true>(acc, A, lda, Wbr + (size_t)n0 * 1536 + seg * 512, 1536, 512, sm);
#pragma unroll
      for (int i = 0; i < 4; ++i)
#pragma unroll
        for (int j = 0; j < 4; ++j) {
          const int row = m0 + wr * 64 + i * 16 + (lane & 15), col = n0 + wc * 64 + j * 16 + (lane >> 4) * 4;
          uint2* mp = (uint2*)(merged + (size_t)row * 1024 + col);
          uint2 prev = make_uint2(0u, 0u);
          if (seg > 0) prev = *mp;
          uint2 o;
          o.x = pack2(lo2f(prev.x) + lo2f(gp[i][j][0]) * acc[i][j][0], hi2f(prev.x) + hi2f(gp[i][j][0]) * acc[i][j][1]);
          o.y = pack2(lo2f(prev.y) + lo2f(gp[i][j][1]) * acc[i][j][2], hi2f(prev.y) + hi2f(gp[i][j][1]) * acc[i][j][3]);
          *mp = o;
        }
    }
  }
}

__device__ __forceinline__ void phase_gemm_out(const Params& p, int l, unsigned char* smem) {
  bf16* sm = (bf16*)smem;
  const bf16* merged = (const bf16*)(p.ws + WS_U);
  const bf16* Wout = (const bf16*)(p.ws + WS_WOUT) + (size_t)l * 1024 * 1024;
  const float* mod = (const float*)(p.ws + WS_MOD);
  const int lane = tidx() & 63, wave = tidx() >> 6, wr = wave >> 1, wc = wave & 1;
  const int ntiles = (TT / 128) * 8;
  for (int t = blockIdx.x; t < ntiles; t += gridDim.x) {
    int pm, pn;
    tile_map(t, 8, pm, pn);
    const int m0 = pm * 128, n0 = pn * 128;
    f32x4 acc[4][4];
    zero_acc<4>(acc);
    gemm_accum<4>(acc, merged + (size_t)m0 * 1024, 1024, Wout + (size_t)n0 * 1024, 1024, 1024, sm);
#pragma unroll
    for (int i = 0; i < 4; ++i) {
      const int row = m0 + wr * 64 + i * 16 + (lane & 15);
      const float* xr = xrow_ptr(p, l, row);
      const float* gate = mod + ((size_t)l * NMOD + mod_row(row)) * 3072 + 2048;
#pragma unroll
      for (int j = 0; j < 4; ++j) {
        const int col = n0 + wc * 64 + j * 16 + (lane >> 4) * 4;
        const float4 xv = *(const float4*)(xr + col), gv = *(const float4*)(gate + col);
        float4 o;
        o.x = xv.x + gv.x * acc[i][j][0]; o.y = xv.y + gv.y * acc[i][j][1];
        o.z = xv.z + gv.z * acc[i][j][2]; o.w = xv.w + gv.w * acc[i][j][3];
        *(float4*)(p.out + (size_t)row * D + col) = o;
      }
    }
  }
}

constexpr int N_PHASES = 19;
template <int S>
__device__ __forceinline__ void run_stage(const Params& p, int l, unsigned char* smem) {
  if (S == -1) phase_prep(p, smem);
  if (S == 0) phase_norm(p, l);
  if (S == 1) phase_gemm_in(p, l, 0, ZAB / 128, ZAB, smem);
  if (S == 2) phase_mix_ab(p, l, smem);
  if (S == 3) phase_gemm_in(p, l, ZAB, ZC / 128, ZC, smem);
  if (S == 4) phase_mix1(p, l, smem);
  if (S == 5) phase_scan(p, l, smem);
  if (S == 6) phase_mix2(p, l, smem);
  if (S == 7) phase_gemm_br(p, l, smem);
  if (S == 8) phase_gemm_out(p, l, smem);
}


#define XB_TMO      128
#define XB_XCNT(j)  (256  + 64 * (j))
#define XB_XSUB(j)  (1280 + 64 * (j))
#define XB_XGEN(j)  (2304 + 64 * (j))
#define XB_TOP      3328
#define XB_TOPGEN   3392
#define XCD_BAR_WORDS 3456
#define XB_SPIN_CAP (1u << 18)
#define LAS __attribute__((address_space(3)))
__device__ __forceinline__ unsigned xb_ld(unsigned* p)              { return __hip_atomic_load(p, __ATOMIC_RELAXED, __HIP_MEMORY_SCOPE_AGENT); }
__device__ __forceinline__ unsigned xb_add(unsigned* p, unsigned v) { return __hip_atomic_fetch_add(p, v, __ATOMIC_RELAXED, __HIP_MEMORY_SCOPE_AGENT); }
__device__ __forceinline__ unsigned xb_xcc_id() { return (unsigned)__builtin_amdgcn_s_getreg((3 << 11) | 20) & 0xFu; }
#define XB_SPIN(cond, bar) do { unsigned _sp = 0; while (cond) { __builtin_amdgcn_s_sleep(1); \
    if ((++_sp & 255u) == 0u) { if (xb_ld(&(bar)[XB_TMO])) break; if (_sp > XB_SPIN_CAP) { atomicAdd(&(bar)[XB_TMO], 1u); break; } } } } while (0)
struct XcdBarrier { unsigned* bar; unsigned x; volatile LAS unsigned* st; };
__device__ __forceinline__ XcdBarrier xcd_barrier_post(unsigned* bar, volatile LAS unsigned* st) {
  XcdBarrier b; b.bar = bar; b.x = xb_xcc_id(); b.st = st;
  if (threadIdx.x == 0) (void)xb_add(&bar[XB_XCNT(b.x)], 1u);
  return b;
}
__device__ __forceinline__ void xcd_barrier_complete(unsigned* bar, unsigned x, unsigned& nloc, unsigned& nx) {
  const unsigned G = gridDim.x * gridDim.y * gridDim.z;
  unsigned sum, cnt, mine, sp = 0u;
  for (;;) {
    sum = 0u; cnt = 0u; mine = 0u;
#pragma unroll
    for (unsigned j = 0; j < 16; ++j) { const unsigned c = xb_ld(&bar[XB_XCNT(j)]); sum += c; cnt += (c > 0u) ? 1u : 0u; mine = (j == x) ? c : mine; }
    if (sum == G) break;
    __builtin_amdgcn_s_sleep(1);
    if ((++sp & 255u) == 0u) { if (xb_ld(&bar[XB_TMO])) break; if (sp > XB_SPIN_CAP) { atomicAdd(&bar[XB_TMO], 1u); break; } }
  }
  nloc = mine > 0u ? mine : 1u; nx = cnt > 0u ? cnt : 1u;
}
__device__ __forceinline__ void xcd_barrier(const XcdBarrier& b) {
  asm volatile("s_waitcnt vmcnt(0)" ::: "memory");
  __syncthreads();
  if (threadIdx.x == 0) {
    unsigned* bar = b.bar;
    __builtin_amdgcn_s_waitcnt(0);
    unsigned nloc = b.st[0], nx = b.st[1];
    if (nloc == 0u) { xcd_barrier_complete(bar, b.x, nloc, nx); b.st[0] = nloc; b.st[1] = nx; }
    const unsigned old = xb_add(&bar[XB_XSUB(b.x)], 1u);
    const unsigned gen = old / nloc;
    if (old + 1u == (gen + 1u) * nloc) {
      __builtin_amdgcn_fence(__ATOMIC_RELEASE, "agent");
      asm volatile("s_waitcnt vmcnt(0)" ::: "memory");
      const unsigned og = xb_add(&bar[XB_TOP], 1u);
      const unsigned tg = og / nx;
      if (og + 1u == (tg + 1u) * nx) xb_add(&bar[XB_TOPGEN], 1u);
      else XB_SPIN(xb_ld(&bar[XB_TOPGEN]) == tg, bar);
      __builtin_amdgcn_fence(__ATOMIC_ACQUIRE, "agent");
      xb_add(&bar[XB_XGEN(b.x)], 1u);
      asm volatile("s_waitcnt vmcnt(0)" ::: "memory");
    } else {
      XB_SPIN(xb_ld(&bar[XB_XGEN(b.x)]) == gen, bar);
      __builtin_amdgcn_fence(__ATOMIC_ACQUIRE, "agent");
      asm volatile("s_waitcnt vmcnt(0)" ::: "memory");
    }
  }
  __syncthreads();
}

#define GSYNC() xcd_barrier(xb)
__global__ void __launch_bounds__(256, 2) mega_kernel(Params p_in) {
  __shared__ __attribute__((aligned(16))) unsigned char smem[SMEM_BYTES];
  const Params& p = *(const Params*)__builtin_amdgcn_kernarg_segment_ptr();
  __shared__ uint4 xb_words;
  if (threadIdx.x == 0) xb_words = make_uint4(0u, 0u, 0u, 0u);
  __syncthreads();
  XcdBarrier xb = xcd_barrier_post((unsigned*)(p.ws + WS_BAR), (volatile LAS unsigned*)&xb_words);
  run_stage<-1>(p, 0, smem);
  if (p.out == nullptr) cg::this_grid().sync();
  GSYNC();
#define LAYER(L, LAST)                 \
  run_stage<0>(p, L, smem); GSYNC();   \
  run_stage<1>(p, L, smem); GSYNC();   \
  run_stage<2>(p, L, smem); GSYNC();   \
  run_stage<3>(p, L, smem); GSYNC();   \
  run_stage<4>(p, L, smem); GSYNC();   \
  run_stage<5>(p, L, smem); GSYNC();   \
  run_stage<6>(p, L, smem); GSYNC();   \
  run_stage<7>(p, L, smem); GSYNC();   \
  run_stage<8>(p, L, smem);            \
  if (!LAST) GSYNC();
  int l0 = 0, l1 = 1;
  asm volatile("" : "+s"(l0));
  asm volatile("" : "+s"(l1));
  LAYER(l0, 0)
  LAYER(l1, 1)
}

extern "C" void kernel_launch(void* const* d_in, const int* in_sizes, int n_in, void* d_out, int out_size, void* d_ws,
                              size_t ws_size, hipStream_t stream) {
  if (ws_size < WS_END || n_in < 29) { fprintf(stderr, "workspace too small / bad inputs\n"); return; }
  Params p{};
  const float** f = (const float**)&p;
  for (int i = 0; i < 29; ++i) f[i] = (const float*)d_in[i];
  p.out = (float*)d_out;
  p.ws = (unsigned char*)d_ws;
  static int grid_blocks = 0;
  if (!grid_blocks) {
    int dev = 0, cus = 0, per_cu = 0;
    (void)hipGetDevice(&dev);
    (void)hipDeviceGetAttribute(&cus, hipDeviceAttributeMultiprocessorCount, dev);
    (void)hipOccupancyMaxActiveBlocksPerMultiprocessor(&per_cu, mega_kernel, 256, 0);
    if (per_cu < 1) per_cu = 1;
    if (per_cu > 2) per_cu = 2;
    grid_blocks = cus * per_cu;
  }
  (void)hipMemsetAsync((unsigned char*)d_ws + WS_BAR, 0, 16384, stream);
  void* args[] = {&p};
  hipError_t e = hipLaunchCooperativeKernel((void*)mega_kernel, dim3(grid_blocks), dim3(256), args, 0, stream);
  if (e != hipSuccess) fprintf(stderr, "cooperative launch failed: %s (grid %d)\n", hipGetErrorString(e), grid_blocks);
}
```

```cpp
#include <hip/hip_runtime.h>
#include <hip/hip_cooperative_groups.h>
#include <cstdio>
namespace cg = cooperative_groups;

typedef unsigned short bf16;
typedef short bf16x8 __attribute__((ext_vector_type(8)));
typedef float f32x4 __attribute__((ext_vector_type(4)));
typedef unsigned u32x4 __attribute__((ext_vector_type(4)));
#define LDSP __attribute__((address_space(3)))

#ifndef SINGLE_LAUNCH
#define SINGLE_LAUNCH 0
#endif

constexpr int D = 1024, TP = 16384, TS = 1024, TT = TP + TS, SEQ = 4096;
constexpr int ZIN = 8456, NWIN = 8576;
constexpr int OFF_AV = 512, OFF_AG = 1024, OFF_BQ = 1536, OFF_BK = 2048, OFF_BV = 2176, OFF_BG = 2304, OFF_MG = 5384;
constexpr int ZAB = 2816;
constexpr int ZC = 2688;
constexpr int C_QK = 0, C_V = 1024, C_I = 1536, C_F = 1540, C_O = 1544, C_G = 2056;
constexpr float EPS = 1e-6f;
constexpr int NMOD = 132;
constexpr int SMEM_BYTES = 73728;

constexpr size_t O_Y = 0;
constexpr size_t O_SKP = (size_t)TT * D;
constexpr size_t O_SVP = O_SKP + 2 * 4 * 128 * 128;
constexpr size_t O_CVP = O_SVP + 2 * 4 * 128 * 128;
constexpr size_t O_CP = O_CVP + 2 * 4 * 3 * 1024;
constexpr size_t O_NP = O_CP + (size_t)2 * 4 * 4 * 128 * 128;
constexpr size_t O_MP = O_NP + 2 * 4 * 4 * 128;
constexpr size_t O_SKS = O_MP + 2 * 4 * 4;
constexpr size_t O_SVS = O_SKS + (size_t)2 * 128 * 128 * 128;
constexpr size_t O_CVS = O_SVS + (size_t)2 * 128 * 128 * 128;
constexpr size_t O_CS = O_CVS + (size_t)2 * 128 * 3 * 1024;
constexpr size_t O_NS = O_CS + (size_t)2 * 128 * 4 * 128 * 128;
constexpr size_t O_MS = O_NS + (size_t)2 * 128 * 4 * 128;
constexpr size_t O_GV = O_MS + 2 * 128 * 4;
constexpr size_t O_END = O_GV + (size_t)2 * 128 * 8 * 512;

constexpr size_t WS_WIN = 0;
constexpr size_t WS_WBR = WS_WIN + (size_t)2 * NWIN * 1024 * 2;
constexpr size_t WS_WOUT = WS_WBR + (size_t)2 * 1024 * 1536 * 2;
constexpr size_t WS_MOD = WS_WOUT + (size_t)2 * 1024 * 1024 * 2;
constexpr size_t WS_H = WS_MOD + (size_t)2 * NMOD * 3072 * 4;
constexpr size_t WS_YAB = WS_H + (size_t)TT * 1024 * 2;
constexpr size_t WS_U = WS_YAB + (size_t)TT * 1024 * 2;
constexpr size_t WS_UN = WS_U + (size_t)TT * 1024 * 2;
constexpr size_t WS_G = WS_UN + (size_t)1024 * 128 * 4;
constexpr size_t WS_TOT = WS_G + 4096;
constexpr size_t WS_M = WS_TOT + 4096;
constexpr size_t WS_Z = WS_M + 4096;
constexpr size_t WS_BAR = WS_Z + (size_t)TT * ZAB * 2;
constexpr size_t WS_H8 = WS_BAR + 16384;
constexpr int W8_ROW0 = 0, W8_ROWS = NWIN;
constexpr size_t WS_W8 = WS_H8 + (size_t)TT * 1024;
constexpr size_t WS_END = WS_W8 + (size_t)2 * W8_ROWS * 1024;

struct Params {
  const float *x_prompt, *x_sample, *cache_k, *cache_v, *st_conv, *st_C, *st_n, *st_m, *c_prompt, *c_sample;
  const float *ada_w, *ada_b, *norm_g, *w_in, *b_in, *vnorm_g, *gmlp_ws, *gmlp_bs, *qn_g, *kn_g, *sinks;
  const float *conv_w, *conv_b, *f_bias, *hnorm_g, *w_a, *w_b, *w_c, *w_out;
  float* out;
  unsigned char* ws;
};

__device__ __forceinline__ int tidx() { int t = threadIdx.x; asm volatile("" : "+v"(t)); return t; }
__device__ __forceinline__ bf16 f2bf(float f) {
  unsigned u = __float_as_uint(f);
  u += 0x7fffu + ((u >> 16) & 1u);
  return (bf16)(u >> 16);
}
__device__ __forceinline__ float bf2f(bf16 h) { return __uint_as_float(((unsigned)h) << 16); }
__device__ __forceinline__ unsigned pack2(float a, float b) { return (unsigned)f2bf(a) | ((unsigned)f2bf(b) << 16); }
__device__ __forceinline__ float lo2f(unsigned u) { return __uint_as_float(u << 16); }
__device__ __forceinline__ float hi2f(unsigned u) { return __uint_as_float(u & 0xffff0000u); }
__device__ __forceinline__ void unpack8(const uint4& v, float* f) {
  f[0] = lo2f(v.x); f[1] = hi2f(v.x); f[2] = lo2f(v.y); f[3] = hi2f(v.y);
  f[4] = lo2f(v.z); f[5] = hi2f(v.z); f[6] = lo2f(v.w); f[7] = hi2f(v.w);
}
__device__ __forceinline__ void unpack4(const uint2& v, float* f) {
  f[0] = lo2f(v.x); f[1] = hi2f(v.x); f[2] = lo2f(v.y); f[3] = hi2f(v.y);
}
__device__ __forceinline__ float sigmoidf_(float x) { return __builtin_amdgcn_rcpf(1.0f + __expf(-x)); }
__device__ __forceinline__ float siluf_(float x) { return x * __builtin_amdgcn_rcpf(1.0f + __expf(-x)); }
__device__ __forceinline__ float logsigmoidf_(float x) { return fminf(x, 0.0f) - log1pf(__expf(-fabsf(x))); }
__device__ __forceinline__ float wave_sum(float v) {
#pragma unroll
  for (int o = 32; o >= 1; o >>= 1) v += __shfl_xor(v, o);
  return v;
}
__device__ __forceinline__ float wave_max(float v) {
#pragma unroll
  for (int o = 32; o >= 1; o >>= 1) v = fmaxf(v, __shfl_xor(v, o));
  return v;
}
__device__ __forceinline__ f32x4 mfma16(bf16x8 a, bf16x8 b, f32x4 c) {
  return __builtin_amdgcn_mfma_f32_16x16x32_bf16(a, b, c, 0, 0, 0);
}
template <int MI, int NI>
__device__ __forceinline__ void mma_lds(f32x4 (&acc)[MI][NI], const bf16* sA, int lda, const bf16* sB, int ldb, int K, int lane) {
  const int r = lane & 15, q = (lane >> 4) * 8;
  for (int k0 = 0; k0 < K; k0 += 32) {
    bf16x8 a[MI], b[NI];
#pragma unroll
    for (int i = 0; i < MI; ++i) a[i] = *(const bf16x8*)(sA + (i * 16 + r) * lda + k0 + q);
#pragma unroll
    for (int j = 0; j < NI; ++j) b[j] = *(const bf16x8*)(sB + (j * 16 + r) * ldb + k0 + q);
#pragma unroll
    for (int i = 0; i < MI; ++i)
#pragma unroll
      for (int j = 0; j < NI; ++j) acc[i][j] = mfma16(b[j], a[i], acc[i][j]);
  }
}

constexpr int GLD = 64;
constexpr int GTILE = 128 * GLD;
template <int NI>
__device__ __forceinline__ void g_load(u32x4 (&ra)[4], u32x4 (&rb)[NI], const bf16* __restrict__ A, int lda, const bf16* __restrict__ B, int ldb, int ko, int tid) {
  const unsigned offA = (unsigned)((tid >> 3) * lda + (tid & 7) * 8), offB = (unsigned)((tid >> 3) * ldb + (tid & 7) * 8);
#pragma unroll
  for (int i = 0; i < 4; ++i) {
    const bf16* Ai = A + (size_t)(i * 32) * lda + ko;
    ra[i] = *(const u32x4*)(Ai + offA);
  }
#pragma unroll
  for (int i = 0; i < NI; ++i) {
    const bf16* Bi = B + (size_t)(i * 32) * ldb + ko;
    rb[i] = *(const u32x4*)(Bi + offB);
  }
}
template <int NI>
__device__ __forceinline__ void g_store(const u32x4 (&ra)[4], const u32x4 (&rb)[NI], bf16* buf, int tid) {
  const int off = (tid >> 3) * GLD + (((tid & 7) ^ ((tid >> 3) & 7)) * 8);
#pragma unroll
  for (int i = 0; i < 4; ++i) *(u32x4*)(buf + off + i * 32 * GLD) = ra[i];
#pragma unroll
  for (int i = 0; i < NI; ++i) *(u32x4*)(buf + GTILE + off + i * 32 * GLD) = rb[i];
}
template <int NI, bool LOWREG = false>
__device__ __forceinline__ void g_compute(f32x4 (&acc)[4][NI], const bf16* cur, int wr, int wc, int lane) {
  const int r16 = lane & 15, sw = lane & 7, q = lane >> 4;
#pragma unroll
  for (int ks = 0; ks < 2; ++ks) {
    const int pc = ((ks * 4 + q) ^ sw) * 8;
    bf16x8 a[4];
#pragma unroll
    for (int i = 0; i < 4; ++i) a[i] = *(const bf16x8*)(cur + (wr * 64 + i * 16 + r16) * GLD + pc);
#pragma unroll
    for (int jh = 0; jh < NI; jh += 2) {
      bf16x8 b[2];
#pragma unroll
      for (int j = 0; j < 2; ++j) b[j] = *(const bf16x8*)(cur + GTILE + (wc * 16 * NI + (jh + j) * 16 + r16) * GLD + pc);
#pragma unroll
      for (int i = 0; i < 4; ++i)
#pragma unroll
        for (int j = 0; j < 2; ++j) acc[i][jh + j] = mfma16(b[j], a[i], acc[i][jh + j]);
      if (LOWREG) __builtin_amdgcn_sched_barrier(0);
    }
  }
}
template <int NI, bool F8SWZ = false>
__device__ __forceinline__ void g_stage(const bf16* __restrict__ A, int lda, const bf16* __restrict__ B, int ldb, int ko, bf16* buf, int tid) {
  const int wave = tid >> 6;
  const int lrow = tid >> 3;
  const int gch = ((tid & 7) ^ (F8SWZ ? ((lrow & 6) | ((lrow >> 3) & 1)) : (lrow & 7))) * 8;
  const unsigned offA = (unsigned)((tid >> 3) * lda + gch), offB = (unsigned)((tid >> 3) * ldb + gch);
#pragma unroll
  for (int i = 0; i < 4; ++i) {
    const bf16* Ai = A + (size_t)(i * 32) * lda + ko;
    __builtin_amdgcn_global_load_lds((const unsigned*)(Ai + offA), (LDSP unsigned*)(buf + (i * 32 + wave * 8) * GLD), 16, 0, 0);
  }
#pragma unroll
  for (int i = 0; i < NI; ++i) {
    const bf16* Bi = B + (size_t)(i * 32) * ldb + ko;
    __builtin_amdgcn_global_load_lds((const unsigned*)(Bi + offB), (LDSP unsigned*)(buf + GTILE + (i * 32 + wave * 8) * GLD), 16, 0, 0);
  }
}
template <int NI, bool LOWREG = false>
__device__ __forceinline__ void gemm_accum(f32x4 (&acc)[4][NI], const bf16* __restrict__ A, int lda,
                                           const bf16* __restrict__ B, int ldb, int K, bf16* sm) {
  const int tid = tidx(), lane = tid & 63, wave = tid >> 6, wr = wave >> 1, wc = wave & 1;
  const int nk = K >> 6;
  bf16* buf0 = sm;
  bf16* buf1 = sm + 2 * GTILE;
  g_stage<NI>(A, lda, B, ldb, 0, buf0, tid);
  asm volatile("s_waitcnt vmcnt(0)" ::: "memory");
  __syncthreads();
#pragma unroll 1
  for (int kt = 0; kt < nk; kt += 2) {
    g_stage<NI>(A, lda, B, ldb, (kt + 1) * 64, buf1, tid);
    g_compute<NI, LOWREG>(acc, buf0, wr, wc, lane);
    asm volatile("s_waitcnt vmcnt(0)" ::: "memory");
    __syncthreads();
    if (kt + 2 < nk) g_stage<NI>(A, lda, B, ldb, (kt + 2) * 64, buf0, tid);
    g_compute<NI, LOWREG>(acc, buf1, wr, wc, lane);
    asm volatile("s_waitcnt vmcnt(0)" ::: "memory");
    __syncthreads();
  }
}
typedef int i32x8 __attribute__((ext_vector_type(8)));
template <int NI>
__device__ __forceinline__ void g_compute_f8(f32x4 (&acc)[4][NI], const bf16* cur, int wr, int wc, int lane) {
  const int r16 = lane & 15, sw = (r16 & 6) | (r16 >> 3), q = lane >> 4;
  const int pc0 = ((2 * q) ^ sw) * 8, pc1 = ((2 * q + 1) ^ sw) * 8;
  i32x8 b[NI];
#pragma unroll
  for (int j = 0; j < NI; ++j) {
    const bf16* rp = cur + GTILE + (wc * 16 * NI + j * 16 + r16) * GLD;
    const u32x4 lo = *(const u32x4*)(rp + pc0), hi = *(const u32x4*)(rp + pc1);
    b[j] = (i32x8){(int)lo.x, (int)lo.y, (int)lo.z, (int)lo.w, (int)hi.x, (int)hi.y, (int)hi.z, (int)hi.w};
  }
#pragma unroll
  for (int i = 0; i < 4; ++i) {
    const bf16* rp = cur + (wr * 64 + i * 16 + r16) * GLD;
    const u32x4 lo = *(const u32x4*)(rp + pc0), hi = *(const u32x4*)(rp + pc1);
    const i32x8 a = (i32x8){(int)lo.x, (int)lo.y, (int)lo.z, (int)lo.w, (int)hi.x, (int)hi.y, (int)hi.z, (int)hi.w};
#pragma unroll
    for (int j = 0; j < NI; ++j)
      acc[i][j] = __builtin_amdgcn_mfma_scale_f32_16x16x128_f8f6f4(b[j], a, acc[i][j], 0, 0, 0, 0x7F7F7F7F, 0, 0x7F7F7F7F);
  }
}
template <int NI>
__device__ __forceinline__ void gemm_accum_f8(f32x4 (&acc)[4][NI], const unsigned char* __restrict__ A8, const unsigned char* __restrict__ B8, bf16* sm) {
  const int tid = tidx(), lane = tid & 63, wave = tid >> 6, wr = wave >> 1, wc = wave & 1;
  const bf16* A = (const bf16*)A8;
  const bf16* B = (const bf16*)B8;
  bf16* buf0 = sm;
  bf16* buf1 = sm + 2 * GTILE;
  g_stage<NI, true>(A, 512, B, 512, 0, buf0, tid);
  asm volatile("s_waitcnt vmcnt(0)" ::: "memory");
  __syncthreads();
#pragma unroll 1
  for (int kt = 0; kt < 8; kt += 2) {
    g_stage<NI, true>(A, 512, B, 512, (kt + 1) * 64, buf1, tid);
    g_compute_f8<NI>(acc, buf0, wr, wc, lane);
    asm volatile("s_waitcnt vmcnt(0)" ::: "memory");
    __syncthreads();
    if (kt + 2 < 8) g_stage<NI, true>(A, 512, B, 512, (kt + 2) * 64, buf0, tid);
    g_compute_f8<NI>(acc, buf1, wr, wc, lane);
    asm volatile("s_waitcnt vmcnt(0)" ::: "memory");
    __syncthreads();
  }
}
template <int NI>
__device__ __forceinline__ void zero_acc(f32x4 (&acc)[4][NI]) {
#pragma unroll
  for (int i = 0; i < 4; ++i)
#pragma unroll
    for (int j = 0; j < NI; ++j) acc[i][j] = (f32x4){0.f, 0.f, 0.f, 0.f};
}
__device__ __forceinline__ void tile_map(int t, int ntn, int& pm, int& pn) {
  const int grp = t / (8 * ntn), w = t % (8 * ntn);
  pm = grp * 8 + (w & 7);
  pn = w >> 3;
}

__device__ __forceinline__ void transpose_tile(const float* __restrict__ src, int ld_src, int n_valid, bf16* __restrict__ dst, int ld_dst,
                               int k0, int n0, int kdst0, float* sm, unsigned char* dst8 = nullptr) {
  const int tid = tidx();
  for (int i = tid; i < 64 * 16; i += 256) {
    const int kk = i >> 4, n4 = (i & 15) * 4, n = n0 + n4;
    float4 v = make_float4(0.f, 0.f, 0.f, 0.f);
    if (n + 3 < n_valid) v = *(const float4*)(src + (size_t)(k0 + kk) * ld_src + n);
    sm[kk * 65 + n4 + 0] = v.x; sm[kk * 65 + n4 + 1] = v.y; sm[kk * 65 + n4 + 2] = v.z; sm[kk * 65 + n4 + 3] = v.w;
  }
  __syncthreads();
  for (int i = tid; i < 64 * 8; i += 256) {
    const int nn = i >> 3, kc = (i & 7) * 8;
    uint4 o;
    o.x = pack2(sm[(kc + 0) * 65 + nn], sm[(kc + 1) * 65 + nn]);
    o.y = pack2(sm[(kc + 2) * 65 + nn], sm[(kc + 3) * 65 + nn]);
    o.z = pack2(sm[(kc + 4) * 65 + nn], sm[(kc + 5) * 65 + nn]);
    o.w = pack2(sm[(kc + 6) * 65 + nn], sm[(kc + 7) * 65 + nn]);
    *(uint4*)(dst + (size_t)(n0 + nn) * ld_dst + kdst0 + kc) = o;
    if (dst8 != nullptr) {
      uint2 q8;
      int t8 = __builtin_amdgcn_cvt_pk_fp8_f32(64.f * sm[(kc + 0) * 65 + nn], 64.f * sm[(kc + 1) * 65 + nn], 0, false);
      q8.x = (unsigned)__builtin_amdgcn_cvt_pk_fp8_f32(64.f * sm[(kc + 2) * 65 + nn], 64.f * sm[(kc + 3) * 65 + nn], t8, true);
      t8 = __builtin_amdgcn_cvt_pk_fp8_f32(64.f * sm[(kc + 4) * 65 + nn], 64.f * sm[(kc + 5) * 65 + nn], 0, false);
      q8.y = (unsigned)__builtin_amdgcn_cvt_pk_fp8_f32(64.f * sm[(kc + 6) * 65 + nn], 64.f * sm[(kc + 7) * 65 + nn], t8, true);
      *(uint2*)(dst8 + (size_t)(n0 + nn - W8_ROW0) * 1024 + kdst0 + kc) = q8;
    }
  }
  __syncthreads();
}

__device__ __forceinline__ void ada_item(const Params& p, int item, float* sm) {
  const int l = item / 192, n0 = (item % 192) * 16;
  const int tid = tidx(), col = tid & 15, rg = tid >> 4;
  constexpr int SLD = 68;
  float* sW = sm + 144 * SLD;
  float acc[9];
#pragma unroll
  for (int j = 0; j < 9; ++j) acc[j] = 0.f;
  const float* W = p.ada_w + (size_t)l * 1024 * 3072 + n0;
  const int wk = tid >> 2, wc4 = (tid & 3) * 4;
  float v[36];
  float4 w0;
#define ADA_LOAD(K0)                                                                                      \
  {                                                                                                       \
    _Pragma("unroll") for (int u = 0; u < 36; ++u) {                                                      \
      const int i = tid + 256 * u, r = i >> 6, kk = i & 63;                                               \
      v[u] = 0.f;                                                                                         \
      if (r < NMOD) v[u] = (r < 4) ? p.c_prompt[r * 1024 + (K0) + kk] : p.c_sample[(r - 4) * 1024 + (K0) + kk]; \
    }                                                                                                     \
    w0 = *(const float4*)(W + (size_t)((K0) + wk) * 3072 + wc4);                                          \
  }
#define ADA_STORE()                                                                                       \
  {                                                                                                       \
    _Pragma("unroll") for (int u = 0; u < 36; ++u) {                                                      \
      const int i = tid + 256 * u, r = i >> 6, kk = i & 63;                                               \
      sm[r * SLD + kk] = siluf_(v[u]);                                                                    \
    }                                                                                                     \
    *(float4*)(sW + wk * 16 + wc4) = w0;                                                                  \
  }
  ADA_LOAD(0)
  ADA_STORE()
  __syncthreads();
#pragma unroll 1
  for (int k0 = 0; k0 < 1024; k0 += 64) {
    if (k0 + 64 < 1024) ADA_LOAD(k0 + 64)
#pragma unroll 4
    for (int k4 = 0; k4 < 16; ++k4) {
      const float x0 = sW[(k4 * 4 + 0) * 16 + col], x1 = sW[(k4 * 4 + 1) * 16 + col];
      const float x2 = sW[(k4 * 4 + 2) * 16 + col], x3 = sW[(k4 * 4 + 3) * 16 + col];
#pragma unroll
      for (int j = 0; j < 9; ++j) {
        const float4 sv = *(const float4*)(sm + (rg * 9 + j) * SLD + k4 * 4);
        acc[j] += sv.x * x0 + sv.y * x1 + sv.z * x2 + sv.w * x3;
      }
    }
    __syncthreads();
    if (k0 + 64 < 1024) ADA_STORE()
    __syncthreads();
  }
#undef ADA_LOAD
#undef ADA_STORE
  float* mod = (float*)(p.ws + WS_MOD);
  const float b = p.ada_b[l * 3072 + n0 + col];
#pragma unroll
  for (int j = 0; j < 9; ++j) {
    const int r = rg * 9 + j;
    if (r < NMOD) mod[((size_t)l * NMOD + r) * 3072 + n0 + col] = acc[j] + b;
  }
}

__device__ __forceinline__ void phase_prep(const Params& p, unsigned char* smem) {
  float* sm = (float*)smem;
  constexpr int N_WIN = 2 * 16 * (NWIN / 64);
  constexpr int N_WBR = 2 * 3 * 8 * 16;
  constexpr int N_WOUT = 2 * 16 * 16;
  constexpr int N_ALL = N_WIN + N_WBR + N_WOUT;
  bf16* WinT = (bf16*)(p.ws + WS_WIN);
  bf16* WbrT = (bf16*)(p.ws + WS_WBR);
  bf16* WoutT = (bf16*)(p.ws + WS_WOUT);
  constexpr int N_ADA = 384;
  for (int it = blockIdx.x; it < N_ADA + N_ALL; it += gridDim.x) {
    if (it < N_ADA) { ada_item(p, it, sm); continue; }
    int i = it - N_ADA;
    if (i < N_WIN) {
      const int l = i / (16 * 134), r = i % (16 * 134), kt = r / 134, nt = r % 134;
      transpose_tile(p.w_in + (size_t)l * 1024 * ZIN, ZIN, ZIN, WinT + (size_t)l * NWIN * 1024, 1024, kt * 64, nt * 64, kt * 64, sm,
                     (nt * 64 >= W8_ROW0) ? p.ws + WS_W8 + (size_t)l * W8_ROWS * 1024 : nullptr);
      continue;
    }
    i -= N_WIN;
    if (i < N_WBR) {
      const int l = i / 384, r = i % 384, seg = r / 128, r2 = r % 128, kt = r2 / 16, nt = r2 % 16;
      const float* src = (seg == 0 ? p.w_a : seg == 1 ? p.w_b : p.w_c) + (size_t)l * 512 * 1024;
      transpose_tile(src, 1024, 1024, WbrT + (size_t)l * 1024 * 1536, 1536, kt * 64, nt * 64, seg * 512 + kt * 64, sm);
      continue;
    }
    i -= N_WBR;
    {
      const int l = i / 256, r = i % 256, kt = r / 16, nt = r % 16;
      transpose_tile(p.w_out + (size_t)l * 1024 * 1024, 1024, 1024, WoutT + (size_t)l * 1024 * 1024, 1024, kt * 64, nt * 64, kt * 64, sm);
    }
  }
}

__device__ __forceinline__ const float* xrow_ptr(const Params& p, int l, int row) {
  if (l == 0) return row < TP ? p.x_prompt + (size_t)row * D : p.x_sample + (size_t)(row - TP) * D;
  return p.out + (size_t)row * D;
}
__device__ __forceinline__ int mod_row(int row) { return row < TP ? (row >> 12) : 4 + ((row - TP) >> 3); }

__device__ __forceinline__ void phase_norm(const Params& p, int l) {
  const int lane = tidx() & 63, wave = tidx() >> 6;
  bf16* hbuf = (bf16*)(p.ws + WS_H);
  unsigned char* h8 = p.ws + WS_H8;
  const float* mod = (const float*)(p.ws + WS_MOD);
  const float* g = p.norm_g + l * D;
  for (int row = blockIdx.x * 4 + wave; row < TT; row += gridDim.x * 4) {
    const float4* x = (const float4*)xrow_ptr(p, l, row);
    float4 v[4];
    float ss = 0.f;
#pragma unroll
    for (int i = 0; i < 4; ++i) {
      v[i] = x[lane + 64 * i];
      ss += v[i].x * v[i].x + v[i].y * v[i].y + v[i].z * v[i].z + v[i].w * v[i].w;
    }
    ss = wave_sum(ss);
    const float rstd = rsqrtf(ss * (1.0f / D) + EPS);
    const float* mp = mod + ((size_t)l * NMOD + mod_row(row)) * 3072;
#pragma unroll
    for (int i = 0; i < 4; ++i) {
      const int c = (lane + 64 * i) * 4;
      const float4 gg = *(const float4*)(g + c), sh = *(const float4*)(mp + c), sc = *(const float4*)(mp + 1024 + c);
      uint2 o;
      o.x = pack2(v[i].x * rstd * gg.x * (1.f + sc.x) + sh.x, v[i].y * rstd * gg.y * (1.f + sc.y) + sh.y);
      o.y = pack2(v[i].z * rstd * gg.z * (1.f + sc.z) + sh.z, v[i].w * rstd * gg.w * (1.f + sc.w) + sh.w);
      *(uint2*)(hbuf + (size_t)row * D + c) = o;
      int p8 = __builtin_amdgcn_cvt_pk_fp8_f32(v[i].x * rstd * gg.x * (1.f + sc.x) + sh.x, v[i].y * rstd * gg.y * (1.f + sc.y) + sh.y, 0, false);
      p8 = __builtin_amdgcn_cvt_pk_fp8_f32(v[i].z * rstd * gg.z * (1.f + sc.z) + sh.z, v[i].w * rstd * gg.w * (1.f + sc.w) + sh.w, p8, true);
      *(int*)(h8 + (size_t)row * D + c) = p8;
    }
  }
}

__device__ __forceinline__ void phase_gemm_in(const Params& p, int l, int col0, int ntn, int ldz, unsigned char* smem) {
  bf16* sm = (bf16*)smem;
  const bf16* hbuf = (const bf16*)(p.ws + WS_H);
  const bf16* W = (const bf16*)(p.ws + WS_WIN) + (size_t)l * NWIN * 1024;
  bf16* z = (bf16*)(p.ws + WS_Z);
  const float* bias = p.b_in + (size_t)l * ZIN;
  const int tid = tidx(), lane = tid & 63, wave = tid >> 6, wr = wave >> 1, wc = wave & 1;
  const int ntiles = (TT / 128) * ntn;
  constexpr int OLD = 136;
  const bool isAB = (col0 == 0);
  const int nb = isAB ? 6 : 13;
  const int NB = (TT / 128) * nb;
  for (int t = blockIdx.x; t < ntiles; t += gridDim.x) {
    const bool f8 = t >= NB;
    int pm, pk;
    tile_map(f8 ? t - NB : t, f8 ? ntn - nb : nb, pm, pk);
    int pn;
    if (isAB) pn = f8 ? (pk < 4 ? pk : pk < 12 ? pk + 4 : pk + 6) : (pk < 4 ? 4 + pk : 12 + pk);
    else pn = f8 ? 13 + pk : pk;
    const int m0 = pm * 128, n0 = pn * 128;
    f32x4 acc[4][4];
    zero_acc<4>(acc);
    float osc = 1.0f;
    if (f8) {
      gemm_accum_f8<4>(acc, p.ws + WS_H8 + (size_t)m0 * 1024, p.ws + WS_W8 + ((size_t)l * W8_ROWS + col0 + n0) * 1024, sm);
      osc = 0.015625f;
    } else {
      gemm_accum<4>(acc, hbuf + (size_t)m0 * 1024, 1024, W + (size_t)(col0 + n0) * 1024, 1024, 1024, sm);
    }
#pragma unroll
    for (int j = 0; j < 4; ++j) {
      const int cl = wc * 64 + j * 16 + (lane >> 4) * 4;
      const float4 b = *(const float4*)(bias + col0 + n0 + cl);
#pragma unroll
      for (int i = 0; i < 4; ++i) {
        const int rl = wr * 64 + i * 16 + (lane & 15);
        uint2 o;
        o.x = pack2(acc[i][j][0] * osc + b.x, acc[i][j][1] * osc + b.y);
        o.y = pack2(acc[i][j][2] * osc + b.z, acc[i][j][3] * osc + b.w);
        *(uint2*)(sm + rl * OLD + cl) = o;
      }
    }
    __syncthreads();
#pragma unroll
    for (int it = 0; it < 8; ++it) {
      const int id = tid + 256 * it, row = id >> 4, ch = id & 15;
      const u32x4 v = *(const u32x4*)(sm + row * OLD + ch * 8);
      *(u32x4*)(z + (size_t)(m0 + row) * ldz + n0 + ch * 8) = v;
    }
    __syncthreads();
  }
}

__device__ __forceinline__ void gmlp_prompt_item(const Params& p, int l, int item, unsigned char* smem) {
  const int b = item >> 7, n = (item >> 2) & 31, g = item & 3;
  const int r0 = b * SEQ + n * 128;
  const bf16* z = (const bf16*)(p.ws + WS_Z);
  bf16* yab = (bf16*)(p.ws + WS_YAB);
  bf16* sW = (bf16*)smem;
  bf16* sV = (bf16*)(smem + 34816);
  float* srstd = (float*)(smem + 69632);
  const int tid = tidx(), lane = tid & 63, wave = tid >> 6, wr = wave >> 1, wc = wave & 1;
  {
    const int tok = tid >> 1, half = tid & 1;
    const uint4* ptr = (const uint4*)(z + (size_t)(r0 + tok) * ZAB + OFF_AV + half * 256);
    float ss = 0.f;
    for (int i = 0; i < 32; ++i) {
      float f[8];
      unpack8(ptr[i], f);
#pragma unroll
      for (int j = 0; j < 8; ++j) ss += f[j] * f[j];
    }
    ss += __shfl_xor(ss, 1);
    if (half == 0) srstd[tok] = rsqrtf(ss * (1.0f / 512.f) + EPS);
  }
  __syncthreads();
  const float* vg = p.vnorm_g + l * 512 + g * 128;
  for (int i = tid; i < 2048; i += 256) {
    const int s = i >> 4, c8 = (i & 15) * 8;
    float f[8];
    unpack8(*(const uint4*)(z + (size_t)(r0 + s) * ZAB + OFF_AV + g * 128 + c8), f);
    const float rs = srstd[s];
#pragma unroll
    for (int j = 0; j < 8; ++j) sV[(c8 + j) * 136 + s] = f2bf(f[j] * rs * vg[c8 + j]);
  }
  const float* Wg = p.gmlp_ws + ((size_t)(l * 4 + g)) * 128 * 128;
  for (int i = tid; i < 4096; i += 256) {
    const int t = i >> 5, s4 = (i & 31) * 4;
    const float4 w = *(const float4*)(Wg + t * 128 + s4);
    uint2 o;
    o.x = pack2(s4 + 0 <= t ? w.x : 0.f, s4 + 1 <= t ? w.y : 0.f);
    o.y = pack2(s4 + 2 <= t ? w.z : 0.f, s4 + 3 <= t ? w.w : 0.f);
    *(uint2*)(sW + t * 136 + s4) = o;
  }
  __syncthreads();
  f32x4 acc[4][4];
  zero_acc<4>(acc);
  mma_lds<4, 4>(acc, sW + wr * 64 * 136, 136, sV + wc * 64 * 136, 136, wr * 64 + 64, lane);
  const float* bs = p.gmlp_bs + (l * 4 + g) * 128;
#pragma unroll
  for (int i = 0; i < 4; ++i) {
    const int t = wr * 64 + i * 16 + (lane & 15);
    const float bst = bs[t];
    const size_t rowoff = (size_t)(r0 + t) * ZAB;
#pragma unroll
    for (int j = 0; j < 4; ++j) {
      const int c = g * 128 + wc * 64 + j * 16 + (lane >> 4) * 4;
      float u[4], ag[4];
      unpack4(*(const uint2*)(z + rowoff + c), u);
      unpack4(*(const uint2*)(z + rowoff + OFF_AG + c), ag);
      uint2 o;
      o.x = pack2(u[0] * (acc[i][j][0] + bst) * siluf_(ag[0]), u[1] * (acc[i][j][1] + bst) * siluf_(ag[1]));
      o.y = pack2(u[2] * (acc[i][j][2] + bst) * siluf_(ag[2]), u[3] * (acc[i][j][3] + bst) * siluf_(ag[3]));
      *(uint2*)(yab + (size_t)(r0 + t) * 1024 + c) = o;
    }
  }
  __syncthreads();
}

__device__ __forceinline__ void gmlp_sample_item(const Params& p, int l, int b, unsigned char* smem) {
  const int r0 = TP + b * 8;
  const bf16* z = (const bf16*)(p.ws + WS_Z);
  bf16* yab = (bf16*)(p.ws + WS_YAB);
  float* svn = (float*)smem;
  const int tid = tidx(), lane = tid & 63, wave = tid >> 6;
  const float* vg = p.vnorm_g + l * 512;
  for (int tt = 0; tt < 2; ++tt) {
    const int t = wave * 2 + tt;
    float f[8];
    unpack8(*(const uint4*)(z + (size_t)(r0 + t) * ZAB + OFF_AV + lane * 8), f);
    float ss = 0.f;
#pragma unroll
    for (int j = 0; j < 8; ++j) ss += f[j] * f[j];
    ss = wave_sum(ss);
    const float rstd = rsqrtf(ss * (1.0f / 512.f) + EPS);
    float* gv = p.out + O_GV + (((size_t)l * 128 + b) * 8 + t) * 512 + lane * 8;
#pragma unroll
    for (int j = 0; j < 8; ++j) {
      const float vn = f[j] * rstd * vg[lane * 8 + j];
      svn[t * 512 + lane * 8 + j] = vn;
      gv[j] = vn;
    }
  }
  __syncthreads();
  {
    const int c = tid * 2, g = c >> 7;
    const float* Wg = p.gmlp_ws + ((size_t)(l * 4 + g)) * 128 * 128;
    const float* bs = p.gmlp_bs + (l * 4 + g) * 128;
    for (int t = 0; t < 8; ++t) {
      float s0 = bs[t], s1 = bs[t];
      for (int s = 0; s <= t; ++s) {
        const float w = Wg[t * 128 + s];
        s0 += w * svn[s * 512 + c];
        s1 += w * svn[s * 512 + c + 1];
      }
      const unsigned uu = *(const unsigned*)(z + (size_t)(r0 + t) * ZAB + c);
      const unsigned gg = *(const unsigned*)(z + (size_t)(r0 + t) * ZAB + OFF_AG + c);
      *(unsigned*)(yab + (size_t)(r0 + t) * 1024 + c) = pack2(lo2f(uu) * s0 * siluf_(lo2f(gg)), hi2f(uu) * s1 * siluf_(hi2f(gg)));
    }
  }
  __syncthreads();
}

__device__ __forceinline__ void swa_prompt_item(const Params& p, int l, int item, unsigned char* smem) {
  const int b = item >> 7, qt = (item >> 1) & 63, kv = item & 1;
  const int q0 = qt * 64, rb = b * SEQ;
  const bf16* z = (const bf16*)(p.ws + WS_Z);
  bf16* yab = (bf16*)(p.ws + WS_YAB);
  bf16* sK = (bf16*)smem;
  bf16* sVT = (bf16*)(smem + 27648);
  const int tid = tidx(), lane = tid & 63, wave = tid >> 6;
  const float* kg = p.kn_g + l * 64;
  const float* qg = p.qn_g + l * 64;
#pragma unroll 1
  for (int it = 0; it < 6; ++it) {
    const int id = tid + 256 * it, kk = id >> 3, ch = id & 7, kp = q0 - 128 + kk;
    float f[8];
    uint4 vraw = make_uint4(0, 0, 0, 0);
    if (kp >= 0) {
      unpack8(*(const uint4*)(z + (size_t)(rb + kp) * ZAB + OFF_BK + kv * 64 + ch * 8), f);
      vraw = *(const uint4*)(z + (size_t)(rb + kp) * ZAB + OFF_BV + kv * 64 + ch * 8);
    } else {
#pragma unroll
      for (int j = 0; j < 8; ++j) f[j] = 0.f;
    }
    float ss = 0.f;
#pragma unroll
    for (int j = 0; j < 8; ++j) ss += f[j] * f[j];
    ss += __shfl_xor(ss, 1); ss += __shfl_xor(ss, 2); ss += __shfl_xor(ss, 4);
    const float rstd = rsqrtf(ss * (1.0f / 64.f) + EPS);
#pragma unroll
    for (int j = 0; j < 8; ++j) f[j] = f[j] * rstd * kg[ch * 8 + j];
    uint4 ko;
    ko.x = pack2(f[0], f[1]); ko.y = pack2(f[2], f[3]); ko.z = pack2(f[4], f[5]); ko.w = pack2(f[6], f[7]);
    *(uint4*)(sK + kk * 72 + ch * 8) = ko;
    float vf[8];
    unpack8(vraw, vf);
#pragma unroll
    for (int j = 0; j < 8; ++j) sVT[(ch * 8 + j) * 200 + kk] = f2bf(vf[j]);
    if (kk >= 128 && kp >= SEQ - 128) {
      const size_t o = ((((size_t)l * 4 + b) * 128 + (kp - (SEQ - 128))) * 2 + kv) * 64 + ch * 8;
#pragma unroll
      for (int j = 0; j < 8; ++j) { p.out[O_SKP + o + j] = f[j]; p.out[O_SVP + o + j] = vf[j]; }
    }
  }
  __syncthreads();
  const int h = kv * 4 + wave;
  const float sink = p.sinks[l * 8 + h];
  const int g4 = lane >> 4, r16 = lane & 15;
#pragma unroll 1
  for (int i = 0; i < 4; ++i) {
    const int qrow = q0 + i * 16 + r16;
    const size_t grow = (size_t)(rb + qrow);
    bf16x8 qf[2];
    {
      float f0[8], f1[8];
      unpack8(*(const uint4*)(z + grow * ZAB + OFF_BQ + h * 64 + g4 * 8), f0);
      unpack8(*(const uint4*)(z + grow * ZAB + OFF_BQ + h * 64 + 32 + g4 * 8), f1);
      float ss = 0.f;
#pragma unroll
      for (int j = 0; j < 8; ++j) ss += f0[j] * f0[j] + f1[j] * f1[j];
      ss += __shfl_xor(ss, 16); ss += __shfl_xor(ss, 32);
      const float rstd = rsqrtf(ss * (1.0f / 64.f) + EPS) * 0.125f;
#pragma unroll
      for (int j = 0; j < 8; ++j) {
        qf[0][j] = (short)f2bf(f0[j] * rstd * qg[g4 * 8 + j]);
        qf[1][j] = (short)f2bf(f1[j] * rstd * qg[32 + g4 * 8 + j]);
      }
    }
    f32x4 st[12];
#pragma unroll
    for (int kt = 0; kt < 12; ++kt) {
      st[kt] = (f32x4){0.f, 0.f, 0.f, 0.f};
#pragma unroll
      for (int ks = 0; ks < 2; ++ks) {
        const bf16x8 kf = *(const bf16x8*)(sK + (kt * 16 + r16) * 72 + ks * 32 + g4 * 8);
        st[kt] = mfma16(kf, qf[ks], st[kt]);
      }
      if ((kt & 1) == 1) __builtin_amdgcn_sched_barrier(0);
    }
    float mx = -INFINITY;
#pragma unroll
    for (int kt = 0; kt < 12; ++kt)
#pragma unroll
      for (int x = 0; x < 4; ++x) {
        const int kp = q0 - 128 + kt * 16 + g4 * 4 + x, diff = qrow - kp;
        const bool valid = (kp >= 0) && (diff >= 0) && (diff < 128);
        st[kt][x] = valid ? st[kt][x] : -INFINITY;
        mx = fmaxf(mx, st[kt][x]);
      }
    mx = fmaxf(mx, __shfl_xor(mx, 16)); mx = fmaxf(mx, __shfl_xor(mx, 32));
    mx = fmaxf(mx, sink);
    float sum = 0.f;
#pragma unroll
    for (int kt = 0; kt < 12; ++kt)
#pragma unroll
      for (int x = 0; x < 4; ++x) {
        const float pv = __expf(st[kt][x] - mx);
        st[kt][x] = pv;
        sum += pv;
      }
    sum += __shfl_xor(sum, 16); sum += __shfl_xor(sum, 32);
    const float inv = 1.0f / (sum + __expf(sink - mx));
    f32x4 o[4];
#pragma unroll
    for (int dt = 0; dt < 4; ++dt) o[dt] = (f32x4){0.f, 0.f, 0.f, 0.f};
#pragma unroll
    for (int t2 = 0; t2 < 6; ++t2) {
      bf16x8 pf;
#pragma unroll
      for (int x = 0; x < 4; ++x) { pf[x] = (short)f2bf(st[2 * t2][x]); pf[4 + x] = (short)f2bf(st[2 * t2 + 1][x]); }
#pragma unroll
      for (int dt = 0; dt < 4; ++dt) {
        const uint2 v0 = *(const uint2*)(sVT + (dt * 16 + r16) * 200 + t2 * 32 + g4 * 4);
        const uint2 v1 = *(const uint2*)(sVT + (dt * 16 + r16) * 200 + t2 * 32 + 16 + g4 * 4);
        union { uint4 u; bf16x8 v; } cv;
        cv.u = make_uint4(v0.x, v0.y, v1.x, v1.y);
        o[dt] = mfma16(cv.v, pf, o[dt]);
      }
      __builtin_amdgcn_sched_barrier(0);
    }
#pragma unroll
    for (int dt = 0; dt < 4; ++dt) {
      const int d0 = dt * 16 + g4 * 4;
      float bg[4];
      unpack4(*(const uint2*)(z + grow * ZAB + OFF_BG + h * 64 + d0), bg);
      uint2 oo;
      oo.x = pack2(o[dt][0] * inv * siluf_(bg[0]), o[dt][1] * inv * siluf_(bg[1]));
      oo.y = pack2(o[dt][2] * inv * siluf_(bg[2]), o[dt][3] * inv * siluf_(bg[3]));
      *(uint2*)(yab + grow * 1024 + 512 + h * 64 + d0) = oo;
    }
  }
  __syncthreads();
}

__device__ __forceinline__ void swa_sample_item(const Params& p, int l, int item, unsigned char* smem) {
  const int b = item >> 1, kv = item & 1;
  const int r0 = TP + b * 8;
  const bf16* z = (const bf16*)(p.ws + WS_Z);
  bf16* yab = (bf16*)(p.ws + WS_YAB);
  bf16* sK = (bf16*)smem;
  bf16* sV = (bf16*)(smem + 19584);
  float* sq = (float*)(smem + 39168);
  float* sP = (float*)(smem + 47488);
  const int tid = tidx();
  const float* kg = p.kn_g + l * 64;
  const float* qg = p.qn_g + l * 64;
  const float* ck = p.cache_k + ((size_t)l * 128 + b) * 128 * 128;
  const float* cvp = p.cache_v + ((size_t)l * 128 + b) * 128 * 128;
#pragma unroll 1
  for (int it = 0; it < 5; ++it) {
    const int id = tid + 256 * it, j = id >> 3, ch = id & 7;
    const bool act = id < 1088;
    float kf[8], vf[8];
#pragma unroll
    for (int x = 0; x < 8; ++x) { kf[x] = 0.f; vf[x] = 0.f; }
    if (act) {
      if (j < 128) {
        const float4 a0 = *(const float4*)(ck + (j * 2 + kv) * 64 + ch * 8), a1 = *(const float4*)(ck + (j * 2 + kv) * 64 + ch * 8 + 4);
        const float4 b0 = *(const float4*)(cvp + (j * 2 + kv) * 64 + ch * 8), b1 = *(const float4*)(cvp + (j * 2 + kv) * 64 + ch * 8 + 4);
        kf[0] = a0.x; kf[1] = a0.y; kf[2] = a0.z; kf[3] = a0.w; kf[4] = a1.x; kf[5] = a1.y; kf[6] = a1.z; kf[7] = a1.w;
        vf[0] = b0.x; vf[1] = b0.y; vf[2] = b0.z; vf[3] = b0.w; vf[4] = b1.x; vf[5] = b1.y; vf[6] = b1.z; vf[7] = b1.w;
      } else {
        unpack8(*(const uint4*)(z + (size_t)(r0 + j - 128) * ZAB + OFF_BK + kv * 64 + ch * 8), kf);
        unpack8(*(const uint4*)(z + (size_t)(r0 + j - 128) * ZAB + OFF_BV + kv * 64 + ch * 8), vf);
      }
    }
    float ss = 0.f;
#pragma unroll
    for (int x = 0; x < 8; ++x) ss += kf[x] * kf[x];
    ss += __shfl_xor(ss, 1); ss += __shfl_xor(ss, 2); ss += __shfl_xor(ss, 4);
    if (act) {
      if (j >= 128) {
        const float rstd = rsqrtf(ss * (1.0f / 64.f) + EPS);
#pragma unroll
        for (int x = 0; x < 8; ++x) kf[x] = kf[x] * rstd * kg[ch * 8 + x];
      }
      uint4 ko, vo;
      ko.x = pack2(kf[0], kf[1]); ko.y = pack2(kf[2], kf[3]); ko.z = pack2(kf[4], kf[5]); ko.w = pack2(kf[6], kf[7]);
      vo.x = pack2(vf[0], vf[1]); vo.y = pack2(vf[2], vf[3]); vo.z = pack2(vf[4], vf[5]); vo.w = pack2(vf[6], vf[7]);
      *(uint4*)(sK + j * 72 + ch * 8) = ko;
      *(uint4*)(sV + j * 72 + ch * 8) = vo;
      if (j >= 8) {
        const size_t o = ((((size_t)l * 128 + b) * 128 + (j - 8)) * 2 + kv) * 64 + ch * 8;
        *(float4*)(p.out + O_SKS + o) = make_float4(kf[0], kf[1], kf[2], kf[3]);
        *(float4*)(p.out + O_SKS + o + 4) = make_float4(kf[4], kf[5], kf[6], kf[7]);
        *(float4*)(p.out + O_SVS + o) = make_float4(vf[0], vf[1], vf[2], vf[3]);
        *(float4*)(p.out + O_SVS + o + 4) = make_float4(vf[4], vf[5], vf[6], vf[7]);
      }
    }
  }
  const int qi = tid >> 3, sub = tid & 7, t = qi >> 2, h = kv * 4 + (qi & 3);
  {
    float f[8];
    unpack8(*(const uint4*)(z + (size_t)(r0 + t) * ZAB + OFF_BQ + h * 64 + sub * 8), f);
    float ss = 0.f;
#pragma unroll
    for (int x = 0; x < 8; ++x) ss += f[x] * f[x];
    ss += __shfl_xor(ss, 1); ss += __shfl_xor(ss, 2); ss += __shfl_xor(ss, 4);
    const float rstd = rsqrtf(ss * (1.0f / 64.f) + EPS) * 0.125f;
#pragma unroll
    for (int x = 0; x < 8; ++x) sq[qi * 65 + sub * 8 + x] = f[x] * rstd * qg[sub * 8 + x];
  }
  __syncthreads();
  const float sink = p.sinks[l * 8 + h];
  float mx = -INFINITY;
#pragma unroll 1
  for (int jj = 0; jj < 17; ++jj) {
    const int key = sub + 8 * jj;
    float s = 0.f;
#pragma unroll 8
    for (int d = 0; d < 64; ++d) s += sq[qi * 65 + d] * bf2f(sK[key * 72 + d]);
    const bool valid = (key >= t + 1) && (key <= t + 128);
    s = valid ? s : -INFINITY;
    sP[qi * 140 + key] = s;
    mx = fmaxf(mx, s);
  }
  mx = fmaxf(mx, __shfl_xor(mx, 1)); mx = fmaxf(mx, __shfl_xor(mx, 2)); mx = fmaxf(mx, __shfl_xor(mx, 4));
  mx = fmaxf(mx, sink);
  float sum = 0.f;
  for (int jj = 0; jj < 17; ++jj) {
    const int key = sub + 8 * jj;
    const float pv = __expf(sP[qi * 140 + key] - mx);
    sP[qi * 140 + key] = pv;
    sum += pv;
  }
  sum += __shfl_xor(sum, 1); sum += __shfl_xor(sum, 2); sum += __shfl_xor(sum, 4);
  const float inv = 1.0f / (sum + __expf(sink - mx));
  __syncthreads();
  {
    float o[8];
#pragma unroll
    for (int x = 0; x < 8; ++x) o[x] = 0.f;
#pragma unroll 2
    for (int key = 0; key < 136; ++key) {
      const float pv = sP[qi * 140 + key];
      float vf[8];
      unpack8(*(const uint4*)(sV + key * 72 + sub * 8), vf);
#pragma unroll
      for (int x = 0; x < 8; ++x) o[x] += pv * vf[x];
    }
    float bg[8];
    unpack8(*(const uint4*)(z + (size_t)(r0 + t) * ZAB + OFF_BG + h * 64 + sub * 8), bg);
    uint4 oo;
    oo.x = pack2(o[0] * inv * siluf_(bg[0]), o[1] * inv * siluf_(bg[1]));
    oo.y = pack2(o[2] * inv * siluf_(bg[2]), o[3] * inv * siluf_(bg[3]));
    oo.z = pack2(o[4] * inv * siluf_(bg[4]), o[5] * inv * siluf_(bg[5]));
    oo.w = pack2(o[6] * inv * siluf_(bg[6]), o[7] * inv * siluf_(bg[7]));
    *(uint4*)(yab + (size_t)(r0 + t) * 1024 + 512 + h * 64 + sub * 8) = oo;
  }
  __syncthreads();
}

__device__ __forceinline__ void phase_mix_ab(const Params& p, int l, unsigned char* smem) {
  constexpr int N_SWA = 512, N_GM = 512, N_SWS = 256, N_GMS = 128;
  constexpr int N_ALL = N_SWA + N_GM + N_SWS + N_GMS;
  for (int it = blockIdx.x; it < N_ALL; it += gridDim.x) {
    int i = it;
    if (i < N_SWA) { swa_prompt_item(p, l, i, smem); continue; }
    i -= N_SWA;
    if (i < N_GM) { gmlp_prompt_item(p, l, i, smem); continue; }
    i -= N_GM;
    if (i < N_SWS) { swa_sample_item(p, l, i, smem); continue; }
    i -= N_SWS;
    gmlp_sample_item(p, l, i, smem);
  }
}

__device__ __forceinline__ void conv8_prompt(const Params& p, int l, const bf16* z, int r0, int pos0, int s, int zc, float* y) {
  const float* cw = p.conv_w + (size_t)l * 4 * 1024 + zc;
  const float* cb = p.conv_b + l * 1024 + zc;
#pragma unroll
  for (int j = 0; j < 8; ++j) y[j] = cb[j];
#pragma unroll
  for (int tap = 0; tap < 4; ++tap) {
    const int back = 3 - tap;
    if (pos0 + s - back >= 0) {
      float f[8];
      unpack8(*(const uint4*)(z + (size_t)(r0 + s - back) * ZC + C_QK + zc), f);
#pragma unroll
      for (int j = 0; j < 8; ++j) y[j] += cw[tap * 1024 + j] * f[j];
    }
  }
#pragma unroll
  for (int j = 0; j < 8; ++j) y[j] = siluf_(y[j]);
}

__device__ __forceinline__ void chunk_gates(const Params& p, int l, const bf16* z, int r0, int hh, int lane, float& cum, float& iv) {
  const float f = bf2f(z[(size_t)(r0 + lane) * ZC + C_F + hh]) + p.f_bias[l * 4 + hh];
  iv = bf2f(z[(size_t)(r0 + lane) * ZC + C_I + hh]);
  float c = logsigmoidf_(f);
#pragma unroll
  for (int o = 1; o < 64; o <<= 1) {
    const float n = __shfl_up(c, o);
    if (lane >= o) c += n;
  }
  cum = c;
}

__device__ __forceinline__ void mlstm_local_item(const Params& p, int l, int item, unsigned char* smem) {
  const int bh = item >> 6, c = item & 63, b = bh >> 2, hh = bh & 3;
  const int r0 = b * SEQ + c * 64;
  const bf16* z = (const bf16*)(p.ws + WS_Z);
  bf16* skT = (bf16*)smem;
  bf16* svT = (bf16*)(smem + 18432);
  float* swsel = (float*)(smem + 36864);
  const int tid = tidx(), lane = tid & 63, wave = tid >> 6, wr = wave >> 1, wc = wave & 1;
  if (wave == 0) {
    float cum, iv;
    chunk_gates(p, l, z, r0, hh, lane, cum, iv);
    const float total = __shfl(cum, 63);
    const float g = total - cum + iv;
    const float G = wave_max(g);
    swsel[lane] = __expf(g - G);
    if (lane == 0) {
      ((float*)(p.ws + WS_G))[item] = G;
      ((float*)(p.ws + WS_TOT))[item] = total;
    }
  }
  __syncthreads();
  for (int i = tid; i < 1024; i += 256) {
    const int s = i >> 4, d8 = (i & 15) * 8;
    float y[8];
    conv8_prompt(p, l, z, r0, c * 64, s, 512 + hh * 128 + d8, y);
    {
      uint4 ko;
      ko.x = pack2(y[0] * 0.08838834764831845f, y[1] * 0.08838834764831845f); ko.y = pack2(y[2] * 0.08838834764831845f, y[3] * 0.08838834764831845f);
      ko.z = pack2(y[4] * 0.08838834764831845f, y[5] * 0.08838834764831845f); ko.w = pack2(y[6] * 0.08838834764831845f, y[7] * 0.08838834764831845f);
      *(uint4*)((bf16*)(p.ws + WS_H) + (size_t)(r0 + s) * 512 + hh * 128 + d8) = ko;
    }
    const float sc = 0.08838834764831845f * swsel[s];
#pragma unroll
    for (int j = 0; j < 8; ++j) skT[(d8 + j) * 72 + s] = f2bf(y[j] * sc);
    float v[8];
    unpack8(*(const uint4*)(z + (size_t)(r0 + s) * ZC + C_V + hh * 128 + d8), v);
#pragma unroll
    for (int j = 0; j < 8; ++j) svT[(d8 + j) * 72 + s] = f2bf(v[j]);
  }
  __syncthreads();
  f32x4 acc[4][4];
  zero_acc<4>(acc);
  mma_lds<4, 4>(acc, svT + wr * 64 * 72, 72, skT + wc * 64 * 72, 72, 64, lane);
  bf16* U = (bf16*)(p.ws + WS_U) + (size_t)item * 16384;
#pragma unroll
  for (int i = 0; i < 4; ++i)
#pragma unroll
    for (int j = 0; j < 4; ++j) {
      const int e = wr * 64 + i * 16 + (lane & 15), d = wc * 64 + j * 16 + (lane >> 4) * 4;
      uint2 o;
      o.x = pack2(acc[i][j][0], acc[i][j][1]);
      o.y = pack2(acc[i][j][2], acc[i][j][3]);
      *(uint2*)(U + e * 128 + d) = o;
    }
  if (tid < 128) {
    float s = 0.f;
    for (int k = 0; k < 64; ++k) s += bf2f(skT[tid * 72 + k]);
    ((float*)(p.ws + WS_UN))[(size_t)item * 128 + tid] = s;
  }
  __syncthreads();
}

__device__ __forceinline__ void mlstm_convout_item(const Params& p, int l, int b) {
  const bf16* z = (const bf16*)(p.ws + WS_Z);
  for (int i = tidx(); i < 3 * 1024; i += 256) {
    const int j = i >> 10, ch = i & 1023;
    p.out[O_CVP + (((size_t)l * 4 + b) * 3 + j) * 1024 + ch] = bf2f(z[(size_t)(b * SEQ + SEQ - 3 + j) * ZC + C_QK + ch]);
  }
}

__device__ __forceinline__ void mlstm_sample_item(const Params& p, int l, int item, unsigned char* smem) {
  const int b = item >> 2, hh = item & 3;
  const int r0 = TP + b * 8;
  bf16* z = (bf16*)(p.ws + WS_Z);
  float* sq = (float*)smem;
  float* sk = sq + 1024;
  float* sv = sk + 1024;
  float* sh = sv + 1024;
  float* sint = sh + 1024;
  float* sa = sint + 2048;
  float* sqn = sa + 64;
  float* smt = sqn + 8;
  float* swi = smt + 8;
  float* swsel = swi + 8;
  float* sdm = swsel + 8;
  float* sdecay = sdm + 64;
  const int tid = tidx(), lane = tid & 63, wave = tid >> 6;
  {
    const int isk = tid >> 7, d = tid & 127, zc = isk * 512 + hh * 128 + d;
    const float* cw = p.conv_w + (size_t)l * 4 * 1024 + zc;
    const float cb = p.conv_b[l * 1024 + zc];
    float xp[11];
    const float* cs = p.st_conv + ((size_t)l * 128 + b) * 3 * 1024 + zc;
    xp[0] = cs[0]; xp[1] = cs[1024]; xp[2] = cs[2048];
#pragma unroll
    for (int t = 0; t < 8; ++t) xp[3 + t] = bf2f(z[(size_t)(r0 + t) * ZC + C_QK + zc]);
    const float w0 = cw[0], w1 = cw[1024], w2 = cw[2048], w3 = cw[3072];
    float* dst = isk ? sk : sq;
    const float sc = isk ? 0.08838834764831845f : 1.0f;
#pragma unroll
    for (int t = 0; t < 8; ++t) {
      const float y = cb + w0 * xp[t] + w1 * xp[t + 1] + w2 * xp[t + 2] + w3 * xp[t + 3];
      dst[t * 128 + d] = siluf_(y) * sc;
    }
    float* co = p.out + O_CVS + ((size_t)l * 128 + b) * 3 * 1024 + zc;
    co[0] = xp[8]; co[1024] = xp[9]; co[2048] = xp[10];
  }
  for (int i = tid; i < 1024; i += 256) {
    const int t = i >> 7, e = i & 127;
    sv[i] = bf2f(z[(size_t)(r0 + t) * ZC + C_V + hh * 128 + e]);
  }
  if (tid == 0) {
    float cum[8], iv[8];
    float c = 0.f;
    for (int t = 0; t < 8; ++t) {
      const float f = bf2f(z[(size_t)(r0 + t) * ZC + C_F + hh]) + p.f_bias[l * 4 + hh];
      c += logsigmoidf_(f);
      cum[t] = c;
      iv[t] = bf2f(z[(size_t)(r0 + t) * ZC + C_I + hh]);
    }
    const float m0 = p.st_m[(l * 128 + b) * 4 + hh];
    for (int t = 0; t < 8; ++t) {
      float dmax = -INFINITY;
      for (int s = 0; s <= t; ++s) dmax = fmaxf(dmax, cum[t] - cum[s] + iv[s]);
      const float mi = cum[t] + m0, mt = fmaxf(mi, dmax);
      smt[t] = mt;
      swi[t] = __expf(mi - mt);
      for (int s = 0; s < 8; ++s) sdm[t * 8 + s] = (s <= t) ? __expf(cum[t] - cum[s] + iv[s] - mt) : 0.f;
    }
    const float total = cum[7];
    float gm = -INFINITY;
    for (int s = 0; s < 8; ++s) gm = fmaxf(gm, total - cum[s] + iv[s]);
    const float mn = fmaxf(total + m0, gm);
    for (int s = 0; s < 8; ++s) swsel[s] = __expf(total - cum[s] + iv[s] - mn);
    sdecay[0] = __expf(total + m0 - mn);
    p.out[O_MS + (l * 128 + b) * 4 + hh] = mn;
  }
  __syncthreads();
  const float* n0 = p.st_n + (((size_t)l * 128 + b) * 4 + hh) * 128;
  if (tid < 64) {
    const int t = tid >> 3, s = tid & 7;
    float dsum = 0.f;
    for (int d = 0; d < 128; ++d) dsum += sq[t * 128 + d] * sk[s * 128 + d];
    sa[t * 8 + s] = sdm[t * 8 + s] * dsum;
  } else if (tid < 128) {
    const int t = (tid - 64) >> 3, part = (tid - 64) & 7;
    float dsum = 0.f;
    for (int d = part * 16; d < part * 16 + 16; ++d) dsum += sq[t * 128 + d] * n0[d];
    dsum += __shfl_xor(dsum, 1); dsum += __shfl_xor(dsum, 2); dsum += __shfl_xor(dsum, 4);
    if (part == 0) sqn[t] = dsum;
  }
  __syncthreads();
  {
    const int e = tid & 127, dh = tid >> 7;
    const float decay = sdecay[0];
    const float* C0 = p.st_C + (((size_t)l * 128 + b) * 4 + hh) * 16384;
    float* C1 = p.out + O_CS + (((size_t)l * 128 + b) * 4 + hh) * 16384;
    float vw[8], inter[8];
#pragma unroll
    for (int s = 0; s < 8; ++s) { vw[s] = sv[s * 128 + e] * swsel[s]; inter[s] = 0.f; }
    for (int d = dh * 64; d < dh * 64 + 64; ++d) {
      const float c0 = C0[d * 128 + e];
      float upd = decay * c0;
#pragma unroll
      for (int s = 0; s < 8; ++s) {
        upd += sk[s * 128 + d] * vw[s];
        inter[s] += sq[s * 128 + d] * c0;
      }
      C1[d * 128 + e] = upd;
    }
#pragma unroll
    for (int t = 0; t < 8; ++t) sint[(dh * 8 + t) * 128 + e] = inter[t];
  }
  __syncthreads();
  if (tid < 128) {
    const int e = tid;
    for (int t = 0; t < 8; ++t) {
      float num = swi[t] * (sint[t * 128 + e] + sint[(8 + t) * 128 + e]);
      float den = swi[t] * sqn[t];
      for (int s = 0; s <= t; ++s) { num += sa[t * 8 + s] * sv[s * 128 + e]; den += sa[t * 8 + s]; }
      sh[t * 128 + e] = num / fmaxf(fabsf(den), __expf(-smt[t]));
    }
    float nn = sdecay[0] * n0[e];
    for (int s = 0; s < 8; ++s) nn += swsel[s] * sk[s * 128 + e];
    p.out[O_NS + (((size_t)l * 128 + b) * 4 + hh) * 128 + e] = nn;
  }
  __syncthreads();
  const float* hg = p.hnorm_g + l * 512 + hh * 128;
  for (int tt = 0; tt < 2; ++tt) {
    const int t = wave * 2 + tt;
    const float h0 = sh[t * 128 + lane], h1 = sh[t * 128 + 64 + lane];
    const float ss = wave_sum(h0 * h0 + h1 * h1);
    const float rstd = rsqrtf(ss * (1.0f / 128.f) + EPS);
    bf16* zr = z + (size_t)(r0 + t) * ZC;
#pragma unroll
    for (int k = 0; k < 2; ++k) {
      const int e = lane + 64 * k;
      const float hv = k ? h1 : h0;
      const float o = bf2f(zr[C_O + hh * 128 + e]), cg_ = bf2f(zr[C_G + hh * 128 + e]);
      zr[C_O + hh * 128 + e] = f2bf(hv * rstd * hg[e] * sigmoidf_(o) * siluf_(cg_));
    }
  }
  __syncthreads();
}

__device__ __forceinline__ void phase_mix1(const Params& p, int l, unsigned char* smem) {
  constexpr int N_LOC = 1024, N_SMP = 512, N_CV = 4;
  constexpr int N_ALL = N_LOC + N_SMP + N_CV;
  for (int it = blockIdx.x; it < N_ALL; it += gridDim.x) {
    int i = it;
    if (i < N_LOC) { mlstm_local_item(p, l, i, smem); continue; }
    i -= N_LOC;
    if (i < N_SMP) { mlstm_sample_item(p, l, i, smem); continue; }
    i -= N_SMP;
    mlstm_convout_item(p, l, i);
  }
}

__device__ __forceinline__ void phase_scan(const Params& p, int l, unsigned char* smem) {
  float* sdec = (float*)smem;
  float* ssc = sdec + 64;
  const int tid = tidx();
  float* Gb = (float*)(p.ws + WS_G);
  float* Tb = (float*)(p.ws + WS_TOT);
  float* Mb = (float*)(p.ws + WS_M);
  for (int it = blockIdx.x; it < 256; it += gridDim.x) {
    const int bh = it >> 4, slice = it & 15;
    if (tid < 64) { sdec[128 + tid] = Gb[bh * 64 + tid]; sdec[192 + tid] = Tb[bh * 64 + tid]; }
    __syncthreads();
    if (tid == 0) {
      float m = 0.f;
      for (int c = 0; c < 64; ++c) {
        const float G = sdec[128 + c], tot = sdec[192 + c];
        const float mn = fmaxf(tot + m, G);
        sdec[c] = __expf(tot + m - mn);
        ssc[c] = __expf(G - mn);
        if (slice == 0) Mb[bh * 64 + c] = m;
        m = mn;
      }
      if (slice == 0) p.out[O_MP + l * 16 + bh] = m;
    }
    __syncthreads();
    {
      const int idx = slice * 1024 + tid * 4;
      bf16* U = (bf16*)(p.ws + WS_U) + (size_t)bh * 64 * 16384 + idx;
      float st[4] = {0.f, 0.f, 0.f, 0.f};
#pragma unroll 8
      for (int c = 0; c < 64; ++c) {
        float u[4];
        unpack4(*(const uint2*)(U + (size_t)c * 16384), u);
        uint2 o;
        o.x = pack2(st[0], st[1]); o.y = pack2(st[2], st[3]);
        *(uint2*)(U + (size_t)c * 16384) = o;
        const float dc = sdec[c], sc = ssc[c];
#pragma unroll
        for (int x = 0; x < 4; ++x) st[x] = dc * st[x] + sc * u[x];
      }
      const int e = idx >> 7, d0 = idx & 127;
      float* Co = p.out + O_CP + ((size_t)l * 16 + bh) * 16384;
#pragma unroll
      for (int x = 0; x < 4; ++x) Co[(d0 + x) * 128 + e] = st[x];
    }
    if (slice == 0 && tid < 128) {
      float* un = (float*)(p.ws + WS_UN) + (size_t)bh * 64 * 128 + tid;
      float n = 0.f;
#pragma unroll 8
      for (int c = 0; c < 64; ++c) {
        const float u = un[c * 128];
        un[c * 128] = n;
        n = sdec[c] * n + ssc[c] * u;
      }
      p.out[O_NP + ((size_t)l * 16 + bh) * 128 + tid] = n;
    }
    __syncthreads();
  }
}

__device__ __forceinline__ void mlstm_out_item(const Params& p, int l, int item, unsigned char* smem) {
  const int bh = item >> 6, c = item & 63, b = bh >> 2, hh = bh & 3;
  const int r0 = b * SEQ + c * 64;
  bf16* z = (bf16*)(p.ws + WS_Z);
  bf16* sq = (bf16*)smem;
  bf16* sk = (bf16*)(smem + 17408);
  bf16* svT = (bf16*)(smem + 34816);
  bf16* sa = (bf16*)(smem + 53248);
  float* scum = (float*)(smem + 62464);
  float* siv = scum + 64;
  float* smt = siv + 64;
  float* swi = smt + 64;
  float* sden = swi + 64;
  float* sqn = sden + 64;
  float* spart = sqn + 64;
  const int tid = tidx(), lane = tid & 63, wave = tid >> 6;
  const int r16 = lane & 15, g4 = lane >> 4;
  if (wave == 0) {
    float cum, iv;
    chunk_gates(p, l, z, r0, hh, lane, cum, iv);
    scum[lane] = cum;
    siv[lane] = iv;
  }
  for (int i = tid; i < 1024; i += 256) {
    const int s = i >> 4, d8 = (i & 15) * 8;
    *(uint4*)(sk + s * 136 + d8) = *(const uint4*)((const bf16*)(p.ws + WS_H) + (size_t)(r0 + s) * 512 + hh * 128 + d8);
  }
  for (int i = tid; i < 1024; i += 256) {
    const int s = i >> 4, d8 = (i & 15) * 8;
    float y[8];
    conv8_prompt(p, l, z, r0, c * 64, s, hh * 128 + d8, y);
    uint4 o;
    o.x = pack2(y[0], y[1]); o.y = pack2(y[2], y[3]);
    o.z = pack2(y[4], y[5]); o.w = pack2(y[6], y[7]);
    *(uint4*)(sq + s * 136 + d8) = o;
  }
  for (int i = tid; i < 1024; i += 256) {
    const int s = i >> 4, d8 = (i & 15) * 8;
    float v[8];
    unpack8(*(const uint4*)(z + (size_t)(r0 + s) * ZC + C_V + hh * 128 + d8), v);
#pragma unroll
    for (int j = 0; j < 8; ++j) svT[(d8 + j) * 72 + s] = f2bf(v[j]);
  }
  __syncthreads();
  const float m_prev = ((const float*)(p.ws + WS_M))[item];
  {
    const int t = wave * 16 + r16;
    bf16x8 qf[4];
#pragma unroll
    for (int ks = 0; ks < 4; ++ks) qf[ks] = *(const bf16x8*)(sq + t * 136 + ks * 32 + g4 * 8);
    f32x4 st[4];
#pragma unroll
    for (int kt = 0; kt < 4; ++kt) {
      st[kt] = (f32x4){0.f, 0.f, 0.f, 0.f};
#pragma unroll
      for (int ks = 0; ks < 4; ++ks) {
        const bf16x8 kf = *(const bf16x8*)(sk + (kt * 16 + r16) * 136 + ks * 32 + g4 * 8);
        st[kt] = mfma16(kf, qf[ks], st[kt]);
      }
    }
    const float cumt = scum[t];
    float dm[4][4];
    float rmax = -INFINITY;
#pragma unroll
    for (int kt = 0; kt < 4; ++kt)
#pragma unroll
      for (int x = 0; x < 4; ++x) {
        const int s = kt * 16 + g4 * 4 + x;
        dm[kt][x] = (s <= t) ? (cumt - scum[s] + siv[s]) : -INFINITY;
        rmax = fmaxf(rmax, dm[kt][x]);
      }
    rmax = fmaxf(rmax, __shfl_xor(rmax, 16)); rmax = fmaxf(rmax, __shfl_xor(rmax, 32));
    const float mi = cumt + m_prev, mt = fmaxf(mi, rmax);
    float rsum = 0.f;
#pragma unroll
    for (int kt = 0; kt < 4; ++kt) {
      float a[4];
#pragma unroll
      for (int x = 0; x < 4; ++x) {
        const int s = kt * 16 + g4 * 4 + x;
        a[x] = (s <= t) ? __expf(dm[kt][x] - mt) * st[kt][x] : 0.f;
        rsum += a[x];
      }
      uint2 o;
      o.x = pack2(a[0], a[1]); o.y = pack2(a[2], a[3]);
      *(uint2*)(sa + t * 72 + kt * 16 + g4 * 4) = o;
    }
    rsum += __shfl_xor(rsum, 16); rsum += __shfl_xor(rsum, 32);
    if (g4 == 0) { smt[t] = mt; swi[t] = __expf(mi - mt); sden[t] = rsum; }
  }
  {
    const int t = tid >> 2, part = tid & 3;
    const float* nc = (const float*)(p.ws + WS_UN) + (size_t)item * 128;
    float s = 0.f;
    for (int d = part * 32; d < part * 32 + 32; ++d) s += bf2f(sq[t * 136 + d]) * nc[d];
    s += __shfl_xor(s, 1); s += __shfl_xor(s, 2);
    if (part == 0) sqn[t] = s;
  }
  __syncthreads();
  f32x4 acc[4][2];
#pragma unroll
  for (int ti = 0; ti < 4; ++ti)
#pragma unroll
    for (int et = 0; et < 2; ++et) acc[ti][et] = (f32x4){0.f, 0.f, 0.f, 0.f};
  const bf16* Cc = (const bf16*)(p.ws + WS_U) + (size_t)item * 16384;
#pragma unroll
  for (int ks = 0; ks < 4; ++ks) {
    bf16x8 cf[2], qf[4];
#pragma unroll
    for (int et = 0; et < 2; ++et) cf[et] = *(const bf16x8*)(Cc + (wave * 32 + et * 16 + r16) * 128 + ks * 32 + g4 * 8);
#pragma unroll
    for (int ti = 0; ti < 4; ++ti) qf[ti] = *(const bf16x8*)(sq + (ti * 16 + r16) * 136 + ks * 32 + g4 * 8);
#pragma unroll
    for (int ti = 0; ti < 4; ++ti)
#pragma unroll
      for (int et = 0; et < 2; ++et) acc[ti][et] = mfma16(cf[et], qf[ti], acc[ti][et]);
  }
#pragma unroll
  for (int ti = 0; ti < 4; ++ti) {
    const float w = swi[ti * 16 + r16];
#pragma unroll
    for (int et = 0; et < 2; ++et) acc[ti][et] *= w;
  }
#pragma unroll
  for (int ks = 0; ks < 2; ++ks) {
    bf16x8 vf[2], af[4];
#pragma unroll
    for (int et = 0; et < 2; ++et) vf[et] = *(const bf16x8*)(svT + (wave * 32 + et * 16 + r16) * 72 + ks * 32 + g4 * 8);
#pragma unroll
    for (int ti = 0; ti < 4; ++ti) af[ti] = *(const bf16x8*)(sa + (ti * 16 + r16) * 72 + ks * 32 + g4 * 8);
#pragma unroll
    for (int ti = 0; ti < 4; ++ti)
#pragma unroll
      for (int et = 0; et < 2; ++et) acc[ti][et] = mfma16(vf[et], af[ti], acc[ti][et]);
  }
#pragma unroll
  for (int ti = 0; ti < 4; ++ti) {
    const int t = ti * 16 + r16;
    const float den = sden[t] + swi[t] * sqn[t];
    const float inv = 1.0f / fmaxf(fabsf(den), __expf(-smt[t]));
    float ss = 0.f;
#pragma unroll
    for (int et = 0; et < 2; ++et) {
      acc[ti][et] *= inv;
#pragma unroll
      for (int x = 0; x < 4; ++x) ss += acc[ti][et][x] * acc[ti][et][x];
    }
    ss += __shfl_xor(ss, 16); ss += __shfl_xor(ss, 32);
    if (g4 == 0) spart[t * 4 + wave] = ss;
  }
  __syncthreads();
  const float* hg = p.hnorm_g + l * 512 + hh * 128;
#pragma unroll
  for (int ti = 0; ti < 4; ++ti) {
    const int t = ti * 16 + r16;
    const float rstd = rsqrtf((spart[t * 4] + spart[t * 4 + 1] + spart[t * 4 + 2] + spart[t * 4 + 3]) * (1.0f / 128.f) + EPS);
    bf16* zr = z + (size_t)(r0 + t) * ZC;
#pragma unroll
    for (int et = 0; et < 2; ++et) {
      const int e = wave * 32 + et * 16 + g4 * 4;
      float o[4], cg_[4];
      unpack4(*(const uint2*)(zr + C_O + hh * 128 + e), o);
      unpack4(*(const uint2*)(zr + C_G + hh * 128 + e), cg_);
      float y[4];
#pragma unroll
      for (int x = 0; x < 4; ++x) y[x] = acc[ti][et][x] * rstd * hg[e + x] * sigmoidf_(o[x]) * siluf_(cg_[x]);
      uint2 oo;
      oo.x = pack2(y[0], y[1]); oo.y = pack2(y[2], y[3]);
      *(uint2*)(zr + C_O + hh * 128 + e) = oo;
    }
  }
  __syncthreads();
}

__device__ __forceinline__ void phase_mix2(const Params& p, int l, unsigned char* smem) {
  for (int it = blockIdx.x; it < 1024; it += gridDim.x) mlstm_out_item(p, l, it, smem);
}

template <int NI>
__device__ __forceinline__ void br_tile(const Params& p, int l, int m0, int n0, bf16* sm) {
  const bf16* Wbr = (const bf16*)(p.ws + WS_WBR) + (size_t)l * 1024 * 1536;
  const bf16* yab = (const bf16*)(p.ws + WS_YAB);
  const bf16* z = (const bf16*)(p.ws + WS_Z);
  bf16* merged = (bf16*)(p.ws + WS_U);
  const float* bias = p.b_in + (size_t)l * ZIN + OFF_MG;
  const int lane = tidx() & 63, wave = tidx() >> 6, wr = wave >> 1, wc = wave & 1;
#pragma unroll 1
  for (int seg = 0; seg < 3; ++seg) {
    f32x4 acc[4][NI];
    zero_acc<NI>(acc);
    gemm_accum_f8<NI>(acc, p.ws + WS_H8 + (size_t)m0 * 1024, p.ws + WS_W8 + ((size_t)l * W8_ROWS + (OFF_MG - W8_ROW0) + seg * 1024 + n0) * 1024, sm);
    unsigned gp[4][NI][2];
#pragma unroll
    for (int j = 0; j < NI; ++j) {
      const int col = n0 + wc * (16 * NI) + j * 16 + (lane >> 4) * 4;
      const float4 bb = *(const float4*)(bias + seg * 1024 + col);
#pragma unroll
      for (int i = 0; i < 4; ++i) {
        gp[i][j][0] = pack2(sigmoidf_(acc[i][j][0] * 0.015625f + bb.x), sigmoidf_(acc[i][j][1] * 0.015625f + bb.y));
        gp[i][j][1] = pack2(sigmoidf_(acc[i][j][2] * 0.015625f + bb.z), sigmoidf_(acc[i][j][3] * 0.015625f + bb.w));
      }
    }
    zero_acc<NI>(acc);
    const bf16* A = (seg == 0) ? yab + (size_t)m0 * 1024 : (seg == 1) ? yab + (size_t)m0 * 1024 + 512 : z + (size_t)m0 * ZC + C_O;
    const int lda = (seg == 2) ? ZC : 1024;
    gemm_accum<NI, true>(acc, A, lda, Wbr + (size_t)n0 * 1536 + seg * 512, 1536, 512, sm);
#pragma unroll
    for (int i = 0; i < 4; ++i)
#pragma unroll
      for (int j = 0; j < NI; ++j) {
        const int row = m0 + wr * 64 + i * 16 + (lane & 15), col = n0 + wc * (16 * NI) + j * 16 + (lane >> 4) * 4;
        uint2* mp = (uint2*)(merged + (size_t)row * 1024 + col);
        uint2 prev = make_uint2(0u, 0u);
        if (seg > 0) prev = *mp;
        uint2 o;
        o.x = pack2(lo2f(prev.x) + lo2f(gp[i][j][0]) * acc[i][j][0], hi2f(prev.x) + hi2f(gp[i][j][0]) * acc[i][j][1]);
        o.y = pack2(lo2f(prev.y) + lo2f(gp[i][j][1]) * acc[i][j][2], hi2f(prev.y) + hi2f(gp[i][j][1]) * acc[i][j][3]);
        *mp = o;
      }
  }
}
__device__ __forceinline__ void phase_gemm_br(const Params& p, int l, unsigned char* smem) {
  bf16* sm = (bf16*)smem;
  const int ntiles = (TT / 128) * 8;
  const int nfull = (ntiles / (int)gridDim.x) * (int)gridDim.x;
  for (int t = blockIdx.x; t < nfull; t += gridDim.x) {
    int pm, pn;
    tile_map(t, 8, pm, pn);
    br_tile<4>(p, l, pm * 128, pn * 128, sm);
  }
  for (int u = blockIdx.x; u < 2 * (ntiles - nfull); u += gridDim.x) {
    int pm, pn;
    tile_map(nfull + (u >> 1), 8, pm, pn);
    br_tile<2>(p, l, pm * 128, pn * 128 + (u & 1) * 64, sm);
  }
}

template <int NI>
__device__ __forceinline__ void out_tile(const Params& p, int l, int m0, int n0, bf16* sm) {
  const bf16* merged = (const bf16*)(p.ws + WS_U);
  const bf16* Wout = (const bf16*)(p.ws + WS_WOUT) + (size_t)l * 1024 * 1024;
  const float* mod = (const float*)(p.ws + WS_MOD);
  const int lane = tidx() & 63, wave = tidx() >> 6, wr = wave >> 1, wc = wave & 1;
  f32x4 acc[4][NI];
  zero_acc<NI>(acc);
  gemm_accum<NI>(acc, merged + (size_t)m0 * 1024, 1024, Wout + (size_t)n0 * 1024, 1024, 1024, sm);
#pragma unroll
  for (int i = 0; i < 4; ++i) {
    const int row = m0 + wr * 64 + i * 16 + (lane & 15);
    const float* xr = xrow_ptr(p, l, row);
    const float* gate = mod + ((size_t)l * NMOD + mod_row(row)) * 3072 + 2048;
#pragma unroll
    for (int j = 0; j < NI; ++j) {
      const int col = n0 + wc * (16 * NI) + j * 16 + (lane >> 4) * 4;
      const float4 xv = *(const float4*)(xr + col), gv = *(const float4*)(gate + col);
      float4 o;
      o.x = xv.x + gv.x * acc[i][j][0]; o.y = xv.y + gv.y * acc[i][j][1];
      o.z = xv.z + gv.z * acc[i][j][2]; o.w = xv.w + gv.w * acc[i][j][3];
      *(float4*)(p.out + (size_t)row * D + col) = o;
    }
  }
}
__device__ __forceinline__ void phase_gemm_out(const Params& p, int l, unsigned char* smem) {
  bf16* sm = (bf16*)smem;
  const int ntiles = (TT / 128) * 8;
  const int nfull = (ntiles / (int)gridDim.x) * (int)gridDim.x;
  for (int t = blockIdx.x; t < nfull; t += gridDim.x) {
    int pm, pn;
    tile_map(t, 8, pm, pn);
    out_tile<4>(p, l, pm * 128, pn * 128, sm);
  }
  for (int u = blockIdx.x; u < 2 * (ntiles - nfull); u += gridDim.x) {
    int pm, pn;
    tile_map(nfull + (u >> 1), 8, pm, pn);
    out_tile<2>(p, l, pm * 128, pn * 128 + (u & 1) * 64, sm);
  }
}

constexpr int N_PHASES = 19;
template <int S>
__device__ __forceinline__ void run_stage(const Params& p, int l, unsigned char* smem) {
  if (S == -1) phase_prep(p, smem);
  if (S == 0) phase_norm(p, l);
  if (S == 1) phase_gemm_in(p, l, 0, ZAB / 128, ZAB, smem);
  if (S == 2) phase_mix_ab(p, l, smem);
  if (S == 3) phase_gemm_in(p, l, ZAB, ZC / 128, ZC, smem);
  if (S == 4) phase_mix1(p, l, smem);
  if (S == 5) phase_scan(p, l, smem);
  if (S == 6) phase_mix2(p, l, smem);
  if (S == 7) phase_gemm_br(p, l, smem);
  if (S == 8) phase_gemm_out(p, l, smem);
}


#define XB_TMO      128
#define XB_XCNT(j)  (256  + 64 * (j))
#define XB_XSUB(j)  (1280 + 64 * (j))
#define XB_XGEN(j)  (2304 + 64 * (j))
#define XB_TOP      3328
#define XB_TOPGEN   3392
#define XCD_BAR_WORDS 3456
#define XB_SPIN_CAP (1u << 18)
#define LAS __attribute__((address_space(3)))
__device__ __forceinline__ unsigned xb_ld(unsigned* p)              { return __hip_atomic_load(p, __ATOMIC_RELAXED, __HIP_MEMORY_SCOPE_AGENT); }
__device__ __forceinline__ unsigned xb_add(unsigned* p, unsigned v) { return __hip_atomic_fetch_add(p, v, __ATOMIC_RELAXED, __HIP_MEMORY_SCOPE_AGENT); }
__device__ __forceinline__ unsigned xb_xcc_id() { return (unsigned)__builtin_amdgcn_s_getreg((3 << 11) | 20) & 0xFu; }
#define XB_SPIN(cond, bar) do { unsigned _sp = 0; while (cond) { __builtin_amdgcn_s_sleep(1); \
    if ((++_sp & 255u) == 0u) { if (xb_ld(&(bar)[XB_TMO])) break; if (_sp > XB_SPIN_CAP) { atomicAdd(&(bar)[XB_TMO], 1u); break; } } } } while (0)
struct XcdBarrier { unsigned* bar; unsigned x; volatile LAS unsigned* st; };
__device__ __forceinline__ XcdBarrier xcd_barrier_post(unsigned* bar, volatile LAS unsigned* st) {
  XcdBarrier b; b.bar = bar; b.x = xb_xcc_id(); b.st = st;
  if (threadIdx.x == 0) (void)xb_add(&bar[XB_XCNT(b.x)], 1u);
  return b;
}
__device__ __forceinline__ void xcd_barrier_complete(unsigned* bar, unsigned x, unsigned& nloc, unsigned& nx) {
  const unsigned G = gridDim.x * gridDim.y * gridDim.z;
  unsigned sum, cnt, mine, sp = 0u;
  for (;;) {
    sum = 0u; cnt = 0u; mine = 0u;
#pragma unroll
    for (unsigned j = 0; j < 16; ++j) { const unsigned c = xb_ld(&bar[XB_XCNT(j)]); sum += c; cnt += (c > 0u) ? 1u : 0u; mine = (j == x) ? c : mine; }
    if (sum == G) break;
    __builtin_amdgcn_s_sleep(1);
    if ((++sp & 255u) == 0u) { if (xb_ld(&bar[XB_TMO])) break; if (sp > XB_SPIN_CAP) { atomicAdd(&bar[XB_TMO], 1u); break; } }
  }
  nloc = mine > 0u ? mine : 1u; nx = cnt > 0u ? cnt : 1u;
}
__device__ __forceinline__ void xcd_barrier(const XcdBarrier& b) {
  asm volatile("s_waitcnt vmcnt(0)" ::: "memory");
  __syncthreads();
  if (threadIdx.x == 0) {
    unsigned* bar = b.bar;
    __builtin_amdgcn_s_waitcnt(0);
    unsigned nloc = b.st[0], nx = b.st[1];
    if (nloc == 0u) { xcd_barrier_complete(bar, b.x, nloc, nx); b.st[0] = nloc; b.st[1] = nx; }
    const unsigned old = xb_add(&bar[XB_XSUB(b.x)], 1u);
    const unsigned gen = old / nloc;
    if (old + 1u == (gen + 1u) * nloc) {
      __builtin_amdgcn_fence(__ATOMIC_RELEASE, "agent");
      asm volatile("s_waitcnt vmcnt(0)" ::: "memory");
      const unsigned og = xb_add(&bar[XB_TOP], 1u);
      const unsigned tg = og / nx;
      if (og + 1u == (tg + 1u) * nx) xb_add(&bar[XB_TOPGEN], 1u);
      else XB_SPIN(xb_ld(&bar[XB_TOPGEN]) == tg, bar);
      __builtin_amdgcn_fence(__ATOMIC_ACQUIRE, "agent");
      xb_add(&bar[XB_XGEN(b.x)], 1u);
      asm volatile("s_waitcnt vmcnt(0)" ::: "memory");
    } else {
      XB_SPIN(xb_ld(&bar[XB_XGEN(b.x)]) == gen, bar);
      __builtin_amdgcn_fence(__ATOMIC_ACQUIRE, "agent");
      asm volatile("s_waitcnt vmcnt(0)" ::: "memory");
    }
  }
  __syncthreads();
}

#define GSYNC() xcd_barrier(xb)
__global__ void __launch_bounds__(256, 2) mega_kernel(Params p_in) {
  __shared__ __attribute__((aligned(16))) unsigned char smem[SMEM_BYTES];
  const Params& p = *(const Params*)__builtin_amdgcn_kernarg_segment_ptr();
  __shared__ uint4 xb_words;
  if (threadIdx.x == 0) xb_words = make_uint4(0u, 0u, 0u, 0u);
  __syncthreads();
  XcdBarrier xb = xcd_barrier_post((unsigned*)(p.ws + WS_BAR), (volatile LAS unsigned*)&xb_words);
  run_stage<-1>(p, 0, smem);
  if (p.out == nullptr) cg::this_grid().sync();
  GSYNC();
#define LAYER(L, LAST)                 \
  run_stage<0>(p, L, smem); GSYNC();   \
  run_stage<1>(p, L, smem); GSYNC();   \
  run_stage<2>(p, L, smem); GSYNC();   \
  run_stage<3>(p, L, smem); GSYNC();   \
  run_stage<4>(p, L, smem); GSYNC();   \
  run_stage<5>(p, L, smem); GSYNC();   \
  run_stage<6>(p, L, smem); GSYNC();   \
  run_stage<7>(p, L, smem); GSYNC();   \
  run_stage<8>(p, L, smem);            \
  if (!LAST) GSYNC();
  int l0 = 0, l1 = 1;
  asm volatile("" : "+s"(l0));
  asm volatile("" : "+s"(l1));
  LAYER(l0, 0)
  LAYER(l1, 1)
}

extern "C" void kernel_launch(void* const* d_in, const int* in_sizes, int n_in, void* d_out, int out_size, void* d_ws,
                              size_t ws_size, hipStream_t stream) {
  if (ws_size < WS_END || n_in < 29) { fprintf(stderr, "workspace too small / bad inputs\n"); return; }
  Params p{};
  const float** f = (const float**)&p;
  for (int i = 0; i < 29; ++i) f[i] = (const float*)d_in[i];
  p.out = (float*)d_out;
  p.ws = (unsigned char*)d_ws;
  static int grid_blocks = 0;
  if (!grid_blocks) {
    int dev = 0, cus = 0, per_cu = 0;
    (void)hipGetDevice(&dev);
    (void)hipDeviceGetAttribute(&cus, hipDeviceAttributeMultiprocessorCount, dev);
    (void)hipOccupancyMaxActiveBlocksPerMultiprocessor(&per_cu, mega_kernel, 256, 0);
    if (per_cu < 1) per_cu = 1;
    if (per_cu > 2) per_cu = 2;
    grid_blocks = cus * per_cu;
  }
  (void)hipMemsetAsync((unsigned char*)d_ws + WS_BAR, 0, 16384, stream);
  void* args[] = {&p};
  hipError_t e = hipLaunchCooperativeKernel((void*)mega_kernel, dim3(grid_blocks), dim3(256), args, 0, stream);
  if (e != hipSuccess) fprintf(stderr, "cooperative launch failed: %s (grid %d)\n", hipGetErrorString(e), grid_blocks);
}
```

```cpp
#include <hip/hip_runtime.h>
#include <hip/hip_cooperative_groups.h>
#include <cstdio>
namespace cg = cooperative_groups;

typedef unsigned short bf16;
typedef short bf16x8 __attribute__((ext_vector_type(8)));
typedef float f32x4 __attribute__((ext_vector_type(4)));
typedef unsigned u32x4 __attribute__((ext_vector_type(4)));
#define LDSP __attribute__((address_space(3)))

#ifndef SINGLE_LAUNCH
#define SINGLE_LAUNCH 0
#endif

constexpr int D = 1024, TP = 16384, TS = 1024, TT = TP + TS, SEQ = 4096;
constexpr int ZIN = 8456, NWIN = 8576;
constexpr int OFF_AV = 512, OFF_AG = 1024, OFF_BQ = 1536, OFF_BK = 2048, OFF_BV = 2176, OFF_BG = 2304, OFF_MG = 5384;
constexpr int ZAB = 2816;
constexpr int ZC = 2688;
constexpr int C_QK = 0, C_V = 1024, C_I = 1536, C_F = 1540, C_O = 1544, C_G = 2056;
constexpr float EPS = 1e-6f;
constexpr int NMOD = 132;
constexpr int SMEM_BYTES = 73728;

constexpr size_t O_Y = 0;
constexpr size_t O_SKP = (size_t)TT * D;
constexpr size_t O_SVP = O_SKP + 2 * 4 * 128 * 128;
constexpr size_t O_CVP = O_SVP + 2 * 4 * 128 * 128;
constexpr size_t O_CP = O_CVP + 2 * 4 * 3 * 1024;
constexpr size_t O_NP = O_CP + (size_t)2 * 4 * 4 * 128 * 128;
constexpr size_t O_MP = O_NP + 2 * 4 * 4 * 128;
constexpr size_t O_SKS = O_MP + 2 * 4 * 4;
constexpr size_t O_SVS = O_SKS + (size_t)2 * 128 * 128 * 128;
constexpr size_t O_CVS = O_SVS + (size_t)2 * 128 * 128 * 128;
constexpr size_t O_CS = O_CVS + (size_t)2 * 128 * 3 * 1024;
constexpr size_t O_NS = O_CS + (size_t)2 * 128 * 4 * 128 * 128;
constexpr size_t O_MS = O_NS + (size_t)2 * 128 * 4 * 128;
constexpr size_t O_GV = O_MS + 2 * 128 * 4;
constexpr size_t O_END = O_GV + (size_t)2 * 128 * 8 * 512;

constexpr size_t WS_WIN = 0;
constexpr size_t WS_WBR = WS_WIN + (size_t)2 * NWIN * 1024 * 2;
constexpr size_t WS_WOUT = WS_WBR + (size_t)2 * 1024 * 1536 * 2;
constexpr size_t WS_MOD = WS_WOUT + (size_t)2 * 1024 * 1024 * 2;
constexpr size_t WS_H = WS_MOD + (size_t)2 * NMOD * 3072 * 4;
constexpr size_t WS_YAB = WS_H + (size_t)TT * 1024 * 2;
constexpr size_t WS_U = WS_YAB + (size_t)TT * 1024 * 2;
constexpr size_t WS_UN = WS_U + (size_t)TT * 1024 * 2;
constexpr size_t WS_G = WS_UN + (size_t)1024 * 128 * 4;
constexpr size_t WS_TOT = WS_G + 4096;
constexpr size_t WS_M = WS_TOT + 4096;
constexpr size_t WS_Z = WS_M + 4096;
constexpr size_t WS_BAR = WS_Z + (size_t)TT * ZAB * 2;
constexpr size_t WS_H8 = WS_BAR + 16384;
constexpr int W8_ROW0 = 0, W8_ROWS = NWIN;
constexpr size_t WS_W8 = WS_H8 + (size_t)TT * 1024;
constexpr size_t WS_END = WS_W8 + (size_t)2 * W8_ROWS * 1024;

struct Params {
  const float *x_prompt, *x_sample, *cache_k, *cache_v, *st_conv, *st_C, *st_n, *st_m, *c_prompt, *c_sample;
  const float *ada_w, *ada_b, *norm_g, *w_in, *b_in, *vnorm_g, *gmlp_ws, *gmlp_bs, *qn_g, *kn_g, *sinks;
  const float *conv_w, *conv_b, *f_bias, *hnorm_g, *w_a, *w_b, *w_c, *w_out;
  float* out;
  unsigned char* ws;
};

__device__ __forceinline__ int tidx() { int t = threadIdx.x; asm volatile("" : "+v"(t)); return t; }
__device__ __forceinline__ bf16 f2bf(float f) {
  unsigned u = __float_as_uint(f);
  u += 0x7fffu + ((u >> 16) & 1u);
  return (bf16)(u >> 16);
}
__device__ __forceinline__ float bf2f(bf16 h) { return __uint_as_float(((unsigned)h) << 16); }
__device__ __forceinline__ unsigned pack2(float a, float b) { return (unsigned)f2bf(a) | ((unsigned)f2bf(b) << 16); }
__device__ __forceinline__ float lo2f(unsigned u) { return __uint_as_float(u << 16); }
__device__ __forceinline__ float hi2f(unsigned u) { return __uint_as_float(u & 0xffff0000u); }
__device__ __forceinline__ void unpack8(const uint4& v, float* f) {
  f[0] = lo2f(v.x); f[1] = hi2f(v.x); f[2] = lo2f(v.y); f[3] = hi2f(v.y);
  f[4] = lo2f(v.z); f[5] = hi2f(v.z); f[6] = lo2f(v.w); f[7] = hi2f(v.w);
}
__device__ __forceinline__ void unpack4(const uint2& v, float* f) {
  f[0] = lo2f(v.x); f[1] = hi2f(v.x); f[2] = lo2f(v.y); f[3] = hi2f(v.y);
}
__device__ __forceinline__ float sigmoidf_(float x) { return __builtin_amdgcn_rcpf(1.0f + __expf(-x)); }
__device__ __forceinline__ float siluf_(float x) { return x * __builtin_amdgcn_rcpf(1.0f + __expf(-x)); }
__device__ __forceinline__ float logsigmoidf_(float x) { return fminf(x, 0.0f) - log1pf(__expf(-fabsf(x))); }
__device__ __forceinline__ float wave_sum(float v) {
#pragma unroll
  for (int o = 32; o >= 1; o >>= 1) v += __shfl_xor(v, o);
  return v;
}
__device__ __forceinline__ float wave_max(float v) {
#pragma unroll
  for (int o = 32; o >= 1; o >>= 1) v = fmaxf(v, __shfl_xor(v, o));
  return v;
}
__device__ __forceinline__ f32x4 mfma16(bf16x8 a, bf16x8 b, f32x4 c) {
  return __builtin_amdgcn_mfma_f32_16x16x32_bf16(a, b, c, 0, 0, 0);
}
template <int MI, int NI>
__device__ __forceinline__ void mma_lds(f32x4 (&acc)[MI][NI], const bf16* sA, int lda, const bf16* sB, int ldb, int K, int lane) {
  const int r = lane & 15, q = (lane >> 4) * 8;
  for (int k0 = 0; k0 < K; k0 += 32) {
    bf16x8 a[MI], b[NI];
#pragma unroll
    for (int i = 0; i < MI; ++i) a[i] = *(const bf16x8*)(sA + (i * 16 + r) * lda + k0 + q);
#pragma unroll
    for (int j = 0; j < NI; ++j) b[j] = *(const bf16x8*)(sB + (j * 16 + r) * ldb + k0 + q);
#pragma unroll
    for (int i = 0; i < MI; ++i)
#pragma unroll
      for (int j = 0; j < NI; ++j) acc[i][j] = mfma16(b[j], a[i], acc[i][j]);
  }
}

constexpr int GLD = 64;
constexpr int GTILE = 128 * GLD;
template <int NI>
__device__ __forceinline__ void g_load(u32x4 (&ra)[4], u32x4 (&rb)[NI], const bf16* __restrict__ A, int lda, const bf16* __restrict__ B, int ldb, int ko, int tid) {
  const unsigned offA = (unsigned)((tid >> 3) * lda + (tid & 7) * 8), offB = (unsigned)((tid >> 3) * ldb + (tid & 7) * 8);
#pragma unroll
  for (int i = 0; i < 4; ++i) {
    const bf16* Ai = A + (size_t)(i * 32) * lda + ko;
    ra[i] = *(const u32x4*)(Ai + offA);
  }
#pragma unroll
  for (int i = 0; i < NI; ++i) {
    const bf16* Bi = B + (size_t)(i * 32) * ldb + ko;
    rb[i] = *(const u32x4*)(Bi + offB);
  }
}
template <int NI>
__device__ __forceinline__ void g_store(const u32x4 (&ra)[4], const u32x4 (&rb)[NI], bf16* buf, int tid) {
  const int off = (tid >> 3) * GLD + (((tid & 7) ^ ((tid >> 3) & 7)) * 8);
#pragma unroll
  for (int i = 0; i < 4; ++i) *(u32x4*)(buf + off + i * 32 * GLD) = ra[i];
#pragma unroll
  for (int i = 0; i < NI; ++i) *(u32x4*)(buf + GTILE + off + i * 32 * GLD) = rb[i];
}
template <int NI, bool LOWREG = false>
__device__ __forceinline__ void g_compute(f32x4 (&acc)[4][NI], const bf16* cur, int wr, int wc, int lane) {
  const int r16 = lane & 15, sw = lane & 7, q = lane >> 4;
#pragma unroll
  for (int ks = 0; ks < 2; ++ks) {
    const int pc = ((ks * 4 + q) ^ sw) * 8;
    bf16x8 a[4];
#pragma unroll
    for (int i = 0; i < 4; ++i) a[i] = *(const bf16x8*)(cur + (wr * 64 + i * 16 + r16) * GLD + pc);
    constexpr int JW = (NI >= 2) ? 2 : 1;
#pragma unroll
    for (int jh = 0; jh < NI; jh += JW) {
      bf16x8 b[JW];
#pragma unroll
      for (int j = 0; j < JW; ++j) b[j] = *(const bf16x8*)(cur + GTILE + (wc * 16 * NI + (jh + j) * 16 + r16) * GLD + pc);
#pragma unroll
      for (int i = 0; i < 4; ++i)
#pragma unroll
        for (int j = 0; j < JW; ++j) acc[i][jh + j] = mfma16(b[j], a[i], acc[i][jh + j]);
      if (LOWREG) __builtin_amdgcn_sched_barrier(0);
    }
  }
}
template <int NI, bool F8SWZ = false>
__device__ __forceinline__ void g_stage(const bf16* __restrict__ A, int lda, const bf16* __restrict__ B, int ldb, int ko, bf16* buf, int tid) {
  const int wave = tid >> 6;
  const int lrow = tid >> 3;
  const int gch = ((tid & 7) ^ (F8SWZ ? ((lrow & 6) | ((lrow >> 3) & 1)) : (lrow & 7))) * 8;
  const unsigned offA = (unsigned)((tid >> 3) * lda + gch), offB = (unsigned)((tid >> 3) * ldb + gch);
#pragma unroll
  for (int i = 0; i < 4; ++i) {
    const bf16* Ai = A + (size_t)(i * 32) * lda + ko;
    __builtin_amdgcn_global_load_lds((const unsigned*)(Ai + offA), (LDSP unsigned*)(buf + (i * 32 + wave * 8) * GLD), 16, 0, 0);
  }
#pragma unroll
  for (int i = 0; i < NI; ++i) {
    const bf16* Bi = B + (size_t)(i * 32) * ldb + ko;
    __builtin_amdgcn_global_load_lds((const unsigned*)(Bi + offB), (LDSP unsigned*)(buf + GTILE + (i * 32 + wave * 8) * GLD), 16, 0, 0);
  }
}
template <int NI, bool LOWREG = false>
__device__ __forceinline__ void gemm_accum(f32x4 (&acc)[4][NI], const bf16* __restrict__ A, int lda,
                                           const bf16* __restrict__ B, int ldb, int K, bf16* sm) {
  const int tid = tidx(), lane = tid & 63, wave = tid >> 6, wr = wave >> 1, wc = wave & 1;
  const int nk = K >> 6;
  bf16* buf0 = sm;
  bf16* buf1 = sm + 2 * GTILE;
  g_stage<NI>(A, lda, B, ldb, 0, buf0, tid);
  asm volatile("s_waitcnt vmcnt(0)" ::: "memory");
  __syncthreads();
#pragma unroll 1
  for (int kt = 0; kt < nk; kt += 2) {
    g_stage<NI>(A, lda, B, ldb, (kt + 1) * 64, buf1, tid);
    g_compute<NI, LOWREG>(acc, buf0, wr, wc, lane);
    asm volatile("s_waitcnt vmcnt(0)" ::: "memory");
    __syncthreads();
    if (kt + 2 < nk) g_stage<NI>(A, lda, B, ldb, (kt + 2) * 64, buf0, tid);
    g_compute<NI, LOWREG>(acc, buf1, wr, wc, lane);
    asm volatile("s_waitcnt vmcnt(0)" ::: "memory");
    __syncthreads();
  }
}
typedef int i32x8 __attribute__((ext_vector_type(8)));
template <int NI>
__device__ __forceinline__ void g_compute_f8(f32x4 (&acc)[4][NI], const bf16* cur, int wr, int wc, int lane) {
  const int r16 = lane & 15, sw = (r16 & 6) | (r16 >> 3), q = lane >> 4;
  const int pc0 = ((2 * q) ^ sw) * 8, pc1 = ((2 * q + 1) ^ sw) * 8;
  i32x8 b[NI];
#pragma unroll
  for (int j = 0; j < NI; ++j) {
    const bf16* rp = cur + GTILE + (wc * 16 * NI + j * 16 + r16) * GLD;
    const u32x4 lo = *(const u32x4*)(rp + pc0), hi = *(const u32x4*)(rp + pc1);
    b[j] = (i32x8){(int)lo.x, (int)lo.y, (int)lo.z, (int)lo.w, (int)hi.x, (int)hi.y, (int)hi.z, (int)hi.w};
  }
#pragma unroll
  for (int i = 0; i < 4; ++i) {
    const bf16* rp = cur + (wr * 64 + i * 16 + r16) * GLD;
    const u32x4 lo = *(const u32x4*)(rp + pc0), hi = *(const u32x4*)(rp + pc1);
    const i32x8 a = (i32x8){(int)lo.x, (int)lo.y, (int)lo.z, (int)lo.w, (int)hi.x, (int)hi.y, (int)hi.z, (int)hi.w};
#pragma unroll
    for (int j = 0; j < NI; ++j)
      acc[i][j] = __builtin_amdgcn_mfma_scale_f32_16x16x128_f8f6f4(b[j], a, acc[i][j], 0, 0, 0, 0x7F7F7F7F, 0, 0x7F7F7F7F);
  }
}
template <int NI>
__device__ __forceinline__ void gemm_accum_f8(f32x4 (&acc)[4][NI], const unsigned char* __restrict__ A8, const unsigned char* __restrict__ B8, bf16* sm) {
  const int tid = tidx(), lane = tid & 63, wave = tid >> 6, wr = wave >> 1, wc = wave & 1;
  const bf16* A = (const bf16*)A8;
  const bf16* B = (const bf16*)B8;
  bf16* buf0 = sm;
  bf16* buf1 = sm + 2 * GTILE;
  g_stage<NI, true>(A, 512, B, 512, 0, buf0, tid);
  asm volatile("s_waitcnt vmcnt(0)" ::: "memory");
  __syncthreads();
#pragma unroll 1
  for (int kt = 0; kt < 8; kt += 2) {
    g_stage<NI, true>(A, 512, B, 512, (kt + 1) * 64, buf1, tid);
    g_compute_f8<NI>(acc, buf0, wr, wc, lane);
    asm volatile("s_waitcnt vmcnt(0)" ::: "memory");
    __syncthreads();
    if (kt + 2 < 8) g_stage<NI, true>(A, 512, B, 512, (kt + 2) * 64, buf0, tid);
    g_compute_f8<NI>(acc, buf1, wr, wc, lane);
    asm volatile("s_waitcnt vmcnt(0)" ::: "memory");
    __syncthreads();
  }
}
template <int NI>
__device__ __forceinline__ void zero_acc(f32x4 (&acc)[4][NI]) {
#pragma unroll
  for (int i = 0; i < 4; ++i)
#pragma unroll
    for (int j = 0; j < NI; ++j) acc[i][j] = (f32x4){0.f, 0.f, 0.f, 0.f};
}
__device__ __forceinline__ void tile_map(int t, int ntn, int& pm, int& pn) {
  const int grp = t / (8 * ntn), w = t % (8 * ntn);
  pm = grp * 8 + (w & 7);
  pn = w >> 3;
}

__device__ __forceinline__ void transpose_tile(const float* __restrict__ src, int ld_src, int n_valid, bf16* __restrict__ dst, int ld_dst,
                               int k0, int n0, int kdst0, float* sm, unsigned char* dst8 = nullptr) {
  const int tid = tidx();
  for (int i = tid; i < 64 * 16; i += 256) {
    const int kk = i >> 4, n4 = (i & 15) * 4, n = n0 + n4;
    float4 v = make_float4(0.f, 0.f, 0.f, 0.f);
    if (n + 3 < n_valid) v = *(const float4*)(src + (size_t)(k0 + kk) * ld_src + n);
    sm[kk * 65 + n4 + 0] = v.x; sm[kk * 65 + n4 + 1] = v.y; sm[kk * 65 + n4 + 2] = v.z; sm[kk * 65 + n4 + 3] = v.w;
  }
  __syncthreads();
  for (int i = tid; i < 64 * 8; i += 256) {
    const int nn = i >> 3, kc = (i & 7) * 8;
    uint4 o;
    o.x = pack2(sm[(kc + 0) * 65 + nn], sm[(kc + 1) * 65 + nn]);
    o.y = pack2(sm[(kc + 2) * 65 + nn], sm[(kc + 3) * 65 + nn]);
    o.z = pack2(sm[(kc + 4) * 65 + nn], sm[(kc + 5) * 65 + nn]);
    o.w = pack2(sm[(kc + 6) * 65 + nn], sm[(kc + 7) * 65 + nn]);
    *(uint4*)(dst + (size_t)(n0 + nn) * ld_dst + kdst0 + kc) = o;
    if (dst8 != nullptr) {
      uint2 q8;
      int t8 = __builtin_amdgcn_cvt_pk_fp8_f32(64.f * sm[(kc + 0) * 65 + nn], 64.f * sm[(kc + 1) * 65 + nn], 0, false);
      q8.x = (unsigned)__builtin_amdgcn_cvt_pk_fp8_f32(64.f * sm[(kc + 2) * 65 + nn], 64.f * sm[(kc + 3) * 65 + nn], t8, true);
      t8 = __builtin_amdgcn_cvt_pk_fp8_f32(64.f * sm[(kc + 4) * 65 + nn], 64.f * sm[(kc + 5) * 65 + nn], 0, false);
      q8.y = (unsigned)__builtin_amdgcn_cvt_pk_fp8_f32(64.f * sm[(kc + 6) * 65 + nn], 64.f * sm[(kc + 7) * 65 + nn], t8, true);
      *(uint2*)(dst8 + (size_t)(n0 + nn - W8_ROW0) * 1024 + kdst0 + kc) = q8;
    }
  }
  __syncthreads();
}

__device__ __forceinline__ void ada_item(const Params& p, int item, float* sm) {
  const int l = item / 192, n0 = (item % 192) * 16;
  const int tid = tidx(), col = tid & 15, rg = tid >> 4;
  constexpr int SLD = 68;
  float* sW = sm + 144 * SLD;
  float acc[9];
#pragma unroll
  for (int j = 0; j < 9; ++j) acc[j] = 0.f;
  const float* W = p.ada_w + (size_t)l * 1024 * 3072 + n0;
  const int wk = tid >> 2, wc4 = (tid & 3) * 4;
  float v[36];
  float4 w0;
#define ADA_LOAD(K0)                                                                                      \
  {                                                                                                       \
    _Pragma("unroll") for (int u = 0; u < 36; ++u) {                                                      \
      const int i = tid + 256 * u, r = i >> 6, kk = i & 63;                                               \
      v[u] = 0.f;                                                                                         \
      if (r < NMOD) v[u] = (r < 4) ? p.c_prompt[r * 1024 + (K0) + kk] : p.c_sample[(r - 4) * 1024 + (K0) + kk]; \
    }                                                                                                     \
    w0 = *(const float4*)(W + (size_t)((K0) + wk) * 3072 + wc4);                                          \
  }
#define ADA_STORE()                                                                                       \
  {                                                                                                       \
    _Pragma("unroll") for (int u = 0; u < 36; ++u) {                                                      \
      const int i = tid + 256 * u, r = i >> 6, kk = i & 63;                                               \
      sm[r * SLD + kk] = siluf_(v[u]);                                                                    \
    }                                                                                                     \
    *(float4*)(sW + wk * 16 + wc4) = w0;                                                                  \
  }
  ADA_LOAD(0)
  ADA_STORE()
  __syncthreads();
#pragma unroll 1
  for (int k0 = 0; k0 < 1024; k0 += 64) {
    if (k0 + 64 < 1024) ADA_LOAD(k0 + 64)
#pragma unroll 4
    for (int k4 = 0; k4 < 16; ++k4) {
      const float x0 = sW[(k4 * 4 + 0) * 16 + col], x1 = sW[(k4 * 4 + 1) * 16 + col];
      const float x2 = sW[(k4 * 4 + 2) * 16 + col], x3 = sW[(k4 * 4 + 3) * 16 + col];
#pragma unroll
      for (int j = 0; j < 9; ++j) {
        const float4 sv = *(const float4*)(sm + (rg * 9 + j) * SLD + k4 * 4);
        acc[j] += sv.x * x0 + sv.y * x1 + sv.z * x2 + sv.w * x3;
      }
    }
    __syncthreads();
    if (k0 + 64 < 1024) ADA_STORE()
    __syncthreads();
  }
#undef ADA_LOAD
#undef ADA_STORE
  float* mod = (float*)(p.ws + WS_MOD);
  const float b = p.ada_b[l * 3072 + n0 + col];
#pragma unroll
  for (int j = 0; j < 9; ++j) {
    const int r = rg * 9 + j;
    if (r < NMOD) mod[((size_t)l * NMOD + r) * 3072 + n0 + col] = acc[j] + b;
  }
}

__device__ __forceinline__ void phase_prep(const Params& p, unsigned char* smem) {
  float* sm = (float*)smem;
  constexpr int N_WIN = 2 * 16 * (NWIN / 64);
  constexpr int N_WBR = 2 * 3 * 8 * 16;
  constexpr int N_WOUT = 2 * 16 * 16;
  constexpr int N_ALL = N_WIN + N_WBR + N_WOUT;
  bf16* WinT = (bf16*)(p.ws + WS_WIN);
  bf16* WbrT = (bf16*)(p.ws + WS_WBR);
  bf16* WoutT = (bf16*)(p.ws + WS_WOUT);
  constexpr int N_ADA = 384;
  for (int it = blockIdx.x; it < N_ADA + N_ALL; it += gridDim.x) {
    if (it < N_ADA) { ada_item(p, it, sm); continue; }
    int i = it - N_ADA;
    if (i < N_WIN) {
      const int l = i / (16 * 134), r = i % (16 * 134), kt = r / 134, nt = r % 134;
      transpose_tile(p.w_in + (size_t)l * 1024 * ZIN, ZIN, ZIN, WinT + (size_t)l * NWIN * 1024, 1024, kt * 64, nt * 64, kt * 64, sm,
                     (nt * 64 >= W8_ROW0) ? p.ws + WS_W8 + (size_t)l * W8_ROWS * 1024 : nullptr);
      continue;
    }
    i -= N_WIN;
    if (i < N_WBR) {
      const int l = i / 384, r = i % 384, seg = r / 128, r2 = r % 128, kt = r2 / 16, nt = r2 % 16;
      const float* src = (seg == 0 ? p.w_a : seg == 1 ? p.w_b : p.w_c) + (size_t)l * 512 * 1024;
      transpose_tile(src, 1024, 1024, WbrT + (size_t)l * 1024 * 1536, 1536, kt * 64, nt * 64, seg * 512 + kt * 64, sm);
      continue;
    }
    i -= N_WBR;
    {
      const int l = i / 256, r = i % 256, kt = r / 16, nt = r % 16;
      transpose_tile(p.w_out + (size_t)l * 1024 * 1024, 1024, 1024, WoutT + (size_t)l * 1024 * 1024, 1024, kt * 64, nt * 64, kt * 64, sm);
    }
  }
}

__device__ __forceinline__ const float* xrow_ptr(const Params& p, int l, int row) {
  if (l == 0) return row < TP ? p.x_prompt + (size_t)row * D : p.x_sample + (size_t)(row - TP) * D;
  return p.out + (size_t)row * D;
}
__device__ __forceinline__ int mod_row(int row) { return row < TP ? (row >> 12) : 4 + ((row - TP) >> 3); }

__device__ __forceinline__ void phase_norm(const Params& p, int l) {
  const int lane = tidx() & 63, wave = tidx() >> 6;
  bf16* hbuf = (bf16*)(p.ws + WS_H);
  unsigned char* h8 = p.ws + WS_H8;
  const float* mod = (const float*)(p.ws + WS_MOD);
  const float* g = p.norm_g + l * D;
  for (int row = blockIdx.x * 4 + wave; row < TT; row += gridDim.x * 4) {
    const float4* x = (const float4*)xrow_ptr(p, l, row);
    float4 v[4];
    float ss = 0.f;
#pragma unroll
    for (int i = 0; i < 4; ++i) {
      v[i] = x[lane + 64 * i];
      ss += v[i].x * v[i].x + v[i].y * v[i].y + v[i].z * v[i].z + v[i].w * v[i].w;
    }
    ss = wave_sum(ss);
    const float rstd = rsqrtf(ss * (1.0f / D) + EPS);
    const float* mp = mod + ((size_t)l * NMOD + mod_row(row)) * 3072;
#pragma unroll
    for (int i = 0; i < 4; ++i) {
      const int c = (lane + 64 * i) * 4;
      const float4 gg = *(const float4*)(g + c), sh = *(const float4*)(mp + c), sc = *(const float4*)(mp + 1024 + c);
      uint2 o;
      o.x = pack2(v[i].x * rstd * gg.x * (1.f + sc.x) + sh.x, v[i].y * rstd * gg.y * (1.f + sc.y) + sh.y);
      o.y = pack2(v[i].z * rstd * gg.z * (1.f + sc.z) + sh.z, v[i].w * rstd * gg.w * (1.f + sc.w) + sh.w);
      *(uint2*)(hbuf + (size_t)row * D + c) = o;
      int p8 = __builtin_amdgcn_cvt_pk_fp8_f32(v[i].x * rstd * gg.x * (1.f + sc.x) + sh.x, v[i].y * rstd * gg.y * (1.f + sc.y) + sh.y, 0, false);
      p8 = __builtin_amdgcn_cvt_pk_fp8_f32(v[i].z * rstd * gg.z * (1.f + sc.z) + sh.z, v[i].w * rstd * gg.w * (1.f + sc.w) + sh.w, p8, true);
      *(int*)(h8 + (size_t)row * D + c) = p8;
    }
  }
}

__device__ __forceinline__ void phase_gemm_in(const Params& p, int l, int col0, int ntn, int ldz, unsigned char* smem) {
  bf16* sm = (bf16*)smem;
  const bf16* hbuf = (const bf16*)(p.ws + WS_H);
  const bf16* W = (const bf16*)(p.ws + WS_WIN) + (size_t)l * NWIN * 1024;
  bf16* z = (bf16*)(p.ws + WS_Z);
  const float* bias = p.b_in + (size_t)l * ZIN;
  const int tid = tidx(), lane = tid & 63, wave = tid >> 6, wr = wave >> 1, wc = wave & 1;
  const int ntiles = (TT / 128) * ntn;
  constexpr int OLD = 136;
  const bool isAB = (col0 == 0);
  const int nb = isAB ? 6 : 13;
  const int NB = (TT / 128) * nb;
  for (int t = blockIdx.x; t < ntiles; t += gridDim.x) {
    const bool f8 = t >= NB;
    int pm, pk;
    tile_map(f8 ? t - NB : t, f8 ? ntn - nb : nb, pm, pk);
    int pn;
    if (isAB) pn = f8 ? (pk < 4 ? pk : pk < 12 ? pk + 4 : pk + 6) : (pk < 4 ? 4 + pk : 12 + pk);
    else pn = f8 ? 13 + pk : pk;
    const int m0 = pm * 128, n0 = pn * 128;
    f32x4 acc[4][4];
    zero_acc<4>(acc);
    float osc = 1.0f;
    if (f8) {
      gemm_accum_f8<4>(acc, p.ws + WS_H8 + (size_t)m0 * 1024, p.ws + WS_W8 + ((size_t)l * W8_ROWS + col0 + n0) * 1024, sm);
      osc = 0.015625f;
    } else {
      gemm_accum<4>(acc, hbuf + (size_t)m0 * 1024, 1024, W + (size_t)(col0 + n0) * 1024, 1024, 1024, sm);
    }
#pragma unroll
    for (int j = 0; j < 4; ++j) {
      const int cl = wc * 64 + j * 16 + (lane >> 4) * 4;
      const float4 b = *(const float4*)(bias + col0 + n0 + cl);
#pragma unroll
      for (int i = 0; i < 4; ++i) {
        const int rl = wr * 64 + i * 16 + (lane & 15);
        uint2 o;
        o.x = pack2(acc[i][j][0] * osc + b.x, acc[i][j][1] * osc + b.y);
        o.y = pack2(acc[i][j][2] * osc + b.z, acc[i][j][3] * osc + b.w);
        *(uint2*)(sm + rl * OLD + cl) = o;
      }
    }
    __syncthreads();
#pragma unroll
    for (int it = 0; it < 8; ++it) {
      const int id = tid + 256 * it, row = id >> 4, ch = id & 15;
      const u32x4 v = *(const u32x4*)(sm + row * OLD + ch * 8);
      *(u32x4*)(z + (size_t)(m0 + row) * ldz + n0 + ch * 8) = v;
    }
    __syncthreads();
  }
}

__device__ __forceinline__ void gmlp_prompt_item(const Params& p, int l, int item, unsigned char* smem) {
  const int b = item >> 7, n = (item >> 2) & 31, g = item & 3;
  const int r0 = b * SEQ + n * 128;
  const bf16* z = (const bf16*)(p.ws + WS_Z);
  bf16* yab = (bf16*)(p.ws + WS_YAB);
  bf16* sW = (bf16*)smem;
  bf16* sV = (bf16*)(smem + 34816);
  float* srstd = (float*)(smem + 69632);
  const int tid = tidx(), lane = tid & 63, wave = tid >> 6, wr = wave >> 1, wc = wave & 1;
  {
    const int tok = tid >> 1, half = tid & 1;
    const uint4* ptr = (const uint4*)(z + (size_t)(r0 + tok) * ZAB + OFF_AV + half * 256);
    float ss = 0.f;
    for (int i = 0; i < 32; ++i) {
      float f[8];
      unpack8(ptr[i], f);
#pragma unroll
      for (int j = 0; j < 8; ++j) ss += f[j] * f[j];
    }
    ss += __shfl_xor(ss, 1);
    if (half == 0) srstd[tok] = rsqrtf(ss * (1.0f / 512.f) + EPS);
  }
  __syncthreads();
  const float* vg = p.vnorm_g + l * 512 + g * 128;
  for (int i = tid; i < 2048; i += 256) {
    const int s = i >> 4, c8 = (i & 15) * 8;
    float f[8];
    unpack8(*(const uint4*)(z + (size_t)(r0 + s) * ZAB + OFF_AV + g * 128 + c8), f);
    const float rs = srstd[s];
#pragma unroll
    for (int j = 0; j < 8; ++j) sV[(c8 + j) * 136 + s] = f2bf(f[j] * rs * vg[c8 + j]);
  }
  const float* Wg = p.gmlp_ws + ((size_t)(l * 4 + g)) * 128 * 128;
  for (int i = tid; i < 4096; i += 256) {
    const int t = i >> 5, s4 = (i & 31) * 4;
    const float4 w = *(const float4*)(Wg + t * 128 + s4);
    uint2 o;
    o.x = pack2(s4 + 0 <= t ? w.x : 0.f, s4 + 1 <= t ? w.y : 0.f);
    o.y = pack2(s4 + 2 <= t ? w.z : 0.f, s4 + 3 <= t ? w.w : 0.f);
    *(uint2*)(sW + t * 136 + s4) = o;
  }
  __syncthreads();
  f32x4 acc[4][4];
  zero_acc<4>(acc);
  mma_lds<4, 4>(acc, sW + wr * 64 * 136, 136, sV + wc * 64 * 136, 136, wr * 64 + 64, lane);
  const float* bs = p.gmlp_bs + (l * 4 + g) * 128;
#pragma unroll
  for (int i = 0; i < 4; ++i) {
    const int t = wr * 64 + i * 16 + (lane & 15);
    const float bst = bs[t];
    const size_t rowoff = (size_t)(r0 + t) * ZAB;
#pragma unroll
    for (int j = 0; j < 4; ++j) {
      const int c = g * 128 + wc * 64 + j * 16 + (lane >> 4) * 4;
      float u[4], ag[4];
      unpack4(*(const uint2*)(z + rowoff + c), u);
      unpack4(*(const uint2*)(z + rowoff + OFF_AG + c), ag);
      uint2 o;
      o.x = pack2(u[0] * (acc[i][j][0] + bst) * siluf_(ag[0]), u[1] * (acc[i][j][1] + bst) * siluf_(ag[1]));
      o.y = pack2(u[2] * (acc[i][j][2] + bst) * siluf_(ag[2]), u[3] * (acc[i][j][3] + bst) * siluf_(ag[3]));
      *(uint2*)(yab + (size_t)(r0 + t) * 1024 + c) = o;
    }
  }
  __syncthreads();
}

__device__ __forceinline__ void gmlp_sample_item(const Params& p, int l, int b, unsigned char* smem) {
  const int r0 = TP + b * 8;
  const bf16* z = (const bf16*)(p.ws + WS_Z);
  bf16* yab = (bf16*)(p.ws + WS_YAB);
  float* svn = (float*)smem;
  const int tid = tidx(), lane = tid & 63, wave = tid >> 6;
  const float* vg = p.vnorm_g + l * 512;
  for (int tt = 0; tt < 2; ++tt) {
    const int t = wave * 2 + tt;
    float f[8];
    unpack8(*(const uint4*)(z + (size_t)(r0 + t) * ZAB + OFF_AV + lane * 8), f);
    float ss = 0.f;
#pragma unroll
    for (int j = 0; j < 8; ++j) ss += f[j] * f[j];
    ss = wave_sum(ss);
    const float rstd = rsqrtf(ss * (1.0f / 512.f) + EPS);
    float* gv = p.out + O_GV + (((size_t)l * 128 + b) * 8 + t) * 512 + lane * 8;
#pragma unroll
    for (int j = 0; j < 8; ++j) {
      const float vn = f[j] * rstd * vg[lane * 8 + j];
      svn[t * 512 + lane * 8 + j] = vn;
      gv[j] = vn;
    }
  }
  __syncthreads();
  {
    const int c = tid * 2, g = c >> 7;
    const float* Wg = p.gmlp_ws + ((size_t)(l * 4 + g)) * 128 * 128;
    const float* bs = p.gmlp_bs + (l * 4 + g) * 128;
    for (int t = 0; t < 8; ++t) {
      float s0 = bs[t], s1 = bs[t];
      for (int s = 0; s <= t; ++s) {
        const float w = Wg[t * 128 + s];
        s0 += w * svn[s * 512 + c];
        s1 += w * svn[s * 512 + c + 1];
      }
      const unsigned uu = *(const unsigned*)(z + (size_t)(r0 + t) * ZAB + c);
      const unsigned gg = *(const unsigned*)(z + (size_t)(r0 + t) * ZAB + OFF_AG + c);
      *(unsigned*)(yab + (size_t)(r0 + t) * 1024 + c) = pack2(lo2f(uu) * s0 * siluf_(lo2f(gg)), hi2f(uu) * s1 * siluf_(hi2f(gg)));
    }
  }
  __syncthreads();
}

__device__ __forceinline__ void swa_prompt_item(const Params& p, int l, int item, unsigned char* smem) {
  const int b = item >> 7, qt = (item >> 1) & 63, kv = item & 1;
  const int q0 = qt * 64, rb = b * SEQ;
  const bf16* z = (const bf16*)(p.ws + WS_Z);
  bf16* yab = (bf16*)(p.ws + WS_YAB);
  bf16* sK = (bf16*)smem;
  bf16* sVT = (bf16*)(smem + 27648);
  const int tid = tidx(), lane = tid & 63, wave = tid >> 6;
  const float* kg = p.kn_g + l * 64;
  const float* qg = p.qn_g + l * 64;
#pragma unroll 1
  for (int it = 0; it < 6; ++it) {
    const int id = tid + 256 * it, kk = id >> 3, ch = id & 7, kp = q0 - 128 + kk;
    float f[8];
    uint4 vraw = make_uint4(0, 0, 0, 0);
    if (kp >= 0) {
      unpack8(*(const uint4*)(z + (size_t)(rb + kp) * ZAB + OFF_BK + kv * 64 + ch * 8), f);
      vraw = *(const uint4*)(z + (size_t)(rb + kp) * ZAB + OFF_BV + kv * 64 + ch * 8);
    } else {
#pragma unroll
      for (int j = 0; j < 8; ++j) f[j] = 0.f;
    }
    float ss = 0.f;
#pragma unroll
    for (int j = 0; j < 8; ++j) ss += f[j] * f[j];
    ss += __shfl_xor(ss, 1); ss += __shfl_xor(ss, 2); ss += __shfl_xor(ss, 4);
    const float rstd = rsqrtf(ss * (1.0f / 64.f) + EPS);
#pragma unroll
    for (int j = 0; j < 8; ++j) f[j] = f[j] * rstd * kg[ch * 8 + j];
    uint4 ko;
    ko.x = pack2(f[0], f[1]); ko.y = pack2(f[2], f[3]); ko.z = pack2(f[4], f[5]); ko.w = pack2(f[6], f[7]);
    *(uint4*)(sK + kk * 72 + ch * 8) = ko;
    float vf[8];
    unpack8(vraw, vf);
#pragma unroll
    for (int j = 0; j < 8; ++j) sVT[(ch * 8 + j) * 200 + kk] = f2bf(vf[j]);
    if (kk >= 128 && kp >= SEQ - 128) {
      const size_t o = ((((size_t)l * 4 + b) * 128 + (kp - (SEQ - 128))) * 2 + kv) * 64 + ch * 8;
#pragma unroll
      for (int j = 0; j < 8; ++j) { p.out[O_SKP + o + j] = f[j]; p.out[O_SVP + o + j] = vf[j]; }
    }
  }
  __syncthreads();
  const int h = kv * 4 + wave;
  const float sink = p.sinks[l * 8 + h];
  const int g4 = lane >> 4, r16 = lane & 15;
#pragma unroll 1
  for (int i = 0; i < 4; ++i) {
    const int qrow = q0 + i * 16 + r16;
    const size_t grow = (size_t)(rb + qrow);
    bf16x8 qf[2];
    {
      float f0[8], f1[8];
      unpack8(*(const uint4*)(z + grow * ZAB + OFF_BQ + h * 64 + g4 * 8), f0);
      unpack8(*(const uint4*)(z + grow * ZAB + OFF_BQ + h * 64 + 32 + g4 * 8), f1);
      float ss = 0.f;
#pragma unroll
      for (int j = 0; j < 8; ++j) ss += f0[j] * f0[j] + f1[j] * f1[j];
      ss += __shfl_xor(ss, 16); ss += __shfl_xor(ss, 32);
      const float rstd = rsqrtf(ss * (1.0f / 64.f) + EPS) * 0.125f;
#pragma unroll
      for (int j = 0; j < 8; ++j) {
        qf[0][j] = (short)f2bf(f0[j] * rstd * qg[g4 * 8 + j]);
        qf[1][j] = (short)f2bf(f1[j] * rstd * qg[32 + g4 * 8 + j]);
      }
    }
    f32x4 st[12];
#pragma unroll
    for (int kt = 0; kt < 12; ++kt) {
      st[kt] = (f32x4){0.f, 0.f, 0.f, 0.f};
#pragma unroll
      for (int ks = 0; ks < 2; ++ks) {
        const bf16x8 kf = *(const bf16x8*)(sK + (kt * 16 + r16) * 72 + ks * 32 + g4 * 8);
        st[kt] = mfma16(kf, qf[ks], st[kt]);
      }
      if ((kt & 1) == 1) __builtin_amdgcn_sched_barrier(0);
    }
    float mx = -INFINITY;
#pragma unroll
    for (int kt = 0; kt < 12; ++kt)
#pragma unroll
      for (int x = 0; x < 4; ++x) {
        const int kp = q0 - 128 + kt * 16 + g4 * 4 + x, diff = qrow - kp;
        const bool valid = (kp >= 0) && (diff >= 0) && (diff < 128);
        st[kt][x] = valid ? st[kt][x] : -INFINITY;
        mx = fmaxf(mx, st[kt][x]);
      }
    mx = fmaxf(mx, __shfl_xor(mx, 16)); mx = fmaxf(mx, __shfl_xor(mx, 32));
    mx = fmaxf(mx, sink);
    float sum = 0.f;
#pragma unroll
    for (int kt = 0; kt < 12; ++kt)
#pragma unroll
      for (int x = 0; x < 4; ++x) {
        const float pv = __expf(st[kt][x] - mx);
        st[kt][x] = pv;
        sum += pv;
      }
    sum += __shfl_xor(sum, 16); sum += __shfl_xor(sum, 32);
    const float inv = 1.0f / (sum + __expf(sink - mx));
    f32x4 o[4];
#pragma unroll
    for (int dt = 0; dt < 4; ++dt) o[dt] = (f32x4){0.f, 0.f, 0.f, 0.f};
#pragma unroll
    for (int t2 = 0; t2 < 6; ++t2) {
      bf16x8 pf;
#pragma unroll
      for (int x = 0; x < 4; ++x) { pf[x] = (short)f2bf(st[2 * t2][x]); pf[4 + x] = (short)f2bf(st[2 * t2 + 1][x]); }
#pragma unroll
      for (int dt = 0; dt < 4; ++dt) {
        const uint2 v0 = *(const uint2*)(sVT + (dt * 16 + r16) * 200 + t2 * 32 + g4 * 4);
        const uint2 v1 = *(const uint2*)(sVT + (dt * 16 + r16) * 200 + t2 * 32 + 16 + g4 * 4);
        union { uint4 u; bf16x8 v; } cv;
        cv.u = make_uint4(v0.x, v0.y, v1.x, v1.y);
        o[dt] = mfma16(cv.v, pf, o[dt]);
      }
      __builtin_amdgcn_sched_barrier(0);
    }
#pragma unroll
    for (int dt = 0; dt < 4; ++dt) {
      const int d0 = dt * 16 + g4 * 4;
      float bg[4];
      unpack4(*(const uint2*)(z + grow * ZAB + OFF_BG + h * 64 + d0), bg);
      uint2 oo;
      oo.x = pack2(o[dt][0] * inv * siluf_(bg[0]), o[dt][1] * inv * siluf_(bg[1]));
      oo.y = pack2(o[dt][2] * inv * siluf_(bg[2]), o[dt][3] * inv * siluf_(bg[3]));
      *(uint2*)(yab + grow * 1024 + 512 + h * 64 + d0) = oo;
    }
  }
  __syncthreads();
}

__device__ __forceinline__ void swa_sample_item(const Params& p, int l, int item, unsigned char* smem) {
  const int b = item >> 1, kv = item & 1;
  const int r0 = TP + b * 8;
  const bf16* z = (const bf16*)(p.ws + WS_Z);
  bf16* yab = (bf16*)(p.ws + WS_YAB);
  bf16* sK = (bf16*)smem;
  bf16* sV = (bf16*)(smem + 19584);
  float* sq = (float*)(smem + 39168);
  float* sP = (float*)(smem + 47488);
  const int tid = tidx();
  const float* kg = p.kn_g + l * 64;
  const float* qg = p.qn_g + l * 64;
  const float* ck = p.cache_k + ((size_t)l * 128 + b) * 128 * 128;
  const float* cvp = p.cache_v + ((size_t)l * 128 + b) * 128 * 128;
#pragma unroll 1
  for (int it = 0; it < 5; ++it) {
    const int id = tid + 256 * it, j = id >> 3, ch = id & 7;
    const bool act = id < 1088;
    float kf[8], vf[8];
#pragma unroll
    for (int x = 0; x < 8; ++x) { kf[x] = 0.f; vf[x] = 0.f; }
    if (act) {
      if (j < 128) {
        const float4 a0 = *(const float4*)(ck + (j * 2 + kv) * 64 + ch * 8), a1 = *(const float4*)(ck + (j * 2 + kv) * 64 + ch * 8 + 4);
        const float4 b0 = *(const float4*)(cvp + (j * 2 + kv) * 64 + ch * 8), b1 = *(const float4*)(cvp + (j * 2 + kv) * 64 + ch * 8 + 4);
        kf[0] = a0.x; kf[1] = a0.y; kf[2] = a0.z; kf[3] = a0.w; kf[4] = a1.x; kf[5] = a1.y; kf[6] = a1.z; kf[7] = a1.w;
        vf[0] = b0.x; vf[1] = b0.y; vf[2] = b0.z; vf[3] = b0.w; vf[4] = b1.x; vf[5] = b1.y; vf[6] = b1.z; vf[7] = b1.w;
      } else {
        unpack8(*(const uint4*)(z + (size_t)(r0 + j - 128) * ZAB + OFF_BK + kv * 64 + ch * 8), kf);
        unpack8(*(const uint4*)(z + (size_t)(r0 + j - 128) * ZAB + OFF_BV + kv * 64 + ch * 8), vf);
      }
    }
    float ss = 0.f;
#pragma unroll
    for (int x = 0; x < 8; ++x) ss += kf[x] * kf[x];
    ss += __shfl_xor(ss, 1); ss += __shfl_xor(ss, 2); ss += __shfl_xor(ss, 4);
    if (act) {
      if (j >= 128) {
        const float rstd = rsqrtf(ss * (1.0f / 64.f) + EPS);
#pragma unroll
        for (int x = 0; x < 8; ++x) kf[x] = kf[x] * rstd * kg[ch * 8 + x];
      }
      uint4 ko, vo;
      ko.x = pack2(kf[0], kf[1]); ko.y = pack2(kf[2], kf[3]); ko.z = pack2(kf[4], kf[5]); ko.w = pack2(kf[6], kf[7]);
      vo.x = pack2(vf[0], vf[1]); vo.y = pack2(vf[2], vf[3]); vo.z = pack2(vf[4], vf[5]); vo.w = pack2(vf[6], vf[7]);
      *(uint4*)(sK + j * 72 + ch * 8) = ko;
      *(uint4*)(sV + j * 72 + ch * 8) = vo;
      if (j >= 8) {
        const size_t o = ((((size_t)l * 128 + b) * 128 + (j - 8)) * 2 + kv) * 64 + ch * 8;
        *(float4*)(p.out + O_SKS + o) = make_float4(kf[0], kf[1], kf[2], kf[3]);
        *(float4*)(p.out + O_SKS + o + 4) = make_float4(kf[4], kf[5], kf[6], kf[7]);
        *(float4*)(p.out + O_SVS + o) = make_float4(vf[0], vf[1], vf[2], vf[3]);
        *(float4*)(p.out + O_SVS + o + 4) = make_float4(vf[4], vf[5], vf[6], vf[7]);
      }
    }
  }
  const int qi = tid >> 3, sub = tid & 7, t = qi >> 2, h = kv * 4 + (qi & 3);
  {
    float f[8];
    unpack8(*(const uint4*)(z + (size_t)(r0 + t) * ZAB + OFF_BQ + h * 64 + sub * 8), f);
    float ss = 0.f;
#pragma unroll
    for (int x = 0; x < 8; ++x) ss += f[x] * f[x];
    ss += __shfl_xor(ss, 1); ss += __shfl_xor(ss, 2); ss += __shfl_xor(ss, 4);
    const float rstd = rsqrtf(ss * (1.0f / 64.f) + EPS) * 0.125f;
#pragma unroll
    for (int x = 0; x < 8; ++x) sq[qi * 65 + sub * 8 + x] = f[x] * rstd * qg[sub * 8 + x];
  }
  __syncthreads();
  const float sink = p.sinks[l * 8 + h];
  float mx = -INFINITY;
#pragma unroll 1
  for (int jj = 0; jj < 17; ++jj) {
    const int key = sub + 8 * jj;
    float s = 0.f;
#pragma unroll 8
    for (int d = 0; d < 64; ++d) s += sq[qi * 65 + d] * bf2f(sK[key * 72 + d]);
    const bool valid = (key >= t + 1) && (key <= t + 128);
    s = valid ? s : -INFINITY;
    sP[qi * 140 + key] = s;
    mx = fmaxf(mx, s);
  }
  mx = fmaxf(mx, __shfl_xor(mx, 1)); mx = fmaxf(mx, __shfl_xor(mx, 2)); mx = fmaxf(mx, __shfl_xor(mx, 4));
  mx = fmaxf(mx, sink);
  float sum = 0.f;
  for (int jj = 0; jj < 17; ++jj) {
    const int key = sub + 8 * jj;
    const float pv = __expf(sP[qi * 140 + key] - mx);
    sP[qi * 140 + key] = pv;
    sum += pv;
  }
  sum += __shfl_xor(sum, 1); sum += __shfl_xor(sum, 2); sum += __shfl_xor(sum, 4);
  const float inv = 1.0f / (sum + __expf(sink - mx));
  __syncthreads();
  {
    float o[8];
#pragma unroll
    for (int x = 0; x < 8; ++x) o[x] = 0.f;
#pragma unroll 2
    for (int key = 0; key < 136; ++key) {
      const float pv = sP[qi * 140 + key];
      float vf[8];
      unpack8(*(const uint4*)(sV + key * 72 + sub * 8), vf);
#pragma unroll
      for (int x = 0; x < 8; ++x) o[x] += pv * vf[x];
    }
    float bg[8];
    unpack8(*(const uint4*)(z + (size_t)(r0 + t) * ZAB + OFF_BG + h * 64 + sub * 8), bg);
    uint4 oo;
    oo.x = pack2(o[0] * inv * siluf_(bg[0]), o[1] * inv * siluf_(bg[1]));
    oo.y = pack2(o[2] * inv * siluf_(bg[2]), o[3] * inv * siluf_(bg[3]));
    oo.z = pack2(o[4] * inv * siluf_(bg[4]), o[5] * inv * siluf_(bg[5]));
    oo.w = pack2(o[6] * inv * siluf_(bg[6]), o[7] * inv * siluf_(bg[7]));
    *(uint4*)(yab + (size_t)(r0 + t) * 1024 + 512 + h * 64 + sub * 8) = oo;
  }
  __syncthreads();
}

__device__ __forceinline__ void phase_mix_ab(const Params& p, int l, unsigned char* smem) {
  constexpr int N_SWA = 512, N_GM = 512, N_SWS = 256, N_GMS = 128;
  constexpr int N_ALL = N_SWA + N_GM + N_SWS + N_GMS;
  for (int it = blockIdx.x; it < N_ALL; it += gridDim.x) {
    int i = it;
    if (i < N_SWA) { swa_prompt_item(p, l, i, smem); continue; }
    i -= N_SWA;
    if (i < N_GM) { gmlp_prompt_item(p, l, i, smem); continue; }
    i -= N_GM;
    if (i < N_SWS) { swa_sample_item(p, l, i, smem); continue; }
    i -= N_SWS;
    gmlp_sample_item(p, l, i, smem);
  }
}

__device__ __forceinline__ void conv8_prompt(const Params& p, int l, const bf16* z, int r0, int pos0, int s, int zc, float* y) {
  const float* cw = p.conv_w + (size_t)l * 4 * 1024 + zc;
  const float* cb = p.conv_b + l * 1024 + zc;
#pragma unroll
  for (int j = 0; j < 8; ++j) y[j] = cb[j];
#pragma unroll
  for (int tap = 0; tap < 4; ++tap) {
    const int back = 3 - tap;
    if (pos0 + s - back >= 0) {
      float f[8];
      unpack8(*(const uint4*)(z + (size_t)(r0 + s - back) * ZC + C_QK + zc), f);
#pragma unroll
      for (int j = 0; j < 8; ++j) y[j] += cw[tap * 1024 + j] * f[j];
    }
  }
#pragma unroll
  for (int j = 0; j < 8; ++j) y[j] = siluf_(y[j]);
}

__device__ __forceinline__ void chunk_gates(const Params& p, int l, const bf16* z, int r0, int hh, int lane, float& cum, float& iv) {
  const float f = bf2f(z[(size_t)(r0 + lane) * ZC + C_F + hh]) + p.f_bias[l * 4 + hh];
  iv = bf2f(z[(size_t)(r0 + lane) * ZC + C_I + hh]);
  float c = logsigmoidf_(f);
#pragma unroll
  for (int o = 1; o < 64; o <<= 1) {
    const float n = __shfl_up(c, o);
    if (lane >= o) c += n;
  }
  cum = c;
}

__device__ __forceinline__ void mlstm_local_item(const Params& p, int l, int item, unsigned char* smem) {
  const int bh = item >> 6, c = item & 63, b = bh >> 2, hh = bh & 3;
  const int r0 = b * SEQ + c * 64;
  const bf16* z = (const bf16*)(p.ws + WS_Z);
  bf16* skT = (bf16*)smem;
  bf16* svT = (bf16*)(smem + 18432);
  float* swsel = (float*)(smem + 36864);
  const int tid = tidx(), lane = tid & 63, wave = tid >> 6, wr = wave >> 1, wc = wave & 1;
  if (wave == 0) {
    float cum, iv;
    chunk_gates(p, l, z, r0, hh, lane, cum, iv);
    const float total = __shfl(cum, 63);
    const float g = total - cum + iv;
    const float G = wave_max(g);
    swsel[lane] = __expf(g - G);
    if (lane == 0) {
      ((float*)(p.ws + WS_G))[item] = G;
      ((float*)(p.ws + WS_TOT))[item] = total;
    }
  }
  __syncthreads();
  for (int i = tid; i < 1024; i += 256) {
    const int s = i >> 4, d8 = (i & 15) * 8;
    float y[8];
    conv8_prompt(p, l, z, r0, c * 64, s, 512 + hh * 128 + d8, y);
    {
      uint4 ko;
      ko.x = pack2(y[0] * 0.08838834764831845f, y[1] * 0.08838834764831845f); ko.y = pack2(y[2] * 0.08838834764831845f, y[3] * 0.08838834764831845f);
      ko.z = pack2(y[4] * 0.08838834764831845f, y[5] * 0.08838834764831845f); ko.w = pack2(y[6] * 0.08838834764831845f, y[7] * 0.08838834764831845f);
      *(uint4*)((bf16*)(p.ws + WS_H) + (size_t)(r0 + s) * 512 + hh * 128 + d8) = ko;
    }
    const float sc = 0.08838834764831845f * swsel[s];
#pragma unroll
    for (int j = 0; j < 8; ++j) skT[(d8 + j) * 72 + s] = f2bf(y[j] * sc);
    float v[8];
    unpack8(*(const uint4*)(z + (size_t)(r0 + s) * ZC + C_V + hh * 128 + d8), v);
#pragma unroll
    for (int j = 0; j < 8; ++j) svT[(d8 + j) * 72 + s] = f2bf(v[j]);
  }
  __syncthreads();
  f32x4 acc[4][4];
  zero_acc<4>(acc);
  mma_lds<4, 4>(acc, svT + wr * 64 * 72, 72, skT + wc * 64 * 72, 72, 64, lane);
  bf16* U = (bf16*)(p.ws + WS_U) + (size_t)item * 16384;
#pragma unroll
  for (int i = 0; i < 4; ++i)
#pragma unroll
    for (int j = 0; j < 4; ++j) {
      const int e = wr * 64 + i * 16 + (lane & 15), d = wc * 64 + j * 16 + (lane >> 4) * 4;
      uint2 o;
      o.x = pack2(acc[i][j][0], acc[i][j][1]);
      o.y = pack2(acc[i][j][2], acc[i][j][3]);
      *(uint2*)(U + e * 128 + d) = o;
    }
  if (tid < 128) {
    float s = 0.f;
    for (int k = 0; k < 64; ++k) s += bf2f(skT[tid * 72 + k]);
    ((float*)(p.ws + WS_UN))[(size_t)item * 128 + tid] = s;
  }
  __syncthreads();
}

__device__ __forceinline__ void mlstm_convout_item(const Params& p, int l, int b) {
  const bf16* z = (const bf16*)(p.ws + WS_Z);
  for (int i = tidx(); i < 3 * 1024; i += 256) {
    const int j = i >> 10, ch = i & 1023;
    p.out[O_CVP + (((size_t)l * 4 + b) * 3 + j) * 1024 + ch] = bf2f(z[(size_t)(b * SEQ + SEQ - 3 + j) * ZC + C_QK + ch]);
  }
}

__device__ __forceinline__ void mlstm_sample_item(const Params& p, int l, int item, unsigned char* smem) {
  const int b = item >> 2, hh = item & 3;
  const int r0 = TP + b * 8;
  bf16* z = (bf16*)(p.ws + WS_Z);
  float* sq = (float*)smem;
  float* sk = sq + 1024;
  float* sv = sk + 1024;
  float* sh = sv + 1024;
  float* sint = sh + 1024;
  float* sa = sint + 2048;
  float* sqn = sa + 64;
  float* smt = sqn + 8;
  float* swi = smt + 8;
  float* swsel = swi + 8;
  float* sdm = swsel + 8;
  float* sdecay = sdm + 64;
  const int tid = tidx(), lane = tid & 63, wave = tid >> 6;
  {
    const int isk = tid >> 7, d = tid & 127, zc = isk * 512 + hh * 128 + d;
    const float* cw = p.conv_w + (size_t)l * 4 * 1024 + zc;
    const float cb = p.conv_b[l * 1024 + zc];
    float xp[11];
    const float* cs = p.st_conv + ((size_t)l * 128 + b) * 3 * 1024 + zc;
    xp[0] = cs[0]; xp[1] = cs[1024]; xp[2] = cs[2048];
#pragma unroll
    for (int t = 0; t < 8; ++t) xp[3 + t] = bf2f(z[(size_t)(r0 + t) * ZC + C_QK + zc]);
    const float w0 = cw[0], w1 = cw[1024], w2 = cw[2048], w3 = cw[3072];
    float* dst = isk ? sk : sq;
    const float sc = isk ? 0.08838834764831845f : 1.0f;
#pragma unroll
    for (int t = 0; t < 8; ++t) {
      const float y = cb + w0 * xp[t] + w1 * xp[t + 1] + w2 * xp[t + 2] + w3 * xp[t + 3];
      dst[t * 128 + d] = siluf_(y) * sc;
    }
    float* co = p.out + O_CVS + ((size_t)l * 128 + b) * 3 * 1024 + zc;
    co[0] = xp[8]; co[1024] = xp[9]; co[2048] = xp[10];
  }
  for (int i = tid; i < 1024; i += 256) {
    const int t = i >> 7, e = i & 127;
    sv[i] = bf2f(z[(size_t)(r0 + t) * ZC + C_V + hh * 128 + e]);
  }
  if (tid == 0) {
    float cum[8], iv[8];
    float c = 0.f;
    for (int t = 0; t < 8; ++t) {
      const float f = bf2f(z[(size_t)(r0 + t) * ZC + C_F + hh]) + p.f_bias[l * 4 + hh];
      c += logsigmoidf_(f);
      cum[t] = c;
      iv[t] = bf2f(z[(size_t)(r0 + t) * ZC + C_I + hh]);
    }
    const float m0 = p.st_m[(l * 128 + b) * 4 + hh];
    for (int t = 0; t < 8; ++t) {
      float dmax = -INFINITY;
      for (int s = 0; s <= t; ++s) dmax = fmaxf(dmax, cum[t] - cum[s] + iv[s]);
      const float mi = cum[t] + m0, mt = fmaxf(mi, dmax);
      smt[t] = mt;
      swi[t] = __expf(mi - mt);
      for (int s = 0; s < 8; ++s) sdm[t * 8 + s] = (s <= t) ? __expf(cum[t] - cum[s] + iv[s] - mt) : 0.f;
    }
    const float total = cum[7];
    float gm = -INFINITY;
    for (int s = 0; s < 8; ++s) gm = fmaxf(gm, total - cum[s] + iv[s]);
    const float mn = fmaxf(total + m0, gm);
    for (int s = 0; s < 8; ++s) swsel[s] = __expf(total - cum[s] + iv[s] - mn);
    sdecay[0] = __expf(total + m0 - mn);
    p.out[O_MS + (l * 128 + b) * 4 + hh] = mn;
  }
  __syncthreads();
  const float* n0 = p.st_n + (((size_t)l * 128 + b) * 4 + hh) * 128;
  if (tid < 64) {
    const int t = tid >> 3, s = tid & 7;
    float dsum = 0.f;
    for (int d = 0; d < 128; ++d) dsum += sq[t * 128 + d] * sk[s * 128 + d];
    sa[t * 8 + s] = sdm[t * 8 + s] * dsum;
  } else if (tid < 128) {
    const int t = (tid - 64) >> 3, part = (tid - 64) & 7;
    float dsum = 0.f;
    for (int d = part * 16; d < part * 16 + 16; ++d) dsum += sq[t * 128 + d] * n0[d];
    dsum += __shfl_xor(dsum, 1); dsum += __shfl_xor(dsum, 2); dsum += __shfl_xor(dsum, 4);
    if (part == 0) sqn[t] = dsum;
  }
  __syncthreads();
  {
    const int e = tid & 127, dh = tid >> 7;
    const float decay = sdecay[0];
    const float* C0 = p.st_C + (((size_t)l * 128 + b) * 4 + hh) * 16384;
    float* C1 = p.out + O_CS + (((size_t)l * 128 + b) * 4 + hh) * 16384;
    float vw[8], inter[8];
#pragma unroll
    for (int s = 0; s < 8; ++s) { vw[s] = sv[s * 128 + e] * swsel[s]; inter[s] = 0.f; }
    for (int d = dh * 64; d < dh * 64 + 64; ++d) {
      const float c0 = C0[d * 128 + e];
      float upd = decay * c0;
#pragma unroll
      for (int s = 0; s < 8; ++s) {
        upd += sk[s * 128 + d] * vw[s];
        inter[s] += sq[s * 128 + d] * c0;
      }
      C1[d * 128 + e] = upd;
    }
#pragma unroll
    for (int t = 0; t < 8; ++t) sint[(dh * 8 + t) * 128 + e] = inter[t];
  }
  __syncthreads();
  if (tid < 128) {
    const int e = tid;
    for (int t = 0; t < 8; ++t) {
      float num = swi[t] * (sint[t * 128 + e] + sint[(8 + t) * 128 + e]);
      float den = swi[t] * sqn[t];
      for (int s = 0; s <= t; ++s) { num += sa[t * 8 + s] * sv[s * 128 + e]; den += sa[t * 8 + s]; }
      sh[t * 128 + e] = num / fmaxf(fabsf(den), __expf(-smt[t]));
    }
    float nn = sdecay[0] * n0[e];
    for (int s = 0; s < 8; ++s) nn += swsel[s] * sk[s * 128 + e];
    p.out[O_NS + (((size_t)l * 128 + b) * 4 + hh) * 128 + e] = nn;
  }
  __syncthreads();
  const float* hg = p.hnorm_g + l * 512 + hh * 128;
  for (int tt = 0; tt < 2; ++tt) {
    const int t = wave * 2 + tt;
    const float h0 = sh[t * 128 + lane], h1 = sh[t * 128 + 64 + lane];
    const float ss = wave_sum(h0 * h0 + h1 * h1);
    const float rstd = rsqrtf(ss * (1.0f / 128.f) + EPS);
    bf16* zr = z + (size_t)(r0 + t) * ZC;
#pragma unroll
    for (int k = 0; k < 2; ++k) {
      const int e = lane + 64 * k;
      const float hv = k ? h1 : h0;
      const float o = bf2f(zr[C_O + hh * 128 + e]), cg_ = bf2f(zr[C_G + hh * 128 + e]);
      zr[C_O + hh * 128 + e] = f2bf(hv * rstd * hg[e] * sigmoidf_(o) * siluf_(cg_));
    }
  }
  __syncthreads();
}

__device__ __forceinline__ void phase_mix1(const Params& p, int l, unsigned char* smem) {
  constexpr int N_LOC = 1024, N_SMP = 512, N_CV = 4;
  constexpr int N_ALL = N_LOC + N_SMP + N_CV;
  for (int it = blockIdx.x; it < N_ALL; it += gridDim.x) {
    int i = it;
    if (i < N_LOC) { mlstm_local_item(p, l, i, smem); continue; }
    i -= N_LOC;
    if (i < N_SMP) { mlstm_sample_item(p, l, i, smem); continue; }
    i -= N_SMP;
    mlstm_convout_item(p, l, i);
  }
}

__device__ __forceinline__ void phase_scan(const Params& p, int l, unsigned char* smem) {
  float* sdec = (float*)smem;
  float* ssc = sdec + 64;
  const int tid = tidx();
  float* Gb = (float*)(p.ws + WS_G);
  float* Tb = (float*)(p.ws + WS_TOT);
  float* Mb = (float*)(p.ws + WS_M);
  for (int it = blockIdx.x; it < 256; it += gridDim.x) {
    const int bh = it >> 4, slice = it & 15;
    if (tid < 64) { sdec[128 + tid] = Gb[bh * 64 + tid]; sdec[192 + tid] = Tb[bh * 64 + tid]; }
    __syncthreads();
    if (tid == 0) {
      float m = 0.f;
      for (int c = 0; c < 64; ++c) {
        const float G = sdec[128 + c], tot = sdec[192 + c];
        const float mn = fmaxf(tot + m, G);
        sdec[c] = __expf(tot + m - mn);
        ssc[c] = __expf(G - mn);
        if (slice == 0) Mb[bh * 64 + c] = m;
        m = mn;
      }
      if (slice == 0) p.out[O_MP + l * 16 + bh] = m;
    }
    __syncthreads();
    {
      const int idx = slice * 1024 + tid * 4;
      bf16* U = (bf16*)(p.ws + WS_U) + (size_t)bh * 64 * 16384 + idx;
      float st[4] = {0.f, 0.f, 0.f, 0.f};
#pragma unroll 8
      for (int c = 0; c < 64; ++c) {
        float u[4];
        unpack4(*(const uint2*)(U + (size_t)c * 16384), u);
        uint2 o;
        o.x = pack2(st[0], st[1]); o.y = pack2(st[2], st[3]);
        *(uint2*)(U + (size_t)c * 16384) = o;
        const float dc = sdec[c], sc = ssc[c];
#pragma unroll
        for (int x = 0; x < 4; ++x) st[x] = dc * st[x] + sc * u[x];
      }
      const int e = idx >> 7, d0 = idx & 127;
      float* Co = p.out + O_CP + ((size_t)l * 16 + bh) * 16384;
#pragma unroll
      for (int x = 0; x < 4; ++x) Co[(d0 + x) * 128 + e] = st[x];
    }
    if (slice == 0 && tid < 128) {
      float* un = (float*)(p.ws + WS_UN) + (size_t)bh * 64 * 128 + tid;
      float n = 0.f;
#pragma unroll 8
      for (int c = 0; c < 64; ++c) {
        const float u = un[c * 128];
        un[c * 128] = n;
        n = sdec[c] * n + ssc[c] * u;
      }
      p.out[O_NP + ((size_t)l * 16 + bh) * 128 + tid] = n;
    }
    __syncthreads();
  }
}

__device__ __forceinline__ void mlstm_out_item(const Params& p, int l, int item, unsigned char* smem) {
  const int bh = item >> 6, c = item & 63, b = bh >> 2, hh = bh & 3;
  const int r0 = b * SEQ + c * 64;
  bf16* z = (bf16*)(p.ws + WS_Z);
  bf16* sq = (bf16*)smem;
  bf16* sk = (bf16*)(smem + 17408);
  bf16* svT = (bf16*)(smem + 34816);
  bf16* sa = (bf16*)(smem + 53248);
  float* scum = (float*)(smem + 62464);
  float* siv = scum + 64;
  float* smt = siv + 64;
  float* swi = smt + 64;
  float* sden = swi + 64;
  float* sqn = sden + 64;
  float* spart = sqn + 64;
  const int tid = tidx(), lane = tid & 63, wave = tid >> 6;
  const int r16 = lane & 15, g4 = lane >> 4;
  if (wave == 0) {
    float cum, iv;
    chunk_gates(p, l, z, r0, hh, lane, cum, iv);
    scum[lane] = cum;
    siv[lane] = iv;
  }
  for (int i = tid; i < 1024; i += 256) {
    const int s = i >> 4, d8 = (i & 15) * 8;
    *(uint4*)(sk + s * 136 + d8) = *(const uint4*)((const bf16*)(p.ws + WS_H) + (size_t)(r0 + s) * 512 + hh * 128 + d8);
  }
  for (int i = tid; i < 1024; i += 256) {
    const int s = i >> 4, d8 = (i & 15) * 8;
    float y[8];
    conv8_prompt(p, l, z, r0, c * 64, s, hh * 128 + d8, y);
    uint4 o;
    o.x = pack2(y[0], y[1]); o.y = pack2(y[2], y[3]);
    o.z = pack2(y[4], y[5]); o.w = pack2(y[6], y[7]);
    *(uint4*)(sq + s * 136 + d8) = o;
  }
  for (int i = tid; i < 1024; i += 256) {
    const int s = i >> 4, d8 = (i & 15) * 8;
    float v[8];
    unpack8(*(const uint4*)(z + (size_t)(r0 + s) * ZC + C_V + hh * 128 + d8), v);
#pragma unroll
    for (int j = 0; j < 8; ++j) svT[(d8 + j) * 72 + s] = f2bf(v[j]);
  }
  __syncthreads();
  const float m_prev = ((const float*)(p.ws + WS_M))[item];
  {
    const int t = wave * 16 + r16;
    bf16x8 qf[4];
#pragma unroll
    for (int ks = 0; ks < 4; ++ks) qf[ks] = *(const bf16x8*)(sq + t * 136 + ks * 32 + g4 * 8);
    f32x4 st[4];
#pragma unroll
    for (int kt = 0; kt < 4; ++kt) {
      st[kt] = (f32x4){0.f, 0.f, 0.f, 0.f};
#pragma unroll
      for (int ks = 0; ks < 4; ++ks) {
        const bf16x8 kf = *(const bf16x8*)(sk + (kt * 16 + r16) * 136 + ks * 32 + g4 * 8);
        st[kt] = mfma16(kf, qf[ks], st[kt]);
      }
    }
    const float cumt = scum[t];
    float dm[4][4];
    float rmax = -INFINITY;
#pragma unroll
    for (int kt = 0; kt < 4; ++kt)
#pragma unroll
      for (int x = 0; x < 4; ++x) {
        const int s = kt * 16 + g4 * 4 + x;
        dm[kt][x] = (s <= t) ? (cumt - scum[s] + siv[s]) : -INFINITY;
        rmax = fmaxf(rmax, dm[kt][x]);
      }
    rmax = fmaxf(rmax, __shfl_xor(rmax, 16)); rmax = fmaxf(rmax, __shfl_xor(rmax, 32));
    const float mi = cumt + m_prev, mt = fmaxf(mi, rmax);
    float rsum = 0.f;
#pragma unroll
    for (int kt = 0; kt < 4; ++kt) {
      float a[4];
#pragma unroll
      for (int x = 0; x < 4; ++x) {
        const int s = kt * 16 + g4 * 4 + x;
        a[x] = (s <= t) ? __expf(dm[kt][x] - mt) * st[kt][x] : 0.f;
        rsum += a[x];
      }
      uint2 o;
      o.x = pack2(a[0], a[1]); o.y = pack2(a[2], a[3]);
      *(uint2*)(sa + t * 72 + kt * 16 + g4 * 4) = o;
    }
    rsum += __shfl_xor(rsum, 16); rsum += __shfl_xor(rsum, 32);
    if (g4 == 0) { smt[t] = mt; swi[t] = __expf(mi - mt); sden[t] = rsum; }
  }
  {
    const int t = tid >> 2, part = tid & 3;
    const float* nc = (const float*)(p.ws + WS_UN) + (size_t)item * 128;
    float s = 0.f;
    for (int d = part * 32; d < part * 32 + 32; ++d) s += bf2f(sq[t * 136 + d]) * nc[d];
    s += __shfl_xor(s, 1); s += __shfl_xor(s, 2);
    if (part == 0) sqn[t] = s;
  }
  __syncthreads();
  f32x4 acc[4][2];
#pragma unroll
  for (int ti = 0; ti < 4; ++ti)
#pragma unroll
    for (int et = 0; et < 2; ++et) acc[ti][et] = (f32x4){0.f, 0.f, 0.f, 0.f};
  const bf16* Cc = (const bf16*)(p.ws + WS_U) + (size_t)item * 16384;
#pragma unroll
  for (int ks = 0; ks < 4; ++ks) {
    bf16x8 cf[2], qf[4];
#pragma unroll
    for (int et = 0; et < 2; ++et) cf[et] = *(const bf16x8*)(Cc + (wave * 32 + et * 16 + r16) * 128 + ks * 32 + g4 * 8);
#pragma unroll
    for (int ti = 0; ti < 4; ++ti) qf[ti] = *(const bf16x8*)(sq + (ti * 16 + r16) * 136 + ks * 32 + g4 * 8);
#pragma unroll
    for (int ti = 0; ti < 4; ++ti)
#pragma unroll
      for (int et = 0; et < 2; ++et) acc[ti][et] = mfma16(cf[et], qf[ti], acc[ti][et]);
  }
#pragma unroll
  for (int ti = 0; ti < 4; ++ti) {
    const float w = swi[ti * 16 + r16];
#pragma unroll
    for (int et = 0; et < 2; ++et) acc[ti][et] *= w;
  }
#pragma unroll
  for (int ks = 0; ks < 2; ++ks) {
    bf16x8 vf[2], af[4];
#pragma unroll
    for (int et = 0; et < 2; ++et) vf[et] = *(const bf16x8*)(svT + (wave * 32 + et * 16 + r16) * 72 + ks * 32 + g4 * 8);
#pragma unroll
    for (int ti = 0; ti < 4; ++ti) af[ti] = *(const bf16x8*)(sa + (ti * 16 + r16) * 72 + ks * 32 + g4 * 8);
#pragma unroll
    for (int ti = 0; ti < 4; ++ti)
#pragma unroll
      for (int et = 0; et < 2; ++et) acc[ti][et] = mfma16(vf[et], af[ti], acc[ti][et]);
  }
#pragma unroll
  for (int ti = 0; ti < 4; ++ti) {
    const int t = ti * 16 + r16;
    const float den = sden[t] + swi[t] * sqn[t];
    const float inv = 1.0f / fmaxf(fabsf(den), __expf(-smt[t]));
    float ss = 0.f;
#pragma unroll
    for (int et = 0; et < 2; ++et) {
      acc[ti][et] *= inv;
#pragma unroll
      for (int x = 0; x < 4; ++x) ss += acc[ti][et][x] * acc[ti][et][x];
    }
    ss += __shfl_xor(ss, 16); ss += __shfl_xor(ss, 32);
    if (g4 == 0) spart[t * 4 + wave] = ss;
  }
  __syncthreads();
  const float* hg = p.hnorm_g + l * 512 + hh * 128;
#pragma unroll
  for (int ti = 0; ti < 4; ++ti) {
    const int t = ti * 16 + r16;
    const float rstd = rsqrtf((spart[t * 4] + spart[t * 4 + 1] + spart[t * 4 + 2] + spart[t * 4 + 3]) * (1.0f / 128.f) + EPS);
    bf16* zr = z + (size_t)(r0 + t) * ZC;
#pragma unroll
    for (int et = 0; et < 2; ++et) {
      const int e = wave * 32 + et * 16 + g4 * 4;
      float o[4], cg_[4];
      unpack4(*(const uint2*)(zr + C_O + hh * 128 + e), o);
      unpack4(*(const uint2*)(zr + C_G + hh * 128 + e), cg_);
      float y[4];
#pragma unroll
      for (int x = 0; x < 4; ++x) y[x] = acc[ti][et][x] * rstd * hg[e + x] * sigmoidf_(o[x]) * siluf_(cg_[x]);
      uint2 oo;
      oo.x = pack2(y[0], y[1]); oo.y = pack2(y[2], y[3]);
      *(uint2*)(zr + C_O + hh * 128 + e) = oo;
    }
  }
  __syncthreads();
}

__device__ __forceinline__ void phase_mix2(const Params& p, int l, unsigned char* smem) {
  for (int it = blockIdx.x; it < 1024; it += gridDim.x) mlstm_out_item(p, l, it, smem);
}

template <int NI>
__device__ __forceinline__ void br_tile(const Params& p, int l, int m0, int n0, bf16* sm) {
  const bf16* Wbr = (const bf16*)(p.ws + WS_WBR) + (size_t)l * 1024 * 1536;
  const bf16* yab = (const bf16*)(p.ws + WS_YAB);
  const bf16* z = (const bf16*)(p.ws + WS_Z);
  bf16* merged = (bf16*)(p.ws + WS_U);
  const float* bias = p.b_in + (size_t)l * ZIN + OFF_MG;
  const int lane = tidx() & 63, wave = tidx() >> 6, wr = wave >> 1, wc = wave & 1;
#pragma unroll 1
  for (int seg = 0; seg < 3; ++seg) {
    f32x4 acc[4][NI];
    zero_acc<NI>(acc);
    gemm_accum_f8<NI>(acc, p.ws + WS_H8 + (size_t)m0 * 1024, p.ws + WS_W8 + ((size_t)l * W8_ROWS + (OFF_MG - W8_ROW0) + seg * 1024 + n0) * 1024, sm);
    unsigned gp[4][NI][2];
#pragma unroll
    for (int j = 0; j < NI; ++j) {
      const int col = n0 + wc * (16 * NI) + j * 16 + (lane >> 4) * 4;
      const float4 bb = *(const float4*)(bias + seg * 1024 + col);
#pragma unroll
      for (int i = 0; i < 4; ++i) {
        gp[i][j][0] = pack2(sigmoidf_(acc[i][j][0] * 0.015625f + bb.x), sigmoidf_(acc[i][j][1] * 0.015625f + bb.y));
        gp[i][j][1] = pack2(sigmoidf_(acc[i][j][2] * 0.015625f + bb.z), sigmoidf_(acc[i][j][3] * 0.015625f + bb.w));
      }
    }
    zero_acc<NI>(acc);
    const bf16* A = (seg == 0) ? yab + (size_t)m0 * 1024 : (seg == 1) ? yab + (size_t)m0 * 1024 + 512 : z + (size_t)m0 * ZC + C_O;
    const int lda = (seg == 2) ? ZC : 1024;
    gemm_accum<NI, (NI >= 2)>(acc, A, lda, Wbr + (size_t)n0 * 1536 + seg * 512, 1536, 512, sm);
#pragma unroll
    for (int i = 0; i < 4; ++i)
#pragma unroll
      for (int j = 0; j < NI; ++j) {
        const int row = m0 + wr * 64 + i * 16 + (lane & 15), col = n0 + wc * (16 * NI) + j * 16 + (lane >> 4) * 4;
        uint2* mp = (uint2*)(merged + (size_t)row * 1024 + col);
        uint2 prev = make_uint2(0u, 0u);
        if (seg > 0) prev = *mp;
        uint2 o;
        o.x = pack2(lo2f(prev.x) + lo2f(gp[i][j][0]) * acc[i][j][0], hi2f(prev.x) + hi2f(gp[i][j][0]) * acc[i][j][1]);
        o.y = pack2(lo2f(prev.y) + lo2f(gp[i][j][1]) * acc[i][j][2], hi2f(prev.y) + hi2f(gp[i][j][1]) * acc[i][j][3]);
        *mp = o;
      }
  }
}
__device__ __forceinline__ void phase_gemm_br(const Params& p, int l, unsigned char* smem) {
  bf16* sm = (bf16*)smem;
  const int ntiles = (TT / 128) * 8;
  const int nfull = (ntiles / (int)gridDim.x) * (int)gridDim.x;
  for (int t = blockIdx.x; t < nfull; t += gridDim.x) {
    int pm, pn;
    tile_map(t, 8, pm, pn);
    br_tile<4>(p, l, pm * 128, pn * 128, sm);
  }
  for (int u = blockIdx.x; u < 4 * (ntiles - nfull); u += gridDim.x) {
    int pm, pn;
    tile_map(nfull + (u >> 2), 8, pm, pn);
    br_tile<1>(p, l, pm * 128, pn * 128 + (u & 3) * 32, sm);
  }
}

template <int NI>
__device__ __forceinline__ void out_tile(const Params& p, int l, int m0, int n0, bf16* sm) {
  const bf16* merged = (const bf16*)(p.ws + WS_U);
  const bf16* Wout = (const bf16*)(p.ws + WS_WOUT) + (size_t)l * 1024 * 1024;
  const float* mod = (const float*)(p.ws + WS_MOD);
  const int lane = tidx() & 63, wave = tidx() >> 6, wr = wave >> 1, wc = wave & 1;
  f32x4 acc[4][NI];
  zero_acc<NI>(acc);
  gemm_accum<NI>(acc, merged + (size_t)m0 * 1024, 1024, Wout + (size_t)n0 * 1024, 1024, 1024, sm);
#pragma unroll
  for (int i = 0; i < 4; ++i) {
    const int row = m0 + wr * 64 + i * 16 + (lane & 15);
    const float* xr = xrow_ptr(p, l, row);
    const float* gate = mod + ((size_t)l * NMOD + mod_row(row)) * 3072 + 2048;
#pragma unroll
    for (int j = 0; j < NI; ++j) {
      const int col = n0 + wc * (16 * NI) + j * 16 + (lane >> 4) * 4;
      const float4 xv = *(const float4*)(xr + col), gv = *(const float4*)(gate + col);
      float4 o;
      o.x = xv.x + gv.x * acc[i][j][0]; o.y = xv.y + gv.y * acc[i][j][1];
      o.z = xv.z + gv.z * acc[i][j][2]; o.w = xv.w + gv.w * acc[i][j][3];
      *(float4*)(p.out + (size_t)row * D + col) = o;
    }
  }
}
__device__ __forceinline__ void phase_gemm_out(const Params& p, int l, unsigned char* smem) {
  bf16* sm = (bf16*)smem;
  const int ntiles = (TT / 128) * 8;
  const int nfull = (ntiles / (int)gridDim.x) * (int)gridDim.x;
  for (int t = blockIdx.x; t < nfull; t += gridDim.x) {
    int pm, pn;
    tile_map(t, 8, pm, pn);
    out_tile<4>(p, l, pm * 128, pn * 128, sm);
  }
  for (int u = blockIdx.x; u < 4 * (ntiles - nfull); u += gridDim.x) {
    int pm, pn;
    tile_map(nfull + (u >> 2), 8, pm, pn);
    out_tile<1>(p, l, pm * 128, pn * 128 + (u & 3) * 32, sm);
  }
}

constexpr int N_PHASES = 19;
template <int S>
__device__ __forceinline__ void run_stage(const Params& p, int l, unsigned char* smem) {
  if (S == -1) phase_prep(p, smem);
  if (S == 0) phase_norm(p, l);
  if (S == 1) phase_gemm_in(p, l, 0, ZAB / 128, ZAB, smem);
  if (S == 2) phase_mix_ab(p, l, smem);
  if (S == 3) phase_gemm_in(p, l, ZAB, ZC / 128, ZC, smem);
  if (S == 4) phase_mix1(p, l, smem);
  if (S == 5) phase_scan(p, l, smem);
  if (S == 6) phase_mix2(p, l, smem);
  if (S == 7) phase_gemm_br(p, l, smem);
  if (S == 8) phase_gemm_out(p, l, smem);
}


#define XB_TMO      128
#define XB_XCNT(j)  (256  + 64 * (j))
#define XB_XSUB(j)  (1280 + 64 * (j))
#define XB_XGEN(j)  (2304 + 64 * (j))
#define XB_TOP      3328
#define XB_TOPGEN   3392
#define XCD_BAR_WORDS 3456
#define XB_SPIN_CAP (1u << 18)
#define LAS __attribute__((address_space(3)))
__device__ __forceinline__ unsigned xb_ld(unsigned* p)              { return __hip_atomic_load(p, __ATOMIC_RELAXED, __HIP_MEMORY_SCOPE_AGENT); }
__device__ __forceinline__ unsigned xb_add(unsigned* p, unsigned v) { return __hip_atomic_fetch_add(p, v, __ATOMIC_RELAXED, __HIP_MEMORY_SCOPE_AGENT); }
__device__ __forceinline__ unsigned xb_xcc_id() { return (unsigned)__builtin_amdgcn_s_getreg((3 << 11) | 20) & 0xFu; }
#define XB_SPIN(cond, bar) do { unsigned _sp = 0; while (cond) { __builtin_amdgcn_s_sleep(1); \
    if ((++_sp & 255u) == 0u) { if (xb_ld(&(bar)[XB_TMO])) break; if (_sp > XB_SPIN_CAP) { atomicAdd(&(bar)[XB_TMO], 1u); break; } } } } while (0)
struct XcdBarrier { unsigned* bar; unsigned x; volatile LAS unsigned* st; };
__device__ __forceinline__ XcdBarrier xcd_barrier_post(unsigned* bar, volatile LAS unsigned* st) {
  XcdBarrier b; b.bar = bar; b.x = xb_xcc_id(); b.st = st;
  if (threadIdx.x == 0) (void)xb_add(&bar[XB_XCNT(b.x)], 1u);
  return b;
}
__device__ __forceinline__ void xcd_barrier_complete(unsigned* bar, unsigned x, unsigned& nloc, unsigned& nx) {
  const unsigned G = gridDim.x * gridDim.y * gridDim.z;
  unsigned sum, cnt, mine, sp = 0u;
  for (;;) {
    sum = 0u; cnt = 0u; mine = 0u;
#pragma unroll
    for (unsigned j = 0; j < 16; ++j) { const unsigned c = xb_ld(&bar[XB_XCNT(j)]); sum += c; cnt += (c > 0u) ? 1u : 0u; mine = (j == x) ? c : mine; }
    if (sum == G) break;
    __builtin_amdgcn_s_sleep(1);
    if ((++sp & 255u) == 0u) { if (xb_ld(&bar[XB_TMO])) break; if (sp > XB_SPIN_CAP) { atomicAdd(&bar[XB_TMO], 1u); break; } }
  }
  nloc = mine > 0u ? mine : 1u; nx = cnt > 0u ? cnt : 1u;
}
__device__ __forceinline__ void xcd_barrier(const XcdBarrier& b) {
  asm volatile("s_waitcnt vmcnt(0)" ::: "memory");
  __syncthreads();
  if (threadIdx.x == 0) {
    unsigned* bar = b.bar;
    __builtin_amdgcn_s_waitcnt(0);
    unsigned nloc = b.st[0], nx = b.st[1];
    if (nloc == 0u) { xcd_barrier_complete(bar, b.x, nloc, nx); b.st[0] = nloc; b.st[1] = nx; }
    const unsigned old = xb_add(&bar[XB_XSUB(b.x)], 1u);
    const unsigned gen = old / nloc;
    if (old + 1u == (gen + 1u) * nloc) {
      __builtin_amdgcn_fence(__ATOMIC_RELEASE, "agent");
      asm volatile("s_waitcnt vmcnt(0)" ::: "memory");
      const unsigned og = xb_add(&bar[XB_TOP], 1u);
      const unsigned tg = og / nx;
      if (og + 1u == (tg + 1u) * nx) xb_add(&bar[XB_TOPGEN], 1u);
      else XB_SPIN(xb_ld(&bar[XB_TOPGEN]) == tg, bar);
      __builtin_amdgcn_fence(__ATOMIC_ACQUIRE, "agent");
      xb_add(&bar[XB_XGEN(b.x)], 1u);
      asm volatile("s_waitcnt vmcnt(0)" ::: "memory");
    } else {
      XB_SPIN(xb_ld(&bar[XB_XGEN(b.x)]) == gen, bar);
      __builtin_amdgcn_fence(__ATOMIC_ACQUIRE, "agent");
      asm volatile("s_waitcnt vmcnt(0)" ::: "memory");
    }
  }
  __syncthreads();
}

#define GSYNC() xcd_barrier(xb)
__global__ void __launch_bounds__(256, 2) mega_kernel(Params p_in) {
  __shared__ __attribute__((aligned(16))) unsigned char smem[SMEM_BYTES];
  const Params& p = *(const Params*)__builtin_amdgcn_kernarg_segment_ptr();
  __shared__ uint4 xb_words;
  if (threadIdx.x == 0) xb_words = make_uint4(0u, 0u, 0u, 0u);
  __syncthreads();
  XcdBarrier xb = xcd_barrier_post((unsigned*)(p.ws + WS_BAR), (volatile LAS unsigned*)&xb_words);
  run_stage<-1>(p, 0, smem);
  if (p.out == nullptr) cg::this_grid().sync();
  GSYNC();
#define LAYER(L, LAST)                 \
  run_stage<0>(p, L, smem); GSYNC();   \
  run_stage<1>(p, L, smem); GSYNC();   \
  run_stage<2>(p, L, smem); GSYNC();   \
  run_stage<3>(p, L, smem); GSYNC();   \
  run_stage<4>(p, L, smem); GSYNC();   \
  run_stage<5>(p, L, smem); GSYNC();   \
  run_stage<6>(p, L, smem); GSYNC();   \
  run_stage<7>(p, L, smem); GSYNC();   \
  run_stage<8>(p, L, smem);            \
  if (!LAST) GSYNC();
  int l0 = 0, l1 = 1;
  asm volatile("" : "+s"(l0));
  asm volatile("" : "+s"(l1));
  LAYER(l0, 0)
  LAYER(l1, 1)
}

extern "C" void kernel_launch(void* const* d_in, const int* in_sizes, int n_in, void* d_out, int out_size, void* d_ws,
                              size_t ws_size, hipStream_t stream) {
  if (ws_size < WS_END || n_in < 29) { fprintf(stderr, "workspace too small / bad inputs\n"); return; }
  Params p{};
  const float** f = (const float**)&p;
  for (int i = 0; i < 29; ++i) f[i] = (const float*)d_in[i];
  p.out = (float*)d_out;
  p.ws = (unsigned char*)d_ws;
  static int grid_blocks = 0;
  if (!grid_blocks) {
    int dev = 0, cus = 0, per_cu = 0;
    (void)hipGetDevice(&dev);
    (void)hipDeviceGetAttribute(&cus, hipDeviceAttributeMultiprocessorCount, dev);
    (void)hipOccupancyMaxActiveBlocksPerMultiprocessor(&per_cu, mega_kernel, 256, 0);
    if (per_cu < 1) per_cu = 1;
    if (per_cu > 2) per_cu = 2;
    grid_blocks = cus * per_cu;
  }
  (void)hipMemsetAsync((unsigned char*)d_ws + WS_BAR, 0, 16384, stream);
  void* args[] = {&p};
  hipError_t e = hipLaunchCooperativeKernel((void*)mega_kernel, dim3(grid_blocks), dim3(256), args, 0, stream);
  if (e != hipSuccess) fprintf(stderr, "cooperative launch failed: %s (grid %d)\n", hipGetErrorString(e), grid_blocks);
}
```

```cpp
#include <hip/hip_runtime.h>
#include <hip/hip_cooperative_groups.h>
#include <cstdio>
namespace cg = cooperative_groups;

typedef unsigned short bf16;
typedef short bf16x8 __attribute__((ext_vector_type(8)));
typedef float f32x4 __attribute__((ext_vector_type(4)));
typedef unsigned u32x4 __attribute__((ext_vector_type(4)));
#define LDSP __attribute__((address_space(3)))

#ifndef SINGLE_LAUNCH
#define SINGLE_LAUNCH 0
#endif

constexpr int D = 1024, TP = 16384, TS = 1024, TT = TP + TS, SEQ = 4096;
constexpr int ZIN = 8456, NWIN = 8576;
constexpr int OFF_AV = 512, OFF_AG = 1024, OFF_BQ = 1536, OFF_BK = 2048, OFF_BV = 2176, OFF_BG = 2304, OFF_MG = 5384;
constexpr int ZAB = 2816;
constexpr int ZC = 2688;
constexpr int C_QK = 0, C_V = 1024, C_I = 1536, C_F = 1540, C_O = 1544, C_G = 2056;
constexpr float EPS = 1e-6f;
constexpr int NMOD = 132;
constexpr int SMEM_BYTES = 73728;

constexpr size_t O_Y = 0;
constexpr size_t O_SKP = (size_t)TT * D;
constexpr size_t O_SVP = O_SKP + 2 * 4 * 128 * 128;
constexpr size_t O_CVP = O_SVP + 2 * 4 * 128 * 128;
constexpr size_t O_CP = O_CVP + 2 * 4 * 3 * 1024;
constexpr size_t O_NP = O_CP + (size_t)2 * 4 * 4 * 128 * 128;
constexpr size_t O_MP = O_NP + 2 * 4 * 4 * 128;
constexpr size_t O_SKS = O_MP + 2 * 4 * 4;
constexpr size_t O_SVS = O_SKS + (size_t)2 * 128 * 128 * 128;
constexpr size_t O_CVS = O_SVS + (size_t)2 * 128 * 128 * 128;
constexpr size_t O_CS = O_CVS + (size_t)2 * 128 * 3 * 1024;
constexpr size_t O_NS = O_CS + (size_t)2 * 128 * 4 * 128 * 128;
constexpr size_t O_MS = O_NS + (size_t)2 * 128 * 4 * 128;
constexpr size_t O_GV = O_MS + 2 * 128 * 4;
constexpr size_t O_END = O_GV + (size_t)2 * 128 * 8 * 512;

constexpr size_t WS_WIN = 0;
constexpr size_t WS_WBR = WS_WIN + (size_t)2 * NWIN * 1024 * 2;
constexpr size_t WS_WOUT = WS_WBR + (size_t)2 * 1024 * 1536 * 2;
constexpr size_t WS_MOD = WS_WOUT + (size_t)2 * 1024 * 1024 * 2;
constexpr size_t WS_H = WS_MOD + (size_t)2 * NMOD * 3072 * 4;
constexpr size_t WS_YAB = WS_H + (size_t)TT * 1024 * 2;
constexpr size_t WS_U = WS_YAB + (size_t)TT * 1024 * 2;
constexpr size_t WS_UN = WS_U + (size_t)TT * 1024 * 2;
constexpr size_t WS_G = WS_UN + (size_t)1024 * 128 * 4;
constexpr size_t WS_TOT = WS_G + 4096;
constexpr size_t WS_M = WS_TOT + 4096;
constexpr size_t WS_Z = WS_M + 4096;
constexpr size_t WS_BAR = WS_Z + (size_t)TT * ZAB * 2;
constexpr size_t WS_H8 = WS_BAR + 16384;
constexpr int W8_ROW0 = 0, W8_ROWS = NWIN;
constexpr size_t WS_W8 = WS_H8 + (size_t)TT * 1024;
constexpr size_t WS_END = WS_W8 + (size_t)2 * W8_ROWS * 1024;

struct Params {
  const float *x_prompt, *x_sample, *cache_k, *cache_v, *st_conv, *st_C, *st_n, *st_m, *c_prompt, *c_sample;
  const float *ada_w, *ada_b, *norm_g, *w_in, *b_in, *vnorm_g, *gmlp_ws, *gmlp_bs, *qn_g, *kn_g, *sinks;
  const float *conv_w, *conv_b, *f_bias, *hnorm_g, *w_a, *w_b, *w_c, *w_out;
  float* out;
  unsigned char* ws;
};

__device__ __forceinline__ int tidx() { int t = threadIdx.x; asm volatile("" : "+v"(t)); return t; }
__device__ __forceinline__ bf16 f2bf(float f) {
  unsigned u = __float_as_uint(f);
  u += 0x7fffu + ((u >> 16) & 1u);
  return (bf16)(u >> 16);
}
__device__ __forceinline__ float bf2f(bf16 h) { return __uint_as_float(((unsigned)h) << 16); }
__device__ __forceinline__ unsigned pack2(float a, float b) { return (unsigned)f2bf(a) | ((unsigned)f2bf(b) << 16); }
__device__ __forceinline__ float lo2f(unsigned u) { return __uint_as_float(u << 16); }
__device__ __forceinline__ float hi2f(unsigned u) { return __uint_as_float(u & 0xffff0000u); }
__device__ __forceinline__ void unpack8(const uint4& v, float* f) {
  f[0] = lo2f(v.x); f[1] = hi2f(v.x); f[2] = lo2f(v.y); f[3] = hi2f(v.y);
  f[4] = lo2f(v.z); f[5] = hi2f(v.z); f[6] = lo2f(v.w); f[7] = hi2f(v.w);
}
__device__ __forceinline__ void unpack4(const uint2& v, float* f) {
  f[0] = lo2f(v.x); f[1] = hi2f(v.x); f[2] = lo2f(v.y); f[3] = hi2f(v.y);
}
__device__ __forceinline__ float sigmoidf_(float x) { return __builtin_amdgcn_rcpf(1.0f + __expf(-x)); }
__device__ __forceinline__ float siluf_(float x) { return x * __builtin_amdgcn_rcpf(1.0f + __expf(-x)); }
__device__ __forceinline__ float logsigmoidf_(float x) { return fminf(x, 0.0f) - log1pf(__expf(-fabsf(x))); }
__device__ __forceinline__ float wave_sum(float v) {
#pragma unroll
  for (int o = 32; o >= 1; o >>= 1) v += __shfl_xor(v, o);
  return v;
}
__device__ __forceinline__ float wave_max(float v) {
#pragma unroll
  for (int o = 32; o >= 1; o >>= 1) v = fmaxf(v, __shfl_xor(v, o));
  return v;
}
__device__ __forceinline__ f32x4 mfma16(bf16x8 a, bf16x8 b, f32x4 c) {
  return __builtin_amdgcn_mfma_f32_16x16x32_bf16(a, b, c, 0, 0, 0);
}
template <int MI, int NI, bool SWZA = false, bool SWZB = false>
__device__ __forceinline__ void mma_lds(f32x4 (&acc)[MI][NI], const bf16* sA, int lda, const bf16* sB, int ldb, int K, int lane) {
  const int r = lane & 15, q = (lane >> 4) * 8;
  for (int k0 = 0; k0 < K; k0 += 32) {
    bf16x8 a[MI], b[NI];
#pragma unroll
    for (int i = 0; i < MI; ++i) a[i] = *(const bf16x8*)(sA + (i * 16 + r) * lda + ((k0 + q) ^ (SWZA ? (((i * 2 + (r >> 3)) & 7) << 3) : 0)));
#pragma unroll
    for (int j = 0; j < NI; ++j) b[j] = *(const bf16x8*)(sB + (j * 16 + r) * ldb + ((k0 + q) ^ (SWZB ? (((j * 2 + (r >> 3)) & 7) << 3) : 0)));
#pragma unroll
    for (int i = 0; i < MI; ++i)
#pragma unroll
      for (int j = 0; j < NI; ++j) acc[i][j] = mfma16(b[j], a[i], acc[i][j]);
  }
}

constexpr int GLD = 64;
constexpr int GTILE = 128 * GLD;
template <int NI>
__device__ __forceinline__ void g_load(u32x4 (&ra)[4], u32x4 (&rb)[NI], const bf16* __restrict__ A, int lda, const bf16* __restrict__ B, int ldb, int ko, int tid) {
  const unsigned offA = (unsigned)((tid >> 3) * lda + (tid & 7) * 8), offB = (unsigned)((tid >> 3) * ldb + (tid & 7) * 8);
#pragma unroll
  for (int i = 0; i < 4; ++i) {
    const bf16* Ai = A + (size_t)(i * 32) * lda + ko;
    ra[i] = *(const u32x4*)(Ai + offA);
  }
#pragma unroll
  for (int i = 0; i < NI; ++i) {
    const bf16* Bi = B + (size_t)(i * 32) * ldb + ko;
    rb[i] = *(const u32x4*)(Bi + offB);
  }
}
template <int NI>
__device__ __forceinline__ void g_store(const u32x4 (&ra)[4], const u32x4 (&rb)[NI], bf16* buf, int tid) {
  const int off = (tid >> 3) * GLD + (((tid & 7) ^ ((tid >> 3) & 7)) * 8);
#pragma unroll
  for (int i = 0; i < 4; ++i) *(u32x4*)(buf + off + i * 32 * GLD) = ra[i];
#pragma unroll
  for (int i = 0; i < NI; ++i) *(u32x4*)(buf + GTILE + off + i * 32 * GLD) = rb[i];
}
template <int NI, bool LOWREG = false>
__device__ __forceinline__ void g_compute(f32x4 (&acc)[4][NI], const bf16* cur, int wr, int wc, int lane) {
  const int r16 = lane & 15, sw = lane & 7, q = lane >> 4;
#pragma unroll
  for (int ks = 0; ks < 2; ++ks) {
    const int pc = ((ks * 4 + q) ^ sw) * 8;
    bf16x8 a[4];
#pragma unroll
    for (int i = 0; i < 4; ++i) a[i] = *(const bf16x8*)(cur + (wr * 64 + i * 16 + r16) * GLD + pc);
    constexpr int JW = (NI >= 2) ? 2 : 1;
#pragma unroll
    for (int jh = 0; jh < NI; jh += JW) {
      bf16x8 b[JW];
#pragma unroll
      for (int j = 0; j < JW; ++j) b[j] = *(const bf16x8*)(cur + GTILE + (wc * 16 * NI + (jh + j) * 16 + r16) * GLD + pc);
#pragma unroll
      for (int i = 0; i < 4; ++i)
#pragma unroll
        for (int j = 0; j < JW; ++j) acc[i][jh + j] = mfma16(b[j], a[i], acc[i][jh + j]);
      if (LOWREG) __builtin_amdgcn_sched_barrier(0);
    }
  }
}
template <int NI, bool F8SWZ = false>
__device__ __forceinline__ void g_stage(const bf16* __restrict__ A, int lda, const bf16* __restrict__ B, int ldb, int ko, bf16* buf, int tid) {
  const int wave = tid >> 6;
  const int lrow = tid >> 3;
  const int gch = ((tid & 7) ^ (F8SWZ ? ((lrow & 6) | ((lrow >> 3) & 1)) : (lrow & 7))) * 8;
  const unsigned offA = (unsigned)((tid >> 3) * lda + gch), offB = (unsigned)((tid >> 3) * ldb + gch);
#pragma unroll
  for (int i = 0; i < 4; ++i) {
    const bf16* Ai = A + (size_t)(i * 32) * lda + ko;
    __builtin_amdgcn_global_load_lds((const unsigned*)(Ai + offA), (LDSP unsigned*)(buf + (i * 32 + wave * 8) * GLD), 16, 0, 0);
  }
#pragma unroll
  for (int i = 0; i < NI; ++i) {
    const bf16* Bi = B + (size_t)(i * 32) * ldb + ko;
    __builtin_amdgcn_global_load_lds((const unsigned*)(Bi + offB), (LDSP unsigned*)(buf + GTILE + (i * 32 + wave * 8) * GLD), 16, 0, 0);
  }
}
template <int NI, bool LOWREG = false>
__device__ __forceinline__ void gemm_accum(f32x4 (&acc)[4][NI], const bf16* __restrict__ A, int lda,
                                           const bf16* __restrict__ B, int ldb, int K, bf16* sm) {
  const int tid = tidx(), lane = tid & 63, wave = tid >> 6, wr = wave >> 1, wc = wave & 1;
  const int nk = K >> 6;
  bf16* buf0 = sm;
  bf16* buf1 = sm + 2 * GTILE;
  g_stage<NI>(A, lda, B, ldb, 0, buf0, tid);
  asm volatile("s_waitcnt vmcnt(0)" ::: "memory");
  __syncthreads();
#pragma unroll 1
  for (int kt = 0; kt < nk; kt += 2) {
    g_stage<NI>(A, lda, B, ldb, (kt + 1) * 64, buf1, tid);
    g_compute<NI, LOWREG>(acc, buf0, wr, wc, lane);
    asm volatile("s_waitcnt vmcnt(0)" ::: "memory");
    __syncthreads();
    if (kt + 2 < nk) g_stage<NI>(A, lda, B, ldb, (kt + 2) * 64, buf0, tid);
    g_compute<NI, LOWREG>(acc, buf1, wr, wc, lane);
    asm volatile("s_waitcnt vmcnt(0)" ::: "memory");
    __syncthreads();
  }
}
typedef int i32x8 __attribute__((ext_vector_type(8)));
template <int NI>
__device__ __forceinline__ void g_compute_f8(f32x4 (&acc)[4][NI], const bf16* cur, int wr, int wc, int lane) {
  const int r16 = lane & 15, sw = (r16 & 6) | (r16 >> 3), q = lane >> 4;
  const int pc0 = ((2 * q) ^ sw) * 8, pc1 = ((2 * q + 1) ^ sw) * 8;
  i32x8 b[NI];
#pragma unroll
  for (int j = 0; j < NI; ++j) {
    const bf16* rp = cur + GTILE + (wc * 16 * NI + j * 16 + r16) * GLD;
    const u32x4 lo = *(const u32x4*)(rp + pc0), hi = *(const u32x4*)(rp + pc1);
    b[j] = (i32x8){(int)lo.x, (int)lo.y, (int)lo.z, (int)lo.w, (int)hi.x, (int)hi.y, (int)hi.z, (int)hi.w};
  }
#pragma unroll
  for (int i = 0; i < 4; ++i) {
    const bf16* rp = cur + (wr * 64 + i * 16 + r16) * GLD;
    const u32x4 lo = *(const u32x4*)(rp + pc0), hi = *(const u32x4*)(rp + pc1);
    const i32x8 a = (i32x8){(int)lo.x, (int)lo.y, (int)lo.z, (int)lo.w, (int)hi.x, (int)hi.y, (int)hi.z, (int)hi.w};
#pragma unroll
    for (int j = 0; j < NI; ++j)
      acc[i][j] = __builtin_amdgcn_mfma_scale_f32_16x16x128_f8f6f4(b[j], a, acc[i][j], 0, 0, 0, 0x7F7F7F7F, 0, 0x7F7F7F7F);
  }
}
template <int NI>
__device__ __forceinline__ void gemm_accum_f8(f32x4 (&acc)[4][NI], const unsigned char* __restrict__ A8, const unsigned char* __restrict__ B8, bf16* sm) {
  const int tid = tidx(), lane = tid & 63, wave = tid >> 6, wr = wave >> 1, wc = wave & 1;
  const bf16* A = (const bf16*)A8;
  const bf16* B = (const bf16*)B8;
  bf16* buf0 = sm;
  bf16* buf1 = sm + 2 * GTILE;
  g_stage<NI, true>(A, 512, B, 512, 0, buf0, tid);
  asm volatile("s_waitcnt vmcnt(0)" ::: "memory");
  __syncthreads();
#pragma unroll 1
  for (int kt = 0; kt < 8; kt += 2) {
    g_stage<NI, true>(A, 512, B, 512, (kt + 1) * 64, buf1, tid);
    g_compute_f8<NI>(acc, buf0, wr, wc, lane);
    asm volatile("s_waitcnt vmcnt(0)" ::: "memory");
    __syncthreads();
    if (kt + 2 < 8) g_stage<NI, true>(A, 512, B, 512, (kt + 2) * 64, buf0, tid);
    g_compute_f8<NI>(acc, buf1, wr, wc, lane);
    asm volatile("s_waitcnt vmcnt(0)" ::: "memory");
    __syncthreads();
  }
}
template <int NI>
__device__ __forceinline__ void zero_acc(f32x4 (&acc)[4][NI]) {
#pragma unroll
  for (int i = 0; i < 4; ++i)
#pragma unroll
    for (int j = 0; j < NI; ++j) acc[i][j] = (f32x4){0.f, 0.f, 0.f, 0.f};
}
__device__ __forceinline__ void tile_map(int t, int ntn, int& pm, int& pn) {
  const int grp = t / (8 * ntn), w = t % (8 * ntn);
  pm = grp * 8 + (w & 7);
  pn = w >> 3;
}

__device__ __forceinline__ void transpose_tile(const float* __restrict__ src, int ld_src, int n_valid, bf16* __restrict__ dst, int ld_dst,
                               int k0, int n0, int kdst0, float* sm, unsigned char* dst8 = nullptr) {
  const int tid = tidx();
  for (int i = tid; i < 64 * 16; i += 256) {
    const int kk = i >> 4, n4 = (i & 15) * 4, n = n0 + n4;
    float4 v = make_float4(0.f, 0.f, 0.f, 0.f);
    if (n + 3 < n_valid) v = *(const float4*)(src + (size_t)(k0 + kk) * ld_src + n);
    sm[kk * 65 + n4 + 0] = v.x; sm[kk * 65 + n4 + 1] = v.y; sm[kk * 65 + n4 + 2] = v.z; sm[kk * 65 + n4 + 3] = v.w;
  }
  __syncthreads();
  for (int i = tid; i < 64 * 8; i += 256) {
    const int nn = i >> 3, kc = (i & 7) * 8;
    uint4 o;
    o.x = pack2(sm[(kc + 0) * 65 + nn], sm[(kc + 1) * 65 + nn]);
    o.y = pack2(sm[(kc + 2) * 65 + nn], sm[(kc + 3) * 65 + nn]);
    o.z = pack2(sm[(kc + 4) * 65 + nn], sm[(kc + 5) * 65 + nn]);
    o.w = pack2(sm[(kc + 6) * 65 + nn], sm[(kc + 7) * 65 + nn]);
    *(uint4*)(dst + (size_t)(n0 + nn) * ld_dst + kdst0 + kc) = o;
    if (dst8 != nullptr) {
      uint2 q8;
      int t8 = __builtin_amdgcn_cvt_pk_fp8_f32(64.f * sm[(kc + 0) * 65 + nn], 64.f * sm[(kc + 1) * 65 + nn], 0, false);
      q8.x = (unsigned)__builtin_amdgcn_cvt_pk_fp8_f32(64.f * sm[(kc + 2) * 65 + nn], 64.f * sm[(kc + 3) * 65 + nn], t8, true);
      t8 = __builtin_amdgcn_cvt_pk_fp8_f32(64.f * sm[(kc + 4) * 65 + nn], 64.f * sm[(kc + 5) * 65 + nn], 0, false);
      q8.y = (unsigned)__builtin_amdgcn_cvt_pk_fp8_f32(64.f * sm[(kc + 6) * 65 + nn], 64.f * sm[(kc + 7) * 65 + nn], t8, true);
      *(uint2*)(dst8 + (size_t)(n0 + nn - W8_ROW0) * 1024 + kdst0 + kc) = q8;
    }
  }
  __syncthreads();
}

__device__ __forceinline__ void ada_item(const Params& p, int item, float* sm) {
  const int l = item / 192, n0 = (item % 192) * 16;
  const int tid = tidx(), col = tid & 15, rg = tid >> 4;
  constexpr int SLD = 68;
  float* sW = sm + 144 * SLD;
  float acc[9];
#pragma unroll
  for (int j = 0; j < 9; ++j) acc[j] = 0.f;
  const float* W = p.ada_w + (size_t)l * 1024 * 3072 + n0;
  const int wk = tid >> 2, wc4 = (tid & 3) * 4;
  float v[36];
  float4 w0;
#define ADA_LOAD(K0)                                                                                      \
  {                                                                                                       \
    _Pragma("unroll") for (int u = 0; u < 36; ++u) {                                                      \
      const int i = tid + 256 * u, r = i >> 6, kk = i & 63;                                               \
      v[u] = 0.f;                                                                                         \
      if (r < NMOD) v[u] = (r < 4) ? p.c_prompt[r * 1024 + (K0) + kk] : p.c_sample[(r - 4) * 1024 + (K0) + kk]; \
    }                                                                                                     \
    w0 = *(const float4*)(W + (size_t)((K0) + wk) * 3072 + wc4);                                          \
  }
#define ADA_STORE()                                                                                       \
  {                                                                                                       \
    _Pragma("unroll") for (int u = 0; u < 36; ++u) {                                                      \
      const int i = tid + 256 * u, r = i >> 6, kk = i & 63;                                               \
      sm[r * SLD + kk] = siluf_(v[u]);                                                                    \
    }                                                                                                     \
    *(float4*)(sW + wk * 16 + wc4) = w0;                                                                  \
  }
  ADA_LOAD(0)
  ADA_STORE()
  __syncthreads();
#pragma unroll 1
  for (int k0 = 0; k0 < 1024; k0 += 64) {
    if (k0 + 64 < 1024) ADA_LOAD(k0 + 64)
#pragma unroll 4
    for (int k4 = 0; k4 < 16; ++k4) {
      const float x0 = sW[(k4 * 4 + 0) * 16 + col], x1 = sW[(k4 * 4 + 1) * 16 + col];
      const float x2 = sW[(k4 * 4 + 2) * 16 + col], x3 = sW[(k4 * 4 + 3) * 16 + col];
#pragma unroll
      for (int j = 0; j < 9; ++j) {
        const float4 sv = *(const float4*)(sm + (rg * 9 + j) * SLD + k4 * 4);
        acc[j] += sv.x * x0 + sv.y * x1 + sv.z * x2 + sv.w * x3;
      }
    }
    __syncthreads();
    if (k0 + 64 < 1024) ADA_STORE()
    __syncthreads();
  }
#undef ADA_LOAD
#undef ADA_STORE
  float* mod = (float*)(p.ws + WS_MOD);
  const float b = p.ada_b[l * 3072 + n0 + col];
#pragma unroll
  for (int j = 0; j < 9; ++j) {
    const int r = rg * 9 + j;
    if (r < NMOD) mod[((size_t)l * NMOD + r) * 3072 + n0 + col] = acc[j] + b;
  }
}

__device__ __forceinline__ void phase_prep(const Params& p, unsigned char* smem) {
  float* sm = (float*)smem;
  constexpr int N_WIN = 2 * 16 * (NWIN / 64);
  constexpr int N_WBR = 2 * 3 * 8 * 16;
  constexpr int N_WOUT = 2 * 16 * 16;
  constexpr int N_ALL = N_WIN + N_WBR + N_WOUT;
  bf16* WinT = (bf16*)(p.ws + WS_WIN);
  bf16* WbrT = (bf16*)(p.ws + WS_WBR);
  bf16* WoutT = (bf16*)(p.ws + WS_WOUT);
  constexpr int N_ADA = 384;
  for (int it = blockIdx.x; it < N_ADA + N_ALL; it += gridDim.x) {
    if (it < N_ADA) { ada_item(p, it, sm); continue; }
    int i = it - N_ADA;
    if (i < N_WIN) {
      const int l = i / (16 * 134), r = i % (16 * 134), kt = r / 134, nt = r % 134;
      transpose_tile(p.w_in + (size_t)l * 1024 * ZIN, ZIN, ZIN, WinT + (size_t)l * NWIN * 1024, 1024, kt * 64, nt * 64, kt * 64, sm,
                     (nt * 64 >= W8_ROW0) ? p.ws + WS_W8 + (size_t)l * W8_ROWS * 1024 : nullptr);
      continue;
    }
    i -= N_WIN;
    if (i < N_WBR) {
      const int l = i / 384, r = i % 384, seg = r / 128, r2 = r % 128, kt = r2 / 16, nt = r2 % 16;
      const float* src = (seg == 0 ? p.w_a : seg == 1 ? p.w_b : p.w_c) + (size_t)l * 512 * 1024;
      transpose_tile(src, 1024, 1024, WbrT + (size_t)l * 1024 * 1536, 1536, kt * 64, nt * 64, seg * 512 + kt * 64, sm);
      continue;
    }
    i -= N_WBR;
    {
      const int l = i / 256, r = i % 256, kt = r / 16, nt = r % 16;
      transpose_tile(p.w_out + (size_t)l * 1024 * 1024, 1024, 1024, WoutT + (size_t)l * 1024 * 1024, 1024, kt * 64, nt * 64, kt * 64, sm);
    }
  }
}

__device__ __forceinline__ const float* xrow_ptr(const Params& p, int l, int row) {
  if (l == 0) return row < TP ? p.x_prompt + (size_t)row * D : p.x_sample + (size_t)(row - TP) * D;
  return p.out + (size_t)row * D;
}
__device__ __forceinline__ int mod_row(int row) { return row < TP ? (row >> 12) : 4 + ((row - TP) >> 3); }

__device__ __forceinline__ void phase_norm(const Params& p, int l) {
  const int lane = tidx() & 63, wave = tidx() >> 6;
  bf16* hbuf = (bf16*)(p.ws + WS_H);
  unsigned char* h8 = p.ws + WS_H8;
  const float* mod = (const float*)(p.ws + WS_MOD);
  const float* g = p.norm_g + l * D;
  for (int row = blockIdx.x * 4 + wave; row < TT; row += gridDim.x * 4) {
    const float4* x = (const float4*)xrow_ptr(p, l, row);
    float4 v[4];
    float ss = 0.f;
#pragma unroll
    for (int i = 0; i < 4; ++i) {
      v[i] = x[lane + 64 * i];
      ss += v[i].x * v[i].x + v[i].y * v[i].y + v[i].z * v[i].z + v[i].w * v[i].w;
    }
    ss = wave_sum(ss);
    const float rstd = rsqrtf(ss * (1.0f / D) + EPS);
    const float* mp = mod + ((size_t)l * NMOD + mod_row(row)) * 3072;
#pragma unroll
    for (int i = 0; i < 4; ++i) {
      const int c = (lane + 64 * i) * 4;
      const float4 gg = *(const float4*)(g + c), sh = *(const float4*)(mp + c), sc = *(const float4*)(mp + 1024 + c);
      uint2 o;
      o.x = pack2(v[i].x * rstd * gg.x * (1.f + sc.x) + sh.x, v[i].y * rstd * gg.y * (1.f + sc.y) + sh.y);
      o.y = pack2(v[i].z * rstd * gg.z * (1.f + sc.z) + sh.z, v[i].w * rstd * gg.w * (1.f + sc.w) + sh.w);
      *(uint2*)(hbuf + (size_t)row * D + c) = o;
      int p8 = __builtin_amdgcn_cvt_pk_fp8_f32(v[i].x * rstd * gg.x * (1.f + sc.x) + sh.x, v[i].y * rstd * gg.y * (1.f + sc.y) + sh.y, 0, false);
      p8 = __builtin_amdgcn_cvt_pk_fp8_f32(v[i].z * rstd * gg.z * (1.f + sc.z) + sh.z, v[i].w * rstd * gg.w * (1.f + sc.w) + sh.w, p8, true);
      *(int*)(h8 + (size_t)row * D + c) = p8;
    }
  }
}

__device__ __forceinline__ void phase_gemm_in(const Params& p, int l, int col0, int ntn, int ldz, unsigned char* smem) {
  bf16* sm = (bf16*)smem;
  const bf16* hbuf = (const bf16*)(p.ws + WS_H);
  const bf16* W = (const bf16*)(p.ws + WS_WIN) + (size_t)l * NWIN * 1024;
  bf16* z = (bf16*)(p.ws + WS_Z);
  const float* bias = p.b_in + (size_t)l * ZIN;
  const int tid = tidx(), lane = tid & 63, wave = tid >> 6, wr = wave >> 1, wc = wave & 1;
  const int ntiles = (TT / 128) * ntn;
  constexpr int OLD = 136;
  const bool isAB = (col0 == 0);
  const int nb = isAB ? 6 : 13;
  const int NB = (TT / 128) * nb;
  for (int t = blockIdx.x; t < ntiles; t += gridDim.x) {
    const bool f8 = t >= NB;
    int pm, pk;
    tile_map(f8 ? t - NB : t, f8 ? ntn - nb : nb, pm, pk);
    int pn;
    if (isAB) pn = f8 ? (pk < 4 ? pk : pk < 12 ? pk + 4 : pk + 6) : (pk < 4 ? 4 + pk : 12 + pk);
    else pn = f8 ? 13 + pk : pk;
    const int m0 = pm * 128, n0 = pn * 128;
    f32x4 acc[4][4];
    zero_acc<4>(acc);
    float osc = 1.0f;
    if (f8) {
      gemm_accum_f8<4>(acc, p.ws + WS_H8 + (size_t)m0 * 1024, p.ws + WS_W8 + ((size_t)l * W8_ROWS + col0 + n0) * 1024, sm);
      osc = 0.015625f;
    } else {
      gemm_accum<4>(acc, hbuf + (size_t)m0 * 1024, 1024, W + (size_t)(col0 + n0) * 1024, 1024, 1024, sm);
    }
#pragma unroll
    for (int j = 0; j < 4; ++j) {
      const int cl = wc * 64 + j * 16 + (lane >> 4) * 4;
      const float4 b = *(const float4*)(bias + col0 + n0 + cl);
#pragma unroll
      for (int i = 0; i < 4; ++i) {
        const int rl = wr * 64 + i * 16 + (lane & 15);
        uint2 o;
        o.x = pack2(acc[i][j][0] * osc + b.x, acc[i][j][1] * osc + b.y);
        o.y = pack2(acc[i][j][2] * osc + b.z, acc[i][j][3] * osc + b.w);
        *(uint2*)(sm + rl * OLD + cl) = o;
      }
    }
    __syncthreads();
#pragma unroll
    for (int it = 0; it < 8; ++it) {
      const int id = tid + 256 * it, row = id >> 4, ch = id & 15;
      const u32x4 v = *(const u32x4*)(sm + row * OLD + ch * 8);
      *(u32x4*)(z + (size_t)(m0 + row) * ldz + n0 + ch * 8) = v;
    }
    __syncthreads();
  }
}

__device__ __forceinline__ void gmlp_prompt_item(const Params& p, int l, int item, unsigned char* smem) {
  const int b = item >> 7, n = (item >> 2) & 31, g = item & 3;
  const int r0 = b * SEQ + n * 128;
  const bf16* z = (const bf16*)(p.ws + WS_Z);
  bf16* yab = (bf16*)(p.ws + WS_YAB);
  bf16* sW = (bf16*)smem;
  bf16* sV = (bf16*)(smem + 34816);
  float* srstd = (float*)(smem + 69632);
  const int tid = tidx(), lane = tid & 63, wave = tid >> 6, wr = wave >> 1, wc = wave & 1;
  {
    const int tok = tid >> 1, half = tid & 1;
    const uint4* ptr = (const uint4*)(z + (size_t)(r0 + tok) * ZAB + OFF_AV + half * 256);
    float ss = 0.f;
    for (int i = 0; i < 32; ++i) {
      float f[8];
      unpack8(ptr[i], f);
#pragma unroll
      for (int j = 0; j < 8; ++j) ss += f[j] * f[j];
    }
    ss += __shfl_xor(ss, 1);
    if (half == 0) srstd[tok] = rsqrtf(ss * (1.0f / 512.f) + EPS);
  }
  __syncthreads();
  const float* vg = p.vnorm_g + l * 512 + g * 128;
  for (int i = tid; i < 2048; i += 256) {
    const int s = i >> 4, c8 = (i & 15) * 8;
    float f[8];
    unpack8(*(const uint4*)(z + (size_t)(r0 + s) * ZAB + OFF_AV + g * 128 + c8), f);
    const float rs = srstd[s];
#pragma unroll
    for (int j = 0; j < 8; ++j) sV[(c8 + j) * 136 + (s ^ (((c8 >> 3) & 7) << 3))] = f2bf(f[j] * rs * vg[c8 + j]);
  }
  const float* Wg = p.gmlp_ws + ((size_t)(l * 4 + g)) * 128 * 128;
  for (int i = tid; i < 4096; i += 256) {
    const int t = i >> 5, s4 = (i & 31) * 4;
    const float4 w = *(const float4*)(Wg + t * 128 + s4);
    uint2 o;
    o.x = pack2(s4 + 0 <= t ? w.x : 0.f, s4 + 1 <= t ? w.y : 0.f);
    o.y = pack2(s4 + 2 <= t ? w.z : 0.f, s4 + 3 <= t ? w.w : 0.f);
    *(uint2*)(sW + t * 136 + s4) = o;
  }
  __syncthreads();
  f32x4 acc[4][4];
  zero_acc<4>(acc);
  mma_lds<4, 4, false, true>(acc, sW + wr * 64 * 136, 136, sV + wc * 64 * 136, 136, wr * 64 + 64, lane);
  const float* bs = p.gmlp_bs + (l * 4 + g) * 128;
#pragma unroll
  for (int i = 0; i < 4; ++i) {
    const int t = wr * 64 + i * 16 + (lane & 15);
    const float bst = bs[t];
    const size_t rowoff = (size_t)(r0 + t) * ZAB;
#pragma unroll
    for (int j = 0; j < 4; ++j) {
      const int c = g * 128 + wc * 64 + j * 16 + (lane >> 4) * 4;
      float u[4], ag[4];
      unpack4(*(const uint2*)(z + rowoff + c), u);
      unpack4(*(const uint2*)(z + rowoff + OFF_AG + c), ag);
      uint2 o;
      o.x = pack2(u[0] * (acc[i][j][0] + bst) * siluf_(ag[0]), u[1] * (acc[i][j][1] + bst) * siluf_(ag[1]));
      o.y = pack2(u[2] * (acc[i][j][2] + bst) * siluf_(ag[2]), u[3] * (acc[i][j][3] + bst) * siluf_(ag[3]));
      *(uint2*)(yab + (size_t)(r0 + t) * 1024 + c) = o;
    }
  }
  __syncthreads();
}

__device__ __forceinline__ void gmlp_sample_item(const Params& p, int l, int b, unsigned char* smem) {
  const int r0 = TP + b * 8;
  const bf16* z = (const bf16*)(p.ws + WS_Z);
  bf16* yab = (bf16*)(p.ws + WS_YAB);
  float* svn = (float*)smem;
  const int tid = tidx(), lane = tid & 63, wave = tid >> 6;
  const float* vg = p.vnorm_g + l * 512;
  for (int tt = 0; tt < 2; ++tt) {
    const int t = wave * 2 + tt;
    float f[8];
    unpack8(*(const uint4*)(z + (size_t)(r0 + t) * ZAB + OFF_AV + lane * 8), f);
    float ss = 0.f;
#pragma unroll
    for (int j = 0; j < 8; ++j) ss += f[j] * f[j];
    ss = wave_sum(ss);
    const float rstd = rsqrtf(ss * (1.0f / 512.f) + EPS);
    float* gv = p.out + O_GV + (((size_t)l * 128 + b) * 8 + t) * 512 + lane * 8;
#pragma unroll
    for (int j = 0; j < 8; ++j) {
      const float vn = f[j] * rstd * vg[lane * 8 + j];
      svn[t * 512 + lane * 8 + j] = vn;
      gv[j] = vn;
    }
  }
  __syncthreads();
  {
    const int c = tid * 2, g = c >> 7;
    const float* Wg = p.gmlp_ws + ((size_t)(l * 4 + g)) * 128 * 128;
    const float* bs = p.gmlp_bs + (l * 4 + g) * 128;
    for (int t = 0; t < 8; ++t) {
      float s0 = bs[t], s1 = bs[t];
      for (int s = 0; s <= t; ++s) {
        const float w = Wg[t * 128 + s];
        s0 += w * svn[s * 512 + c];
        s1 += w * svn[s * 512 + c + 1];
      }
      const unsigned uu = *(const unsigned*)(z + (size_t)(r0 + t) * ZAB + c);
      const unsigned gg = *(const unsigned*)(z + (size_t)(r0 + t) * ZAB + OFF_AG + c);
      *(unsigned*)(yab + (size_t)(r0 + t) * 1024 + c) = pack2(lo2f(uu) * s0 * siluf_(lo2f(gg)), hi2f(uu) * s1 * siluf_(hi2f(gg)));
    }
  }
  __syncthreads();
}

__device__ __forceinline__ void swa_prompt_item(const Params& p, int l, int item, unsigned char* smem) {
  const int b = item >> 7, qt = (item >> 1) & 63, kv = item & 1;
  const int q0 = qt * 64, rb = b * SEQ;
  const bf16* z = (const bf16*)(p.ws + WS_Z);
  bf16* yab = (bf16*)(p.ws + WS_YAB);
  bf16* sK = (bf16*)smem;
  bf16* sVT = (bf16*)(smem + 27648);
  const int tid = tidx(), lane = tid & 63, wave = tid >> 6;
  const float* kg = p.kn_g + l * 64;
  const float* qg = p.qn_g + l * 64;
#pragma unroll 1
  for (int it = 0; it < 6; ++it) {
    const int id = tid + 256 * it, kk = id >> 3, ch = id & 7, kp = q0 - 128 + kk;
    float f[8];
    uint4 vraw = make_uint4(0, 0, 0, 0);
    if (kp >= 0) {
      unpack8(*(const uint4*)(z + (size_t)(rb + kp) * ZAB + OFF_BK + kv * 64 + ch * 8), f);
      vraw = *(const uint4*)(z + (size_t)(rb + kp) * ZAB + OFF_BV + kv * 64 + ch * 8);
    } else {
#pragma unroll
      for (int j = 0; j < 8; ++j) f[j] = 0.f;
    }
    float ss = 0.f;
#pragma unroll
    for (int j = 0; j < 8; ++j) ss += f[j] * f[j];
    ss += __shfl_xor(ss, 1); ss += __shfl_xor(ss, 2); ss += __shfl_xor(ss, 4);
    const float rstd = rsqrtf(ss * (1.0f / 64.f) + EPS);
#pragma unroll
    for (int j = 0; j < 8; ++j) f[j] = f[j] * rstd * kg[ch * 8 + j];
    uint4 ko;
    ko.x = pack2(f[0], f[1]); ko.y = pack2(f[2], f[3]); ko.z = pack2(f[4], f[5]); ko.w = pack2(f[6], f[7]);
    *(uint4*)(sK + kk * 72 + ch * 8) = ko;
    float vf[8];
    unpack8(vraw, vf);
#pragma unroll
    for (int j = 0; j < 8; ++j) sVT[(ch * 8 + j) * 200 + kk] = f2bf(vf[j]);
    if (kk >= 128 && kp >= SEQ - 128) {
      const size_t o = ((((size_t)l * 4 + b) * 128 + (kp - (SEQ - 128))) * 2 + kv) * 64 + ch * 8;
#pragma unroll
      for (int j = 0; j < 8; ++j) { p.out[O_SKP + o + j] = f[j]; p.out[O_SVP + o + j] = vf[j]; }
    }
  }
  __syncthreads();
  const int h = kv * 4 + wave;
  const float sink = p.sinks[l * 8 + h];
  const int g4 = lane >> 4, r16 = lane & 15;
#pragma unroll 1
  for (int i = 0; i < 4; ++i) {
    const int qrow = q0 + i * 16 + r16;
    const size_t grow = (size_t)(rb + qrow);
    bf16x8 qf[2];
    {
      float f0[8], f1[8];
      unpack8(*(const uint4*)(z + grow * ZAB + OFF_BQ + h * 64 + g4 * 8), f0);
      unpack8(*(const uint4*)(z + grow * ZAB + OFF_BQ + h * 64 + 32 + g4 * 8), f1);
      float ss = 0.f;
#pragma unroll
      for (int j = 0; j < 8; ++j) ss += f0[j] * f0[j] + f1[j] * f1[j];
      ss += __shfl_xor(ss, 16); ss += __shfl_xor(ss, 32);
      const float rstd = rsqrtf(ss * (1.0f / 64.f) + EPS) * 0.125f;
#pragma unroll
      for (int j = 0; j < 8; ++j) {
        qf[0][j] = (short)f2bf(f0[j] * rstd * qg[g4 * 8 + j]);
        qf[1][j] = (short)f2bf(f1[j] * rstd * qg[32 + g4 * 8 + j]);
      }
    }
    f32x4 st[12];
#pragma unroll
    for (int kt = 0; kt < 12; ++kt) {
      st[kt] = (f32x4){0.f, 0.f, 0.f, 0.f};
#pragma unroll
      for (int ks = 0; ks < 2; ++ks) {
        const bf16x8 kf = *(const bf16x8*)(sK + (kt * 16 + r16) * 72 + ks * 32 + g4 * 8);
        st[kt] = mfma16(kf, qf[ks], st[kt]);
      }
      if ((kt & 1) == 1) __builtin_amdgcn_sched_barrier(0);
    }
    float mx = -INFINITY;
#pragma unroll
    for (int kt = 0; kt < 12; ++kt)
#pragma unroll
      for (int x = 0; x < 4; ++x) {
        const int kp = q0 - 128 + kt * 16 + g4 * 4 + x, diff = qrow - kp;
        const bool valid = (kp >= 0) && (diff >= 0) && (diff < 128);
        st[kt][x] = valid ? st[kt][x] : -INFINITY;
        mx = fmaxf(mx, st[kt][x]);
      }
    mx = fmaxf(mx, __shfl_xor(mx, 16)); mx = fmaxf(mx, __shfl_xor(mx, 32));
    mx = fmaxf(mx, sink);
    float sum = 0.f;
#pragma unroll
    for (int kt = 0; kt < 12; ++kt)
#pragma unroll
      for (int x = 0; x < 4; ++x) {
        const float pv = __expf(st[kt][x] - mx);
        st[kt][x] = pv;
        sum += pv;
      }
    sum += __shfl_xor(sum, 16); sum += __shfl_xor(sum, 32);
    const float inv = 1.0f / (sum + __expf(sink - mx));
    f32x4 o[4];
#pragma unroll
    for (int dt = 0; dt < 4; ++dt) o[dt] = (f32x4){0.f, 0.f, 0.f, 0.f};
#pragma unroll
    for (int t2 = 0; t2 < 6; ++t2) {
      bf16x8 pf;
#pragma unroll
      for (int x = 0; x < 4; ++x) { pf[x] = (short)f2bf(st[2 * t2][x]); pf[4 + x] = (short)f2bf(st[2 * t2 + 1][x]); }
#pragma unroll
      for (int dt = 0; dt < 4; ++dt) {
        const uint2 v0 = *(const uint2*)(sVT + (dt * 16 + r16) * 200 + t2 * 32 + g4 * 4);
        const uint2 v1 = *(const uint2*)(sVT + (dt * 16 + r16) * 200 + t2 * 32 + 16 + g4 * 4);
        union { uint4 u; bf16x8 v; } cv;
        cv.u = make_uint4(v0.x, v0.y, v1.x, v1.y);
        o[dt] = mfma16(cv.v, pf, o[dt]);
      }
      __builtin_amdgcn_sched_barrier(0);
    }
#pragma unroll
    for (int dt = 0; dt < 4; ++dt) {
      const int d0 = dt * 16 + g4 * 4;
      float bg[4];
      unpack4(*(const uint2*)(z + grow * ZAB + OFF_BG + h * 64 + d0), bg);
      uint2 oo;
      oo.x = pack2(o[dt][0] * inv * siluf_(bg[0]), o[dt][1] * inv * siluf_(bg[1]));
      oo.y = pack2(o[dt][2] * inv * siluf_(bg[2]), o[dt][3] * inv * siluf_(bg[3]));
      *(uint2*)(yab + grow * 1024 + 512 + h * 64 + d0) = oo;
    }
  }
  __syncthreads();
}

__device__ __forceinline__ void swa_sample_item(const Params& p, int l, int item, unsigned char* smem) {
  const int b = item >> 1, kv = item & 1;
  const int r0 = TP + b * 8;
  const bf16* z = (const bf16*)(p.ws + WS_Z);
  bf16* yab = (bf16*)(p.ws + WS_YAB);
  bf16* sK = (bf16*)smem;
  bf16* sV = (bf16*)(smem + 19584);
  float* sq = (float*)(smem + 39168);
  float* sP = (float*)(smem + 47488);
  const int tid = tidx();
  const float* kg = p.kn_g + l * 64;
  const float* qg = p.qn_g + l * 64;
  const float* ck = p.cache_k + ((size_t)l * 128 + b) * 128 * 128;
  const float* cvp = p.cache_v + ((size_t)l * 128 + b) * 128 * 128;
#pragma unroll 1
  for (int it = 0; it < 5; ++it) {
    const int id = tid + 256 * it, j = id >> 3, ch = id & 7;
    const bool act = id < 1088;
    float kf[8], vf[8];
#pragma unroll
    for (int x = 0; x < 8; ++x) { kf[x] = 0.f; vf[x] = 0.f; }
    if (act) {
      if (j < 128) {
        const float4 a0 = *(const float4*)(ck + (j * 2 + kv) * 64 + ch * 8), a1 = *(const float4*)(ck + (j * 2 + kv) * 64 + ch * 8 + 4);
        const float4 b0 = *(const float4*)(cvp + (j * 2 + kv) * 64 + ch * 8), b1 = *(const float4*)(cvp + (j * 2 + kv) * 64 + ch * 8 + 4);
        kf[0] = a0.x; kf[1] = a0.y; kf[2] = a0.z; kf[3] = a0.w; kf[4] = a1.x; kf[5] = a1.y; kf[6] = a1.z; kf[7] = a1.w;
        vf[0] = b0.x; vf[1] = b0.y; vf[2] = b0.z; vf[3] = b0.w; vf[4] = b1.x; vf[5] = b1.y; vf[6] = b1.z; vf[7] = b1.w;
      } else {
        unpack8(*(const uint4*)(z + (size_t)(r0 + j - 128) * ZAB + OFF_BK + kv * 64 + ch * 8), kf);
        unpack8(*(const uint4*)(z + (size_t)(r0 + j - 128) * ZAB + OFF_BV + kv * 64 + ch * 8), vf);
      }
    }
    float ss = 0.f;
#pragma unroll
    for (int x = 0; x < 8; ++x) ss += kf[x] * kf[x];
    ss += __shfl_xor(ss, 1); ss += __shfl_xor(ss, 2); ss += __shfl_xor(ss, 4);
    if (act) {
      if (j >= 128) {
        const float rstd = rsqrtf(ss * (1.0f / 64.f) + EPS);
#pragma unroll
        for (int x = 0; x < 8; ++x) kf[x] = kf[x] * rstd * kg[ch * 8 + x];
      }
      uint4 ko, vo;
      ko.x = pack2(kf[0], kf[1]); ko.y = pack2(kf[2], kf[3]); ko.z = pack2(kf[4], kf[5]); ko.w = pack2(kf[6], kf[7]);
      vo.x = pack2(vf[0], vf[1]); vo.y = pack2(vf[2], vf[3]); vo.z = pack2(vf[4], vf[5]); vo.w = pack2(vf[6], vf[7]);
      *(uint4*)(sK + j * 72 + ch * 8) = ko;
      *(uint4*)(sV + j * 72 + ch * 8) = vo;
      if (j >= 8) {
        const size_t o = ((((size_t)l * 128 + b) * 128 + (j - 8)) * 2 + kv) * 64 + ch * 8;
        *(float4*)(p.out + O_SKS + o) = make_float4(kf[0], kf[1], kf[2], kf[3]);
        *(float4*)(p.out + O_SKS + o + 4) = make_float4(kf[4], kf[5], kf[6], kf[7]);
        *(float4*)(p.out + O_SVS + o) = make_float4(vf[0], vf[1], vf[2], vf[3]);
        *(float4*)(p.out + O_SVS + o + 4) = make_float4(vf[4], vf[5], vf[6], vf[7]);
      }
    }
  }
  const int qi = tid >> 3, sub = tid & 7, t = qi >> 2, h = kv * 4 + (qi & 3);
  {
    float f[8];
    unpack8(*(const uint4*)(z + (size_t)(r0 + t) * ZAB + OFF_BQ + h * 64 + sub * 8), f);
    float ss = 0.f;
#pragma unroll
    for (int x = 0; x < 8; ++x) ss += f[x] * f[x];
    ss += __shfl_xor(ss, 1); ss += __shfl_xor(ss, 2); ss += __shfl_xor(ss, 4);
    const float rstd = rsqrtf(ss * (1.0f / 64.f) + EPS) * 0.125f;
#pragma unroll
    for (int x = 0; x < 8; ++x) sq[qi * 65 + sub * 8 + x] = f[x] * rstd * qg[sub * 8 + x];
  }
  __syncthreads();
  const float sink = p.sinks[l * 8 + h];
  float mx = -INFINITY;
#pragma unroll 1
  for (int jj = 0; jj < 17; ++jj) {
    const int key = sub + 8 * jj;
    float s = 0.f;
#pragma unroll 8
    for (int d = 0; d < 64; ++d) s += sq[qi * 65 + d] * bf2f(sK[key * 72 + d]);
    const bool valid = (key >= t + 1) && (key <= t + 128);
    s = valid ? s : -INFINITY;
    sP[qi * 140 + key] = s;
    mx = fmaxf(mx, s);
  }
  mx = fmaxf(mx, __shfl_xor(mx, 1)); mx = fmaxf(mx, __shfl_xor(mx, 2)); mx = fmaxf(mx, __shfl_xor(mx, 4));
  mx = fmaxf(mx, sink);
  float sum = 0.f;
  for (int jj = 0; jj < 17; ++jj) {
    const int key = sub + 8 * jj;
    const float pv = __expf(sP[qi * 140 + key] - mx);
    sP[qi * 140 + key] = pv;
    sum += pv;
  }
  sum += __shfl_xor(sum, 1); sum += __shfl_xor(sum, 2); sum += __shfl_xor(sum, 4);
  const float inv = 1.0f / (sum + __expf(sink - mx));
  __syncthreads();
  {
    float o[8];
#pragma unroll
    for (int x = 0; x < 8; ++x) o[x] = 0.f;
#pragma unroll 2
    for (int key = 0; key < 136; ++key) {
      const float pv = sP[qi * 140 + key];
      float vf[8];
      unpack8(*(const uint4*)(sV + key * 72 + sub * 8), vf);
#pragma unroll
      for (int x = 0; x < 8; ++x) o[x] += pv * vf[x];
    }
    float bg[8];
    unpack8(*(const uint4*)(z + (size_t)(r0 + t) * ZAB + OFF_BG + h * 64 + sub * 8), bg);
    uint4 oo;
    oo.x = pack2(o[0] * inv * siluf_(bg[0]), o[1] * inv * siluf_(bg[1]));
    oo.y = pack2(o[2] * inv * siluf_(bg[2]), o[3] * inv * siluf_(bg[3]));
    oo.z = pack2(o[4] * inv * siluf_(bg[4]), o[5] * inv * siluf_(bg[5]));
    oo.w = pack2(o[6] * inv * siluf_(bg[6]), o[7] * inv * siluf_(bg[7]));
    *(uint4*)(yab + (size_t)(r0 + t) * 1024 + 512 + h * 64 + sub * 8) = oo;
  }
  __syncthreads();
}

__device__ __forceinline__ void phase_mix_ab(const Params& p, int l, unsigned char* smem) {
  constexpr int N_SWA = 512, N_GM = 512, N_SWS = 256, N_GMS = 128;
  constexpr int N_ALL = N_SWA + N_GM + N_SWS + N_GMS;
  for (int it = blockIdx.x; it < N_ALL; it += gridDim.x) {
    int i = it;
    if (i < N_SWA) { swa_prompt_item(p, l, i, smem); continue; }
    i -= N_SWA;
    if (i < N_GM) { gmlp_prompt_item(p, l, i, smem); continue; }
    i -= N_GM;
    if (i < N_SWS) { swa_sample_item(p, l, i, smem); continue; }
    i -= N_SWS;
    gmlp_sample_item(p, l, i, smem);
  }
}

__device__ __forceinline__ void conv8_prompt(const Params& p, int l, const bf16* z, int r0, int pos0, int s, int zc, float* y) {
  const float* cw = p.conv_w + (size_t)l * 4 * 1024 + zc;
  const float* cb = p.conv_b + l * 1024 + zc;
#pragma unroll
  for (int j = 0; j < 8; ++j) y[j] = cb[j];
#pragma unroll
  for (int tap = 0; tap < 4; ++tap) {
    const int back = 3 - tap;
    if (pos0 + s - back >= 0) {
      float f[8];
      unpack8(*(const uint4*)(z + (size_t)(r0 + s - back) * ZC + C_QK + zc), f);
#pragma unroll
      for (int j = 0; j < 8; ++j) y[j] += cw[tap * 1024 + j] * f[j];
    }
  }
#pragma unroll
  for (int j = 0; j < 8; ++j) y[j] = siluf_(y[j]);
}

__device__ __forceinline__ void chunk_gates(const Params& p, int l, const bf16* z, int r0, int hh, int lane, float& cum, float& iv) {
  const float f = bf2f(z[(size_t)(r0 + lane) * ZC + C_F + hh]) + p.f_bias[l * 4 + hh];
  iv = bf2f(z[(size_t)(r0 + lane) * ZC + C_I + hh]);
  float c = logsigmoidf_(f);
#pragma unroll
  for (int o = 1; o < 64; o <<= 1) {
    const float n = __shfl_up(c, o);
    if (lane >= o) c += n;
  }
  cum = c;
}

__device__ __forceinline__ void mlstm_local_item(const Params& p, int l, int item, unsigned char* smem) {
  const int bh = item >> 6, c = item & 63, b = bh >> 2, hh = bh & 3;
  const int r0 = b * SEQ + c * 64;
  const bf16* z = (const bf16*)(p.ws + WS_Z);
  bf16* skT = (bf16*)smem;
  bf16* svT = (bf16*)(smem + 18432);
  float* swsel = (float*)(smem + 36864);
  const int tid = tidx(), lane = tid & 63, wave = tid >> 6, wr = wave >> 1, wc = wave & 1;
  if (wave == 0) {
    float cum, iv;
    chunk_gates(p, l, z, r0, hh, lane, cum, iv);
    const float total = __shfl(cum, 63);
    const float g = total - cum + iv;
    const float G = wave_max(g);
    swsel[lane] = __expf(g - G);
    if (lane == 0) {
      ((float*)(p.ws + WS_G))[item] = G;
      ((float*)(p.ws + WS_TOT))[item] = total;
    }
  }
  __syncthreads();
  for (int i = tid; i < 1024; i += 256) {
    const int s = i >> 4, d8 = (i & 15) * 8;
    float y[8];
    conv8_prompt(p, l, z, r0, c * 64, s, 512 + hh * 128 + d8, y);
    {
      uint4 ko;
      ko.x = pack2(y[0] * 0.08838834764831845f, y[1] * 0.08838834764831845f); ko.y = pack2(y[2] * 0.08838834764831845f, y[3] * 0.08838834764831845f);
      ko.z = pack2(y[4] * 0.08838834764831845f, y[5] * 0.08838834764831845f); ko.w = pack2(y[6] * 0.08838834764831845f, y[7] * 0.08838834764831845f);
      *(uint4*)((bf16*)(p.ws + WS_H) + (size_t)(r0 + s) * 512 + hh * 128 + d8) = ko;
    }
    const float sc = 0.08838834764831845f * swsel[s];
#pragma unroll
    for (int j = 0; j < 8; ++j) skT[(d8 + j) * 72 + (s ^ (((d8 >> 3) & 7) << 3))] = f2bf(y[j] * sc);
    float v[8];
    unpack8(*(const uint4*)(z + (size_t)(r0 + s) * ZC + C_V + hh * 128 + d8), v);
#pragma unroll
    for (int j = 0; j < 8; ++j) svT[(d8 + j) * 72 + (s ^ (((d8 >> 3) & 7) << 3))] = f2bf(v[j]);
  }
  __syncthreads();
  f32x4 acc[4][4];
  zero_acc<4>(acc);
  mma_lds<4, 4, true, true>(acc, svT + wr * 64 * 72, 72, skT + wc * 64 * 72, 72, 64, lane);
  bf16* U = (bf16*)(p.ws + WS_U) + (size_t)item * 16384;
#pragma unroll
  for (int i = 0; i < 4; ++i)
#pragma unroll
    for (int j = 0; j < 4; ++j) {
      const int e = wr * 64 + i * 16 + (lane & 15), d = wc * 64 + j * 16 + (lane >> 4) * 4;
      uint2 o;
      o.x = pack2(acc[i][j][0], acc[i][j][1]);
      o.y = pack2(acc[i][j][2], acc[i][j][3]);
      *(uint2*)(U + e * 128 + d) = o;
    }
  if (tid < 128) {
    float s = 0.f;
    for (int k = 0; k < 64; ++k) s += bf2f(skT[tid * 72 + k]);
    ((float*)(p.ws + WS_UN))[(size_t)item * 128 + tid] = s;
  }
  __syncthreads();
}

__device__ __forceinline__ void mlstm_convout_item(const Params& p, int l, int b) {
  const bf16* z = (const bf16*)(p.ws + WS_Z);
  for (int i = tidx(); i < 3 * 1024; i += 256) {
    const int j = i >> 10, ch = i & 1023;
    p.out[O_CVP + (((size_t)l * 4 + b) * 3 + j) * 1024 + ch] = bf2f(z[(size_t)(b * SEQ + SEQ - 3 + j) * ZC + C_QK + ch]);
  }
}

__device__ __forceinline__ void mlstm_sample_item(const Params& p, int l, int item, unsigned char* smem) {
  const int b = item >> 2, hh = item & 3;
  const int r0 = TP + b * 8;
  bf16* z = (bf16*)(p.ws + WS_Z);
  float* sq = (float*)smem;
  float* sk = sq + 1024;
  float* sv = sk + 1024;
  float* sh = sv + 1024;
  float* sint = sh + 1024;
  float* sa = sint + 2048;
  float* sqn = sa + 64;
  float* smt = sqn + 8;
  float* swi = smt + 8;
  float* swsel = swi + 8;
  float* sdm = swsel + 8;
  float* sdecay = sdm + 64;
  const int tid = tidx(), lane = tid & 63, wave = tid >> 6;
  {
    const int isk = tid >> 7, d = tid & 127, zc = isk * 512 + hh * 128 + d;
    const float* cw = p.conv_w + (size_t)l * 4 * 1024 + zc;
    const float cb = p.conv_b[l * 1024 + zc];
    float xp[11];
    const float* cs = p.st_conv + ((size_t)l * 128 + b) * 3 * 1024 + zc;
    xp[0] = cs[0]; xp[1] = cs[1024]; xp[2] = cs[2048];
#pragma unroll
    for (int t = 0; t < 8; ++t) xp[3 + t] = bf2f(z[(size_t)(r0 + t) * ZC + C_QK + zc]);
    const float w0 = cw[0], w1 = cw[1024], w2 = cw[2048], w3 = cw[3072];
    float* dst = isk ? sk : sq;
    const float sc = isk ? 0.08838834764831845f : 1.0f;
#pragma unroll
    for (int t = 0; t < 8; ++t) {
      const float y = cb + w0 * xp[t] + w1 * xp[t + 1] + w2 * xp[t + 2] + w3 * xp[t + 3];
      dst[t * 128 + d] = siluf_(y) * sc;
    }
    float* co = p.out + O_CVS + ((size_t)l * 128 + b) * 3 * 1024 + zc;
    co[0] = xp[8]; co[1024] = xp[9]; co[2048] = xp[10];
  }
  for (int i = tid; i < 1024; i += 256) {
    const int t = i >> 7, e = i & 127;
    sv[i] = bf2f(z[(size_t)(r0 + t) * ZC + C_V + hh * 128 + e]);
  }
  if (tid == 0) {
    float cum[8], iv[8];
    float c = 0.f;
    for (int t = 0; t < 8; ++t) {
      const float f = bf2f(z[(size_t)(r0 + t) * ZC + C_F + hh]) + p.f_bias[l * 4 + hh];
      c += logsigmoidf_(f);
      cum[t] = c;
      iv[t] = bf2f(z[(size_t)(r0 + t) * ZC + C_I + hh]);
    }
    const float m0 = p.st_m[(l * 128 + b) * 4 + hh];
    for (int t = 0; t < 8; ++t) {
      float dmax = -INFINITY;
      for (int s = 0; s <= t; ++s) dmax = fmaxf(dmax, cum[t] - cum[s] + iv[s]);
      const float mi = cum[t] + m0, mt = fmaxf(mi, dmax);
      smt[t] = mt;
      swi[t] = __expf(mi - mt);
      for (int s = 0; s < 8; ++s) sdm[t * 8 + s] = (s <= t) ? __expf(cum[t] - cum[s] + iv[s] - mt) : 0.f;
    }
    const float total = cum[7];
    float gm = -INFINITY;
    for (int s = 0; s < 8; ++s) gm = fmaxf(gm, total - cum[s] + iv[s]);
    const float mn = fmaxf(total + m0, gm);
    for (int s = 0; s < 8; ++s) swsel[s] = __expf(total - cum[s] + iv[s] - mn);
    sdecay[0] = __expf(total + m0 - mn);
    p.out[O_MS + (l * 128 + b) * 4 + hh] = mn;
  }
  __syncthreads();
  const float* n0 = p.st_n + (((size_t)l * 128 + b) * 4 + hh) * 128;
  if (tid < 64) {
    const int t = tid >> 3, s = tid & 7;
    float dsum = 0.f;
    for (int d = 0; d < 128; ++d) dsum += sq[t * 128 + d] * sk[s * 128 + d];
    sa[t * 8 + s] = sdm[t * 8 + s] * dsum;
  } else if (tid < 128) {
    const int t = (tid - 64) >> 3, part = (tid - 64) & 7;
    float dsum = 0.f;
    for (int d = part * 16; d < part * 16 + 16; ++d) dsum += sq[t * 128 + d] * n0[d];
    dsum += __shfl_xor(dsum, 1); dsum += __shfl_xor(dsum, 2); dsum += __shfl_xor(dsum, 4);
    if (part == 0) sqn[t] = dsum;
  }
  __syncthreads();
  {
    const int e = tid & 127, dh = tid >> 7;
    const float decay = sdecay[0];
    const float* C0 = p.st_C + (((size_t)l * 128 + b) * 4 + hh) * 16384;
    float* C1 = p.out + O_CS + (((size_t)l * 128 + b) * 4 + hh) * 16384;
    float vw[8], inter[8];
#pragma unroll
    for (int s = 0; s < 8; ++s) { vw[s] = sv[s * 128 + e] * swsel[s]; inter[s] = 0.f; }
    for (int d = dh * 64; d < dh * 64 + 64; ++d) {
      const float c0 = C0[d * 128 + e];
      float upd = decay * c0;
#pragma unroll
      for (int s = 0; s < 8; ++s) {
        upd += sk[s * 128 + d] * vw[s];
        inter[s] += sq[s * 128 + d] * c0;
      }
      C1[d * 128 + e] = upd;
    }
#pragma unroll
    for (int t = 0; t < 8; ++t) sint[(dh * 8 + t) * 128 + e] = inter[t];
  }
  __syncthreads();
  if (tid < 128) {
    const int e = tid;
    for (int t = 0; t < 8; ++t) {
      float num = swi[t] * (sint[t * 128 + e] + sint[(8 + t) * 128 + e]);
      float den = swi[t] * sqn[t];
      for (int s = 0; s <= t; ++s) { num += sa[t * 8 + s] * sv[s * 128 + e]; den += sa[t * 8 + s]; }
      sh[t * 128 + e] = num / fmaxf(fabsf(den), __expf(-smt[t]));
    }
    float nn = sdecay[0] * n0[e];
    for (int s = 0; s < 8; ++s) nn += swsel[s] * sk[s * 128 + e];
    p.out[O_NS + (((size_t)l * 128 + b) * 4 + hh) * 128 + e] = nn;
  }
  __syncthreads();
  const float* hg = p.hnorm_g + l * 512 + hh * 128;
  for (int tt = 0; tt < 2; ++tt) {
    const int t = wave * 2 + tt;
    const float h0 = sh[t * 128 + lane], h1 = sh[t * 128 + 64 + lane];
    const float ss = wave_sum(h0 * h0 + h1 * h1);
    const float rstd = rsqrtf(ss * (1.0f / 128.f) + EPS);
    bf16* zr = z + (size_t)(r0 + t) * ZC;
#pragma unroll
    for (int k = 0; k < 2; ++k) {
      const int e = lane + 64 * k;
      const float hv = k ? h1 : h0;
      const float o = bf2f(zr[C_O + hh * 128 + e]), cg_ = bf2f(zr[C_G + hh * 128 + e]);
      zr[C_O + hh * 128 + e] = f2bf(hv * rstd * hg[e] * sigmoidf_(o) * siluf_(cg_));
    }
  }
  __syncthreads();
}

__device__ __forceinline__ void phase_mix1(const Params& p, int l, unsigned char* smem) {
  constexpr int N_LOC = 1024, N_SMP = 512, N_CV = 4;
  constexpr int N_ALL = N_LOC + N_SMP + N_CV;
  for (int it = blockIdx.x; it < N_ALL; it += gridDim.x) {
    int i = it;
    if (i < N_LOC) { mlstm_local_item(p, l, i, smem); continue; }
    i -= N_LOC;
    if (i < N_SMP) { mlstm_sample_item(p, l, i, smem); continue; }
    i -= N_SMP;
    mlstm_convout_item(p, l, i);
  }
}

__device__ __forceinline__ void phase_scan(const Params& p, int l, unsigned char* smem) {
  float* sdec = (float*)smem;
  float* ssc = sdec + 64;
  const int tid = tidx();
  float* Gb = (float*)(p.ws + WS_G);
  float* Tb = (float*)(p.ws + WS_TOT);
  float* Mb = (float*)(p.ws + WS_M);
  for (int it = blockIdx.x; it < 256; it += gridDim.x) {
    const int bh = it >> 4, slice = it & 15;
    if (tid < 64) { sdec[128 + tid] = Gb[bh * 64 + tid]; sdec[192 + tid] = Tb[bh * 64 + tid]; }
    __syncthreads();
    if (tid == 0) {
      float m = 0.f;
      for (int c = 0; c < 64; ++c) {
        const float G = sdec[128 + c], tot = sdec[192 + c];
        const float mn = fmaxf(tot + m, G);
        sdec[c] = __expf(tot + m - mn);
        ssc[c] = __expf(G - mn);
        if (slice == 0) Mb[bh * 64 + c] = m;
        m = mn;
      }
      if (slice == 0) p.out[O_MP + l * 16 + bh] = m;
    }
    __syncthreads();
    {
      const int idx = slice * 1024 + tid * 4;
      bf16* U = (bf16*)(p.ws + WS_U) + (size_t)bh * 64 * 16384 + idx;
      float st[4] = {0.f, 0.f, 0.f, 0.f};
#pragma unroll 8
      for (int c = 0; c < 64; ++c) {
        float u[4];
        unpack4(*(const uint2*)(U + (size_t)c * 16384), u);
        uint2 o;
        o.x = pack2(st[0], st[1]); o.y = pack2(st[2], st[3]);
        *(uint2*)(U + (size_t)c * 16384) = o;
        const float dc = sdec[c], sc = ssc[c];
#pragma unroll
        for (int x = 0; x < 4; ++x) st[x] = dc * st[x] + sc * u[x];
      }
      const int e = idx >> 7, d0 = idx & 127;
      float* Co = p.out + O_CP + ((size_t)l * 16 + bh) * 16384;
#pragma unroll
      for (int x = 0; x < 4; ++x) Co[(d0 + x) * 128 + e] = st[x];
    }
    if (slice == 0 && tid < 128) {
      float* un = (float*)(p.ws + WS_UN) + (size_t)bh * 64 * 128 + tid;
      float n = 0.f;
#pragma unroll 8
      for (int c = 0; c < 64; ++c) {
        const float u = un[c * 128];
        un[c * 128] = n;
        n = sdec[c] * n + ssc[c] * u;
      }
      p.out[O_NP + ((size_t)l * 16 + bh) * 128 + tid] = n;
    }
    __syncthreads();
  }
}

__device__ __forceinline__ void mlstm_out_item(const Params& p, int l, int item, unsigned char* smem) {
  const int bh = item >> 6, c = item & 63, b = bh >> 2, hh = bh & 3;
  const int r0 = b * SEQ + c * 64;
  bf16* z = (bf16*)(p.ws + WS_Z);
  bf16* sq = (bf16*)smem;
  bf16* sk = (bf16*)(smem + 17408);
  bf16* svT = (bf16*)(smem + 34816);
  bf16* sa = (bf16*)(smem + 53248);
  float* scum = (float*)(smem + 62464);
  float* siv = scum + 64;
  float* smt = siv + 64;
  float* swi = smt + 64;
  float* sden = swi + 64;
  float* sqn = sden + 64;
  float* spart = sqn + 64;
  const int tid = tidx(), lane = tid & 63, wave = tid >> 6;
  const int r16 = lane & 15, g4 = lane >> 4;
  if (wave == 0) {
    float cum, iv;
    chunk_gates(p, l, z, r0, hh, lane, cum, iv);
    scum[lane] = cum;
    siv[lane] = iv;
  }
  for (int i = tid; i < 1024; i += 256) {
    const int s = i >> 4, d8 = (i & 15) * 8;
    *(uint4*)(sk + s * 136 + d8) = *(const uint4*)((const bf16*)(p.ws + WS_H) + (size_t)(r0 + s) * 512 + hh * 128 + d8);
  }
  for (int i = tid; i < 1024; i += 256) {
    const int s = i >> 4, d8 = (i & 15) * 8;
    float y[8];
    conv8_prompt(p, l, z, r0, c * 64, s, hh * 128 + d8, y);
    uint4 o;
    o.x = pack2(y[0], y[1]); o.y = pack2(y[2], y[3]);
    o.z = pack2(y[4], y[5]); o.w = pack2(y[6], y[7]);
    *(uint4*)(sq + s * 136 + d8) = o;
  }
  for (int i = tid; i < 1024; i += 256) {
    const int s = i >> 4, d8 = (i & 15) * 8;
    float v[8];
    unpack8(*(const uint4*)(z + (size_t)(r0 + s) * ZC + C_V + hh * 128 + d8), v);
#pragma unroll
    for (int j = 0; j < 8; ++j) svT[(d8 + j) * 72 + (s ^ (((d8 >> 3) & 7) << 3))] = f2bf(v[j]);
  }
  __syncthreads();
  const float m_prev = ((const float*)(p.ws + WS_M))[item];
  {
    const int t = wave * 16 + r16;
    bf16x8 qf[4];
#pragma unroll
    for (int ks = 0; ks < 4; ++ks) qf[ks] = *(const bf16x8*)(sq + t * 136 + ks * 32 + g4 * 8);
    f32x4 st[4];
#pragma unroll
    for (int kt = 0; kt < 4; ++kt) {
      st[kt] = (f32x4){0.f, 0.f, 0.f, 0.f};
#pragma unroll
      for (int ks = 0; ks < 4; ++ks) {
        const bf16x8 kf = *(const bf16x8*)(sk + (kt * 16 + r16) * 136 + ks * 32 + g4 * 8);
        st[kt] = mfma16(kf, qf[ks], st[kt]);
      }
    }
    const float cumt = scum[t];
    float dm[4][4];
    float rmax = -INFINITY;
#pragma unroll
    for (int kt = 0; kt < 4; ++kt)
#pragma unroll
      for (int x = 0; x < 4; ++x) {
        const int s = kt * 16 + g4 * 4 + x;
        dm[kt][x] = (s <= t) ? (cumt - scum[s] + siv[s]) : -INFINITY;
        rmax = fmaxf(rmax, dm[kt][x]);
      }
    rmax = fmaxf(rmax, __shfl_xor(rmax, 16)); rmax = fmaxf(rmax, __shfl_xor(rmax, 32));
    const float mi = cumt + m_prev, mt = fmaxf(mi, rmax);
    float rsum = 0.f;
#pragma unroll
    for (int kt = 0; kt < 4; ++kt) {
      float a[4];
#pragma unroll
      for (int x = 0; x < 4; ++x) {
        const int s = kt * 16 + g4 * 4 + x;
        a[x] = (s <= t) ? __expf(dm[kt][x] - mt) * st[kt][x] : 0.f;
        rsum += a[x];
      }
      uint2 o;
      o.x = pack2(a[0], a[1]); o.y = pack2(a[2], a[3]);
      *(uint2*)(sa + t * 72 + kt * 16 + g4 * 4) = o;
    }
    rsum += __shfl_xor(rsum, 16); rsum += __shfl_xor(rsum, 32);
    if (g4 == 0) { smt[t] = mt; swi[t] = __expf(mi - mt); sden[t] = rsum; }
  }
  {
    const int t = tid >> 2, part = tid & 3;
    const float* nc = (const float*)(p.ws + WS_UN) + (size_t)item * 128;
    float s = 0.f;
    for (int d = part * 32; d < part * 32 + 32; ++d) s += bf2f(sq[t * 136 + d]) * nc[d];
    s += __shfl_xor(s, 1); s += __shfl_xor(s, 2);
    if (part == 0) sqn[t] = s;
  }
  __syncthreads();
  f32x4 acc[4][2];
#pragma unroll
  for (int ti = 0; ti < 4; ++ti)
#pragma unroll
    for (int et = 0; et < 2; ++et) acc[ti][et] = (f32x4){0.f, 0.f, 0.f, 0.f};
  const bf16* Cc = (const bf16*)(p.ws + WS_U) + (size_t)item * 16384;
#pragma unroll
  for (int ks = 0; ks < 4; ++ks) {
    bf16x8 cf[2], qf[4];
#pragma unroll
    for (int et = 0; et < 2; ++et) cf[et] = *(const bf16x8*)(Cc + (wave * 32 + et * 16 + r16) * 128 + ks * 32 + g4 * 8);
#pragma unroll
    for (int ti = 0; ti < 4; ++ti) qf[ti] = *(const bf16x8*)(sq + (ti * 16 + r16) * 136 + ks * 32 + g4 * 8);
#pragma unroll
    for (int ti = 0; ti < 4; ++ti)
#pragma unroll
      for (int et = 0; et < 2; ++et) acc[ti][et] = mfma16(cf[et], qf[ti], acc[ti][et]);
  }
#pragma unroll
  for (int ti = 0; ti < 4; ++ti) {
    const float w = swi[ti * 16 + r16];
#pragma unroll
    for (int et = 0; et < 2; ++et) acc[ti][et] *= w;
  }
#pragma unroll
  for (int ks = 0; ks < 2; ++ks) {
    bf16x8 vf[2], af[4];
#pragma unroll
    for (int et = 0; et < 2; ++et) vf[et] = *(const bf16x8*)(svT + (wave * 32 + et * 16 + r16) * 72 + ((ks * 32 + g4 * 8) ^ (((wave * 4 + et * 2 + (r16 >> 3)) & 7) << 3)));
#pragma unroll
    for (int ti = 0; ti < 4; ++ti) af[ti] = *(const bf16x8*)(sa + (ti * 16 + r16) * 72 + ks * 32 + g4 * 8);
#pragma unroll
    for (int ti = 0; ti < 4; ++ti)
#pragma unroll
      for (int et = 0; et < 2; ++et) acc[ti][et] = mfma16(vf[et], af[ti], acc[ti][et]);
  }
#pragma unroll
  for (int ti = 0; ti < 4; ++ti) {
    const int t = ti * 16 + r16;
    const float den = sden[t] + swi[t] * sqn[t];
    const float inv = 1.0f / fmaxf(fabsf(den), __expf(-smt[t]));
    float ss = 0.f;
#pragma unroll
    for (int et = 0; et < 2; ++et) {
      acc[ti][et] *= inv;
#pragma unroll
      for (int x = 0; x < 4; ++x) ss += acc[ti][et][x] * acc[ti][et][x];
    }
    ss += __shfl_xor(ss, 16); ss += __shfl_xor(ss, 32);
    if (g4 == 0) spart[t * 4 + wave] = ss;
  }
  __syncthreads();
  const float* hg = p.hnorm_g + l * 512 + hh * 128;
#pragma unroll
  for (int ti = 0; ti < 4; ++ti) {
    const int t = ti * 16 + r16;
    const float rstd = rsqrtf((spart[t * 4] + spart[t * 4 + 1] + spart[t * 4 + 2] + spart[t * 4 + 3]) * (1.0f / 128.f) + EPS);
    bf16* zr = z + (size_t)(r0 + t) * ZC;
#pragma unroll
    for (int et = 0; et < 2; ++et) {
      const int e = wave * 32 + et * 16 + g4 * 4;
      float o[4], cg_[4];
      unpack4(*(const uint2*)(zr + C_O + hh * 128 + e), o);
      unpack4(*(const uint2*)(zr + C_G + hh * 128 + e), cg_);
      float y[4];
#pragma unroll
      for (int x = 0; x < 4; ++x) y[x] = acc[ti][et][x] * rstd * hg[e + x] * sigmoidf_(o[x]) * siluf_(cg_[x]);
      uint2 oo;
      oo.x = pack2(y[0], y[1]); oo.y = pack2(y[2], y[3]);
      *(uint2*)(zr + C_O + hh * 128 + e) = oo;
    }
  }
  __syncthreads();
}

__device__ __forceinline__ void phase_mix2(const Params& p, int l, unsigned char* smem) {
  for (int it = blockIdx.x; it < 1024; it += gridDim.x) mlstm_out_item(p, l, it, smem);
}

template <int NI>
__device__ __forceinline__ void br_tile(const Params& p, int l, int m0, int n0, bf16* sm) {
  const bf16* Wbr = (const bf16*)(p.ws + WS_WBR) + (size_t)l * 1024 * 1536;
  const bf16* yab = (const bf16*)(p.ws + WS_YAB);
  const bf16* z = (const bf16*)(p.ws + WS_Z);
  bf16* merged = (bf16*)(p.ws + WS_U);
  const float* bias = p.b_in + (size_t)l * ZIN + OFF_MG;
  const int lane = tidx() & 63, wave = tidx() >> 6, wr = wave >> 1, wc = wave & 1;
#pragma unroll 1
  for (int seg = 0; seg < 3; ++seg) {
    f32x4 acc[4][NI];
    zero_acc<NI>(acc);
    gemm_accum_f8<NI>(acc, p.ws + WS_H8 + (size_t)m0 * 1024, p.ws + WS_W8 + ((size_t)l * W8_ROWS + (OFF_MG - W8_ROW0) + seg * 1024 + n0) * 1024, sm);
    unsigned gp[4][NI][2];
#pragma unroll
    for (int j = 0; j < NI; ++j) {
      const int col = n0 + wc * (16 * NI) + j * 16 + (lane >> 4) * 4;
      const float4 bb = *(const float4*)(bias + seg * 1024 + col);
#pragma unroll
      for (int i = 0; i < 4; ++i) {
        gp[i][j][0] = pack2(sigmoidf_(acc[i][j][0] * 0.015625f + bb.x), sigmoidf_(acc[i][j][1] * 0.015625f + bb.y));
        gp[i][j][1] = pack2(sigmoidf_(acc[i][j][2] * 0.015625f + bb.z), sigmoidf_(acc[i][j][3] * 0.015625f + bb.w));
      }
    }
    zero_acc<NI>(acc);
    const bf16* A = (seg == 0) ? yab + (size_t)m0 * 1024 : (seg == 1) ? yab + (size_t)m0 * 1024 + 512 : z + (size_t)m0 * ZC + C_O;
    const int lda = (seg == 2) ? ZC : 1024;
    gemm_accum<NI, (NI >= 2)>(acc, A, lda, Wbr + (size_t)n0 * 1536 + seg * 512, 1536, 512, sm);
#pragma unroll
    for (int i = 0; i < 4; ++i)
#pragma unroll
      for (int j = 0; j < NI; ++j) {
        const int row = m0 + wr * 64 + i * 16 + (lane & 15), col = n0 + wc * (16 * NI) + j * 16 + (lane >> 4) * 4;
        uint2* mp = (uint2*)(merged + (size_t)row * 1024 + col);
        uint2 prev = make_uint2(0u, 0u);
        if (seg > 0) prev = *mp;
        uint2 o;
        o.x = pack2(lo2f(prev.x) + lo2f(gp[i][j][0]) * acc[i][j][0], hi2f(prev.x) + hi2f(gp[i][j][0]) * acc[i][j][1]);
        o.y = pack2(lo2f(prev.y) + lo2f(gp[i][j][1]) * acc[i][j][2], hi2f(prev.y) + hi2f(gp[i][j][1]) * acc[i][j][3]);
        *mp = o;
      }
  }
}
__device__ __forceinline__ void phase_gemm_br(const Params& p, int l, unsigned char* smem) {
  bf16* sm = (bf16*)smem;
  const int ntiles = (TT / 128) * 8;
  const int nfull = (ntiles / (int)gridDim.x) * (int)gridDim.x;
  for (int t = blockIdx.x; t < nfull; t += gridDim.x) {
    int pm, pn;
    tile_map(t, 8, pm, pn);
    br_tile<4>(p, l, pm * 128, pn * 128, sm);
  }
  for (int u = blockIdx.x; u < 4 * (ntiles - nfull); u += gridDim.x) {
    int pm, pn;
    tile_map(nfull + (u >> 2), 8, pm, pn);
    br_tile<1>(p, l, pm * 128, pn * 128 + (u & 3) * 32, sm);
  }
}

template <int NI>
__device__ __forceinline__ void out_tile(const Params& p, int l, int m0, int n0, bf16* sm) {
  const bf16* merged = (const bf16*)(p.ws + WS_U);
  const bf16* Wout = (const bf16*)(p.ws + WS_WOUT) + (size_t)l * 1024 * 1024;
  const float* mod = (const float*)(p.ws + WS_MOD);
  const int lane = tidx() & 63, wave = tidx() >> 6, wr = wave >> 1, wc = wave & 1;
  f32x4 acc[4][NI];
  zero_acc<NI>(acc);
  gemm_accum<NI>(acc, merged + (size_t)m0 * 1024, 1024, Wout + (size_t)n0 * 1024, 1024, 1024, sm);
#pragma unroll
  for (int i = 0; i < 4; ++i) {
    const int row = m0 + wr * 64 + i * 16 + (lane & 15);
    const float* xr = xrow_ptr(p, l, row);
    const float* gate = mod + ((size_t)l * NMOD + mod_row(row)) * 3072 + 2048;
#pragma unroll
    for (int j = 0; j < NI; ++j) {
      const int col = n0 + wc * (16 * NI) + j * 16 + (lane >> 4) * 4;
      const float4 xv = *(const float4*)(xr + col), gv = *(const float4*)(gate + col);
      float4 o;
      o.x = xv.x + gv.x * acc[i][j][0]; o.y = xv.y + gv.y * acc[i][j][1];
      o.z = xv.z + gv.z * acc[i][j][2]; o.w = xv.w + gv.w * acc[i][j][3];
      *(float4*)(p.out + (size_t)row * D + col) = o;
    }
  }
}
__device__ __forceinline__ void phase_gemm_out(const Params& p, int l, unsigned char* smem) {
  bf16* sm = (bf16*)smem;
  const int ntiles = (TT / 128) * 8;
  const int nfull = (ntiles / (int)gridDim.x) * (int)gridDim.x;
  for (int t = blockIdx.x; t < nfull; t += gridDim.x) {
    int pm, pn;
    tile_map(t, 8, pm, pn);
    out_tile<4>(p, l, pm * 128, pn * 128, sm);
  }
  for (int u = blockIdx.x; u < 4 * (ntiles - nfull); u += gridDim.x) {
    int pm, pn;
    tile_map(nfull + (u >> 2), 8, pm, pn);
    out_tile<1>(p, l, pm * 128, pn * 128 + (u & 3) * 32, sm);
  }
}

constexpr int N_PHASES = 19;
template <int S>
__device__ __forceinline__ void run_stage(const Params& p, int l, unsigned char* smem) {
  if (S == -1) phase_prep(p, smem);
  if (S == 0) phase_norm(p, l);
  if (S == 1) phase_gemm_in(p, l, 0, ZAB / 128, ZAB, smem);
  if (S == 2) phase_mix_ab(p, l, smem);
  if (S == 3) phase_gemm_in(p, l, ZAB, ZC / 128, ZC, smem);
  if (S == 4) phase_mix1(p, l, smem);
  if (S == 5) phase_scan(p, l, smem);
  if (S == 6) phase_mix2(p, l, smem);
  if (S == 7) phase_gemm_br(p, l, smem);
  if (S == 8) phase_gemm_out(p, l, smem);
}


#define XB_TMO      128
#define XB_XCNT(j)  (256  + 64 * (j))
#define XB_XSUB(j)  (1280 + 64 * (j))
#define XB_XGEN(j)  (2304 + 64 * (j))
#define XB_TOP      3328
#define XB_TOPGEN   3392
#define XCD_BAR_WORDS 3456
#define XB_SPIN_CAP (1u << 18)
#define LAS __attribute__((address_space(3)))
__device__ __forceinline__ unsigned xb_ld(unsigned* p)              { return __hip_atomic_load(p, __ATOMIC_RELAXED, __HIP_MEMORY_SCOPE_AGENT); }
__device__ __forceinline__ unsigned xb_add(unsigned* p, unsigned v) { return __hip_atomic_fetch_add(p, v, __ATOMIC_RELAXED, __HIP_MEMORY_SCOPE_AGENT); }
__device__ __forceinline__ unsigned xb_xcc_id() { return (unsigned)__builtin_amdgcn_s_getreg((3 << 11) | 20) & 0xFu; }
#define XB_SPIN(cond, bar) do { unsigned _sp = 0; while (cond) { __builtin_amdgcn_s_sleep(1); \
    if ((++_sp & 255u) == 0u) { if (xb_ld(&(bar)[XB_TMO])) break; if (_sp > XB_SPIN_CAP) { atomicAdd(&(bar)[XB_TMO], 1u); break; } } } } while (0)
struct XcdBarrier { unsigned* bar; unsigned x; volatile LAS unsigned* st; };
__device__ __forceinline__ XcdBarrier xcd_barrier_post(unsigned* bar, volatile LAS unsigned* st) {
  XcdBarrier b; b.bar = bar; b.x = xb_xcc_id(); b.st = st;
  if (threadIdx.x == 0) (void)xb_add(&bar[XB_XCNT(b.x)], 1u);
  return b;
}
__device__ __forceinline__ void xcd_barrier_complete(unsigned* bar, unsigned x, unsigned& nloc, unsigned& nx) {
  const unsigned G = gridDim.x * gridDim.y * gridDim.z;
  unsigned sum, cnt, mine, sp = 0u;
  for (;;) {
    sum = 0u; cnt = 0u; mine = 0u;
#pragma unroll
    for (unsigned j = 0; j < 16; ++j) { const unsigned c = xb_ld(&bar[XB_XCNT(j)]); sum += c; cnt += (c > 0u) ? 1u : 0u; mine = (j == x) ? c : mine; }
    if (sum == G) break;
    __builtin_amdgcn_s_sleep(1);
    if ((++sp & 255u) == 0u) { if (xb_ld(&bar[XB_TMO])) break; if (sp > XB_SPIN_CAP) { atomicAdd(&bar[XB_TMO], 1u); break; } }
  }
  nloc = mine > 0u ? mine : 1u; nx = cnt > 0u ? cnt : 1u;
}
__device__ __forceinline__ void xcd_barrier(const XcdBarrier& b) {
  asm volatile("s_waitcnt vmcnt(0)" ::: "memory");
  __syncthreads();
  if (threadIdx.x == 0) {
    unsigned* bar = b.bar;
    __builtin_amdgcn_s_waitcnt(0);
    unsigned nloc = b.st[0], nx = b.st[1];
    if (nloc == 0u) { xcd_barrier_complete(bar, b.x, nloc, nx); b.st[0] = nloc; b.st[1] = nx; }
    const unsigned old = xb_add(&bar[XB_XSUB(b.x)], 1u);
    const unsigned gen = old / nloc;
    if (old + 1u == (gen + 1u) * nloc) {
      __builtin_amdgcn_fence(__ATOMIC_RELEASE, "agent");
      asm volatile("s_waitcnt vmcnt(0)" ::: "memory");
      const unsigned og = xb_add(&bar[XB_TOP], 1u);
      const unsigned tg = og / nx;
      if (og + 1u == (tg + 1u) * nx) xb_add(&bar[XB_TOPGEN], 1u);
      else XB_SPIN(xb_ld(&bar[XB_TOPGEN]) == tg, bar);
      __builtin_amdgcn_fence(__ATOMIC_ACQUIRE, "agent");
      xb_add(&bar[XB_XGEN(b.x)], 1u);
      asm volatile("s_waitcnt vmcnt(0)" ::: "memory");
    } else {
      XB_SPIN(xb_ld(&bar[XB_XGEN(b.x)]) == gen, bar);
      __builtin_amdgcn_fence(__ATOMIC_ACQUIRE, "agent");
      asm volatile("s_waitcnt vmcnt(0)" ::: "memory");
    }
  }
  __syncthreads();
}

#define GSYNC() xcd_barrier(xb)
__global__ void __launch_bounds__(256, 2) mega_kernel(Params p_in) {
  __shared__ __attribute__((aligned(16))) unsigned char smem[SMEM_BYTES];
  const Params& p = *(const Params*)__builtin_amdgcn_kernarg_segment_ptr();
  __shared__ uint4 xb_words;
  if (threadIdx.x == 0) xb_words = make_uint4(0u, 0u, 0u, 0u);
  __syncthreads();
  XcdBarrier xb = xcd_barrier_post((unsigned*)(p.ws + WS_BAR), (volatile LAS unsigned*)&xb_words);
  run_stage<-1>(p, 0, smem);
  if (p.out == nullptr) cg::this_grid().sync();
  GSYNC();
#define LAYER(L, LAST)                 \
  run_stage<0>(p, L, smem); GSYNC();   \
  run_stage<1>(p, L, smem); GSYNC();   \
  run_stage<2>(p, L, smem); GSYNC();   \
  run_stage<3>(p, L, smem); GSYNC();   \
  run_stage<4>(p, L, smem); GSYNC();   \
  run_stage<5>(p, L, smem); GSYNC();   \
  run_stage<6>(p, L, smem); GSYNC();   \
  run_stage<7>(p, L, smem); GSYNC();   \
  run_stage<8>(p, L, smem);            \
  if (!LAST) GSYNC();
  int l0 = 0, l1 = 1;
  asm volatile("" : "+s"(l0));
  asm volatile("" : "+s"(l1));
  LAYER(l0, 0)
  LAYER(l1, 1)
}

extern "C" void kernel_launch(void* const* d_in, const int* in_sizes, int n_in, void* d_out, int out_size, void* d_ws,
                              size_t ws_size, hipStream_t stream) {
  if (ws_size < WS_END || n_in < 29) { fprintf(stderr, "workspace too small / bad inputs\n"); return; }
  Params p{};
  const float** f = (const float**)&p;
  for (int i = 0; i < 29; ++i) f[i] = (const float*)d_in[i];
  p.out = (float*)d_out;
  p.ws = (unsigned char*)d_ws;
  static int grid_blocks = 0;
  if (!grid_blocks) {
    int dev = 0, cus = 0, per_cu = 0;
    (void)hipGetDevice(&dev);
    (void)hipDeviceGetAttribute(&cus, hipDeviceAttributeMultiprocessorCount, dev);
    (void)hipOccupancyMaxActiveBlocksPerMultiprocessor(&per_cu, mega_kernel, 256, 0);
    if (per_cu < 1) per_cu = 1;
    if (per_cu > 2) per_cu = 2;
    grid_blocks = cus * per_cu;
  }
  (void)hipMemsetAsync((unsigned char*)d_ws + WS_BAR, 0, 16384, stream);
  void* args[] = {&p};
  hipError_t e = hipLaunchCooperativeKernel((void*)mega_kernel, dim3(grid_blocks), dim3(256), args, 0, stream);
  if (e != hipSuccess) fprintf(stderr, "cooperative launch failed: %s (grid %d)\n", hipGetErrorString(e), grid_blocks);
}
```

```cpp
#include <hip/hip_runtime.h>
#include <hip/hip_cooperative_groups.h>
#include <cstdio>
namespace cg = cooperative_groups;

typedef unsigned short bf16;
typedef short bf16x8 __attribute__((ext_vector_type(8)));
typedef float f32x4 __attribute__((ext_vector_type(4)));
typedef unsigned u32x4 __attribute__((ext_vector_type(4)));
#define LDSP __attribute__((address_space(3)))

#ifndef SINGLE_LAUNCH
#define SINGLE_LAUNCH 0
#endif

constexpr int D = 1024, TP = 16384, TS = 1024, TT = TP + TS, SEQ = 4096;
constexpr int ZIN = 8456, NWIN = 8576;
constexpr int OFF_AV = 512, OFF_AG = 1024, OFF_BQ = 1536, OFF_BK = 2048, OFF_BV = 2176, OFF_BG = 2304, OFF_MG = 5384;
constexpr int ZAB = 2816;
constexpr int ZC = 2688;
constexpr int C_QK = 0, C_V = 1024, C_I = 1536, C_F = 1540, C_O = 1544, C_G = 2056;
constexpr float EPS = 1e-6f;
constexpr int NMOD = 132;
constexpr int SMEM_BYTES = 73728;

constexpr size_t O_Y = 0;
constexpr size_t O_SKP = (size_t)TT * D;
constexpr size_t O_SVP = O_SKP + 2 * 4 * 128 * 128;
constexpr size_t O_CVP = O_SVP + 2 * 4 * 128 * 128;
constexpr size_t O_CP = O_CVP + 2 * 4 * 3 * 1024;
constexpr size_t O_NP = O_CP + (size_t)2 * 4 * 4 * 128 * 128;
constexpr size_t O_MP = O_NP + 2 * 4 * 4 * 128;
constexpr size_t O_SKS = O_MP + 2 * 4 * 4;
constexpr size_t O_SVS = O_SKS + (size_t)2 * 128 * 128 * 128;
constexpr size_t O_CVS = O_SVS + (size_t)2 * 128 * 128 * 128;
constexpr size_t O_CS = O_CVS + (size_t)2 * 128 * 3 * 1024;
constexpr size_t O_NS = O_CS + (size_t)2 * 128 * 4 * 128 * 128;
constexpr size_t O_MS = O_NS + (size_t)2 * 128 * 4 * 128;
constexpr size_t O_GV = O_MS + 2 * 128 * 4;
constexpr size_t O_END = O_GV + (size_t)2 * 128 * 8 * 512;

constexpr size_t WS_WIN = 0;
constexpr size_t WS_WBR = WS_WIN + (size_t)2 * NWIN * 1024 * 2;
constexpr size_t WS_WOUT = WS_WBR + (size_t)2 * 1024 * 1536 * 2;
constexpr size_t WS_MOD = WS_WOUT + (size_t)2 * 1024 * 1024 * 2;
constexpr size_t WS_H = WS_MOD + (size_t)2 * NMOD * 3072 * 4;
constexpr size_t WS_YAB = WS_H + (size_t)TT * 1024 * 2;
constexpr size_t WS_U = WS_YAB + (size_t)TT * 1024 * 2;
constexpr size_t WS_UN = WS_U + (size_t)TT * 1024 * 2;
constexpr size_t WS_G = WS_UN + (size_t)1024 * 128 * 4;
constexpr size_t WS_TOT = WS_G + 4096;
constexpr size_t WS_M = WS_TOT + 4096;
constexpr size_t WS_Z = WS_M + 4096;
constexpr size_t WS_BAR = WS_Z + (size_t)TT * ZAB * 2;
constexpr size_t WS_H8 = WS_BAR + 16384;
constexpr int W8_ROW0 = 0, W8_ROWS = NWIN;
constexpr size_t WS_W8 = WS_H8 + (size_t)TT * 1024;
constexpr size_t WS_END = WS_W8 + (size_t)2 * W8_ROWS * 1024;

struct Params {
  const float *x_prompt, *x_sample, *cache_k, *cache_v, *st_conv, *st_C, *st_n, *st_m, *c_prompt, *c_sample;
  const float *ada_w, *ada_b, *norm_g, *w_in, *b_in, *vnorm_g, *gmlp_ws, *gmlp_bs, *qn_g, *kn_g, *sinks;
  const float *conv_w, *conv_b, *f_bias, *hnorm_g, *w_a, *w_b, *w_c, *w_out;
  float* out;
  unsigned char* ws;
};

__device__ __forceinline__ int tidx() { int t = threadIdx.x; asm volatile("" : "+v"(t)); return t; }
__device__ __forceinline__ bf16 f2bf(float f) {
  unsigned u = __float_as_uint(f);
  u += 0x7fffu + ((u >> 16) & 1u);
  return (bf16)(u >> 16);
}
__device__ __forceinline__ float bf2f(bf16 h) { return __uint_as_float(((unsigned)h) << 16); }
__device__ __forceinline__ unsigned pack2(float a, float b) { return (unsigned)f2bf(a) | ((unsigned)f2bf(b) << 16); }
__device__ __forceinline__ float lo2f(unsigned u) { return __uint_as_float(u << 16); }
__device__ __forceinline__ float hi2f(unsigned u) { return __uint_as_float(u & 0xffff0000u); }
__device__ __forceinline__ void unpack8(const uint4& v, float* f) {
  f[0] = lo2f(v.x); f[1] = hi2f(v.x); f[2] = lo2f(v.y); f[3] = hi2f(v.y);
  f[4] = lo2f(v.z); f[5] = hi2f(v.z); f[6] = lo2f(v.w); f[7] = hi2f(v.w);
}
__device__ __forceinline__ void unpack4(const uint2& v, float* f) {
  f[0] = lo2f(v.x); f[1] = hi2f(v.x); f[2] = lo2f(v.y); f[3] = hi2f(v.y);
}
__device__ __forceinline__ float sigmoidf_(float x) { return __builtin_amdgcn_rcpf(1.0f + __expf(-x)); }
__device__ __forceinline__ float siluf_(float x) { return x * __builtin_amdgcn_rcpf(1.0f + __expf(-x)); }
__device__ __forceinline__ float logsigmoidf_(float x) { return fminf(x, 0.0f) - log1pf(__expf(-fabsf(x))); }
__device__ __forceinline__ float wave_sum(float v) {
#pragma unroll
  for (int o = 32; o >= 1; o >>= 1) v += __shfl_xor(v, o);
  return v;
}
__device__ __forceinline__ float wave_max(float v) {
#pragma unroll
  for (int o = 32; o >= 1; o >>= 1) v = fmaxf(v, __shfl_xor(v, o));
  return v;
}
__device__ __forceinline__ f32x4 mfma16(bf16x8 a, bf16x8 b, f32x4 c) {
  return __builtin_amdgcn_mfma_f32_16x16x32_bf16(a, b, c, 0, 0, 0);
}
template <int MI, int NI, bool SWZA = false, bool SWZB = false>
__device__ __forceinline__ void mma_lds(f32x4 (&acc)[MI][NI], const bf16* sA, int lda, const bf16* sB, int ldb, int K, int lane) {
  const int r = lane & 15, q = (lane >> 4) * 8;
  for (int k0 = 0; k0 < K; k0 += 32) {
    bf16x8 a[MI], b[NI];
#pragma unroll
    for (int i = 0; i < MI; ++i) a[i] = *(const bf16x8*)(sA + (i * 16 + r) * lda + ((k0 + q) ^ (SWZA ? (((i * 2 + (r >> 3)) & 7) << 3) : 0)));
#pragma unroll
    for (int j = 0; j < NI; ++j) b[j] = *(const bf16x8*)(sB + (j * 16 + r) * ldb + ((k0 + q) ^ (SWZB ? (((j * 2 + (r >> 3)) & 7) << 3) : 0)));
#pragma unroll
    for (int i = 0; i < MI; ++i)
#pragma unroll
      for (int j = 0; j < NI; ++j) acc[i][j] = mfma16(b[j], a[i], acc[i][j]);
  }
}

constexpr int GLD = 64;
constexpr int GTILE = 128 * GLD;
template <int NI>
__device__ __forceinline__ void g_load(u32x4 (&ra)[4], u32x4 (&rb)[NI], const bf16* __restrict__ A, int lda, const bf16* __restrict__ B, int ldb, int ko, int tid) {
  const unsigned offA = (unsigned)((tid >> 3) * lda + (tid & 7) * 8), offB = (unsigned)((tid >> 3) * ldb + (tid & 7) * 8);
#pragma unroll
  for (int i = 0; i < 4; ++i) {
    const bf16* Ai = A + (size_t)(i * 32) * lda + ko;
    ra[i] = *(const u32x4*)(Ai + offA);
  }
#pragma unroll
  for (int i = 0; i < NI; ++i) {
    const bf16* Bi = B + (size_t)(i * 32) * ldb + ko;
    rb[i] = *(const u32x4*)(Bi + offB);
  }
}
template <int NI>
__device__ __forceinline__ void g_store(const u32x4 (&ra)[4], const u32x4 (&rb)[NI], bf16* buf, int tid) {
  const int off = (tid >> 3) * GLD + (((tid & 7) ^ ((tid >> 3) & 7)) * 8);
#pragma unroll
  for (int i = 0; i < 4; ++i) *(u32x4*)(buf + off + i * 32 * GLD) = ra[i];
#pragma unroll
  for (int i = 0; i < NI; ++i) *(u32x4*)(buf + GTILE + off + i * 32 * GLD) = rb[i];
}
template <int NI, bool LOWREG = false>
__device__ __forceinline__ void g_compute(f32x4 (&acc)[4][NI], const bf16* cur, int wr, int wc, int lane) {
  const int r16 = lane & 15, sw = lane & 7, q = lane >> 4;
#pragma unroll
  for (int ks = 0; ks < 2; ++ks) {
    const int pc = ((ks * 4 + q) ^ sw) * 8;
    bf16x8 a[4];
#pragma unroll
    for (int i = 0; i < 4; ++i) a[i] = *(const bf16x8*)(cur + (wr * 64 + i * 16 + r16) * GLD + pc);
    constexpr int JW = (NI >= 2) ? 2 : 1;
#pragma unroll
    for (int jh = 0; jh < NI; jh += JW) {
      bf16x8 b[JW];
#pragma unroll
      for (int j = 0; j < JW; ++j) b[j] = *(const bf16x8*)(cur + GTILE + (wc * 16 * NI + (jh + j) * 16 + r16) * GLD + pc);
#pragma unroll
      for (int i = 0; i < 4; ++i)
#pragma unroll
        for (int j = 0; j < JW; ++j) acc[i][jh + j] = mfma16(b[j], a[i], acc[i][jh + j]);
      if (LOWREG) __builtin_amdgcn_sched_barrier(0);
    }
  }
}
template <int NI, bool F8SWZ = false>
__device__ __forceinline__ void g_stage(const bf16* __restrict__ A, int lda, const bf16* __restrict__ B, int ldb, int ko, bf16* buf, int tid) {
  const int wave = tid >> 6;
  const int lrow = tid >> 3;
  const int gch = ((tid & 7) ^ (F8SWZ ? ((lrow & 6) | ((lrow >> 3) & 1)) : (lrow & 7))) * 8;
  const unsigned offA = (unsigned)((tid >> 3) * lda + gch), offB = (unsigned)((tid >> 3) * ldb + gch);
#pragma unroll
  for (int i = 0; i < 4; ++i) {
    const bf16* Ai = A + (size_t)(i * 32) * lda + ko;
    __builtin_amdgcn_global_load_lds((const unsigned*)(Ai + offA), (LDSP unsigned*)(buf + (i * 32 + wave * 8) * GLD), 16, 0, 0);
  }
#pragma unroll
  for (int i = 0; i < NI; ++i) {
    const bf16* Bi = B + (size_t)(i * 32) * ldb + ko;
    __builtin_amdgcn_global_load_lds((const unsigned*)(Bi + offB), (LDSP unsigned*)(buf + GTILE + (i * 32 + wave * 8) * GLD), 16, 0, 0);
  }
}
template <int NI, bool LOWREG = false>
__device__ __forceinline__ void gemm_accum(f32x4 (&acc)[4][NI], const bf16* __restrict__ A, int lda,
                                           const bf16* __restrict__ B, int ldb, int K, bf16* sm) {
  const int tid = tidx(), lane = tid & 63, wave = tid >> 6, wr = wave >> 1, wc = wave & 1;
  const int nk = K >> 6;
  bf16* buf0 = sm;
  bf16* buf1 = sm + 2 * GTILE;
  g_stage<NI>(A, lda, B, ldb, 0, buf0, tid);
  asm volatile("s_waitcnt vmcnt(0)" ::: "memory");
  __syncthreads();
#pragma unroll 1
  for (int kt = 0; kt < nk; kt += 2) {
    g_stage<NI>(A, lda, B, ldb, (kt + 1) * 64, buf1, tid);
    g_compute<NI, LOWREG>(acc, buf0, wr, wc, lane);
    asm volatile("s_waitcnt vmcnt(0)" ::: "memory");
    __syncthreads();
    if (kt + 2 < nk) g_stage<NI>(A, lda, B, ldb, (kt + 2) * 64, buf0, tid);
    g_compute<NI, LOWREG>(acc, buf1, wr, wc, lane);
    asm volatile("s_waitcnt vmcnt(0)" ::: "memory");
    __syncthreads();
  }
}
typedef int i32x8 __attribute__((ext_vector_type(8)));
template <int NI>
__device__ __forceinline__ void g_compute_f8(f32x4 (&acc)[4][NI], const bf16* cur, int wr, int wc, int lane) {
  const int r16 = lane & 15, sw = (r16 & 6) | (r16 >> 3), q = lane >> 4;
  const int pc0 = ((2 * q) ^ sw) * 8, pc1 = ((2 * q + 1) ^ sw) * 8;
  i32x8 b[NI];
#pragma unroll
  for (int j = 0; j < NI; ++j) {
    const bf16* rp = cur + GTILE + (wc * 16 * NI + j * 16 + r16) * GLD;
    const u32x4 lo = *(const u32x4*)(rp + pc0), hi = *(const u32x4*)(rp + pc1);
    b[j] = (i32x8){(int)lo.x, (int)lo.y, (int)lo.z, (int)lo.w, (int)hi.x, (int)hi.y, (int)hi.z, (int)hi.w};
  }
#pragma unroll
  for (int i = 0; i < 4; ++i) {
    const bf16* rp = cur + (wr * 64 + i * 16 + r16) * GLD;
    const u32x4 lo = *(const u32x4*)(rp + pc0), hi = *(const u32x4*)(rp + pc1);
    const i32x8 a = (i32x8){(int)lo.x, (int)lo.y, (int)lo.z, (int)lo.w, (int)hi.x, (int)hi.y, (int)hi.z, (int)hi.w};
#pragma unroll
    for (int j = 0; j < NI; ++j)
      acc[i][j] = __builtin_amdgcn_mfma_scale_f32_16x16x128_f8f6f4(b[j], a, acc[i][j], 0, 0, 0, 0x7F7F7F7F, 0, 0x7F7F7F7F);
  }
}
template <int NI>
__device__ __forceinline__ void gemm_accum_f8(f32x4 (&acc)[4][NI], const unsigned char* __restrict__ A8, const unsigned char* __restrict__ B8, bf16* sm) {
  const int tid = tidx(), lane = tid & 63, wave = tid >> 6, wr = wave >> 1, wc = wave & 1;
  const bf16* A = (const bf16*)A8;
  const bf16* B = (const bf16*)B8;
  bf16* buf0 = sm;
  bf16* buf1 = sm + 2 * GTILE;
  g_stage<NI, true>(A, 512, B, 512, 0, buf0, tid);
  asm volatile("s_waitcnt vmcnt(0)" ::: "memory");
  __syncthreads();
#pragma unroll 1
  for (int kt = 0; kt < 8; kt += 2) {
    g_stage<NI, true>(A, 512, B, 512, (kt + 1) * 64, buf1, tid);
    g_compute_f8<NI>(acc, buf0, wr, wc, lane);
    asm volatile("s_waitcnt vmcnt(0)" ::: "memory");
    __syncthreads();
    if (kt + 2 < 8) g_stage<NI, true>(A, 512, B, 512, (kt + 2) * 64, buf0, tid);
    g_compute_f8<NI>(acc, buf1, wr, wc, lane);
    asm volatile("s_waitcnt vmcnt(0)" ::: "memory");
    __syncthreads();
  }
}
template <int NI>
__device__ __forceinline__ void zero_acc(f32x4 (&acc)[4][NI]) {
#pragma unroll
  for (int i = 0; i < 4; ++i)
#pragma unroll
    for (int j = 0; j < NI; ++j) acc[i][j] = (f32x4){0.f, 0.f, 0.f, 0.f};
}
__device__ __forceinline__ void tile_map(int t, int ntn, int& pm, int& pn) {
  const int grp = t / (8 * ntn), w = t % (8 * ntn);
  pm = grp * 8 + (w & 7);
  pn = w >> 3;
}

__device__ __forceinline__ void transpose_tile(const float* __restrict__ src, int ld_src, int n_valid, bf16* __restrict__ dst, int ld_dst,
                               int k0, int n0, int kdst0, float* sm, unsigned char* dst8 = nullptr) {
  const int tid = tidx();
  for (int i = tid; i < 64 * 16; i += 256) {
    const int kk = i >> 4, n4 = (i & 15) * 4, n = n0 + n4;
    float4 v = make_float4(0.f, 0.f, 0.f, 0.f);
    if (n + 3 < n_valid) v = *(const float4*)(src + (size_t)(k0 + kk) * ld_src + n);
    sm[kk * 65 + n4 + 0] = v.x; sm[kk * 65 + n4 + 1] = v.y; sm[kk * 65 + n4 + 2] = v.z; sm[kk * 65 + n4 + 3] = v.w;
  }
  __syncthreads();
  for (int i = tid; i < 64 * 8; i += 256) {
    const int nn = i >> 3, kc = (i & 7) * 8;
    uint4 o;
    o.x = pack2(sm[(kc + 0) * 65 + nn], sm[(kc + 1) * 65 + nn]);
    o.y = pack2(sm[(kc + 2) * 65 + nn], sm[(kc + 3) * 65 + nn]);
    o.z = pack2(sm[(kc + 4) * 65 + nn], sm[(kc + 5) * 65 + nn]);
    o.w = pack2(sm[(kc + 6) * 65 + nn], sm[(kc + 7) * 65 + nn]);
    *(uint4*)(dst + (size_t)(n0 + nn) * ld_dst + kdst0 + kc) = o;
    if (dst8 != nullptr) {
      uint2 q8;
      int t8 = __builtin_amdgcn_cvt_pk_fp8_f32(64.f * sm[(kc + 0) * 65 + nn], 64.f * sm[(kc + 1) * 65 + nn], 0, false);
      q8.x = (unsigned)__builtin_amdgcn_cvt_pk_fp8_f32(64.f * sm[(kc + 2) * 65 + nn], 64.f * sm[(kc + 3) * 65 + nn], t8, true);
      t8 = __builtin_amdgcn_cvt_pk_fp8_f32(64.f * sm[(kc + 4) * 65 + nn], 64.f * sm[(kc + 5) * 65 + nn], 0, false);
      q8.y = (unsigned)__builtin_amdgcn_cvt_pk_fp8_f32(64.f * sm[(kc + 6) * 65 + nn], 64.f * sm[(kc + 7) * 65 + nn], t8, true);
      *(uint2*)(dst8 + (size_t)(n0 + nn - W8_ROW0) * 1024 + kdst0 + kc) = q8;
    }
  }
  __syncthreads();
}

__device__ __forceinline__ void ada_item(const Params& p, int item, float* sm) {
  const int l = item / 192, n0 = (item % 192) * 16;
  const int tid = tidx(), col = tid & 15, rg = tid >> 4;
  constexpr int SLD = 68;
  float* sW = sm + 144 * SLD;
  float acc[9];
#pragma unroll
  for (int j = 0; j < 9; ++j) acc[j] = 0.f;
  const float* W = p.ada_w + (size_t)l * 1024 * 3072 + n0;
  const int wk = tid >> 2, wc4 = (tid & 3) * 4;
  float v[36];
  float4 w0;
#define ADA_LOAD(K0)                                                                                      \
  {                                                                                                       \
    _Pragma("unroll") for (int u = 0; u < 36; ++u) {                                                      \
      const int i = tid + 256 * u, r = i >> 6, kk = i & 63;                                               \
      v[u] = 0.f;                                                                                         \
      if (r < NMOD) v[u] = (r < 4) ? p.c_prompt[r * 1024 + (K0) + kk] : p.c_sample[(r - 4) * 1024 + (K0) + kk]; \
    }                                                                                                     \
    w0 = *(const float4*)(W + (size_t)((K0) + wk) * 3072 + wc4);                                          \
  }
#define ADA_STORE()                                                                                       \
  {                                                                                                       \
    _Pragma("unroll") for (int u = 0; u < 36; ++u) {                                                      \
      const int i = tid + 256 * u, r = i >> 6, kk = i & 63;                                               \
      sm[r * SLD + kk] = siluf_(v[u]);                                                                    \
    }                                                                                                     \
    *(float4*)(sW + wk * 16 + wc4) = w0;                                                                  \
  }
  ADA_LOAD(0)
  ADA_STORE()
  __syncthreads();
#pragma unroll 1
  for (int k0 = 0; k0 < 1024; k0 += 64) {
    if (k0 + 64 < 1024) ADA_LOAD(k0 + 64)
#pragma unroll 4
    for (int k4 = 0; k4 < 16; ++k4) {
      const float x0 = sW[(k4 * 4 + 0) * 16 + col], x1 = sW[(k4 * 4 + 1) * 16 + col];
      const float x2 = sW[(k4 * 4 + 2) * 16 + col], x3 = sW[(k4 * 4 + 3) * 16 + col];
#pragma unroll
      for (int j = 0; j < 9; ++j) {
        const float4 sv = *(const float4*)(sm + (rg * 9 + j) * SLD + k4 * 4);
        acc[j] += sv.x * x0 + sv.y * x1 + sv.z * x2 + sv.w * x3;
      }
    }
    __syncthreads();
    if (k0 + 64 < 1024) ADA_STORE()
    __syncthreads();
  }
#undef ADA_LOAD
#undef ADA_STORE
  float* mod = (float*)(p.ws + WS_MOD);
  const float b = p.ada_b[l * 3072 + n0 + col];
#pragma unroll
  for (int j = 0; j < 9; ++j) {
    const int r = rg * 9 + j;
    if (r < NMOD) mod[((size_t)l * NMOD + r) * 3072 + n0 + col] = acc[j] + b;
  }
}

__device__ __forceinline__ void phase_prep(const Params& p, unsigned char* smem) {
  float* sm = (float*)smem;
  constexpr int N_WIN = 2 * 16 * (NWIN / 64);
  constexpr int N_WBR = 2 * 3 * 8 * 16;
  constexpr int N_WOUT = 2 * 16 * 16;
  constexpr int N_ALL = N_WIN + N_WBR + N_WOUT;
  bf16* WinT = (bf16*)(p.ws + WS_WIN);
  bf16* WbrT = (bf16*)(p.ws + WS_WBR);
  bf16* WoutT = (bf16*)(p.ws + WS_WOUT);
  constexpr int N_ADA = 384;
  for (int it = blockIdx.x; it < N_ADA + N_ALL; it += gridDim.x) {
    if (it < N_ADA) { ada_item(p, it, sm); continue; }
    int i = it - N_ADA;
    if (i < N_WIN) {
      const int l = i / (16 * 134), r = i % (16 * 134), kt = r / 134, nt = r % 134;
      transpose_tile(p.w_in + (size_t)l * 1024 * ZIN, ZIN, ZIN, WinT + (size_t)l * NWIN * 1024, 1024, kt * 64, nt * 64, kt * 64, sm,
                     (nt * 64 >= W8_ROW0) ? p.ws + WS_W8 + (size_t)l * W8_ROWS * 1024 : nullptr);
      continue;
    }
    i -= N_WIN;
    if (i < N_WBR) {
      const int l = i / 384, r = i % 384, seg = r / 128, r2 = r % 128, kt = r2 / 16, nt = r2 % 16;
      const float* src = (seg == 0 ? p.w_a : seg == 1 ? p.w_b : p.w_c) + (size_t)l * 512 * 1024;
      transpose_tile(src, 1024, 1024, WbrT + (size_t)l * 1024 * 1536, 1536, kt * 64, nt * 64, seg * 512 + kt * 64, sm);
      continue;
    }
    i -= N_WBR;
    {
      const int l = i / 256, r = i % 256, kt = r / 16, nt = r % 16;
      transpose_tile(p.w_out + (size_t)l * 1024 * 1024, 1024, 1024, WoutT + (size_t)l * 1024 * 1024, 1024, kt * 64, nt * 64, kt * 64, sm);
    }
  }
}

__device__ __forceinline__ const float* xrow_ptr(const Params& p, int l, int row) {
  if (l == 0) return row < TP ? p.x_prompt + (size_t)row * D : p.x_sample + (size_t)(row - TP) * D;
  return p.out + (size_t)row * D;
}
__device__ __forceinline__ int mod_row(int row) { return row < TP ? (row >> 12) : 4 + ((row - TP) >> 3); }

__device__ __forceinline__ void phase_norm(const Params& p, int l) {
  const int lane = tidx() & 63, wave = tidx() >> 6;
  bf16* hbuf = (bf16*)(p.ws + WS_H);
  unsigned char* h8 = p.ws + WS_H8;
  const float* mod = (const float*)(p.ws + WS_MOD);
  const float* g = p.norm_g + l * D;
  for (int row = blockIdx.x * 4 + wave; row < TT; row += gridDim.x * 4) {
    const float4* x = (const float4*)xrow_ptr(p, l, row);
    float4 v[4];
    float ss = 0.f;
#pragma unroll
    for (int i = 0; i < 4; ++i) {
      v[i] = x[lane + 64 * i];
      ss += v[i].x * v[i].x + v[i].y * v[i].y + v[i].z * v[i].z + v[i].w * v[i].w;
    }
    ss = wave_sum(ss);
    const float rstd = rsqrtf(ss * (1.0f / D) + EPS);
    const float* mp = mod + ((size_t)l * NMOD + mod_row(row)) * 3072;
#pragma unroll
    for (int i = 0; i < 4; ++i) {
      const int c = (lane + 64 * i) * 4;
      const float4 gg = *(const float4*)(g + c), sh = *(const float4*)(mp + c), sc = *(const float4*)(mp + 1024 + c);
      uint2 o;
      o.x = pack2(v[i].x * rstd * gg.x * (1.f + sc.x) + sh.x, v[i].y * rstd * gg.y * (1.f + sc.y) + sh.y);
      o.y = pack2(v[i].z * rstd * gg.z * (1.f + sc.z) + sh.z, v[i].w * rstd * gg.w * (1.f + sc.w) + sh.w);
      *(uint2*)(hbuf + (size_t)row * D + c) = o;
      int p8 = __builtin_amdgcn_cvt_pk_fp8_f32(v[i].x * rstd * gg.x * (1.f + sc.x) + sh.x, v[i].y * rstd * gg.y * (1.f + sc.y) + sh.y, 0, false);
      p8 = __builtin_amdgcn_cvt_pk_fp8_f32(v[i].z * rstd * gg.z * (1.f + sc.z) + sh.z, v[i].w * rstd * gg.w * (1.f + sc.w) + sh.w, p8, true);
      *(int*)(h8 + (size_t)row * D + c) = p8;
    }
  }
}

__device__ __forceinline__ void phase_gemm_in(const Params& p, int l, int col0, int ntn, int ldz, unsigned char* smem) {
  bf16* sm = (bf16*)smem;
  const bf16* hbuf = (const bf16*)(p.ws + WS_H);
  const bf16* W = (const bf16*)(p.ws + WS_WIN) + (size_t)l * NWIN * 1024;
  bf16* z = (bf16*)(p.ws + WS_Z);
  const float* bias = p.b_in + (size_t)l * ZIN;
  const int tid = tidx(), lane = tid & 63, wave = tid >> 6, wr = wave >> 1, wc = wave & 1;
  const int ntiles = (TT / 128) * ntn;
  constexpr int OLD = 136;
  const bool isAB = (col0 == 0);
  const int nb = isAB ? 6 : 13;
  const int NB = (TT / 128) * nb;
  for (int t = blockIdx.x; t < ntiles; t += gridDim.x) {
    const bool f8 = t >= NB;
    int pm, pk;
    tile_map(f8 ? t - NB : t, f8 ? ntn - nb : nb, pm, pk);
    int pn;
    if (isAB) pn = f8 ? (pk < 4 ? pk : pk < 12 ? pk + 4 : pk + 6) : (pk < 4 ? 4 + pk : 12 + pk);
    else pn = f8 ? 13 + pk : pk;
    const int m0 = pm * 128, n0 = pn * 128;
    f32x4 acc[4][4];
    zero_acc<4>(acc);
    float osc = 1.0f;
    if (f8) {
      gemm_accum_f8<4>(acc, p.ws + WS_H8 + (size_t)m0 * 1024, p.ws + WS_W8 + ((size_t)l * W8_ROWS + col0 + n0) * 1024, sm);
      osc = 0.015625f;
    } else {
      gemm_accum<4>(acc, hbuf + (size_t)m0 * 1024, 1024, W + (size_t)(col0 + n0) * 1024, 1024, 1024, sm);
    }
#pragma unroll
    for (int j = 0; j < 4; ++j) {
      const int cl = wc * 64 + j * 16 + (lane >> 4) * 4;
      const float4 b = *(const float4*)(bias + col0 + n0 + cl);
#pragma unroll
      for (int i = 0; i < 4; ++i) {
        const int rl = wr * 64 + i * 16 + (lane & 15);
        uint2 o;
        o.x = pack2(acc[i][j][0] * osc + b.x, acc[i][j][1] * osc + b.y);
        o.y = pack2(acc[i][j][2] * osc + b.z, acc[i][j][3] * osc + b.w);
        *(uint2*)(sm + rl * OLD + cl) = o;
      }
    }
    __syncthreads();
#pragma unroll
    for (int it = 0; it < 8; ++it) {
      const int id = tid + 256 * it, row = id >> 4, ch = id & 15;
      const u32x4 v = *(const u32x4*)(sm + row * OLD + ch * 8);
      *(u32x4*)(z + (size_t)(m0 + row) * ldz + n0 + ch * 8) = v;
    }
    __syncthreads();
  }
}

__device__ __forceinline__ void gmlp_prompt_item(const Params& p, int l, int item, unsigned char* smem) {
  const int b = item >> 7, n = (item >> 2) & 31, g = item & 3;
  const int r0 = b * SEQ + n * 128;
  const bf16* z = (const bf16*)(p.ws + WS_Z);
  bf16* yab = (bf16*)(p.ws + WS_YAB);
  bf16* sW = (bf16*)smem;
  bf16* sV = (bf16*)(smem + 34816);
  float* srstd = (float*)(smem + 69632);
  const int tid = tidx(), lane = tid & 63, wave = tid >> 6, wr = wave >> 1, wc = wave & 1;
  {
    float myr = 0.f;
#pragma unroll 8
    for (int k = 0; k < 32; ++k) {
      const int tok = wave * 32 + k;
      float f[8];
      unpack8(*(const uint4*)(z + (size_t)(r0 + tok) * ZAB + OFF_AV + lane * 8), f);
      float ss = 0.f;
#pragma unroll
      for (int j = 0; j < 8; ++j) ss += f[j] * f[j];
      ss = wave_sum(ss);
      if (lane == k) myr = rsqrtf(ss * (1.0f / 512.f) + EPS);
    }
    if (lane < 32) srstd[wave * 32 + lane] = myr;
  }
  __syncthreads();
  const float* vg = p.vnorm_g + l * 512 + g * 128;
  for (int i = tid; i < 2048; i += 256) {
    const int s = i >> 4, c8 = (i & 15) * 8;
    float f[8];
    unpack8(*(const uint4*)(z + (size_t)(r0 + s) * ZAB + OFF_AV + g * 128 + c8), f);
    const float rs = srstd[s];
#pragma unroll
    for (int j = 0; j < 8; ++j) sV[(c8 + j) * 136 + (s ^ (((c8 >> 3) & 7) << 3))] = f2bf(f[j] * rs * vg[c8 + j]);
  }
  const float* Wg = p.gmlp_ws + ((size_t)(l * 4 + g)) * 128 * 128;
  for (int i = tid; i < 4096; i += 256) {
    const int t = i >> 5, s4 = (i & 31) * 4;
    const float4 w = *(const float4*)(Wg + t * 128 + s4);
    uint2 o;
    o.x = pack2(s4 + 0 <= t ? w.x : 0.f, s4 + 1 <= t ? w.y : 0.f);
    o.y = pack2(s4 + 2 <= t ? w.z : 0.f, s4 + 3 <= t ? w.w : 0.f);
    *(uint2*)(sW + t * 136 + s4) = o;
  }
  __syncthreads();
  f32x4 acc[4][4];
  zero_acc<4>(acc);
  mma_lds<4, 4, false, true>(acc, sW + wr * 64 * 136, 136, sV + wc * 64 * 136, 136, wr * 64 + 64, lane);
  const float* bs = p.gmlp_bs + (l * 4 + g) * 128;
#pragma unroll
  for (int i = 0; i < 4; ++i) {
    const int t = wr * 64 + i * 16 + (lane & 15);
    const float bst = bs[t];
    const size_t rowoff = (size_t)(r0 + t) * ZAB;
#pragma unroll
    for (int j = 0; j < 4; ++j) {
      const int c = g * 128 + wc * 64 + j * 16 + (lane >> 4) * 4;
      float u[4], ag[4];
      unpack4(*(const uint2*)(z + rowoff + c), u);
      unpack4(*(const uint2*)(z + rowoff + OFF_AG + c), ag);
      uint2 o;
      o.x = pack2(u[0] * (acc[i][j][0] + bst) * siluf_(ag[0]), u[1] * (acc[i][j][1] + bst) * siluf_(ag[1]));
      o.y = pack2(u[2] * (acc[i][j][2] + bst) * siluf_(ag[2]), u[3] * (acc[i][j][3] + bst) * siluf_(ag[3]));
      *(uint2*)(yab + (size_t)(r0 + t) * 1024 + c) = o;
    }
  }
  __syncthreads();
}

__device__ __forceinline__ void gmlp_sample_item(const Params& p, int l, int b, unsigned char* smem) {
  const int r0 = TP + b * 8;
  const bf16* z = (const bf16*)(p.ws + WS_Z);
  bf16* yab = (bf16*)(p.ws + WS_YAB);
  float* svn = (float*)smem;
  const int tid = tidx(), lane = tid & 63, wave = tid >> 6;
  const float* vg = p.vnorm_g + l * 512;
  for (int tt = 0; tt < 2; ++tt) {
    const int t = wave * 2 + tt;
    float f[8];
    unpack8(*(const uint4*)(z + (size_t)(r0 + t) * ZAB + OFF_AV + lane * 8), f);
    float ss = 0.f;
#pragma unroll
    for (int j = 0; j < 8; ++j) ss += f[j] * f[j];
    ss = wave_sum(ss);
    const float rstd = rsqrtf(ss * (1.0f / 512.f) + EPS);
    float* gv = p.out + O_GV + (((size_t)l * 128 + b) * 8 + t) * 512 + lane * 8;
#pragma unroll
    for (int j = 0; j < 8; ++j) {
      const float vn = f[j] * rstd * vg[lane * 8 + j];
      svn[t * 512 + lane * 8 + j] = vn;
      gv[j] = vn;
    }
  }
  __syncthreads();
  {
    const int c = tid * 2, g = c >> 7;
    const float* Wg = p.gmlp_ws + ((size_t)(l * 4 + g)) * 128 * 128;
    const float* bs = p.gmlp_bs + (l * 4 + g) * 128;
    for (int t = 0; t < 8; ++t) {
      float s0 = bs[t], s1 = bs[t];
      for (int s = 0; s <= t; ++s) {
        const float w = Wg[t * 128 + s];
        s0 += w * svn[s * 512 + c];
        s1 += w * svn[s * 512 + c + 1];
      }
      const unsigned uu = *(const unsigned*)(z + (size_t)(r0 + t) * ZAB + c);
      const unsigned gg = *(const unsigned*)(z + (size_t)(r0 + t) * ZAB + OFF_AG + c);
      *(unsigned*)(yab + (size_t)(r0 + t) * 1024 + c) = pack2(lo2f(uu) * s0 * siluf_(lo2f(gg)), hi2f(uu) * s1 * siluf_(hi2f(gg)));
    }
  }
  __syncthreads();
}

__device__ __forceinline__ void swa_prompt_item(const Params& p, int l, int item, unsigned char* smem) {
  const int b = item >> 7, qt = (item >> 1) & 63, kv = item & 1;
  const int q0 = qt * 64, rb = b * SEQ;
  const bf16* z = (const bf16*)(p.ws + WS_Z);
  bf16* yab = (bf16*)(p.ws + WS_YAB);
  bf16* sK = (bf16*)smem;
  bf16* sVT = (bf16*)(smem + 27648);
  const int tid = tidx(), lane = tid & 63, wave = tid >> 6;
  const float* kg = p.kn_g + l * 64;
  const float* qg = p.qn_g + l * 64;
#pragma unroll 1
  for (int it = 0; it < 6; ++it) {
    const int id = tid + 256 * it, kk = id >> 3, ch = id & 7, kp = q0 - 128 + kk;
    float f[8];
    uint4 vraw = make_uint4(0, 0, 0, 0);
    if (kp >= 0) {
      unpack8(*(const uint4*)(z + (size_t)(rb + kp) * ZAB + OFF_BK + kv * 64 + ch * 8), f);
      vraw = *(const uint4*)(z + (size_t)(rb + kp) * ZAB + OFF_BV + kv * 64 + ch * 8);
    } else {
#pragma unroll
      for (int j = 0; j < 8; ++j) f[j] = 0.f;
    }
    float ss = 0.f;
#pragma unroll
    for (int j = 0; j < 8; ++j) ss += f[j] * f[j];
    ss += __shfl_xor(ss, 1); ss += __shfl_xor(ss, 2); ss += __shfl_xor(ss, 4);
    const float rstd = rsqrtf(ss * (1.0f / 64.f) + EPS);
#pragma unroll
    for (int j = 0; j < 8; ++j) f[j] = f[j] * rstd * kg[ch * 8 + j];
    uint4 ko;
    ko.x = pack2(f[0], f[1]); ko.y = pack2(f[2], f[3]); ko.z = pack2(f[4], f[5]); ko.w = pack2(f[6], f[7]);
    *(uint4*)(sK + kk * 72 + ch * 8) = ko;
    float vf[8];
    unpack8(vraw, vf);
#pragma unroll
    for (int j = 0; j < 8; ++j) sVT[(ch * 8 + j) * 200 + kk] = f2bf(vf[j]);
    if (kk >= 128 && kp >= SEQ - 128) {
      const size_t o = ((((size_t)l * 4 + b) * 128 + (kp - (SEQ - 128))) * 2 + kv) * 64 + ch * 8;
#pragma unroll
      for (int j = 0; j < 8; ++j) { p.out[O_SKP + o + j] = f[j]; p.out[O_SVP + o + j] = vf[j]; }
    }
  }
  __syncthreads();
  const int h = kv * 4 + wave;
  const float sink = p.sinks[l * 8 + h];
  const int g4 = lane >> 4, r16 = lane & 15;
#pragma unroll 1
  for (int i = 0; i < 4; ++i) {
    const int qrow = q0 + i * 16 + r16;
    const size_t grow = (size_t)(rb + qrow);
    bf16x8 qf[2];
    {
      float f0[8], f1[8];
      unpack8(*(const uint4*)(z + grow * ZAB + OFF_BQ + h * 64 + g4 * 8), f0);
      unpack8(*(const uint4*)(z + grow * ZAB + OFF_BQ + h * 64 + 32 + g4 * 8), f1);
      float ss = 0.f;
#pragma unroll
      for (int j = 0; j < 8; ++j) ss += f0[j] * f0[j] + f1[j] * f1[j];
      ss += __shfl_xor(ss, 16); ss += __shfl_xor(ss, 32);
      const float rstd = rsqrtf(ss * (1.0f / 64.f) + EPS) * 0.125f;
#pragma unroll
      for (int j = 0; j < 8; ++j) {
        qf[0][j] = (short)f2bf(f0[j] * rstd * qg[g4 * 8 + j]);
        qf[1][j] = (short)f2bf(f1[j] * rstd * qg[32 + g4 * 8 + j]);
      }
    }
    f32x4 st[12];
#pragma unroll
    for (int kt = 0; kt < 12; ++kt) {
      st[kt] = (f32x4){0.f, 0.f, 0.f, 0.f};
#pragma unroll
      for (int ks = 0; ks < 2; ++ks) {
        const bf16x8 kf = *(const bf16x8*)(sK + (kt * 16 + r16) * 72 + ks * 32 + g4 * 8);
        st[kt] = mfma16(kf, qf[ks], st[kt]);
      }
      if ((kt & 1) == 1) __builtin_amdgcn_sched_barrier(0);
    }
    float mx = -INFINITY;
#pragma unroll
    for (int kt = 0; kt < 12; ++kt)
#pragma unroll
      for (int x = 0; x < 4; ++x) {
        const int kp = q0 - 128 + kt * 16 + g4 * 4 + x, diff = qrow - kp;
        const bool valid = (kp >= 0) && (diff >= 0) && (diff < 128);
        st[kt][x] = valid ? st[kt][x] : -INFINITY;
        mx = fmaxf(mx, st[kt][x]);
      }
    mx = fmaxf(mx, __shfl_xor(mx, 16)); mx = fmaxf(mx, __shfl_xor(mx, 32));
    mx = fmaxf(mx, sink);
    float sum = 0.f;
#pragma unroll
    for (int kt = 0; kt < 12; ++kt)
#pragma unroll
      for (int x = 0; x < 4; ++x) {
        const float pv = __expf(st[kt][x] - mx);
        st[kt][x] = pv;
        sum += pv;
      }
    sum += __shfl_xor(sum, 16); sum += __shfl_xor(sum, 32);
    const float inv = 1.0f / (sum + __expf(sink - mx));
    f32x4 o[4];
#pragma unroll
    for (int dt = 0; dt < 4; ++dt) o[dt] = (f32x4){0.f, 0.f, 0.f, 0.f};
#pragma unroll
    for (int t2 = 0; t2 < 6; ++t2) {
      bf16x8 pf;
#pragma unroll
      for (int x = 0; x < 4; ++x) { pf[x] = (short)f2bf(st[2 * t2][x]); pf[4 + x] = (short)f2bf(st[2 * t2 + 1][x]); }
#pragma unroll
      for (int dt = 0; dt < 4; ++dt) {
        const uint2 v0 = *(const uint2*)(sVT + (dt * 16 + r16) * 200 + t2 * 32 + g4 * 4);
        const uint2 v1 = *(const uint2*)(sVT + (dt * 16 + r16) * 200 + t2 * 32 + 16 + g4 * 4);
        union { uint4 u; bf16x8 v; } cv;
        cv.u = make_uint4(v0.x, v0.y, v1.x, v1.y);
        o[dt] = mfma16(cv.v, pf, o[dt]);
      }
      __builtin_amdgcn_sched_barrier(0);
    }
#pragma unroll
    for (int dt = 0; dt < 4; ++dt) {
      const int d0 = dt * 16 + g4 * 4;
      float bg[4];
      unpack4(*(const uint2*)(z + grow * ZAB + OFF_BG + h * 64 + d0), bg);
      uint2 oo;
      oo.x = pack2(o[dt][0] * inv * siluf_(bg[0]), o[dt][1] * inv * siluf_(bg[1]));
      oo.y = pack2(o[dt][2] * inv * siluf_(bg[2]), o[dt][3] * inv * siluf_(bg[3]));
      *(uint2*)(yab + grow * 1024 + 512 + h * 64 + d0) = oo;
    }
  }
  __syncthreads();
}

__device__ __forceinline__ void swa_sample_item(const Params& p, int l, int item, unsigned char* smem) {
  const int b = item >> 1, kv = item & 1;
  const int r0 = TP + b * 8;
  const bf16* z = (const bf16*)(p.ws + WS_Z);
  bf16* yab = (bf16*)(p.ws + WS_YAB);
  bf16* sK = (bf16*)smem;
  bf16* sV = (bf16*)(smem + 19584);
  float* sq = (float*)(smem + 39168);
  float* sP = (float*)(smem + 47872);
  const int tid = tidx();
  const float* kg = p.kn_g + l * 64;
  const float* qg = p.qn_g + l * 64;
  const float* ck = p.cache_k + ((size_t)l * 128 + b) * 128 * 128;
  const float* cvp = p.cache_v + ((size_t)l * 128 + b) * 128 * 128;
#pragma unroll 1
  for (int it = 0; it < 5; ++it) {
    const int id = tid + 256 * it, j = id >> 3, ch = id & 7;
    const bool act = id < 1088;
    float kf[8], vf[8];
#pragma unroll
    for (int x = 0; x < 8; ++x) { kf[x] = 0.f; vf[x] = 0.f; }
    if (act) {
      if (j < 128) {
        const float4 a0 = *(const float4*)(ck + (j * 2 + kv) * 64 + ch * 8), a1 = *(const float4*)(ck + (j * 2 + kv) * 64 + ch * 8 + 4);
        const float4 b0 = *(const float4*)(cvp + (j * 2 + kv) * 64 + ch * 8), b1 = *(const float4*)(cvp + (j * 2 + kv) * 64 + ch * 8 + 4);
        kf[0] = a0.x; kf[1] = a0.y; kf[2] = a0.z; kf[3] = a0.w; kf[4] = a1.x; kf[5] = a1.y; kf[6] = a1.z; kf[7] = a1.w;
        vf[0] = b0.x; vf[1] = b0.y; vf[2] = b0.z; vf[3] = b0.w; vf[4] = b1.x; vf[5] = b1.y; vf[6] = b1.z; vf[7] = b1.w;
      } else {
        unpack8(*(const uint4*)(z + (size_t)(r0 + j - 128) * ZAB + OFF_BK + kv * 64 + ch * 8), kf);
        unpack8(*(const uint4*)(z + (size_t)(r0 + j - 128) * ZAB + OFF_BV + kv * 64 + ch * 8), vf);
      }
    }
    float ss = 0.f;
#pragma unroll
    for (int x = 0; x < 8; ++x) ss += kf[x] * kf[x];
    ss += __shfl_xor(ss, 1); ss += __shfl_xor(ss, 2); ss += __shfl_xor(ss, 4);
    if (act) {
      if (j >= 128) {
        const float rstd = rsqrtf(ss * (1.0f / 64.f) + EPS);
#pragma unroll
        for (int x = 0; x < 8; ++x) kf[x] = kf[x] * rstd * kg[ch * 8 + x];
      }
      uint4 ko, vo;
      ko.x = pack2(kf[0], kf[1]); ko.y = pack2(kf[2], kf[3]); ko.z = pack2(kf[4], kf[5]); ko.w = pack2(kf[6], kf[7]);
      vo.x = pack2(vf[0], vf[1]); vo.y = pack2(vf[2], vf[3]); vo.z = pack2(vf[4], vf[5]); vo.w = pack2(vf[6], vf[7]);
      *(uint4*)(sK + j * 72 + ch * 8) = ko;
      *(uint4*)(sV + j * 72 + ch * 8) = vo;
      if (j >= 8) {
        const size_t o = ((((size_t)l * 128 + b) * 128 + (j - 8)) * 2 + kv) * 64 + ch * 8;
        *(float4*)(p.out + O_SKS + o) = make_float4(kf[0], kf[1], kf[2], kf[3]);
        *(float4*)(p.out + O_SKS + o + 4) = make_float4(kf[4], kf[5], kf[6], kf[7]);
        *(float4*)(p.out + O_SVS + o) = make_float4(vf[0], vf[1], vf[2], vf[3]);
        *(float4*)(p.out + O_SVS + o + 4) = make_float4(vf[4], vf[5], vf[6], vf[7]);
      }
    }
  }
  const int qi = tid >> 3, sub = tid & 7, t = qi >> 2, h = kv * 4 + (qi & 3);
  {
    float f[8];
    unpack8(*(const uint4*)(z + (size_t)(r0 + t) * ZAB + OFF_BQ + h * 64 + sub * 8), f);
    float ss = 0.f;
#pragma unroll
    for (int x = 0; x < 8; ++x) ss += f[x] * f[x];
    ss += __shfl_xor(ss, 1); ss += __shfl_xor(ss, 2); ss += __shfl_xor(ss, 4);
    const float rstd = rsqrtf(ss * (1.0f / 64.f) + EPS) * 0.125f;
#pragma unroll
    for (int x = 0; x < 8; ++x) sq[qi * 68 + sub * 8 + x] = f[x] * rstd * qg[sub * 8 + x];
  }
  __syncthreads();
  const float sink = p.sinks[l * 8 + h];
  float mx = -INFINITY;
  float qr[64];
#pragma unroll
  for (int c = 0; c < 16; ++c) {
    const float4 q4 = *(const float4*)(sq + qi * 68 + c * 4);
    qr[c * 4 + 0] = q4.x; qr[c * 4 + 1] = q4.y; qr[c * 4 + 2] = q4.z; qr[c * 4 + 3] = q4.w;
  }
#pragma unroll 1
  for (int jj = 0; jj < 17; ++jj) {
    const int key = sub + 8 * jj;
    float s = 0.f;
#pragma unroll
    for (int c = 0; c < 8; ++c) {
      float kf8[8];
      unpack8(*(const uint4*)(sK + key * 72 + c * 8), kf8);
#pragma unroll
      for (int x = 0; x < 8; ++x) s += qr[c * 8 + x] * kf8[x];
    }
    const bool valid = (key >= t + 1) && (key <= t + 128);
    s = valid ? s : -INFINITY;
    sP[qi * 140 + key] = s;
    mx = fmaxf(mx, s);
  }
  mx = fmaxf(mx, __shfl_xor(mx, 1)); mx = fmaxf(mx, __shfl_xor(mx, 2)); mx = fmaxf(mx, __shfl_xor(mx, 4));
  mx = fmaxf(mx, sink);
  float sum = 0.f;
  for (int jj = 0; jj < 17; ++jj) {
    const int key = sub + 8 * jj;
    const float pv = __expf(sP[qi * 140 + key] - mx);
    sP[qi * 140 + key] = pv;
    sum += pv;
  }
  sum += __shfl_xor(sum, 1); sum += __shfl_xor(sum, 2); sum += __shfl_xor(sum, 4);
  const float inv = 1.0f / (sum + __expf(sink - mx));
  __syncthreads();
  {
    float o[8];
#pragma unroll
    for (int x = 0; x < 8; ++x) o[x] = 0.f;
#pragma unroll 2
    for (int key = 0; key < 136; ++key) {
      const float pv = sP[qi * 140 + key];
      float vf[8];
      unpack8(*(const uint4*)(sV + key * 72 + sub * 8), vf);
#pragma unroll
      for (int x = 0; x < 8; ++x) o[x] += pv * vf[x];
    }
    float bg[8];
    unpack8(*(const uint4*)(z + (size_t)(r0 + t) * ZAB + OFF_BG + h * 64 + sub * 8), bg);
    uint4 oo;
    oo.x = pack2(o[0] * inv * siluf_(bg[0]), o[1] * inv * siluf_(bg[1]));
    oo.y = pack2(o[2] * inv * siluf_(bg[2]), o[3] * inv * siluf_(bg[3]));
    oo.z = pack2(o[4] * inv * siluf_(bg[4]), o[5] * inv * siluf_(bg[5]));
    oo.w = pack2(o[6] * inv * siluf_(bg[6]), o[7] * inv * siluf_(bg[7]));
    *(uint4*)(yab + (size_t)(r0 + t) * 1024 + 512 + h * 64 + sub * 8) = oo;
  }
  __syncthreads();
}

__device__ __forceinline__ void phase_mix_ab(const Params& p, int l, unsigned char* smem) {
  constexpr int N_SWA = 512, N_GM = 512, N_SWS = 256, N_GMS = 128;
  constexpr int N_ALL = N_SWA + N_GM + N_SWS + N_GMS;
  for (int it = blockIdx.x; it < N_ALL; it += gridDim.x) {
    int i = it;
    if (i < N_SWA) { swa_prompt_item(p, l, i, smem); continue; }
    i -= N_SWA;
    if (i < N_GM) { gmlp_prompt_item(p, l, i, smem); continue; }
    i -= N_GM;
    if (i < N_SWS) { swa_sample_item(p, l, i, smem); continue; }
    i -= N_SWS;
    gmlp_sample_item(p, l, i, smem);
  }
}

__device__ __forceinline__ void conv8_prompt(const Params& p, int l, const bf16* z, int r0, int pos0, int s, int zc, float* y) {
  const float* cw = p.conv_w + (size_t)l * 4 * 1024 + zc;
  const float* cb = p.conv_b + l * 1024 + zc;
#pragma unroll
  for (int j = 0; j < 8; ++j) y[j] = cb[j];
#pragma unroll
  for (int tap = 0; tap < 4; ++tap) {
    const int back = 3 - tap;
    if (pos0 + s - back >= 0) {
      float f[8];
      unpack8(*(const uint4*)(z + (size_t)(r0 + s - back) * ZC + C_QK + zc), f);
#pragma unroll
      for (int j = 0; j < 8; ++j) y[j] += cw[tap * 1024 + j] * f[j];
    }
  }
#pragma unroll
  for (int j = 0; j < 8; ++j) y[j] = siluf_(y[j]);
}

__device__ __forceinline__ void chunk_gates(const Params& p, int l, const bf16* z, int r0, int hh, int lane, float& cum, float& iv) {
  const float f = bf2f(z[(size_t)(r0 + lane) * ZC + C_F + hh]) + p.f_bias[l * 4 + hh];
  iv = bf2f(z[(size_t)(r0 + lane) * ZC + C_I + hh]);
  float c = logsigmoidf_(f);
#pragma unroll
  for (int o = 1; o < 64; o <<= 1) {
    const float n = __shfl_up(c, o);
    if (lane >= o) c += n;
  }
  cum = c;
}

__device__ __forceinline__ void mlstm_local_item(const Params& p, int l, int item, unsigned char* smem) {
  const int bh = item >> 6, c = item & 63, b = bh >> 2, hh = bh & 3;
  const int r0 = b * SEQ + c * 64;
  const bf16* z = (const bf16*)(p.ws + WS_Z);
  bf16* skT = (bf16*)smem;
  bf16* svT = (bf16*)(smem + 18432);
  float* swsel = (float*)(smem + 36864);
  const int tid = tidx(), lane = tid & 63, wave = tid >> 6, wr = wave >> 1, wc = wave & 1;
  if (wave == 0) {
    float cum, iv;
    chunk_gates(p, l, z, r0, hh, lane, cum, iv);
    const float total = __shfl(cum, 63);
    const float g = total - cum + iv;
    const float G = wave_max(g);
    swsel[lane] = __expf(g - G);
    if (lane == 0) {
      ((float*)(p.ws + WS_G))[item] = G;
      ((float*)(p.ws + WS_TOT))[item] = total;
    }
  }
  __syncthreads();
  for (int i = tid; i < 1024; i += 256) {
    const int s = i >> 4, d8 = (i & 15) * 8;
    float y[8];
    conv8_prompt(p, l, z, r0, c * 64, s, 512 + hh * 128 + d8, y);
    {
      uint4 ko;
      ko.x = pack2(y[0] * 0.08838834764831845f, y[1] * 0.08838834764831845f); ko.y = pack2(y[2] * 0.08838834764831845f, y[3] * 0.08838834764831845f);
      ko.z = pack2(y[4] * 0.08838834764831845f, y[5] * 0.08838834764831845f); ko.w = pack2(y[6] * 0.08838834764831845f, y[7] * 0.08838834764831845f);
      *(uint4*)((bf16*)(p.ws + WS_H) + (size_t)(r0 + s) * 512 + hh * 128 + d8) = ko;
    }
    const float sc = 0.08838834764831845f * swsel[s];
#pragma unroll
    for (int j = 0; j < 8; ++j) skT[(d8 + j) * 72 + (s ^ (((d8 >> 3) & 7) << 3))] = f2bf(y[j] * sc);
    float v[8];
    unpack8(*(const uint4*)(z + (size_t)(r0 + s) * ZC + C_V + hh * 128 + d8), v);
#pragma unroll
    for (int j = 0; j < 8; ++j) svT[(d8 + j) * 72 + (s ^ (((d8 >> 3) & 7) << 3))] = f2bf(v[j]);
  }
  __syncthreads();
  f32x4 acc[4][4];
  zero_acc<4>(acc);
  mma_lds<4, 4, true, true>(acc, svT + wr * 64 * 72, 72, skT + wc * 64 * 72, 72, 64, lane);
  bf16* U = (bf16*)(p.ws + WS_U) + (size_t)item * 16384;
#pragma unroll
  for (int i = 0; i < 4; ++i)
#pragma unroll
    for (int j = 0; j < 4; ++j) {
      const int e = wr * 64 + i * 16 + (lane & 15), d = wc * 64 + j * 16 + (lane >> 4) * 4;
      uint2 o;
      o.x = pack2(acc[i][j][0], acc[i][j][1]);
      o.y = pack2(acc[i][j][2], acc[i][j][3]);
      *(uint2*)(U + e * 128 + d) = o;
    }
  if (tid < 128) {
    float s = 0.f;
    for (int k = 0; k < 64; ++k) s += bf2f(skT[tid * 72 + k]);
    ((float*)(p.ws + WS_UN))[(size_t)item * 128 + tid] = s;
  }
  __syncthreads();
}

__device__ __forceinline__ void mlstm_convout_item(const Params& p, int l, int b) {
  const bf16* z = (const bf16*)(p.ws + WS_Z);
  for (int i = tidx(); i < 3 * 1024; i += 256) {
    const int j = i >> 10, ch = i & 1023;
    p.out[O_CVP + (((size_t)l * 4 + b) * 3 + j) * 1024 + ch] = bf2f(z[(size_t)(b * SEQ + SEQ - 3 + j) * ZC + C_QK + ch]);
  }
}

__device__ __forceinline__ void mlstm_sample_item(const Params& p, int l, int item, unsigned char* smem) {
  const int b = item >> 2, hh = item & 3;
  const int r0 = TP + b * 8;
  bf16* z = (bf16*)(p.ws + WS_Z);
  float* sq = (float*)smem;
  float* sk = sq + 1024;
  float* sv = sk + 1024;
  float* sh = sv + 1024;
  float* sint = sh + 1024;
  float* sa = sint + 2048;
  float* sqn = sa + 64;
  float* smt = sqn + 8;
  float* swi = smt + 8;
  float* swsel = swi + 8;
  float* sdm = swsel + 8;
  float* sdecay = sdm + 64;
  const int tid = tidx(), lane = tid & 63, wave = tid >> 6;
  {
    const int isk = tid >> 7, d = tid & 127, zc = isk * 512 + hh * 128 + d;
    const float* cw = p.conv_w + (size_t)l * 4 * 1024 + zc;
    const float cb = p.conv_b[l * 1024 + zc];
    float xp[11];
    const float* cs = p.st_conv + ((size_t)l * 128 + b) * 3 * 1024 + zc;
    xp[0] = cs[0]; xp[1] = cs[1024]; xp[2] = cs[2048];
#pragma unroll
    for (int t = 0; t < 8; ++t) xp[3 + t] = bf2f(z[(size_t)(r0 + t) * ZC + C_QK + zc]);
    const float w0 = cw[0], w1 = cw[1024], w2 = cw[2048], w3 = cw[3072];
    float* dst = isk ? sk : sq;
    const float sc = isk ? 0.08838834764831845f : 1.0f;
#pragma unroll
    for (int t = 0; t < 8; ++t) {
      const float y = cb + w0 * xp[t] + w1 * xp[t + 1] + w2 * xp[t + 2] + w3 * xp[t + 3];
      dst[t * 128 + d] = siluf_(y) * sc;
    }
    float* co = p.out + O_CVS + ((size_t)l * 128 + b) * 3 * 1024 + zc;
    co[0] = xp[8]; co[1024] = xp[9]; co[2048] = xp[10];
  }
  for (int i = tid; i < 1024; i += 256) {
    const int t = i >> 7, e = i & 127;
    sv[i] = bf2f(z[(size_t)(r0 + t) * ZC + C_V + hh * 128 + e]);
  }
  if (tid == 0) {
    float cum[8], iv[8];
    float c = 0.f;
    for (int t = 0; t < 8; ++t) {
      const float f = bf2f(z[(size_t)(r0 + t) * ZC + C_F + hh]) + p.f_bias[l * 4 + hh];
      c += logsigmoidf_(f);
      cum[t] = c;
      iv[t] = bf2f(z[(size_t)(r0 + t) * ZC + C_I + hh]);
    }
    const float m0 = p.st_m[(l * 128 + b) * 4 + hh];
    for (int t = 0; t < 8; ++t) {
      float dmax = -INFINITY;
      for (int s = 0; s <= t; ++s) dmax = fmaxf(dmax, cum[t] - cum[s] + iv[s]);
      const float mi = cum[t] + m0, mt = fmaxf(mi, dmax);
      smt[t] = mt;
      swi[t] = __expf(mi - mt);
      for (int s = 0; s < 8; ++s) sdm[t * 8 + s] = (s <= t) ? __expf(cum[t] - cum[s] + iv[s] - mt) : 0.f;
    }
    const float total = cum[7];
    float gm = -INFINITY;
    for (int s = 0; s < 8; ++s) gm = fmaxf(gm, total - cum[s] + iv[s]);
    const float mn = fmaxf(total + m0, gm);
    for (int s = 0; s < 8; ++s) swsel[s] = __expf(total - cum[s] + iv[s] - mn);
    sdecay[0] = __expf(total + m0 - mn);
    p.out[O_MS + (l * 128 + b) * 4 + hh] = mn;
  }
  __syncthreads();
  const float* n0 = p.st_n + (((size_t)l * 128 + b) * 4 + hh) * 128;
  if (tid < 64) {
    const int t = tid >> 3, s = tid & 7;
    float dsum = 0.f;
    for (int d = 0; d < 128; ++d) dsum += sq[t * 128 + d] * sk[s * 128 + d];
    sa[t * 8 + s] = sdm[t * 8 + s] * dsum;
  } else if (tid < 128) {
    const int t = (tid - 64) >> 3, part = (tid - 64) & 7;
    float dsum = 0.f;
    for (int d = part * 16; d < part * 16 + 16; ++d) dsum += sq[t * 128 + d] * n0[d];
    dsum += __shfl_xor(dsum, 1); dsum += __shfl_xor(dsum, 2); dsum += __shfl_xor(dsum, 4);
    if (part == 0) sqn[t] = dsum;
  }
  __syncthreads();
  {
    const int e = tid & 127, dh = tid >> 7;
    const float decay = sdecay[0];
    const float* C0 = p.st_C + (((size_t)l * 128 + b) * 4 + hh) * 16384;
    float* C1 = p.out + O_CS + (((size_t)l * 128 + b) * 4 + hh) * 16384;
    float vw[8], inter[8];
#pragma unroll
    for (int s = 0; s < 8; ++s) { vw[s] = sv[s * 128 + e] * swsel[s]; inter[s] = 0.f; }
    for (int d = dh * 64; d < dh * 64 + 64; ++d) {
      const float c0 = C0[d * 128 + e];
      float upd = decay * c0;
#pragma unroll
      for (int s = 0; s < 8; ++s) {
        upd += sk[s * 128 + d] * vw[s];
        inter[s] += sq[s * 128 + d] * c0;
      }
      C1[d * 128 + e] = upd;
    }
#pragma unroll
    for (int t = 0; t < 8; ++t) sint[(dh * 8 + t) * 128 + e] = inter[t];
  }
  __syncthreads();
  if (tid < 128) {
    const int e = tid;
    for (int t = 0; t < 8; ++t) {
      float num = swi[t] * (sint[t * 128 + e] + sint[(8 + t) * 128 + e]);
      float den = swi[t] * sqn[t];
      for (int s = 0; s <= t; ++s) { num += sa[t * 8 + s] * sv[s * 128 + e]; den += sa[t * 8 + s]; }
      sh[t * 128 + e] = num / fmaxf(fabsf(den), __expf(-smt[t]));
    }
    float nn = sdecay[0] * n0[e];
    for (int s = 0; s < 8; ++s) nn += swsel[s] * sk[s * 128 + e];
    p.out[O_NS + (((size_t)l * 128 + b) * 4 + hh) * 128 + e] = nn;
  }
  __syncthreads();
  const float* hg = p.hnorm_g + l * 512 + hh * 128;
  for (int tt = 0; tt < 2; ++tt) {
    const int t = wave * 2 + tt;
    const float h0 = sh[t * 128 + lane], h1 = sh[t * 128 + 64 + lane];
    const float ss = wave_sum(h0 * h0 + h1 * h1);
    const float rstd = rsqrtf(ss * (1.0f / 128.f) + EPS);
    bf16* zr = z + (size_t)(r0 + t) * ZC;
#pragma unroll
    for (int k = 0; k < 2; ++k) {
      const int e = lane + 64 * k;
      const float hv = k ? h1 : h0;
      const float o = bf2f(zr[C_O + hh * 128 + e]), cg_ = bf2f(zr[C_G + hh * 128 + e]);
      zr[C_O + hh * 128 + e] = f2bf(hv * rstd * hg[e] * sigmoidf_(o) * siluf_(cg_));
    }
  }
  __syncthreads();
}

__device__ __forceinline__ void phase_mix1(const Params& p, int l, unsigned char* smem) {
  constexpr int N_LOC = 1024, N_SMP = 512, N_CV = 4;
  constexpr int N_ALL = N_LOC + N_SMP + N_CV;
  for (int it = blockIdx.x; it < N_ALL; it += gridDim.x) {
    int i = it;
    if (i < N_LOC) { mlstm_local_item(p, l, i, smem); continue; }
    i -= N_LOC;
    if (i < N_SMP) { mlstm_sample_item(p, l, i, smem); continue; }
    i -= N_SMP;
    mlstm_convout_item(p, l, i);
  }
}

__device__ __forceinline__ void phase_scan(const Params& p, int l, unsigned char* smem) {
  float* sdec = (float*)smem;
  float* ssc = sdec + 64;
  const int tid = tidx();
  float* Gb = (float*)(p.ws + WS_G);
  float* Tb = (float*)(p.ws + WS_TOT);
  float* Mb = (float*)(p.ws + WS_M);
  for (int it = blockIdx.x; it < 256; it += gridDim.x) {
    const int bh = it >> 4, slice = it & 15;
    if (tid < 64) { sdec[128 + tid] = Gb[bh * 64 + tid]; sdec[192 + tid] = Tb[bh * 64 + tid]; }
    __syncthreads();
    if (tid == 0) {
      float m = 0.f;
      for (int c = 0; c < 64; ++c) {
        const float G = sdec[128 + c], tot = sdec[192 + c];
        const float mn = fmaxf(tot + m, G);
        sdec[c] = __expf(tot + m - mn);
        ssc[c] = __expf(G - mn);
        if (slice == 0) Mb[bh * 64 + c] = m;
        m = mn;
      }
      if (slice == 0) p.out[O_MP + l * 16 + bh] = m;
    }
    __syncthreads();
    {
      const int idx = slice * 1024 + tid * 4;
      bf16* U = (bf16*)(p.ws + WS_U) + (size_t)bh * 64 * 16384 + idx;
      float st[4] = {0.f, 0.f, 0.f, 0.f};
#pragma unroll 8
      for (int c = 0; c < 64; ++c) {
        float u[4];
        unpack4(*(const uint2*)(U + (size_t)c * 16384), u);
        uint2 o;
        o.x = pack2(st[0], st[1]); o.y = pack2(st[2], st[3]);
        *(uint2*)(U + (size_t)c * 16384) = o;
        const float dc = sdec[c], sc = ssc[c];
#pragma unroll
        for (int x = 0; x < 4; ++x) st[x] = dc * st[x] + sc * u[x];
      }
      const int e = idx >> 7, d0 = idx & 127;
      float* Co = p.out + O_CP + ((size_t)l * 16 + bh) * 16384;
#pragma unroll
      for (int x = 0; x < 4; ++x) Co[(d0 + x) * 128 + e] = st[x];
    }
    if (slice == 0 && tid < 128) {
      float* un = (float*)(p.ws + WS_UN) + (size_t)bh * 64 * 128 + tid;
      float n = 0.f;
#pragma unroll 8
      for (int c = 0; c < 64; ++c) {
        const float u = un[c * 128];
        un[c * 128] = n;
        n = sdec[c] * n + ssc[c] * u;
      }
      p.out[O_NP + ((size_t)l * 16 + bh) * 128 + tid] = n;
    }
    __syncthreads();
  }
}

__device__ __forceinline__ void mlstm_out_item(const Params& p, int l, int item, unsigned char* smem) {
  const int bh = item >> 6, c = item & 63, b = bh >> 2, hh = bh & 3;
  const int r0 = b * SEQ + c * 64;
  bf16* z = (bf16*)(p.ws + WS_Z);
  bf16* sq = (bf16*)smem;
  bf16* sk = (bf16*)(smem + 17408);
  bf16* svT = (bf16*)(smem + 34816);
  bf16* sa = (bf16*)(smem + 53248);
  float* scum = (float*)(smem + 62464);
  float* siv = scum + 64;
  float* smt = siv + 64;
  float* swi = smt + 64;
  float* sden = swi + 64;
  float* sqn = sden + 64;
  float* spart = sqn + 64;
  const int tid = tidx(), lane = tid & 63, wave = tid >> 6;
  const int r16 = lane & 15, g4 = lane >> 4;
  if (wave == 0) {
    float cum, iv;
    chunk_gates(p, l, z, r0, hh, lane, cum, iv);
    scum[lane] = cum;
    siv[lane] = iv;
  }
  for (int i = tid; i < 1024; i += 256) {
    const int s = i >> 4, d8 = (i & 15) * 8;
    *(uint4*)(sk + s * 136 + d8) = *(const uint4*)((const bf16*)(p.ws + WS_H) + (size_t)(r0 + s) * 512 + hh * 128 + d8);
  }
  for (int i = tid; i < 1024; i += 256) {
    const int s = i >> 4, d8 = (i & 15) * 8;
    float y[8];
    conv8_prompt(p, l, z, r0, c * 64, s, hh * 128 + d8, y);
    uint4 o;
    o.x = pack2(y[0], y[1]); o.y = pack2(y[2], y[3]);
    o.z = pack2(y[4], y[5]); o.w = pack2(y[6], y[7]);
    *(uint4*)(sq + s * 136 + d8) = o;
  }
  for (int i = tid; i < 1024; i += 256) {
    const int s = i >> 4, d8 = (i & 15) * 8;
    float v[8];
    unpack8(*(const uint4*)(z + (size_t)(r0 + s) * ZC + C_V + hh * 128 + d8), v);
#pragma unroll
    for (int j = 0; j < 8; ++j) svT[(d8 + j) * 72 + (s ^ (((d8 >> 3) & 7) << 3))] = f2bf(v[j]);
  }
  __syncthreads();
  const float m_prev = ((const float*)(p.ws + WS_M))[item];
  {
    const int t = wave * 16 + r16;
    bf16x8 qf[4];
#pragma unroll
    for (int ks = 0; ks < 4; ++ks) qf[ks] = *(const bf16x8*)(sq + t * 136 + ks * 32 + g4 * 8);
    f32x4 st[4];
#pragma unroll
    for (int kt = 0; kt < 4; ++kt) {
      st[kt] = (f32x4){0.f, 0.f, 0.f, 0.f};
#pragma unroll
      for (int ks = 0; ks < 4; ++ks) {
        const bf16x8 kf = *(const bf16x8*)(sk + (kt * 16 + r16) * 136 + ks * 32 + g4 * 8);
        st[kt] = mfma16(kf, qf[ks], st[kt]);
      }
    }
    const float cumt = scum[t];
    float dm[4][4];
    float rmax = -INFINITY;
#pragma unroll
    for (int kt = 0; kt < 4; ++kt)
#pragma unroll
      for (int x = 0; x < 4; ++x) {
        const int s = kt * 16 + g4 * 4 + x;
        dm[kt][x] = (s <= t) ? (cumt - scum[s] + siv[s]) : -INFINITY;
        rmax = fmaxf(rmax, dm[kt][x]);
      }
    rmax = fmaxf(rmax, __shfl_xor(rmax, 16)); rmax = fmaxf(rmax, __shfl_xor(rmax, 32));
    const float mi = cumt + m_prev, mt = fmaxf(mi, rmax);
    float rsum = 0.f;
#pragma unroll
    for (int kt = 0; kt < 4; ++kt) {
      float a[4];
#pragma unroll
      for (int x = 0; x < 4; ++x) {
        const int s = kt * 16 + g4 * 4 + x;
        a[x] = (s <= t) ? __expf(dm[kt][x] - mt) * st[kt][x] : 0.f;
        rsum += a[x];
      }
      uint2 o;
      o.x = pack2(a[0], a[1]); o.y = pack2(a[2], a[3]);
      *(uint2*)(sa + t * 72 + kt * 16 + g4 * 4) = o;
    }
    rsum += __shfl_xor(rsum, 16); rsum += __shfl_xor(rsum, 32);
    if (g4 == 0) { smt[t] = mt; swi[t] = __expf(mi - mt); sden[t] = rsum; }
  }
  {
    const int t = tid >> 2, part = tid & 3;
    const float* nc = (const float*)(p.ws + WS_UN) + (size_t)item * 128;
    float s = 0.f;
    for (int d = part * 32; d < part * 32 + 32; ++d) s += bf2f(sq[t * 136 + d]) * nc[d];
    s += __shfl_xor(s, 1); s += __shfl_xor(s, 2);
    if (part == 0) sqn[t] = s;
  }
  __syncthreads();
  f32x4 acc[4][2];
#pragma unroll
  for (int ti = 0; ti < 4; ++ti)
#pragma unroll
    for (int et = 0; et < 2; ++et) acc[ti][et] = (f32x4){0.f, 0.f, 0.f, 0.f};
  const bf16* Cc = (const bf16*)(p.ws + WS_U) + (size_t)item * 16384;
#pragma unroll
  for (int ks = 0; ks < 4; ++ks) {
    bf16x8 cf[2], qf[4];
#pragma unroll
    for (int et = 0; et < 2; ++et) cf[et] = *(const bf16x8*)(Cc + (wave * 32 + et * 16 + r16) * 128 + ks * 32 + g4 * 8);
#pragma unroll
    for (int ti = 0; ti < 4; ++ti) qf[ti] = *(const bf16x8*)(sq + (ti * 16 + r16) * 136 + ks * 32 + g4 * 8);
#pragma unroll
    for (int ti = 0; ti < 4; ++ti)
#pragma unroll
      for (int et = 0; et < 2; ++et) acc[ti][et] = mfma16(cf[et], qf[ti], acc[ti][et]);
  }
#pragma unroll
  for (int ti = 0; ti < 4; ++ti) {
    const float w = swi[ti * 16 + r16];
#pragma unroll
    for (int et = 0; et < 2; ++et) acc[ti][et] *= w;
  }
#pragma unroll
  for (int ks = 0; ks < 2; ++ks) {
    bf16x8 vf[2], af[4];
#pragma unroll
    for (int et = 0; et < 2; ++et) vf[et] = *(const bf16x8*)(svT + (wave * 32 + et * 16 + r16) * 72 + ((ks * 32 + g4 * 8) ^ (((wave * 4 + et * 2 + (r16 >> 3)) & 7) << 3)));
#pragma unroll
    for (int ti = 0; ti < 4; ++ti) af[ti] = *(const bf16x8*)(sa + (ti * 16 + r16) * 72 + ks * 32 + g4 * 8);
#pragma unroll
    for (int ti = 0; ti < 4; ++ti)
#pragma unroll
      for (int et = 0; et < 2; ++et) acc[ti][et] = mfma16(vf[et], af[ti], acc[ti][et]);
  }
#pragma unroll
  for (int ti = 0; ti < 4; ++ti) {
    const int t = ti * 16 + r16;
    const float den = sden[t] + swi[t] * sqn[t];
    const float inv = 1.0f / fmaxf(fabsf(den), __expf(-smt[t]));
    float ss = 0.f;
#pragma unroll
    for (int et = 0; et < 2; ++et) {
      acc[ti][et] *= inv;
#pragma unroll
      for (int x = 0; x < 4; ++x) ss += acc[ti][et][x] * acc[ti][et][x];
    }
    ss += __shfl_xor(ss, 16); ss += __shfl_xor(ss, 32);
    if (g4 == 0) spart[t * 4 + wave] = ss;
  }
  __syncthreads();
  const float* hg = p.hnorm_g + l * 512 + hh * 128;
#pragma unroll
  for (int ti = 0; ti < 4; ++ti) {
    const int t = ti * 16 + r16;
    const float rstd = rsqrtf((spart[t * 4] + spart[t * 4 + 1] + spart[t * 4 + 2] + spart[t * 4 + 3]) * (1.0f / 128.f) + EPS);
    bf16* zr = z + (size_t)(r0 + t) * ZC;
#pragma unroll
    for (int et = 0; et < 2; ++et) {
      const int e = wave * 32 + et * 16 + g4 * 4;
      float o[4], cg_[4];
      unpack4(*(const uint2*)(zr + C_O + hh * 128 + e), o);
      unpack4(*(const uint2*)(zr + C_G + hh * 128 + e), cg_);
      float y[4];
#pragma unroll
      for (int x = 0; x < 4; ++x) y[x] = acc[ti][et][x] * rstd * hg[e + x] * sigmoidf_(o[x]) * siluf_(cg_[x]);
      uint2 oo;
      oo.x = pack2(y[0], y[1]); oo.y = pack2(y[2], y[3]);
      *(uint2*)(zr + C_O + hh * 128 + e) = oo;
    }
  }
  __syncthreads();
}

__device__ __forceinline__ void phase_mix2(const Params& p, int l, unsigned char* smem) {
  for (int it = blockIdx.x; it < 1024; it += gridDim.x) mlstm_out_item(p, l, it, smem);
}

template <int NI>
__device__ __forceinline__ void br_tile(const Params& p, int l, int m0, int n0, bf16* sm) {
  const bf16* Wbr = (const bf16*)(p.ws + WS_WBR) + (size_t)l * 1024 * 1536;
  const bf16* yab = (const bf16*)(p.ws + WS_YAB);
  const bf16* z = (const bf16*)(p.ws + WS_Z);
  bf16* merged = (bf16*)(p.ws + WS_U);
  const float* bias = p.b_in + (size_t)l * ZIN + OFF_MG;
  const int lane = tidx() & 63, wave = tidx() >> 6, wr = wave >> 1, wc = wave & 1;
#pragma unroll 1
  for (int seg = 0; seg < 3; ++seg) {
    f32x4 acc[4][NI];
    zero_acc<NI>(acc);
    gemm_accum_f8<NI>(acc, p.ws + WS_H8 + (size_t)m0 * 1024, p.ws + WS_W8 + ((size_t)l * W8_ROWS + (OFF_MG - W8_ROW0) + seg * 1024 + n0) * 1024, sm);
    unsigned gp[4][NI][2];
#pragma unroll
    for (int j = 0; j < NI; ++j) {
      const int col = n0 + wc * (16 * NI) + j * 16 + (lane >> 4) * 4;
      const float4 bb = *(const float4*)(bias + seg * 1024 + col);
#pragma unroll
      for (int i = 0; i < 4; ++i) {
        gp[i][j][0] = pack2(sigmoidf_(acc[i][j][0] * 0.015625f + bb.x), sigmoidf_(acc[i][j][1] * 0.015625f + bb.y));
        gp[i][j][1] = pack2(sigmoidf_(acc[i][j][2] * 0.015625f + bb.z), sigmoidf_(acc[i][j][3] * 0.015625f + bb.w));
      }
    }
    zero_acc<NI>(acc);
    const bf16* A = (seg == 0) ? yab + (size_t)m0 * 1024 : (seg == 1) ? yab + (size_t)m0 * 1024 + 512 : z + (size_t)m0 * ZC + C_O;
    const int lda = (seg == 2) ? ZC : 1024;
    gemm_accum<NI, (NI >= 2)>(acc, A, lda, Wbr + (size_t)n0 * 1536 + seg * 512, 1536, 512, sm);
#pragma unroll
    for (int i = 0; i < 4; ++i)
#pragma unroll
      for (int j = 0; j < NI; ++j) {
        const int row = m0 + wr * 64 + i * 16 + (lane & 15), col = n0 + wc * (16 * NI) + j * 16 + (lane >> 4) * 4;
        uint2* mp = (uint2*)(merged + (size_t)row * 1024 + col);
        uint2 prev = make_uint2(0u, 0u);
        if (seg > 0) prev = *mp;
        uint2 o;
        o.x = pack2(lo2f(prev.x) + lo2f(gp[i][j][0]) * acc[i][j][0], hi2f(prev.x) + hi2f(gp[i][j][0]) * acc[i][j][1]);
        o.y = pack2(lo2f(prev.y) + lo2f(gp[i][j][1]) * acc[i][j][2], hi2f(prev.y) + hi2f(gp[i][j][1]) * acc[i][j][3]);
        *mp = o;
      }
  }
}
__device__ __forceinline__ void phase_gemm_br(const Params& p, int l, unsigned char* smem) {
  bf16* sm = (bf16*)smem;
  const int ntiles = (TT / 128) * 8;
  const int nfull = (ntiles / (int)gridDim.x) * (int)gridDim.x;
  for (int t = blockIdx.x; t < nfull; t += gridDim.x) {
    int pm, pn;
    tile_map(t, 8, pm, pn);
    br_tile<4>(p, l, pm * 128, pn * 128, sm);
  }
  for (int u = blockIdx.x; u < 4 * (ntiles - nfull); u += gridDim.x) {
    int pm, pn;
    tile_map(nfull + (u >> 2), 8, pm, pn);
    br_tile<1>(p, l, pm * 128, pn * 128 + (u & 3) * 32, sm);
  }
}

template <int NI>
__device__ __forceinline__ void out_tile(const Params& p, int l, int m0, int n0, bf16* sm) {
  const bf16* merged = (const bf16*)(p.ws + WS_U);
  const bf16* Wout = (const bf16*)(p.ws + WS_WOUT) + (size_t)l * 1024 * 1024;
  const float* mod = (const float*)(p.ws + WS_MOD);
  const int lane = tidx() & 63, wave = tidx() >> 6, wr = wave >> 1, wc = wave & 1;
  f32x4 acc[4][NI];
  zero_acc<NI>(acc);
  gemm_accum<NI>(acc, merged + (size_t)m0 * 1024, 1024, Wout + (size_t)n0 * 1024, 1024, 1024, sm);
#pragma unroll
  for (int i = 0; i < 4; ++i) {
    const int row = m0 + wr * 64 + i * 16 + (lane & 15);
    const float* xr = xrow_ptr(p, l, row);
    const float* gate = mod + ((size_t)l * NMOD + mod_row(row)) * 3072 + 2048;
#pragma unroll
    for (int j = 0; j < NI; ++j) {
      const int col = n0 + wc * (16 * NI) + j * 16 + (lane >> 4) * 4;
      const float4 xv = *(const float4*)(xr + col), gv = *(const float4*)(gate + col);
      float4 o;
      o.x = xv.x + gv.x * acc[i][j][0]; o.y = xv.y + gv.y * acc[i][j][1];
      o.z = xv.z + gv.z * acc[i][j][2]; o.w = xv.w + gv.w * acc[i][j][3];
      *(float4*)(p.out + (size_t)row * D + col) = o;
    }
  }
}
__device__ __forceinline__ void phase_gemm_out(const Params& p, int l, unsigned char* smem) {
  bf16* sm = (bf16*)smem;
  const int ntiles = (TT / 128) * 8;
  const int nfull = (ntiles / (int)gridDim.x) * (int)gridDim.x;
  for (int t = blockIdx.x; t < nfull; t += gridDim.x) {
    int pm, pn;
    tile_map(t, 8, pm, pn);
    out_tile<4>(p, l, pm * 128, pn * 128, sm);
  }
  for (int u = blockIdx.x; u < 4 * (ntiles - nfull); u += gridDim.x) {
    int pm, pn;
    tile_map(nfull + (u >> 2), 8, pm, pn);
    out_tile<1>(p, l, pm * 128, pn * 128 + (u & 3) * 32, sm);
  }
}

constexpr int N_PHASES = 19;
template <int S>
__device__ __forceinline__ void run_stage(const Params& p, int l, unsigned char* smem) {
  if (S == -1) phase_prep(p, smem);
  if (S == 0) phase_norm(p, l);
  if (S == 1) phase_gemm_in(p, l, 0, ZAB / 128, ZAB, smem);
  if (S == 2) phase_mix_ab(p, l, smem);
  if (S == 3) phase_gemm_in(p, l, ZAB, ZC / 128, ZC, smem);
  if (S == 4) phase_mix1(p, l, smem);
  if (S == 5) phase_scan(p, l, smem);
  if (S == 6) phase_mix2(p, l, smem);
  if (S == 7) phase_gemm_br(p, l, smem);
  if (S == 8) phase_gemm_out(p, l, smem);
}


#define XB_TMO      128
#define XB_XCNT(j)  (256  + 64 * (j))
#define XB_XSUB(j)  (1280 + 64 * (j))
#define XB_XGEN(j)  (2304 + 64 * (j))
#define XB_TOP      3328
#define XB_TOPGEN   3392
#define XCD_BAR_WORDS 3456
#define XB_SPIN_CAP (1u << 18)
#define LAS __attribute__((address_space(3)))
__device__ __forceinline__ unsigned xb_ld(unsigned* p)              { return __hip_atomic_load(p, __ATOMIC_RELAXED, __HIP_MEMORY_SCOPE_AGENT); }
__device__ __forceinline__ unsigned xb_add(unsigned* p, unsigned v) { return __hip_atomic_fetch_add(p, v, __ATOMIC_RELAXED, __HIP_MEMORY_SCOPE_AGENT); }
__device__ __forceinline__ unsigned xb_xcc_id() { return (unsigned)__builtin_amdgcn_s_getreg((3 << 11) | 20) & 0xFu; }
#define XB_SPIN(cond, bar) do { unsigned _sp = 0; while (cond) { __builtin_amdgcn_s_sleep(1); \
    if ((++_sp & 255u) == 0u) { if (xb_ld(&(bar)[XB_TMO])) break; if (_sp > XB_SPIN_CAP) { atomicAdd(&(bar)[XB_TMO], 1u); break; } } } } while (0)
struct XcdBarrier { unsigned* bar; unsigned x; volatile LAS unsigned* st; };
__device__ __forceinline__ XcdBarrier xcd_barrier_post(unsigned* bar, volatile LAS unsigned* st) {
  XcdBarrier b; b.bar = bar; b.x = xb_xcc_id(); b.st = st;
  if (threadIdx.x == 0) (void)xb_add(&bar[XB_XCNT(b.x)], 1u);
  return b;
}
__device__ __forceinline__ void xcd_barrier_complete(unsigned* bar, unsigned x, unsigned& nloc, unsigned& nx) {
  const unsigned G = gridDim.x * gridDim.y * gridDim.z;
  unsigned sum, cnt, mine, sp = 0u;
  for (;;) {
    sum = 0u; cnt = 0u; mine = 0u;
#pragma unroll
    for (unsigned j = 0; j < 16; ++j) { const unsigned c = xb_ld(&bar[XB_XCNT(j)]); sum += c; cnt += (c > 0u) ? 1u : 0u; mine = (j == x) ? c : mine; }
    if (sum == G) break;
    __builtin_amdgcn_s_sleep(1);
    if ((++sp & 255u) == 0u) { if (xb_ld(&bar[XB_TMO])) break; if (sp > XB_SPIN_CAP) { atomicAdd(&bar[XB_TMO], 1u); break; } }
  }
  nloc = mine > 0u ? mine : 1u; nx = cnt > 0u ? cnt : 1u;
}
__device__ __forceinline__ void xcd_barrier(const XcdBarrier& b) {
  asm volatile("s_waitcnt vmcnt(0)" ::: "memory");
  __syncthreads();
  if (threadIdx.x == 0) {
    unsigned* bar = b.bar;
    __builtin_amdgcn_s_waitcnt(0);
    unsigned nloc = b.st[0], nx = b.st[1];
    if (nloc == 0u) { xcd_barrier_complete(bar, b.x, nloc, nx); b.st[0] = nloc; b.st[1] = nx; }
    const unsigned old = xb_add(&bar[XB_XSUB(b.x)], 1u);
    const unsigned gen = old / nloc;
    if (old + 1u == (gen + 1u) * nloc) {
      __builtin_amdgcn_fence(__ATOMIC_RELEASE, "agent");
      asm volatile("s_waitcnt vmcnt(0)" ::: "memory");
      const unsigned og = xb_add(&bar[XB_TOP], 1u);
      const unsigned tg = og / nx;
      if (og + 1u == (tg + 1u) * nx) xb_add(&bar[XB_TOPGEN], 1u);
      else XB_SPIN(xb_ld(&bar[XB_TOPGEN]) == tg, bar);
      __builtin_amdgcn_fence(__ATOMIC_ACQUIRE, "agent");
      xb_add(&bar[XB_XGEN(b.x)], 1u);
      asm volatile("s_waitcnt vmcnt(0)" ::: "memory");
    } else {
      XB_SPIN(xb_ld(&bar[XB_XGEN(b.x)]) == gen, bar);
      __builtin_amdgcn_fence(__ATOMIC_ACQUIRE, "agent");
      asm volatile("s_waitcnt vmcnt(0)" ::: "memory");
    }
  }
  __syncthreads();
}

#define GSYNC() xcd_barrier(xb)
__global__ void __launch_bounds__(256, 2) mega_kernel(Params p_in) {
  __shared__ __attribute__((aligned(16))) unsigned char smem[SMEM_BYTES];
  const Params& p = *(const Params*)__builtin_amdgcn_kernarg_segment_ptr();
  __shared__ uint4 xb_words;
  if (threadIdx.x == 0) xb_words = make_uint4(0u, 0u, 0u, 0u);
  __syncthreads();
  XcdBarrier xb = xcd_barrier_post((unsigned*)(p.ws + WS_BAR), (volatile LAS unsigned*)&xb_words);
  run_stage<-1>(p, 0, smem);
  if (p.out == nullptr) cg::this_grid().sync();
  GSYNC();
#define LAYER(L, LAST)                 \
  run_stage<0>(p, L, smem); GSYNC();   \
  run_stage<1>(p, L, smem); GSYNC();   \
  run_stage<2>(p, L, smem); GSYNC();   \
  run_stage<3>(p, L, smem); GSYNC();   \
  run_stage<4>(p, L, smem); GSYNC();   \
  run_stage<5>(p, L, smem); GSYNC();   \
  run_stage<6>(p, L, smem); GSYNC();   \
  run_stage<7>(p, L, smem); GSYNC();   \
  run_stage<8>(p, L, smem);            \
  if (!LAST) GSYNC();
  int l0 = 0, l1 = 1;
  asm volatile("" : "+s"(l0));
  asm volatile("" : "+s"(l1));
  LAYER(l0, 0)
  LAYER(l1, 1)
}

extern "C" void kernel_launch(void* const* d_in, const int* in_sizes, int n_in, void* d_out, int out_size, void* d_ws,
                              size_t ws_size, hipStream_t stream) {
  if (ws_size < WS_END || n_in < 29) { fprintf(stderr, "workspace too small / bad inputs\n"); return; }
  Params p{};
  const float** f = (const float**)&p;
  for (int i = 0; i < 29; ++i) f[i] = (const float*)d_in[i];
  p.out = (float*)d_out;
  p.ws = (unsigned char*)d_ws;
  static int grid_blocks = 0;
  if (!grid_blocks) {
    int dev = 0, cus = 0, per_cu = 0;
    (void)hipGetDevice(&dev);
    (void)hipDeviceGetAttribute(&cus, hipDeviceAttributeMultiprocessorCount, dev);
    (void)hipOccupancyMaxActiveBlocksPerMultiprocessor(&per_cu, mega_kernel, 256, 0);
    if (per_cu < 1) per_cu = 1;
    if (per_cu > 2) per_cu = 2;
    grid_blocks = cus * per_cu;
  }
  (void)hipMemsetAsync((unsigned char*)d_ws + WS_BAR, 0, 16384, stream);
  void* args[] = {&p};
  hipError_t e = hipLaunchCooperativeKernel((void*)mega_kernel, dim3(grid_blocks), dim3(256), args, 0, stream);
  if (e != hipSuccess) fprintf(stderr, "cooperative launch failed: %s (grid %d)\n", hipGetErrorString(e), grid_blocks);
}
```

```cpp
#include <hip/hip_runtime.h>
#include <hip/hip_cooperative_groups.h>
#include <cstdio>
namespace cg = cooperative_groups;

typedef unsigned short bf16;
typedef short bf16x8 __attribute__((ext_vector_type(8)));
typedef float f32x4 __attribute__((ext_vector_type(4)));
typedef unsigned u32x4 __attribute__((ext_vector_type(4)));
#define LDSP __attribute__((address_space(3)))

#ifndef SINGLE_LAUNCH
#define SINGLE_LAUNCH 0
#endif

constexpr int D = 1024, TP = 16384, TS = 1024, TT = TP + TS, SEQ = 4096;
constexpr int ZIN = 8456, NWIN = 8576;
constexpr int OFF_AV = 512, OFF_AG = 1024, OFF_BQ = 1536, OFF_BK = 2048, OFF_BV = 2176, OFF_BG = 2304, OFF_MG = 5384;
constexpr int ZAB = 2816;
constexpr int ZC = 2688;
constexpr int C_QK = 0, C_V = 1024, C_I = 1536, C_F = 1540, C_O = 1544, C_G = 2056;
constexpr float EPS = 1e-6f;
constexpr int NMOD = 132;
constexpr int SMEM_BYTES = 73728;

constexpr size_t O_Y = 0;
constexpr size_t O_SKP = (size_t)TT * D;
constexpr size_t O_SVP = O_SKP + 2 * 4 * 128 * 128;
constexpr size_t O_CVP = O_SVP + 2 * 4 * 128 * 128;
constexpr size_t O_CP = O_CVP + 2 * 4 * 3 * 1024;
constexpr size_t O_NP = O_CP + (size_t)2 * 4 * 4 * 128 * 128;
constexpr size_t O_MP = O_NP + 2 * 4 * 4 * 128;
constexpr size_t O_SKS = O_MP + 2 * 4 * 4;
constexpr size_t O_SVS = O_SKS + (size_t)2 * 128 * 128 * 128;
constexpr size_t O_CVS = O_SVS + (size_t)2 * 128 * 128 * 128;
constexpr size_t O_CS = O_CVS + (size_t)2 * 128 * 3 * 1024;
constexpr size_t O_NS = O_CS + (size_t)2 * 128 * 4 * 128 * 128;
constexpr size_t O_MS = O_NS + (size_t)2 * 128 * 4 * 128;
constexpr size_t O_GV = O_MS + 2 * 128 * 4;
constexpr size_t O_END = O_GV + (size_t)2 * 128 * 8 * 512;

constexpr size_t WS_WIN = 0;
constexpr size_t WS_WBR = WS_WIN + (size_t)2 * NWIN * 1024 * 2;
constexpr size_t WS_WOUT = WS_WBR + (size_t)2 * 1024 * 1536 * 2;
constexpr size_t WS_MOD = WS_WOUT + (size_t)2 * 1024 * 1024 * 2;
constexpr size_t WS_H = WS_MOD + (size_t)2 * NMOD * 3072 * 4;
constexpr size_t WS_YAB = WS_H + (size_t)TT * 1024 * 2;
constexpr size_t WS_U = WS_YAB + (size_t)TT * 1024 * 2;
constexpr size_t WS_UN = WS_U + (size_t)TT * 1024 * 2;
constexpr size_t WS_G = WS_UN + (size_t)1024 * 128 * 4;
constexpr size_t WS_TOT = WS_G + 4096;
constexpr size_t WS_M = WS_TOT + 4096;
constexpr size_t WS_Z = WS_M + 4096;
constexpr size_t WS_BAR = WS_Z + (size_t)TT * ZAB * 2;
constexpr size_t WS_H8 = WS_BAR + 16384;
constexpr int W8_ROW0 = 0, W8_ROWS = NWIN;
constexpr size_t WS_W8 = WS_H8 + (size_t)TT * 1024;
constexpr size_t WS_END = WS_W8 + (size_t)2 * W8_ROWS * 1024;

struct Params {
  const float *x_prompt, *x_sample, *cache_k, *cache_v, *st_conv, *st_C, *st_n, *st_m, *c_prompt, *c_sample;
  const float *ada_w, *ada_b, *norm_g, *w_in, *b_in, *vnorm_g, *gmlp_ws, *gmlp_bs, *qn_g, *kn_g, *sinks;
  const float *conv_w, *conv_b, *f_bias, *hnorm_g, *w_a, *w_b, *w_c, *w_out;
  float* out;
  unsigned char* ws;
};

__device__ __forceinline__ int tidx() { int t = threadIdx.x; asm volatile("" : "+v"(t)); return t; }
__device__ __forceinline__ bf16 f2bf(float f) {
  unsigned u = __float_as_uint(f);
  u += 0x7fffu + ((u >> 16) & 1u);
  return (bf16)(u >> 16);
}
__device__ __forceinline__ float bf2f(bf16 h) { return __uint_as_float(((unsigned)h) << 16); }
__device__ __forceinline__ unsigned pack2(float a, float b) { return (unsigned)f2bf(a) | ((unsigned)f2bf(b) << 16); }
__device__ __forceinline__ float lo2f(unsigned u) { return __uint_as_float(u << 16); }
__device__ __forceinline__ float hi2f(unsigned u) { return __uint_as_float(u & 0xffff0000u); }
__device__ __forceinline__ void unpack8(const uint4& v, float* f) {
  f[0] = lo2f(v.x); f[1] = hi2f(v.x); f[2] = lo2f(v.y); f[3] = hi2f(v.y);
  f[4] = lo2f(v.z); f[5] = hi2f(v.z); f[6] = lo2f(v.w); f[7] = hi2f(v.w);
}
__device__ __forceinline__ void unpack4(const uint2& v, float* f) {
  f[0] = lo2f(v.x); f[1] = hi2f(v.x); f[2] = lo2f(v.y); f[3] = hi2f(v.y);
}
__device__ __forceinline__ float sigmoidf_(float x) { return __builtin_amdgcn_rcpf(1.0f + __expf(-x)); }
__device__ __forceinline__ float siluf_(float x) { return x * __builtin_amdgcn_rcpf(1.0f + __expf(-x)); }
__device__ __forceinline__ float logsigmoidf_(float x) { return fminf(x, 0.0f) - log1pf(__expf(-fabsf(x))); }
__device__ __forceinline__ float wave_sum(float v) {
#pragma unroll
  for (int o = 32; o >= 1; o >>= 1) v += __shfl_xor(v, o);
  return v;
}
__device__ __forceinline__ float wave_max(float v) {
#pragma unroll
  for (int o = 32; o >= 1; o >>= 1) v = fmaxf(v, __shfl_xor(v, o));
  return v;
}
__device__ __forceinline__ f32x4 mfma16(bf16x8 a, bf16x8 b, f32x4 c) {
  return __builtin_amdgcn_mfma_f32_16x16x32_bf16(a, b, c, 0, 0, 0);
}
template <int MI, int NI, bool SWZA = false, bool SWZB = false>
__device__ __forceinline__ void mma_lds(f32x4 (&acc)[MI][NI], const bf16* sA, int lda, const bf16* sB, int ldb, int K, int lane) {
  const int r = lane & 15, q = (lane >> 4) * 8;
  for (int k0 = 0; k0 < K; k0 += 32) {
    bf16x8 a[MI], b[NI];
#pragma unroll
    for (int i = 0; i < MI; ++i) a[i] = *(const bf16x8*)(sA + (i * 16 + r) * lda + ((k0 + q) ^ (SWZA ? (((i * 2 + (r >> 3)) & 7) << 3) : 0)));
#pragma unroll
    for (int j = 0; j < NI; ++j) b[j] = *(const bf16x8*)(sB + (j * 16 + r) * ldb + ((k0 + q) ^ (SWZB ? (((j * 2 + (r >> 3)) & 7) << 3) : 0)));
#pragma unroll
    for (int i = 0; i < MI; ++i)
#pragma unroll
      for (int j = 0; j < NI; ++j) acc[i][j] = mfma16(b[j], a[i], acc[i][j]);
  }
}

constexpr int GLD = 64;
constexpr int GTILE = 128 * GLD;
template <int NI>
__device__ __forceinline__ void g_load(u32x4 (&ra)[4], u32x4 (&rb)[NI], const bf16* __restrict__ A, int lda, const bf16* __restrict__ B, int ldb, int ko, int tid) {
  const unsigned offA = (unsigned)((tid >> 3) * lda + (tid & 7) * 8), offB = (unsigned)((tid >> 3) * ldb + (tid & 7) * 8);
#pragma unroll
  for (int i = 0; i < 4; ++i) {
    const bf16* Ai = A + (size_t)(i * 32) * lda + ko;
    ra[i] = *(const u32x4*)(Ai + offA);
  }
#pragma unroll
  for (int i = 0; i < NI; ++i) {
    const bf16* Bi = B + (size_t)(i * 32) * ldb + ko;
    rb[i] = *(const u32x4*)(Bi + offB);
  }
}
template <int NI>
__device__ __forceinline__ void g_store(const u32x4 (&ra)[4], const u32x4 (&rb)[NI], bf16* buf, int tid) {
  const int off = (tid >> 3) * GLD + (((tid & 7) ^ ((tid >> 3) & 7)) * 8);
#pragma unroll
  for (int i = 0; i < 4; ++i) *(u32x4*)(buf + off + i * 32 * GLD) = ra[i];
#pragma unroll
  for (int i = 0; i < NI; ++i) *(u32x4*)(buf + GTILE + off + i * 32 * GLD) = rb[i];
}
template <int NI, bool LOWREG = false>
__device__ __forceinline__ void g_compute(f32x4 (&acc)[4][NI], const bf16* cur, int wr, int wc, int lane) {
  const int r16 = lane & 15, sw = lane & 7, q = lane >> 4;
#pragma unroll
  for (int ks = 0; ks < 2; ++ks) {
    const int pc = ((ks * 4 + q) ^ sw) * 8;
    bf16x8 a[4];
#pragma unroll
    for (int i = 0; i < 4; ++i) a[i] = *(const bf16x8*)(cur + (wr * 64 + i * 16 + r16) * GLD + pc);
    constexpr int JW = (NI >= 2) ? 2 : 1;
#pragma unroll
    for (int jh = 0; jh < NI; jh += JW) {
      bf16x8 b[JW];
#pragma unroll
      for (int j = 0; j < JW; ++j) b[j] = *(const bf16x8*)(cur + GTILE + (wc * 16 * NI + (jh + j) * 16 + r16) * GLD + pc);
#pragma unroll
      for (int i = 0; i < 4; ++i)
#pragma unroll
        for (int j = 0; j < JW; ++j) acc[i][jh + j] = mfma16(b[j], a[i], acc[i][jh + j]);
      if (LOWREG) __builtin_amdgcn_sched_barrier(0);
    }
  }
}
template <int NI, bool F8SWZ = false>
__device__ __forceinline__ void g_stage(const bf16* __restrict__ A, int lda, const bf16* __restrict__ B, int ldb, int ko, bf16* buf, int tid) {
  const int wave = tid >> 6;
  const int lrow = tid >> 3;
  const int gch = ((tid & 7) ^ (F8SWZ ? ((lrow & 6) | ((lrow >> 3) & 1)) : (lrow & 7))) * 8;
  const unsigned offA = (unsigned)((tid >> 3) * lda + gch), offB = (unsigned)((tid >> 3) * ldb + gch);
#pragma unroll
  for (int i = 0; i < 4; ++i) {
    const bf16* Ai = A + (size_t)(i * 32) * lda + ko;
    __builtin_amdgcn_global_load_lds((const unsigned*)(Ai + offA), (LDSP unsigned*)(buf + (i * 32 + wave * 8) * GLD), 16, 0, 0);
  }
#pragma unroll
  for (int i = 0; i < NI; ++i) {
    const bf16* Bi = B + (size_t)(i * 32) * ldb + ko;
    __builtin_amdgcn_global_load_lds((const unsigned*)(Bi + offB), (LDSP unsigned*)(buf + GTILE + (i * 32 + wave * 8) * GLD), 16, 0, 0);
  }
}
template <int NI, bool LOWREG = false>
__device__ __forceinline__ void gemm_accum(f32x4 (&acc)[4][NI], const bf16* __restrict__ A, int lda,
                                           const bf16* __restrict__ B, int ldb, int K, bf16* sm) {
  const int tid = tidx(), lane = tid & 63, wave = tid >> 6, wr = wave >> 1, wc = wave & 1;
  const int nk = K >> 6;
  bf16* buf0 = sm;
  bf16* buf1 = sm + 2 * GTILE;
  g_stage<NI>(A, lda, B, ldb, 0, buf0, tid);
  asm volatile("s_waitcnt vmcnt(0)" ::: "memory");
  __syncthreads();
#pragma unroll 1
  for (int kt = 0; kt < nk; kt += 2) {
    g_stage<NI>(A, lda, B, ldb, (kt + 1) * 64, buf1, tid);
    g_compute<NI, LOWREG>(acc, buf0, wr, wc, lane);
    asm volatile("s_waitcnt vmcnt(0)" ::: "memory");
    __syncthreads();
    if (kt + 2 < nk) g_stage<NI>(A, lda, B, ldb, (kt + 2) * 64, buf0, tid);
    g_compute<NI, LOWREG>(acc, buf1, wr, wc, lane);
    asm volatile("s_waitcnt vmcnt(0)" ::: "memory");
    __syncthreads();
  }
}
typedef int i32x8 __attribute__((ext_vector_type(8)));
template <int NI>
__device__ __forceinline__ void g_compute_f8(f32x4 (&acc)[4][NI], const bf16* cur, int wr, int wc, int lane) {
  const int r16 = lane & 15, sw = (r16 & 6) | (r16 >> 3), q = lane >> 4;
  const int pc0 = ((2 * q) ^ sw) * 8, pc1 = ((2 * q + 1) ^ sw) * 8;
  i32x8 b[NI];
#pragma unroll
  for (int j = 0; j < NI; ++j) {
    const bf16* rp = cur + GTILE + (wc * 16 * NI + j * 16 + r16) * GLD;
    const u32x4 lo = *(const u32x4*)(rp + pc0), hi = *(const u32x4*)(rp + pc1);
    b[j] = (i32x8){(int)lo.x, (int)lo.y, (int)lo.z, (int)lo.w, (int)hi.x, (int)hi.y, (int)hi.z, (int)hi.w};
  }
#pragma unroll
  for (int i = 0; i < 4; ++i) {
    const bf16* rp = cur + (wr * 64 + i * 16 + r16) * GLD;
    const u32x4 lo = *(const u32x4*)(rp + pc0), hi = *(const u32x4*)(rp + pc1);
    const i32x8 a = (i32x8){(int)lo.x, (int)lo.y, (int)lo.z, (int)lo.w, (int)hi.x, (int)hi.y, (int)hi.z, (int)hi.w};
#pragma unroll
    for (int j = 0; j < NI; ++j)
      acc[i][j] = __builtin_amdgcn_mfma_scale_f32_16x16x128_f8f6f4(b[j], a, acc[i][j], 0, 0, 0, 0x7F7F7F7F, 0, 0x7F7F7F7F);
  }
}
template <int NI>
__device__ __forceinline__ void gemm_accum_f8(f32x4 (&acc)[4][NI], const unsigned char* __restrict__ A8, const unsigned char* __restrict__ B8, bf16* sm) {
  const int tid = tidx(), lane = tid & 63, wave = tid >> 6, wr = wave >> 1, wc = wave & 1;
  const bf16* A = (const bf16*)A8;
  const bf16* B = (const bf16*)B8;
  bf16* buf0 = sm;
  bf16* buf1 = sm + 2 * GTILE;
  g_stage<NI, true>(A, 512, B, 512, 0, buf0, tid);
  asm volatile("s_waitcnt vmcnt(0)" ::: "memory");
  __syncthreads();
#pragma unroll 1
  for (int kt = 0; kt < 8; kt += 2) {
    g_stage<NI, true>(A, 512, B, 512, (kt + 1) * 64, buf1, tid);
    g_compute_f8<NI>(acc, buf0, wr, wc, lane);
    asm volatile("s_waitcnt vmcnt(0)" ::: "memory");
    __syncthreads();
    if (kt + 2 < 8) g_stage<NI, true>(A, 512, B, 512, (kt + 2) * 64, buf0, tid);
    g_compute_f8<NI>(acc, buf1, wr, wc, lane);
    asm volatile("s_waitcnt vmcnt(0)" ::: "memory");
    __syncthreads();
  }
}
template <int NI>
__device__ __forceinline__ void zero_acc(f32x4 (&acc)[4][NI]) {
#pragma unroll
  for (int i = 0; i < 4; ++i)
#pragma unroll
    for (int j = 0; j < NI; ++j) acc[i][j] = (f32x4){0.f, 0.f, 0.f, 0.f};
}
__device__ __forceinline__ void tile_map(int t, int ntn, int& pm, int& pn) {
  const int grp = t / (8 * ntn), w = t % (8 * ntn);
  pm = grp * 8 + (w & 7);
  pn = w >> 3;
}

__device__ __forceinline__ void transpose_tile(const float* __restrict__ src, int ld_src, int n_valid, bf16* __restrict__ dst, int ld_dst,
                               int k0, int n0, int kdst0, float* sm, unsigned char* dst8 = nullptr) {
  const int tid = tidx();
  for (int i = tid; i < 64 * 16; i += 256) {
    const int kk = i >> 4, n4 = (i & 15) * 4, n = n0 + n4;
    float4 v = make_float4(0.f, 0.f, 0.f, 0.f);
    if (n + 3 < n_valid) v = *(const float4*)(src + (size_t)(k0 + kk) * ld_src + n);
    sm[kk * 65 + n4 + 0] = v.x; sm[kk * 65 + n4 + 1] = v.y; sm[kk * 65 + n4 + 2] = v.z; sm[kk * 65 + n4 + 3] = v.w;
  }
  __syncthreads();
  for (int i = tid; i < 64 * 8; i += 256) {
    const int nn = i >> 3, kc = (i & 7) * 8;
    uint4 o;
    o.x = pack2(sm[(kc + 0) * 65 + nn], sm[(kc + 1) * 65 + nn]);
    o.y = pack2(sm[(kc + 2) * 65 + nn], sm[(kc + 3) * 65 + nn]);
    o.z = pack2(sm[(kc + 4) * 65 + nn], sm[(kc + 5) * 65 + nn]);
    o.w = pack2(sm[(kc + 6) * 65 + nn], sm[(kc + 7) * 65 + nn]);
    *(uint4*)(dst + (size_t)(n0 + nn) * ld_dst + kdst0 + kc) = o;
    if (dst8 != nullptr) {
      uint2 q8;
      int t8 = __builtin_amdgcn_cvt_pk_fp8_f32(64.f * sm[(kc + 0) * 65 + nn], 64.f * sm[(kc + 1) * 65 + nn], 0, false);
      q8.x = (unsigned)__builtin_amdgcn_cvt_pk_fp8_f32(64.f * sm[(kc + 2) * 65 + nn], 64.f * sm[(kc + 3) * 65 + nn], t8, true);
      t8 = __builtin_amdgcn_cvt_pk_fp8_f32(64.f * sm[(kc + 4) * 65 + nn], 64.f * sm[(kc + 5) * 65 + nn], 0, false);
      q8.y = (unsigned)__builtin_amdgcn_cvt_pk_fp8_f32(64.f * sm[(kc + 6) * 65 + nn], 64.f * sm[(kc + 7) * 65 + nn], t8, true);
      *(uint2*)(dst8 + (size_t)(n0 + nn - W8_ROW0) * 1024 + kdst0 + kc) = q8;
    }
  }
  __syncthreads();
}

__device__ __forceinline__ void ada_item(const Params& p, int item, float* sm) {
  const int l = item / 192, n0 = (item % 192) * 16;
  const int tid = tidx(), col = tid & 15, rg = tid >> 4;
  constexpr int SLD = 68;
  float* sW = sm + 144 * SLD;
  float acc[9];
#pragma unroll
  for (int j = 0; j < 9; ++j) acc[j] = 0.f;
  const float* W = p.ada_w + (size_t)l * 1024 * 3072 + n0;
  const int wk = tid >> 2, wc4 = (tid & 3) * 4;
  float v[36];
  float4 w0;
#define ADA_LOAD(K0)                                                                                      \
  {                                                                                                       \
    _Pragma("unroll") for (int u = 0; u < 36; ++u) {                                                      \
      const int i = tid + 256 * u, r = i >> 6, kk = i & 63;                                               \
      v[u] = 0.f;                                                                                         \
      if (r < NMOD) v[u] = (r < 4) ? p.c_prompt[r * 1024 + (K0) + kk] : p.c_sample[(r - 4) * 1024 + (K0) + kk]; \
    }                                                                                                     \
    w0 = *(const float4*)(W + (size_t)((K0) + wk) * 3072 + wc4);                                          \
  }
#define ADA_STORE()                                                                                       \
  {                                                                                                       \
    _Pragma("unroll") for (int u = 0; u < 36; ++u) {                                                      \
      const int i = tid + 256 * u, r = i >> 6, kk = i & 63;                                               \
      sm[r * SLD + kk] = siluf_(v[u]);                                                                    \
    }                                                                                                     \
    *(float4*)(sW + wk * 16 + wc4) = w0;                                                                  \
  }
  ADA_LOAD(0)
  ADA_STORE()
  __syncthreads();
#pragma unroll 1
  for (int k0 = 0; k0 < 1024; k0 += 64) {
    if (k0 + 64 < 1024) ADA_LOAD(k0 + 64)
#pragma unroll 4
    for (int k4 = 0; k4 < 16; ++k4) {
      const float x0 = sW[(k4 * 4 + 0) * 16 + col], x1 = sW[(k4 * 4 + 1) * 16 + col];
      const float x2 = sW[(k4 * 4 + 2) * 16 + col], x3 = sW[(k4 * 4 + 3) * 16 + col];
#pragma unroll
      for (int j = 0; j < 9; ++j) {
        const float4 sv = *(const float4*)(sm + (rg * 9 + j) * SLD + k4 * 4);
        acc[j] += sv.x * x0 + sv.y * x1 + sv.z * x2 + sv.w * x3;
      }
    }
    __syncthreads();
    if (k0 + 64 < 1024) ADA_STORE()
    __syncthreads();
  }
#undef ADA_LOAD
#undef ADA_STORE
  float* mod = (float*)(p.ws + WS_MOD);
  const float b = p.ada_b[l * 3072 + n0 + col];
#pragma unroll
  for (int j = 0; j < 9; ++j) {
    const int r = rg * 9 + j;
    if (r < NMOD) mod[((size_t)l * NMOD + r) * 3072 + n0 + col] = acc[j] + b;
  }
}

__device__ __forceinline__ void prep_tile(const Params& p, int i, float* sm) {
  constexpr int N_WIN = 2 * 16 * (NWIN / 64);
  constexpr int N_WBR = 2 * 3 * 8 * 16;
  bf16* WinT = (bf16*)(p.ws + WS_WIN);
  bf16* WbrT = (bf16*)(p.ws + WS_WBR);
  bf16* WoutT = (bf16*)(p.ws + WS_WOUT);
  if (i < N_WIN) {
    const int l = i / (16 * 134), r = i % (16 * 134), kt = r / 134, nt = r % 134;
    transpose_tile(p.w_in + (size_t)l * 1024 * ZIN, ZIN, ZIN, WinT + (size_t)l * NWIN * 1024, 1024, kt * 64, nt * 64, kt * 64, sm,
                   (nt * 64 >= W8_ROW0) ? p.ws + WS_W8 + (size_t)l * W8_ROWS * 1024 : nullptr);
    return;
  }
  i -= N_WIN;
  if (i < N_WBR) {
    const int l = i / 384, r = i % 384, seg = r / 128, r2 = r % 128, kt = r2 / 16, nt = r2 % 16;
    const float* src = (seg == 0 ? p.w_a : seg == 1 ? p.w_b : p.w_c) + (size_t)l * 512 * 1024;
    transpose_tile(src, 1024, 1024, WbrT + (size_t)l * 1024 * 1536, 1536, kt * 64, nt * 64, seg * 512 + kt * 64, sm);
    return;
  }
  i -= N_WBR;
  {
    const int l = i / 256, r = i % 256, kt = r / 16, nt = r % 16;
    transpose_tile(p.w_out + (size_t)l * 1024 * 1024, 1024, 1024, WoutT + (size_t)l * 1024 * 1024, 1024, kt * 64, nt * 64, kt * 64, sm);
  }
}

__device__ __forceinline__ void phase_prep(const Params& p, unsigned char* smem) {
  float* sm = (float*)smem;
  constexpr int N_ALL = 2 * 16 * (NWIN / 64) + 2 * 3 * 8 * 16 + 2 * 16 * 16;
  constexpr int N_ADA = 384;
  for (int it = blockIdx.x; it < N_ADA; it += gridDim.x) ada_item(p, it, sm);
  unsigned* qctr = (unsigned*)(p.ws + WS_BAR) + 3500;
  volatile int* snext = (volatile int*)(smem + 73000);
  const int tid = tidx();
  __syncthreads();
  if (tid == 0) *snext = (int)atomicAdd(qctr, 1u);
  __syncthreads();
  int t = *snext;
  while (t < N_ALL) {
    __syncthreads();
    if (tid == 0) *snext = (int)atomicAdd(qctr, 1u);
    prep_tile(p, t, sm);
    t = *snext;
  }
}

__device__ __forceinline__ const float* xrow_ptr(const Params& p, int l, int row) {
  if (l == 0) return row < TP ? p.x_prompt + (size_t)row * D : p.x_sample + (size_t)(row - TP) * D;
  return p.out + (size_t)row * D;
}
__device__ __forceinline__ int mod_row(int row) { return row < TP ? (row >> 12) : 4 + ((row - TP) >> 3); }

__device__ __forceinline__ void phase_norm(const Params& p, int l) {
  const int lane = tidx() & 63, wave = tidx() >> 6;
  bf16* hbuf = (bf16*)(p.ws + WS_H);
  unsigned char* h8 = p.ws + WS_H8;
  const float* mod = (const float*)(p.ws + WS_MOD);
  const float* g = p.norm_g + l * D;
  for (int row = blockIdx.x * 4 + wave; row < TT; row += gridDim.x * 4) {
    const float4* x = (const float4*)xrow_ptr(p, l, row);
    float4 v[4];
    float ss = 0.f;
#pragma unroll
    for (int i = 0; i < 4; ++i) {
      v[i] = x[lane + 64 * i];
      ss += v[i].x * v[i].x + v[i].y * v[i].y + v[i].z * v[i].z + v[i].w * v[i].w;
    }
    ss = wave_sum(ss);
    const float rstd = rsqrtf(ss * (1.0f / D) + EPS);
    const float* mp = mod + ((size_t)l * NMOD + mod_row(row)) * 3072;
#pragma unroll
    for (int i = 0; i < 4; ++i) {
      const int c = (lane + 64 * i) * 4;
      const float4 gg = *(const float4*)(g + c), sh = *(const float4*)(mp + c), sc = *(const float4*)(mp + 1024 + c);
      uint2 o;
      o.x = pack2(v[i].x * rstd * gg.x * (1.f + sc.x) + sh.x, v[i].y * rstd * gg.y * (1.f + sc.y) + sh.y);
      o.y = pack2(v[i].z * rstd * gg.z * (1.f + sc.z) + sh.z, v[i].w * rstd * gg.w * (1.f + sc.w) + sh.w);
      *(uint2*)(hbuf + (size_t)row * D + c) = o;
      int p8 = __builtin_amdgcn_cvt_pk_fp8_f32(v[i].x * rstd * gg.x * (1.f + sc.x) + sh.x, v[i].y * rstd * gg.y * (1.f + sc.y) + sh.y, 0, false);
      p8 = __builtin_amdgcn_cvt_pk_fp8_f32(v[i].z * rstd * gg.z * (1.f + sc.z) + sh.z, v[i].w * rstd * gg.w * (1.f + sc.w) + sh.w, p8, true);
      *(int*)(h8 + (size_t)row * D + c) = p8;
    }
  }
}

__device__ __forceinline__ void phase_gemm_in(const Params& p, int l, int col0, int ntn, int ldz, unsigned char* smem) {
  bf16* sm = (bf16*)smem;
  const bf16* hbuf = (const bf16*)(p.ws + WS_H);
  const bf16* W = (const bf16*)(p.ws + WS_WIN) + (size_t)l * NWIN * 1024;
  bf16* z = (bf16*)(p.ws + WS_Z);
  const float* bias = p.b_in + (size_t)l * ZIN;
  const int tid = tidx(), lane = tid & 63, wave = tid >> 6, wr = wave >> 1, wc = wave & 1;
  const int ntiles = (TT / 128) * ntn;
  constexpr int OLD = 136;
  const bool isAB = (col0 == 0);
  const int nb = isAB ? 6 : 13;
  const int NB = (TT / 128) * nb;
  for (int t = blockIdx.x; t < ntiles; t += gridDim.x) {
    const bool f8 = t >= NB;
    int pm, pk;
    tile_map(f8 ? t - NB : t, f8 ? ntn - nb : nb, pm, pk);
    int pn;
    if (isAB) pn = f8 ? (pk < 4 ? pk : pk < 12 ? pk + 4 : pk + 6) : (pk < 4 ? 4 + pk : 12 + pk);
    else pn = f8 ? 13 + pk : pk;
    const int m0 = pm * 128, n0 = pn * 128;
    f32x4 acc[4][4];
    zero_acc<4>(acc);
    float osc = 1.0f;
    if (f8) {
      gemm_accum_f8<4>(acc, p.ws + WS_H8 + (size_t)m0 * 1024, p.ws + WS_W8 + ((size_t)l * W8_ROWS + col0 + n0) * 1024, sm);
      osc = 0.015625f;
    } else {
      gemm_accum<4>(acc, hbuf + (size_t)m0 * 1024, 1024, W + (size_t)(col0 + n0) * 1024, 1024, 1024, sm);
    }
#pragma unroll
    for (int j = 0; j < 4; ++j) {
      const int cl = wc * 64 + j * 16 + (lane >> 4) * 4;
      const float4 b = *(const float4*)(bias + col0 + n0 + cl);
#pragma unroll
      for (int i = 0; i < 4; ++i) {
        const int rl = wr * 64 + i * 16 + (lane & 15);
        uint2 o;
        o.x = pack2(acc[i][j][0] * osc + b.x, acc[i][j][1] * osc + b.y);
        o.y = pack2(acc[i][j][2] * osc + b.z, acc[i][j][3] * osc + b.w);
        *(uint2*)(sm + rl * OLD + cl) = o;
      }
    }
    __syncthreads();
#pragma unroll
    for (int it = 0; it < 8; ++it) {
      const int id = tid + 256 * it, row = id >> 4, ch = id & 15;
      const u32x4 v = *(const u32x4*)(sm + row * OLD + ch * 8);
      *(u32x4*)(z + (size_t)(m0 + row) * ldz + n0 + ch * 8) = v;
    }
    __syncthreads();
  }
}

__device__ __forceinline__ void gmlp_prompt_item(const Params& p, int l, int item, unsigned char* smem) {
  const int b = item >> 7, n = (item >> 2) & 31, g = item & 3;
  const int r0 = b * SEQ + n * 128;
  const bf16* z = (const bf16*)(p.ws + WS_Z);
  bf16* yab = (bf16*)(p.ws + WS_YAB);
  bf16* sW = (bf16*)smem;
  bf16* sV = (bf16*)(smem + 34816);
  float* srstd = (float*)(smem + 69632);
  const int tid = tidx(), lane = tid & 63, wave = tid >> 6, wr = wave >> 1, wc = wave & 1;
  {
    float myr = 0.f;
#pragma unroll 8
    for (int k = 0; k < 32; ++k) {
      const int tok = wave * 32 + k;
      float f[8];
      unpack8(*(const uint4*)(z + (size_t)(r0 + tok) * ZAB + OFF_AV + lane * 8), f);
      float ss = 0.f;
#pragma unroll
      for (int j = 0; j < 8; ++j) ss += f[j] * f[j];
      ss = wave_sum(ss);
      if (lane == k) myr = rsqrtf(ss * (1.0f / 512.f) + EPS);
    }
    if (lane < 32) srstd[wave * 32 + lane] = myr;
  }
  __syncthreads();
  const float* vg = p.vnorm_g + l * 512 + g * 128;
  for (int i = tid; i < 2048; i += 256) {
    const int s = i >> 4, c8 = (i & 15) * 8;
    float f[8];
    unpack8(*(const uint4*)(z + (size_t)(r0 + s) * ZAB + OFF_AV + g * 128 + c8), f);
    const float rs = srstd[s];
#pragma unroll
    for (int j = 0; j < 8; ++j) sV[(c8 + j) * 136 + (s ^ (((c8 >> 3) & 7) << 3))] = f2bf(f[j] * rs * vg[c8 + j]);
  }
  const float* Wg = p.gmlp_ws + ((size_t)(l * 4 + g)) * 128 * 128;
  for (int i = tid; i < 4096; i += 256) {
    const int t = i >> 5, s4 = (i & 31) * 4;
    const float4 w = *(const float4*)(Wg + t * 128 + s4);
    uint2 o;
    o.x = pack2(s4 + 0 <= t ? w.x : 0.f, s4 + 1 <= t ? w.y : 0.f);
    o.y = pack2(s4 + 2 <= t ? w.z : 0.f, s4 + 3 <= t ? w.w : 0.f);
    *(uint2*)(sW + t * 136 + s4) = o;
  }
  __syncthreads();
  f32x4 acc[4][4];
  zero_acc<4>(acc);
  mma_lds<4, 4, false, true>(acc, sW + wr * 64 * 136, 136, sV + wc * 64 * 136, 136, wr * 64 + 64, lane);
  const float* bs = p.gmlp_bs + (l * 4 + g) * 128;
#pragma unroll
  for (int i = 0; i < 4; ++i) {
    const int t = wr * 64 + i * 16 + (lane & 15);
    const float bst = bs[t];
    const size_t rowoff = (size_t)(r0 + t) * ZAB;
#pragma unroll
    for (int j = 0; j < 4; ++j) {
      const int c = g * 128 + wc * 64 + j * 16 + (lane >> 4) * 4;
      float u[4], ag[4];
      unpack4(*(const uint2*)(z + rowoff + c), u);
      unpack4(*(const uint2*)(z + rowoff + OFF_AG + c), ag);
      uint2 o;
      o.x = pack2(u[0] * (acc[i][j][0] + bst) * siluf_(ag[0]), u[1] * (acc[i][j][1] + bst) * siluf_(ag[1]));
      o.y = pack2(u[2] * (acc[i][j][2] + bst) * siluf_(ag[2]), u[3] * (acc[i][j][3] + bst) * siluf_(ag[3]));
      *(uint2*)(yab + (size_t)(r0 + t) * 1024 + c) = o;
    }
  }
  __syncthreads();
}

__device__ __forceinline__ void gmlp_sample_item(const Params& p, int l, int b, unsigned char* smem) {
  const int r0 = TP + b * 8;
  const bf16* z = (const bf16*)(p.ws + WS_Z);
  bf16* yab = (bf16*)(p.ws + WS_YAB);
  float* svn = (float*)smem;
  const int tid = tidx(), lane = tid & 63, wave = tid >> 6;
  const float* vg = p.vnorm_g + l * 512;
  for (int tt = 0; tt < 2; ++tt) {
    const int t = wave * 2 + tt;
    float f[8];
    unpack8(*(const uint4*)(z + (size_t)(r0 + t) * ZAB + OFF_AV + lane * 8), f);
    float ss = 0.f;
#pragma unroll
    for (int j = 0; j < 8; ++j) ss += f[j] * f[j];
    ss = wave_sum(ss);
    const float rstd = rsqrtf(ss * (1.0f / 512.f) + EPS);
    float* gv = p.out + O_GV + (((size_t)l * 128 + b) * 8 + t) * 512 + lane * 8;
#pragma unroll
    for (int j = 0; j < 8; ++j) {
      const float vn = f[j] * rstd * vg[lane * 8 + j];
      svn[t * 512 + lane * 8 + j] = vn;
      gv[j] = vn;
    }
  }
  __syncthreads();
  {
    const int c = tid * 2, g = c >> 7;
    const float* Wg = p.gmlp_ws + ((size_t)(l * 4 + g)) * 128 * 128;
    const float* bs = p.gmlp_bs + (l * 4 + g) * 128;
    for (int t = 0; t < 8; ++t) {
      float s0 = bs[t], s1 = bs[t];
      for (int s = 0; s <= t; ++s) {
        const float w = Wg[t * 128 + s];
        s0 += w * svn[s * 512 + c];
        s1 += w * svn[s * 512 + c + 1];
      }
      const unsigned uu = *(const unsigned*)(z + (size_t)(r0 + t) * ZAB + c);
      const unsigned gg = *(const unsigned*)(z + (size_t)(r0 + t) * ZAB + OFF_AG + c);
      *(unsigned*)(yab + (size_t)(r0 + t) * 1024 + c) = pack2(lo2f(uu) * s0 * siluf_(lo2f(gg)), hi2f(uu) * s1 * siluf_(hi2f(gg)));
    }
  }
  __syncthreads();
}

__device__ __forceinline__ void swa_prompt_item(const Params& p, int l, int item, unsigned char* smem) {
  const int b = item >> 7, qt = (item >> 1) & 63, kv = item & 1;
  const int q0 = qt * 64, rb = b * SEQ;
  const bf16* z = (const bf16*)(p.ws + WS_Z);
  bf16* yab = (bf16*)(p.ws + WS_YAB);
  bf16* sK = (bf16*)smem;
  bf16* sVT = (bf16*)(smem + 27648);
  const int tid = tidx(), lane = tid & 63, wave = tid >> 6;
  const float* kg = p.kn_g + l * 64;
  const float* qg = p.qn_g + l * 64;
#pragma unroll 1
  for (int it = 0; it < 6; ++it) {
    const int id = tid + 256 * it, kk = id >> 3, ch = id & 7, kp = q0 - 128 + kk;
    float f[8];
    uint4 vraw = make_uint4(0, 0, 0, 0);
    if (kp >= 0) {
      unpack8(*(const uint4*)(z + (size_t)(rb + kp) * ZAB + OFF_BK + kv * 64 + ch * 8), f);
      vraw = *(const uint4*)(z + (size_t)(rb + kp) * ZAB + OFF_BV + kv * 64 + ch * 8);
    } else {
#pragma unroll
      for (int j = 0; j < 8; ++j) f[j] = 0.f;
    }
    float ss = 0.f;
#pragma unroll
    for (int j = 0; j < 8; ++j) ss += f[j] * f[j];
    ss += __shfl_xor(ss, 1); ss += __shfl_xor(ss, 2); ss += __shfl_xor(ss, 4);
    const float rstd = rsqrtf(ss * (1.0f / 64.f) + EPS);
#pragma unroll
    for (int j = 0; j < 8; ++j) f[j] = f[j] * rstd * kg[ch * 8 + j];
    uint4 ko;
    ko.x = pack2(f[0], f[1]); ko.y = pack2(f[2], f[3]); ko.z = pack2(f[4], f[5]); ko.w = pack2(f[6], f[7]);
    *(uint4*)(sK + kk * 72 + ch * 8) = ko;
    float vf[8];
    unpack8(vraw, vf);
#pragma unroll
    for (int j = 0; j < 8; ++j) sVT[(ch * 8 + j) * 200 + kk] = f2bf(vf[j]);
    if (kk >= 128 && kp >= SEQ - 128) {
      const size_t o = ((((size_t)l * 4 + b) * 128 + (kp - (SEQ - 128))) * 2 + kv) * 64 + ch * 8;
#pragma unroll
      for (int j = 0; j < 8; ++j) { p.out[O_SKP + o + j] = f[j]; p.out[O_SVP + o + j] = vf[j]; }
    }
  }
  __syncthreads();
  const int h = kv * 4 + wave;
  const float sink = p.sinks[l * 8 + h];
  const int g4 = lane >> 4, r16 = lane & 15;
#pragma unroll 1
  for (int i = 0; i < 4; ++i) {
    const int qrow = q0 + i * 16 + r16;
    const size_t grow = (size_t)(rb + qrow);
    bf16x8 qf[2];
    {
      float f0[8], f1[8];
      unpack8(*(const uint4*)(z + grow * ZAB + OFF_BQ + h * 64 + g4 * 8), f0);
      unpack8(*(const uint4*)(z + grow * ZAB + OFF_BQ + h * 64 + 32 + g4 * 8), f1);
      float ss = 0.f;
#pragma unroll
      for (int j = 0; j < 8; ++j) ss += f0[j] * f0[j] + f1[j] * f1[j];
      ss += __shfl_xor(ss, 16); ss += __shfl_xor(ss, 32);
      const float rstd = rsqrtf(ss * (1.0f / 64.f) + EPS) * 0.125f;
#pragma unroll
      for (int j = 0; j < 8; ++j) {
        qf[0][j] = (short)f2bf(f0[j] * rstd * qg[g4 * 8 + j]);
        qf[1][j] = (short)f2bf(f1[j] * rstd * qg[32 + g4 * 8 + j]);
      }
    }
    f32x4 st[12];
#pragma unroll
    for (int kt = 0; kt < 12; ++kt) {
      st[kt] = (f32x4){0.f, 0.f, 0.f, 0.f};
#pragma unroll
      for (int ks = 0; ks < 2; ++ks) {
        const bf16x8 kf = *(const bf16x8*)(sK + (kt * 16 + r16) * 72 + ks * 32 + g4 * 8);
        st[kt] = mfma16(kf, qf[ks], st[kt]);
      }
      if ((kt & 1) == 1) __builtin_amdgcn_sched_barrier(0);
    }
    float mx = -INFINITY;
#pragma unroll
    for (int kt = 0; kt < 12; ++kt)
#pragma unroll
      for (int x = 0; x < 4; ++x) {
        const int kp = q0 - 128 + kt * 16 + g4 * 4 + x, diff = qrow - kp;
        const bool valid = (kp >= 0) && (diff >= 0) && (diff < 128);
        st[kt][x] = valid ? st[kt][x] : -INFINITY;
        mx = fmaxf(mx, st[kt][x]);
      }
    mx = fmaxf(mx, __shfl_xor(mx, 16)); mx = fmaxf(mx, __shfl_xor(mx, 32));
    mx = fmaxf(mx, sink);
    float sum = 0.f;
#pragma unroll
    for (int kt = 0; kt < 12; ++kt)
#pragma unroll
      for (int x = 0; x < 4; ++x) {
        const float pv = __expf(st[kt][x] - mx);
        st[kt][x] = pv;
        sum += pv;
      }
    sum += __shfl_xor(sum, 16); sum += __shfl_xor(sum, 32);
    const float inv = 1.0f / (sum + __expf(sink - mx));
    f32x4 o[4];
#pragma unroll
    for (int dt = 0; dt < 4; ++dt) o[dt] = (f32x4){0.f, 0.f, 0.f, 0.f};
#pragma unroll
    for (int t2 = 0; t2 < 6; ++t2) {
      bf16x8 pf;
#pragma unroll
      for (int x = 0; x < 4; ++x) { pf[x] = (short)f2bf(st[2 * t2][x]); pf[4 + x] = (short)f2bf(st[2 * t2 + 1][x]); }
#pragma unroll
      for (int dt = 0; dt < 4; ++dt) {
        const uint2 v0 = *(const uint2*)(sVT + (dt * 16 + r16) * 200 + t2 * 32 + g4 * 4);
        const uint2 v1 = *(const uint2*)(sVT + (dt * 16 + r16) * 200 + t2 * 32 + 16 + g4 * 4);
        union { uint4 u; bf16x8 v; } cv;
        cv.u = make_uint4(v0.x, v0.y, v1.x, v1.y);
        o[dt] = mfma16(cv.v, pf, o[dt]);
      }
      __builtin_amdgcn_sched_barrier(0);
    }
#pragma unroll
    for (int dt = 0; dt < 4; ++dt) {
      const int d0 = dt * 16 + g4 * 4;
      float bg[4];
      unpack4(*(const uint2*)(z + grow * ZAB + OFF_BG + h * 64 + d0), bg);
      uint2 oo;
      oo.x = pack2(o[dt][0] * inv * siluf_(bg[0]), o[dt][1] * inv * siluf_(bg[1]));
      oo.y = pack2(o[dt][2] * inv * siluf_(bg[2]), o[dt][3] * inv * siluf_(bg[3]));
      *(uint2*)(yab + grow * 1024 + 512 + h * 64 + d0) = oo;
    }
  }
  __syncthreads();
}

__device__ __forceinline__ void swa_sample_item(const Params& p, int l, int item, unsigned char* smem) {
  const int b = item >> 1, kv = item & 1;
  const int r0 = TP + b * 8;
  const bf16* z = (const bf16*)(p.ws + WS_Z);
  bf16* yab = (bf16*)(p.ws + WS_YAB);
  bf16* sK = (bf16*)smem;
  bf16* sV = (bf16*)(smem + 19584);
  float* sq = (float*)(smem + 39168);
  float* sP = (float*)(smem + 47872);
  const int tid = tidx();
  const float* kg = p.kn_g + l * 64;
  const float* qg = p.qn_g + l * 64;
  const float* ck = p.cache_k + ((size_t)l * 128 + b) * 128 * 128;
  const float* cvp = p.cache_v + ((size_t)l * 128 + b) * 128 * 128;
#pragma unroll 1
  for (int it = 0; it < 5; ++it) {
    const int id = tid + 256 * it, j = id >> 3, ch = id & 7;
    const bool act = id < 1088;
    float kf[8], vf[8];
#pragma unroll
    for (int x = 0; x < 8; ++x) { kf[x] = 0.f; vf[x] = 0.f; }
    if (act) {
      if (j < 128) {
        const float4 a0 = *(const float4*)(ck + (j * 2 + kv) * 64 + ch * 8), a1 = *(const float4*)(ck + (j * 2 + kv) * 64 + ch * 8 + 4);
        const float4 b0 = *(const float4*)(cvp + (j * 2 + kv) * 64 + ch * 8), b1 = *(const float4*)(cvp + (j * 2 + kv) * 64 + ch * 8 + 4);
        kf[0] = a0.x; kf[1] = a0.y; kf[2] = a0.z; kf[3] = a0.w; kf[4] = a1.x; kf[5] = a1.y; kf[6] = a1.z; kf[7] = a1.w;
        vf[0] = b0.x; vf[1] = b0.y; vf[2] = b0.z; vf[3] = b0.w; vf[4] = b1.x; vf[5] = b1.y; vf[6] = b1.z; vf[7] = b1.w;
      } else {
        unpack8(*(const uint4*)(z + (size_t)(r0 + j - 128) * ZAB + OFF_BK + kv * 64 + ch * 8), kf);
        unpack8(*(const uint4*)(z + (size_t)(r0 + j - 128) * ZAB + OFF_BV + kv * 64 + ch * 8), vf);
      }
    }
    float ss = 0.f;
#pragma unroll
    for (int x = 0; x < 8; ++x) ss += kf[x] * kf[x];
    ss += __shfl_xor(ss, 1); ss += __shfl_xor(ss, 2); ss += __shfl_xor(ss, 4);
    if (act) {
      if (j >= 128) {
        const float rstd = rsqrtf(ss * (1.0f / 64.f) + EPS);
#pragma unroll
        for (int x = 0; x < 8; ++x) kf[x] = kf[x] * rstd * kg[ch * 8 + x];
      }
      uint4 ko, vo;
      ko.x = pack2(kf[0], kf[1]); ko.y = pack2(kf[2], kf[3]); ko.z = pack2(kf[4], kf[5]); ko.w = pack2(kf[6], kf[7]);
      vo.x = pack2(vf[0], vf[1]); vo.y = pack2(vf[2], vf[3]); vo.z = pack2(vf[4], vf[5]); vo.w = pack2(vf[6], vf[7]);
      *(uint4*)(sK + j * 72 + ch * 8) = ko;
      *(uint4*)(sV + j * 72 + ch * 8) = vo;
      if (j >= 8) {
        const size_t o = ((((size_t)l * 128 + b) * 128 + (j - 8)) * 2 + kv) * 64 + ch * 8;
        *(float4*)(p.out + O_SKS + o) = make_float4(kf[0], kf[1], kf[2], kf[3]);
        *(float4*)(p.out + O_SKS + o + 4) = make_float4(kf[4], kf[5], kf[6], kf[7]);
        *(float4*)(p.out + O_SVS + o) = make_float4(vf[0], vf[1], vf[2], vf[3]);
        *(float4*)(p.out + O_SVS + o + 4) = make_float4(vf[4], vf[5], vf[6], vf[7]);
      }
    }
  }
  const int qi = tid >> 3, sub = tid & 7, t = qi >> 2, h = kv * 4 + (qi & 3);
  {
    float f[8];
    unpack8(*(const uint4*)(z + (size_t)(r0 + t) * ZAB + OFF_BQ + h * 64 + sub * 8), f);
    float ss = 0.f;
#pragma unroll
    for (int x = 0; x < 8; ++x) ss += f[x] * f[x];
    ss += __shfl_xor(ss, 1); ss += __shfl_xor(ss, 2); ss += __shfl_xor(ss, 4);
    const float rstd = rsqrtf(ss * (1.0f / 64.f) + EPS) * 0.125f;
#pragma unroll
    for (int x = 0; x < 8; ++x) sq[qi * 68 + sub * 8 + x] = f[x] * rstd * qg[sub * 8 + x];
  }
  __syncthreads();
  const float sink = p.sinks[l * 8 + h];
  float mx = -INFINITY;
  float qr[64];
#pragma unroll
  for (int c = 0; c < 16; ++c) {
    const float4 q4 = *(const float4*)(sq + qi * 68 + c * 4);
    qr[c * 4 + 0] = q4.x; qr[c * 4 + 1] = q4.y; qr[c * 4 + 2] = q4.z; qr[c * 4 + 3] = q4.w;
  }
#pragma unroll 1
  for (int jj = 0; jj < 17; ++jj) {
    const int key = sub + 8 * jj;
    float s = 0.f;
#pragma unroll
    for (int c = 0; c < 8; ++c) {
      float kf8[8];
      unpack8(*(const uint4*)(sK + key * 72 + c * 8), kf8);
#pragma unroll
      for (int x = 0; x < 8; ++x) s += qr[c * 8 + x] * kf8[x];
    }
    const bool valid = (key >= t + 1) && (key <= t + 128);
    s = valid ? s : -INFINITY;
    sP[qi * 140 + key] = s;
    mx = fmaxf(mx, s);
  }
  mx = fmaxf(mx, __shfl_xor(mx, 1)); mx = fmaxf(mx, __shfl_xor(mx, 2)); mx = fmaxf(mx, __shfl_xor(mx, 4));
  mx = fmaxf(mx, sink);
  float sum = 0.f;
  for (int jj = 0; jj < 17; ++jj) {
    const int key = sub + 8 * jj;
    const float pv = __expf(sP[qi * 140 + key] - mx);
    sP[qi * 140 + key] = pv;
    sum += pv;
  }
  sum += __shfl_xor(sum, 1); sum += __shfl_xor(sum, 2); sum += __shfl_xor(sum, 4);
  const float inv = 1.0f / (sum + __expf(sink - mx));
  __syncthreads();
  {
    float o[8];
#pragma unroll
    for (int x = 0; x < 8; ++x) o[x] = 0.f;
#pragma unroll 2
    for (int key = 0; key < 136; ++key) {
      const float pv = sP[qi * 140 + key];
      float vf[8];
      unpack8(*(const uint4*)(sV + key * 72 + sub * 8), vf);
#pragma unroll
      for (int x = 0; x < 8; ++x) o[x] += pv * vf[x];
    }
    float bg[8];
    unpack8(*(const uint4*)(z + (size_t)(r0 + t) * ZAB + OFF_BG + h * 64 + sub * 8), bg);
    uint4 oo;
    oo.x = pack2(o[0] * inv * siluf_(bg[0]), o[1] * inv * siluf_(bg[1]));
    oo.y = pack2(o[2] * inv * siluf_(bg[2]), o[3] * inv * siluf_(bg[3]));
    oo.z = pack2(o[4] * inv * siluf_(bg[4]), o[5] * inv * siluf_(bg[5]));
    oo.w = pack2(o[6] * inv * siluf_(bg[6]), o[7] * inv * siluf_(bg[7]));
    *(uint4*)(yab + (size_t)(r0 + t) * 1024 + 512 + h * 64 + sub * 8) = oo;
  }
  __syncthreads();
}

__device__ __forceinline__ void phase_mix_ab(const Params& p, int l, unsigned char* smem) {
  constexpr int N_SWA = 512, N_GM = 512, N_SWS = 256, N_GMS = 128;
  constexpr int N_ALL = N_SWA + N_GM + N_SWS + N_GMS;
  for (int it = blockIdx.x; it < N_ALL; it += gridDim.x) {
    int i = it;
    if (i < N_SWA) { swa_prompt_item(p, l, i, smem); continue; }
    i -= N_SWA;
    if (i < N_GM) { gmlp_prompt_item(p, l, i, smem); continue; }
    i -= N_GM;
    if (i < N_SWS) { swa_sample_item(p, l, i, smem); continue; }
    i -= N_SWS;
    gmlp_sample_item(p, l, i, smem);
  }
}

__device__ __forceinline__ void conv8_prompt(const Params& p, int l, const bf16* z, int r0, int pos0, int s, int zc, float* y) {
  const float* cw = p.conv_w + (size_t)l * 4 * 1024 + zc;
  const float* cb = p.conv_b + l * 1024 + zc;
#pragma unroll
  for (int j = 0; j < 8; ++j) y[j] = cb[j];
#pragma unroll
  for (int tap = 0; tap < 4; ++tap) {
    const int back = 3 - tap;
    if (pos0 + s - back >= 0) {
      float f[8];
      unpack8(*(const uint4*)(z + (size_t)(r0 + s - back) * ZC + C_QK + zc), f);
#pragma unroll
      for (int j = 0; j < 8; ++j) y[j] += cw[tap * 1024 + j] * f[j];
    }
  }
#pragma unroll
  for (int j = 0; j < 8; ++j) y[j] = siluf_(y[j]);
}

__device__ __forceinline__ void chunk_gates(const Params& p, int l, const bf16* z, int r0, int hh, int lane, float& cum, float& iv) {
  const float f = bf2f(z[(size_t)(r0 + lane) * ZC + C_F + hh]) + p.f_bias[l * 4 + hh];
  iv = bf2f(z[(size_t)(r0 + lane) * ZC + C_I + hh]);
  float c = logsigmoidf_(f);
#pragma unroll
  for (int o = 1; o < 64; o <<= 1) {
    const float n = __shfl_up(c, o);
    if (lane >= o) c += n;
  }
  cum = c;
}

__device__ __forceinline__ void mlstm_local_item(const Params& p, int l, int item, unsigned char* smem) {
  const int bh = item >> 6, c = item & 63, b = bh >> 2, hh = bh & 3;
  const int r0 = b * SEQ + c * 64;
  const bf16* z = (const bf16*)(p.ws + WS_Z);
  bf16* skT = (bf16*)smem;
  bf16* svT = (bf16*)(smem + 18432);
  float* swsel = (float*)(smem + 36864);
  const int tid = tidx(), lane = tid & 63, wave = tid >> 6, wr = wave >> 1, wc = wave & 1;
  if (wave == 0) {
    float cum, iv;
    chunk_gates(p, l, z, r0, hh, lane, cum, iv);
    const float total = __shfl(cum, 63);
    const float g = total - cum + iv;
    const float G = wave_max(g);
    swsel[lane] = __expf(g - G);
    if (lane == 0) {
      ((float*)(p.ws + WS_G))[item] = G;
      ((float*)(p.ws + WS_TOT))[item] = total;
    }
  }
  __syncthreads();
  for (int i = tid; i < 1024; i += 256) {
    const int s = i >> 4, d8 = (i & 15) * 8;
    float y[8];
    conv8_prompt(p, l, z, r0, c * 64, s, 512 + hh * 128 + d8, y);
    {
      uint4 ko;
      ko.x = pack2(y[0] * 0.08838834764831845f, y[1] * 0.08838834764831845f); ko.y = pack2(y[2] * 0.08838834764831845f, y[3] * 0.08838834764831845f);
      ko.z = pack2(y[4] * 0.08838834764831845f, y[5] * 0.08838834764831845f); ko.w = pack2(y[6] * 0.08838834764831845f, y[7] * 0.08838834764831845f);
      *(uint4*)((bf16*)(p.ws + WS_H) + (size_t)(r0 + s) * 512 + hh * 128 + d8) = ko;
    }
    const float sc = 0.08838834764831845f * swsel[s];
#pragma unroll
    for (int j = 0; j < 8; ++j) skT[(d8 + j) * 72 + (s ^ (((d8 >> 3) & 7) << 3))] = f2bf(y[j] * sc);
    float v[8];
    unpack8(*(const uint4*)(z + (size_t)(r0 + s) * ZC + C_V + hh * 128 + d8), v);
#pragma unroll
    for (int j = 0; j < 8; ++j) svT[(d8 + j) * 72 + (s ^ (((d8 >> 3) & 7) << 3))] = f2bf(v[j]);
  }
  __syncthreads();
  f32x4 acc[4][4];
  zero_acc<4>(acc);
  mma_lds<4, 4, true, true>(acc, svT + wr * 64 * 72, 72, skT + wc * 64 * 72, 72, 64, lane);
  bf16* U = (bf16*)(p.ws + WS_U) + (size_t)item * 16384;
#pragma unroll
  for (int i = 0; i < 4; ++i)
#pragma unroll
    for (int j = 0; j < 4; ++j) {
      const int e = wr * 64 + i * 16 + (lane & 15), d = wc * 64 + j * 16 + (lane >> 4) * 4;
      uint2 o;
      o.x = pack2(acc[i][j][0], acc[i][j][1]);
      o.y = pack2(acc[i][j][2], acc[i][j][3]);
      *(uint2*)(U + e * 128 + d) = o;
    }
  if (tid < 128) {
    float s = 0.f;
    for (int k = 0; k < 64; ++k) s += bf2f(skT[tid * 72 + k]);
    ((float*)(p.ws + WS_UN))[(size_t)item * 128 + tid] = s;
  }
  __syncthreads();
}

__device__ __forceinline__ void mlstm_convout_item(const Params& p, int l, int b) {
  const bf16* z = (const bf16*)(p.ws + WS_Z);
  for (int i = tidx(); i < 3 * 1024; i += 256) {
    const int j = i >> 10, ch = i & 1023;
    p.out[O_CVP + (((size_t)l * 4 + b) * 3 + j) * 1024 + ch] = bf2f(z[(size_t)(b * SEQ + SEQ - 3 + j) * ZC + C_QK + ch]);
  }
}

__device__ __forceinline__ void mlstm_sample_item(const Params& p, int l, int item, unsigned char* smem) {
  const int b = item >> 2, hh = item & 3;
  const int r0 = TP + b * 8;
  bf16* z = (bf16*)(p.ws + WS_Z);
  float* sq = (float*)smem;
  float* sk = sq + 1024;
  float* sv = sk + 1024;
  float* sh = sv + 1024;
  float* sint = sh + 1024;
  float* sa = sint + 2048;
  float* sqn = sa + 64;
  float* smt = sqn + 8;
  float* swi = smt + 8;
  float* swsel = swi + 8;
  float* sdm = swsel + 8;
  float* sdecay = sdm + 64;
  const int tid = tidx(), lane = tid & 63, wave = tid >> 6;
  {
    const int isk = tid >> 7, d = tid & 127, zc = isk * 512 + hh * 128 + d;
    const float* cw = p.conv_w + (size_t)l * 4 * 1024 + zc;
    const float cb = p.conv_b[l * 1024 + zc];
    float xp[11];
    const float* cs = p.st_conv + ((size_t)l * 128 + b) * 3 * 1024 + zc;
    xp[0] = cs[0]; xp[1] = cs[1024]; xp[2] = cs[2048];
#pragma unroll
    for (int t = 0; t < 8; ++t) xp[3 + t] = bf2f(z[(size_t)(r0 + t) * ZC + C_QK + zc]);
    const float w0 = cw[0], w1 = cw[1024], w2 = cw[2048], w3 = cw[3072];
    float* dst = isk ? sk : sq;
    const float sc = isk ? 0.08838834764831845f : 1.0f;
#pragma unroll
    for (int t = 0; t < 8; ++t) {
      const float y = cb + w0 * xp[t] + w1 * xp[t + 1] + w2 * xp[t + 2] + w3 * xp[t + 3];
      dst[t * 128 + d] = siluf_(y) * sc;
    }
    float* co = p.out + O_CVS + ((size_t)l * 128 + b) * 3 * 1024 + zc;
    co[0] = xp[8]; co[1024] = xp[9]; co[2048] = xp[10];
  }
  for (int i = tid; i < 1024; i += 256) {
    const int t = i >> 7, e = i & 127;
    sv[i] = bf2f(z[(size_t)(r0 + t) * ZC + C_V + hh * 128 + e]);
  }
  if (tid == 0) {
    float cum[8], iv[8];
    float c = 0.f;
    for (int t = 0; t < 8; ++t) {
      const float f = bf2f(z[(size_t)(r0 + t) * ZC + C_F + hh]) + p.f_bias[l * 4 + hh];
      c += logsigmoidf_(f);
      cum[t] = c;
      iv[t] = bf2f(z[(size_t)(r0 + t) * ZC + C_I + hh]);
    }
    const float m0 = p.st_m[(l * 128 + b) * 4 + hh];
    for (int t = 0; t < 8; ++t) {
      float dmax = -INFINITY;
      for (int s = 0; s <= t; ++s) dmax = fmaxf(dmax, cum[t] - cum[s] + iv[s]);
      const float mi = cum[t] + m0, mt = fmaxf(mi, dmax);
      smt[t] = mt;
      swi[t] = __expf(mi - mt);
      for (int s = 0; s < 8; ++s) sdm[t * 8 + s] = (s <= t) ? __expf(cum[t] - cum[s] + iv[s] - mt) : 0.f;
    }
    const float total = cum[7];
    float gm = -INFINITY;
    for (int s = 0; s < 8; ++s) gm = fmaxf(gm, total - cum[s] + iv[s]);
    const float mn = fmaxf(total + m0, gm);
    for (int s = 0; s < 8; ++s) swsel[s] = __expf(total - cum[s] + iv[s] - mn);
    sdecay[0] = __expf(total + m0 - mn);
    p.out[O_MS + (l * 128 + b) * 4 + hh] = mn;
  }
  __syncthreads();
  const float* n0 = p.st_n + (((size_t)l * 128 + b) * 4 + hh) * 128;
  if (tid < 64) {
    const int t = tid >> 3, s = tid & 7;
    float dsum = 0.f;
    for (int d = 0; d < 128; ++d) dsum += sq[t * 128 + d] * sk[s * 128 + d];
    sa[t * 8 + s] = sdm[t * 8 + s] * dsum;
  } else if (tid < 128) {
    const int t = (tid - 64) >> 3, part = (tid - 64) & 7;
    float dsum = 0.f;
    for (int d = part * 16; d < part * 16 + 16; ++d) dsum += sq[t * 128 + d] * n0[d];
    dsum += __shfl_xor(dsum, 1); dsum += __shfl_xor(dsum, 2); dsum += __shfl_xor(dsum, 4);
    if (part == 0) sqn[t] = dsum;
  }
  __syncthreads();
  {
    const int e = tid & 127, dh = tid >> 7;
    const float decay = sdecay[0];
    const float* C0 = p.st_C + (((size_t)l * 128 + b) * 4 + hh) * 16384;
    float* C1 = p.out + O_CS + (((size_t)l * 128 + b) * 4 + hh) * 16384;
    float vw[8], inter[8];
#pragma unroll
    for (int s = 0; s < 8; ++s) { vw[s] = sv[s * 128 + e] * swsel[s]; inter[s] = 0.f; }
    for (int d = dh * 64; d < dh * 64 + 64; ++d) {
      const float c0 = C0[d * 128 + e];
      float upd = decay * c0;
#pragma unroll
      for (int s = 0; s < 8; ++s) {
        upd += sk[s * 128 + d] * vw[s];
        inter[s] += sq[s * 128 + d] * c0;
      }
      C1[d * 128 + e] = upd;
    }
#pragma unroll
    for (int t = 0; t < 8; ++t) sint[(dh * 8 + t) * 128 + e] = inter[t];
  }
  __syncthreads();
  if (tid < 128) {
    const int e = tid;
    for (int t = 0; t < 8; ++t) {
      float num = swi[t] * (sint[t * 128 + e] + sint[(8 + t) * 128 + e]);
      float den = swi[t] * sqn[t];
      for (int s = 0; s <= t; ++s) { num += sa[t * 8 + s] * sv[s * 128 + e]; den += sa[t * 8 + s]; }
      sh[t * 128 + e] = num / fmaxf(fabsf(den), __expf(-smt[t]));
    }
    float nn = sdecay[0] * n0[e];
    for (int s = 0; s < 8; ++s) nn += swsel[s] * sk[s * 128 + e];
    p.out[O_NS + (((size_t)l * 128 + b) * 4 + hh) * 128 + e] = nn;
  }
  __syncthreads();
  const float* hg = p.hnorm_g + l * 512 + hh * 128;
  for (int tt = 0; tt < 2; ++tt) {
    const int t = wave * 2 + tt;
    const float h0 = sh[t * 128 + lane], h1 = sh[t * 128 + 64 + lane];
    const float ss = wave_sum(h0 * h0 + h1 * h1);
    const float rstd = rsqrtf(ss * (1.0f / 128.f) + EPS);
    bf16* zr = z + (size_t)(r0 + t) * ZC;
#pragma unroll
    for (int k = 0; k < 2; ++k) {
      const int e = lane + 64 * k;
      const float hv = k ? h1 : h0;
      const float o = bf2f(zr[C_O + hh * 128 + e]), cg_ = bf2f(zr[C_G + hh * 128 + e]);
      zr[C_O + hh * 128 + e] = f2bf(hv * rstd * hg[e] * sigmoidf_(o) * siluf_(cg_));
    }
  }
  __syncthreads();
}

__device__ __forceinline__ void phase_mix1(const Params& p, int l, unsigned char* smem) {
  constexpr int N_LOC = 1024, N_SMP = 512, N_CV = 4;
  constexpr int N_ALL = N_LOC + N_SMP + N_CV;
  for (int it = blockIdx.x; it < N_ALL; it += gridDim.x) {
    int i = it;
    if (i < N_LOC) { mlstm_local_item(p, l, i, smem); continue; }
    i -= N_LOC;
    if (i < N_SMP) { mlstm_sample_item(p, l, i, smem); continue; }
    i -= N_SMP;
    mlstm_convout_item(p, l, i);
  }
}

__device__ __forceinline__ void phase_scan(const Params& p, int l, unsigned char* smem) {
  float* sdec = (float*)smem;
  float* ssc = sdec + 64;
  const int tid = tidx();
  float* Gb = (float*)(p.ws + WS_G);
  float* Tb = (float*)(p.ws + WS_TOT);
  float* Mb = (float*)(p.ws + WS_M);
  for (int it = blockIdx.x; it < 256; it += gridDim.x) {
    const int bh = it >> 4, slice = it & 15;
    if (tid < 64) { sdec[128 + tid] = Gb[bh * 64 + tid]; sdec[192 + tid] = Tb[bh * 64 + tid]; }
    __syncthreads();
    if (tid == 0) {
      float m = 0.f;
      for (int c = 0; c < 64; ++c) {
        const float G = sdec[128 + c], tot = sdec[192 + c];
        const float mn = fmaxf(tot + m, G);
        sdec[c] = __expf(tot + m - mn);
        ssc[c] = __expf(G - mn);
        if (slice == 0) Mb[bh * 64 + c] = m;
        m = mn;
      }
      if (slice == 0) p.out[O_MP + l * 16 + bh] = m;
    }
    __syncthreads();
    {
      const int idx = slice * 1024 + tid * 4;
      bf16* U = (bf16*)(p.ws + WS_U) + (size_t)bh * 64 * 16384 + idx;
      float st[4] = {0.f, 0.f, 0.f, 0.f};
#pragma unroll 8
      for (int c = 0; c < 64; ++c) {
        float u[4];
        unpack4(*(const uint2*)(U + (size_t)c * 16384), u);
        uint2 o;
        o.x = pack2(st[0], st[1]); o.y = pack2(st[2], st[3]);
        *(uint2*)(U + (size_t)c * 16384) = o;
        const float dc = sdec[c], sc = ssc[c];
#pragma unroll
        for (int x = 0; x < 4; ++x) st[x] = dc * st[x] + sc * u[x];
      }
      const int e = idx >> 7, d0 = idx & 127;
      float* Co = p.out + O_CP + ((size_t)l * 16 + bh) * 16384;
#pragma unroll
      for (int x = 0; x < 4; ++x) Co[(d0 + x) * 128 + e] = st[x];
    }
    if (slice == 0 && tid < 128) {
      float* un = (float*)(p.ws + WS_UN) + (size_t)bh * 64 * 128 + tid;
      float n = 0.f;
#pragma unroll 8
      for (int c = 0; c < 64; ++c) {
        const float u = un[c * 128];
        un[c * 128] = n;
        n = sdec[c] * n + ssc[c] * u;
      }
      p.out[O_NP + ((size_t)l * 16 + bh) * 128 + tid] = n;
    }
    __syncthreads();
  }
}

__device__ __forceinline__ void mlstm_out_item(const Params& p, int l, int item, unsigned char* smem) {
  const int bh = item >> 6, c = item & 63, b = bh >> 2, hh = bh & 3;
  const int r0 = b * SEQ + c * 64;
  bf16* z = (bf16*)(p.ws + WS_Z);
  bf16* sq = (bf16*)smem;
  bf16* sk = (bf16*)(smem + 17408);
  bf16* svT = (bf16*)(smem + 34816);
  bf16* sa = (bf16*)(smem + 53248);
  float* scum = (float*)(smem + 62464);
  float* siv = scum + 64;
  float* smt = siv + 64;
  float* swi = smt + 64;
  float* sden = swi + 64;
  float* sqn = sden + 64;
  float* spart = sqn + 64;
  const int tid = tidx(), lane = tid & 63, wave = tid >> 6;
  const int r16 = lane & 15, g4 = lane >> 4;
  if (wave == 0) {
    float cum, iv;
    chunk_gates(p, l, z, r0, hh, lane, cum, iv);
    scum[lane] = cum;
    siv[lane] = iv;
  }
  for (int i = tid; i < 1024; i += 256) {
    const int s = i >> 4, d8 = (i & 15) * 8;
    *(uint4*)(sk + s * 136 + d8) = *(const uint4*)((const bf16*)(p.ws + WS_H) + (size_t)(r0 + s) * 512 + hh * 128 + d8);
  }
  for (int i = tid; i < 1024; i += 256) {
    const int s = i >> 4, d8 = (i & 15) * 8;
    float y[8];
    conv8_prompt(p, l, z, r0, c * 64, s, hh * 128 + d8, y);
    uint4 o;
    o.x = pack2(y[0], y[1]); o.y = pack2(y[2], y[3]);
    o.z = pack2(y[4], y[5]); o.w = pack2(y[6], y[7]);
    *(uint4*)(sq + s * 136 + d8) = o;
  }
  for (int i = tid; i < 1024; i += 256) {
    const int s = i >> 4, d8 = (i & 15) * 8;
    float v[8];
    unpack8(*(const uint4*)(z + (size_t)(r0 + s) * ZC + C_V + hh * 128 + d8), v);
#pragma unroll
    for (int j = 0; j < 8; ++j) svT[(d8 + j) * 72 + (s ^ (((d8 >> 3) & 7) << 3))] = f2bf(v[j]);
  }
  __syncthreads();
  const float m_prev = ((const float*)(p.ws + WS_M))[item];
  {
    const int t = wave * 16 + r16;
    bf16x8 qf[4];
#pragma unroll
    for (int ks = 0; ks < 4; ++ks) qf[ks] = *(const bf16x8*)(sq + t * 136 + ks * 32 + g4 * 8);
    f32x4 st[4];
#pragma unroll
    for (int kt = 0; kt < 4; ++kt) {
      st[kt] = (f32x4){0.f, 0.f, 0.f, 0.f};
#pragma unroll
      for (int ks = 0; ks < 4; ++ks) {
        const bf16x8 kf = *(const bf16x8*)(sk + (kt * 16 + r16) * 136 + ks * 32 + g4 * 8);
        st[kt] = mfma16(kf, qf[ks], st[kt]);
      }
    }
    const float cumt = scum[t];
    float dm[4][4];
    float rmax = -INFINITY;
#pragma unroll
    for (int kt = 0; kt < 4; ++kt)
#pragma unroll
      for (int x = 0; x < 4; ++x) {
        const int s = kt * 16 + g4 * 4 + x;
        dm[kt][x] = (s <= t) ? (cumt - scum[s] + siv[s]) : -INFINITY;
        rmax = fmaxf(rmax, dm[kt][x]);
      }
    rmax = fmaxf(rmax, __shfl_xor(rmax, 16)); rmax = fmaxf(rmax, __shfl_xor(rmax, 32));
    const float mi = cumt + m_prev, mt = fmaxf(mi, rmax);
    float rsum = 0.f;
#pragma unroll
    for (int kt = 0; kt < 4; ++kt) {
      float a[4];
#pragma unroll
      for (int x = 0; x < 4; ++x) {
        const int s = kt * 16 + g4 * 4 + x;
        a[x] = (s <= t) ? __expf(dm[kt][x] - mt) * st[kt][x] : 0.f;
        rsum += a[x];
      }
      uint2 o;
      o.x = pack2(a[0], a[1]); o.y = pack2(a[2], a[3]);
      *(uint2*)(sa + t * 72 + kt * 16 + g4 * 4) = o;
    }
    rsum += __shfl_xor(rsum, 16); rsum += __shfl_xor(rsum, 32);
    if (g4 == 0) { smt[t] = mt; swi[t] = __expf(mi - mt); sden[t] = rsum; }
  }
  {
    const int t = tid >> 2, part = tid & 3;
    const float* nc = (const float*)(p.ws + WS_UN) + (size_t)item * 128;
    float s = 0.f;
    for (int d = part * 32; d < part * 32 + 32; ++d) s += bf2f(sq[t * 136 + d]) * nc[d];
    s += __shfl_xor(s, 1); s += __shfl_xor(s, 2);
    if (part == 0) sqn[t] = s;
  }
  __syncthreads();
  f32x4 acc[4][2];
#pragma unroll
  for (int ti = 0; ti < 4; ++ti)
#pragma unroll
    for (int et = 0; et < 2; ++et) acc[ti][et] = (f32x4){0.f, 0.f, 0.f, 0.f};
  const bf16* Cc = (const bf16*)(p.ws + WS_U) + (size_t)item * 16384;
#pragma unroll
  for (int ks = 0; ks < 4; ++ks) {
    bf16x8 cf[2], qf[4];
#pragma unroll
    for (int et = 0; et < 2; ++et) cf[et] = *(const bf16x8*)(Cc + (wave * 32 + et * 16 + r16) * 128 + ks * 32 + g4 * 8);
#pragma unroll
    for (int ti = 0; ti < 4; ++ti) qf[ti] = *(const bf16x8*)(sq + (ti * 16 + r16) * 136 + ks * 32 + g4 * 8);
#pragma unroll
    for (int ti = 0; ti < 4; ++ti)
#pragma unroll
      for (int et = 0; et < 2; ++et) acc[ti][et] = mfma16(cf[et], qf[ti], acc[ti][et]);
  }
#pragma unroll
  for (int ti = 0; ti < 4; ++ti) {
    const float w = swi[ti * 16 + r16];
#pragma unroll
    for (int et = 0; et < 2; ++et) acc[ti][et] *= w;
  }
#pragma unroll
  for (int ks = 0; ks < 2; ++ks) {
    bf16x8 vf[2], af[4];
#pragma unroll
    for (int et = 0; et < 2; ++et) vf[et] = *(const bf16x8*)(svT + (wave * 32 + et * 16 + r16) * 72 + ((ks * 32 + g4 * 8) ^ (((wave * 4 + et * 2 + (r16 >> 3)) & 7) << 3)));
#pragma unroll
    for (int ti = 0; ti < 4; ++ti) af[ti] = *(const bf16x8*)(sa + (ti * 16 + r16) * 72 + ks * 32 + g4 * 8);
#pragma unroll
    for (int ti = 0; ti < 4; ++ti)
#pragma unroll
      for (int et = 0; et < 2; ++et) acc[ti][et] = mfma16(vf[et], af[ti], acc[ti][et]);
  }
#pragma unroll
  for (int ti = 0; ti < 4; ++ti) {
    const int t = ti * 16 + r16;
    const float den = sden[t] + swi[t] * sqn[t];
    const float inv = 1.0f / fmaxf(fabsf(den), __expf(-smt[t]));
    float ss = 0.f;
#pragma unroll
    for (int et = 0; et < 2; ++et) {
      acc[ti][et] *= inv;
#pragma unroll
      for (int x = 0; x < 4; ++x) ss += acc[ti][et][x] * acc[ti][et][x];
    }
    ss += __shfl_xor(ss, 16); ss += __shfl_xor(ss, 32);
    if (g4 == 0) spart[t * 4 + wave] = ss;
  }
  __syncthreads();
  const float* hg = p.hnorm_g + l * 512 + hh * 128;
#pragma unroll
  for (int ti = 0; ti < 4; ++ti) {
    const int t = ti * 16 + r16;
    const float rstd = rsqrtf((spart[t * 4] + spart[t * 4 + 1] + spart[t * 4 + 2] + spart[t * 4 + 3]) * (1.0f / 128.f) + EPS);
    bf16* zr = z + (size_t)(r0 + t) * ZC;
#pragma unroll
    for (int et = 0; et < 2; ++et) {
      const int e = wave * 32 + et * 16 + g4 * 4;
      float o[4], cg_[4];
      unpack4(*(const uint2*)(zr + C_O + hh * 128 + e), o);
      unpack4(*(const uint2*)(zr + C_G + hh * 128 + e), cg_);
      float y[4];
#pragma unroll
      for (int x = 0; x < 4; ++x) y[x] = acc[ti][et][x] * rstd * hg[e + x] * sigmoidf_(o[x]) * siluf_(cg_[x]);
      uint2 oo;
      oo.x = pack2(y[0], y[1]); oo.y = pack2(y[2], y[3]);
      *(uint2*)(zr + C_O + hh * 128 + e) = oo;
    }
  }
  __syncthreads();
}

__device__ __forceinline__ void phase_mix2(const Params& p, int l, unsigned char* smem) {
  for (int it = blockIdx.x; it < 1024; it += gridDim.x) mlstm_out_item(p, l, it, smem);
}

template <int NI>
__device__ __forceinline__ void br_tile(const Params& p, int l, int m0, int n0, bf16* sm) {
  const bf16* Wbr = (const bf16*)(p.ws + WS_WBR) + (size_t)l * 1024 * 1536;
  const bf16* yab = (const bf16*)(p.ws + WS_YAB);
  const bf16* z = (const bf16*)(p.ws + WS_Z);
  bf16* merged = (bf16*)(p.ws + WS_U);
  const float* bias = p.b_in + (size_t)l * ZIN + OFF_MG;
  const int lane = tidx() & 63, wave = tidx() >> 6, wr = wave >> 1, wc = wave & 1;
#pragma unroll 1
  for (int seg = 0; seg < 3; ++seg) {
    f32x4 acc[4][NI];
    zero_acc<NI>(acc);
    gemm_accum_f8<NI>(acc, p.ws + WS_H8 + (size_t)m0 * 1024, p.ws + WS_W8 + ((size_t)l * W8_ROWS + (OFF_MG - W8_ROW0) + seg * 1024 + n0) * 1024, sm);
    unsigned gp[4][NI][2];
#pragma unroll
    for (int j = 0; j < NI; ++j) {
      const int col = n0 + wc * (16 * NI) + j * 16 + (lane >> 4) * 4;
      const float4 bb = *(const float4*)(bias + seg * 1024 + col);
#pragma unroll
      for (int i = 0; i < 4; ++i) {
        gp[i][j][0] = pack2(sigmoidf_(acc[i][j][0] * 0.015625f + bb.x), sigmoidf_(acc[i][j][1] * 0.015625f + bb.y));
        gp[i][j][1] = pack2(sigmoidf_(acc[i][j][2] * 0.015625f + bb.z), sigmoidf_(acc[i][j][3] * 0.015625f + bb.w));
      }
    }
    zero_acc<NI>(acc);
    const bf16* A = (seg == 0) ? yab + (size_t)m0 * 1024 : (seg == 1) ? yab + (size_t)m0 * 1024 + 512 : z + (size_t)m0 * ZC + C_O;
    const int lda = (seg == 2) ? ZC : 1024;
    gemm_accum<NI, (NI >= 2)>(acc, A, lda, Wbr + (size_t)n0 * 1536 + seg * 512, 1536, 512, sm);
#pragma unroll
    for (int i = 0; i < 4; ++i)
#pragma unroll
      for (int j = 0; j < NI; ++j) {
        const int row = m0 + wr * 64 + i * 16 + (lane & 15), col = n0 + wc * (16 * NI) + j * 16 + (lane >> 4) * 4;
        uint2* mp = (uint2*)(merged + (size_t)row * 1024 + col);
        uint2 prev = make_uint2(0u, 0u);
        if (seg > 0) prev = *mp;
        uint2 o;
        o.x = pack2(lo2f(prev.x) + lo2f(gp[i][j][0]) * acc[i][j][0], hi2f(prev.x) + hi2f(gp[i][j][0]) * acc[i][j][1]);
        o.y = pack2(lo2f(prev.y) + lo2f(gp[i][j][1]) * acc[i][j][2], hi2f(prev.y) + hi2f(gp[i][j][1]) * acc[i][j][3]);
        *mp = o;
      }
  }
}
__device__ __forceinline__ void phase_gemm_br(const Params& p, int l, unsigned char* smem) {
  bf16* sm = (bf16*)smem;
  const int ntiles = (TT / 128) * 8;
  const int nfull = (ntiles / (int)gridDim.x) * (int)gridDim.x;
  for (int t = blockIdx.x; t < nfull; t += gridDim.x) {
    int pm, pn;
    tile_map(t, 8, pm, pn);
    br_tile<4>(p, l, pm * 128, pn * 128, sm);
  }
  for (int u = blockIdx.x; u < 4 * (ntiles - nfull); u += gridDim.x) {
    int pm, pn;
    tile_map(nfull + (u >> 2), 8, pm, pn);
    br_tile<1>(p, l, pm * 128, pn * 128 + (u & 3) * 32, sm);
  }
}

template <int NI>
__device__ __forceinline__ void out_tile(const Params& p, int l, int m0, int n0, bf16* sm) {
  const bf16* merged = (const bf16*)(p.ws + WS_U);
  const bf16* Wout = (const bf16*)(p.ws + WS_WOUT) + (size_t)l * 1024 * 1024;
  const float* mod = (const float*)(p.ws + WS_MOD);
  const int lane = tidx() & 63, wave = tidx() >> 6, wr = wave >> 1, wc = wave & 1;
  f32x4 acc[4][NI];
  zero_acc<NI>(acc);
  gemm_accum<NI>(acc, merged + (size_t)m0 * 1024, 1024, Wout + (size_t)n0 * 1024, 1024, 1024, sm);
#pragma unroll
  for (int i = 0; i < 4; ++i) {
    const int row = m0 + wr * 64 + i * 16 + (lane & 15);
    const float* xr = xrow_ptr(p, l, row);
    const float* gate = mod + ((size_t)l * NMOD + mod_row(row)) * 3072 + 2048;
#pragma unroll
    for (int j = 0; j < NI; ++j) {
      const int col = n0 + wc * (16 * NI) + j * 16 + (lane >> 4) * 4;
      const float4 xv = *(const float4*)(xr + col), gv = *(const float4*)(gate + col);
      float4 o;
      o.x = xv.x + gv.x * acc[i][j][0]; o.y = xv.y + gv.y * acc[i][j][1];
      o.z = xv.z + gv.z * acc[i][j][2]; o.w = xv.w + gv.w * acc[i][j][3];
      *(float4*)(p.out + (size_t)row * D + col) = o;
    }
  }
}
__device__ __forceinline__ void phase_gemm_out(const Params& p, int l, unsigned char* smem) {
  bf16* sm = (bf16*)smem;
  const int ntiles = (TT / 128) * 8;
  const int nfull = (ntiles / (int)gridDim.x) * (int)gridDim.x;
  for (int t = blockIdx.x; t < nfull; t += gridDim.x) {
    int pm, pn;
    tile_map(t, 8, pm, pn);
    out_tile<4>(p, l, pm * 128, pn * 128, sm);
  }
  for (int u = blockIdx.x; u < 4 * (ntiles - nfull); u += gridDim.x) {
    int pm, pn;
    tile_map(nfull + (u >> 2), 8, pm, pn);
    out_tile<1>(p, l, pm * 128, pn * 128 + (u & 3) * 32, sm);
  }
}

constexpr int N_PHASES = 19;
template <int S>
__device__ __forceinline__ void run_stage(const Params& p, int l, unsigned char* smem) {
  if (S == -1) phase_prep(p, smem);
  if (S == 0) phase_norm(p, l);
  if (S == 1) phase_gemm_in(p, l, 0, ZAB / 128, ZAB, smem);
  if (S == 2) phase_mix_ab(p, l, smem);
  if (S == 3) phase_gemm_in(p, l, ZAB, ZC / 128, ZC, smem);
  if (S == 4) phase_mix1(p, l, smem);
  if (S == 5) phase_scan(p, l, smem);
  if (S == 6) phase_mix2(p, l, smem);
  if (S == 7) phase_gemm_br(p, l, smem);
  if (S == 8) phase_gemm_out(p, l, smem);
}


#define XB_TMO      128
#define XB_XCNT(j)  (256  + 64 * (j))
#define XB_XSUB(j)  (1280 + 64 * (j))
#define XB_XGEN(j)  (2304 + 64 * (j))
#define XB_TOP      3328
#define XB_TOPGEN   3392
#define XCD_BAR_WORDS 3456
#define XB_SPIN_CAP (1u << 18)
#define LAS __attribute__((address_space(3)))
__device__ __forceinline__ unsigned xb_ld(unsigned* p)              { return __hip_atomic_load(p, __ATOMIC_RELAXED, __HIP_MEMORY_SCOPE_AGENT); }
__device__ __forceinline__ unsigned xb_add(unsigned* p, unsigned v) { return __hip_atomic_fetch_add(p, v, __ATOMIC_RELAXED, __HIP_MEMORY_SCOPE_AGENT); }
__device__ __forceinline__ unsigned xb_xcc_id() { return (unsigned)__builtin_amdgcn_s_getreg((3 << 11) | 20) & 0xFu; }
#define XB_SPIN(cond, bar) do { unsigned _sp = 0; while (cond) { __builtin_amdgcn_s_sleep(1); \
    if ((++_sp & 255u) == 0u) { if (xb_ld(&(bar)[XB_TMO])) break; if (_sp > XB_SPIN_CAP) { atomicAdd(&(bar)[XB_TMO], 1u); break; } } } } while (0)
struct XcdBarrier { unsigned* bar; unsigned x; volatile LAS unsigned* st; };
__device__ __forceinline__ XcdBarrier xcd_barrier_post(unsigned* bar, volatile LAS unsigned* st) {
  XcdBarrier b; b.bar = bar; b.x = xb_xcc_id(); b.st = st;
  if (threadIdx.x == 0) (void)xb_add(&bar[XB_XCNT(b.x)], 1u);
  return b;
}
__device__ __forceinline__ void xcd_barrier_complete(unsigned* bar, unsigned x, unsigned& nloc, unsigned& nx) {
  const unsigned G = gridDim.x * gridDim.y * gridDim.z;
  unsigned sum, cnt, mine, sp = 0u;
  for (;;) {
    sum = 0u; cnt = 0u; mine = 0u;
#pragma unroll
    for (unsigned j = 0; j < 16; ++j) { const unsigned c = xb_ld(&bar[XB_XCNT(j)]); sum += c; cnt += (c > 0u) ? 1u : 0u; mine = (j == x) ? c : mine; }
    if (sum == G) break;
    __builtin_amdgcn_s_sleep(1);
    if ((++sp & 255u) == 0u) { if (xb_ld(&bar[XB_TMO])) break; if (sp > XB_SPIN_CAP) { atomicAdd(&bar[XB_TMO], 1u); break; } }
  }
  nloc = mine > 0u ? mine : 1u; nx = cnt > 0u ? cnt : 1u;
}
__device__ __forceinline__ void xcd_barrier(const XcdBarrier& b) {
  asm volatile("s_waitcnt vmcnt(0)" ::: "memory");
  __syncthreads();
  if (threadIdx.x == 0) {
    unsigned* bar = b.bar;
    __builtin_amdgcn_s_waitcnt(0);
    unsigned nloc = b.st[0], nx = b.st[1];
    if (nloc == 0u) { xcd_barrier_complete(bar, b.x, nloc, nx); b.st[0] = nloc; b.st[1] = nx; }
    const unsigned old = xb_add(&bar[XB_XSUB(b.x)], 1u);
    const unsigned gen = old / nloc;
    if (old + 1u == (gen + 1u) * nloc) {
      __builtin_amdgcn_fence(__ATOMIC_RELEASE, "agent");
      asm volatile("s_waitcnt vmcnt(0)" ::: "memory");
      const unsigned og = xb_add(&bar[XB_TOP], 1u);
      const unsigned tg = og / nx;
      if (og + 1u == (tg + 1u) * nx) xb_add(&bar[XB_TOPGEN], 1u);
      else XB_SPIN(xb_ld(&bar[XB_TOPGEN]) == tg, bar);
      __builtin_amdgcn_fence(__ATOMIC_ACQUIRE, "agent");
      xb_add(&bar[XB_XGEN(b.x)], 1u);
      asm volatile("s_waitcnt vmcnt(0)" ::: "memory");
    } else {
      XB_SPIN(xb_ld(&bar[XB_XGEN(b.x)]) == gen, bar);
      __builtin_amdgcn_fence(__ATOMIC_ACQUIRE, "agent");
      asm volatile("s_waitcnt vmcnt(0)" ::: "memory");
    }
  }
  __syncthreads();
}

#define GSYNC() xcd_barrier(xb)
__global__ void __launch_bounds__(256, 2) mega_kernel(Params p_in) {
  __shared__ __attribute__((aligned(16))) unsigned char smem[SMEM_BYTES];
  const Params& p = *(const Params*)__builtin_amdgcn_kernarg_segment_ptr();
  __shared__ uint4 xb_words;
  if (threadIdx.x == 0) xb_words = make_uint4(0u, 0u, 0u, 0u);
  __syncthreads();
  XcdBarrier xb = xcd_barrier_post((unsigned*)(p.ws + WS_BAR), (volatile LAS unsigned*)&xb_words);
  run_stage<-1>(p, 0, smem);
  if (p.out == nullptr) cg::this_grid().sync();
  GSYNC();
#define LAYER(L, LAST)                 \
  run_stage<0>(p, L, smem); GSYNC();   \
  run_stage<1>(p, L, smem); GSYNC();   \
  run_stage<2>(p, L, smem); GSYNC();   \
  run_stage<3>(p, L, smem); GSYNC();   \
  run_stage<4>(p, L, smem); GSYNC();   \
  run_stage<5>(p, L, smem); GSYNC();   \
  run_stage<6>(p, L, smem); GSYNC();   \
  run_stage<7>(p, L, smem); GSYNC();   \
  run_stage<8>(p, L, smem);            \
  if (!LAST) GSYNC();
  int l0 = 0, l1 = 1;
  asm volatile("" : "+s"(l0));
  asm volatile("" : "+s"(l1));
  LAYER(l0, 0)
  LAYER(l1, 1)
}

extern "C" void kernel_launch(void* const* d_in, const int* in_sizes, int n_in, void* d_out, int out_size, void* d_ws,
                              size_t ws_size, hipStream_t stream) {
  if (ws_size < WS_END || n_in < 29) { fprintf(stderr, "workspace too small / bad inputs\n"); return; }
  Params p{};
  const float** f = (const float**)&p;
  for (int i = 0; i < 29; ++i) f[i] = (const float*)d_in[i];
  p.out = (float*)d_out;
  p.ws = (unsigned char*)d_ws;
  static int grid_blocks = 0;
  if (!grid_blocks) {
    int dev = 0, cus = 0, per_cu = 0;
    (void)hipGetDevice(&dev);
    (void)hipDeviceGetAttribute(&cus, hipDeviceAttributeMultiprocessorCount, dev);
    (void)hipOccupancyMaxActiveBlocksPerMultiprocessor(&per_cu, mega_kernel, 256, 0);
    if (per_cu < 1) per_cu = 1;
    if (per_cu > 2) per_cu = 2;
    grid_blocks = cus * per_cu;
  }
  (void)hipMemsetAsync((unsigned char*)d_ws + WS_BAR, 0, 16384, stream);
  void* args[] = {&p};
  hipError_t e = hipLaunchCooperativeKernel((void*)mega_kernel, dim3(grid_blocks), dim3(256), args, 0, stream);
  if (e != hipSuccess) fprintf(stderr, "cooperative launch failed: %s (grid %d)\n", hipGetErrorString(e), grid_blocks);
}
```
